# Optimizing an MI355X kernel written in HIP

```python
import math
import jax, jax.numpy as jnp
from jax import lax
import numpy as np

D_MODEL = 1024
BATCH = 1
SEQ = 16384
DEPTH = 1

GRID_W = 64
CTX_LEN = 256
D_HG = 512
HG_HEADS = 4
HG_DK = D_HG // HG_HEADS
HG_DV = HG_DK
HG_CHUNK = 64
D_RW = D_MODEL - D_HG
RW_HEAD = 64
RW_HEADS = D_RW // RW_HEAD
RW_DECAY_LORA = 32
RW_AAA_LORA = 32
RW_GATE_LORA = 96
HG_COLS = 5 * D_HG
RW_COLS = 3 * D_RW + 2 * RW_DECAY_LORA + RW_AAA_LORA + RW_GATE_LORA
D_IN = HG_COLS + RW_COLS
N_GROUPS = 8
EXPERTS_PER_GROUP = 8
N_EXPERTS = N_GROUPS * EXPERTS_PER_GROUP
TOP_K_INNER = 2
D_EXPERT = 512
MOE_BLOCK = 128
N_MOD = 6
DN_ALPHA = (2.0 * DEPTH) ** 0.25
DN_BETA = (8.0 * DEPTH) ** -0.25
LN_EPS = 1e-5
HEAD_NORM_EPS = 1e-6
RW_GN_EPS = 64e-5
RW_DECAY_SCALE = math.exp(-0.5)

kernel_name = "hybrid_hgrn2_rwkv7_hmoe_dit_block"


def layer_norm(x):
    xf = x.astype(jnp.float32)
    mu = jnp.mean(xf, -1, keepdims=True)
    var = jnp.mean(jnp.square(xf - mu), -1, keepdims=True)
    return ((xf - mu) * lax.rsqrt(var + LN_EPS)).astype(x.dtype)


def ln_affine(x, g, b):
    return layer_norm(x) * g + b


def dir_stack(fwd, bwd):
    return jnp.stack([fwd, jnp.flip(bwd, axis=1)])


def dir_merge(o):
    return o[0] + jnp.flip(o[1], axis=1)


def grid_shift(p, rows):
    b, l, ch = p.shape
    g = p.reshape(b, rows, GRID_W, ch)
    gp = jnp.pad(g, ((0, 0), (1, 1), (1, 1), (0, 0)))
    nb = 0.25 * (gp[:, :-2, 1:-1] + gp[:, 2:, 1:-1] + gp[:, 1:-1, :-2] + gp[:, 1:-1, 2:])
    return nb.reshape(b, l, ch)


def seq_shift(p):
    pp = jnp.pad(p, ((0, 0), (1, 1), (0, 0)))
    return 0.5 * (pp[:, :-2] + pp[:, 2:])


def hg_heads(t):
    return t.reshape(t.shape[:-1] + (HG_HEADS, HG_DK))


def rw_heads(t):
    return t.reshape(t.shape[:-1] + (RW_HEADS, RW_HEAD))


def hgrn2_prep(p, lb):
    q, i, zf, zb, g = jnp.split(p.astype(jnp.float32), 5, axis=-1)
    z = dir_stack(zf, zb)
    lbb = lb[:, None, None, :]
    logf = jnp.logaddexp(jnp.log(lbb), jnp.log1p(-lbb) + jax.nn.log_sigmoid(z))
    k = (1.0 - lbb) * jax.nn.sigmoid(-z)
    qs = jax.nn.silu(q)
    return hg_heads(dir_stack(qs, qs)), hg_heads(k), hg_heads(dir_stack(i, i)), hg_heads(logf), g


def hgrn2_chunk_scan(q, k, v, logf, s0):
    n, b, l, h, _ = q.shape
    nc = l // HG_CHUNK

    def to_chunks(t):
        return t.reshape(n, b, nc, HG_CHUNK, h, t.shape[-1]).transpose(2, 0, 1, 4, 3, 5)

    xs = tuple(to_chunks(t) for t in (q, k, v, logf))
    causal = jnp.tril(jnp.ones((HG_CHUNK, HG_CHUNK), bool))[:, :, None]

    def step(s, inp):
        qq, kk, vv, ff = inp
        bc = jnp.cumsum(ff, axis=-2)
        o_inter = jnp.einsum('nbhcd,nbhde->nbhce', qq * jnp.exp(bc), s)
        diff = bc[..., :, None, :] - bc[..., None, :, :]
        decay = jnp.where(causal, jnp.exp(jnp.where(causal, diff, 0.0)), 0.0)
        scores = jnp.einsum('nbhtd,nbhsd,nbhtsd->nbhts', qq, kk, decay)
        o = o_inter + jnp.einsum('nbhts,nbhse->nbhte', scores, vv)
        blast = bc[..., -1:, :]
        s_new = jnp.exp(blast[..., 0, :])[..., None] * s + jnp.einsum(
            'nbhsd,nbhse->nbhde', kk * jnp.exp(blast - bc), vv)
        return s_new, o

    s_fin, o = lax.scan(step, s0, xs)
    o = o.transpose(1, 2, 0, 4, 3, 5).reshape(n, b, l, h, HG_DV)
    return o, s_fin


def hgrn2_readout(o, g, norm_w):
    o = dir_merge(o)
    o = o * lax.rsqrt(jnp.mean(o * o, -1, keepdims=True) + HEAD_NORM_EPS)
    o = o.reshape(o.shape[:-2] + (D_HG,)) * norm_w
    return o * jax.nn.silu(g)


def rwkv7_prep(p, p_nb, mu, w0, w_decay2, a0, w_a2, w_g2, k_k, k_a):
    p = p.astype(jnp.float32)
    p = p + (p_nb.astype(jnp.float32) - p) * mu
    cuts = [D_RW, 2 * D_RW, 3 * D_RW, 3 * D_RW + RW_DECAY_LORA, 3 * D_RW + 2 * RW_DECAY_LORA,
            3 * D_RW + 2 * RW_DECAY_LORA + RW_AAA_LORA]
    r, k, v, lwf, lwb, la, lg = jnp.split(p, cuts, axis=-1)
    w_logit = dir_stack(w0[0] + jnp.tanh(lwf) @ w_decay2[0], w0[1] + jnp.tanh(lwb) @ w_decay2[1])
    decay = jnp.exp(-RW_DECAY_SCALE * jax.nn.sigmoid(w_logit))
    a = jax.nn.sigmoid(a0 + la @ w_a2)
    g = jax.nn.sigmoid(lg) @ w_g2
    kk = rw_heads(k * k_k)
    kk = kk * lax.rsqrt(jnp.maximum(jnp.sum(kk * kk, -1, keepdims=True), 1e-12))
    k = rw_heads(k * (1.0 + (a - 1.0) * k_a))
    r, v, a = rw_heads(r), rw_heads(v), rw_heads(a)
    scan_in = (dir_stack(r, r), rw_heads(decay), dir_stack(k, k), dir_stack(v, v),
               dir_stack(kk, kk), dir_stack(a, a))
    return scan_in, (r, k, v, g)


def rwkv7_scan(r, w, k, v, kk, a, s0):
    def step(s, inp):
        rt, wt, kt, vt, kkt, at = inp
        sa = jnp.einsum('nbhij,nbhj->nbhi', s, kkt)
        s = (s * wt[..., None, :] - sa[..., :, None] * (kkt * at)[..., None, :]
             + vt[..., :, None] * kt[..., None, :])
        return s, jnp.einsum('nbhij,nbhj->nbhi', s, rt)

    xs = tuple(jnp.moveaxis(t, 2, 0) for t in (r, w, k, v, kk, a))
    s_fin, y = lax.scan(step, s0, xs)
    return jnp.moveaxis(y, 0, 2), s_fin


def rwkv7_readout(y, r, k, v, g, r_k, gn_w, gn_b):
    y = dir_merge(y)
    mu = jnp.mean(y, -1, keepdims=True)
    var = jnp.mean(jnp.square(y - mu), -1, keepdims=True)
    yn = ((y - mu) * lax.rsqrt(var + RW_GN_EPS)).reshape(y.shape[:-2] + (D_RW,)) * gn_w + gn_b
    bonus = jnp.sum(r * k * r_k, -1, keepdims=True) * v
    return (yn + bonus.reshape(bonus.shape[:-2] + (D_RW,))) * g


def token_mixer(h, hc, rows, lb, w_in, w_out, hg_norm_w, rw_mu, rw_w0, rw_w_decay2, rw_a0, rw_w_a2,
                rw_w_g2, rw_k_k, rw_k_a, rw_r_k, rw_gn_w, rw_gn_b, need_ctx):
    b = h.shape[0]
    p = h @ w_in
    pc = hc @ w_in
    q_c, k_c, v_c, f_c, g_c = hgrn2_prep(pc[..., :HG_COLS], lb)
    q_l, k_l, v_l, f_l, g_l = hgrn2_prep(p[..., :HG_COLS], lb)
    s0 = jnp.zeros((2, b, HG_HEADS, HG_DK, HG_DV), jnp.float32)
    o_c, s_c = hgrn2_chunk_scan(q_c, k_c, v_c, f_c, s0)
    o_l, _ = hgrn2_chunk_scan(q_l, k_l, v_l, f_l, s_c)
    rw_prm = (rw_mu, rw_w0, rw_w_decay2, rw_a0, rw_w_a2, rw_w_g2, rw_k_k, rw_k_a)
    rc = pc[..., HG_COLS:]
    rl = p[..., HG_COLS:]
    sin_c, aux_c = rwkv7_prep(rc, seq_shift(rc), *rw_prm)
    sin_l, aux_l = rwkv7_prep(rl, grid_shift(rl, rows), *rw_prm)
    st0 = jnp.zeros((2, b, RW_HEADS, RW_HEAD, RW_HEAD), jnp.float32)
    y_c, st_c = rwkv7_scan(*sin_c, st0)
    y_l, _ = rwkv7_scan(*sin_l, st_c)
    out_l = jnp.concatenate([hgrn2_readout(o_l, g_l, hg_norm_w),
                             rwkv7_readout(y_l, *aux_l, rw_r_k, rw_gn_w, rw_gn_b)], -1) @ w_out
    out_c = None
    if need_ctx:
        out_c = (jnp.concatenate([hgrn2_readout(o_c, g_c, hg_norm_w),
                                  rwkv7_readout(y_c, *aux_c, rw_r_k, rw_gn_w, rw_gn_b)], -1) @ w_out
                 ).astype(hc.dtype)
    return out_l.astype(h.dtype), out_c


def hier_moe(h, w_group, b_group, w_router, b_router, w_gate, w_up, w_down):
    b, l, d = h.shape
    t = h.reshape(-1, d)
    n_tok = t.shape[0]
    gl = (t @ w_group + b_group).astype(jnp.float32)
    g_idx = jnp.argmax(gl, -1)
    g_prob = jnp.take_along_axis(jax.nn.softmax(gl, -1), g_idx[:, None], -1)
    el = (t @ w_router).reshape(n_tok, N_GROUPS, EXPERTS_PER_GROUP) + b_router
    el = jnp.take_along_axis(el, g_idx[:, None, None], 1)[:, 0].astype(jnp.float32)
    top_v, top_i = lax.top_k(el, TOP_K_INNER)
    wts = jax.nn.softmax(top_v, -1) * g_prob
    e_idx = g_idx[:, None].astype(jnp.int32) * EXPERTS_PER_GROUP + top_i.astype(jnp.int32)
    n_as = n_tok * TOP_K_INNER
    flat_e = e_idx.reshape(-1)
    flat_tok = jnp.repeat(jnp.arange(n_tok, dtype=jnp.int32), TOP_K_INNER)
    flat_w = wts.reshape(-1)
    order = jnp.argsort(flat_e)
    se = flat_e[order]
    counts = jnp.bincount(flat_e, length=N_EXPERTS)
    starts = jnp.cumsum(counts) - counts
    padded = (counts + MOE_BLOCK - 1) // MOE_BLOCK * MOE_BLOCK
    pad_ends = jnp.cumsum(padded)
    pad_starts = pad_ends - padded
    dest = pad_starts[se] + (jnp.arange(n_as) - starts[se])
    n_blocks = -(-n_as // MOE_BLOCK) + N_EXPERTS
    cap = n_blocks * MOE_BLOCK
    row_tok = jnp.full((cap,), n_tok, jnp.int32).at[dest].set(flat_tok[order])
    row_w = jnp.zeros((cap,), jnp.float32).at[dest].set(flat_w[order])
    block_exp = jnp.minimum(
        jnp.searchsorted(pad_ends, jnp.arange(n_blocks) * MOE_BLOCK, side='right'), N_EXPERTS - 1)
    t_pad = jnp.concatenate([t, jnp.zeros((1, d), t.dtype)], 0)
    xb = t_pad[row_tok].reshape(n_blocks, MOE_BLOCK, d)

    def expert_block(args):
        xblk, e = args
        hid = jax.nn.silu(xblk @ w_gate[e]) * (xblk @ w_up[e])
        return hid @ w_down[e]

    yb = lax.map(expert_block, (xb, block_exp))
    y = jax.ops.segment_sum(yb.reshape(cap, d).astype(jnp.float32) * row_w[:, None], row_tok,
                            num_segments=n_tok + 1)[:n_tok]
    return y.reshape(b, l, d).astype(h.dtype)


def setup_inputs(seed: int = 0) -> dict:
    key = jax.random.key(seed)
    ks = iter(jax.random.split(key, 40))
    D = D_MODEL

    def nrm(shape, scale):
        return jax.random.normal(next(ks), shape, jnp.float32) * scale

    def uni(shape):
        return jax.random.uniform(next(ks), shape, jnp.float32)

    return {
        "x": nrm((BATCH, SEQ, D), 1.0),
        "c": nrm((BATCH, D), 1.0),
        "ctx": nrm((BATCH, CTX_LEN, D), 1.0),
        "c_ctx": nrm((D,), 1.0),
        "w_mod": nrm((DEPTH, D, N_MOD * D), D ** -0.5),
        "b_mod": nrm((DEPTH, N_MOD * D), 0.02),
        "w_in": nrm((DEPTH, D, D_IN), D ** -0.5),
        "w_out": nrm((DEPTH, D, D), D ** -0.5 * DN_BETA),
        "hg_lb_logits": nrm((2, DEPTH + 1, D_HG), 0.5),
        "hg_norm_w": 1.0 + nrm((DEPTH, D_HG), 0.05),
        "rw_mu": uni((DEPTH, RW_COLS)),
        "rw_w0": nrm((DEPTH, 2, D_RW), 0.5) - 0.5,
        "rw_w_decay2": nrm((DEPTH, 2, RW_DECAY_LORA, D_RW), 0.1),
        "rw_a0": nrm((DEPTH, D_RW), 0.1),
        "rw_w_a2": nrm((DEPTH, RW_AAA_LORA, D_RW), 0.1),
        "rw_w_g2": nrm((DEPTH, RW_GATE_LORA, D_RW), RW_GATE_LORA ** -0.5),
        "rw_k_k": 0.85 + nrm((DEPTH, D_RW), 0.05),
        "rw_k_a": 1.0 + nrm((DEPTH, D_RW), 0.05),
        "rw_r_k": nrm((DEPTH, RW_HEADS, RW_HEAD), 0.1),
        "rw_gn_w": 1.0 + nrm((DEPTH, D_RW), 0.05),
        "rw_gn_b": nrm((DEPTH, D_RW), 0.02),
        "ln1_g": 1.0 + nrm((DEPTH, D), 0.05),
        "ln1_b": nrm((DEPTH, D), 0.02),
        "ln2_g": 1.0 + nrm((DEPTH, D), 0.05),
        "ln2_b": nrm((DEPTH, D), 0.02),
        "moe_w_group": nrm((DEPTH, D, N_GROUPS), D ** -0.5),
        "moe_b_group": nrm((DEPTH, N_GROUPS), 0.01),
        "moe_w_router": nrm((DEPTH, D, N_EXPERTS), D ** -0.5),
        "moe_b_router": nrm((DEPTH, N_GROUPS, EXPERTS_PER_GROUP), 0.01),
        "moe_w_gate": nrm((DEPTH, N_EXPERTS, D, D_EXPERT), D ** -0.5),
        "moe_w_up": nrm((DEPTH, N_EXPERTS, D, D_EXPERT), D ** -0.5),
        "moe_w_down": nrm((DEPTH, N_EXPERTS, D_EXPERT, D), D_EXPERT ** -0.5 * DN_BETA),
    }


def reference(x, c, ctx, c_ctx, w_mod, b_mod, w_in, w_out, hg_lb_logits, hg_norm_w, rw_mu, rw_w0,
              rw_w_decay2, rw_a0, rw_w_a2, rw_w_g2, rw_k_k, rw_k_a, rw_r_k, rw_gn_w, rw_gn_b,
              ln1_g, ln1_b, ln2_g, ln2_b, moe_w_group, moe_b_group, moe_w_router, moe_b_router,
              moe_w_gate, moe_w_up, moe_w_down):
    rows = x.shape[1] // GRID_W
    lb_all = jnp.cumsum(jax.nn.softmax(hg_lb_logits.astype(jnp.float32), axis=1), axis=1)
    for l in range(DEPTH):
        need_ctx = l < DEPTH - 1
        mod = jax.nn.silu(c) @ w_mod[l] + b_mod[l]
        sh1, sc1, g1, sh2, sc2, g2 = jnp.split(mod[:, None, :], N_MOD, axis=-1)
        modc = jax.nn.silu(c_ctx) @ w_mod[l] + b_mod[l]
        csh1, csc1, cg1, csh2, csc2, cg2 = jnp.split(modc, N_MOD, axis=-1)
        h = layer_norm(x) * (1.0 + sc1) + sh1
        hc = layer_norm(ctx) * (1.0 + csc1) + csh1
        y, yc = token_mixer(h, hc, rows, lb_all[:, l], w_in[l], w_out[l], hg_norm_w[l], rw_mu[l],
                            rw_w0[l], rw_w_decay2[l], rw_a0[l], rw_w_a2[l], rw_w_g2[l], rw_k_k[l],
                            rw_k_a[l], rw_r_k[l], rw_gn_w[l], rw_gn_b[l], need_ctx)
        x = ln_affine(DN_ALPHA * x + g1 * y, ln1_g[l], ln1_b[l])
        h2 = layer_norm(x) * (1.0 + sc2) + sh2
        x = ln_affine(DN_ALPHA * x + g2 * hier_moe(h2, moe_w_group[l], moe_b_group[l], moe_w_router[l],
                                                     moe_b_router[l], moe_w_gate[l], moe_w_up[l],
                                                     moe_w_down[l]), ln2_g[l], ln2_b[l])
        if need_ctx:
            ctx = ln_affine(DN_ALPHA * ctx + cg1 * yc, ln1_g[l], ln1_b[l])
            hc2 = layer_norm(ctx) * (1.0 + csc2) + csh2
            ctx = ln_affine(DN_ALPHA * ctx + cg2 * hier_moe(hc2, moe_w_group[l], moe_b_group[l],
                                                             moe_w_router[l], moe_b_router[l],
                                                             moe_w_gate[l], moe_w_up[l], moe_w_down[l]),
                            ln2_g[l], ln2_b[l])
    return x
```

```cpp
#include <hip/hip_runtime.h>
#include <hip/hip_cooperative_groups.h>
#include <cstdio>

typedef __attribute__((ext_vector_type(8))) short bf16x8;
typedef __attribute__((ext_vector_type(4))) short s16x4;
typedef __attribute__((ext_vector_type(4))) float f32x4;
typedef __attribute__((ext_vector_type(2))) float f32x2;
typedef __attribute__((ext_vector_type(2))) __bf16 bf16x2_t;
typedef unsigned short bfr;

#define DI __device__ __forceinline__

constexpr int T_LAT = 16384, T_CTX = 256, T_ALL = T_LAT + T_CTX;
constexpr int DM = 1024, DIN = 4288, HGC = 2560, RWC = 1728, DRW = 512, DHG = 512;
constexpr int NEXP = 64, DEXP = 512;
constexpr int NTHR = 256;
constexpr float DN_ALPHA = 1.189207115002721f;
constexpr float RW_DECAY_SCALE = 0.6065306597126334f;

constexpr size_t MB = 1ull << 20;
constexpr size_t WS_MOD = 0;
constexpr size_t WS_MODC = 32768;
constexpr size_t WS_LB = 65536;
constexpr size_t WS_CNT = 65536 + 8192;
constexpr size_t WS_ASGW = 131072;
constexpr size_t WS_LIST = 1 * MB;
constexpr size_t WS_H = 6 * MB;
constexpr size_t WS_P = 42 * MB;
constexpr size_t WS_Y = 42 * MB;
constexpr size_t WS_H2 = 106 * MB;
constexpr size_t WS_HID = 138 * MB;
constexpr size_t WS_RW = 186 * MB;
constexpr size_t RW_ARR = (size_t)T_ALL * 512 * 2;
constexpr size_t WS_LW = 284 * MB;
constexpr size_t LW_ARR = (size_t)T_ALL * 512 * 4;
constexpr size_t WS_YRW = 350 * MB;
constexpr size_t WS_OHG = 414 * MB;
constexpr size_t WS_MOUT = 186 * MB;

struct Params {
  const float* in[32];
  float* out;
  char* ws;
};

DI unsigned pack2(float a, float b) {
  f32x2 v = {a, b};
  bf16x2_t r = __builtin_convertvector(v, bf16x2_t);
  return __builtin_bit_cast(unsigned, r);
}
DI bfr f2bf(float a) { return (bfr)(pack2(a, 0.f) & 0xffffu); }
DI float bf2f(bfr v) { return __uint_as_float(((unsigned)v) << 16); }
DI float sigmoidf_(float x) { return 1.f / (1.f + __expf(-x)); }
DI float siluf_(float x) { return x / (1.f + __expf(-x)); }
DI float wave_sum(float v) {
#pragma unroll
  for (int o = 32; o > 0; o >>= 1) v += __shfl_xor(v, o);
  return v;
}

constexpr int LSTR = 72;
constexpr int GEMM_LDS_BYTES = 2 * 128 * LSTR * 2;

struct ALoadBf16 {
  const bfr* rp[4];
  bf16x8 r[4];
  DI void load(int kt) {
#pragma unroll
    for (int i = 0; i < 4; ++i) r[i] = *(const bf16x8*)(rp[i] + kt * 64);
  }
  DI void store(short* sA) const {
    const int tid = threadIdx.x;
#pragma unroll
    for (int i = 0; i < 4; ++i) *(bf16x8*)(sA + ((tid >> 3) + 32 * i) * LSTR + (tid & 7) * 8) = r[i];
  }
};

struct BLoadF32 {
  const float* p;
  long ldb;
  bool valid;
  f32x4 v[8];
  DI void load(int kt) {
#pragma unroll
    for (int j = 0; j < 8; ++j) {
      if (valid) v[j] = *(const f32x4*)(p + ((long)kt * 64 + j) * ldb);
      else v[j] = f32x4{0.f, 0.f, 0.f, 0.f};
    }
  }
  DI void store(short* sB) const {
    const int tid = threadIdx.x, kg = tid & 7, n4 = tid >> 3;
#pragma unroll
    for (int i = 0; i < 4; ++i) {
      unsigned a0 = pack2(v[0][i], v[1][i]), a1 = pack2(v[2][i], v[3][i]);
      unsigned a2 = pack2(v[4][i], v[5][i]), a3 = pack2(v[6][i], v[7][i]);
      typedef __attribute__((ext_vector_type(4))) unsigned u32x4;
      u32x4 w = {a0, a1, a2, a3};
      *(u32x4*)(sB + (4 * n4 + i) * LSTR + kg * 8) = w;
    }
  }
};

template <class AL, class BL>
DI void gemm_mainloop(short* sA, short* sB, int nk, AL& al, BL& bl, f32x4 (&acc)[4][4]) {
  const int tid = threadIdx.x, wid = tid >> 6, lane = tid & 63;
  const int wr = wid >> 1, wc = wid & 1, fr = lane & 15, fq = lane >> 4;
#pragma unroll
  for (int m = 0; m < 4; ++m)
#pragma unroll
    for (int n = 0; n < 4; ++n) acc[m][n] = f32x4{0.f, 0.f, 0.f, 0.f};
  al.load(0); bl.load(0);
  for (int kt = 0; kt < nk; ++kt) {
    __syncthreads();
    al.store(sA); bl.store(sB);
    __syncthreads();
    if (kt + 1 < nk) { al.load(kt + 1); bl.load(kt + 1); }
#pragma unroll
    for (int ks = 0; ks < 2; ++ks) {
      bf16x8 af[4], bf[4];
#pragma unroll
      for (int m = 0; m < 4; ++m) af[m] = *(const bf16x8*)(sA + (wr * 64 + m * 16 + fr) * LSTR + ks * 32 + fq * 8);
#pragma unroll
      for (int n = 0; n < 4; ++n) bf[n] = *(const bf16x8*)(sB + (wc * 64 + n * 16 + fr) * LSTR + ks * 32 + fq * 8);
#pragma unroll
      for (int m = 0; m < 4; ++m)
#pragma unroll
        for (int n = 0; n < 4; ++n) acc[m][n] = __builtin_amdgcn_mfma_f32_16x16x32_bf16(af[m], bf[n], acc[m][n], 0, 0, 0);
    }
  }
}

DI void phase_mod(const Params& P, int bid, int nb, char* smem) {
  const float* c = P.in[1]; const float* cc = P.in[3];
  const float* w_mod = P.in[4]; const float* b_mod = P.in[5];
  float* mod = (float*)(P.ws + WS_MOD); float* modc = (float*)(P.ws + WS_MODC);
  float* red = (float*)smem;
  const int tid = threadIdx.x;
  for (int it = bid; it < 194; it += nb) {
    if (it < 192) {
      const int kq = tid >> 3, c4 = tid & 7;
      const int col = it * 32 + c4 * 4;
      f32x4 a1 = {0, 0, 0, 0}, a2 = {0, 0, 0, 0};
      for (int k = kq; k < DM; k += 32) {
        f32x4 w = *(const f32x4*)(w_mod + (long)k * 6144 + col);
        float s1 = siluf_(c[k]), s2 = siluf_(cc[k]);
        a1 += w * s1; a2 += w * s2;
      }
      __syncthreads();
#pragma unroll
      for (int e = 0; e < 4; ++e) { red[(kq * 32) + c4 * 4 + e] = a1[e]; red[1024 + kq * 32 + c4 * 4 + e] = a2[e]; }
      __syncthreads();
      if (tid < 64) {
        const int which = tid >> 5, cl = tid & 31;
        float s = 0.f;
        for (int q = 0; q < 32; ++q) s += red[which * 1024 + q * 32 + cl];
        const int cg = it * 32 + cl;
        s += b_mod[cg];
        if (which == 0) mod[cg] = s; else modc[cg] = s;
      }
    } else if (it == 192) {
      const float* L = P.in[8];
      float* lb = (float*)(P.ws + WS_LB);
      for (int i = tid; i < 1024; i += NTHR) {
        const int d = i >> 9, j = i & 511;
        float l0 = L[d * 1024 + j], l1 = L[d * 1024 + 512 + j];
        lb[i] = 1.f / (1.f + __expf(l1 - l0));
      }
    } else {
      int* cnt = (int*)(P.ws + WS_CNT);
      if (tid < 64) cnt[tid] = 0;
    }
  }
}

DI void phase_ln1(const Params& P, int bid, int nb) {
  const float* x = P.in[0]; const float* ctx = P.in[2];
  const float* mod = (const float*)(P.ws + WS_MOD); const float* modc = (const float*)(P.ws + WS_MODC);
  bfr* h = (bfr*)(P.ws + WS_H);
  const int wid = threadIdx.x >> 6, lane = threadIdx.x & 63;
  for (int row = bid * 4 + wid; row < T_ALL; row += nb * 4) {
    const float* src = row < T_LAT ? x + (long)row * DM : ctx + (long)(row - T_LAT) * DM;
    const float* mm = row < T_LAT ? mod : modc;
    f32x4 v[4];
    float s = 0.f;
#pragma unroll
    for (int i = 0; i < 4; ++i) { v[i] = *(const f32x4*)(src + lane * 4 + 256 * i); s += v[i][0] + v[i][1] + v[i][2] + v[i][3]; }
    const float mu = wave_sum(s) * (1.f / DM);
    float q = 0.f;
#pragma unroll
    for (int i = 0; i < 4; ++i) { v[i] -= mu; q += v[i][0] * v[i][0] + v[i][1] * v[i][1] + v[i][2] * v[i][2] + v[i][3] * v[i][3]; }
    const float rs = rsqrtf(wave_sum(q) * (1.f / DM) + 1e-5f);
#pragma unroll
    for (int i = 0; i < 4; ++i) {
      const int cidx = lane * 4 + 256 * i;
      f32x4 sh = *(const f32x4*)(mm + cidx), sc = *(const f32x4*)(mm + 1024 + cidx);
      f32x4 o = v[i] * rs * (sc + 1.f) + sh;
      uint2 w = {pack2(o[0], o[1]), pack2(o[2], o[3])};
      *(uint2*)(h + (long)row * DM + cidx) = w;
    }
  }
}

DI void phase_pgemm(const Params& P, int bid, int nb, char* smem) {
  const bfr* h = (const bfr*)(P.ws + WS_H);
  const float* w_in = P.in[6];
  bfr* p = (bfr*)(P.ws + WS_P);
  short* sA = (short*)smem; short* sB = sA + 128 * LSTR;
  const int tid = threadIdx.x, wid = tid >> 6, lane = tid & 63;
  const int wr = wid >> 1, wc = wid & 1, fr = lane & 15, fq = lane >> 4;
  constexpr int NT = 34, MT = T_ALL / 128;
  for (int it = bid; it < NT * MT; it += nb) {
    const int mt = it / NT, nt = it % NT;
    ALoadBf16 al; BLoadF32 bl;
#pragma unroll
    for (int i = 0; i < 4; ++i) al.rp[i] = h + (long)(mt * 128 + (tid >> 3) + 32 * i) * DM + (tid & 7) * 8;
    const int col = nt * 128 + (tid >> 3) * 4;
    bl.valid = col < DIN; bl.ldb = DIN;
    bl.p = w_in + (long)((tid & 7) * 8) * DIN + (bl.valid ? col : 0);
    f32x4 acc[4][4];
    gemm_mainloop(sA, sB, DM / 64, al, bl, acc);
#pragma unroll
    for (int m = 0; m < 4; ++m)
#pragma unroll
      for (int n = 0; n < 4; ++n) {
        const int cc = nt * 128 + wc * 64 + n * 16 + fr;
        if (cc < DIN) {
#pragma unroll
          for (int j = 0; j < 4; ++j) {
            const int rr = mt * 128 + wr * 64 + m * 16 + fq * 4 + j;
            p[(long)rr * DIN + cc] = f2bf(acc[m][n][j]);
          }
        }
      }
  }
}

DI float rw_mixed(const bfr* p, int row, int c, const float* mu) {
  const long base = (long)row * DIN + HGC + c;
  const float pc = bf2f(p[base]);
  float nbv;
  if (row < T_LAT) {
    const int gr = row >> 6, gc = row & 63;
    float s = 0.f;
    if (gr > 0) s += bf2f(p[base - 64l * DIN]);
    if (gr < 255) s += bf2f(p[base + 64l * DIN]);
    if (gc > 0) s += bf2f(p[base - DIN]);
    if (gc < 63) s += bf2f(p[base + DIN]);
    nbv = 0.25f * s;
  } else {
    const int sidx = row - T_LAT;
    float s = 0.f;
    if (sidx > 0) s += bf2f(p[base - DIN]);
    if (sidx < T_CTX - 1) s += bf2f(p[base + DIN]);
    nbv = 0.5f * s;
  }
  return pc + (nbv - pc) * mu[c];
}

constexpr int RWP_TOK = 16;
DI void phase_rwprep(const Params& P, int bid, int nb, char* smem) {
  const bfr* p = (const bfr*)(P.ws + WS_P);
  const float* mu = P.in[10]; const float* w0 = P.in[11]; const float* wd2 = P.in[12];
  const float* a0 = P.in[13]; const float* wa2 = P.in[14]; const float* wg2 = P.in[15];
  const float* k_k = P.in[16]; const float* k_a = P.in[17];
  bfr* R = (bfr*)(P.ws + WS_RW); bfr* K = (bfr*)(P.ws + WS_RW + RW_ARR); bfr* V = (bfr*)(P.ws + WS_RW + 2 * RW_ARR);
  bfr* KK = (bfr*)(P.ws + WS_RW + 3 * RW_ARR); bfr* A = (bfr*)(P.ws + WS_RW + 4 * RW_ARR); bfr* G = (bfr*)(P.ws + WS_RW + 5 * RW_ARR);
  float* LWF = (float*)(P.ws + WS_LW); float* LWB = (float*)(P.ws + WS_LW + LW_ARR);
  float* lo = (float*)smem;
  const int tid = threadIdx.x;
  for (int it = bid; it < T_ALL / RWP_TOK; it += nb) {
    const int row0 = it * RWP_TOK;
    __syncthreads();
    for (int i = tid; i < RWP_TOK * 192; i += NTHR) {
      const int tk = i / 192, j = i % 192;
      float v = rw_mixed(p, row0 + tk, 1536 + j, mu);
      if (j < 64) v = tanhf(v);
      else if (j >= 96) v = sigmoidf_(v);
      lo[i] = v;
    }
    __syncthreads();
    float av[RWP_TOK][2];
#pragma unroll
    for (int d = 0; d < 2; ++d) {
      float acc[RWP_TOK][2];
#pragma unroll
      for (int t = 0; t < RWP_TOK; ++t) { acc[t][0] = 0.f; acc[t][1] = 0.f; }
      for (int j = 0; j < 32; ++j) {
        const float wA = wd2[(d * 32 + j) * 512 + tid], wB = wd2[(d * 32 + j) * 512 + tid + 256];
#pragma unroll
        for (int t = 0; t < RWP_TOK; ++t) { const float xv = lo[t * 192 + d * 32 + j]; acc[t][0] += xv * wA; acc[t][1] += xv * wB; }
      }
      float* LW = d == 0 ? LWF : LWB;
#pragma unroll
      for (int t = 0; t < RWP_TOK; ++t)
#pragma unroll
        for (int hh = 0; hh < 2; ++hh) {
          const int ch = tid + 256 * hh;
          const float wl = w0[d * 512 + ch] + acc[t][hh];
          LW[(long)(row0 + t) * 512 + ch] = -RW_DECAY_SCALE * sigmoidf_(wl);
        }
    }
    {
#pragma unroll
      for (int t = 0; t < RWP_TOK; ++t) { av[t][0] = 0.f; av[t][1] = 0.f; }
      for (int j = 0; j < 32; ++j) {
        const float wA = wa2[j * 512 + tid], wB = wa2[j * 512 + tid + 256];
#pragma unroll
        for (int t = 0; t < RWP_TOK; ++t) { const float xv = lo[t * 192 + 64 + j]; av[t][0] += xv * wA; av[t][1] += xv * wB; }
      }
#pragma unroll
      for (int t = 0; t < RWP_TOK; ++t)
#pragma unroll
        for (int hh = 0; hh < 2; ++hh) av[t][hh] = sigmoidf_(a0[tid + 256 * hh] + av[t][hh]);
    }
    {
      float acc[RWP_TOK][2];
#pragma unroll
      for (int t = 0; t < RWP_TOK; ++t) { acc[t][0] = 0.f; acc[t][1] = 0.f; }
      for (int j = 0; j < 96; ++j) {
        const float wA = wg2[j * 512 + tid], wB = wg2[j * 512 + tid + 256];
#pragma unroll
        for (int t = 0; t < RWP_TOK; ++t) { const float xv = lo[t * 192 + 96 + j]; acc[t][0] += xv * wA; acc[t][1] += xv * wB; }
      }
#pragma unroll
      for (int t = 0; t < RWP_TOK; ++t)
#pragma unroll
        for (int hh = 0; hh < 2; ++hh) G[(long)(row0 + t) * 512 + tid + 256 * hh] = f2bf(acc[t][hh]);
    }
#pragma unroll
    for (int t = 0; t < RWP_TOK; ++t)
#pragma unroll
      for (int hh = 0; hh < 2; ++hh) {
        const int ch = tid + 256 * hh;
        const int row = row0 + t;
        const float r = rw_mixed(p, row, ch, mu);
        const float kraw = rw_mixed(p, row, 512 + ch, mu);
        const float v = rw_mixed(p, row, 1024 + ch, mu);
        const float kkr = kraw * k_k[ch];
        const float ss = wave_sum(kkr * kkr);
        const float kk = kkr * rsqrtf(fmaxf(ss, 1e-12f));
        const float a = av[t][hh];
        const float k = kraw * (1.f + (a - 1.f) * k_a[ch]);
        const long o = (long)row * 512 + ch;
        R[o] = f2bf(r); K[o] = f2bf(k); V[o] = f2bf(v); KK[o] = f2bf(kk); A[o] = f2bf(a);
      }
  }
}

DI void rwkv_chain_naive(const Params& P, int chain, char* smem) {
  const int dir = chain >> 3, hd = chain & 7;
  const bfr* R = (const bfr*)(P.ws + WS_RW); const bfr* K = (const bfr*)(P.ws + WS_RW + RW_ARR); const bfr* V = (const bfr*)(P.ws + WS_RW + 2 * RW_ARR);
  const bfr* KK = (const bfr*)(P.ws + WS_RW + 3 * RW_ARR); const bfr* A = (const bfr*)(P.ws + WS_RW + 4 * RW_ARR);
  const float* LW = (const float*)(P.ws + WS_LW + (dir ? LW_ARR : 0));
  float* Y = (float*)(P.ws + WS_YRW) + (long)dir * T_LAT * 512;
  float* vec = (float*)smem;
  float* red = vec + 16 * 6 * 64;
  const int tid = threadIdx.x, i = tid & 63, jq = tid >> 6;
  float S[16];
#pragma unroll
  for (int j = 0; j < 16; ++j) S[j] = 0.f;
  for (int s0 = 0; s0 < T_ALL; s0 += 16) {
    __syncthreads();
    for (int e = tid; e < 16 * 64; e += NTHR) {
      const int st = e >> 6, j = e & 63;
      const int s = s0 + st;
      int row;
      if (s < T_CTX) row = T_LAT + (dir ? (T_CTX - 1 - s) : s);
      else row = dir ? (T_LAT - 1 - (s - T_CTX)) : (s - T_CTX);
      const long o = (long)row * 512 + hd * 64 + j;
      float* vp = vec + st * 384;
      const float kk = bf2f(KK[o]);
      vp[j] = bf2f(R[o]); vp[64 + j] = __expf(LW[o]); vp[128 + j] = bf2f(K[o]); vp[192 + j] = bf2f(V[o]);
      vp[256 + j] = kk; vp[320 + j] = kk * bf2f(A[o]);
    }
    __syncthreads();
    for (int st = 0; st < 16; ++st) {
      const float* vp = vec + st * 384;
      const int par = st & 1;
      float sa = 0.f;
#pragma unroll
      for (int j = 0; j < 16; ++j) sa += S[j] * vp[256 + jq * 16 + j];
      red[(par * 2 + 0) * 256 + jq * 64 + i] = sa;
      __syncthreads();
      sa = red[(par * 2) * 256 + i] + red[(par * 2) * 256 + 64 + i] + red[(par * 2) * 256 + 128 + i] + red[(par * 2) * 256 + 192 + i];
      const float vi = vp[192 + i];
      float y = 0.f;
#pragma unroll
      for (int j = 0; j < 16; ++j) {
        const int jj = jq * 16 + j;
        S[j] = S[j] * vp[64 + jj] - sa * vp[320 + jj] + vi * vp[128 + jj];
        y += S[j] * vp[jj];
      }
      red[(par * 2 + 1) * 256 + jq * 64 + i] = y;
      __syncthreads();
      const int s = s0 + st;
      if (jq == 0 && s >= T_CTX) {
        y = red[(par * 2 + 1) * 256 + i] + red[(par * 2 + 1) * 256 + 64 + i] + red[(par * 2 + 1) * 256 + 128 + i] + red[(par * 2 + 1) * 256 + 192 + i];
        const int row = dir ? (T_LAT - 1 - (s - T_CTX)) : (s - T_CTX);
        Y[(long)row * 512 + hd * 64 + i] = y;
      }
    }
  }
}

DI void hgrn_chain_naive(const Params& P, int chain, char* smem) {
  const int dir = chain >> 2, hd = chain & 3;
  const bfr* p = (const bfr*)(P.ws + WS_P);
  const float* lb = (const float*)(P.ws + WS_LB) + dir * 512 + hd * 128;
  float* O = (float*)(P.ws + WS_OHG) + (long)dir * T_LAT * 512;
  float* vec = (float*)smem;
  float* red = vec + 16 * 4 * 128;
  const int tid = threadIdx.x, e = tid & 127, dh = tid >> 7;
  float S[64];
#pragma unroll
  for (int d = 0; d < 64; ++d) S[d] = 0.f;
  for (int s0 = 0; s0 < T_ALL; s0 += 16) {
    __syncthreads();
    for (int x = tid; x < 16 * 128; x += NTHR) {
      const int st = x >> 7, d = x & 127;
      const int s = s0 + st;
      int row;
      if (s < T_CTX) row = T_LAT + (dir ? (T_CTX - 1 - s) : s);
      else row = dir ? (T_LAT - 1 - (s - T_CTX)) : (s - T_CTX);
      const bfr* pr = p + (long)row * DIN + hd * 128 + d;
      const float q = bf2f(pr[0]), iv = bf2f(pr[512]), z = bf2f(pr[1024 + dir * 512]);
      const float l = lb[d];
      const float f = l + (1.f - l) * sigmoidf_(z);
      float* vp = vec + st * 512;
      vp[d] = siluf_(q); vp[128 + d] = f; vp[256 + d] = (1.f - l) * sigmoidf_(-z); vp[384 + d] = iv;
    }
    __syncthreads();
    for (int st = 0; st < 16; ++st) {
      const float* vp = vec + st * 512;
      const int par = st & 1;
      const float ve = vp[384 + e];
      float o = 0.f;
#pragma unroll
      for (int d = 0; d < 64; ++d) {
        const int dd = dh * 64 + d;
        S[d] = S[d] * vp[128 + dd] + vp[256 + dd] * ve;
        o += vp[dd] * S[d];
      }
      red[par * 256 + dh * 128 + e] = o;
      __syncthreads();
      const int s = s0 + st;
      if (dh == 0 && s >= T_CTX) {
        o = red[par * 256 + e] + red[par * 256 + 128 + e];
        const int row = dir ? (T_LAT - 1 - (s - T_CTX)) : (s - T_CTX);
        O[(long)row * 512 + hd * 128 + e] = o;
      }
    }
  }
}

DI void phase_readout(const Params& P, int bid, int nb) {
  const bfr* p = (const bfr*)(P.ws + WS_P);
  const float* Of = (const float*)(P.ws + WS_OHG); const float* Ob = Of + (long)T_LAT * 512;
  const float* Yf = (const float*)(P.ws + WS_YRW); const float* Yb = Yf + (long)T_LAT * 512;
  const bfr* R = (const bfr*)(P.ws + WS_RW); const bfr* K = (const bfr*)(P.ws + WS_RW + RW_ARR); const bfr* V = (const bfr*)(P.ws + WS_RW + 2 * RW_ARR);
  const bfr* G = (const bfr*)(P.ws + WS_RW + 5 * RW_ARR);
  const float* hg_norm_w = P.in[9]; const float* r_k = P.in[18]; const float* gn_w = P.in[19]; const float* gn_b = P.in[20];
  bfr* mix = (bfr*)(P.ws + WS_H);
  const int wid = threadIdx.x >> 6, lane = threadIdx.x & 63;
  for (int t = bid * 4 + wid; t < T_LAT; t += nb * 4) {
    {
      float o[8]; float ss = 0.f;
#pragma unroll
      for (int e = 0; e < 8; ++e) { const long idx = (long)t * 512 + lane * 8 + e; o[e] = Of[idx] + Ob[idx]; ss += o[e] * o[e]; }
      ss += __shfl_xor(ss, 1); ss += __shfl_xor(ss, 2); ss += __shfl_xor(ss, 4); ss += __shfl_xor(ss, 8);
      const float rs = rsqrtf(ss * (1.f / 128.f) + 1e-6f);
      unsigned w[4];
#pragma unroll
      for (int e = 0; e < 8; e += 2) {
        const int c0 = lane * 8 + e;
        const float g0 = bf2f(p[(long)t * DIN + 2048 + c0]), g1 = bf2f(p[(long)t * DIN + 2048 + c0 + 1]);
        const float v0 = o[e] * rs * hg_norm_w[c0] * siluf_(g0);
        const float v1 = o[e + 1] * rs * hg_norm_w[c0 + 1] * siluf_(g1);
        w[e >> 1] = pack2(v0, v1);
      }
      *(uint4*)(mix + (long)t * DM + lane * 8) = uint4{w[0], w[1], w[2], w[3]};
    }
    {
      float y[8]; float s = 0.f, bs = 0.f;
      float vv[8];
#pragma unroll
      for (int e = 0; e < 8; ++e) {
        const long idx = (long)t * 512 + lane * 8 + e;
        y[e] = Yf[idx] + Yb[idx]; s += y[e];
        bs += bf2f(R[idx]) * bf2f(K[idx]) * r_k[lane * 8 + e];
        vv[e] = bf2f(V[idx]);
      }
      s += __shfl_xor(s, 1); s += __shfl_xor(s, 2); s += __shfl_xor(s, 4);
      bs += __shfl_xor(bs, 1); bs += __shfl_xor(bs, 2); bs += __shfl_xor(bs, 4);
      const float mu = s * (1.f / 64.f);
      float q = 0.f;
#pragma unroll
      for (int e = 0; e < 8; ++e) { y[e] -= mu; q += y[e] * y[e]; }
      q += __shfl_xor(q, 1); q += __shfl_xor(q, 2); q += __shfl_xor(q, 4);
      const float rs = rsqrtf(q * (1.f / 64.f) + 64e-5f);
      unsigned w[4];
#pragma unroll
      for (int e = 0; e < 8; e += 2) {
        const int c0 = lane * 8 + e;
        const long idx = (long)t * 512 + c0;
        const float v0 = (y[e] * rs * gn_w[c0] + gn_b[c0] + bs * vv[e]) * bf2f(G[idx]);
        const float v1 = (y[e + 1] * rs * gn_w[c0 + 1] + gn_b[c0 + 1] + bs * vv[e + 1]) * bf2f(G[idx + 1]);
        w[e >> 1] = pack2(v0, v1);
      }
      *(uint4*)(mix + (long)t * DM + 512 + lane * 8) = uint4{w[0], w[1], w[2], w[3]};
    }
  }
}

DI void phase_outproj(const Params& P, int bid, int nb, char* smem) {
  const bfr* mix = (const bfr*)(P.ws + WS_H);
  const float* w_out = P.in[7];
  float* y = (float*)(P.ws + WS_Y);
  short* sA = (short*)smem; short* sB = sA + 128 * LSTR;
  const int tid = threadIdx.x, wid = tid >> 6, lane = tid & 63;
  const int wr = wid >> 1, wc = wid & 1, fr = lane & 15, fq = lane >> 4;
  constexpr int NT = 8, MT = T_LAT / 128;
  for (int it = bid; it < NT * MT; it += nb) {
    const int mt = it / NT, nt = it % NT;
    ALoadBf16 al; BLoadF32 bl;
#pragma unroll
    for (int i = 0; i < 4; ++i) al.rp[i] = mix + (long)(mt * 128 + (tid >> 3) + 32 * i) * DM + (tid & 7) * 8;
    bl.valid = true; bl.ldb = DM;
    bl.p = w_out + (long)((tid & 7) * 8) * DM + nt * 128 + (tid >> 3) * 4;
    f32x4 acc[4][4];
    gemm_mainloop(sA, sB, DM / 64, al, bl, acc);
#pragma unroll
    for (int m = 0; m < 4; ++m)
#pragma unroll
      for (int n = 0; n < 4; ++n)
#pragma unroll
        for (int j = 0; j < 4; ++j) {
          const int rr = mt * 128 + wr * 64 + m * 16 + fq * 4 + j, cc = nt * 128 + wc * 64 + n * 16 + fr;
          y[(long)rr * DM + cc] = acc[m][n][j];
        }
  }
}

DI void phase_ln2route(const Params& P, int bid, int nb) {
  const float* x = P.in[0];
  const float* y = (const float*)(P.ws + WS_Y);
  const float* mod = (const float*)(P.ws + WS_MOD);
  const float* ln1_g = P.in[21]; const float* ln1_b = P.in[22];
  const float* wgrp = P.in[25]; const float* bgrp = P.in[26]; const float* wrt = P.in[27]; const float* brt = P.in[28];
  float* x1 = P.out;
  bfr* h2 = (bfr*)(P.ws + WS_H2);
  int* cnt = (int*)(P.ws + WS_CNT); int* list = (int*)(P.ws + WS_LIST); float* asgw = (float*)(P.ws + WS_ASGW);
  const int wid = threadIdx.x >> 6, lane = threadIdx.x & 63;
  for (int t = bid * 4 + wid; t < T_LAT; t += nb * 4) {
    f32x4 v[4]; float s = 0.f;
#pragma unroll
    for (int i = 0; i < 4; ++i) {
      const int c = lane * 4 + 256 * i;
      f32x4 xv = *(const f32x4*)(x + (long)t * DM + c), yv = *(const f32x4*)(y + (long)t * DM + c), g1 = *(const f32x4*)(mod + 2048 + c);
      v[i] = xv * DN_ALPHA + g1 * yv;
      s += v[i][0] + v[i][1] + v[i][2] + v[i][3];
    }
    float mu = wave_sum(s) * (1.f / DM); float q = 0.f;
#pragma unroll
    for (int i = 0; i < 4; ++i) { v[i] -= mu; q += v[i][0] * v[i][0] + v[i][1] * v[i][1] + v[i][2] * v[i][2] + v[i][3] * v[i][3]; }
    float rs = rsqrtf(wave_sum(q) * (1.f / DM) + 1e-5f);
    s = 0.f;
#pragma unroll
    for (int i = 0; i < 4; ++i) {
      const int c = lane * 4 + 256 * i;
      f32x4 g = *(const f32x4*)(ln1_g + c), b = *(const f32x4*)(ln1_b + c);
      v[i] = v[i] * rs * g + b;
      *(f32x4*)(x1 + (long)t * DM + c) = v[i];
      s += v[i][0] + v[i][1] + v[i][2] + v[i][3];
    }
    mu = wave_sum(s) * (1.f / DM); q = 0.f;
#pragma unroll
    for (int i = 0; i < 4; ++i) { v[i] -= mu; q += v[i][0] * v[i][0] + v[i][1] * v[i][1] + v[i][2] * v[i][2] + v[i][3] * v[i][3]; }
    rs = rsqrtf(wave_sum(q) * (1.f / DM) + 1e-5f);
#pragma unroll
    for (int i = 0; i < 4; ++i) {
      const int c = lane * 4 + 256 * i;
      f32x4 sh = *(const f32x4*)(mod + 3072 + c), sc = *(const f32x4*)(mod + 4096 + c);
      v[i] = v[i] * rs * (sc + 1.f) + sh;
      uint2 w = {pack2(v[i][0], v[i][1]), pack2(v[i][2], v[i][3])};
      *(uint2*)(h2 + (long)t * DM + c) = w;
    }
    float gl[8];
#pragma unroll
    for (int g = 0; g < 8; ++g) gl[g] = 0.f;
#pragma unroll
    for (int i = 0; i < 4; ++i)
#pragma unroll
      for (int e = 0; e < 4; ++e) {
        const int k = lane * 4 + 256 * i + e;
        const f32x4 w0 = *(const f32x4*)(wgrp + k * 8), w1 = *(const f32x4*)(wgrp + k * 8 + 4);
        const float hv = v[i][e];
        gl[0] += hv * w0[0]; gl[1] += hv * w0[1]; gl[2] += hv * w0[2]; gl[3] += hv * w0[3];
        gl[4] += hv * w1[0]; gl[5] += hv * w1[1]; gl[6] += hv * w1[2]; gl[7] += hv * w1[3];
      }
    int gi = 0; float gmax = -3.4e38f;
#pragma unroll
    for (int g = 0; g < 8; ++g) { gl[g] = wave_sum(gl[g]) + bgrp[g]; if (gl[g] > gmax) { gmax = gl[g]; gi = g; } }
    float den = 0.f;
#pragma unroll
    for (int g = 0; g < 8; ++g) den += __expf(gl[g] - gmax);
    const float gprob = 1.f / den;
    float el[8];
#pragma unroll
    for (int g = 0; g < 8; ++g) el[g] = 0.f;
#pragma unroll
    for (int i = 0; i < 4; ++i)
#pragma unroll
      for (int e = 0; e < 4; ++e) {
        const int k = lane * 4 + 256 * i + e;
        const f32x4 w0 = *(const f32x4*)(wrt + k * 64 + gi * 8), w1 = *(const f32x4*)(wrt + k * 64 + gi * 8 + 4);
        const float hv = v[i][e];
        el[0] += hv * w0[0]; el[1] += hv * w0[1]; el[2] += hv * w0[2]; el[3] += hv * w0[3];
        el[4] += hv * w1[0]; el[5] += hv * w1[1]; el[6] += hv * w1[2]; el[7] += hv * w1[3];
      }
    int i1 = 0; float v1 = -3.4e38f;
#pragma unroll
    for (int g = 0; g < 8; ++g) { el[g] = wave_sum(el[g]) + brt[gi * 8 + g]; if (el[g] > v1) { v1 = el[g]; i1 = g; } }
    int i2 = 0; float v2 = -3.4e38f;
#pragma unroll
    for (int g = 0; g < 8; ++g) { if (g != i1 && el[g] > v2) { v2 = el[g]; i2 = g; } }
    const float e2 = __expf(v2 - v1);
    const float wt1 = gprob / (1.f + e2), wt2 = gprob * e2 / (1.f + e2);
    if (lane == 0) {
      const int ex1 = gi * 8 + i1, ex2 = gi * 8 + i2;
      int s1 = atomicAdd(&cnt[ex1], 1); list[ex1 * T_LAT + s1] = t * 2;
      int s2 = atomicAdd(&cnt[ex2], 1); list[ex2 * T_LAT + s2] = t * 2 + 1;
      asgw[t * 2] = wt1; asgw[t * 2 + 1] = wt2;
    }
  }
}

DI void moe_block_table(const Params& P, int* tab  ) {
  const int* cnt = (const int*)(P.ws + WS_CNT);
  const int tid = threadIdx.x;
  __syncthreads();
  if (tid < 64) {
    int nbk = (cnt[tid] + 127) >> 7;
    int incl = nbk;
#pragma unroll
    for (int o = 1; o < 64; o <<= 1) { int u = __shfl_up(incl, o); if (tid >= o) incl += u; }
    tab[tid + 1] = incl;
    if (tid == 0) tab[0] = 0;
  }
  __syncthreads();
}
DI int moe_find_expert(const int* tab, int rb) {
  int e = 0;
  while (tab[e + 1] <= rb) ++e;
  return e;
}

DI void phase_moe1(const Params& P, int bid, int nb, char* smem) {
  const bfr* h2 = (const bfr*)(P.ws + WS_H2);
  const int* cnt = (const int*)(P.ws + WS_CNT); const int* list = (const int*)(P.ws + WS_LIST);
  const float* wg = P.in[29]; const float* wu = P.in[30];
  bfr* hid = (bfr*)(P.ws + WS_HID);
  short* sA = (short*)smem; short* sB = sA + 128 * LSTR;
  int* tab = (int*)(smem + GEMM_LDS_BYTES);
  const int tid = threadIdx.x, wid = tid >> 6, lane = tid & 63;
  const int wr = wid >> 1, wc = wid & 1, fr = lane & 15, fq = lane >> 4;
  moe_block_table(P, tab);
  const int nrb = tab[64];
  for (int it = bid; it < nrb * 8; it += nb) {
    const int rb = it >> 3, nt = it & 7;
    const int e = moe_find_expert(tab, rb);
    const int lrb = rb - tab[e];
    const int ce = cnt[e];
    ALoadBf16 al; BLoadF32 bl;
#pragma unroll
    for (int i = 0; i < 4; ++i) {
      int r = lrb * 128 + (tid >> 3) + 32 * i;
      if (r >= ce) r = ce - 1;
      const int tok = list[e * T_LAT + r] >> 1;
      al.rp[i] = h2 + (long)tok * DM + (tid & 7) * 8;
    }
    const int n4 = tid >> 3;
    const int isup = (n4 >> 3) & 1;
    const int col = nt * 64 + (n4 >> 4) * 32 + ((4 * n4) & 31);
    bl.valid = true; bl.ldb = DEXP;
    bl.p = (isup ? wu : wg) + (long)e * DM * DEXP + (long)((tid & 7) * 8) * DEXP + col;
    f32x4 acc[4][4];
    gemm_mainloop(sA, sB, DM / 64, al, bl, acc);
#pragma unroll
    for (int m = 0; m < 4; ++m)
#pragma unroll
      for (int n = 0; n < 2; ++n)
#pragma unroll
        for (int j = 0; j < 4; ++j) {
          const int rl = wr * 64 + m * 16 + fq * 4 + j;
          const int cc = nt * 64 + wc * 32 + n * 16 + fr;
          const float gv = acc[m][n][j], uv = acc[m][n + 2][j];
          hid[((long)rb * 128 + rl) * DEXP + cc] = f2bf(siluf_(gv) * uv);
        }
  }
}

DI void phase_moe2(const Params& P, int bid, int nb, char* smem) {
  const int* cnt = (const int*)(P.ws + WS_CNT); const int* list = (const int*)(P.ws + WS_LIST);
  const float* wd = P.in[31];
  const bfr* hid = (const bfr*)(P.ws + WS_HID);
  bfr* mout = (bfr*)(P.ws + WS_MOUT);
  short* sA = (short*)smem; short* sB = sA + 128 * LSTR;
  int* tab = (int*)(smem + GEMM_LDS_BYTES);
  const int tid = threadIdx.x, wid = tid >> 6, lane = tid & 63;
  const int wr = wid >> 1, wc = wid & 1, fr = lane & 15, fq = lane >> 4;
  moe_block_table(P, tab);
  const int nrb = tab[64];
  for (int it = bid; it < nrb * 8; it += nb) {
    const int rb = it >> 3, nt = it & 7;
    const int e = moe_find_expert(tab, rb);
    const int lrb = rb - tab[e];
    const int ce = cnt[e];
    ALoadBf16 al; BLoadF32 bl;
#pragma unroll
    for (int i = 0; i < 4; ++i) al.rp[i] = hid + ((long)rb * 128 + (tid >> 3) + 32 * i) * DEXP + (tid & 7) * 8;
    bl.valid = true; bl.ldb = DM;
    bl.p = wd + (long)e * DEXP * DM + (long)((tid & 7) * 8) * DM + nt * 128 + (tid >> 3) * 4;
    f32x4 acc[4][4];
    gemm_mainloop(sA, sB, DEXP / 64, al, bl, acc);
#pragma unroll
    for (int m = 0; m < 4; ++m)
#pragma unroll
      for (int j = 0; j < 4; ++j) {
        const int r = lrb * 128 + wr * 64 + m * 16 + fq * 4 + j;
        if (r < ce) {
          const int asg = list[e * T_LAT + r];
#pragma unroll
          for (int n = 0; n < 4; ++n) mout[(long)asg * DM + nt * 128 + wc * 64 + n * 16 + fr] = f2bf(acc[m][n][j]);
        }
      }
  }
}

DI void phase_final(const Params& P, int bid, int nb) {
  const float* mod = (const float*)(P.ws + WS_MOD);
  const float* ln2_g = P.in[23]; const float* ln2_b = P.in[24];
  const bfr* mout = (const bfr*)(P.ws + WS_MOUT);
  const float* asgw = (const float*)(P.ws + WS_ASGW);
  float* out = P.out;
  const int wid = threadIdx.x >> 6, lane = threadIdx.x & 63;
  for (int t = bid * 4 + wid; t < T_LAT; t += nb * 4) {
    const float w1 = asgw[t * 2], w2 = asgw[t * 2 + 1];
    f32x4 v[4]; float s = 0.f;
#pragma unroll
    for (int i = 0; i < 4; ++i) {
      const int c = lane * 4 + 256 * i;
      f32x4 xv = *(const f32x4*)(out + (long)t * DM + c), g2 = *(const f32x4*)(mod + 5120 + c);
      const uint2 m1 = *(const uint2*)(mout + (long)(2 * t) * DM + c), m2 = *(const uint2*)(mout + (long)(2 * t + 1) * DM + c);
      f32x4 a = {__uint_as_float(m1.x << 16), __uint_as_float(m1.x & 0xffff0000u), __uint_as_float(m1.y << 16), __uint_as_float(m1.y & 0xffff0000u)};
      f32x4 b = {__uint_as_float(m2.x << 16), __uint_as_float(m2.x & 0xffff0000u), __uint_as_float(m2.y << 16), __uint_as_float(m2.y & 0xffff0000u)};
      v[i] = xv * DN_ALPHA + g2 * (a * w1 + b * w2);
      s += v[i][0] + v[i][1] + v[i][2] + v[i][3];
    }
    const float mu = wave_sum(s) * (1.f / DM); float q = 0.f;
#pragma unroll
    for (int i = 0; i < 4; ++i) { v[i] -= mu; q += v[i][0] * v[i][0] + v[i][1] * v[i][1] + v[i][2] * v[i][2] + v[i][3] * v[i][3]; }
    const float rs = rsqrtf(wave_sum(q) * (1.f / DM) + 1e-5f);
#pragma unroll
    for (int i = 0; i < 4; ++i) {
      const int c = lane * 4 + 256 * i;
      f32x4 g = *(const f32x4*)(ln2_g + c), b = *(const f32x4*)(ln2_b + c);
      *(f32x4*)(out + (long)t * DM + c) = v[i] * rs * g + b;
    }
  }
}

constexpr int SMEM_BYTES = 40960;
__global__ void __launch_bounds__(NTHR) k_mod(Params P) { __shared__ __attribute__((aligned(16))) char smem[SMEM_BYTES]; phase_mod(P, blockIdx.x, gridDim.x, smem); }
__global__ void __launch_bounds__(NTHR) k_ln1(Params P) { phase_ln1(P, blockIdx.x, gridDim.x); }
__global__ void __launch_bounds__(NTHR) k_pgemm(Params P) { __shared__ __attribute__((aligned(16))) char smem[SMEM_BYTES]; phase_pgemm(P, blockIdx.x, gridDim.x, smem); }
__global__ void __launch_bounds__(NTHR) k_rwprep(Params P) { __shared__ __attribute__((aligned(16))) char smem[SMEM_BYTES]; phase_rwprep(P, blockIdx.x, gridDim.x, smem); }
__global__ void __launch_bounds__(NTHR) k_scans(Params P) {
  __shared__ __attribute__((aligned(16))) char smem[SMEM_BYTES];
  if (blockIdx.x < 16) rwkv_chain_naive(P, blockIdx.x, smem); else hgrn_chain_naive(P, blockIdx.x - 16, smem);
}
__global__ void __launch_bounds__(NTHR) k_readout(Params P) { phase_readout(P, blockIdx.x, gridDim.x); }
__global__ void __launch_bounds__(NTHR) k_outproj(Params P) { __shared__ __attribute__((aligned(16))) char smem[SMEM_BYTES]; phase_outproj(P, blockIdx.x, gridDim.x, smem); }
__global__ void __launch_bounds__(NTHR) k_ln2route(Params P) { phase_ln2route(P, blockIdx.x, gridDim.x); }
__global__ void __launch_bounds__(NTHR) k_moe1(Params P) { __shared__ __attribute__((aligned(16))) char smem[SMEM_BYTES]; phase_moe1(P, blockIdx.x, gridDim.x, smem); }
__global__ void __launch_bounds__(NTHR) k_moe2(Params P) { __shared__ __attribute__((aligned(16))) char smem[SMEM_BYTES]; phase_moe2(P, blockIdx.x, gridDim.x, smem); }
__global__ void __launch_bounds__(NTHR) k_final(Params P) { phase_final(P, blockIdx.x, gridDim.x); }

extern "C" void kernel_launch(void* const* d_in, const int* in_sizes, int n_in, void* d_out, int out_size, void* d_ws, size_t ws_size, hipStream_t stream) {
  Params P{};
  for (int i = 0; i < 32; ++i) P.in[i] = (const float*)d_in[i];
  P.out = (float*)d_out; P.ws = (char*)d_ws;
  const int G = 512;
  k_mod<<<194, NTHR, 0, stream>>>(P);
  k_ln1<<<G, NTHR, 0, stream>>>(P);
  k_pgemm<<<G * 2, NTHR, 0, stream>>>(P);
  k_rwprep<<<G * 2, NTHR, 0, stream>>>(P);
  k_scans<<<24, NTHR, 0, stream>>>(P);
  k_readout<<<G, NTHR, 0, stream>>>(P);
  k_outproj<<<G * 2, NTHR, 0, stream>>>(P);
  k_ln2route<<<G, NTHR, 0, stream>>>(P);
  k_moe1<<<G * 2, NTHR, 0, stream>>>(P);
  k_moe2<<<G * 2, NTHR, 0, stream>>>(P);
  k_final<<<G, NTHR, 0, stream>>>(P);
}
```

```cpp
#include <hip/hip_runtime.h>
#include <hip/hip_cooperative_groups.h>
#include <cstdio>

typedef __attribute__((ext_vector_type(8))) short bf16x8;
typedef __attribute__((ext_vector_type(4))) short s16x4;
typedef __attribute__((ext_vector_type(4))) float f32x4;
typedef __attribute__((ext_vector_type(2))) float f32x2;
typedef __attribute__((ext_vector_type(2))) __bf16 bf16x2_t;
typedef unsigned short bfr;

#define DI __device__ __forceinline__

constexpr int T_LAT = 16384, T_CTX = 256, T_ALL = T_LAT + T_CTX;
constexpr int DM = 1024, DIN = 4288, HGC = 2560, RWC = 1728, DRW = 512, DHG = 512;
constexpr int NEXP = 64, DEXP = 512;
constexpr int NTHR = 256;
constexpr float DN_ALPHA = 1.189207115002721f;
constexpr float RW_DECAY_SCALE = 0.6065306597126334f;

constexpr size_t MB = 1ull << 20;
constexpr size_t WS_MOD = 0;
constexpr size_t WS_MODC = 32768;
constexpr size_t WS_LB = 65536;
constexpr size_t WS_CNT = 65536 + 8192;
constexpr size_t WS_ASGW = 131072;
constexpr size_t WS_LIST = 1 * MB;
constexpr size_t WS_H = 6 * MB;
constexpr size_t WS_P = 42 * MB;
constexpr size_t WS_Y = 42 * MB;
constexpr size_t WS_H2 = 106 * MB;
constexpr size_t WS_HID = 138 * MB;
constexpr size_t WS_RW = 186 * MB;
constexpr size_t RW_ARR = (size_t)T_ALL * 512 * 2;
constexpr size_t WS_LW = 284 * MB;
constexpr size_t LW_ARR = (size_t)T_ALL * 512 * 4;
constexpr size_t WS_YRW = 350 * MB;
constexpr size_t WS_OHG = 414 * MB;
constexpr size_t WS_MOUT = 186 * MB;

struct Params {
  const float* in[32];
  float* out;
  char* ws;
};

DI unsigned pack2(float a, float b) {
  f32x2 v = {a, b};
  bf16x2_t r = __builtin_convertvector(v, bf16x2_t);
  return __builtin_bit_cast(unsigned, r);
}
DI bfr f2bf(float a) { return (bfr)(pack2(a, 0.f) & 0xffffu); }
DI float bf2f(bfr v) { return __uint_as_float(((unsigned)v) << 16); }
DI float sigmoidf_(float x) { return 1.f / (1.f + __expf(-x)); }
DI float siluf_(float x) { return x / (1.f + __expf(-x)); }
DI float wave_sum(float v) {
#pragma unroll
  for (int o = 32; o > 0; o >>= 1) v += __shfl_xor(v, o);
  return v;
}

constexpr int LSTR = 72;
constexpr int GEMM_LDS_BYTES = 2 * 128 * LSTR * 2;

struct ALoadBf16 {
  const bfr* rp[4];
  bf16x8 r[4];
  DI void load(int kt) {
#pragma unroll
    for (int i = 0; i < 4; ++i) r[i] = *(const bf16x8*)(rp[i] + kt * 64);
  }
  DI void store(short* sA) const {
    const int tid = threadIdx.x;
#pragma unroll
    for (int i = 0; i < 4; ++i) *(bf16x8*)(sA + ((tid >> 3) + 32 * i) * LSTR + (tid & 7) * 8) = r[i];
  }
};

struct BLoadF32 {
  const float* p;
  long ldb;
  bool valid;
  f32x4 v[8];
  DI void load(int kt) {
#pragma unroll
    for (int j = 0; j < 8; ++j) {
      if (valid) v[j] = *(const f32x4*)(p + ((long)kt * 64 + j) * ldb);
      else v[j] = f32x4{0.f, 0.f, 0.f, 0.f};
    }
  }
  DI void store(short* sB) const {
    const int tid = threadIdx.x, kg = tid & 7, n4 = tid >> 3;
#pragma unroll
    for (int i = 0; i < 4; ++i) {
      unsigned a0 = pack2(v[0][i], v[1][i]), a1 = pack2(v[2][i], v[3][i]);
      unsigned a2 = pack2(v[4][i], v[5][i]), a3 = pack2(v[6][i], v[7][i]);
      typedef __attribute__((ext_vector_type(4))) unsigned u32x4;
      u32x4 w = {a0, a1, a2, a3};
      *(u32x4*)(sB + (4 * n4 + i) * LSTR + kg * 8) = w;
    }
  }
};

template <class AL, class BL>
DI void gemm_mainloop(short* sA, short* sB, int nk, AL& al, BL& bl, f32x4 (&acc)[4][4]) {
  const int tid = threadIdx.x, wid = tid >> 6, lane = tid & 63;
  const int wr = wid >> 1, wc = wid & 1, fr = lane & 15, fq = lane >> 4;
#pragma unroll
  for (int m = 0; m < 4; ++m)
#pragma unroll
    for (int n = 0; n < 4; ++n) acc[m][n] = f32x4{0.f, 0.f, 0.f, 0.f};
  al.load(0); bl.load(0);
  for (int kt = 0; kt < nk; ++kt) {
    __syncthreads();
    al.store(sA); bl.store(sB);
    __syncthreads();
    if (kt + 1 < nk) { al.load(kt + 1); bl.load(kt + 1); }
#pragma unroll
    for (int ks = 0; ks < 2; ++ks) {
      bf16x8 af[4], bf[4];
#pragma unroll
      for (int m = 0; m < 4; ++m) af[m] = *(const bf16x8*)(sA + (wr * 64 + m * 16 + fr) * LSTR + ks * 32 + fq * 8);
#pragma unroll
      for (int n = 0; n < 4; ++n) bf[n] = *(const bf16x8*)(sB + (wc * 64 + n * 16 + fr) * LSTR + ks * 32 + fq * 8);
#pragma unroll
      for (int m = 0; m < 4; ++m)
#pragma unroll
        for (int n = 0; n < 4; ++n) acc[m][n] = __builtin_amdgcn_mfma_f32_16x16x32_bf16(af[m], bf[n], acc[m][n], 0, 0, 0);
    }
  }
}

DI void phase_mod(const Params& P, int bid, int nb, char* smem) {
  const float* c = P.in[1]; const float* cc = P.in[3];
  const float* w_mod = P.in[4]; const float* b_mod = P.in[5];
  float* mod = (float*)(P.ws + WS_MOD); float* modc = (float*)(P.ws + WS_MODC);
  float* red = (float*)smem;
  const int tid = threadIdx.x;
  for (int it = bid; it < 194; it += nb) {
    if (it < 192) {
      const int kq = tid >> 3, c4 = tid & 7;
      const int col = it * 32 + c4 * 4;
      f32x4 a1 = {0, 0, 0, 0}, a2 = {0, 0, 0, 0};
      for (int k = kq; k < DM; k += 32) {
        f32x4 w = *(const f32x4*)(w_mod + (long)k * 6144 + col);
        float s1 = siluf_(c[k]), s2 = siluf_(cc[k]);
        a1 += w * s1; a2 += w * s2;
      }
      __syncthreads();
#pragma unroll
      for (int e = 0; e < 4; ++e) { red[(kq * 32) + c4 * 4 + e] = a1[e]; red[1024 + kq * 32 + c4 * 4 + e] = a2[e]; }
      __syncthreads();
      if (tid < 64) {
        const int which = tid >> 5, cl = tid & 31;
        float s = 0.f;
        for (int q = 0; q < 32; ++q) s += red[which * 1024 + q * 32 + cl];
        const int cg = it * 32 + cl;
        s += b_mod[cg];
        if (which == 0) mod[cg] = s; else modc[cg] = s;
      }
    } else if (it == 192) {
      const float* L = P.in[8];
      float* lb = (float*)(P.ws + WS_LB);
      for (int i = tid; i < 1024; i += NTHR) {
        const int d = i >> 9, j = i & 511;
        float l0 = L[d * 1024 + j], l1 = L[d * 1024 + 512 + j];
        lb[i] = 1.f / (1.f + __expf(l1 - l0));
      }
    } else {
      int* cnt = (int*)(P.ws + WS_CNT);
      if (tid < 64) cnt[tid] = 0;
    }
  }
}

DI void phase_ln1(const Params& P, int bid, int nb) {
  const float* x = P.in[0]; const float* ctx = P.in[2];
  const float* mod = (const float*)(P.ws + WS_MOD); const float* modc = (const float*)(P.ws + WS_MODC);
  bfr* h = (bfr*)(P.ws + WS_H);
  const int wid = threadIdx.x >> 6, lane = threadIdx.x & 63;
  for (int row = bid * 4 + wid; row < T_ALL; row += nb * 4) {
    const float* src = row < T_LAT ? x + (long)row * DM : ctx + (long)(row - T_LAT) * DM;
    const float* mm = row < T_LAT ? mod : modc;
    f32x4 v[4];
    float s = 0.f;
#pragma unroll
    for (int i = 0; i < 4; ++i) { v[i] = *(const f32x4*)(src + lane * 4 + 256 * i); s += v[i][0] + v[i][1] + v[i][2] + v[i][3]; }
    const float mu = wave_sum(s) * (1.f / DM);
    float q = 0.f;
#pragma unroll
    for (int i = 0; i < 4; ++i) { v[i] -= mu; q += v[i][0] * v[i][0] + v[i][1] * v[i][1] + v[i][2] * v[i][2] + v[i][3] * v[i][3]; }
    const float rs = rsqrtf(wave_sum(q) * (1.f / DM) + 1e-5f);
#pragma unroll
    for (int i = 0; i < 4; ++i) {
      const int cidx = lane * 4 + 256 * i;
      f32x4 sh = *(const f32x4*)(mm + cidx), sc = *(const f32x4*)(mm + 1024 + cidx);
      f32x4 o = v[i] * rs * (sc + 1.f) + sh;
      uint2 w = {pack2(o[0], o[1]), pack2(o[2], o[3])};
      *(uint2*)(h + (long)row * DM + cidx) = w;
    }
  }
}

DI void phase_pgemm(const Params& P, int bid, int nb, char* smem) {
  const bfr* h = (const bfr*)(P.ws + WS_H);
  const float* w_in = P.in[6];
  bfr* p = (bfr*)(P.ws + WS_P);
  short* sA = (short*)smem; short* sB = sA + 128 * LSTR;
  const int tid = threadIdx.x, wid = tid >> 6, lane = tid & 63;
  const int wr = wid >> 1, wc = wid & 1, fr = lane & 15, fq = lane >> 4;
  constexpr int NT = 34, MT = T_ALL / 128;
  for (int it = bid; it < NT * MT; it += nb) {
    const int mt = it / NT, nt = it % NT;
    ALoadBf16 al; BLoadF32 bl;
#pragma unroll
    for (int i = 0; i < 4; ++i) al.rp[i] = h + (long)(mt * 128 + (tid >> 3) + 32 * i) * DM + (tid & 7) * 8;
    const int col = nt * 128 + (tid >> 3) * 4;
    bl.valid = col < DIN; bl.ldb = DIN;
    bl.p = w_in + (long)((tid & 7) * 8) * DIN + (bl.valid ? col : 0);
    f32x4 acc[4][4];
    gemm_mainloop(sA, sB, DM / 64, al, bl, acc);
#pragma unroll
    for (int m = 0; m < 4; ++m)
#pragma unroll
      for (int n = 0; n < 4; ++n) {
        const int cc = nt * 128 + wc * 64 + n * 16 + fr;
        if (cc < DIN) {
#pragma unroll
          for (int j = 0; j < 4; ++j) {
            const int rr = mt * 128 + wr * 64 + m * 16 + fq * 4 + j;
            p[(long)rr * DIN + cc] = f2bf(acc[m][n][j]);
          }
        }
      }
  }
}

DI float rw_mixed(const bfr* p, int row, int c, const float* mu) {
  const long base = (long)row * DIN + HGC + c;
  const float pc = bf2f(p[base]);
  float nbv;
  if (row < T_LAT) {
    const int gr = row >> 6, gc = row & 63;
    float s = 0.f;
    if (gr > 0) s += bf2f(p[base - 64l * DIN]);
    if (gr < 255) s += bf2f(p[base + 64l * DIN]);
    if (gc > 0) s += bf2f(p[base - DIN]);
    if (gc < 63) s += bf2f(p[base + DIN]);
    nbv = 0.25f * s;
  } else {
    const int sidx = row - T_LAT;
    float s = 0.f;
    if (sidx > 0) s += bf2f(p[base - DIN]);
    if (sidx < T_CTX - 1) s += bf2f(p[base + DIN]);
    nbv = 0.5f * s;
  }
  return pc + (nbv - pc) * mu[c];
}

constexpr int RWP_TOK = 16;
DI void phase_rwprep(const Params& P, int bid, int nb, char* smem) {
  const bfr* p = (const bfr*)(P.ws + WS_P);
  const float* mu = P.in[10]; const float* w0 = P.in[11]; const float* wd2 = P.in[12];
  const float* a0 = P.in[13]; const float* wa2 = P.in[14]; const float* wg2 = P.in[15];
  const float* k_k = P.in[16]; const float* k_a = P.in[17];
  bfr* R = (bfr*)(P.ws + WS_RW); bfr* K = (bfr*)(P.ws + WS_RW + RW_ARR); bfr* V = (bfr*)(P.ws + WS_RW + 2 * RW_ARR);
  bfr* KK = (bfr*)(P.ws + WS_RW + 3 * RW_ARR); bfr* A = (bfr*)(P.ws + WS_RW + 4 * RW_ARR); bfr* G = (bfr*)(P.ws + WS_RW + 5 * RW_ARR);
  float* LWF = (float*)(P.ws + WS_LW); float* LWB = (float*)(P.ws + WS_LW + LW_ARR);
  float* lo = (float*)smem;
  const int tid = threadIdx.x;
  for (int it = bid; it < T_ALL / RWP_TOK; it += nb) {
    const int row0 = it * RWP_TOK;
    __syncthreads();
    for (int i = tid; i < RWP_TOK * 192; i += NTHR) {
      const int tk = i / 192, j = i % 192;
      float v = rw_mixed(p, row0 + tk, 1536 + j, mu);
      if (j < 64) v = tanhf(v);
      else if (j >= 96) v = sigmoidf_(v);
      lo[i] = v;
    }
    __syncthreads();
    float av[RWP_TOK][2];
#pragma unroll
    for (int d = 0; d < 2; ++d) {
      float acc[RWP_TOK][2];
#pragma unroll
      for (int t = 0; t < RWP_TOK; ++t) { acc[t][0] = 0.f; acc[t][1] = 0.f; }
      for (int j = 0; j < 32; ++j) {
        const float wA = wd2[(d * 32 + j) * 512 + tid], wB = wd2[(d * 32 + j) * 512 + tid + 256];
#pragma unroll
        for (int t = 0; t < RWP_TOK; ++t) { const float xv = lo[t * 192 + d * 32 + j]; acc[t][0] += xv * wA; acc[t][1] += xv * wB; }
      }
      float* LW = d == 0 ? LWF : LWB;
#pragma unroll
      for (int t = 0; t < RWP_TOK; ++t)
#pragma unroll
        for (int hh = 0; hh < 2; ++hh) {
          const int ch = tid + 256 * hh;
          const float wl = w0[d * 512 + ch] + acc[t][hh];
          LW[(long)(row0 + t) * 512 + ch] = -RW_DECAY_SCALE * sigmoidf_(wl);
        }
    }
    {
#pragma unroll
      for (int t = 0; t < RWP_TOK; ++t) { av[t][0] = 0.f; av[t][1] = 0.f; }
      for (int j = 0; j < 32; ++j) {
        const float wA = wa2[j * 512 + tid], wB = wa2[j * 512 + tid + 256];
#pragma unroll
        for (int t = 0; t < RWP_TOK; ++t) { const float xv = lo[t * 192 + 64 + j]; av[t][0] += xv * wA; av[t][1] += xv * wB; }
      }
#pragma unroll
      for (int t = 0; t < RWP_TOK; ++t)
#pragma unroll
        for (int hh = 0; hh < 2; ++hh) av[t][hh] = sigmoidf_(a0[tid + 256 * hh] + av[t][hh]);
    }
    {
      float acc[RWP_TOK][2];
#pragma unroll
      for (int t = 0; t < RWP_TOK; ++t) { acc[t][0] = 0.f; acc[t][1] = 0.f; }
      for (int j = 0; j < 96; ++j) {
        const float wA = wg2[j * 512 + tid], wB = wg2[j * 512 + tid + 256];
#pragma unroll
        for (int t = 0; t < RWP_TOK; ++t) { const float xv = lo[t * 192 + 96 + j]; acc[t][0] += xv * wA; acc[t][1] += xv * wB; }
      }
#pragma unroll
      for (int t = 0; t < RWP_TOK; ++t)
#pragma unroll
        for (int hh = 0; hh < 2; ++hh) G[(long)(row0 + t) * 512 + tid + 256 * hh] = f2bf(acc[t][hh]);
    }
#pragma unroll
    for (int t = 0; t < RWP_TOK; ++t)
#pragma unroll
      for (int hh = 0; hh < 2; ++hh) {
        const int ch = tid + 256 * hh;
        const int row = row0 + t;
        const float r = rw_mixed(p, row, ch, mu);
        const float kraw = rw_mixed(p, row, 512 + ch, mu);
        const float v = rw_mixed(p, row, 1024 + ch, mu);
        const float kkr = kraw * k_k[ch];
        const float ss = wave_sum(kkr * kkr);
        const float kk = kkr * rsqrtf(fmaxf(ss, 1e-12f));
        const float a = av[t][hh];
        const float k = kraw * (1.f + (a - 1.f) * k_a[ch]);
        const long o = (long)row * 512 + ch;
        R[o] = f2bf(r); K[o] = f2bf(k); V[o] = f2bf(v); KK[o] = f2bf(kk); A[o] = f2bf(a);
      }
  }
}

DI void rwkv_chain_naive(const Params& P, int chain, char* smem) {
  const int dir = chain >> 3, hd = chain & 7;
  const bfr* R = (const bfr*)(P.ws + WS_RW); const bfr* K = (const bfr*)(P.ws + WS_RW + RW_ARR); const bfr* V = (const bfr*)(P.ws + WS_RW + 2 * RW_ARR);
  const bfr* KK = (const bfr*)(P.ws + WS_RW + 3 * RW_ARR); const bfr* A = (const bfr*)(P.ws + WS_RW + 4 * RW_ARR);
  const float* LW = (const float*)(P.ws + WS_LW + (dir ? LW_ARR : 0));
  float* Y = (float*)(P.ws + WS_YRW) + (long)dir * T_LAT * 512;
  float* vec = (float*)smem;
  float* red = vec + 16 * 6 * 64;
  const int tid = threadIdx.x, i = tid & 63, jq = tid >> 6;
  float S[16];
#pragma unroll
  for (int j = 0; j < 16; ++j) S[j] = 0.f;
  for (int s0 = 0; s0 < T_ALL; s0 += 16) {
    __syncthreads();
    for (int e = tid; e < 16 * 64; e += NTHR) {
      const int st = e >> 6, j = e & 63;
      const int s = s0 + st;
      int row;
      if (s < T_CTX) row = T_LAT + (dir ? (T_CTX - 1 - s) : s);
      else row = dir ? (T_LAT - 1 - (s - T_CTX)) : (s - T_CTX);
      const long o = (long)row * 512 + hd * 64 + j;
      float* vp = vec + st * 384;
      const float kk = bf2f(KK[o]);
      vp[j] = bf2f(R[o]); vp[64 + j] = __expf(LW[o]); vp[128 + j] = bf2f(K[o]); vp[192 + j] = bf2f(V[o]);
      vp[256 + j] = kk; vp[320 + j] = kk * bf2f(A[o]);
    }
    __syncthreads();
    for (int st = 0; st < 16; ++st) {
      const float* vp = vec + st * 384;
      const int par = st & 1;
      float sa = 0.f;
#pragma unroll
      for (int j = 0; j < 16; ++j) sa += S[j] * vp[256 + jq * 16 + j];
      red[(par * 2 + 0) * 256 + jq * 64 + i] = sa;
      __syncthreads();
      sa = red[(par * 2) * 256 + i] + red[(par * 2) * 256 + 64 + i] + red[(par * 2) * 256 + 128 + i] + red[(par * 2) * 256 + 192 + i];
      const float vi = vp[192 + i];
      float y = 0.f;
#pragma unroll
      for (int j = 0; j < 16; ++j) {
        const int jj = jq * 16 + j;
        S[j] = S[j] * vp[64 + jj] - sa * vp[320 + jj] + vi * vp[128 + jj];
        y += S[j] * vp[jj];
      }
      red[(par * 2 + 1) * 256 + jq * 64 + i] = y;
      __syncthreads();
      const int s = s0 + st;
      if (jq == 0 && s >= T_CTX) {
        y = red[(par * 2 + 1) * 256 + i] + red[(par * 2 + 1) * 256 + 64 + i] + red[(par * 2 + 1) * 256 + 128 + i] + red[(par * 2 + 1) * 256 + 192 + i];
        const int row = dir ? (T_LAT - 1 - (s - T_CTX)) : (s - T_CTX);
        Y[(long)row * 512 + hd * 64 + i] = y;
      }
    }
  }
}

DI void hgrn_chain_naive(const Params& P, int chain, char* smem) {
  const int dir = chain >> 2, hd = chain & 3;
  const bfr* p = (const bfr*)(P.ws + WS_P);
  const float* lb = (const float*)(P.ws + WS_LB) + dir * 512 + hd * 128;
  float* O = (float*)(P.ws + WS_OHG) + (long)dir * T_LAT * 512;
  float* vec = (float*)smem;
  float* red = vec + 16 * 4 * 128;
  const int tid = threadIdx.x, e = tid & 127, dh = tid >> 7;
  float S[64];
#pragma unroll
  for (int d = 0; d < 64; ++d) S[d] = 0.f;
  for (int s0 = 0; s0 < T_ALL; s0 += 16) {
    __syncthreads();
    for (int x = tid; x < 16 * 128; x += NTHR) {
      const int st = x >> 7, d = x & 127;
      const int s = s0 + st;
      int row;
      if (s < T_CTX) row = T_LAT + (dir ? (T_CTX - 1 - s) : s);
      else row = dir ? (T_LAT - 1 - (s - T_CTX)) : (s - T_CTX);
      const bfr* pr = p + (long)row * DIN + hd * 128 + d;
      const float q = bf2f(pr[0]), iv = bf2f(pr[512]), z = bf2f(pr[1024 + dir * 512]);
      const float l = lb[d];
      const float f = l + (1.f - l) * sigmoidf_(z);
      float* vp = vec + st * 512;
      vp[d] = siluf_(q); vp[128 + d] = f; vp[256 + d] = (1.f - l) * sigmoidf_(-z); vp[384 + d] = iv;
    }
    __syncthreads();
    for (int st = 0; st < 16; ++st) {
      const float* vp = vec + st * 512;
      const int par = st & 1;
      const float ve = vp[384 + e];
      float o = 0.f;
#pragma unroll
      for (int d = 0; d < 64; ++d) {
        const int dd = dh * 64 + d;
        S[d] = S[d] * vp[128 + dd] + vp[256 + dd] * ve;
        o += vp[dd] * S[d];
      }
      red[par * 256 + dh * 128 + e] = o;
      __syncthreads();
      const int s = s0 + st;
      if (dh == 0 && s >= T_CTX) {
        o = red[par * 256 + e] + red[par * 256 + 128 + e];
        const int row = dir ? (T_LAT - 1 - (s - T_CTX)) : (s - T_CTX);
        O[(long)row * 512 + hd * 128 + e] = o;
      }
    }
  }
}

DI void phase_readout(const Params& P, int bid, int nb) {
  const bfr* p = (const bfr*)(P.ws + WS_P);
  const float* Of = (const float*)(P.ws + WS_OHG); const float* Ob = Of + (long)T_LAT * 512;
  const float* Yf = (const float*)(P.ws + WS_YRW); const float* Yb = Yf + (long)T_LAT * 512;
  const bfr* R = (const bfr*)(P.ws + WS_RW); const bfr* K = (const bfr*)(P.ws + WS_RW + RW_ARR); const bfr* V = (const bfr*)(P.ws + WS_RW + 2 * RW_ARR);
  const bfr* G = (const bfr*)(P.ws + WS_RW + 5 * RW_ARR);
  const float* hg_norm_w = P.in[9]; const float* r_k = P.in[18]; const float* gn_w = P.in[19]; const float* gn_b = P.in[20];
  bfr* mix = (bfr*)(P.ws + WS_H);
  const int wid = threadIdx.x >> 6, lane = threadIdx.x & 63;
  for (int t = bid * 4 + wid; t < T_LAT; t += nb * 4) {
    {
      float o[8]; float ss = 0.f;
#pragma unroll
      for (int e = 0; e < 8; ++e) { const long idx = (long)t * 512 + lane * 8 + e; o[e] = Of[idx] + Ob[idx]; ss += o[e] * o[e]; }
      ss += __shfl_xor(ss, 1); ss += __shfl_xor(ss, 2); ss += __shfl_xor(ss, 4); ss += __shfl_xor(ss, 8);
      const float rs = rsqrtf(ss * (1.f / 128.f) + 1e-6f);
      unsigned w[4];
#pragma unroll
      for (int e = 0; e < 8; e += 2) {
        const int c0 = lane * 8 + e;
        const float g0 = bf2f(p[(long)t * DIN + 2048 + c0]), g1 = bf2f(p[(long)t * DIN + 2048 + c0 + 1]);
        const float v0 = o[e] * rs * hg_norm_w[c0] * siluf_(g0);
        const float v1 = o[e + 1] * rs * hg_norm_w[c0 + 1] * siluf_(g1);
        w[e >> 1] = pack2(v0, v1);
      }
      *(uint4*)(mix + (long)t * DM + lane * 8) = uint4{w[0], w[1], w[2], w[3]};
    }
    {
      float y[8]; float s = 0.f, bs = 0.f;
      float vv[8];
#pragma unroll
      for (int e = 0; e < 8; ++e) {
        const long idx = (long)t * 512 + lane * 8 + e;
        y[e] = Yf[idx] + Yb[idx]; s += y[e];
        bs += bf2f(R[idx]) * bf2f(K[idx]) * r_k[lane * 8 + e];
        vv[e] = bf2f(V[idx]);
      }
      s += __shfl_xor(s, 1); s += __shfl_xor(s, 2); s += __shfl_xor(s, 4);
      bs += __shfl_xor(bs, 1); bs += __shfl_xor(bs, 2); bs += __shfl_xor(bs, 4);
      const float mu = s * (1.f / 64.f);
      float q = 0.f;
#pragma unroll
      for (int e = 0; e < 8; ++e) { y[e] -= mu; q += y[e] * y[e]; }
      q += __shfl_xor(q, 1); q += __shfl_xor(q, 2); q += __shfl_xor(q, 4);
      const float rs = rsqrtf(q * (1.f / 64.f) + 64e-5f);
      unsigned w[4];
#pragma unroll
      for (int e = 0; e < 8; e += 2) {
        const int c0 = lane * 8 + e;
        const long idx = (long)t * 512 + c0;
        const float v0 = (y[e] * rs * gn_w[c0] + gn_b[c0] + bs * vv[e]) * bf2f(G[idx]);
        const float v1 = (y[e + 1] * rs * gn_w[c0 + 1] + gn_b[c0 + 1] + bs * vv[e + 1]) * bf2f(G[idx + 1]);
        w[e >> 1] = pack2(v0, v1);
      }
      *(uint4*)(mix + (long)t * DM + 512 + lane * 8) = uint4{w[0], w[1], w[2], w[3]};
    }
  }
}

DI void phase_outproj(const Params& P, int bid, int nb, char* smem) {
  const bfr* mix = (const bfr*)(P.ws + WS_H);
  const float* w_out = P.in[7];
  float* y = (float*)(P.ws + WS_Y);
  short* sA = (short*)smem; short* sB = sA + 128 * LSTR;
  const int tid = threadIdx.x, wid = tid >> 6, lane = tid & 63;
  const int wr = wid >> 1, wc = wid & 1, fr = lane & 15, fq = lane >> 4;
  constexpr int NT = 8, MT = T_LAT / 128;
  for (int it = bid; it < NT * MT; it += nb) {
    const int mt = it / NT, nt = it % NT;
    ALoadBf16 al; BLoadF32 bl;
#pragma unroll
    for (int i = 0; i < 4; ++i) al.rp[i] = mix + (long)(mt * 128 + (tid >> 3) + 32 * i) * DM + (tid & 7) * 8;
    bl.valid = true; bl.ldb = DM;
    bl.p = w_out + (long)((tid & 7) * 8) * DM + nt * 128 + (tid >> 3) * 4;
    f32x4 acc[4][4];
    gemm_mainloop(sA, sB, DM / 64, al, bl, acc);
#pragma unroll
    for (int m = 0; m < 4; ++m)
#pragma unroll
      for (int n = 0; n < 4; ++n)
#pragma unroll
        for (int j = 0; j < 4; ++j) {
          const int rr = mt * 128 + wr * 64 + m * 16 + fq * 4 + j, cc = nt * 128 + wc * 64 + n * 16 + fr;
          y[(long)rr * DM + cc] = acc[m][n][j];
        }
  }
}

DI void phase_ln2route(const Params& P, int bid, int nb) {
  const float* x = P.in[0];
  const float* y = (const float*)(P.ws + WS_Y);
  const float* mod = (const float*)(P.ws + WS_MOD);
  const float* ln1_g = P.in[21]; const float* ln1_b = P.in[22];
  const float* wgrp = P.in[25]; const float* bgrp = P.in[26]; const float* wrt = P.in[27]; const float* brt = P.in[28];
  float* x1 = P.out;
  bfr* h2 = (bfr*)(P.ws + WS_H2);
  int* cnt = (int*)(P.ws + WS_CNT); int* list = (int*)(P.ws + WS_LIST); float* asgw = (float*)(P.ws + WS_ASGW);
  const int wid = threadIdx.x >> 6, lane = threadIdx.x & 63;
  for (int t = bid * 4 + wid; t < T_LAT; t += nb * 4) {
    f32x4 v[4]; float s = 0.f;
#pragma unroll
    for (int i = 0; i < 4; ++i) {
      const int c = lane * 4 + 256 * i;
      f32x4 xv = *(const f32x4*)(x + (long)t * DM + c), yv = *(const f32x4*)(y + (long)t * DM + c), g1 = *(const f32x4*)(mod + 2048 + c);
      v[i] = xv * DN_ALPHA + g1 * yv;
      s += v[i][0] + v[i][1] + v[i][2] + v[i][3];
    }
    float mu = wave_sum(s) * (1.f / DM); float q = 0.f;
#pragma unroll
    for (int i = 0; i < 4; ++i) { v[i] -= mu; q += v[i][0] * v[i][0] + v[i][1] * v[i][1] + v[i][2] * v[i][2] + v[i][3] * v[i][3]; }
    float rs = rsqrtf(wave_sum(q) * (1.f / DM) + 1e-5f);
    s = 0.f;
#pragma unroll
    for (int i = 0; i < 4; ++i) {
      const int c = lane * 4 + 256 * i;
      f32x4 g = *(const f32x4*)(ln1_g + c), b = *(const f32x4*)(ln1_b + c);
      v[i] = v[i] * rs * g + b;
      *(f32x4*)(x1 + (long)t * DM + c) = v[i];
      s += v[i][0] + v[i][1] + v[i][2] + v[i][3];
    }
    mu = wave_sum(s) * (1.f / DM); q = 0.f;
#pragma unroll
    for (int i = 0; i < 4; ++i) { v[i] -= mu; q += v[i][0] * v[i][0] + v[i][1] * v[i][1] + v[i][2] * v[i][2] + v[i][3] * v[i][3]; }
    rs = rsqrtf(wave_sum(q) * (1.f / DM) + 1e-5f);
#pragma unroll
    for (int i = 0; i < 4; ++i) {
      const int c = lane * 4 + 256 * i;
      f32x4 sh = *(const f32x4*)(mod + 3072 + c), sc = *(const f32x4*)(mod + 4096 + c);
      v[i] = v[i] * rs * (sc + 1.f) + sh;
      uint2 w = {pack2(v[i][0], v[i][1]), pack2(v[i][2], v[i][3])};
      *(uint2*)(h2 + (long)t * DM + c) = w;
    }
    float gl[8];
#pragma unroll
    for (int g = 0; g < 8; ++g) gl[g] = 0.f;
#pragma unroll
    for (int i = 0; i < 4; ++i)
#pragma unroll
      for (int e = 0; e < 4; ++e) {
        const int k = lane * 4 + 256 * i + e;
        const f32x4 w0 = *(const f32x4*)(wgrp + k * 8), w1 = *(const f32x4*)(wgrp + k * 8 + 4);
        const float hv = v[i][e];
        gl[0] += hv * w0[0]; gl[1] += hv * w0[1]; gl[2] += hv * w0[2]; gl[3] += hv * w0[3];
        gl[4] += hv * w1[0]; gl[5] += hv * w1[1]; gl[6] += hv * w1[2]; gl[7] += hv * w1[3];
      }
    int gi = 0; float gmax = -3.4e38f;
#pragma unroll
    for (int g = 0; g < 8; ++g) { gl[g] = wave_sum(gl[g]) + bgrp[g]; if (gl[g] > gmax) { gmax = gl[g]; gi = g; } }
    float den = 0.f;
#pragma unroll
    for (int g = 0; g < 8; ++g) den += __expf(gl[g] - gmax);
    const float gprob = 1.f / den;
    float el[8];
#pragma unroll
    for (int g = 0; g < 8; ++g) el[g] = 0.f;
#pragma unroll
    for (int i = 0; i < 4; ++i)
#pragma unroll
      for (int e = 0; e < 4; ++e) {
        const int k = lane * 4 + 256 * i + e;
        const f32x4 w0 = *(const f32x4*)(wrt + k * 64 + gi * 8), w1 = *(const f32x4*)(wrt + k * 64 + gi * 8 + 4);
        const float hv = v[i][e];
        el[0] += hv * w0[0]; el[1] += hv * w0[1]; el[2] += hv * w0[2]; el[3] += hv * w0[3];
        el[4] += hv * w1[0]; el[5] += hv * w1[1]; el[6] += hv * w1[2]; el[7] += hv * w1[3];
      }
    int i1 = 0; float v1 = -3.4e38f;
#pragma unroll
    for (int g = 0; g < 8; ++g) { el[g] = wave_sum(el[g]) + brt[gi * 8 + g]; if (el[g] > v1) { v1 = el[g]; i1 = g; } }
    int i2 = 0; float v2 = -3.4e38f;
#pragma unroll
    for (int g = 0; g < 8; ++g) { if (g != i1 && el[g] > v2) { v2 = el[g]; i2 = g; } }
    const float e2 = __expf(v2 - v1);
    const float wt1 = gprob / (1.f + e2), wt2 = gprob * e2 / (1.f + e2);
    if (lane == 0) {
      const int ex1 = gi * 8 + i1, ex2 = gi * 8 + i2;
      int s1 = atomicAdd(&cnt[ex1], 1); list[ex1 * T_LAT + s1] = t * 2;
      int s2 = atomicAdd(&cnt[ex2], 1); list[ex2 * T_LAT + s2] = t * 2 + 1;
      asgw[t * 2] = wt1; asgw[t * 2 + 1] = wt2;
    }
  }
}

DI void moe_block_table(const Params& P, int* tab  ) {
  const int* cnt = (const int*)(P.ws + WS_CNT);
  const int tid = threadIdx.x;
  __syncthreads();
  if (tid < 64) {
    int nbk = (cnt[tid] + 127) >> 7;
    int incl = nbk;
#pragma unroll
    for (int o = 1; o < 64; o <<= 1) { int u = __shfl_up(incl, o); if (tid >= o) incl += u; }
    tab[tid + 1] = incl;
    if (tid == 0) tab[0] = 0;
  }
  __syncthreads();
}
DI int moe_find_expert(const int* tab, int rb) {
  int e = 0;
  while (tab[e + 1] <= rb) ++e;
  return e;
}

DI void phase_moe1(const Params& P, int bid, int nb, char* smem) {
  const bfr* h2 = (const bfr*)(P.ws + WS_H2);
  const int* cnt = (const int*)(P.ws + WS_CNT); const int* list = (const int*)(P.ws + WS_LIST);
  const float* wg = P.in[29]; const float* wu = P.in[30];
  bfr* hid = (bfr*)(P.ws + WS_HID);
  short* sA = (short*)smem; short* sB = sA + 128 * LSTR;
  int* tab = (int*)(smem + GEMM_LDS_BYTES);
  const int tid = threadIdx.x, wid = tid >> 6, lane = tid & 63;
  const int wr = wid >> 1, wc = wid & 1, fr = lane & 15, fq = lane >> 4;
  moe_block_table(P, tab);
  const int nrb = tab[64];
  for (int it = bid; it < nrb * 8; it += nb) {
    const int rb = it >> 3, nt = it & 7;
    const int e = moe_find_expert(tab, rb);
    const int lrb = rb - tab[e];
    const int ce = cnt[e];
    ALoadBf16 al; BLoadF32 bl;
#pragma unroll
    for (int i = 0; i < 4; ++i) {
      int r = lrb * 128 + (tid >> 3) + 32 * i;
      if (r >= ce) r = ce - 1;
      const int tok = list[e * T_LAT + r] >> 1;
      al.rp[i] = h2 + (long)tok * DM + (tid & 7) * 8;
    }
    const int n4 = tid >> 3;
    const int isup = (n4 >> 3) & 1;
    const int col = nt * 64 + (n4 >> 4) * 32 + ((4 * n4) & 31);
    bl.valid = true; bl.ldb = DEXP;
    bl.p = (isup ? wu : wg) + (long)e * DM * DEXP + (long)((tid & 7) * 8) * DEXP + col;
    f32x4 acc[4][4];
    gemm_mainloop(sA, sB, DM / 64, al, bl, acc);
#pragma unroll
    for (int m = 0; m < 4; ++m)
#pragma unroll
      for (int n = 0; n < 2; ++n)
#pragma unroll
        for (int j = 0; j < 4; ++j) {
          const int rl = wr * 64 + m * 16 + fq * 4 + j;
          const int cc = nt * 64 + wc * 32 + n * 16 + fr;
          const float gv = acc[m][n][j], uv = acc[m][n + 2][j];
          hid[((long)rb * 128 + rl) * DEXP + cc] = f2bf(siluf_(gv) * uv);
        }
  }
}

DI void phase_moe2(const Params& P, int bid, int nb, char* smem) {
  const int* cnt = (const int*)(P.ws + WS_CNT); const int* list = (const int*)(P.ws + WS_LIST);
  const float* wd = P.in[31];
  const bfr* hid = (const bfr*)(P.ws + WS_HID);
  bfr* mout = (bfr*)(P.ws + WS_MOUT);
  short* sA = (short*)smem; short* sB = sA + 128 * LSTR;
  int* tab = (int*)(smem + GEMM_LDS_BYTES);
  const int tid = threadIdx.x, wid = tid >> 6, lane = tid & 63;
  const int wr = wid >> 1, wc = wid & 1, fr = lane & 15, fq = lane >> 4;
  moe_block_table(P, tab);
  const int nrb = tab[64];
  for (int it = bid; it < nrb * 8; it += nb) {
    const int rb = it >> 3, nt = it & 7;
    const int e = moe_find_expert(tab, rb);
    const int lrb = rb - tab[e];
    const int ce = cnt[e];
    ALoadBf16 al; BLoadF32 bl;
#pragma unroll
    for (int i = 0; i < 4; ++i) al.rp[i] = hid + ((long)rb * 128 + (tid >> 3) + 32 * i) * DEXP + (tid & 7) * 8;
    bl.valid = true; bl.ldb = DM;
    bl.p = wd + (long)e * DEXP * DM + (long)((tid & 7) * 8) * DM + nt * 128 + (tid >> 3) * 4;
    f32x4 acc[4][4];
    gemm_mainloop(sA, sB, DEXP / 64, al, bl, acc);
#pragma unroll
    for (int m = 0; m < 4; ++m)
#pragma unroll
      for (int j = 0; j < 4; ++j) {
        const int r = lrb * 128 + wr * 64 + m * 16 + fq * 4 + j;
        if (r < ce) {
          const int asg = list[e * T_LAT + r];
#pragma unroll
          for (int n = 0; n < 4; ++n) mout[(long)asg * DM + nt * 128 + wc * 64 + n * 16 + fr] = f2bf(acc[m][n][j]);
        }
      }
  }
}

DI void phase_final(const Params& P, int bid, int nb) {
  const float* mod = (const float*)(P.ws + WS_MOD);
  const float* ln2_g = P.in[23]; const float* ln2_b = P.in[24];
  const bfr* mout = (const bfr*)(P.ws + WS_MOUT);
  const float* asgw = (const float*)(P.ws + WS_ASGW);
  float* out = P.out;
  const int wid = threadIdx.x >> 6, lane = threadIdx.x & 63;
  for (int t = bid * 4 + wid; t < T_LAT; t += nb * 4) {
    const float w1 = asgw[t * 2], w2 = asgw[t * 2 + 1];
    f32x4 v[4]; float s = 0.f;
#pragma unroll
    for (int i = 0; i < 4; ++i) {
      const int c = lane * 4 + 256 * i;
      f32x4 xv = *(const f32x4*)(out + (long)t * DM + c), g2 = *(const f32x4*)(mod + 5120 + c);
      const uint2 m1 = *(const uint2*)(mout + (long)(2 * t) * DM + c), m2 = *(const uint2*)(mout + (long)(2 * t + 1) * DM + c);
      f32x4 a = {__uint_as_float(m1.x << 16), __uint_as_float(m1.x & 0xffff0000u), __uint_as_float(m1.y << 16), __uint_as_float(m1.y & 0xffff0000u)};
      f32x4 b = {__uint_as_float(m2.x << 16), __uint_as_float(m2.x & 0xffff0000u), __uint_as_float(m2.y << 16), __uint_as_float(m2.y & 0xffff0000u)};
      v[i] = xv * DN_ALPHA + g2 * (a * w1 + b * w2);
      s += v[i][0] + v[i][1] + v[i][2] + v[i][3];
    }
    const float mu = wave_sum(s) * (1.f / DM); float q = 0.f;
#pragma unroll
    for (int i = 0; i < 4; ++i) { v[i] -= mu; q += v[i][0] * v[i][0] + v[i][1] * v[i][1] + v[i][2] * v[i][2] + v[i][3] * v[i][3]; }
    const float rs = rsqrtf(wave_sum(q) * (1.f / DM) + 1e-5f);
#pragma unroll
    for (int i = 0; i < 4; ++i) {
      const int c = lane * 4 + 256 * i;
      f32x4 g = *(const f32x4*)(ln2_g + c), b = *(const f32x4*)(ln2_b + c);
      *(f32x4*)(out + (long)t * DM + c) = v[i] * rs * g + b;
    }
  }
}

namespace cg = cooperative_groups;
constexpr int SMEM_BYTES = 40960;
__global__ void __launch_bounds__(NTHR, 2) k_fused(Params P) {
  __shared__ __attribute__((aligned(16))) char smem[SMEM_BYTES];
  cg::grid_group grid = cg::this_grid();
  const int bid = blockIdx.x, nb = gridDim.x;
  phase_mod(P, bid, nb, smem);
  grid.sync();
  phase_ln1(P, bid, nb);
  grid.sync();
  phase_pgemm(P, bid, nb, smem);
  grid.sync();
  phase_rwprep(P, bid, nb, smem);
  grid.sync();
  if (bid < 16) rwkv_chain_naive(P, bid, smem); else if (bid < 24) hgrn_chain_naive(P, bid - 16, smem);
  grid.sync();
  phase_readout(P, bid, nb);
  grid.sync();
  phase_outproj(P, bid, nb, smem);
  grid.sync();
  phase_ln2route(P, bid, nb);
  grid.sync();
  phase_moe1(P, bid, nb, smem);
  grid.sync();
  phase_moe2(P, bid, nb, smem);
  grid.sync();
  phase_final(P, bid, nb);
}

extern "C" void kernel_launch(void* const* d_in, const int* in_sizes, int n_in, void* d_out, int out_size, void* d_ws, size_t ws_size, hipStream_t stream) {
  static int grid_blocks = 0;
  if (!grid_blocks) {
    int dev = 0, cus = 0, per_cu = 0;
    hipGetDevice(&dev);
    hipDeviceGetAttribute(&cus, hipDeviceAttributeMultiprocessorCount, dev);
    hipOccupancyMaxActiveBlocksPerMultiprocessor(&per_cu, k_fused, NTHR, 0);
    if (per_cu > 2) per_cu = 2;
    if (per_cu < 1) per_cu = 1;
    grid_blocks = cus * per_cu;
  }
  Params P{};
  for (int i = 0; i < 32; ++i) P.in[i] = (const float*)d_in[i];
  P.out = (float*)d_out; P.ws = (char*)d_ws;
  void* args[] = {&P};
  hipError_t e = hipLaunchCooperativeKernel((void*)k_fused, dim3(grid_blocks), dim3(NTHR), args, 0, stream);
  if (e != hipSuccess) fprintf(stderr, "cooperative launch failed: %s (grid %d)\n", hipGetErrorString(e), grid_blocks);
}
```

```cpp
#include <hip/hip_runtime.h>
#include <hip/hip_cooperative_groups.h>
#include <cstdio>

typedef __attribute__((ext_vector_type(8))) short bf16x8;
typedef __attribute__((ext_vector_type(4))) short s16x4;
typedef __attribute__((ext_vector_type(4))) float f32x4;
typedef __attribute__((ext_vector_type(2))) float f32x2;
typedef __attribute__((ext_vector_type(2))) __bf16 bf16x2_t;
typedef unsigned short bfr;

#define DI __device__ __forceinline__

constexpr int T_LAT = 16384, T_CTX = 256, T_ALL = T_LAT + T_CTX;
constexpr int DM = 1024, DIN = 4288, HGC = 2560, RWC = 1728, DRW = 512, DHG = 512;
constexpr int NEXP = 64, DEXP = 512;
constexpr int NTHR = 256;
constexpr float DN_ALPHA = 1.189207115002721f;
constexpr float RW_DECAY_SCALE = 0.6065306597126334f;

constexpr size_t MB = 1ull << 20;
constexpr size_t WS_MOD = 0;
constexpr size_t WS_MODC = 32768;
constexpr size_t WS_LB = 65536;
constexpr size_t WS_CNT = 65536 + 8192;
constexpr size_t WS_ASGW = 131072;
constexpr size_t WS_LIST = 1 * MB;
constexpr size_t WS_H = 6 * MB;
constexpr size_t WS_P = 42 * MB;
constexpr size_t WS_Y = 42 * MB;
constexpr size_t WS_H2 = 106 * MB;
constexpr size_t WS_HID = 138 * MB;
constexpr size_t WS_RW = 186 * MB;
constexpr size_t RW_ARR = (size_t)T_ALL * 512 * 2;
constexpr size_t WS_LW = 284 * MB;
constexpr size_t LW_ARR = (size_t)T_ALL * 512 * 4;
constexpr size_t WS_YRW = 350 * MB;
constexpr size_t WS_OHG = 414 * MB;
constexpr size_t WS_MOUT = 186 * MB;

struct Params {
  const float* in[32];
  float* out;
  char* ws;
};

DI unsigned pack2(float a, float b) {
  f32x2 v = {a, b};
  bf16x2_t r = __builtin_convertvector(v, bf16x2_t);
  return __builtin_bit_cast(unsigned, r);
}
DI bfr f2bf(float a) { return (bfr)(pack2(a, 0.f) & 0xffffu); }
DI float bf2f(bfr v) { return __uint_as_float(((unsigned)v) << 16); }
DI float sigmoidf_(float x) { return 1.f / (1.f + __expf(-x)); }
DI float siluf_(float x) { return x / (1.f + __expf(-x)); }
DI float wave_sum(float v) {
#pragma unroll
  for (int o = 32; o > 0; o >>= 1) v += __shfl_xor(v, o);
  return v;
}

constexpr int LSTR = 72;
constexpr int GEMM_LDS_BYTES = 2 * 128 * LSTR * 2;

struct ALoadBf16 {
  const bfr* rp[4];
  bf16x8 r[4];
  DI void load(int kt) {
#pragma unroll
    for (int i = 0; i < 4; ++i) r[i] = *(const bf16x8*)(rp[i] + kt * 64);
  }
  DI void store(short* sA) const {
    const int tid = threadIdx.x;
#pragma unroll
    for (int i = 0; i < 4; ++i) *(bf16x8*)(sA + ((tid >> 3) + 32 * i) * LSTR + (tid & 7) * 8) = r[i];
  }
};

struct BLoadF32 {
  const float* p;
  long ldb;
  bool valid;
  f32x4 v[8];
  DI void load(int kt) {
#pragma unroll
    for (int j = 0; j < 8; ++j) {
      if (valid) v[j] = *(const f32x4*)(p + ((long)kt * 64 + j) * ldb);
      else v[j] = f32x4{0.f, 0.f, 0.f, 0.f};
    }
  }
  DI void store(short* sB) const {
    const int tid = threadIdx.x, kg = tid & 7, n4 = tid >> 3;
#pragma unroll
    for (int i = 0; i < 4; ++i) {
      unsigned a0 = pack2(v[0][i], v[1][i]), a1 = pack2(v[2][i], v[3][i]);
      unsigned a2 = pack2(v[4][i], v[5][i]), a3 = pack2(v[6][i], v[7][i]);
      typedef __attribute__((ext_vector_type(4))) unsigned u32x4;
      u32x4 w = {a0, a1, a2, a3};
      *(u32x4*)(sB + (4 * n4 + i) * LSTR + kg * 8) = w;
    }
  }
};

template <class AL, class BL>
DI void gemm_mainloop(short* sA, short* sB, int nk, AL& al, BL& bl, f32x4 (&acc)[4][4]) {
  const int tid = threadIdx.x, wid = tid >> 6, lane = tid & 63;
  const int wr = wid >> 1, wc = wid & 1, fr = lane & 15, fq = lane >> 4;
#pragma unroll
  for (int m = 0; m < 4; ++m)
#pragma unroll
    for (int n = 0; n < 4; ++n) acc[m][n] = f32x4{0.f, 0.f, 0.f, 0.f};
  al.load(0); bl.load(0);
  for (int kt = 0; kt < nk; ++kt) {
    __syncthreads();
    al.store(sA); bl.store(sB);
    __syncthreads();
    if (kt + 1 < nk) { al.load(kt + 1); bl.load(kt + 1); }
#pragma unroll
    for (int ks = 0; ks < 2; ++ks) {
      bf16x8 af[4], bf[4];
#pragma unroll
      for (int m = 0; m < 4; ++m) af[m] = *(const bf16x8*)(sA + (wr * 64 + m * 16 + fr) * LSTR + ks * 32 + fq * 8);
#pragma unroll
      for (int n = 0; n < 4; ++n) bf[n] = *(const bf16x8*)(sB + (wc * 64 + n * 16 + fr) * LSTR + ks * 32 + fq * 8);
#pragma unroll
      for (int m = 0; m < 4; ++m)
#pragma unroll
        for (int n = 0; n < 4; ++n) acc[m][n] = __builtin_amdgcn_mfma_f32_16x16x32_bf16(af[m], bf[n], acc[m][n], 0, 0, 0);
    }
  }
}

DI void phase_mod(const Params& P, int bid, int nb, char* smem) {
  const float* c = P.in[1]; const float* cc = P.in[3];
  const float* w_mod = P.in[4]; const float* b_mod = P.in[5];
  float* mod = (float*)(P.ws + WS_MOD); float* modc = (float*)(P.ws + WS_MODC);
  float* red = (float*)smem;
  const int tid = threadIdx.x;
  for (int it = bid; it < 194; it += nb) {
    if (it < 192) {
      const int kq = tid >> 3, c4 = tid & 7;
      const int col = it * 32 + c4 * 4;
      f32x4 a1 = {0, 0, 0, 0}, a2 = {0, 0, 0, 0};
      for (int k = kq; k < DM; k += 32) {
        f32x4 w = *(const f32x4*)(w_mod + (long)k * 6144 + col);
        float s1 = siluf_(c[k]), s2 = siluf_(cc[k]);
        a1 += w * s1; a2 += w * s2;
      }
      __syncthreads();
#pragma unroll
      for (int e = 0; e < 4; ++e) { red[(kq * 32) + c4 * 4 + e] = a1[e]; red[1024 + kq * 32 + c4 * 4 + e] = a2[e]; }
      __syncthreads();
      if (tid < 64) {
        const int which = tid >> 5, cl = tid & 31;
        float s = 0.f;
        for (int q = 0; q < 32; ++q) s += red[which * 1024 + q * 32 + cl];
        const int cg = it * 32 + cl;
        s += b_mod[cg];
        if (which == 0) mod[cg] = s; else modc[cg] = s;
      }
    } else if (it == 192) {
      const float* L = P.in[8];
      float* lb = (float*)(P.ws + WS_LB);
      for (int i = tid; i < 1024; i += NTHR) {
        const int d = i >> 9, j = i & 511;
        float l0 = L[d * 1024 + j], l1 = L[d * 1024 + 512 + j];
        lb[i] = 1.f / (1.f + __expf(l1 - l0));
      }
    } else {
      int* cnt = (int*)(P.ws + WS_CNT);
      if (tid < 64) cnt[tid] = 0;
    }
  }
}

DI void phase_ln1(const Params& P, int bid, int nb) {
  const float* x = P.in[0]; const float* ctx = P.in[2];
  const float* mod = (const float*)(P.ws + WS_MOD); const float* modc = (const float*)(P.ws + WS_MODC);
  bfr* h = (bfr*)(P.ws + WS_H);
  const int wid = threadIdx.x >> 6, lane = threadIdx.x & 63;
  for (int row = bid * 4 + wid; row < T_ALL; row += nb * 4) {
    const float* src = row < T_LAT ? x + (long)row * DM : ctx + (long)(row - T_LAT) * DM;
    const float* mm = row < T_LAT ? mod : modc;
    f32x4 v[4];
    float s = 0.f;
#pragma unroll
    for (int i = 0; i < 4; ++i) { v[i] = *(const f32x4*)(src + lane * 4 + 256 * i); s += v[i][0] + v[i][1] + v[i][2] + v[i][3]; }
    const float mu = wave_sum(s) * (1.f / DM);
    float q = 0.f;
#pragma unroll
    for (int i = 0; i < 4; ++i) { v[i] -= mu; q += v[i][0] * v[i][0] + v[i][1] * v[i][1] + v[i][2] * v[i][2] + v[i][3] * v[i][3]; }
    const float rs = rsqrtf(wave_sum(q) * (1.f / DM) + 1e-5f);
#pragma unroll
    for (int i = 0; i < 4; ++i) {
      const int cidx = lane * 4 + 256 * i;
      f32x4 sh = *(const f32x4*)(mm + cidx), sc = *(const f32x4*)(mm + 1024 + cidx);
      f32x4 o = v[i] * rs * (sc + 1.f) + sh;
      uint2 w = {pack2(o[0], o[1]), pack2(o[2], o[3])};
      *(uint2*)(h + (long)row * DM + cidx) = w;
    }
  }
}

DI void phase_pgemm(const Params& P, int bid, int nb, char* smem) {
  const bfr* h = (const bfr*)(P.ws + WS_H);
  const float* w_in = P.in[6];
  bfr* p = (bfr*)(P.ws + WS_P);
  short* sA = (short*)smem; short* sB = sA + 128 * LSTR;
  const int tid = threadIdx.x, wid = tid >> 6, lane = tid & 63;
  const int wr = wid >> 1, wc = wid & 1, fr = lane & 15, fq = lane >> 4;
  constexpr int NT = 34, MT = T_ALL / 128;
  for (int it = bid; it < NT * MT; it += nb) {
    const int mt = it / NT, nt = it % NT;
    ALoadBf16 al; BLoadF32 bl;
#pragma unroll
    for (int i = 0; i < 4; ++i) al.rp[i] = h + (long)(mt * 128 + (tid >> 3) + 32 * i) * DM + (tid & 7) * 8;
    const int col = nt * 128 + (tid >> 3) * 4;
    bl.valid = col < DIN; bl.ldb = DIN;
    bl.p = w_in + (long)((tid & 7) * 8) * DIN + (bl.valid ? col : 0);
    f32x4 acc[4][4];
    gemm_mainloop(sA, sB, DM / 64, al, bl, acc);
#pragma unroll
    for (int m = 0; m < 4; ++m)
#pragma unroll
      for (int n = 0; n < 4; ++n) {
        const int cc = nt * 128 + wc * 64 + n * 16 + fr;
        if (cc < DIN) {
#pragma unroll
          for (int j = 0; j < 4; ++j) {
            const int rr = mt * 128 + wr * 64 + m * 16 + fq * 4 + j;
            p[(long)rr * DIN + cc] = f2bf(acc[m][n][j]);
          }
        }
      }
  }
}

DI float rw_mixed(const bfr* p, int row, int c, const float* mu) {
  const long base = (long)row * DIN + HGC + c;
  const float pc = bf2f(p[base]);
  float nbv;
  if (row < T_LAT) {
    const int gr = row >> 6, gc = row & 63;
    float s = 0.f;
    if (gr > 0) s += bf2f(p[base - 64l * DIN]);
    if (gr < 255) s += bf2f(p[base + 64l * DIN]);
    if (gc > 0) s += bf2f(p[base - DIN]);
    if (gc < 63) s += bf2f(p[base + DIN]);
    nbv = 0.25f * s;
  } else {
    const int sidx = row - T_LAT;
    float s = 0.f;
    if (sidx > 0) s += bf2f(p[base - DIN]);
    if (sidx < T_CTX - 1) s += bf2f(p[base + DIN]);
    nbv = 0.5f * s;
  }
  return pc + (nbv - pc) * mu[c];
}

constexpr int RWP_TOK = 16;
DI void phase_rwprep(const Params& P, int bid, int nb, char* smem) {
  const bfr* p = (const bfr*)(P.ws + WS_P);
  const float* mu = P.in[10]; const float* w0 = P.in[11]; const float* wd2 = P.in[12];
  const float* a0 = P.in[13]; const float* wa2 = P.in[14]; const float* wg2 = P.in[15];
  const float* k_k = P.in[16]; const float* k_a = P.in[17];
  bfr* R = (bfr*)(P.ws + WS_RW); bfr* K = (bfr*)(P.ws + WS_RW + RW_ARR); bfr* V = (bfr*)(P.ws + WS_RW + 2 * RW_ARR);
  bfr* KK = (bfr*)(P.ws + WS_RW + 3 * RW_ARR); bfr* A = (bfr*)(P.ws + WS_RW + 4 * RW_ARR); bfr* G = (bfr*)(P.ws + WS_RW + 5 * RW_ARR);
  float* LWF = (float*)(P.ws + WS_LW); float* LWB = (float*)(P.ws + WS_LW + LW_ARR);
  float* lo = (float*)smem;
  const int tid = threadIdx.x;
  for (int it = bid; it < T_ALL / RWP_TOK; it += nb) {
    const int row0 = it * RWP_TOK;
    __syncthreads();
    for (int i = tid; i < RWP_TOK * 192; i += NTHR) {
      const int tk = i / 192, j = i % 192;
      float v = rw_mixed(p, row0 + tk, 1536 + j, mu);
      if (j < 64) v = tanhf(v);
      else if (j >= 96) v = sigmoidf_(v);
      lo[i] = v;
    }
    __syncthreads();
    float av[RWP_TOK][2];
#pragma unroll
    for (int d = 0; d < 2; ++d) {
      float acc[RWP_TOK][2];
#pragma unroll
      for (int t = 0; t < RWP_TOK; ++t) { acc[t][0] = 0.f; acc[t][1] = 0.f; }
      for (int j = 0; j < 32; ++j) {
        const float wA = wd2[(d * 32 + j) * 512 + tid], wB = wd2[(d * 32 + j) * 512 + tid + 256];
#pragma unroll
        for (int t = 0; t < RWP_TOK; ++t) { const float xv = lo[t * 192 + d * 32 + j]; acc[t][0] += xv * wA; acc[t][1] += xv * wB; }
      }
      float* LW = d == 0 ? LWF : LWB;
#pragma unroll
      for (int t = 0; t < RWP_TOK; ++t)
#pragma unroll
        for (int hh = 0; hh < 2; ++hh) {
          const int ch = tid + 256 * hh;
          const float wl = w0[d * 512 + ch] + acc[t][hh];
          LW[(long)(row0 + t) * 512 + ch] = -RW_DECAY_SCALE * sigmoidf_(wl);
        }
    }
    {
#pragma unroll
      for (int t = 0; t < RWP_TOK; ++t) { av[t][0] = 0.f; av[t][1] = 0.f; }
      for (int j = 0; j < 32; ++j) {
        const float wA = wa2[j * 512 + tid], wB = wa2[j * 512 + tid + 256];
#pragma unroll
        for (int t = 0; t < RWP_TOK; ++t) { const float xv = lo[t * 192 + 64 + j]; av[t][0] += xv * wA; av[t][1] += xv * wB; }
      }
#pragma unroll
      for (int t = 0; t < RWP_TOK; ++t)
#pragma unroll
        for (int hh = 0; hh < 2; ++hh) av[t][hh] = sigmoidf_(a0[tid + 256 * hh] + av[t][hh]);
    }
    {
      float acc[RWP_TOK][2];
#pragma unroll
      for (int t = 0; t < RWP_TOK; ++t) { acc[t][0] = 0.f; acc[t][1] = 0.f; }
      for (int j = 0; j < 96; ++j) {
        const float wA = wg2[j * 512 + tid], wB = wg2[j * 512 + tid + 256];
#pragma unroll
        for (int t = 0; t < RWP_TOK; ++t) { const float xv = lo[t * 192 + 96 + j]; acc[t][0] += xv * wA; acc[t][1] += xv * wB; }
      }
#pragma unroll
      for (int t = 0; t < RWP_TOK; ++t)
#pragma unroll
        for (int hh = 0; hh < 2; ++hh) G[(long)(row0 + t) * 512 + tid + 256 * hh] = f2bf(acc[t][hh]);
    }
#pragma unroll
    for (int t = 0; t < RWP_TOK; ++t)
#pragma unroll
      for (int hh = 0; hh < 2; ++hh) {
        const int ch = tid + 256 * hh;
        const int row = row0 + t;
        const float r = rw_mixed(p, row, ch, mu);
        const float kraw = rw_mixed(p, row, 512 + ch, mu);
        const float v = rw_mixed(p, row, 1024 + ch, mu);
        const float kkr = kraw * k_k[ch];
        const float ss = wave_sum(kkr * kkr);
        const float kk = kkr * rsqrtf(fmaxf(ss, 1e-12f));
        const float a = av[t][hh];
        const float k = kraw * (1.f + (a - 1.f) * k_a[ch]);
        const long o = (long)row * 512 + ch;
        R[o] = f2bf(r); K[o] = f2bf(k); V[o] = f2bf(v); KK[o] = f2bf(kk); A[o] = f2bf(a);
      }
  }
}

DI void rwkv_chain_naive(const Params& P, int chain, char* smem) {
  const int dir = chain >> 3, hd = chain & 7;
  const bfr* R = (const bfr*)(P.ws + WS_RW); const bfr* K = (const bfr*)(P.ws + WS_RW + RW_ARR); const bfr* V = (const bfr*)(P.ws + WS_RW + 2 * RW_ARR);
  const bfr* KK = (const bfr*)(P.ws + WS_RW + 3 * RW_ARR); const bfr* A = (const bfr*)(P.ws + WS_RW + 4 * RW_ARR);
  const float* LW = (const float*)(P.ws + WS_LW + (dir ? LW_ARR : 0));
  float* Y = (float*)(P.ws + WS_YRW) + (long)dir * T_LAT * 512;
  float* vec = (float*)smem;
  float* red = vec + 16 * 6 * 64;
  const int tid = threadIdx.x, i = tid & 63, jq = tid >> 6;
  float S[16];
#pragma unroll
  for (int j = 0; j < 16; ++j) S[j] = 0.f;
  for (int s0 = 0; s0 < T_ALL; s0 += 16) {
    __syncthreads();
    for (int e = tid; e < 16 * 64; e += NTHR) {
      const int st = e >> 6, j = e & 63;
      const int s = s0 + st;
      int row;
      if (s < T_CTX) row = T_LAT + (dir ? (T_CTX - 1 - s) : s);
      else row = dir ? (T_LAT - 1 - (s - T_CTX)) : (s - T_CTX);
      const long o = (long)row * 512 + hd * 64 + j;
      float* vp = vec + st * 384;
      const float kk = bf2f(KK[o]);
      vp[j] = bf2f(R[o]); vp[64 + j] = __expf(LW[o]); vp[128 + j] = bf2f(K[o]); vp[192 + j] = bf2f(V[o]);
      vp[256 + j] = kk; vp[320 + j] = kk * bf2f(A[o]);
    }
    __syncthreads();
    for (int st = 0; st < 16; ++st) {
      const float* vp = vec + st * 384;
      const int par = st & 1;
      float sa = 0.f;
#pragma unroll
      for (int j = 0; j < 16; ++j) sa += S[j] * vp[256 + jq * 16 + j];
      red[(par * 2 + 0) * 256 + jq * 64 + i] = sa;
      __syncthreads();
      sa = red[(par * 2) * 256 + i] + red[(par * 2) * 256 + 64 + i] + red[(par * 2) * 256 + 128 + i] + red[(par * 2) * 256 + 192 + i];
      const float vi = vp[192 + i];
      float y = 0.f;
#pragma unroll
      for (int j = 0; j < 16; ++j) {
        const int jj = jq * 16 + j;
        S[j] = S[j] * vp[64 + jj] - sa * vp[320 + jj] + vi * vp[128 + jj];
        y += S[j] * vp[jj];
      }
      red[(par * 2 + 1) * 256 + jq * 64 + i] = y;
      __syncthreads();
      const int s = s0 + st;
      if (jq == 0 && s >= T_CTX) {
        y = red[(par * 2 + 1) * 256 + i] + red[(par * 2 + 1) * 256 + 64 + i] + red[(par * 2 + 1) * 256 + 128 + i] + red[(par * 2 + 1) * 256 + 192 + i];
        const int row = dir ? (T_LAT - 1 - (s - T_CTX)) : (s - T_CTX);
        Y[(long)row * 512 + hd * 64 + i] = y;
      }
    }
  }
}

DI void hgrn_chain_naive(const Params& P, int chain, char* smem) {
  const int dir = chain >> 2, hd = chain & 3;
  const bfr* p = (const bfr*)(P.ws + WS_P);
  const float* lb = (const float*)(P.ws + WS_LB) + dir * 512 + hd * 128;
  float* O = (float*)(P.ws + WS_OHG) + (long)dir * T_LAT * 512;
  float* vec = (float*)smem;
  float* red = vec + 16 * 4 * 128;
  const int tid = threadIdx.x, e = tid & 127, dh = tid >> 7;
  float S[64];
#pragma unroll
  for (int d = 0; d < 64; ++d) S[d] = 0.f;
  for (int s0 = 0; s0 < T_ALL; s0 += 16) {
    __syncthreads();
    for (int x = tid; x < 16 * 128; x += NTHR) {
      const int st = x >> 7, d = x & 127;
      const int s = s0 + st;
      int row;
      if (s < T_CTX) row = T_LAT + (dir ? (T_CTX - 1 - s) : s);
      else row = dir ? (T_LAT - 1 - (s - T_CTX)) : (s - T_CTX);
      const bfr* pr = p + (long)row * DIN + hd * 128 + d;
      const float q = bf2f(pr[0]), iv = bf2f(pr[512]), z = bf2f(pr[1024 + dir * 512]);
      const float l = lb[d];
      const float f = l + (1.f - l) * sigmoidf_(z);
      float* vp = vec + st * 512;
      vp[d] = siluf_(q); vp[128 + d] = f; vp[256 + d] = (1.f - l) * sigmoidf_(-z); vp[384 + d] = iv;
    }
    __syncthreads();
    for (int st = 0; st < 16; ++st) {
      const float* vp = vec + st * 512;
      const int par = st & 1;
      const float ve = vp[384 + e];
      float o = 0.f;
#pragma unroll
      for (int d = 0; d < 64; ++d) {
        const int dd = dh * 64 + d;
        S[d] = S[d] * vp[128 + dd] + vp[256 + dd] * ve;
        o += vp[dd] * S[d];
      }
      red[par * 256 + dh * 128 + e] = o;
      __syncthreads();
      const int s = s0 + st;
      if (dh == 0 && s >= T_CTX) {
        o = red[par * 256 + e] + red[par * 256 + 128 + e];
        const int row = dir ? (T_LAT - 1 - (s - T_CTX)) : (s - T_CTX);
        O[(long)row * 512 + hd * 128 + e] = o;
      }
    }
  }
}

#define LDSP(T) __attribute__((address_space(3))) T*
DI int row_of_step(int dir, int s) {
  if (s < T_CTX) return T_LAT + (dir ? (T_CTX - 1 - s) : s);
  return dir ? (T_LAT - 1 - (s - T_CTX)) : (s - T_CTX);
}
DI bf16x8 ld_tr8(const short* base, int stride, int k0, int n0) {
  const int lane = threadIdx.x & 63, g = lane >> 4, q = (lane & 15) >> 2, p = lane & 3;
  const short* a0 = base + (k0 + 8 * g + q) * stride + n0 + 4 * p;
  s16x4 lo = __builtin_amdgcn_ds_read_tr16_b64_v4i16((LDSP(s16x4))a0);
  s16x4 hi = __builtin_amdgcn_ds_read_tr16_b64_v4i16((LDSP(s16x4))(a0 + 4 * stride));
  return __builtin_shufflevector(lo, hi, 0, 1, 2, 3, 4, 5, 6, 7);
}
template <bool AT, bool BT>
DI f32x4 mm_tile(const short* A, int lda, int m0, const short* B, int ldb, int n0, int K, f32x4 acc) {
  const int lane = threadIdx.x & 63, fr = lane & 15, fq = lane >> 4;
#ifdef SLOWMM
#pragma unroll
  for (int reg = 0; reg < 4; ++reg) {
    const int row = m0 + 4 * fq + reg, col = n0 + fr;
    float s = 0.f;
    for (int k = 0; k < K; ++k) {
      const float a = bf2f((bfr)(AT ? A[k * lda + row] : A[row * lda + k]));
      const float b = bf2f((bfr)(BT ? B[col * ldb + k] : B[k * ldb + col]));
      s += a * b;
    }
    acc[reg] += s;
  }
#else
  for (int k0 = 0; k0 < K; k0 += 32) {
    bf16x8 a, b;
    if (AT) a = ld_tr8(A, lda, k0, m0); else a = *(const bf16x8*)(A + (m0 + fr) * lda + k0 + fq * 8);
    if (BT) b = *(const bf16x8*)(B + (n0 + fr) * ldb + k0 + fq * 8); else b = ld_tr8(B, ldb, k0, n0);
    acc = __builtin_amdgcn_mfma_f32_16x16x32_bf16(a, b, acc, 0, 0, 0);
  }
#endif
  return acc;
}
DI void st_tile(short* C, int ldc, int m0, int n0, f32x4 acc) {
  const int lane = threadIdx.x & 63, fr = lane & 15, fq = lane >> 4;
#pragma unroll
  for (int reg = 0; reg < 4; ++reg) C[(m0 + 4 * fq + reg) * ldc + n0 + fr] = (short)f2bf(acc[reg]);
}

constexpr int RW_NSC = 32;
DI int rw_sc_begin(int sc) { return sc * 16 + (sc < 8 ? sc : 8); }
DI int rw_sc_of_chunk(int ci) { return ci < 136 ? ci / 17 : 8 + (ci - 136) / 16; }
constexpr int XS = 72, SS = 40, GS = 72;
constexpr int RWL_XK = 0, RWL_XKB = 4608, RWL_XBB = 9216, RWL_XR = 13824, RWL_XV = 18432, RWL_S = 23040;
constexpr int RWL_GP = 38400, RWL_GQ = 47616, RWL_GAM = 56832, RWL_TOT = 57088, RWL_END = 58112;
constexpr size_t WS_PTOT = 6 * MB;
constexpr size_t WS_QTOT = 10 * MB;
constexpr size_t WS_SINRW = 18 * MB;
constexpr size_t WS_R2P = 350 * MB;
constexpr size_t WS_Y0P = 382 * MB;

DI void rw_levelA_item(const Params& P, int chain, int sc, char* smem) {
  const int dir = chain >> 3, hd = chain & 7;
  const bfr* Rg = (const bfr*)(P.ws + WS_RW); const bfr* Kg = (const bfr*)(P.ws + WS_RW + RW_ARR); const bfr* Vg = (const bfr*)(P.ws + WS_RW + 2 * RW_ARR);
  const bfr* KKg = (const bfr*)(P.ws + WS_RW + 3 * RW_ARR); const bfr* Ag = (const bfr*)(P.ws + WS_RW + 4 * RW_ARR);
  const float* LWg = (const float*)(P.ws + WS_LW + (dir ? LW_ARR : 0));
  bfr* R2P = (bfr*)(P.ws + WS_R2P) + (size_t)dir * T_LAT * 512;
  bfr* Y0P = (bfr*)(P.ws + WS_Y0P) + (size_t)dir * T_LAT * 512;
  short* XK = (short*)(smem + RWL_XK); short* XKB = (short*)(smem + RWL_XKB); short* XBB = (short*)(smem + RWL_XBB);
  short* XR = (short*)(smem + RWL_XR); short* XV = (short*)(smem + RWL_XV);
  short* XZ = XR; short* XR2 = XR; short* GPc = XK;
  short* SL = (short*)(smem + RWL_S); short* SAkk = SL + 32 * SS; short* SAkr = SAkk + 32 * SS; short* SM = SAkr + 32 * SS;
  short* ST = SM + 32 * SS; short* SnAbr = ST + 32 * SS;
  short* XW1 = SL; short* XW2 = SAkr;
  short* GP = (short*)(smem + RWL_GP); short* GQ = (short*)(smem + RWL_GQ);
  float* gam = (float*)(smem + RWL_GAM); float* tot = (float*)(smem + RWL_TOT);
  const int tid = threadIdx.x, lane = tid & 63, w = tid >> 6, fr = lane & 15, fq = lane >> 4;
  const int tm = w >> 1, tn = w & 1;
  const f32x4 z4 = {0.f, 0.f, 0.f, 0.f};
  __syncthreads();
  for (int i = tid; i < 64 * 64; i += NTHR) { const int r = i >> 6, c = i & 63; GP[r * GS + c] = (r == c) ? (short)0x3F80 : (short)0; GQ[r * GS + c] = 0; }
  f32x4 pcum[4], qcum[4];
#pragma unroll
  for (int n = 0; n < 4; ++n) { pcum[n] = z4; qcum[n] = z4; }
  const int c_begin = rw_sc_begin(sc), c_end = rw_sc_begin(sc + 1);
  for (int ci = c_begin; ci < c_end; ++ci) {
    __syncthreads();
    {
      const int j = tid & 63, qt = tid >> 6;
      float lwv[8], lam[8]; bfr rr[8], kr[8], vr[8], kkr[8], ar[8];
      float run = 0.f;
#pragma unroll
      for (int e = 0; e < 8; ++e) {
        const int row = row_of_step(dir, ci * 32 + qt * 8 + e);
        const size_t o = (size_t)row * 512 + hd * 64 + j;
        lwv[e] = LWg[o]; rr[e] = Rg[o]; kr[e] = Kg[o]; vr[e] = Vg[o]; kkr[e] = KKg[o]; ar[e] = Ag[o];
      }
#pragma unroll
      for (int e = 0; e < 8; ++e) { run += lwv[e]; lam[e] = run; }
      tot[qt * 64 + j] = run;
      __syncthreads();
      float base = 0.f, total = 0.f;
#pragma unroll
      for (int q2 = 0; q2 < 4; ++q2) { const float tv = tot[q2 * 64 + j]; total += tv; if (q2 < qt) base += tv; }
#pragma unroll
      for (int e = 0; e < 8; ++e) {
        const float L = base + lam[e], Lp = L - lwv[e];
        const float eL = __expf(L), enL = __expf(-L), eLp = __expf(Lp);
        const float kkv = bf2f(kkr[e]);
        const int t = qt * 8 + e;
        XK[t * XS + j] = (short)f2bf(kkv * eLp);
        XKB[t * XS + j] = (short)f2bf(bf2f(kr[e]) * enL);
        XBB[t * XS + j] = (short)f2bf(kkv * bf2f(ar[e]) * enL);
        XR[t * XS + j] = (short)f2bf(bf2f(rr[e]) * eL);
        XV[t * XS + j] = (short)vr[e];
      }
      if (qt == 0) gam[j] = __expf(total);
    }
    __syncthreads();
    f32x4 tacc; f32x4 rt[2];
    {
      f32x4 aL = mm_tile<false, true>(XK, XS, 16 * tm, XBB, XS, 16 * tn, 64, z4);
      f32x4 aKK = mm_tile<false, true>(XK, XS, 16 * tm, XKB, XS, 16 * tn, 64, z4);
      f32x4 aBR = mm_tile<false, true>(XR, XS, 16 * tm, XBB, XS, 16 * tn, 64, z4);
      f32x4 aKR = mm_tile<false, true>(XR, XS, 16 * tm, XKB, XS, 16 * tn, 64, z4);
#pragma unroll
      for (int reg = 0; reg < 4; ++reg) {
        const int row = 16 * tm + 4 * fq + reg, col = 16 * tn + fr;
        const bool st = col < row, inc = col <= row;
        aL[reg] = st ? aL[reg] : 0.f; aKK[reg] = st ? aKK[reg] : 0.f;
        aBR[reg] = inc ? -aBR[reg] : 0.f; aKR[reg] = inc ? aKR[reg] : 0.f;
        tacc[reg] = (row == col ? 1.f : 0.f) - aL[reg];
      }
      st_tile(SL, SS, 16 * tm, 16 * tn, aL); st_tile(ST, SS, 16 * tm, 16 * tn, tacc);
      st_tile(SAkk, SS, 16 * tm, 16 * tn, aKK); st_tile(SnAbr, SS, 16 * tm, 16 * tn, aBR); st_tile(SAkr, SS, 16 * tm, 16 * tn, aKR);
#pragma unroll
      for (int i = 0; i < 2; ++i)
#pragma unroll
        for (int reg = 0; reg < 4; ++reg) rt[i][reg] = bf2f((bfr)XR[(16 * tm + 4 * fq + reg) * XS + 16 * (2 * tn + i) + fr]);
    }
    __syncthreads();
    f32x4 y0[2];
    {
#pragma unroll
      for (int i = 0; i < 2; ++i) {
        f32x4 z = mm_tile<false, false>(SAkk, SS, 16 * tm, XV, XS, 16 * (2 * tn + i), 32, z4);
        st_tile(XZ, XS, 16 * tm, 16 * (2 * tn + i), z);
        y0[i] = mm_tile<false, false>(SAkr, SS, 16 * tm, XV, XS, 16 * (2 * tn + i), 32, z4);
      }
      f32x4 m = mm_tile<false, false>(SL, SS, 16 * tm, SL, SS, 16 * tn, 32, z4);
      st_tile(SM, SS, 16 * tm, 16 * tn, m);
    }
    __syncthreads();
#pragma unroll 1
    for (int rd = 0; rd < 4; ++rd) {
      f32x4 tnew = mm_tile<false, false>(ST, SS, 16 * tm, SM, SS, 16 * tn, 32, tacc);
      f32x4 mnew = z4;
      if (rd < 3) mnew = mm_tile<false, false>(SM, SS, 16 * tm, SM, SS, 16 * tn, 32, z4);
      __syncthreads();
      tacc = tnew;
      st_tile(ST, SS, 16 * tm, 16 * tn, tacc);
      if (rd < 3) st_tile(SM, SS, 16 * tm, 16 * tn, mnew);
      __syncthreads();
    }
    {
      f32x4 w1[2], w2[2];
#pragma unroll
      for (int i = 0; i < 2; ++i) {
        w1[i] = mm_tile<false, false>(ST, SS, 16 * tm, XK, XS, 16 * (2 * tn + i), 32, z4);
        w2[i] = mm_tile<false, false>(ST, SS, 16 * tm, XZ, XS, 16 * (2 * tn + i), 32, z4);
      }
#pragma unroll
      for (int i = 0; i < 2; ++i) { st_tile(XW1, XS, 16 * tm, 16 * (2 * tn + i), w1[i]); st_tile(XW2, XS, 16 * tm, 16 * (2 * tn + i), w2[i]); }
    }
    __syncthreads();
    f32x4 pa[4], qc[4], r2[2];
    {
#pragma unroll
      for (int n = 0; n < 4; ++n) {
        pa[n] = mm_tile<true, false>(XW1, XS, 16 * w, XBB, XS, 16 * n, 32, z4);
        f32x4 qa = mm_tile<true, false>(XV, XS, 16 * w, XKB, XS, 16 * n, 32, z4);
        f32x4 qb = mm_tile<true, false>(XW2, XS, 16 * w, XBB, XS, 16 * n, 32, z4);
        qc[n] = qa - qb;
      }
#pragma unroll
      for (int i = 0; i < 2; ++i) {
        r2[i] = mm_tile<false, false>(SnAbr, SS, 16 * tm, XW1, XS, 16 * (2 * tn + i), 32, rt[i]);
        y0[i] = mm_tile<false, false>(SnAbr, SS, 16 * tm, XW2, XS, 16 * (2 * tn + i), 32, y0[i]);
      }
    }
    __syncthreads();
    {
#pragma unroll
      for (int n = 0; n < 4; ++n) {
        const float gcol = gam[16 * n + fr];
        f32x4 pc;
#pragma unroll
        for (int reg = 0; reg < 4; ++reg) {
          const int row = 16 * w + 4 * fq + reg, col = 16 * n + fr;
          pc[reg] = ((row == col ? 1.f : 0.f) - pa[n][reg]) * gcol;
          qc[n][reg] *= gcol;
        }
        st_tile(GPc, GS, 16 * w, 16 * n, pc);
      }
#pragma unroll
      for (int i = 0; i < 2; ++i) st_tile(XR2, XS, 16 * tm, 16 * (2 * tn + i), r2[i]);
    }
    __syncthreads();
    {
      if (ci >= 8) {
#pragma unroll
        for (int i = 0; i < 2; ++i) {
          f32x4 o1 = mm_tile<false, true>(XR2, XS, 16 * tm, GP, GS, 16 * (2 * tn + i), 64, z4);
          f32x4 o2 = mm_tile<false, true>(XR2, XS, 16 * tm, GQ, GS, 16 * (2 * tn + i), 64, y0[i]);
#pragma unroll
          for (int reg = 0; reg < 4; ++reg) {
            const int row = row_of_step(dir, ci * 32 + 16 * tm + 4 * fq + reg);
            const size_t o = (size_t)row * 512 + hd * 64 + 16 * (2 * tn + i) + fr;
            R2P[o] = f2bf(o1[reg]); Y0P[o] = f2bf(o2[reg]);
          }
        }
      }
#pragma unroll
      for (int n = 0; n < 4; ++n) {
        pcum[n] = mm_tile<false, false>(GP, GS, 16 * w, GPc, GS, 16 * n, 64, z4);
        qcum[n] = mm_tile<false, false>(GQ, GS, 16 * w, GPc, GS, 16 * n, 64, qc[n]);
      }
    }
    __syncthreads();
#pragma unroll
    for (int n = 0; n < 4; ++n) { st_tile(GP, GS, 16 * w, 16 * n, pcum[n]); st_tile(GQ, GS, 16 * w, 16 * n, qcum[n]); }
  }
  {
    bfr* Pt = (bfr*)(P.ws + WS_PTOT) + (size_t)(chain * RW_NSC + sc) * 4096;
    float* Qt = (float*)(P.ws + WS_QTOT) + (size_t)(chain * RW_NSC + sc) * 4096;
#pragma unroll
    for (int n = 0; n < 4; ++n)
#pragma unroll
      for (int reg = 0; reg < 4; ++reg) {
        const int row = 16 * w + 4 * fq + reg, col = 16 * n + fr;
        Pt[row * 64 + col] = f2bf(pcum[n][reg]); Qt[row * 64 + col] = qcum[n][reg];
      }
  }
}

DI void rw_levelB_chain(const Params& P, int chain, char* smem) {
  short* SB = (short*)smem; short* PT = SB + 64 * GS;
  const bfr* Ptot = (const bfr*)(P.ws + WS_PTOT) + (size_t)chain * RW_NSC * 4096;
  const float* Qtot = (const float*)(P.ws + WS_QTOT) + (size_t)chain * RW_NSC * 4096;
  bfr* SIN = (bfr*)(P.ws + WS_SINRW) + (size_t)chain * (RW_NSC + 1) * 4096;
  const int tid = threadIdx.x, lane = tid & 63, w = tid >> 6, fr = lane & 15, fq = lane >> 4;
  f32x4 S[4];
#pragma unroll
  for (int n = 0; n < 4; ++n) S[n] = f32x4{0.f, 0.f, 0.f, 0.f};
  for (int sc = 0; sc < RW_NSC; ++sc) {
    __syncthreads();
#pragma unroll
    for (int n = 0; n < 4; ++n) {
      st_tile(SB, GS, 16 * w, 16 * n, S[n]);
#pragma unroll
      for (int reg = 0; reg < 4; ++reg) SIN[(size_t)sc * 4096 + (16 * w + 4 * fq + reg) * 64 + 16 * n + fr] = f2bf(S[n][reg]);
    }
    for (int i = tid; i < 512; i += NTHR) {
      const int r = i >> 3, c8 = i & 7;
      *(bf16x8*)(PT + r * GS + c8 * 8) = *(const bf16x8*)(Ptot + (size_t)sc * 4096 + r * 64 + c8 * 8);
    }
    __syncthreads();
#pragma unroll
    for (int n = 0; n < 4; ++n) {
      f32x4 q;
#pragma unroll
      for (int reg = 0; reg < 4; ++reg) q[reg] = Qtot[(size_t)sc * 4096 + (16 * w + 4 * fq + reg) * 64 + 16 * n + fr];
      S[n] = mm_tile<false, false>(SB, GS, 16 * w, PT, GS, 16 * n, 64, q);
    }
  }
}

DI void rw_finish(const Params& P, int bid, int nb) {
  float* YM = P.out;
  const int tid = threadIdx.x, lane = tid & 63, w = tid >> 6, fr = lane & 15, fq = lane >> 4;
  for (int it = bid; it < 512 * 4; it += nb) {
    const int tile = it >> 2, hp = it & 3;
    const int hd = hp * 2 + (w >> 1), tm = w & 1;
    const int t0 = tile * 32;
    f32x4 acc[4];
#pragma unroll
    for (int n = 0; n < 4; ++n) acc[n] = f32x4{0.f, 0.f, 0.f, 0.f};
#pragma unroll
    for (int dir = 0; dir < 2; ++dir) {
      const int ci = dir ? (519 - tile) : (8 + tile);
      const int sc = rw_sc_of_chunk(ci);
      const bfr* A = (const bfr*)(P.ws + WS_R2P) + (size_t)dir * T_LAT * 512 + (size_t)t0 * 512 + hd * 64;
      const bfr* Y0 = (const bfr*)(P.ws + WS_Y0P) + (size_t)dir * T_LAT * 512 + (size_t)t0 * 512 + hd * 64;
      const bfr* Sin = (const bfr*)(P.ws + WS_SINRW) + ((size_t)(dir * 8 + hd) * (RW_NSC + 1) + sc) * 4096;
#pragma unroll
      for (int n = 0; n < 4; ++n) {
#pragma unroll
        for (int k0 = 0; k0 < 64; k0 += 32) {
          bf16x8 a = *(const bf16x8*)(A + (size_t)(16 * tm + fr) * 512 + k0 + fq * 8);
          bf16x8 b = *(const bf16x8*)(Sin + (16 * n + fr) * 64 + k0 + fq * 8);
          acc[n] = __builtin_amdgcn_mfma_f32_16x16x32_bf16(a, b, acc[n], 0, 0, 0);
        }
#pragma unroll
        for (int reg = 0; reg < 4; ++reg) acc[n][reg] += bf2f(Y0[(size_t)(16 * tm + 4 * fq + reg) * 512 + 16 * n + fr]);
      }
    }
#pragma unroll
    for (int n = 0; n < 4; ++n)
#pragma unroll
      for (int reg = 0; reg < 4; ++reg) YM[(size_t)(t0 + 16 * tm + 4 * fq + reg) * 512 + hd * 64 + 16 * n + fr] = acc[n][reg];
  }
}

constexpr int HG_NSC = 64;
DI int hg_sc_begin(int sc) { return sc * 8 + (sc < 8 ? sc : 8); }
DI int hg_sc_of_chunk(int ci) { return ci < 72 ? ci / 9 : 8 + (ci - 72) / 8; }
constexpr int QS = 136;
constexpr int HGL_Q0 = 0, HGL_Q1 = 8704, HGL_KP = 13056, HGL_KH = 21760, HGL_VV = 30464, HGL_PM = 39168, HGL_STT = 41728;
constexpr int HGL_BL = 76544, HGL_TOT = 77056, HGL_END = 78080;
constexpr size_t WS_SINHG = 23 * MB;
constexpr size_t WS_QH = 414 * MB;
constexpr size_t WS_O0 = 446 * MB;
constexpr size_t WS_SLOC = 478 * MB;
constexpr size_t WS_DTOT = 510 * MB;

DI void hg_levelA_item(const Params& P, int chain, int sc, char* smem) {
  const int dir = chain >> 2, hd = chain & 3;
  const bfr* p = (const bfr*)(P.ws + WS_P);
  const float* lbp = (const float*)(P.ws + WS_LB) + dir * 512 + hd * 128;
  bfr* QH = (bfr*)(P.ws + WS_QH) + (size_t)dir * T_LAT * 512;
  bfr* O0 = (bfr*)(P.ws + WS_O0) + (size_t)dir * T_LAT * 512;
  short* Q0 = (short*)(smem + HGL_Q0); short* Q1 = (short*)(smem + HGL_Q1); short* KP = (short*)(smem + HGL_KP);
  short* KH = (short*)(smem + HGL_KH); short* VV = (short*)(smem + HGL_VV); short* PM = (short*)(smem + HGL_PM);
  short* STT = (short*)(smem + HGL_STT);
  float* BL = (float*)(smem + HGL_BL); float* tot = (float*)(smem + HGL_TOT);
  const int tid = threadIdx.x, lane = tid & 63, w = tid >> 6, fr = lane & 15, fq = lane >> 4;
  const f32x4 z4 = {0.f, 0.f, 0.f, 0.f};
  f32x4 S[8][2];
#pragma unroll
  for (int m = 0; m < 8; ++m) { S[m][0] = z4; S[m][1] = z4; }
  const int d = tid & 127, hf = tid >> 7;
  const float lb = lbp[d];
  float dcum = 0.f;
  const int c_begin = hg_sc_begin(sc), c_end = hg_sc_begin(sc + 1);
  for (int ci = c_begin; ci < c_end; ++ci) {
    __syncthreads();
    {
      bfr qr[16], vr[16], zr[16];
#pragma unroll
      for (int e = 0; e < 16; ++e) {
        const int row = row_of_step(dir, ci * 32 + hf * 16 + e);
        const bfr* pr = p + (size_t)row * DIN + hd * 128 + d;
        qr[e] = pr[0]; vr[e] = pr[512]; zr[e] = pr[1024 + dir * 512];
      }
      float lc[16], kv[16]; float run = 0.f;
#pragma unroll
      for (int e = 0; e < 16; ++e) {
        const float sg = sigmoidf_(bf2f(zr[e]));
        const float f = lb + (1.f - lb) * sg;
        kv[e] = (1.f - lb) * (1.f - sg);
        run += __logf(f); lc[e] = run;
      }
      tot[hf * 128 + d] = run;
      __syncthreads();
      const float tot0 = tot[d], tot1 = tot[128 + d];
      const float blast = tot0 + tot1;
#pragma unroll
      for (int e = 0; e < 16; ++e) {
        const int t = hf * 16 + e;
        const float bc = lc[e] + (hf ? tot0 : 0.f);
        const float qs = siluf_(bf2f(qr[e]));
        Q0[t * QS + d] = (short)f2bf(qs * __expf(bc));
        if (hf) Q1[e * QS + d] = (short)f2bf(qs * __expf(lc[e]));
        KP[t * QS + d] = (short)f2bf(kv[e] * __expf(-lc[e]));
        KH[t * QS + d] = (short)f2bf(kv[e] * __expf(blast - bc));
        VV[t * QS + d] = (short)vr[e];
        if (ci >= 8) {
          const int row = row_of_step(dir, ci * 32 + t);
          QH[(size_t)row * 512 + hd * 128 + d] = f2bf(qs * __expf(bc + dcum));
        }
      }
      if (hf == 0) BL[d] = blast;
      dcum += blast;
    }
#pragma unroll
    for (int m = 0; m < 8; ++m)
#pragma unroll
      for (int n = 0; n < 2; ++n) {
        uint2 wv = {pack2(S[m][n][0], S[m][n][1]), pack2(S[m][n][2], S[m][n][3])};
        *(uint2*)(STT + (32 * w + 16 * n + fr) * QS + 16 * m + 4 * fq) = wv;
      }
    __syncthreads();
    {
      f32x4 pt = z4;
      if (w == 0) pt = mm_tile<false, true>(Q0, QS, 0, KP, QS, 0, 128, z4);
      else if (w == 1) pt = mm_tile<false, true>(Q0, QS, 16, KP, QS, 0, 128, z4);
      else if (w == 2) pt = mm_tile<false, true>(Q1, QS, 0, KP, QS, 16, 128, z4);
      if (w == 0 || w == 2) {
#pragma unroll
        for (int reg = 0; reg < 4; ++reg) pt[reg] = (fr <= 4 * fq + reg) ? pt[reg] : 0.f;
      }
      const int ptm = (w == 0 || w == 3) ? 0 : 1, ptn = (w >= 2) ? 1 : 0;
      st_tile(PM, 40, 16 * ptm, 16 * ptn, pt);
    }
    __syncthreads();
    {
#pragma unroll
      for (int m = 0; m < 2; ++m)
#pragma unroll
        for (int n = 0; n < 2; ++n) {
          f32x4 o = mm_tile<false, true>(Q0, QS, 16 * m, STT, QS, 32 * w + 16 * n, 128, z4);
          o = mm_tile<false, false>(PM, 40, 16 * m, VV, QS, 32 * w + 16 * n, 32, o);
          if (ci >= 8) {
#pragma unroll
            for (int reg = 0; reg < 4; ++reg) {
              const int row = row_of_step(dir, ci * 32 + 16 * m + 4 * fq + reg);
              O0[(size_t)row * 512 + hd * 128 + 32 * w + 16 * n + fr] = f2bf(o[reg]);
            }
          }
        }
#pragma unroll
      for (int m = 0; m < 8; ++m) {
        const f32x4 bl = *(const f32x4*)(BL + 16 * m + 4 * fq);
        f32x4 sc4 = {__expf(bl[0]), __expf(bl[1]), __expf(bl[2]), __expf(bl[3])};
#pragma unroll
        for (int n = 0; n < 2; ++n) S[m][n] = mm_tile<true, false>(KH, QS, 16 * m, VV, QS, 32 * w + 16 * n, 32, S[m][n] * sc4);
      }
    }
  }
  {
    float* SL_ = (float*)(P.ws + WS_SLOC) + (size_t)(chain * HG_NSC + sc) * 16384;
    float* DT = (float*)(P.ws + WS_DTOT) + (size_t)(chain * HG_NSC + sc) * 128;
#pragma unroll
    for (int m = 0; m < 8; ++m)
#pragma unroll
      for (int n = 0; n < 2; ++n) *(f32x4*)(SL_ + (32 * w + 16 * n + fr) * 128 + 16 * m + 4 * fq) = S[m][n];
    if (hf == 0) DT[d] = dcum;
  }
}

DI void hg_levelB(const Params& P, int bid, int nb) {
  const float* SLOC = (const float*)(P.ws + WS_SLOC); const float* DT = (const float*)(P.ws + WS_DTOT);
  bfr* SIN = (bfr*)(P.ws + WS_SINHG);
  for (int idx = bid * NTHR + threadIdx.x; idx < 8 * 16384; idx += nb * NTHR) {
    const int chain = idx >> 14, ed = idx & 16383, dd = ed & 127;
    float s = 0.f;
    for (int sc = 0; sc < HG_NSC; ++sc) {
      const size_t item = (size_t)chain * HG_NSC + sc;
      SIN[item * 16384 + ed] = f2bf(s);
      s = __expf(DT[item * 128 + dd]) * s + SLOC[item * 16384 + ed];
    }
  }
}

DI void hg_finish(const Params& P, int bid, int nb, float* OM) {
  const int tid = threadIdx.x, lane = tid & 63, w = tid >> 6, fr = lane & 15, fq = lane >> 4;
  for (int it = bid; it < 512 * 4; it += nb) {
    const int tile = it >> 2, hd = it & 3;
    const int t0 = tile * 32;
    f32x4 acc[2][2];
#pragma unroll
    for (int m = 0; m < 2; ++m) { acc[m][0] = f32x4{0.f, 0.f, 0.f, 0.f}; acc[m][1] = f32x4{0.f, 0.f, 0.f, 0.f}; }
#pragma unroll
    for (int dir = 0; dir < 2; ++dir) {
      const int ci = dir ? (519 - tile) : (8 + tile);
      const int sc = hg_sc_of_chunk(ci);
      const bfr* A = (const bfr*)(P.ws + WS_QH) + (size_t)dir * T_LAT * 512 + (size_t)t0 * 512 + hd * 128;
      const bfr* O0 = (const bfr*)(P.ws + WS_O0) + (size_t)dir * T_LAT * 512 + (size_t)t0 * 512 + hd * 128;
      const bfr* Sin = (const bfr*)(P.ws + WS_SINHG) + ((size_t)(dir * 4 + hd) * HG_NSC + sc) * 16384;
#pragma unroll
      for (int m = 0; m < 2; ++m)
#pragma unroll
        for (int n = 0; n < 2; ++n) {
#pragma unroll
          for (int k0 = 0; k0 < 128; k0 += 32) {
            bf16x8 a = *(const bf16x8*)(A + (size_t)(16 * m + fr) * 512 + k0 + fq * 8);
            bf16x8 b = *(const bf16x8*)(Sin + (32 * w + 16 * n + fr) * 128 + k0 + fq * 8);
            acc[m][n] = __builtin_amdgcn_mfma_f32_16x16x32_bf16(a, b, acc[m][n], 0, 0, 0);
          }
#pragma unroll
          for (int reg = 0; reg < 4; ++reg) acc[m][n][reg] += bf2f(O0[(size_t)(16 * m + 4 * fq + reg) * 512 + 32 * w + 16 * n + fr]);
        }
    }
#pragma unroll
    for (int m = 0; m < 2; ++m)
#pragma unroll
      for (int n = 0; n < 2; ++n)
#pragma unroll
        for (int reg = 0; reg < 4; ++reg) OM[(size_t)(t0 + 16 * m + 4 * fq + reg) * 512 + hd * 128 + 32 * w + 16 * n + fr] = acc[m][n][reg];
  }
}

DI void phase_readout(const Params& P, int bid, int nb) {
  const bfr* p = (const bfr*)(P.ws + WS_P);
  const float* Of = P.out + (size_t)T_LAT * 512;
  const float* Yf = P.out;
  const bfr* R = (const bfr*)(P.ws + WS_RW); const bfr* K = (const bfr*)(P.ws + WS_RW + RW_ARR); const bfr* V = (const bfr*)(P.ws + WS_RW + 2 * RW_ARR);
  const bfr* G = (const bfr*)(P.ws + WS_RW + 5 * RW_ARR);
  const float* hg_norm_w = P.in[9]; const float* r_k = P.in[18]; const float* gn_w = P.in[19]; const float* gn_b = P.in[20];
  bfr* mix = (bfr*)(P.ws + WS_H);
  const int wid = threadIdx.x >> 6, lane = threadIdx.x & 63;
  for (int t = bid * 4 + wid; t < T_LAT; t += nb * 4) {
    {
      float o[8]; float ss = 0.f;
#pragma unroll
      for (int e = 0; e < 8; ++e) { const long idx = (long)t * 512 + lane * 8 + e; o[e] = Of[idx]; ss += o[e] * o[e]; }
      ss += __shfl_xor(ss, 1); ss += __shfl_xor(ss, 2); ss += __shfl_xor(ss, 4); ss += __shfl_xor(ss, 8);
      const float rs = rsqrtf(ss * (1.f / 128.f) + 1e-6f);
      unsigned w[4];
#pragma unroll
      for (int e = 0; e < 8; e += 2) {
        const int c0 = lane * 8 + e;
        const float g0 = bf2f(p[(long)t * DIN + 2048 + c0]), g1 = bf2f(p[(long)t * DIN + 2048 + c0 + 1]);
        const float v0 = o[e] * rs * hg_norm_w[c0] * siluf_(g0);
        const float v1 = o[e + 1] * rs * hg_norm_w[c0 + 1] * siluf_(g1);
        w[e >> 1] = pack2(v0, v1);
      }
      *(uint4*)(mix + (long)t * DM + lane * 8) = uint4{w[0], w[1], w[2], w[3]};
    }
    {
      float y[8]; float s = 0.f, bs = 0.f;
      float vv[8];
#pragma unroll
      for (int e = 0; e < 8; ++e) {
        const long idx = (long)t * 512 + lane * 8 + e;
        y[e] = Yf[idx]; s += y[e];
        bs += bf2f(R[idx]) * bf2f(K[idx]) * r_k[lane * 8 + e];
        vv[e] = bf2f(V[idx]);
      }
      s += __shfl_xor(s, 1); s += __shfl_xor(s, 2); s += __shfl_xor(s, 4);
      bs += __shfl_xor(bs, 1); bs += __shfl_xor(bs, 2); bs += __shfl_xor(bs, 4);
      const float mu = s * (1.f / 64.f);
      float q = 0.f;
#pragma unroll
      for (int e = 0; e < 8; ++e) { y[e] -= mu; q += y[e] * y[e]; }
      q += __shfl_xor(q, 1); q += __shfl_xor(q, 2); q += __shfl_xor(q, 4);
      const float rs = rsqrtf(q * (1.f / 64.f) + 64e-5f);
      unsigned w[4];
#pragma unroll
      for (int e = 0; e < 8; e += 2) {
        const int c0 = lane * 8 + e;
        const long idx = (long)t * 512 + c0;
        const float v0 = (y[e] * rs * gn_w[c0] + gn_b[c0] + bs * vv[e]) * bf2f(G[idx]);
        const float v1 = (y[e + 1] * rs * gn_w[c0 + 1] + gn_b[c0 + 1] + bs * vv[e + 1]) * bf2f(G[idx + 1]);
        w[e >> 1] = pack2(v0, v1);
      }
      *(uint4*)(mix + (long)t * DM + 512 + lane * 8) = uint4{w[0], w[1], w[2], w[3]};
    }
  }
}

DI void phase_outproj(const Params& P, int bid, int nb, char* smem) {
  const bfr* mix = (const bfr*)(P.ws + WS_H);
  const float* w_out = P.in[7];
  float* y = (float*)(P.ws + WS_Y);
  short* sA = (short*)smem; short* sB = sA + 128 * LSTR;
  const int tid = threadIdx.x, wid = tid >> 6, lane = tid & 63;
  const int wr = wid >> 1, wc = wid & 1, fr = lane & 15, fq = lane >> 4;
  constexpr int NT = 8, MT = T_LAT / 128;
  for (int it = bid; it < NT * MT; it += nb) {
    const int mt = it / NT, nt = it % NT;
    ALoadBf16 al; BLoadF32 bl;
#pragma unroll
    for (int i = 0; i < 4; ++i) al.rp[i] = mix + (long)(mt * 128 + (tid >> 3) + 32 * i) * DM + (tid & 7) * 8;
    bl.valid = true; bl.ldb = DM;
    bl.p = w_out + (long)((tid & 7) * 8) * DM + nt * 128 + (tid >> 3) * 4;
    f32x4 acc[4][4];
    gemm_mainloop(sA, sB, DM / 64, al, bl, acc);
#pragma unroll
    for (int m = 0; m < 4; ++m)
#pragma unroll
      for (int n = 0; n < 4; ++n)
#pragma unroll
        for (int j = 0; j < 4; ++j) {
          const int rr = mt * 128 + wr * 64 + m * 16 + fq * 4 + j, cc = nt * 128 + wc * 64 + n * 16 + fr;
          y[(long)rr * DM + cc] = acc[m][n][j];
        }
  }
}

DI void phase_ln2route(const Params& P, int bid, int nb) {
  const float* x = P.in[0];
  const float* y = (const float*)(P.ws + WS_Y);
  const float* mod = (const float*)(P.ws + WS_MOD);
  const float* ln1_g = P.in[21]; const float* ln1_b = P.in[22];
  const float* wgrp = P.in[25]; const float* bgrp = P.in[26]; const float* wrt = P.in[27]; const float* brt = P.in[28];
  float* x1 = P.out;
  bfr* h2 = (bfr*)(P.ws + WS_H2);
  int* cnt = (int*)(P.ws + WS_CNT); int* list = (int*)(P.ws + WS_LIST); float* asgw = (float*)(P.ws + WS_ASGW);
  const int wid = threadIdx.x >> 6, lane = threadIdx.x & 63;
  for (int t = bid * 4 + wid; t < T_LAT; t += nb * 4) {
    f32x4 v[4]; float s = 0.f;
#pragma unroll
    for (int i = 0; i < 4; ++i) {
      const int c = lane * 4 + 256 * i;
      f32x4 xv = *(const f32x4*)(x + (long)t * DM + c), yv = *(const f32x4*)(y + (long)t * DM + c), g1 = *(const f32x4*)(mod + 2048 + c);
      v[i] = xv * DN_ALPHA + g1 * yv;
      s += v[i][0] + v[i][1] + v[i][2] + v[i][3];
    }
    float mu = wave_sum(s) * (1.f / DM); float q = 0.f;
#pragma unroll
    for (int i = 0; i < 4; ++i) { v[i] -= mu; q += v[i][0] * v[i][0] + v[i][1] * v[i][1] + v[i][2] * v[i][2] + v[i][3] * v[i][3]; }
    float rs = rsqrtf(wave_sum(q) * (1.f / DM) + 1e-5f);
    s = 0.f;
#pragma unroll
    for (int i = 0; i < 4; ++i) {
      const int c = lane * 4 + 256 * i;
      f32x4 g = *(const f32x4*)(ln1_g + c), b = *(const f32x4*)(ln1_b + c);
      v[i] = v[i] * rs * g + b;
      *(f32x4*)(x1 + (long)t * DM + c) = v[i];
      s += v[i][0] + v[i][1] + v[i][2] + v[i][3];
    }
    mu = wave_sum(s) * (1.f / DM); q = 0.f;
#pragma unroll
    for (int i = 0; i < 4; ++i) { v[i] -= mu; q += v[i][0] * v[i][0] + v[i][1] * v[i][1] + v[i][2] * v[i][2] + v[i][3] * v[i][3]; }
    rs = rsqrtf(wave_sum(q) * (1.f / DM) + 1e-5f);
#pragma unroll
    for (int i = 0; i < 4; ++i) {
      const int c = lane * 4 + 256 * i;
      f32x4 sh = *(const f32x4*)(mod + 3072 + c), sc = *(const f32x4*)(mod + 4096 + c);
      v[i] = v[i] * rs * (sc + 1.f) + sh;
      uint2 w = {pack2(v[i][0], v[i][1]), pack2(v[i][2], v[i][3])};
      *(uint2*)(h2 + (long)t * DM + c) = w;
    }
    float gl[8];
#pragma unroll
    for (int g = 0; g < 8; ++g) gl[g] = 0.f;
#pragma unroll
    for (int i = 0; i < 4; ++i)
#pragma unroll
      for (int e = 0; e < 4; ++e) {
        const int k = lane * 4 + 256 * i + e;
        const f32x4 w0 = *(const f32x4*)(wgrp + k * 8), w1 = *(const f32x4*)(wgrp + k * 8 + 4);
        const float hv = v[i][e];
        gl[0] += hv * w0[0]; gl[1] += hv * w0[1]; gl[2] += hv * w0[2]; gl[3] += hv * w0[3];
        gl[4] += hv * w1[0]; gl[5] += hv * w1[1]; gl[6] += hv * w1[2]; gl[7] += hv * w1[3];
      }
    int gi = 0; float gmax = -3.4e38f;
#pragma unroll
    for (int g = 0; g < 8; ++g) { gl[g] = wave_sum(gl[g]) + bgrp[g]; if (gl[g] > gmax) { gmax = gl[g]; gi = g; } }
    float den = 0.f;
#pragma unroll
    for (int g = 0; g < 8; ++g) den += __expf(gl[g] - gmax);
    const float gprob = 1.f / den;
    float el[8];
#pragma unroll
    for (int g = 0; g < 8; ++g) el[g] = 0.f;
#pragma unroll
    for (int i = 0; i < 4; ++i)
#pragma unroll
      for (int e = 0; e < 4; ++e) {
        const int k = lane * 4 + 256 * i + e;
        const f32x4 w0 = *(const f32x4*)(wrt + k * 64 + gi * 8), w1 = *(const f32x4*)(wrt + k * 64 + gi * 8 + 4);
        const float hv = v[i][e];
        el[0] += hv * w0[0]; el[1] += hv * w0[1]; el[2] += hv * w0[2]; el[3] += hv * w0[3];
        el[4] += hv * w1[0]; el[5] += hv * w1[1]; el[6] += hv * w1[2]; el[7] += hv * w1[3];
      }
    int i1 = 0; float v1 = -3.4e38f;
#pragma unroll
    for (int g = 0; g < 8; ++g) { el[g] = wave_sum(el[g]) + brt[gi * 8 + g]; if (el[g] > v1) { v1 = el[g]; i1 = g; } }
    int i2 = 0; float v2 = -3.4e38f;
#pragma unroll
    for (int g = 0; g < 8; ++g) { if (g != i1 && el[g] > v2) { v2 = el[g]; i2 = g; } }
    const float e2 = __expf(v2 - v1);
    const float wt1 = gprob / (1.f + e2), wt2 = gprob * e2 / (1.f + e2);
    if (lane == 0) {
      const int ex1 = gi * 8 + i1, ex2 = gi * 8 + i2;
      int s1 = atomicAdd(&cnt[ex1], 1); list[ex1 * T_LAT + s1] = t * 2;
      int s2 = atomicAdd(&cnt[ex2], 1); list[ex2 * T_LAT + s2] = t * 2 + 1;
      asgw[t * 2] = wt1; asgw[t * 2 + 1] = wt2;
    }
  }
}

DI void moe_block_table(const Params& P, int* tab  ) {
  const int* cnt = (const int*)(P.ws + WS_CNT);
  const int tid = threadIdx.x;
  __syncthreads();
  if (tid < 64) {
    int nbk = (cnt[tid] + 127) >> 7;
    int incl = nbk;
#pragma unroll
    for (int o = 1; o < 64; o <<= 1) { int u = __shfl_up(incl, o); if (tid >= o) incl += u; }
    tab[tid + 1] = incl;
    if (tid == 0) tab[0] = 0;
  }
  __syncthreads();
}
DI int moe_find_expert(const int* tab, int rb) {
  int e = 0;
  while (tab[e + 1] <= rb) ++e;
  return e;
}

DI void phase_moe1(const Params& P, int bid, int nb, char* smem) {
  const bfr* h2 = (const bfr*)(P.ws + WS_H2);
  const int* cnt = (const int*)(P.ws + WS_CNT); const int* list = (const int*)(P.ws + WS_LIST);
  const float* wg = P.in[29]; const float* wu = P.in[30];
  bfr* hid = (bfr*)(P.ws + WS_HID);
  short* sA = (short*)smem; short* sB = sA + 128 * LSTR;
  int* tab = (int*)(smem + GEMM_LDS_BYTES);
  const int tid = threadIdx.x, wid = tid >> 6, lane = tid & 63;
  const int wr = wid >> 1, wc = wid & 1, fr = lane & 15, fq = lane >> 4;
  moe_block_table(P, tab);
  const int nrb = tab[64];
  for (int it = bid; it < nrb * 8; it += nb) {
    const int rb = it >> 3, nt = it & 7;
    const int e = moe_find_expert(tab, rb);
    const int lrb = rb - tab[e];
    const int ce = cnt[e];
    ALoadBf16 al; BLoadF32 bl;
#pragma unroll
    for (int i = 0; i < 4; ++i) {
      int r = lrb * 128 + (tid >> 3) + 32 * i;
      if (r >= ce) r = ce - 1;
      const int tok = list[e * T_LAT + r] >> 1;
      al.rp[i] = h2 + (long)tok * DM + (tid & 7) * 8;
    }
    const int n4 = tid >> 3;
    const int isup = (n4 >> 3) & 1;
    const int col = nt * 64 + (n4 >> 4) * 32 + ((4 * n4) & 31);
    bl.valid = true; bl.ldb = DEXP;
    bl.p = (isup ? wu : wg) + (long)e * DM * DEXP + (long)((tid & 7) * 8) * DEXP + col;
    f32x4 acc[4][4];
    gemm_mainloop(sA, sB, DM / 64, al, bl, acc);
#pragma unroll
    for (int m = 0; m < 4; ++m)
#pragma unroll
      for (int n = 0; n < 2; ++n)
#pragma unroll
        for (int j = 0; j < 4; ++j) {
          const int rl = wr * 64 + m * 16 + fq * 4 + j;
          const int cc = nt * 64 + wc * 32 + n * 16 + fr;
          const float gv = acc[m][n][j], uv = acc[m][n + 2][j];
          hid[((long)rb * 128 + rl) * DEXP + cc] = f2bf(siluf_(gv) * uv);
        }
  }
}

DI void phase_moe2(const Params& P, int bid, int nb, char* smem) {
  const int* cnt = (const int*)(P.ws + WS_CNT); const int* list = (const int*)(P.ws + WS_LIST);
  const float* wd = P.in[31];
  const bfr* hid = (const bfr*)(P.ws + WS_HID);
  bfr* mout = (bfr*)(P.ws + WS_MOUT);
  short* sA = (short*)smem; short* sB = sA + 128 * LSTR;
  int* tab = (int*)(smem + GEMM_LDS_BYTES);
  const int tid = threadIdx.x, wid = tid >> 6, lane = tid & 63;
  const int wr = wid >> 1, wc = wid & 1, fr = lane & 15, fq = lane >> 4;
  moe_block_table(P, tab);
  const int nrb = tab[64];
  for (int it = bid; it < nrb * 8; it += nb) {
    const int rb = it >> 3, nt = it & 7;
    const int e = moe_find_expert(tab, rb);
    const int lrb = rb - tab[e];
    const int ce = cnt[e];
    ALoadBf16 al; BLoadF32 bl;
#pragma unroll
    for (int i = 0; i < 4; ++i) al.rp[i] = hid + ((long)rb * 128 + (tid >> 3) + 32 * i) * DEXP + (tid & 7) * 8;
    bl.valid = true; bl.ldb = DM;
    bl.p = wd + (long)e * DEXP * DM + (long)((tid & 7) * 8) * DM + nt * 128 + (tid >> 3) * 4;
    f32x4 acc[4][4];
    gemm_mainloop(sA, sB, DEXP / 64, al, bl, acc);
#pragma unroll
    for (int m = 0; m < 4; ++m)
#pragma unroll
      for (int j = 0; j < 4; ++j) {
        const int r = lrb * 128 + wr * 64 + m * 16 + fq * 4 + j;
        if (r < ce) {
          const int asg = list[e * T_LAT + r];
#pragma unroll
          for (int n = 0; n < 4; ++n) mout[(long)asg * DM + nt * 128 + wc * 64 + n * 16 + fr] = f2bf(acc[m][n][j]);
        }
      }
  }
}

DI void phase_final(const Params& P, int bid, int nb) {
  const float* mod = (const float*)(P.ws + WS_MOD);
  const float* ln2_g = P.in[23]; const float* ln2_b = P.in[24];
  const bfr* mout = (const bfr*)(P.ws + WS_MOUT);
  const float* asgw = (const float*)(P.ws + WS_ASGW);
  float* out = P.out;
  const int wid = threadIdx.x >> 6, lane = threadIdx.x & 63;
  for (int t = bid * 4 + wid; t < T_LAT; t += nb * 4) {
    const float w1 = asgw[t * 2], w2 = asgw[t * 2 + 1];
    f32x4 v[4]; float s = 0.f;
#pragma unroll
    for (int i = 0; i < 4; ++i) {
      const int c = lane * 4 + 256 * i;
      f32x4 xv = *(const f32x4*)(out + (long)t * DM + c), g2 = *(const f32x4*)(mod + 5120 + c);
      const uint2 m1 = *(const uint2*)(mout + (long)(2 * t) * DM + c), m2 = *(const uint2*)(mout + (long)(2 * t + 1) * DM + c);
      f32x4 a = {__uint_as_float(m1.x << 16), __uint_as_float(m1.x & 0xffff0000u), __uint_as_float(m1.y << 16), __uint_as_float(m1.y & 0xffff0000u)};
      f32x4 b = {__uint_as_float(m2.x << 16), __uint_as_float(m2.x & 0xffff0000u), __uint_as_float(m2.y << 16), __uint_as_float(m2.y & 0xffff0000u)};
      v[i] = xv * DN_ALPHA + g2 * (a * w1 + b * w2);
      s += v[i][0] + v[i][1] + v[i][2] + v[i][3];
    }
    const float mu = wave_sum(s) * (1.f / DM); float q = 0.f;
#pragma unroll
    for (int i = 0; i < 4; ++i) { v[i] -= mu; q += v[i][0] * v[i][0] + v[i][1] * v[i][1] + v[i][2] * v[i][2] + v[i][3] * v[i][3]; }
    const float rs = rsqrtf(wave_sum(q) * (1.f / DM) + 1e-5f);
#pragma unroll
    for (int i = 0; i < 4; ++i) {
      const int c = lane * 4 + 256 * i;
      f32x4 g = *(const f32x4*)(ln2_g + c), b = *(const f32x4*)(ln2_b + c);
      *(f32x4*)(out + (long)t * DM + c) = v[i] * rs * g + b;
    }
  }
}

namespace cg = cooperative_groups;
constexpr int SMEM_BYTES = 78080;
__global__ void __launch_bounds__(NTHR, 2) k_fused(Params P) {
  __shared__ __attribute__((aligned(16))) char smem[SMEM_BYTES];
  cg::grid_group grid = cg::this_grid();
  const int bid = blockIdx.x, nb = gridDim.x;
  phase_mod(P, bid, nb, smem);
  grid.sync();
  phase_ln1(P, bid, nb);
  grid.sync();
  phase_pgemm(P, bid, nb, smem);
  grid.sync();
  phase_rwprep(P, bid, nb, smem);
  grid.sync();
  for (int it = bid; it < 16 * RW_NSC; it += nb) rw_levelA_item(P, it / RW_NSC, it % RW_NSC, smem);
  for (int it = bid; it < 8 * HG_NSC; it += nb) hg_levelA_item(P, it / HG_NSC, it % HG_NSC, smem);
  grid.sync();
  if (bid < 16) rw_levelB_chain(P, bid, smem); else hg_levelB(P, bid - 16, nb - 16);
  grid.sync();
  rw_finish(P, bid, nb);
  hg_finish(P, bid, nb, P.out + (size_t)T_LAT * 512);
  grid.sync();
  phase_readout(P, bid, nb);
  grid.sync();
  phase_outproj(P, bid, nb, smem);
  grid.sync();
  phase_ln2route(P, bid, nb);
  grid.sync();
  phase_moe1(P, bid, nb, smem);
  grid.sync();
  phase_moe2(P, bid, nb, smem);
  grid.sync();
  phase_final(P, bid, nb);
}

extern "C" void kernel_launch(void* const* d_in, const int* in_sizes, int n_in, void* d_out, int out_size, void* d_ws, size_t ws_size, hipStream_t stream) {
  static int grid_blocks = 0;
  if (!grid_blocks) {
    int dev = 0, cus = 0, per_cu = 0;
    hipGetDevice(&dev);
    hipDeviceGetAttribute(&cus, hipDeviceAttributeMultiprocessorCount, dev);
    hipOccupancyMaxActiveBlocksPerMultiprocessor(&per_cu, k_fused, NTHR, 0);
    if (per_cu > 2) per_cu = 2;
    if (per_cu < 1) per_cu = 1;
    grid_blocks = cus * per_cu;
  }
  Params P{};
  for (int i = 0; i < 32; ++i) P.in[i] = (const float*)d_in[i];
  P.out = (float*)d_out; P.ws = (char*)d_ws;
  void* args[] = {&P};
  hipError_t e = hipLaunchCooperativeKernel((void*)k_fused, dim3(grid_blocks), dim3(NTHR), args, 0, stream);
  if (e != hipSuccess) fprintf(stderr, "cooperative launch failed: %s (grid %d)\n", hipGetErrorString(e), grid_blocks);
}
```

```cpp
#include <hip/hip_runtime.h>
#include <hip/hip_cooperative_groups.h>
#include <cstdio>

typedef __attribute__((ext_vector_type(8))) short bf16x8;
typedef __attribute__((ext_vector_type(4))) short s16x4;
typedef __attribute__((ext_vector_type(4))) float f32x4;
typedef __attribute__((ext_vector_type(2))) float f32x2;
typedef __attribute__((ext_vector_type(2))) __bf16 bf16x2_t;
typedef unsigned short bfr;

#define DI __device__ __forceinline__

constexpr int T_LAT = 16384, T_CTX = 256, T_ALL = T_LAT + T_CTX;
constexpr int DM = 1024, DIN = 4288, HGC = 2560, RWC = 1728, DRW = 512, DHG = 512;
constexpr int NEXP = 64, DEXP = 512;
constexpr int NTHR = 256;
constexpr float DN_ALPHA = 1.189207115002721f;
constexpr float RW_DECAY_SCALE = 0.6065306597126334f;

constexpr size_t MB = 1ull << 20;
constexpr size_t WS_MOD = 0;
constexpr size_t WS_MODC = 32768;
constexpr size_t WS_LB = 65536;
constexpr size_t WS_CNT = 65536 + 8192;
constexpr size_t WS_BAR = 81920;
constexpr size_t WS_ASGW = 131072;
constexpr size_t WS_LIST = 1 * MB;
constexpr size_t WS_H = 6 * MB;
constexpr size_t WS_P = 42 * MB;
constexpr size_t WS_Y = 42 * MB;
constexpr size_t WS_H2 = 106 * MB;
constexpr size_t WS_HID = 138 * MB;
constexpr size_t WS_RW = 186 * MB;
constexpr size_t RW_ARR = (size_t)T_ALL * 512 * 2;
constexpr size_t WS_LW = 284 * MB;
constexpr size_t LW_ARR = (size_t)T_ALL * 512 * 4;
constexpr size_t WS_YRW = 350 * MB;
constexpr size_t WS_OHG = 414 * MB;
constexpr size_t WS_MOUT = 186 * MB;

struct Params {
  const float* in[32];
  float* out;
  char* ws;
  unsigned* bar;
  int use_cg;
  int pad;
};

DI unsigned pack2(float a, float b) {
  f32x2 v = {a, b};
  bf16x2_t r = __builtin_convertvector(v, bf16x2_t);
  return __builtin_bit_cast(unsigned, r);
}
DI bfr f2bf(float a) { return (bfr)(pack2(a, 0.f) & 0xffffu); }
DI float bf2f(bfr v) { return __uint_as_float(((unsigned)v) << 16); }
DI float sigmoidf_(float x) { return 1.f / (1.f + __expf(-x)); }
DI float siluf_(float x) { return x / (1.f + __expf(-x)); }
DI float wave_sum(float v) {
#pragma unroll
  for (int o = 32; o > 0; o >>= 1) v += __shfl_xor(v, o);
  return v;
}

constexpr int LSTR = 72;
constexpr int GEMM_LDS_BYTES = 2 * 128 * LSTR * 2;

struct ALoadBf16 {
  const bfr* rp[4];
  bf16x8 r[4];
  DI void load(int kt) {
#pragma unroll
    for (int i = 0; i < 4; ++i) r[i] = *(const bf16x8*)(rp[i] + kt * 64);
  }
  DI void store(short* sA) const {
    const int tid = threadIdx.x;
#pragma unroll
    for (int i = 0; i < 4; ++i) *(bf16x8*)(sA + ((tid >> 3) + 32 * i) * LSTR + (tid & 7) * 8) = r[i];
  }
};

struct BLoadF32 {
  const float* p;
  long ldb;
  bool valid;
  f32x4 v[8];
  DI void load(int kt) {
#pragma unroll
    for (int j = 0; j < 8; ++j) {
      if (valid) v[j] = *(const f32x4*)(p + ((long)kt * 64 + j) * ldb);
      else v[j] = f32x4{0.f, 0.f, 0.f, 0.f};
    }
  }
  DI void store(short* sB) const {
    const int tid = threadIdx.x, kg = tid & 7, n4 = tid >> 3;
#pragma unroll
    for (int i = 0; i < 4; ++i) {
      unsigned a0 = pack2(v[0][i], v[1][i]), a1 = pack2(v[2][i], v[3][i]);
      unsigned a2 = pack2(v[4][i], v[5][i]), a3 = pack2(v[6][i], v[7][i]);
      typedef __attribute__((ext_vector_type(4))) unsigned u32x4;
      u32x4 w = {a0, a1, a2, a3};
      *(u32x4*)(sB + (4 * n4 + i) * LSTR + kg * 8) = w;
    }
  }
};

template <class AL, class BL>
DI void gemm_mainloop(short* sA, short* sB, int nk, AL& al, BL& bl, f32x4 (&acc)[4][4]) {
  const int tid = threadIdx.x, wid = tid >> 6, lane = tid & 63;
  const int wr = wid >> 1, wc = wid & 1, fr = lane & 15, fq = lane >> 4;
#pragma unroll
  for (int m = 0; m < 4; ++m)
#pragma unroll
    for (int n = 0; n < 4; ++n) acc[m][n] = f32x4{0.f, 0.f, 0.f, 0.f};
  al.load(0); bl.load(0);
  for (int kt = 0; kt < nk; ++kt) {
    __syncthreads();
    al.store(sA); bl.store(sB);
    __syncthreads();
    if (kt + 1 < nk) { al.load(kt + 1); bl.load(kt + 1); }
#pragma unroll
    for (int ks = 0; ks < 2; ++ks) {
      bf16x8 af[4], bf[4];
#pragma unroll
      for (int m = 0; m < 4; ++m) af[m] = *(const bf16x8*)(sA + (wr * 64 + m * 16 + fr) * LSTR + ks * 32 + fq * 8);
#pragma unroll
      for (int n = 0; n < 4; ++n) bf[n] = *(const bf16x8*)(sB + (wc * 64 + n * 16 + fr) * LSTR + ks * 32 + fq * 8);
#pragma unroll
      for (int m = 0; m < 4; ++m)
#pragma unroll
        for (int n = 0; n < 4; ++n) acc[m][n] = __builtin_amdgcn_mfma_f32_16x16x32_bf16(af[m], bf[n], acc[m][n], 0, 0, 0);
    }
  }
}

DI void phase_mod(const Params& P, int bid, int nb, char* smem) {
  const float* c = P.in[1]; const float* cc = P.in[3];
  const float* w_mod = P.in[4]; const float* b_mod = P.in[5];
  float* mod = (float*)(P.ws + WS_MOD); float* modc = (float*)(P.ws + WS_MODC);
  float* red = (float*)smem;
  const int tid = threadIdx.x;
  for (int it = bid; it < 194; it += nb) {
    if (it < 192) {
      const int kq = tid >> 3, c4 = tid & 7;
      const int col = it * 32 + c4 * 4;
      f32x4 a1 = {0, 0, 0, 0}, a2 = {0, 0, 0, 0};
      for (int k = kq; k < DM; k += 32) {
        f32x4 w = *(const f32x4*)(w_mod + (long)k * 6144 + col);
        float s1 = siluf_(c[k]), s2 = siluf_(cc[k]);
        a1 += w * s1; a2 += w * s2;
      }
      __syncthreads();
#pragma unroll
      for (int e = 0; e < 4; ++e) { red[(kq * 32) + c4 * 4 + e] = a1[e]; red[1024 + kq * 32 + c4 * 4 + e] = a2[e]; }
      __syncthreads();
      if (tid < 64) {
        const int which = tid >> 5, cl = tid & 31;
        float s = 0.f;
        for (int q = 0; q < 32; ++q) s += red[which * 1024 + q * 32 + cl];
        const int cg = it * 32 + cl;
        s += b_mod[cg];
        if (which == 0) mod[cg] = s; else modc[cg] = s;
      }
    } else if (it == 192) {
      const float* L = P.in[8];
      float* lb = (float*)(P.ws + WS_LB);
      for (int i = tid; i < 1024; i += NTHR) {
        const int d = i >> 9, j = i & 511;
        float l0 = L[d * 1024 + j], l1 = L[d * 1024 + 512 + j];
        lb[i] = 1.f / (1.f + __expf(l1 - l0));
      }
    } else {
      int* cnt = (int*)(P.ws + WS_CNT);
      if (tid < 64) cnt[tid] = 0;
    }
  }
}

DI void phase_ln1(const Params& P, int bid, int nb) {
  const float* x = P.in[0]; const float* ctx = P.in[2];
  const float* mod = (const float*)(P.ws + WS_MOD); const float* modc = (const float*)(P.ws + WS_MODC);
  bfr* h = (bfr*)(P.ws + WS_H);
  const int wid = threadIdx.x >> 6, lane = threadIdx.x & 63;
  for (int row = bid * 4 + wid; row < T_ALL; row += nb * 4) {
    const float* src = row < T_LAT ? x + (long)row * DM : ctx + (long)(row - T_LAT) * DM;
    const float* mm = row < T_LAT ? mod : modc;
    f32x4 v[4];
    float s = 0.f;
#pragma unroll
    for (int i = 0; i < 4; ++i) { v[i] = *(const f32x4*)(src + lane * 4 + 256 * i); s += v[i][0] + v[i][1] + v[i][2] + v[i][3]; }
    const float mu = wave_sum(s) * (1.f / DM);
    float q = 0.f;
#pragma unroll
    for (int i = 0; i < 4; ++i) { v[i] -= mu; q += v[i][0] * v[i][0] + v[i][1] * v[i][1] + v[i][2] * v[i][2] + v[i][3] * v[i][3]; }
    const float rs = rsqrtf(wave_sum(q) * (1.f / DM) + 1e-5f);
#pragma unroll
    for (int i = 0; i < 4; ++i) {
      const int cidx = lane * 4 + 256 * i;
      f32x4 sh = *(const f32x4*)(mm + cidx), sc = *(const f32x4*)(mm + 1024 + cidx);
      f32x4 o = v[i] * rs * (sc + 1.f) + sh;
      uint2 w = {pack2(o[0], o[1]), pack2(o[2], o[3])};
      *(uint2*)(h + (long)row * DM + cidx) = w;
    }
  }
}

DI void phase_pgemm(const Params& P, int bid, int nb, char* smem) {
  const bfr* h = (const bfr*)(P.ws + WS_H);
  const float* w_in = P.in[6];
  bfr* p = (bfr*)(P.ws + WS_P);
  short* sA = (short*)smem; short* sB = sA + 128 * LSTR;
  const int tid = threadIdx.x, wid = tid >> 6, lane = tid & 63;
  const int wr = wid >> 1, wc = wid & 1, fr = lane & 15, fq = lane >> 4;
  constexpr int NT = 34, MT = T_ALL / 128;
  for (int it = bid; it < NT * MT; it += nb) {
    const int mt = it / NT, nt = it % NT;
    ALoadBf16 al; BLoadF32 bl;
#pragma unroll
    for (int i = 0; i < 4; ++i) al.rp[i] = h + (long)(mt * 128 + (tid >> 3) + 32 * i) * DM + (tid & 7) * 8;
    const int col = nt * 128 + (tid >> 3) * 4;
    bl.valid = col < DIN; bl.ldb = DIN;
    bl.p = w_in + (long)((tid & 7) * 8) * DIN + (bl.valid ? col : 0);
    f32x4 acc[4][4];
    gemm_mainloop(sA, sB, DM / 64, al, bl, acc);
#pragma unroll
    for (int m = 0; m < 4; ++m)
#pragma unroll
      for (int n = 0; n < 4; ++n) {
        const int cc = nt * 128 + wc * 64 + n * 16 + fr;
        if (cc < DIN) {
#pragma unroll
          for (int j = 0; j < 4; ++j) {
            const int rr = mt * 128 + wr * 64 + m * 16 + fq * 4 + j;
            p[(long)rr * DIN + cc] = f2bf(acc[m][n][j]);
          }
        }
      }
  }
}

DI float rw_mixed(const bfr* p, int row, int c, const float* mu) {
  const long base = (long)row * DIN + HGC + c;
  const float pc = bf2f(p[base]);
  float nbv;
  if (row < T_LAT) {
    const int gr = row >> 6, gc = row & 63;
    float s = 0.f;
    if (gr > 0) s += bf2f(p[base - 64l * DIN]);
    if (gr < 255) s += bf2f(p[base + 64l * DIN]);
    if (gc > 0) s += bf2f(p[base - DIN]);
    if (gc < 63) s += bf2f(p[base + DIN]);
    nbv = 0.25f * s;
  } else {
    const int sidx = row - T_LAT;
    float s = 0.f;
    if (sidx > 0) s += bf2f(p[base - DIN]);
    if (sidx < T_CTX - 1) s += bf2f(p[base + DIN]);
    nbv = 0.5f * s;
  }
  return pc + (nbv - pc) * mu[c];
}

constexpr int RWP_TOK = 16;
DI void phase_rwprep(const Params& P, int bid, int nb, char* smem) {
  const bfr* p = (const bfr*)(P.ws + WS_P);
  const float* mu = P.in[10]; const float* w0 = P.in[11]; const float* wd2 = P.in[12];
  const float* a0 = P.in[13]; const float* wa2 = P.in[14]; const float* wg2 = P.in[15];
  const float* k_k = P.in[16]; const float* k_a = P.in[17];
  bfr* R = (bfr*)(P.ws + WS_RW); bfr* K = (bfr*)(P.ws + WS_RW + RW_ARR); bfr* V = (bfr*)(P.ws + WS_RW + 2 * RW_ARR);
  bfr* KK = (bfr*)(P.ws + WS_RW + 3 * RW_ARR); bfr* A = (bfr*)(P.ws + WS_RW + 4 * RW_ARR); bfr* G = (bfr*)(P.ws + WS_RW + 5 * RW_ARR);
  float* LWF = (float*)(P.ws + WS_LW); float* LWB = (float*)(P.ws + WS_LW + LW_ARR);
  float* lo = (float*)smem;
  const int tid = threadIdx.x;
  for (int it = bid; it < T_ALL / RWP_TOK; it += nb) {
    const int row0 = it * RWP_TOK;
    __syncthreads();
    for (int i = tid; i < RWP_TOK * 192; i += NTHR) {
      const int tk = i / 192, j = i % 192;
      float v = rw_mixed(p, row0 + tk, 1536 + j, mu);
      if (j < 64) v = tanhf(v);
      else if (j >= 96) v = sigmoidf_(v);
      lo[i] = v;
    }
    __syncthreads();
    float av[RWP_TOK][2];
#pragma unroll
    for (int d = 0; d < 2; ++d) {
      float acc[RWP_TOK][2];
#pragma unroll
      for (int t = 0; t < RWP_TOK; ++t) { acc[t][0] = 0.f; acc[t][1] = 0.f; }
      for (int j = 0; j < 32; ++j) {
        const float wA = wd2[(d * 32 + j) * 512 + tid], wB = wd2[(d * 32 + j) * 512 + tid + 256];
#pragma unroll
        for (int t = 0; t < RWP_TOK; ++t) { const float xv = lo[t * 192 + d * 32 + j]; acc[t][0] += xv * wA; acc[t][1] += xv * wB; }
      }
      float* LW = d == 0 ? LWF : LWB;
#pragma unroll
      for (int t = 0; t < RWP_TOK; ++t)
#pragma unroll
        for (int hh = 0; hh < 2; ++hh) {
          const int ch = tid + 256 * hh;
          const float wl = w0[d * 512 + ch] + acc[t][hh];
          LW[(long)(row0 + t) * 512 + ch] = -RW_DECAY_SCALE * sigmoidf_(wl);
        }
    }
    {
#pragma unroll
      for (int t = 0; t < RWP_TOK; ++t) { av[t][0] = 0.f; av[t][1] = 0.f; }
      for (int j = 0; j < 32; ++j) {
        const float wA = wa2[j * 512 + tid], wB = wa2[j * 512 + tid + 256];
#pragma unroll
        for (int t = 0; t < RWP_TOK; ++t) { const float xv = lo[t * 192 + 64 + j]; av[t][0] += xv * wA; av[t][1] += xv * wB; }
      }
#pragma unroll
      for (int t = 0; t < RWP_TOK; ++t)
#pragma unroll
        for (int hh = 0; hh < 2; ++hh) av[t][hh] = sigmoidf_(a0[tid + 256 * hh] + av[t][hh]);
    }
    {
      float acc[RWP_TOK][2];
#pragma unroll
      for (int t = 0; t < RWP_TOK; ++t) { acc[t][0] = 0.f; acc[t][1] = 0.f; }
      for (int j = 0; j < 96; ++j) {
        const float wA = wg2[j * 512 + tid], wB = wg2[j * 512 + tid + 256];
#pragma unroll
        for (int t = 0; t < RWP_TOK; ++t) { const float xv = lo[t * 192 + 96 + j]; acc[t][0] += xv * wA; acc[t][1] += xv * wB; }
      }
#pragma unroll
      for (int t = 0; t < RWP_TOK; ++t)
#pragma unroll
        for (int hh = 0; hh < 2; ++hh) G[(long)(row0 + t) * 512 + tid + 256 * hh] = f2bf(acc[t][hh]);
    }
#pragma unroll
    for (int t = 0; t < RWP_TOK; ++t)
#pragma unroll
      for (int hh = 0; hh < 2; ++hh) {
        const int ch = tid + 256 * hh;
        const int row = row0 + t;
        const float r = rw_mixed(p, row, ch, mu);
        const float kraw = rw_mixed(p, row, 512 + ch, mu);
        const float v = rw_mixed(p, row, 1024 + ch, mu);
        const float kkr = kraw * k_k[ch];
        const float ss = wave_sum(kkr * kkr);
        const float kk = kkr * rsqrtf(fmaxf(ss, 1e-12f));
        const float a = av[t][hh];
        const float k = kraw * (1.f + (a - 1.f) * k_a[ch]);
        const long o = (long)row * 512 + ch;
        R[o] = f2bf(r); K[o] = f2bf(k); V[o] = f2bf(v); KK[o] = f2bf(kk); A[o] = f2bf(a);
      }
  }
}

DI void rwkv_chain_naive(const Params& P, int chain, char* smem) {
  const int dir = chain >> 3, hd = chain & 7;
  const bfr* R = (const bfr*)(P.ws + WS_RW); const bfr* K = (const bfr*)(P.ws + WS_RW + RW_ARR); const bfr* V = (const bfr*)(P.ws + WS_RW + 2 * RW_ARR);
  const bfr* KK = (const bfr*)(P.ws + WS_RW + 3 * RW_ARR); const bfr* A = (const bfr*)(P.ws + WS_RW + 4 * RW_ARR);
  const float* LW = (const float*)(P.ws + WS_LW + (dir ? LW_ARR : 0));
  float* Y = (float*)(P.ws + WS_YRW) + (long)dir * T_LAT * 512;
  float* vec = (float*)smem;
  float* red = vec + 16 * 6 * 64;
  const int tid = threadIdx.x, i = tid & 63, jq = tid >> 6;
  float S[16];
#pragma unroll
  for (int j = 0; j < 16; ++j) S[j] = 0.f;
  for (int s0 = 0; s0 < T_ALL; s0 += 16) {
    __syncthreads();
    for (int e = tid; e < 16 * 64; e += NTHR) {
      const int st = e >> 6, j = e & 63;
      const int s = s0 + st;
      int row;
      if (s < T_CTX) row = T_LAT + (dir ? (T_CTX - 1 - s) : s);
      else row = dir ? (T_LAT - 1 - (s - T_CTX)) : (s - T_CTX);
      const long o = (long)row * 512 + hd * 64 + j;
      float* vp = vec + st * 384;
      const float kk = bf2f(KK[o]);
      vp[j] = bf2f(R[o]); vp[64 + j] = __expf(LW[o]); vp[128 + j] = bf2f(K[o]); vp[192 + j] = bf2f(V[o]);
      vp[256 + j] = kk; vp[320 + j] = kk * bf2f(A[o]);
    }
    __syncthreads();
    for (int st = 0; st < 16; ++st) {
      const float* vp = vec + st * 384;
      const int par = st & 1;
      float sa = 0.f;
#pragma unroll
      for (int j = 0; j < 16; ++j) sa += S[j] * vp[256 + jq * 16 + j];
      red[(par * 2 + 0) * 256 + jq * 64 + i] = sa;
      __syncthreads();
      sa = red[(par * 2) * 256 + i] + red[(par * 2) * 256 + 64 + i] + red[(par * 2) * 256 + 128 + i] + red[(par * 2) * 256 + 192 + i];
      const float vi = vp[192 + i];
      float y = 0.f;
#pragma unroll
      for (int j = 0; j < 16; ++j) {
        const int jj = jq * 16 + j;
        S[j] = S[j] * vp[64 + jj] - sa * vp[320 + jj] + vi * vp[128 + jj];
        y += S[j] * vp[jj];
      }
      red[(par * 2 + 1) * 256 + jq * 64 + i] = y;
      __syncthreads();
      const int s = s0 + st;
      if (jq == 0 && s >= T_CTX) {
        y = red[(par * 2 + 1) * 256 + i] + red[(par * 2 + 1) * 256 + 64 + i] + red[(par * 2 + 1) * 256 + 128 + i] + red[(par * 2 + 1) * 256 + 192 + i];
        const int row = dir ? (T_LAT - 1 - (s - T_CTX)) : (s - T_CTX);
        Y[(long)row * 512 + hd * 64 + i] = y;
      }
    }
  }
}

DI void hgrn_chain_naive(const Params& P, int chain, char* smem) {
  const int dir = chain >> 2, hd = chain & 3;
  const bfr* p = (const bfr*)(P.ws + WS_P);
  const float* lb = (const float*)(P.ws + WS_LB) + dir * 512 + hd * 128;
  float* O = (float*)(P.ws + WS_OHG) + (long)dir * T_LAT * 512;
  float* vec = (float*)smem;
  float* red = vec + 16 * 4 * 128;
  const int tid = threadIdx.x, e = tid & 127, dh = tid >> 7;
  float S[64];
#pragma unroll
  for (int d = 0; d < 64; ++d) S[d] = 0.f;
  for (int s0 = 0; s0 < T_ALL; s0 += 16) {
    __syncthreads();
    for (int x = tid; x < 16 * 128; x += NTHR) {
      const int st = x >> 7, d = x & 127;
      const int s = s0 + st;
      int row;
      if (s < T_CTX) row = T_LAT + (dir ? (T_CTX - 1 - s) : s);
      else row = dir ? (T_LAT - 1 - (s - T_CTX)) : (s - T_CTX);
      const bfr* pr = p + (long)row * DIN + hd * 128 + d;
      const float q = bf2f(pr[0]), iv = bf2f(pr[512]), z = bf2f(pr[1024 + dir * 512]);
      const float l = lb[d];
      const float f = l + (1.f - l) * sigmoidf_(z);
      float* vp = vec + st * 512;
      vp[d] = siluf_(q); vp[128 + d] = f; vp[256 + d] = (1.f - l) * sigmoidf_(-z); vp[384 + d] = iv;
    }
    __syncthreads();
    for (int st = 0; st < 16; ++st) {
      const float* vp = vec + st * 512;
      const int par = st & 1;
      const float ve = vp[384 + e];
      float o = 0.f;
#pragma unroll
      for (int d = 0; d < 64; ++d) {
        const int dd = dh * 64 + d;
        S[d] = S[d] * vp[128 + dd] + vp[256 + dd] * ve;
        o += vp[dd] * S[d];
      }
      red[par * 256 + dh * 128 + e] = o;
      __syncthreads();
      const int s = s0 + st;
      if (dh == 0 && s >= T_CTX) {
        o = red[par * 256 + e] + red[par * 256 + 128 + e];
        const int row = dir ? (T_LAT - 1 - (s - T_CTX)) : (s - T_CTX);
        O[(long)row * 512 + hd * 128 + e] = o;
      }
    }
  }
}

#define LDSP(T) __attribute__((address_space(3))) T*
DI int row_of_step(int dir, int s) {
  if (s < T_CTX) return T_LAT + (dir ? (T_CTX - 1 - s) : s);
  return dir ? (T_LAT - 1 - (s - T_CTX)) : (s - T_CTX);
}
DI bf16x8 ld_tr8(const short* base, int stride, int k0, int n0) {
  const int lane = threadIdx.x & 63, g = lane >> 4, q = (lane & 15) >> 2, p = lane & 3;
  const short* a0 = base + (k0 + 8 * g + q) * stride + n0 + 4 * p;
  s16x4 lo = __builtin_amdgcn_ds_read_tr16_b64_v4i16((LDSP(s16x4))a0);
  s16x4 hi = __builtin_amdgcn_ds_read_tr16_b64_v4i16((LDSP(s16x4))(a0 + 4 * stride));
  return __builtin_shufflevector(lo, hi, 0, 1, 2, 3, 4, 5, 6, 7);
}
template <bool AT, bool BT>
DI f32x4 mm_tile(const short* A, int lda, int m0, const short* B, int ldb, int n0, int K, f32x4 acc) {
  const int lane = threadIdx.x & 63, fr = lane & 15, fq = lane >> 4;
#ifdef SLOWMM
#pragma unroll
  for (int reg = 0; reg < 4; ++reg) {
    const int row = m0 + 4 * fq + reg, col = n0 + fr;
    float s = 0.f;
    for (int k = 0; k < K; ++k) {
      const float a = bf2f((bfr)(AT ? A[k * lda + row] : A[row * lda + k]));
      const float b = bf2f((bfr)(BT ? B[col * ldb + k] : B[k * ldb + col]));
      s += a * b;
    }
    acc[reg] += s;
  }
#else
  for (int k0 = 0; k0 < K; k0 += 32) {
    bf16x8 a, b;
    if (AT) a = ld_tr8(A, lda, k0, m0); else a = *(const bf16x8*)(A + (m0 + fr) * lda + k0 + fq * 8);
    if (BT) b = *(const bf16x8*)(B + (n0 + fr) * ldb + k0 + fq * 8); else b = ld_tr8(B, ldb, k0, n0);
    acc = __builtin_amdgcn_mfma_f32_16x16x32_bf16(a, b, acc, 0, 0, 0);
  }
#endif
  return acc;
}
DI void st_tile(short* C, int ldc, int m0, int n0, f32x4 acc) {
  const int lane = threadIdx.x & 63, fr = lane & 15, fq = lane >> 4;
#pragma unroll
  for (int reg = 0; reg < 4; ++reg) C[(m0 + 4 * fq + reg) * ldc + n0 + fr] = (short)f2bf(acc[reg]);
}

constexpr int RW_NSC = 32;
DI int rw_sc_begin(int sc) { return sc * 16 + (sc < 8 ? sc : 8); }
DI int rw_sc_of_chunk(int ci) { return ci < 136 ? ci / 17 : 8 + (ci - 136) / 16; }
constexpr int XS = 72, SS = 40, GS = 72;
constexpr int RWL_XK = 0, RWL_XKB = 4608, RWL_XBB = 9216, RWL_XR = 13824, RWL_XV = 18432, RWL_S = 23040;
constexpr int RWL_GP = 38400, RWL_GQ = 47616, RWL_GAM = 56832, RWL_TOT = 57088, RWL_END = 58112;
constexpr size_t WS_PTOT = 6 * MB;
constexpr size_t WS_QTOT = 10 * MB;
constexpr size_t WS_SINRW = 18 * MB;
constexpr size_t WS_R2P = 350 * MB;
constexpr size_t WS_Y0P = 382 * MB;

DI void rw_levelA_item(const Params& P, int chain, int sc, char* smem) {
  const int dir = chain >> 3, hd = chain & 7;
  const bfr* Rg = (const bfr*)(P.ws + WS_RW); const bfr* Kg = (const bfr*)(P.ws + WS_RW + RW_ARR); const bfr* Vg = (const bfr*)(P.ws + WS_RW + 2 * RW_ARR);
  const bfr* KKg = (const bfr*)(P.ws + WS_RW + 3 * RW_ARR); const bfr* Ag = (const bfr*)(P.ws + WS_RW + 4 * RW_ARR);
  const float* LWg = (const float*)(P.ws + WS_LW + (dir ? LW_ARR : 0));
  bfr* R2P = (bfr*)(P.ws + WS_R2P) + (size_t)dir * T_LAT * 512;
  bfr* Y0P = (bfr*)(P.ws + WS_Y0P) + (size_t)dir * T_LAT * 512;
  short* XK = (short*)(smem + RWL_XK); short* XKB = (short*)(smem + RWL_XKB); short* XBB = (short*)(smem + RWL_XBB);
  short* XR = (short*)(smem + RWL_XR); short* XV = (short*)(smem + RWL_XV);
  short* XZ = XR; short* XR2 = XR; short* GPc = XK;
  short* SL = (short*)(smem + RWL_S); short* SAkk = SL + 32 * SS; short* SAkr = SAkk + 32 * SS; short* SM = SAkr + 32 * SS;
  short* ST = SM + 32 * SS; short* SnAbr = ST + 32 * SS;
  short* XW1 = SL; short* XW2 = SAkr;
  short* GP = (short*)(smem + RWL_GP); short* GQ = (short*)(smem + RWL_GQ);
  float* gam = (float*)(smem + RWL_GAM); float* tot = (float*)(smem + RWL_TOT);
  const int tid = threadIdx.x, lane = tid & 63, w = tid >> 6, fr = lane & 15, fq = lane >> 4;
  const int tm = w >> 1, tn = w & 1;
  const f32x4 z4 = {0.f, 0.f, 0.f, 0.f};
  __syncthreads();
  for (int i = tid; i < 64 * 64; i += NTHR) { const int r = i >> 6, c = i & 63; GP[r * GS + c] = (r == c) ? (short)0x3F80 : (short)0; GQ[r * GS + c] = 0; }
  f32x4 pcum[4], qcum[4];
#pragma unroll
  for (int n = 0; n < 4; ++n) { pcum[n] = z4; qcum[n] = z4; }
  const int c_begin = rw_sc_begin(sc), c_end = rw_sc_begin(sc + 1);
  for (int ci = c_begin; ci < c_end; ++ci) {
    __syncthreads();
    {
      const int j = tid & 63, qt = tid >> 6;
      float lwv[8], lam[8]; bfr rr[8], kr[8], vr[8], kkr[8], ar[8];
      float run = 0.f;
#pragma unroll
      for (int e = 0; e < 8; ++e) {
        const int row = row_of_step(dir, ci * 32 + qt * 8 + e);
        const size_t o = (size_t)row * 512 + hd * 64 + j;
        lwv[e] = LWg[o]; rr[e] = Rg[o]; kr[e] = Kg[o]; vr[e] = Vg[o]; kkr[e] = KKg[o]; ar[e] = Ag[o];
      }
#pragma unroll
      for (int e = 0; e < 8; ++e) { run += lwv[e]; lam[e] = run; }
      tot[qt * 64 + j] = run;
      __syncthreads();
      float base = 0.f, total = 0.f;
#pragma unroll
      for (int q2 = 0; q2 < 4; ++q2) { const float tv = tot[q2 * 64 + j]; total += tv; if (q2 < qt) base += tv; }
#pragma unroll
      for (int e = 0; e < 8; ++e) {
        const float L = base + lam[e], Lp = L - lwv[e];
        const float eL = __expf(L), enL = __expf(-L), eLp = __expf(Lp);
        const float kkv = bf2f(kkr[e]);
        const int t = qt * 8 + e;
        XK[t * XS + j] = (short)f2bf(kkv * eLp);
        XKB[t * XS + j] = (short)f2bf(bf2f(kr[e]) * enL);
        XBB[t * XS + j] = (short)f2bf(kkv * bf2f(ar[e]) * enL);
        XR[t * XS + j] = (short)f2bf(bf2f(rr[e]) * eL);
        XV[t * XS + j] = (short)vr[e];
      }
      if (qt == 0) gam[j] = __expf(total);
    }
    __syncthreads();
    f32x4 tacc; f32x4 rt[2];
    {
      f32x4 aL = mm_tile<false, true>(XK, XS, 16 * tm, XBB, XS, 16 * tn, 64, z4);
      f32x4 aKK = mm_tile<false, true>(XK, XS, 16 * tm, XKB, XS, 16 * tn, 64, z4);
      f32x4 aBR = mm_tile<false, true>(XR, XS, 16 * tm, XBB, XS, 16 * tn, 64, z4);
      f32x4 aKR = mm_tile<false, true>(XR, XS, 16 * tm, XKB, XS, 16 * tn, 64, z4);
#pragma unroll
      for (int reg = 0; reg < 4; ++reg) {
        const int row = 16 * tm + 4 * fq + reg, col = 16 * tn + fr;
        const bool st = col < row, inc = col <= row;
        aL[reg] = st ? aL[reg] : 0.f; aKK[reg] = st ? aKK[reg] : 0.f;
        aBR[reg] = inc ? -aBR[reg] : 0.f; aKR[reg] = inc ? aKR[reg] : 0.f;
        tacc[reg] = (row == col ? 1.f : 0.f) - aL[reg];
      }
      st_tile(SL, SS, 16 * tm, 16 * tn, aL); st_tile(ST, SS, 16 * tm, 16 * tn, tacc);
      st_tile(SAkk, SS, 16 * tm, 16 * tn, aKK); st_tile(SnAbr, SS, 16 * tm, 16 * tn, aBR); st_tile(SAkr, SS, 16 * tm, 16 * tn, aKR);
#pragma unroll
      for (int i = 0; i < 2; ++i)
#pragma unroll
        for (int reg = 0; reg < 4; ++reg) rt[i][reg] = bf2f((bfr)XR[(16 * tm + 4 * fq + reg) * XS + 16 * (2 * tn + i) + fr]);
    }
    __syncthreads();
    f32x4 y0[2];
    {
#pragma unroll
      for (int i = 0; i < 2; ++i) {
        f32x4 z = mm_tile<false, false>(SAkk, SS, 16 * tm, XV, XS, 16 * (2 * tn + i), 32, z4);
        st_tile(XZ, XS, 16 * tm, 16 * (2 * tn + i), z);
        y0[i] = mm_tile<false, false>(SAkr, SS, 16 * tm, XV, XS, 16 * (2 * tn + i), 32, z4);
      }
      f32x4 m = mm_tile<false, false>(SL, SS, 16 * tm, SL, SS, 16 * tn, 32, z4);
      st_tile(SM, SS, 16 * tm, 16 * tn, m);
    }
    __syncthreads();
#pragma unroll 1
    for (int rd = 0; rd < 4; ++rd) {
      f32x4 tnew = mm_tile<false, false>(ST, SS, 16 * tm, SM, SS, 16 * tn, 32, tacc);
      f32x4 mnew = z4;
      if (rd < 3) mnew = mm_tile<false, false>(SM, SS, 16 * tm, SM, SS, 16 * tn, 32, z4);
      __syncthreads();
      tacc = tnew;
      st_tile(ST, SS, 16 * tm, 16 * tn, tacc);
      if (rd < 3) st_tile(SM, SS, 16 * tm, 16 * tn, mnew);
      __syncthreads();
    }
    {
      f32x4 w1[2], w2[2];
#pragma unroll
      for (int i = 0; i < 2; ++i) {
        w1[i] = mm_tile<false, false>(ST, SS, 16 * tm, XK, XS, 16 * (2 * tn + i), 32, z4);
        w2[i] = mm_tile<false, false>(ST, SS, 16 * tm, XZ, XS, 16 * (2 * tn + i), 32, z4);
      }
#pragma unroll
      for (int i = 0; i < 2; ++i) { st_tile(XW1, XS, 16 * tm, 16 * (2 * tn + i), w1[i]); st_tile(XW2, XS, 16 * tm, 16 * (2 * tn + i), w2[i]); }
    }
    __syncthreads();
    f32x4 pa[4], qc[4], r2[2];
    {
#pragma unroll
      for (int n = 0; n < 4; ++n) {
        pa[n] = mm_tile<true, false>(XW1, XS, 16 * w, XBB, XS, 16 * n, 32, z4);
        f32x4 qa = mm_tile<true, false>(XV, XS, 16 * w, XKB, XS, 16 * n, 32, z4);
        f32x4 qb = mm_tile<true, false>(XW2, XS, 16 * w, XBB, XS, 16 * n, 32, z4);
        qc[n] = qa - qb;
      }
#pragma unroll
      for (int i = 0; i < 2; ++i) {
        r2[i] = mm_tile<false, false>(SnAbr, SS, 16 * tm, XW1, XS, 16 * (2 * tn + i), 32, rt[i]);
        y0[i] = mm_tile<false, false>(SnAbr, SS, 16 * tm, XW2, XS, 16 * (2 * tn + i), 32, y0[i]);
      }
    }
    __syncthreads();
    {
#pragma unroll
      for (int n = 0; n < 4; ++n) {
        const float gcol = gam[16 * n + fr];
        f32x4 pc;
#pragma unroll
        for (int reg = 0; reg < 4; ++reg) {
          const int row = 16 * w + 4 * fq + reg, col = 16 * n + fr;
          pc[reg] = ((row == col ? 1.f : 0.f) - pa[n][reg]) * gcol;
          qc[n][reg] *= gcol;
        }
        st_tile(GPc, GS, 16 * w, 16 * n, pc);
      }
#pragma unroll
      for (int i = 0; i < 2; ++i) st_tile(XR2, XS, 16 * tm, 16 * (2 * tn + i), r2[i]);
    }
    __syncthreads();
    {
      if (ci >= 8) {
#pragma unroll
        for (int i = 0; i < 2; ++i) {
          f32x4 o1 = mm_tile<false, true>(XR2, XS, 16 * tm, GP, GS, 16 * (2 * tn + i), 64, z4);
          f32x4 o2 = mm_tile<false, true>(XR2, XS, 16 * tm, GQ, GS, 16 * (2 * tn + i), 64, y0[i]);
#pragma unroll
          for (int reg = 0; reg < 4; ++reg) {
            const int row = row_of_step(dir, ci * 32 + 16 * tm + 4 * fq + reg);
            const size_t o = (size_t)row * 512 + hd * 64 + 16 * (2 * tn + i) + fr;
            R2P[o] = f2bf(o1[reg]); Y0P[o] = f2bf(o2[reg]);
          }
        }
      }
#pragma unroll
      for (int n = 0; n < 4; ++n) {
        pcum[n] = mm_tile<false, false>(GP, GS, 16 * w, GPc, GS, 16 * n, 64, z4);
        qcum[n] = mm_tile<false, false>(GQ, GS, 16 * w, GPc, GS, 16 * n, 64, qc[n]);
      }
    }
    __syncthreads();
#pragma unroll
    for (int n = 0; n < 4; ++n) { st_tile(GP, GS, 16 * w, 16 * n, pcum[n]); st_tile(GQ, GS, 16 * w, 16 * n, qcum[n]); }
  }
  {
    bfr* Pt = (bfr*)(P.ws + WS_PTOT) + (size_t)(chain * RW_NSC + sc) * 4096;
    float* Qt = (float*)(P.ws + WS_QTOT) + (size_t)(chain * RW_NSC + sc) * 4096;
#pragma unroll
    for (int n = 0; n < 4; ++n)
#pragma unroll
      for (int reg = 0; reg < 4; ++reg) {
        const int row = 16 * w + 4 * fq + reg, col = 16 * n + fr;
        Pt[row * 64 + col] = f2bf(pcum[n][reg]); Qt[row * 64 + col] = qcum[n][reg];
      }
  }
}

DI void rw_levelB_chain(const Params& P, int chain, char* smem) {
  short* SB = (short*)smem; short* PT = SB + 64 * GS;
  const bfr* Ptot = (const bfr*)(P.ws + WS_PTOT) + (size_t)chain * RW_NSC * 4096;
  const float* Qtot = (const float*)(P.ws + WS_QTOT) + (size_t)chain * RW_NSC * 4096;
  bfr* SIN = (bfr*)(P.ws + WS_SINRW) + (size_t)chain * (RW_NSC + 1) * 4096;
  const int tid = threadIdx.x, lane = tid & 63, w = tid >> 6, fr = lane & 15, fq = lane >> 4;
  f32x4 S[4];
#pragma unroll
  for (int n = 0; n < 4; ++n) S[n] = f32x4{0.f, 0.f, 0.f, 0.f};
  for (int sc = 0; sc < RW_NSC; ++sc) {
    __syncthreads();
#pragma unroll
    for (int n = 0; n < 4; ++n) {
      st_tile(SB, GS, 16 * w, 16 * n, S[n]);
#pragma unroll
      for (int reg = 0; reg < 4; ++reg) SIN[(size_t)sc * 4096 + (16 * w + 4 * fq + reg) * 64 + 16 * n + fr] = f2bf(S[n][reg]);
    }
    for (int i = tid; i < 512; i += NTHR) {
      const int r = i >> 3, c8 = i & 7;
      *(bf16x8*)(PT + r * GS + c8 * 8) = *(const bf16x8*)(Ptot + (size_t)sc * 4096 + r * 64 + c8 * 8);
    }
    __syncthreads();
#pragma unroll
    for (int n = 0; n < 4; ++n) {
      f32x4 q;
#pragma unroll
      for (int reg = 0; reg < 4; ++reg) q[reg] = Qtot[(size_t)sc * 4096 + (16 * w + 4 * fq + reg) * 64 + 16 * n + fr];
      S[n] = mm_tile<false, false>(SB, GS, 16 * w, PT, GS, 16 * n, 64, q);
    }
  }
}

DI void rw_finish(const Params& P, int bid, int nb) {
  float* YM = P.out;
  const int tid = threadIdx.x, lane = tid & 63, w = tid >> 6, fr = lane & 15, fq = lane >> 4;
  for (int it = bid; it < 512 * 4; it += nb) {
    const int tile = it >> 2, hp = it & 3;
    const int hd = hp * 2 + (w >> 1), tm = w & 1;
    const int t0 = tile * 32;
    f32x4 acc[4];
#pragma unroll
    for (int n = 0; n < 4; ++n) acc[n] = f32x4{0.f, 0.f, 0.f, 0.f};
#pragma unroll
    for (int dir = 0; dir < 2; ++dir) {
      const int ci = dir ? (519 - tile) : (8 + tile);
      const int sc = rw_sc_of_chunk(ci);
      const bfr* A = (const bfr*)(P.ws + WS_R2P) + (size_t)dir * T_LAT * 512 + (size_t)t0 * 512 + hd * 64;
      const bfr* Y0 = (const bfr*)(P.ws + WS_Y0P) + (size_t)dir * T_LAT * 512 + (size_t)t0 * 512 + hd * 64;
      const bfr* Sin = (const bfr*)(P.ws + WS_SINRW) + ((size_t)(dir * 8 + hd) * (RW_NSC + 1) + sc) * 4096;
#pragma unroll
      for (int n = 0; n < 4; ++n) {
#pragma unroll
        for (int k0 = 0; k0 < 64; k0 += 32) {
          bf16x8 a = *(const bf16x8*)(A + (size_t)(16 * tm + fr) * 512 + k0 + fq * 8);
          bf16x8 b = *(const bf16x8*)(Sin + (16 * n + fr) * 64 + k0 + fq * 8);
          acc[n] = __builtin_amdgcn_mfma_f32_16x16x32_bf16(a, b, acc[n], 0, 0, 0);
        }
#pragma unroll
        for (int reg = 0; reg < 4; ++reg) acc[n][reg] += bf2f(Y0[(size_t)(16 * tm + 4 * fq + reg) * 512 + 16 * n + fr]);
      }
    }
#pragma unroll
    for (int n = 0; n < 4; ++n)
#pragma unroll
      for (int reg = 0; reg < 4; ++reg) YM[(size_t)(t0 + 16 * tm + 4 * fq + reg) * 512 + hd * 64 + 16 * n + fr] = acc[n][reg];
  }
}

constexpr int HG_NSC = 64;
DI int hg_sc_begin(int sc) { return sc * 8 + (sc < 8 ? sc : 8); }
DI int hg_sc_of_chunk(int ci) { return ci < 72 ? ci / 9 : 8 + (ci - 72) / 8; }
constexpr int QS = 136;
constexpr int HGL_Q0 = 0, HGL_Q1 = 8704, HGL_KP = 13056, HGL_KH = 21760, HGL_VV = 30464, HGL_PM = 39168, HGL_STT = 41728;
constexpr int HGL_BL = 76544, HGL_TOT = 77056, HGL_END = 78080;
constexpr size_t WS_SINHG = 23 * MB;
constexpr size_t WS_QH = 414 * MB;
constexpr size_t WS_O0 = 446 * MB;
constexpr size_t WS_SLOC = 478 * MB;
constexpr size_t WS_DTOT = 510 * MB;

DI void hg_levelA_item(const Params& P, int chain, int sc, char* smem) {
  const int dir = chain >> 2, hd = chain & 3;
  const bfr* p = (const bfr*)(P.ws + WS_P);
  const float* lbp = (const float*)(P.ws + WS_LB) + dir * 512 + hd * 128;
  bfr* QH = (bfr*)(P.ws + WS_QH) + (size_t)dir * T_LAT * 512;
  bfr* O0 = (bfr*)(P.ws + WS_O0) + (size_t)dir * T_LAT * 512;
  short* Q0 = (short*)(smem + HGL_Q0); short* Q1 = (short*)(smem + HGL_Q1); short* KP = (short*)(smem + HGL_KP);
  short* KH = (short*)(smem + HGL_KH); short* VV = (short*)(smem + HGL_VV); short* PM = (short*)(smem + HGL_PM);
  short* STT = (short*)(smem + HGL_STT);
  float* BL = (float*)(smem + HGL_BL); float* tot = (float*)(smem + HGL_TOT);
  const int tid = threadIdx.x, lane = tid & 63, w = tid >> 6, fr = lane & 15, fq = lane >> 4;
  const f32x4 z4 = {0.f, 0.f, 0.f, 0.f};
  f32x4 S[8][2];
#pragma unroll
  for (int m = 0; m < 8; ++m) { S[m][0] = z4; S[m][1] = z4; }
  const int d = tid & 127, hf = tid >> 7;
  const float lb = lbp[d];
  float dcum = 0.f;
  const int c_begin = hg_sc_begin(sc), c_end = hg_sc_begin(sc + 1);
  for (int ci = c_begin; ci < c_end; ++ci) {
    __syncthreads();
    {
      bfr qr[16], vr[16], zr[16];
#pragma unroll
      for (int e = 0; e < 16; ++e) {
        const int row = row_of_step(dir, ci * 32 + hf * 16 + e);
        const bfr* pr = p + (size_t)row * DIN + hd * 128 + d;
        qr[e] = pr[0]; vr[e] = pr[512]; zr[e] = pr[1024 + dir * 512];
      }
      float lc[16], kv[16]; float run = 0.f;
#pragma unroll
      for (int e = 0; e < 16; ++e) {
        const float sg = sigmoidf_(bf2f(zr[e]));
        const float f = lb + (1.f - lb) * sg;
        kv[e] = (1.f - lb) * (1.f - sg);
        run += __logf(f); lc[e] = run;
      }
      tot[hf * 128 + d] = run;
      __syncthreads();
      const float tot0 = tot[d], tot1 = tot[128 + d];
      const float blast = tot0 + tot1;
#pragma unroll
      for (int e = 0; e < 16; ++e) {
        const int t = hf * 16 + e;
        const float bc = lc[e] + (hf ? tot0 : 0.f);
        const float qs = siluf_(bf2f(qr[e]));
        Q0[t * QS + d] = (short)f2bf(qs * __expf(bc));
        if (hf) Q1[e * QS + d] = (short)f2bf(qs * __expf(lc[e]));
        KP[t * QS + d] = (short)f2bf(kv[e] * __expf(-lc[e]));
        KH[t * QS + d] = (short)f2bf(kv[e] * __expf(blast - bc));
        VV[t * QS + d] = (short)vr[e];
        if (ci >= 8) {
          const int row = row_of_step(dir, ci * 32 + t);
          QH[(size_t)row * 512 + hd * 128 + d] = f2bf(qs * __expf(bc + dcum));
        }
      }
      if (hf == 0) BL[d] = blast;
      dcum += blast;
    }
#pragma unroll
    for (int m = 0; m < 8; ++m)
#pragma unroll
      for (int n = 0; n < 2; ++n) {
        uint2 wv = {pack2(S[m][n][0], S[m][n][1]), pack2(S[m][n][2], S[m][n][3])};
        *(uint2*)(STT + (32 * w + 16 * n + fr) * QS + 16 * m + 4 * fq) = wv;
      }
    __syncthreads();
    {
      f32x4 pt = z4;
      if (w == 0) pt = mm_tile<false, true>(Q0, QS, 0, KP, QS, 0, 128, z4);
      else if (w == 1) pt = mm_tile<false, true>(Q0, QS, 16, KP, QS, 0, 128, z4);
      else if (w == 2) pt = mm_tile<false, true>(Q1, QS, 0, KP, QS, 16, 128, z4);
      if (w == 0 || w == 2) {
#pragma unroll
        for (int reg = 0; reg < 4; ++reg) pt[reg] = (fr <= 4 * fq + reg) ? pt[reg] : 0.f;
      }
      const int ptm = (w == 0 || w == 3) ? 0 : 1, ptn = (w >= 2) ? 1 : 0;
      st_tile(PM, 40, 16 * ptm, 16 * ptn, pt);
    }
    __syncthreads();
    {
#pragma unroll
      for (int m = 0; m < 2; ++m)
#pragma unroll
        for (int n = 0; n < 2; ++n) {
          f32x4 o = mm_tile<false, true>(Q0, QS, 16 * m, STT, QS, 32 * w + 16 * n, 128, z4);
          o = mm_tile<false, false>(PM, 40, 16 * m, VV, QS, 32 * w + 16 * n, 32, o);
          if (ci >= 8) {
#pragma unroll
            for (int reg = 0; reg < 4; ++reg) {
              const int row = row_of_step(dir, ci * 32 + 16 * m + 4 * fq + reg);
              O0[(size_t)row * 512 + hd * 128 + 32 * w + 16 * n + fr] = f2bf(o[reg]);
            }
          }
        }
#pragma unroll
      for (int m = 0; m < 8; ++m) {
        const f32x4 bl = *(const f32x4*)(BL + 16 * m + 4 * fq);
        f32x4 sc4 = {__expf(bl[0]), __expf(bl[1]), __expf(bl[2]), __expf(bl[3])};
#pragma unroll
        for (int n = 0; n < 2; ++n) S[m][n] = mm_tile<true, false>(KH, QS, 16 * m, VV, QS, 32 * w + 16 * n, 32, S[m][n] * sc4);
      }
    }
  }
  {
    float* SL_ = (float*)(P.ws + WS_SLOC) + (size_t)(chain * HG_NSC + sc) * 16384;
    float* DT = (float*)(P.ws + WS_DTOT) + (size_t)(chain * HG_NSC + sc) * 128;
#pragma unroll
    for (int m = 0; m < 8; ++m)
#pragma unroll
      for (int n = 0; n < 2; ++n) *(f32x4*)(SL_ + (32 * w + 16 * n + fr) * 128 + 16 * m + 4 * fq) = S[m][n];
    if (hf == 0) DT[d] = dcum;
  }
}

DI void hg_levelB(const Params& P, int bid, int nb) {
  const float* SLOC = (const float*)(P.ws + WS_SLOC); const float* DT = (const float*)(P.ws + WS_DTOT);
  bfr* SIN = (bfr*)(P.ws + WS_SINHG);
  for (int idx = bid * NTHR + threadIdx.x; idx < 8 * 16384; idx += nb * NTHR) {
    const int chain = idx >> 14, ed = idx & 16383, dd = ed & 127;
    float s = 0.f;
    for (int sc = 0; sc < HG_NSC; ++sc) {
      const size_t item = (size_t)chain * HG_NSC + sc;
      SIN[item * 16384 + ed] = f2bf(s);
      s = __expf(DT[item * 128 + dd]) * s + SLOC[item * 16384 + ed];
    }
  }
}

DI void hg_finish(const Params& P, int bid, int nb, float* OM) {
  const int tid = threadIdx.x, lane = tid & 63, w = tid >> 6, fr = lane & 15, fq = lane >> 4;
  for (int it = bid; it < 512 * 4; it += nb) {
    const int tile = it >> 2, hd = it & 3;
    const int t0 = tile * 32;
    f32x4 acc[2][2];
#pragma unroll
    for (int m = 0; m < 2; ++m) { acc[m][0] = f32x4{0.f, 0.f, 0.f, 0.f}; acc[m][1] = f32x4{0.f, 0.f, 0.f, 0.f}; }
#pragma unroll
    for (int dir = 0; dir < 2; ++dir) {
      const int ci = dir ? (519 - tile) : (8 + tile);
      const int sc = hg_sc_of_chunk(ci);
      const bfr* A = (const bfr*)(P.ws + WS_QH) + (size_t)dir * T_LAT * 512 + (size_t)t0 * 512 + hd * 128;
      const bfr* O0 = (const bfr*)(P.ws + WS_O0) + (size_t)dir * T_LAT * 512 + (size_t)t0 * 512 + hd * 128;
      const bfr* Sin = (const bfr*)(P.ws + WS_SINHG) + ((size_t)(dir * 4 + hd) * HG_NSC + sc) * 16384;
#pragma unroll
      for (int m = 0; m < 2; ++m)
#pragma unroll
        for (int n = 0; n < 2; ++n) {
#pragma unroll
          for (int k0 = 0; k0 < 128; k0 += 32) {
            bf16x8 a = *(const bf16x8*)(A + (size_t)(16 * m + fr) * 512 + k0 + fq * 8);
            bf16x8 b = *(const bf16x8*)(Sin + (32 * w + 16 * n + fr) * 128 + k0 + fq * 8);
            acc[m][n] = __builtin_amdgcn_mfma_f32_16x16x32_bf16(a, b, acc[m][n], 0, 0, 0);
          }
#pragma unroll
          for (int reg = 0; reg < 4; ++reg) acc[m][n][reg] += bf2f(O0[(size_t)(16 * m + 4 * fq + reg) * 512 + 32 * w + 16 * n + fr]);
        }
    }
#pragma unroll
    for (int m = 0; m < 2; ++m)
#pragma unroll
      for (int n = 0; n < 2; ++n)
#pragma unroll
        for (int reg = 0; reg < 4; ++reg) OM[(size_t)(t0 + 16 * m + 4 * fq + reg) * 512 + hd * 128 + 32 * w + 16 * n + fr] = acc[m][n][reg];
  }
}

DI void phase_readout(const Params& P, int bid, int nb) {
  const bfr* p = (const bfr*)(P.ws + WS_P);
  const float* Of = P.out + (size_t)T_LAT * 512;
  const float* Yf = P.out;
  const bfr* R = (const bfr*)(P.ws + WS_RW); const bfr* K = (const bfr*)(P.ws + WS_RW + RW_ARR); const bfr* V = (const bfr*)(P.ws + WS_RW + 2 * RW_ARR);
  const bfr* G = (const bfr*)(P.ws + WS_RW + 5 * RW_ARR);
  const float* hg_norm_w = P.in[9]; const float* r_k = P.in[18]; const float* gn_w = P.in[19]; const float* gn_b = P.in[20];
  bfr* mix = (bfr*)(P.ws + WS_H);
  const int wid = threadIdx.x >> 6, lane = threadIdx.x & 63;
  for (int t = bid * 4 + wid; t < T_LAT; t += nb * 4) {
    {
      float o[8]; float ss = 0.f;
#pragma unroll
      for (int e = 0; e < 8; ++e) { const long idx = (long)t * 512 + lane * 8 + e; o[e] = Of[idx]; ss += o[e] * o[e]; }
      ss += __shfl_xor(ss, 1); ss += __shfl_xor(ss, 2); ss += __shfl_xor(ss, 4); ss += __shfl_xor(ss, 8);
      const float rs = rsqrtf(ss * (1.f / 128.f) + 1e-6f);
      unsigned w[4];
#pragma unroll
      for (int e = 0; e < 8; e += 2) {
        const int c0 = lane * 8 + e;
        const float g0 = bf2f(p[(long)t * DIN + 2048 + c0]), g1 = bf2f(p[(long)t * DIN + 2048 + c0 + 1]);
        const float v0 = o[e] * rs * hg_norm_w[c0] * siluf_(g0);
        const float v1 = o[e + 1] * rs * hg_norm_w[c0 + 1] * siluf_(g1);
        w[e >> 1] = pack2(v0, v1);
      }
      *(uint4*)(mix + (long)t * DM + lane * 8) = uint4{w[0], w[1], w[2], w[3]};
    }
    {
      float y[8]; float s = 0.f, bs = 0.f;
      float vv[8];
#pragma unroll
      for (int e = 0; e < 8; ++e) {
        const long idx = (long)t * 512 + lane * 8 + e;
        y[e] = Yf[idx]; s += y[e];
        bs += bf2f(R[idx]) * bf2f(K[idx]) * r_k[lane * 8 + e];
        vv[e] = bf2f(V[idx]);
      }
      s += __shfl_xor(s, 1); s += __shfl_xor(s, 2); s += __shfl_xor(s, 4);
      bs += __shfl_xor(bs, 1); bs += __shfl_xor(bs, 2); bs += __shfl_xor(bs, 4);
      const float mu = s * (1.f / 64.f);
      float q = 0.f;
#pragma unroll
      for (int e = 0; e < 8; ++e) { y[e] -= mu; q += y[e] * y[e]; }
      q += __shfl_xor(q, 1); q += __shfl_xor(q, 2); q += __shfl_xor(q, 4);
      const float rs = rsqrtf(q * (1.f / 64.f) + 64e-5f);
      unsigned w[4];
#pragma unroll
      for (int e = 0; e < 8; e += 2) {
        const int c0 = lane * 8 + e;
        const long idx = (long)t * 512 + c0;
        const float v0 = (y[e] * rs * gn_w[c0] + gn_b[c0] + bs * vv[e]) * bf2f(G[idx]);
        const float v1 = (y[e + 1] * rs * gn_w[c0 + 1] + gn_b[c0 + 1] + bs * vv[e + 1]) * bf2f(G[idx + 1]);
        w[e >> 1] = pack2(v0, v1);
      }
      *(uint4*)(mix + (long)t * DM + 512 + lane * 8) = uint4{w[0], w[1], w[2], w[3]};
    }
  }
}

DI void phase_outproj(const Params& P, int bid, int nb, char* smem) {
  const bfr* mix = (const bfr*)(P.ws + WS_H);
  const float* w_out = P.in[7];
  float* y = (float*)(P.ws + WS_Y);
  short* sA = (short*)smem; short* sB = sA + 128 * LSTR;
  const int tid = threadIdx.x, wid = tid >> 6, lane = tid & 63;
  const int wr = wid >> 1, wc = wid & 1, fr = lane & 15, fq = lane >> 4;
  constexpr int NT = 8, MT = T_LAT / 128;
  for (int it = bid; it < NT * MT; it += nb) {
    const int mt = it / NT, nt = it % NT;
    ALoadBf16 al; BLoadF32 bl;
#pragma unroll
    for (int i = 0; i < 4; ++i) al.rp[i] = mix + (long)(mt * 128 + (tid >> 3) + 32 * i) * DM + (tid & 7) * 8;
    bl.valid = true; bl.ldb = DM;
    bl.p = w_out + (long)((tid & 7) * 8) * DM + nt * 128 + (tid >> 3) * 4;
    f32x4 acc[4][4];
    gemm_mainloop(sA, sB, DM / 64, al, bl, acc);
#pragma unroll
    for (int m = 0; m < 4; ++m)
#pragma unroll
      for (int n = 0; n < 4; ++n)
#pragma unroll
        for (int j = 0; j < 4; ++j) {
          const int rr = mt * 128 + wr * 64 + m * 16 + fq * 4 + j, cc = nt * 128 + wc * 64 + n * 16 + fr;
          y[(long)rr * DM + cc] = acc[m][n][j];
        }
  }
}

DI void phase_ln2route(const Params& P, int bid, int nb) {
  const float* x = P.in[0];
  const float* y = (const float*)(P.ws + WS_Y);
  const float* mod = (const float*)(P.ws + WS_MOD);
  const float* ln1_g = P.in[21]; const float* ln1_b = P.in[22];
  const float* wgrp = P.in[25]; const float* bgrp = P.in[26]; const float* wrt = P.in[27]; const float* brt = P.in[28];
  float* x1 = P.out;
  bfr* h2 = (bfr*)(P.ws + WS_H2);
  int* cnt = (int*)(P.ws + WS_CNT); int* list = (int*)(P.ws + WS_LIST); float* asgw = (float*)(P.ws + WS_ASGW);
  const int wid = threadIdx.x >> 6, lane = threadIdx.x & 63;
  for (int t = bid * 4 + wid; t < T_LAT; t += nb * 4) {
    f32x4 v[4]; float s = 0.f;
#pragma unroll
    for (int i = 0; i < 4; ++i) {
      const int c = lane * 4 + 256 * i;
      f32x4 xv = *(const f32x4*)(x + (long)t * DM + c), yv = *(const f32x4*)(y + (long)t * DM + c), g1 = *(const f32x4*)(mod + 2048 + c);
      v[i] = xv * DN_ALPHA + g1 * yv;
      s += v[i][0] + v[i][1] + v[i][2] + v[i][3];
    }
    float mu = wave_sum(s) * (1.f / DM); float q = 0.f;
#pragma unroll
    for (int i = 0; i < 4; ++i) { v[i] -= mu; q += v[i][0] * v[i][0] + v[i][1] * v[i][1] + v[i][2] * v[i][2] + v[i][3] * v[i][3]; }
    float rs = rsqrtf(wave_sum(q) * (1.f / DM) + 1e-5f);
    s = 0.f;
#pragma unroll
    for (int i = 0; i < 4; ++i) {
      const int c = lane * 4 + 256 * i;
      f32x4 g = *(const f32x4*)(ln1_g + c), b = *(const f32x4*)(ln1_b + c);
      v[i] = v[i] * rs * g + b;
      *(f32x4*)(x1 + (long)t * DM + c) = v[i];
      s += v[i][0] + v[i][1] + v[i][2] + v[i][3];
    }
    mu = wave_sum(s) * (1.f / DM); q = 0.f;
#pragma unroll
    for (int i = 0; i < 4; ++i) { v[i] -= mu; q += v[i][0] * v[i][0] + v[i][1] * v[i][1] + v[i][2] * v[i][2] + v[i][3] * v[i][3]; }
    rs = rsqrtf(wave_sum(q) * (1.f / DM) + 1e-5f);
#pragma unroll
    for (int i = 0; i < 4; ++i) {
      const int c = lane * 4 + 256 * i;
      f32x4 sh = *(const f32x4*)(mod + 3072 + c), sc = *(const f32x4*)(mod + 4096 + c);
      v[i] = v[i] * rs * (sc + 1.f) + sh;
      uint2 w = {pack2(v[i][0], v[i][1]), pack2(v[i][2], v[i][3])};
      *(uint2*)(h2 + (long)t * DM + c) = w;
    }
    float gl[8];
#pragma unroll
    for (int g = 0; g < 8; ++g) gl[g] = 0.f;
#pragma unroll
    for (int i = 0; i < 4; ++i)
#pragma unroll
      for (int e = 0; e < 4; ++e) {
        const int k = lane * 4 + 256 * i + e;
        const f32x4 w0 = *(const f32x4*)(wgrp + k * 8), w1 = *(const f32x4*)(wgrp + k * 8 + 4);
        const float hv = v[i][e];
        gl[0] += hv * w0[0]; gl[1] += hv * w0[1]; gl[2] += hv * w0[2]; gl[3] += hv * w0[3];
        gl[4] += hv * w1[0]; gl[5] += hv * w1[1]; gl[6] += hv * w1[2]; gl[7] += hv * w1[3];
      }
    int gi = 0; float gmax = -3.4e38f;
#pragma unroll
    for (int g = 0; g < 8; ++g) { gl[g] = wave_sum(gl[g]) + bgrp[g]; if (gl[g] > gmax) { gmax = gl[g]; gi = g; } }
    float den = 0.f;
#pragma unroll
    for (int g = 0; g < 8; ++g) den += __expf(gl[g] - gmax);
    const float gprob = 1.f / den;
    float el[8];
#pragma unroll
    for (int g = 0; g < 8; ++g) el[g] = 0.f;
#pragma unroll
    for (int i = 0; i < 4; ++i)
#pragma unroll
      for (int e = 0; e < 4; ++e) {
        const int k = lane * 4 + 256 * i + e;
        const f32x4 w0 = *(const f32x4*)(wrt + k * 64 + gi * 8), w1 = *(const f32x4*)(wrt + k * 64 + gi * 8 + 4);
        const float hv = v[i][e];
        el[0] += hv * w0[0]; el[1] += hv * w0[1]; el[2] += hv * w0[2]; el[3] += hv * w0[3];
        el[4] += hv * w1[0]; el[5] += hv * w1[1]; el[6] += hv * w1[2]; el[7] += hv * w1[3];
      }
    int i1 = 0; float v1 = -3.4e38f;
#pragma unroll
    for (int g = 0; g < 8; ++g) { el[g] = wave_sum(el[g]) + brt[gi * 8 + g]; if (el[g] > v1) { v1 = el[g]; i1 = g; } }
    int i2 = 0; float v2 = -3.4e38f;
#pragma unroll
    for (int g = 0; g < 8; ++g) { if (g != i1 && el[g] > v2) { v2 = el[g]; i2 = g; } }
    const float e2 = __expf(v2 - v1);
    const float wt1 = gprob / (1.f + e2), wt2 = gprob * e2 / (1.f + e2);
    if (lane == 0) {
      const int ex1 = gi * 8 + i1, ex2 = gi * 8 + i2;
      int s1 = atomicAdd(&cnt[ex1], 1); list[ex1 * T_LAT + s1] = t * 2;
      int s2 = atomicAdd(&cnt[ex2], 1); list[ex2 * T_LAT + s2] = t * 2 + 1;
      asgw[t * 2] = wt1; asgw[t * 2 + 1] = wt2;
    }
  }
}

DI void moe_block_table(const Params& P, int* tab  ) {
  const int* cnt = (const int*)(P.ws + WS_CNT);
  const int tid = threadIdx.x;
  __syncthreads();
  if (tid < 64) {
    int nbk = (cnt[tid] + 127) >> 7;
    int incl = nbk;
#pragma unroll
    for (int o = 1; o < 64; o <<= 1) { int u = __shfl_up(incl, o); if (tid >= o) incl += u; }
    tab[tid + 1] = incl;
    if (tid == 0) tab[0] = 0;
  }
  __syncthreads();
}
DI int moe_find_expert(const int* tab, int rb) {
  int e = 0;
  while (tab[e + 1] <= rb) ++e;
  return e;
}

DI void phase_moe1(const Params& P, int bid, int nb, char* smem) {
  const bfr* h2 = (const bfr*)(P.ws + WS_H2);
  const int* cnt = (const int*)(P.ws + WS_CNT); const int* list = (const int*)(P.ws + WS_LIST);
  const float* wg = P.in[29]; const float* wu = P.in[30];
  bfr* hid = (bfr*)(P.ws + WS_HID);
  short* sA = (short*)smem; short* sB = sA + 128 * LSTR;
  int* tab = (int*)(smem + GEMM_LDS_BYTES);
  const int tid = threadIdx.x, wid = tid >> 6, lane = tid & 63;
  const int wr = wid >> 1, wc = wid & 1, fr = lane & 15, fq = lane >> 4;
  moe_block_table(P, tab);
  const int nrb = tab[64];
  for (int it = bid; it < nrb * 8; it += nb) {
    const int rb = it >> 3, nt = it & 7;
    const int e = moe_find_expert(tab, rb);
    const int lrb = rb - tab[e];
    const int ce = cnt[e];
    ALoadBf16 al; BLoadF32 bl;
#pragma unroll
    for (int i = 0; i < 4; ++i) {
      int r = lrb * 128 + (tid >> 3) + 32 * i;
      if (r >= ce) r = ce - 1;
      const int tok = list[e * T_LAT + r] >> 1;
      al.rp[i] = h2 + (long)tok * DM + (tid & 7) * 8;
    }
    const int n4 = tid >> 3;
    const int isup = (n4 >> 3) & 1;
    const int col = nt * 64 + (n4 >> 4) * 32 + ((4 * n4) & 31);
    bl.valid = true; bl.ldb = DEXP;
    bl.p = (isup ? wu : wg) + (long)e * DM * DEXP + (long)((tid & 7) * 8) * DEXP + col;
    f32x4 acc[4][4];
    gemm_mainloop(sA, sB, DM / 64, al, bl, acc);
#pragma unroll
    for (int m = 0; m < 4; ++m)
#pragma unroll
      for (int n = 0; n < 2; ++n)
#pragma unroll
        for (int j = 0; j < 4; ++j) {
          const int rl = wr * 64 + m * 16 + fq * 4 + j;
          const int cc = nt * 64 + wc * 32 + n * 16 + fr;
          const float gv = acc[m][n][j], uv = acc[m][n + 2][j];
          hid[((long)rb * 128 + rl) * DEXP + cc] = f2bf(siluf_(gv) * uv);
        }
  }
}

DI void phase_moe2(const Params& P, int bid, int nb, char* smem) {
  const int* cnt = (const int*)(P.ws + WS_CNT); const int* list = (const int*)(P.ws + WS_LIST);
  const float* wd = P.in[31];
  const bfr* hid = (const bfr*)(P.ws + WS_HID);
  bfr* mout = (bfr*)(P.ws + WS_MOUT);
  short* sA = (short*)smem; short* sB = sA + 128 * LSTR;
  int* tab = (int*)(smem + GEMM_LDS_BYTES);
  const int tid = threadIdx.x, wid = tid >> 6, lane = tid & 63;
  const int wr = wid >> 1, wc = wid & 1, fr = lane & 15, fq = lane >> 4;
  moe_block_table(P, tab);
  const int nrb = tab[64];
  for (int it = bid; it < nrb * 8; it += nb) {
    const int rb = it >> 3, nt = it & 7;
    const int e = moe_find_expert(tab, rb);
    const int lrb = rb - tab[e];
    const int ce = cnt[e];
    ALoadBf16 al; BLoadF32 bl;
#pragma unroll
    for (int i = 0; i < 4; ++i) al.rp[i] = hid + ((long)rb * 128 + (tid >> 3) + 32 * i) * DEXP + (tid & 7) * 8;
    bl.valid = true; bl.ldb = DM;
    bl.p = wd + (long)e * DEXP * DM + (long)((tid & 7) * 8) * DM + nt * 128 + (tid >> 3) * 4;
    f32x4 acc[4][4];
    gemm_mainloop(sA, sB, DEXP / 64, al, bl, acc);
#pragma unroll
    for (int m = 0; m < 4; ++m)
#pragma unroll
      for (int j = 0; j < 4; ++j) {
        const int r = lrb * 128 + wr * 64 + m * 16 + fq * 4 + j;
        if (r < ce) {
          const int asg = list[e * T_LAT + r];
#pragma unroll
          for (int n = 0; n < 4; ++n) mout[(long)asg * DM + nt * 128 + wc * 64 + n * 16 + fr] = f2bf(acc[m][n][j]);
        }
      }
  }
}

DI void phase_final(const Params& P, int bid, int nb) {
  const float* mod = (const float*)(P.ws + WS_MOD);
  const float* ln2_g = P.in[23]; const float* ln2_b = P.in[24];
  const bfr* mout = (const bfr*)(P.ws + WS_MOUT);
  const float* asgw = (const float*)(P.ws + WS_ASGW);
  float* out = P.out;
  const int wid = threadIdx.x >> 6, lane = threadIdx.x & 63;
  for (int t = bid * 4 + wid; t < T_LAT; t += nb * 4) {
    const float w1 = asgw[t * 2], w2 = asgw[t * 2 + 1];
    f32x4 v[4]; float s = 0.f;
#pragma unroll
    for (int i = 0; i < 4; ++i) {
      const int c = lane * 4 + 256 * i;
      f32x4 xv = *(const f32x4*)(out + (long)t * DM + c), g2 = *(const f32x4*)(mod + 5120 + c);
      const uint2 m1 = *(const uint2*)(mout + (long)(2 * t) * DM + c), m2 = *(const uint2*)(mout + (long)(2 * t + 1) * DM + c);
      f32x4 a = {__uint_as_float(m1.x << 16), __uint_as_float(m1.x & 0xffff0000u), __uint_as_float(m1.y << 16), __uint_as_float(m1.y & 0xffff0000u)};
      f32x4 b = {__uint_as_float(m2.x << 16), __uint_as_float(m2.x & 0xffff0000u), __uint_as_float(m2.y << 16), __uint_as_float(m2.y & 0xffff0000u)};
      v[i] = xv * DN_ALPHA + g2 * (a * w1 + b * w2);
      s += v[i][0] + v[i][1] + v[i][2] + v[i][3];
    }
    const float mu = wave_sum(s) * (1.f / DM); float q = 0.f;
#pragma unroll
    for (int i = 0; i < 4; ++i) { v[i] -= mu; q += v[i][0] * v[i][0] + v[i][1] * v[i][1] + v[i][2] * v[i][2] + v[i][3] * v[i][3]; }
    const float rs = rsqrtf(wave_sum(q) * (1.f / DM) + 1e-5f);
#pragma unroll
    for (int i = 0; i < 4; ++i) {
      const int c = lane * 4 + 256 * i;
      f32x4 g = *(const f32x4*)(ln2_g + c), b = *(const f32x4*)(ln2_b + c);
      *(f32x4*)(out + (long)t * DM + c) = v[i] * rs * g + b;
    }
  }
}

#define XB_TMO      128
#define XB_XCNT(j)  (256  + 64 * (j))
#define XB_XSUB(j)  (1280 + 64 * (j))
#define XB_XGEN(j)  (2304 + 64 * (j))
#define XB_TOP      3328
#define XB_TOPGEN   3392
#define XCD_BAR_WORDS 3456
#define XB_SPIN_CAP (1u << 22)
#define LAS __attribute__((address_space(3)))
DI unsigned xb_ld(unsigned* p)              { return __hip_atomic_load(p, __ATOMIC_RELAXED, __HIP_MEMORY_SCOPE_AGENT); }
DI unsigned xb_add(unsigned* p, unsigned v) { return __hip_atomic_fetch_add(p, v, __ATOMIC_RELAXED, __HIP_MEMORY_SCOPE_AGENT); }
DI unsigned xb_xcc_id() { return (unsigned)__builtin_amdgcn_s_getreg((3 << 11) | 20) & 0xFu; }
#define XB_SPIN(cond, bar) do { unsigned _sp = 0; while (cond) { __builtin_amdgcn_s_sleep(1); \
    if ((++_sp & 255u) == 0u) { if (xb_ld(&(bar)[XB_TMO])) break; if (_sp > XB_SPIN_CAP) { atomicAdd(&(bar)[XB_TMO], 1u); break; } } } } while (0)
struct XcdBarrier { unsigned* bar; unsigned x; volatile LAS unsigned* st; };
DI XcdBarrier xcd_barrier_post(unsigned* bar, volatile LAS unsigned* st) {
  XcdBarrier b; b.bar = bar; b.x = xb_xcc_id(); b.st = st;
  if (threadIdx.x == 0) (void)xb_add(&bar[XB_XCNT(b.x)], 1u);
  return b;
}
DI void xcd_barrier_complete(unsigned* bar, unsigned x, unsigned& nloc, unsigned& nx) {
  const unsigned G = gridDim.x * gridDim.y * gridDim.z;
  unsigned sum, cnt, mine, sp = 0u;
  for (;;) {
    sum = 0u; cnt = 0u; mine = 0u;
#pragma unroll
    for (unsigned j = 0; j < 16; ++j) { const unsigned c = xb_ld(&bar[XB_XCNT(j)]); sum += c; cnt += (c > 0u) ? 1u : 0u; mine = (j == x) ? c : mine; }
    if (sum == G) break;
    __builtin_amdgcn_s_sleep(1);
    if ((++sp & 255u) == 0u) { if (xb_ld(&bar[XB_TMO])) break; if (sp > XB_SPIN_CAP) { atomicAdd(&bar[XB_TMO], 1u); break; } }
  }
  nloc = mine > 0u ? mine : 1u; nx = cnt > 0u ? cnt : 1u;
}
DI void xcd_barrier(const XcdBarrier& b) {
  asm volatile("s_waitcnt vmcnt(0)" ::: "memory");
  __syncthreads();
  if (threadIdx.x == 0) {
    unsigned* bar = b.bar;
    __builtin_amdgcn_s_waitcnt(0);
    unsigned nloc = b.st[0], nx = b.st[1];
    if (nloc == 0u) { xcd_barrier_complete(bar, b.x, nloc, nx); b.st[0] = nloc; b.st[1] = nx; }
    const unsigned old = xb_add(&bar[XB_XSUB(b.x)], 1u);
    const unsigned gen = old / nloc;
    if (old + 1u == (gen + 1u) * nloc) {
      __builtin_amdgcn_fence(__ATOMIC_RELEASE, "agent");
      asm volatile("s_waitcnt vmcnt(0)" ::: "memory");
      const unsigned og = xb_add(&bar[XB_TOP], 1u);
      const unsigned tg = og / nx;
      if (og + 1u == (tg + 1u) * nx) xb_add(&bar[XB_TOPGEN], 1u);
      else XB_SPIN(xb_ld(&bar[XB_TOPGEN]) == tg, bar);
      __builtin_amdgcn_fence(__ATOMIC_ACQUIRE, "agent");
      xb_add(&bar[XB_XGEN(b.x)], 1u);
      asm volatile("s_waitcnt vmcnt(0)" ::: "memory");
    } else {
      XB_SPIN(xb_ld(&bar[XB_XGEN(b.x)]) == gen, bar);
      __builtin_amdgcn_fence(__ATOMIC_ACQUIRE, "agent");
      asm volatile("s_waitcnt vmcnt(0)" ::: "memory");
    }
  }
  __syncthreads();
}

namespace cg = cooperative_groups;
constexpr int SMEM_BYTES = 78080 + 16;
__global__ void __launch_bounds__(NTHR, 2) k_fused(Params P) {
  __shared__ __attribute__((aligned(16))) char smem[SMEM_BYTES];
  cg::grid_group grid = cg::this_grid();
  const int bid = blockIdx.x, nb = gridDim.x;
  volatile LAS unsigned* bst = (volatile LAS unsigned*)(smem + SMEM_BYTES - 16);
  if (threadIdx.x < 4) bst[threadIdx.x] = 0u;
  __syncthreads();
  XcdBarrier xb = xcd_barrier_post(P.bar, bst);
#define GSYNC() do { if (P.use_cg) grid.sync(); else xcd_barrier(xb); } while (0)
  phase_mod(P, bid, nb, smem);
  GSYNC();
  phase_ln1(P, bid, nb);
  GSYNC();
  phase_pgemm(P, bid, nb, smem);
  GSYNC();
  phase_rwprep(P, bid, nb, smem);
  GSYNC();
  for (int it = bid; it < 16 * RW_NSC; it += nb) rw_levelA_item(P, it / RW_NSC, it % RW_NSC, smem);
  for (int it = bid; it < 8 * HG_NSC; it += nb) hg_levelA_item(P, it / HG_NSC, it % HG_NSC, smem);
  GSYNC();
  if (bid < 16) rw_levelB_chain(P, bid, smem); else hg_levelB(P, bid - 16, nb - 16);
  GSYNC();
  rw_finish(P, bid, nb);
  hg_finish(P, bid, nb, P.out + (size_t)T_LAT * 512);
  GSYNC();
  phase_readout(P, bid, nb);
  GSYNC();
  phase_outproj(P, bid, nb, smem);
  GSYNC();
  phase_ln2route(P, bid, nb);
  GSYNC();
  phase_moe1(P, bid, nb, smem);
  GSYNC();
  phase_moe2(P, bid, nb, smem);
  GSYNC();
  phase_final(P, bid, nb);
}

extern "C" void kernel_launch(void* const* d_in, const int* in_sizes, int n_in, void* d_out, int out_size, void* d_ws, size_t ws_size, hipStream_t stream) {
  static int grid_blocks = 0;
  if (!grid_blocks) {
    int dev = 0, cus = 0, per_cu = 0;
    hipGetDevice(&dev);
    hipDeviceGetAttribute(&cus, hipDeviceAttributeMultiprocessorCount, dev);
    hipOccupancyMaxActiveBlocksPerMultiprocessor(&per_cu, k_fused, NTHR, 0);
    if (per_cu > 2) per_cu = 2;
    if (per_cu < 1) per_cu = 1;
    grid_blocks = cus * per_cu;
  }
  Params P{};
  P.bar = (unsigned*)((char*)d_ws + WS_BAR); P.use_cg = 0; P.pad = 0;
  hipMemsetAsync((char*)d_ws + WS_BAR, 0, XCD_BAR_WORDS * 4, stream);
  for (int i = 0; i < 32; ++i) P.in[i] = (const float*)d_in[i];
  P.out = (float*)d_out; P.ws = (char*)d_ws;
  void* args[] = {&P};
  hipError_t e = hipLaunchCooperativeKernel((void*)k_fused, dim3(grid_blocks), dim3(NTHR), args, 0, stream);
  if (e != hipSuccess) fprintf(stderr, "cooperative launch failed: %s (grid %d)\n", hipGetErrorString(e), grid_blocks);
}
```

```cpp
#include <hip/hip_runtime.h>
#include <hip/hip_cooperative_groups.h>
#include <cstdio>

typedef __attribute__((ext_vector_type(8))) short bf16x8;
typedef __attribute__((ext_vector_type(4))) short s16x4;
typedef __attribute__((ext_vector_type(4))) float f32x4;
typedef __attribute__((ext_vector_type(2))) float f32x2;
typedef __attribute__((ext_vector_type(2))) __bf16 bf16x2_t;
typedef unsigned short bfr;

#define DI __device__ __forceinline__

constexpr int T_LAT = 16384, T_CTX = 256, T_ALL = T_LAT + T_CTX;
constexpr int DM = 1024, DIN = 4288, HGC = 2560, RWC = 1728, DRW = 512, DHG = 512;
constexpr int NEXP = 64, DEXP = 512;
constexpr int NTHR = 256;
constexpr int NTHR_BLOCK = 512;
#define VT ((int)(threadIdx.x & 255))
constexpr float DN_ALPHA = 1.189207115002721f;
constexpr float RW_DECAY_SCALE = 0.6065306597126334f;

constexpr size_t MB = 1ull << 20;
constexpr size_t WS_MOD = 0;
constexpr size_t WS_MODC = 32768;
constexpr size_t WS_LB = 65536;
constexpr size_t WS_CNT = 65536 + 8192;
constexpr size_t WS_BAR = 81920;
constexpr size_t WS_ASGW = 131072;
constexpr size_t WS_LIST = 1 * MB;
constexpr size_t WS_H = 6 * MB;
constexpr size_t WS_P = 42 * MB;
constexpr size_t WS_Y = 42 * MB;
constexpr size_t WS_H2 = 106 * MB;
constexpr size_t WS_HID = 138 * MB;
constexpr size_t WS_RW = 186 * MB;
constexpr size_t RW_ARR = (size_t)T_ALL * 512 * 2;
constexpr size_t WS_LW = 284 * MB;
constexpr size_t LW_ARR = (size_t)T_ALL * 512 * 4;
constexpr size_t WS_YRW = 350 * MB;
constexpr size_t WS_OHG = 414 * MB;
constexpr size_t WS_MOUT = 186 * MB;

struct Params {
  const float* in[32];
  float* out;
  char* ws;
  unsigned* bar;
  int use_cg;
  int pad;
};

DI unsigned pack2(float a, float b) {
  f32x2 v = {a, b};
  bf16x2_t r = __builtin_convertvector(v, bf16x2_t);
  return __builtin_bit_cast(unsigned, r);
}
DI bfr f2bf(float a) { return (bfr)(pack2(a, 0.f) & 0xffffu); }
DI float bf2f(bfr v) { return __uint_as_float(((unsigned)v) << 16); }
DI float sigmoidf_(float x) { return 1.f / (1.f + __expf(-x)); }
DI float siluf_(float x) { return x / (1.f + __expf(-x)); }
DI float wave_sum(float v) {
#pragma unroll
  for (int o = 32; o > 0; o >>= 1) v += __shfl_xor(v, o);
  return v;
}

constexpr int LSTR = 72;
constexpr int GEMM_LDS_BYTES = 2 * 128 * LSTR * 2;

struct ALoadBf16 {
  const bfr* rp[4];
  bf16x8 r[4];
  DI void load(int kt) {
#pragma unroll
    for (int i = 0; i < 4; ++i) r[i] = *(const bf16x8*)(rp[i] + kt * 64);
  }
  DI void store(short* sA) const {
    const int tid = VT;
#pragma unroll
    for (int i = 0; i < 4; ++i) *(bf16x8*)(sA + ((tid >> 3) + 32 * i) * LSTR + (tid & 7) * 8) = r[i];
  }
};

struct BLoadF32 {
  const float* p;
  long ldb;
  bool valid;
  f32x4 v[8];
  DI void load(int kt) {
#pragma unroll
    for (int j = 0; j < 8; ++j) {
      if (valid) v[j] = *(const f32x4*)(p + ((long)kt * 64 + j) * ldb);
      else v[j] = f32x4{0.f, 0.f, 0.f, 0.f};
    }
  }
  DI void store(short* sB) const {
    const int tid = VT, kg = tid & 7, n4 = tid >> 3;
#pragma unroll
    for (int i = 0; i < 4; ++i) {
      unsigned a0 = pack2(v[0][i], v[1][i]), a1 = pack2(v[2][i], v[3][i]);
      unsigned a2 = pack2(v[4][i], v[5][i]), a3 = pack2(v[6][i], v[7][i]);
      typedef __attribute__((ext_vector_type(4))) unsigned u32x4;
      u32x4 w = {a0, a1, a2, a3};
      *(u32x4*)(sB + (4 * n4 + i) * LSTR + kg * 8) = w;
    }
  }
};

template <class AL, class BL>
DI void gemm_mainloop(short* sA, short* sB, int nk, AL& al, BL& bl, f32x4 (&acc)[4][4]) {
  const int tid = VT, wid = tid >> 6, lane = tid & 63;
  const int wr = wid >> 1, wc = wid & 1, fr = lane & 15, fq = lane >> 4;
#pragma unroll
  for (int m = 0; m < 4; ++m)
#pragma unroll
    for (int n = 0; n < 4; ++n) acc[m][n] = f32x4{0.f, 0.f, 0.f, 0.f};
  al.load(0); bl.load(0);
  for (int kt = 0; kt < nk; ++kt) {
    __syncthreads();
    al.store(sA); bl.store(sB);
    __syncthreads();
    if (kt + 1 < nk) { al.load(kt + 1); bl.load(kt + 1); }
#pragma unroll
    for (int ks = 0; ks < 2; ++ks) {
      bf16x8 af[4], bf[4];
#pragma unroll
      for (int m = 0; m < 4; ++m) af[m] = *(const bf16x8*)(sA + (wr * 64 + m * 16 + fr) * LSTR + ks * 32 + fq * 8);
#pragma unroll
      for (int n = 0; n < 4; ++n) bf[n] = *(const bf16x8*)(sB + (wc * 64 + n * 16 + fr) * LSTR + ks * 32 + fq * 8);
#pragma unroll
      for (int m = 0; m < 4; ++m)
#pragma unroll
        for (int n = 0; n < 4; ++n) acc[m][n] = __builtin_amdgcn_mfma_f32_16x16x32_bf16(af[m], bf[n], acc[m][n], 0, 0, 0);
    }
  }
}

DI void phase_lora_convert(const Params& P, int part, int nparts);
DI void transpose_tile(const float* W, int ldw, int k0, int n0, int nvalid, bfr* WT, int ldt, char* smem);
DI void phase_mod(const Params& P, int bid, int nb, char* smem) {
  const float* c = P.in[1]; const float* cc = P.in[3];
  const float* w_mod = P.in[4]; const float* b_mod = P.in[5];
  float* mod = (float*)(P.ws + WS_MOD); float* modc = (float*)(P.ws + WS_MODC);
  float* red = (float*)smem;
  const int tid = VT;
  for (int it = bid; it < 1542; it += nb) {
    if (it < 192) {
      const int kq = tid >> 3, c4 = tid & 7;
      const int col = it * 32 + c4 * 4;
      f32x4 a1 = {0, 0, 0, 0}, a2 = {0, 0, 0, 0};
      for (int k = kq; k < DM; k += 32) {
        f32x4 w = *(const f32x4*)(w_mod + (long)k * 6144 + col);
        float s1 = siluf_(c[k]), s2 = siluf_(cc[k]);
        a1 += w * s1; a2 += w * s2;
      }
      __syncthreads();
#pragma unroll
      for (int e = 0; e < 4; ++e) { red[(kq * 32) + c4 * 4 + e] = a1[e]; red[1024 + kq * 32 + c4 * 4 + e] = a2[e]; }
      __syncthreads();
      if (tid < 64) {
        const int which = tid >> 5, cl = tid & 31;
        float s = 0.f;
        for (int q = 0; q < 32; ++q) s += red[which * 1024 + q * 32 + cl];
        const int cg = it * 32 + cl;
        s += b_mod[cg];
        if (which == 0) mod[cg] = s; else modc[cg] = s;
      }
    } else if (it == 192) {
      const float* L = P.in[8];
      float* lb = (float*)(P.ws + WS_LB);
      for (int i = tid; i < 1024; i += NTHR) {
        const int d = i >> 9, j = i & 511;
        float l0 = L[d * 1024 + j], l1 = L[d * 1024 + 512 + j];
        lb[i] = 1.f / (1.f + __expf(l1 - l0));
      }
    } else if (it == 193) {
      int* cnt = (int*)(P.ws + WS_CNT);
      if (tid < 64) cnt[tid] = 0;
    } else if (it < 198) {
      phase_lora_convert(P, it - 194, 4);
    } else if (it < 1286) {
      const int t = it - 198;
      transpose_tile(P.in[6], DIN, (t / 68) * 64, (t % 68) * 64, DIN, (bfr*)(P.ws + (284ull << 20)), DM, smem);
    } else {
      const int t = it - 1286;
      transpose_tile(P.in[7], DM, (t >> 4) * 64, (t & 15) * 64, DM, (bfr*)(P.ws + (1ull << 20)), DM, smem);
    }
  }
}

DI void phase_ln1(const Params& P, int bid, int nb) {
  const float* x = P.in[0]; const float* ctx = P.in[2];
  const float* mod = (const float*)(P.ws + WS_MOD); const float* modc = (const float*)(P.ws + WS_MODC);
  bfr* h = (bfr*)(P.ws + WS_H);
  const int wid = VT >> 6, lane = VT & 63;
  for (int row = bid * 4 + wid; row < T_ALL; row += nb * 4) {
    const float* src = row < T_LAT ? x + (long)row * DM : ctx + (long)(row - T_LAT) * DM;
    const float* mm = row < T_LAT ? mod : modc;
    f32x4 v[4];
    float s = 0.f;
#pragma unroll
    for (int i = 0; i < 4; ++i) { v[i] = *(const f32x4*)(src + lane * 4 + 256 * i); s += v[i][0] + v[i][1] + v[i][2] + v[i][3]; }
    const float mu = wave_sum(s) * (1.f / DM);
    float q = 0.f;
#pragma unroll
    for (int i = 0; i < 4; ++i) { v[i] -= mu; q += v[i][0] * v[i][0] + v[i][1] * v[i][1] + v[i][2] * v[i][2] + v[i][3] * v[i][3]; }
    const float rs = rsqrtf(wave_sum(q) * (1.f / DM) + 1e-5f);
#pragma unroll
    for (int i = 0; i < 4; ++i) {
      const int cidx = lane * 4 + 256 * i;
      f32x4 sh = *(const f32x4*)(mm + cidx), sc = *(const f32x4*)(mm + 1024 + cidx);
      f32x4 o = v[i] * rs * (sc + 1.f) + sh;
      uint2 w = {pack2(o[0], o[1]), pack2(o[2], o[3])};
      *(uint2*)(h + (long)row * DM + cidx) = w;
    }
  }
}

DI void phase_pgemm(const Params& P, int bid, int nb, char* smem) {
  const bfr* h = (const bfr*)(P.ws + WS_H);
  const float* w_in = P.in[6];
  bfr* p = (bfr*)(P.ws + WS_P);
  short* sA = (short*)smem; short* sB = sA + 128 * LSTR;
  const int tid = VT, wid = tid >> 6, lane = tid & 63;
  const int wr = wid >> 1, wc = wid & 1, fr = lane & 15, fq = lane >> 4;
  constexpr int NT = 34, MT = T_ALL / 128;
  for (int it = bid; it < NT * MT; it += nb) {
    const int mt = it / NT, nt = it % NT;
    ALoadBf16 al; BLoadF32 bl;
#pragma unroll
    for (int i = 0; i < 4; ++i) al.rp[i] = h + (long)(mt * 128 + (tid >> 3) + 32 * i) * DM + (tid & 7) * 8;
    const int col = nt * 128 + (tid >> 3) * 4;
    bl.valid = col < DIN; bl.ldb = DIN;
    bl.p = w_in + (long)((tid & 7) * 8) * DIN + (bl.valid ? col : 0);
    f32x4 acc[4][4];
    gemm_mainloop(sA, sB, DM / 64, al, bl, acc);
#pragma unroll
    for (int m = 0; m < 4; ++m)
#pragma unroll
      for (int n = 0; n < 4; ++n) {
        const int cc = nt * 128 + wc * 64 + n * 16 + fr;
        if (cc < DIN) {
#pragma unroll
          for (int j = 0; j < 4; ++j) {
            const int rr = mt * 128 + wr * 64 + m * 16 + fq * 4 + j;
            p[(long)rr * DIN + cc] = f2bf(acc[m][n][j]);
          }
        }
      }
  }
}

DI float rw_mixed(const bfr* p, int row, int c, const float* mu) {
  const long base = (long)row * DIN + HGC + c;
  const float pc = bf2f(p[base]);
  float nbv;
  if (row < T_LAT) {
    const int gr = row >> 6, gc = row & 63;
    float s = 0.f;
    if (gr > 0) s += bf2f(p[base - 64l * DIN]);
    if (gr < 255) s += bf2f(p[base + 64l * DIN]);
    if (gc > 0) s += bf2f(p[base - DIN]);
    if (gc < 63) s += bf2f(p[base + DIN]);
    nbv = 0.25f * s;
  } else {
    const int sidx = row - T_LAT;
    float s = 0.f;
    if (sidx > 0) s += bf2f(p[base - DIN]);
    if (sidx < T_CTX - 1) s += bf2f(p[base + DIN]);
    nbv = 0.5f * s;
  }
  return pc + (nbv - pc) * mu[c];
}

DI void rwkv_chain_naive(const Params& P, int chain, char* smem) {
  const int dir = chain >> 3, hd = chain & 7;
  const bfr* R = (const bfr*)(P.ws + WS_RW); const bfr* K = (const bfr*)(P.ws + WS_RW + RW_ARR); const bfr* V = (const bfr*)(P.ws + WS_RW + 2 * RW_ARR);
  const bfr* KK = (const bfr*)(P.ws + WS_RW + 3 * RW_ARR); const bfr* A = (const bfr*)(P.ws + WS_RW + 4 * RW_ARR);
  const float* LW = (const float*)(P.ws + WS_LW + (dir ? LW_ARR : 0));
  float* Y = (float*)(P.ws + WS_YRW) + (long)dir * T_LAT * 512;
  float* vec = (float*)smem;
  float* red = vec + 16 * 6 * 64;
  const int tid = VT, i = tid & 63, jq = tid >> 6;
  float S[16];
#pragma unroll
  for (int j = 0; j < 16; ++j) S[j] = 0.f;
  for (int s0 = 0; s0 < T_ALL; s0 += 16) {
    __syncthreads();
    for (int e = tid; e < 16 * 64; e += NTHR) {
      const int st = e >> 6, j = e & 63;
      const int s = s0 + st;
      int row;
      if (s < T_CTX) row = T_LAT + (dir ? (T_CTX - 1 - s) : s);
      else row = dir ? (T_LAT - 1 - (s - T_CTX)) : (s - T_CTX);
      const long o = (long)row * 512 + hd * 64 + j;
      float* vp = vec + st * 384;
      const float kk = bf2f(KK[o]);
      vp[j] = bf2f(R[o]); vp[64 + j] = __expf(LW[o]); vp[128 + j] = bf2f(K[o]); vp[192 + j] = bf2f(V[o]);
      vp[256 + j] = kk; vp[320 + j] = kk * bf2f(A[o]);
    }
    __syncthreads();
    for (int st = 0; st < 16; ++st) {
      const float* vp = vec + st * 384;
      const int par = st & 1;
      float sa = 0.f;
#pragma unroll
      for (int j = 0; j < 16; ++j) sa += S[j] * vp[256 + jq * 16 + j];
      red[(par * 2 + 0) * 256 + jq * 64 + i] = sa;
      __syncthreads();
      sa = red[(par * 2) * 256 + i] + red[(par * 2) * 256 + 64 + i] + red[(par * 2) * 256 + 128 + i] + red[(par * 2) * 256 + 192 + i];
      const float vi = vp[192 + i];
      float y = 0.f;
#pragma unroll
      for (int j = 0; j < 16; ++j) {
        const int jj = jq * 16 + j;
        S[j] = S[j] * vp[64 + jj] - sa * vp[320 + jj] + vi * vp[128 + jj];
        y += S[j] * vp[jj];
      }
      red[(par * 2 + 1) * 256 + jq * 64 + i] = y;
      __syncthreads();
      const int s = s0 + st;
      if (jq == 0 && s >= T_CTX) {
        y = red[(par * 2 + 1) * 256 + i] + red[(par * 2 + 1) * 256 + 64 + i] + red[(par * 2 + 1) * 256 + 128 + i] + red[(par * 2 + 1) * 256 + 192 + i];
        const int row = dir ? (T_LAT - 1 - (s - T_CTX)) : (s - T_CTX);
        Y[(long)row * 512 + hd * 64 + i] = y;
      }
    }
  }
}

DI void hgrn_chain_naive(const Params& P, int chain, char* smem) {
  const int dir = chain >> 2, hd = chain & 3;
  const bfr* p = (const bfr*)(P.ws + WS_P);
  const float* lb = (const float*)(P.ws + WS_LB) + dir * 512 + hd * 128;
  float* O = (float*)(P.ws + WS_OHG) + (long)dir * T_LAT * 512;
  float* vec = (float*)smem;
  float* red = vec + 16 * 4 * 128;
  const int tid = VT, e = tid & 127, dh = tid >> 7;
  float S[64];
#pragma unroll
  for (int d = 0; d < 64; ++d) S[d] = 0.f;
  for (int s0 = 0; s0 < T_ALL; s0 += 16) {
    __syncthreads();
    for (int x = tid; x < 16 * 128; x += NTHR) {
      const int st = x >> 7, d = x & 127;
      const int s = s0 + st;
      int row;
      if (s < T_CTX) row = T_LAT + (dir ? (T_CTX - 1 - s) : s);
      else row = dir ? (T_LAT - 1 - (s - T_CTX)) : (s - T_CTX);
      const bfr* pr = p + (long)row * DIN + hd * 128 + d;
      const float q = bf2f(pr[0]), iv = bf2f(pr[512]), z = bf2f(pr[1024 + dir * 512]);
      const float l = lb[d];
      const float f = l + (1.f - l) * sigmoidf_(z);
      float* vp = vec + st * 512;
      vp[d] = siluf_(q); vp[128 + d] = f; vp[256 + d] = (1.f - l) * sigmoidf_(-z); vp[384 + d] = iv;
    }
    __syncthreads();
    for (int st = 0; st < 16; ++st) {
      const float* vp = vec + st * 512;
      const int par = st & 1;
      const float ve = vp[384 + e];
      float o = 0.f;
#pragma unroll
      for (int d = 0; d < 64; ++d) {
        const int dd = dh * 64 + d;
        S[d] = S[d] * vp[128 + dd] + vp[256 + dd] * ve;
        o += vp[dd] * S[d];
      }
      red[par * 256 + dh * 128 + e] = o;
      __syncthreads();
      const int s = s0 + st;
      if (dh == 0 && s >= T_CTX) {
        o = red[par * 256 + e] + red[par * 256 + 128 + e];
        const int row = dir ? (T_LAT - 1 - (s - T_CTX)) : (s - T_CTX);
        O[(long)row * 512 + hd * 128 + e] = o;
      }
    }
  }
}

#define LDSP(T) __attribute__((address_space(3))) T*
DI int row_of_step(int dir, int s) {
  if (s < T_CTX) return T_LAT + (dir ? (T_CTX - 1 - s) : s);
  return dir ? (T_LAT - 1 - (s - T_CTX)) : (s - T_CTX);
}
DI bf16x8 ld_tr8(const short* base, int stride, int k0, int n0) {
  const int lane = VT & 63, g = lane >> 4, q = (lane & 15) >> 2, p = lane & 3;
  const short* a0 = base + (k0 + 8 * g + q) * stride + n0 + 4 * p;
  s16x4 lo = __builtin_amdgcn_ds_read_tr16_b64_v4i16((LDSP(s16x4))a0);
  s16x4 hi = __builtin_amdgcn_ds_read_tr16_b64_v4i16((LDSP(s16x4))(a0 + 4 * stride));
  return __builtin_shufflevector(lo, hi, 0, 1, 2, 3, 4, 5, 6, 7);
}
template <bool AT, bool BT>
DI f32x4 mm_tile(const short* A, int lda, int m0, const short* B, int ldb, int n0, int K, f32x4 acc) {
  const int lane = VT & 63, fr = lane & 15, fq = lane >> 4;
#ifdef SLOWMM
#pragma unroll
  for (int reg = 0; reg < 4; ++reg) {
    const int row = m0 + 4 * fq + reg, col = n0 + fr;
    float s = 0.f;
    for (int k = 0; k < K; ++k) {
      const float a = bf2f((bfr)(AT ? A[k * lda + row] : A[row * lda + k]));
      const float b = bf2f((bfr)(BT ? B[col * ldb + k] : B[k * ldb + col]));
      s += a * b;
    }
    acc[reg] += s;
  }
#else
  for (int k0 = 0; k0 < K; k0 += 32) {
    bf16x8 a, b;
    if (AT) a = ld_tr8(A, lda, k0, m0); else a = *(const bf16x8*)(A + (m0 + fr) * lda + k0 + fq * 8);
    if (BT) b = *(const bf16x8*)(B + (n0 + fr) * ldb + k0 + fq * 8); else b = ld_tr8(B, ldb, k0, n0);
    acc = __builtin_amdgcn_mfma_f32_16x16x32_bf16(a, b, acc, 0, 0, 0);
  }
#endif
  return acc;
}
DI void st_tile(short* C, int ldc, int m0, int n0, f32x4 acc) {
  const int lane = VT & 63, fr = lane & 15, fq = lane >> 4;
#pragma unroll
  for (int reg = 0; reg < 4; ++reg) C[(m0 + 4 * fq + reg) * ldc + n0 + fr] = (short)f2bf(acc[reg]);
}

constexpr int RW_NSC = 32;
DI int rw_sc_begin(int sc) { return sc * 16 + (sc < 8 ? sc : 8); }
DI int rw_sc_of_chunk(int ci) { return ci < 136 ? ci / 17 : 8 + (ci - 136) / 16; }
constexpr int XS = 72, SS = 40, GS = 72;
constexpr int RWL_XK = 0, RWL_XKB = 4608, RWL_XBB = 9216, RWL_XR = 13824, RWL_XV = 18432, RWL_S = 23040;
constexpr int RWL_GP = 38400, RWL_GQ = 47616, RWL_GAM = 56832, RWL_TOT = 57088, RWL_END = 58112;
constexpr size_t WS_PTOT = 6 * MB;
constexpr size_t WS_QTOT = 10 * MB;
constexpr size_t WS_SINRW = 18 * MB;
constexpr size_t WS_R2P = 350 * MB;
constexpr size_t WS_Y0P = 382 * MB;

DI void rw_levelA_item(const Params& P, int chain, int sc, char* smem) {
  const int dir = chain >> 3, hd = chain & 7;
  const bfr* Rg = (const bfr*)(P.ws + WS_RW); const bfr* Kg = (const bfr*)(P.ws + WS_RW + RW_ARR); const bfr* Vg = (const bfr*)(P.ws + WS_RW + 2 * RW_ARR);
  const bfr* KKg = (const bfr*)(P.ws + WS_RW + 3 * RW_ARR); const bfr* Ag = (const bfr*)(P.ws + WS_RW + 4 * RW_ARR);
  const float* LWg = (const float*)(P.ws + WS_LW + (dir ? LW_ARR : 0));
  bfr* R2P = (bfr*)(P.ws + WS_R2P) + (size_t)dir * T_LAT * 512;
  bfr* Y0P = (bfr*)(P.ws + WS_Y0P) + (size_t)dir * T_LAT * 512;
  short* XK = (short*)(smem + RWL_XK); short* XKB = (short*)(smem + RWL_XKB); short* XBB = (short*)(smem + RWL_XBB);
  short* XR = (short*)(smem + RWL_XR); short* XV = (short*)(smem + RWL_XV);
  short* XZ = XR; short* XR2 = XR; short* GPc = XK;
  short* SL = (short*)(smem + RWL_S); short* SAkk = SL + 32 * SS; short* SAkr = SAkk + 32 * SS; short* SM = SAkr + 32 * SS;
  short* ST = SM + 32 * SS; short* SnAbr = ST + 32 * SS;
  short* XW1 = SL; short* XW2 = SAkr;
  short* GP = (short*)(smem + RWL_GP); short* GQ = (short*)(smem + RWL_GQ);
  float* gam = (float*)(smem + RWL_GAM); float* tot = (float*)(smem + RWL_TOT);
  const int tid = VT, lane = tid & 63, w = tid >> 6, fr = lane & 15, fq = lane >> 4;
  const int tm = w >> 1, tn = w & 1;
  const f32x4 z4 = {0.f, 0.f, 0.f, 0.f};
  __syncthreads();
  for (int i = tid; i < 64 * 64; i += NTHR) { const int r = i >> 6, c = i & 63; GP[r * GS + c] = (r == c) ? (short)0x3F80 : (short)0; GQ[r * GS + c] = 0; }
  f32x4 pcum[4], qcum[4];
#pragma unroll
  for (int n = 0; n < 4; ++n) { pcum[n] = z4; qcum[n] = z4; }
  const int c_begin = rw_sc_begin(sc), c_end = rw_sc_begin(sc + 1);
  for (int ci = c_begin; ci < c_end; ++ci) {
    __syncthreads();
    {
      const int j = tid & 63, qt = tid >> 6;
      float lwv[8], lam[8]; bfr rr[8], kr[8], vr[8], kkr[8], ar[8];
      float run = 0.f;
#pragma unroll
      for (int e = 0; e < 8; ++e) {
        const int row = row_of_step(dir, ci * 32 + qt * 8 + e);
        const size_t o = (size_t)row * 512 + hd * 64 + j;
        lwv[e] = LWg[o]; rr[e] = Rg[o]; kr[e] = Kg[o]; vr[e] = Vg[o]; kkr[e] = KKg[o]; ar[e] = Ag[o];
      }
#pragma unroll
      for (int e = 0; e < 8; ++e) { run += lwv[e]; lam[e] = run; }
      tot[qt * 64 + j] = run;
      __syncthreads();
      float base = 0.f, total = 0.f;
#pragma unroll
      for (int q2 = 0; q2 < 4; ++q2) { const float tv = tot[q2 * 64 + j]; total += tv; if (q2 < qt) base += tv; }
#pragma unroll
      for (int e = 0; e < 8; ++e) {
        const float L = base + lam[e], Lp = L - lwv[e];
        const float eL = __expf(L), enL = __expf(-L), eLp = __expf(Lp);
        const float kkv = bf2f(kkr[e]);
        const int t = qt * 8 + e;
        XK[t * XS + j] = (short)f2bf(kkv * eLp);
        XKB[t * XS + j] = (short)f2bf(bf2f(kr[e]) * enL);
        XBB[t * XS + j] = (short)f2bf(kkv * bf2f(ar[e]) * enL);
        XR[t * XS + j] = (short)f2bf(bf2f(rr[e]) * eL);
        XV[t * XS + j] = (short)vr[e];
      }
      if (qt == 0) gam[j] = __expf(total);
    }
    __syncthreads();
    f32x4 tacc; f32x4 rt[2];
    {
      f32x4 aL = mm_tile<false, true>(XK, XS, 16 * tm, XBB, XS, 16 * tn, 64, z4);
      f32x4 aKK = mm_tile<false, true>(XK, XS, 16 * tm, XKB, XS, 16 * tn, 64, z4);
      f32x4 aBR = mm_tile<false, true>(XR, XS, 16 * tm, XBB, XS, 16 * tn, 64, z4);
      f32x4 aKR = mm_tile<false, true>(XR, XS, 16 * tm, XKB, XS, 16 * tn, 64, z4);
#pragma unroll
      for (int reg = 0; reg < 4; ++reg) {
        const int row = 16 * tm + 4 * fq + reg, col = 16 * tn + fr;
        const bool st = col < row, inc = col <= row;
        aL[reg] = st ? aL[reg] : 0.f; aKK[reg] = st ? aKK[reg] : 0.f;
        aBR[reg] = inc ? -aBR[reg] : 0.f; aKR[reg] = inc ? aKR[reg] : 0.f;
        tacc[reg] = (row == col ? 1.f : 0.f) - aL[reg];
      }
      st_tile(SL, SS, 16 * tm, 16 * tn, aL); st_tile(ST, SS, 16 * tm, 16 * tn, tacc);
      st_tile(SAkk, SS, 16 * tm, 16 * tn, aKK); st_tile(SnAbr, SS, 16 * tm, 16 * tn, aBR); st_tile(SAkr, SS, 16 * tm, 16 * tn, aKR);
#pragma unroll
      for (int i = 0; i < 2; ++i)
#pragma unroll
        for (int reg = 0; reg < 4; ++reg) rt[i][reg] = bf2f((bfr)XR[(16 * tm + 4 * fq + reg) * XS + 16 * (2 * tn + i) + fr]);
    }
    __syncthreads();
    f32x4 y0[2];
    {
#pragma unroll
      for (int i = 0; i < 2; ++i) {
        f32x4 z = mm_tile<false, false>(SAkk, SS, 16 * tm, XV, XS, 16 * (2 * tn + i), 32, z4);
        st_tile(XZ, XS, 16 * tm, 16 * (2 * tn + i), z);
        y0[i] = mm_tile<false, false>(SAkr, SS, 16 * tm, XV, XS, 16 * (2 * tn + i), 32, z4);
      }
      f32x4 m = mm_tile<false, false>(SL, SS, 16 * tm, SL, SS, 16 * tn, 32, z4);
      st_tile(SM, SS, 16 * tm, 16 * tn, m);
    }
    __syncthreads();
#pragma unroll 1
    for (int rd = 0; rd < 4; ++rd) {
      f32x4 tnew = mm_tile<false, false>(ST, SS, 16 * tm, SM, SS, 16 * tn, 32, tacc);
      f32x4 mnew = z4;
      if (rd < 3) mnew = mm_tile<false, false>(SM, SS, 16 * tm, SM, SS, 16 * tn, 32, z4);
      __syncthreads();
      tacc = tnew;
      st_tile(ST, SS, 16 * tm, 16 * tn, tacc);
      if (rd < 3) st_tile(SM, SS, 16 * tm, 16 * tn, mnew);
      __syncthreads();
    }
    {
      f32x4 w1[2], w2[2];
#pragma unroll
      for (int i = 0; i < 2; ++i) {
        w1[i] = mm_tile<false, false>(ST, SS, 16 * tm, XK, XS, 16 * (2 * tn + i), 32, z4);
        w2[i] = mm_tile<false, false>(ST, SS, 16 * tm, XZ, XS, 16 * (2 * tn + i), 32, z4);
      }
#pragma unroll
      for (int i = 0; i < 2; ++i) { st_tile(XW1, XS, 16 * tm, 16 * (2 * tn + i), w1[i]); st_tile(XW2, XS, 16 * tm, 16 * (2 * tn + i), w2[i]); }
    }
    __syncthreads();
    f32x4 pa[4], qc[4], r2[2];
    {
#pragma unroll
      for (int n = 0; n < 4; ++n) {
        pa[n] = mm_tile<true, false>(XW1, XS, 16 * w, XBB, XS, 16 * n, 32, z4);
        f32x4 qa = mm_tile<true, false>(XV, XS, 16 * w, XKB, XS, 16 * n, 32, z4);
        f32x4 qb = mm_tile<true, false>(XW2, XS, 16 * w, XBB, XS, 16 * n, 32, z4);
        qc[n] = qa - qb;
      }
#pragma unroll
      for (int i = 0; i < 2; ++i) {
        r2[i] = mm_tile<false, false>(SnAbr, SS, 16 * tm, XW1, XS, 16 * (2 * tn + i), 32, rt[i]);
        y0[i] = mm_tile<false, false>(SnAbr, SS, 16 * tm, XW2, XS, 16 * (2 * tn + i), 32, y0[i]);
      }
    }
    __syncthreads();
    {
#pragma unroll
      for (int n = 0; n < 4; ++n) {
        const float gcol = gam[16 * n + fr];
        f32x4 pc;
#pragma unroll
        for (int reg = 0; reg < 4; ++reg) {
          const int row = 16 * w + 4 * fq + reg, col = 16 * n + fr;
          pc[reg] = ((row == col ? 1.f : 0.f) - pa[n][reg]) * gcol;
          qc[n][reg] *= gcol;
        }
        st_tile(GPc, GS, 16 * w, 16 * n, pc);
      }
#pragma unroll
      for (int i = 0; i < 2; ++i) st_tile(XR2, XS, 16 * tm, 16 * (2 * tn + i), r2[i]);
    }
    __syncthreads();
    {
      if (ci >= 8) {
#pragma unroll
        for (int i = 0; i < 2; ++i) {
          f32x4 o1 = mm_tile<false, true>(XR2, XS, 16 * tm, GP, GS, 16 * (2 * tn + i), 64, z4);
          f32x4 o2 = mm_tile<false, true>(XR2, XS, 16 * tm, GQ, GS, 16 * (2 * tn + i), 64, y0[i]);
#pragma unroll
          for (int reg = 0; reg < 4; ++reg) {
            const int row = row_of_step(dir, ci * 32 + 16 * tm + 4 * fq + reg);
            const size_t o = (size_t)row * 512 + hd * 64 + 16 * (2 * tn + i) + fr;
            R2P[o] = f2bf(o1[reg]); Y0P[o] = f2bf(o2[reg]);
          }
        }
      }
#pragma unroll
      for (int n = 0; n < 4; ++n) {
        pcum[n] = mm_tile<false, false>(GP, GS, 16 * w, GPc, GS, 16 * n, 64, z4);
        qcum[n] = mm_tile<false, false>(GQ, GS, 16 * w, GPc, GS, 16 * n, 64, qc[n]);
      }
    }
    __syncthreads();
#pragma unroll
    for (int n = 0; n < 4; ++n) { st_tile(GP, GS, 16 * w, 16 * n, pcum[n]); st_tile(GQ, GS, 16 * w, 16 * n, qcum[n]); }
  }
  {
    bfr* Pt = (bfr*)(P.ws + WS_PTOT) + (size_t)(chain * RW_NSC + sc) * 4096;
    float* Qt = (float*)(P.ws + WS_QTOT) + (size_t)(chain * RW_NSC + sc) * 4096;
#pragma unroll
    for (int n = 0; n < 4; ++n)
#pragma unroll
      for (int reg = 0; reg < 4; ++reg) {
        const int row = 16 * w + 4 * fq + reg, col = 16 * n + fr;
        Pt[row * 64 + col] = f2bf(pcum[n][reg]); Qt[row * 64 + col] = qcum[n][reg];
      }
  }
}

DI void rw_levelB_chain(const Params& P, int chain, char* smem) {
  short* SB = (short*)smem; short* PT = SB + 64 * GS;
  const bfr* Ptot = (const bfr*)(P.ws + WS_PTOT) + (size_t)chain * RW_NSC * 4096;
  const float* Qtot = (const float*)(P.ws + WS_QTOT) + (size_t)chain * RW_NSC * 4096;
  bfr* SIN = (bfr*)(P.ws + WS_SINRW) + (size_t)chain * (RW_NSC + 1) * 4096;
  const int tid = VT, lane = tid & 63, w = tid >> 6, fr = lane & 15, fq = lane >> 4;
  f32x4 S[4], qn[4];
  bf16x8 pn[2];
#pragma unroll
  for (int n = 0; n < 4; ++n) S[n] = f32x4{0.f, 0.f, 0.f, 0.f};
#pragma unroll
  for (int i = 0; i < 2; ++i) { const int e = tid + i * NTHR; pn[i] = *(const bf16x8*)(Ptot + (e >> 3) * 64 + (e & 7) * 8); }
#pragma unroll
  for (int n = 0; n < 4; ++n)
#pragma unroll
    for (int reg = 0; reg < 4; ++reg) qn[n][reg] = Qtot[(16 * w + 4 * fq + reg) * 64 + 16 * n + fr];
  for (int sc = 0; sc < RW_NSC; ++sc) {
    __syncthreads();
#pragma unroll
    for (int n = 0; n < 4; ++n) {
      st_tile(SB, GS, 16 * w, 16 * n, S[n]);
#pragma unroll
      for (int reg = 0; reg < 4; ++reg) SIN[(size_t)sc * 4096 + (16 * w + 4 * fq + reg) * 64 + 16 * n + fr] = f2bf(S[n][reg]);
    }
#pragma unroll
    for (int i = 0; i < 2; ++i) { const int e = tid + i * NTHR; *(bf16x8*)(PT + (e >> 3) * GS + (e & 7) * 8) = pn[i]; }
    f32x4 qc[4];
#pragma unroll
    for (int n = 0; n < 4; ++n) qc[n] = qn[n];
    __syncthreads();
    if (sc + 1 < RW_NSC) {
#pragma unroll
      for (int i = 0; i < 2; ++i) { const int e = tid + i * NTHR; pn[i] = *(const bf16x8*)(Ptot + (size_t)(sc + 1) * 4096 + (e >> 3) * 64 + (e & 7) * 8); }
#pragma unroll
      for (int n = 0; n < 4; ++n)
#pragma unroll
        for (int reg = 0; reg < 4; ++reg) qn[n][reg] = Qtot[(size_t)(sc + 1) * 4096 + (16 * w + 4 * fq + reg) * 64 + 16 * n + fr];
    }
#pragma unroll
    for (int n = 0; n < 4; ++n) S[n] = mm_tile<false, false>(SB, GS, 16 * w, PT, GS, 16 * n, 64, qc[n]);
  }
}

DI void rw_finish(const Params& P, int bid, int nb) {
  float* YM = P.out;
  const int tid = VT, lane = tid & 63, w = tid >> 6, fr = lane & 15, fq = lane >> 4;
  for (int it = bid; it < 512 * 4; it += nb) {
    const int tile = it >> 2, hp = it & 3;
    const int hd = hp * 2 + (w >> 1), tm = w & 1;
    const int t0 = tile * 32;
    f32x4 acc[4];
#pragma unroll
    for (int n = 0; n < 4; ++n) acc[n] = f32x4{0.f, 0.f, 0.f, 0.f};
#pragma unroll
    for (int dir = 0; dir < 2; ++dir) {
      const int ci = dir ? (519 - tile) : (8 + tile);
      const int sc = rw_sc_of_chunk(ci);
      const bfr* A = (const bfr*)(P.ws + WS_R2P) + (size_t)dir * T_LAT * 512 + (size_t)t0 * 512 + hd * 64;
      const bfr* Y0 = (const bfr*)(P.ws + WS_Y0P) + (size_t)dir * T_LAT * 512 + (size_t)t0 * 512 + hd * 64;
      const bfr* Sin = (const bfr*)(P.ws + WS_SINRW) + ((size_t)(dir * 8 + hd) * (RW_NSC + 1) + sc) * 4096;
#pragma unroll
      for (int n = 0; n < 4; ++n) {
#pragma unroll
        for (int k0 = 0; k0 < 64; k0 += 32) {
          bf16x8 a = *(const bf16x8*)(A + (size_t)(16 * tm + fr) * 512 + k0 + fq * 8);
          bf16x8 b = *(const bf16x8*)(Sin + (16 * n + fr) * 64 + k0 + fq * 8);
          acc[n] = __builtin_amdgcn_mfma_f32_16x16x32_bf16(a, b, acc[n], 0, 0, 0);
        }
#pragma unroll
        for (int reg = 0; reg < 4; ++reg) acc[n][reg] += bf2f(Y0[(size_t)(16 * tm + 4 * fq + reg) * 512 + 16 * n + fr]);
      }
    }
#pragma unroll
    for (int n = 0; n < 4; ++n)
#pragma unroll
      for (int reg = 0; reg < 4; ++reg) YM[(size_t)(t0 + 16 * tm + 4 * fq + reg) * 512 + hd * 64 + 16 * n + fr] = acc[n][reg];
  }
}

constexpr int HG_NSC = 64;
DI int hg_sc_begin(int sc) { return sc * 8 + (sc < 8 ? sc : 8); }
DI int hg_sc_of_chunk(int ci) { return ci < 72 ? ci / 9 : 8 + (ci - 72) / 8; }
constexpr int QS = 136;
constexpr int HGL_Q0 = 0, HGL_Q1 = 8704, HGL_KP = 13056, HGL_KH = 21760, HGL_VV = 30464, HGL_PM = 39168, HGL_STT = 41728;
constexpr int HGL_BL = 76544, HGL_TOT = 77056, HGL_END = 78080;
constexpr size_t WS_SINHG = 23 * MB;
constexpr size_t WS_QH = 414 * MB;
constexpr size_t WS_O0 = 446 * MB;
constexpr size_t WS_SLOC = 478 * MB;
constexpr size_t WS_DTOT = 510 * MB;

DI void hg_levelA_item(const Params& P, int chain, int sc, char* smem) {
  const int dir = chain >> 2, hd = chain & 3;
  const bfr* p = (const bfr*)(P.ws + WS_P);
  const float* lbp = (const float*)(P.ws + WS_LB) + dir * 512 + hd * 128;
  bfr* QH = (bfr*)(P.ws + WS_QH) + (size_t)dir * T_LAT * 512;
  bfr* O0 = (bfr*)(P.ws + WS_O0) + (size_t)dir * T_LAT * 512;
  short* Q0 = (short*)(smem + HGL_Q0); short* Q1 = (short*)(smem + HGL_Q1); short* KP = (short*)(smem + HGL_KP);
  short* KH = (short*)(smem + HGL_KH); short* VV = (short*)(smem + HGL_VV); short* PM = (short*)(smem + HGL_PM);
  short* STT = (short*)(smem + HGL_STT);
  float* BL = (float*)(smem + HGL_BL); float* tot = (float*)(smem + HGL_TOT);
  const int tid = VT, lane = tid & 63, w = tid >> 6, fr = lane & 15, fq = lane >> 4;
  const f32x4 z4 = {0.f, 0.f, 0.f, 0.f};
  f32x4 S[8][2];
#pragma unroll
  for (int m = 0; m < 8; ++m) { S[m][0] = z4; S[m][1] = z4; }
  const int d = tid & 127, hf = tid >> 7;
  const float lb = lbp[d];
  float dcum = 0.f;
  const int c_begin = hg_sc_begin(sc), c_end = hg_sc_begin(sc + 1);
  for (int ci = c_begin; ci < c_end; ++ci) {
    __syncthreads();
    {
      unsigned qv[16]; bfr zr[16];
#pragma unroll
      for (int e = 0; e < 16; ++e) {
        const int row = row_of_step(dir, ci * 32 + hf * 16 + e);
        const bfr* pr = p + (size_t)row * DIN + hd * 128 + d;
        qv[e] = (unsigned)pr[0] | ((unsigned)pr[512] << 16); zr[e] = pr[1024 + dir * 512];
      }
      float lc[16], kv[16]; float run = 0.f;
#pragma unroll
      for (int e = 0; e < 16; ++e) {
        const float sg = sigmoidf_(bf2f(zr[e]));
        const float f = lb + (1.f - lb) * sg;
        kv[e] = (1.f - lb) * (1.f - sg);
        run += __logf(f); lc[e] = run;
      }
      tot[hf * 128 + d] = run;
      __syncthreads();
      const float tot0 = tot[d], tot1 = tot[128 + d];
      const float blast = tot0 + tot1;
#pragma unroll
      for (int e = 0; e < 16; ++e) {
        const int t = hf * 16 + e;
        const float bc = lc[e] + (hf ? tot0 : 0.f);
        const float qs = siluf_(__uint_as_float(qv[e] << 16));
        Q0[t * QS + d] = (short)f2bf(qs * __expf(bc));
        if (hf) Q1[e * QS + d] = (short)f2bf(qs * __expf(lc[e]));
        KP[t * QS + d] = (short)f2bf(kv[e] * __expf(-lc[e]));
        KH[t * QS + d] = (short)f2bf(kv[e] * __expf(blast - bc));
        VV[t * QS + d] = (short)(qv[e] >> 16);
        if (ci >= 8) {
          const int row = row_of_step(dir, ci * 32 + t);
          QH[(size_t)row * 512 + hd * 128 + d] = f2bf(qs * __expf(bc + dcum));
        }
      }
      if (hf == 0) BL[d] = blast;
      dcum += blast;
    }
#pragma unroll
    for (int m = 0; m < 8; ++m)
#pragma unroll
      for (int n = 0; n < 2; ++n) {
        uint2 wv = {pack2(S[m][n][0], S[m][n][1]), pack2(S[m][n][2], S[m][n][3])};
        *(uint2*)(STT + (32 * w + 16 * n + fr) * QS + 16 * m + 4 * fq) = wv;
      }
    __syncthreads();
    {
      f32x4 pt = z4;
      if (w == 0) pt = mm_tile<false, true>(Q0, QS, 0, KP, QS, 0, 128, z4);
      else if (w == 1) pt = mm_tile<false, true>(Q0, QS, 16, KP, QS, 0, 128, z4);
      else if (w == 2) pt = mm_tile<false, true>(Q1, QS, 0, KP, QS, 16, 128, z4);
      if (w == 0 || w == 2) {
#pragma unroll
        for (int reg = 0; reg < 4; ++reg) pt[reg] = (fr <= 4 * fq + reg) ? pt[reg] : 0.f;
      }
      const int ptm = (w == 0 || w == 3) ? 0 : 1, ptn = (w >= 2) ? 1 : 0;
      st_tile(PM, 40, 16 * ptm, 16 * ptn, pt);
    }
    __syncthreads();
    {
#pragma unroll
      for (int m = 0; m < 2; ++m)
#pragma unroll
        for (int n = 0; n < 2; ++n) {
          f32x4 o = mm_tile<false, true>(Q0, QS, 16 * m, STT, QS, 32 * w + 16 * n, 128, z4);
          o = mm_tile<false, false>(PM, 40, 16 * m, VV, QS, 32 * w + 16 * n, 32, o);
          if (ci >= 8) {
#pragma unroll
            for (int reg = 0; reg < 4; ++reg) {
              const int row = row_of_step(dir, ci * 32 + 16 * m + 4 * fq + reg);
              O0[(size_t)row * 512 + hd * 128 + 32 * w + 16 * n + fr] = f2bf(o[reg]);
            }
          }
        }
#pragma unroll
      for (int m = 0; m < 8; ++m) {
        const f32x4 bl = *(const f32x4*)(BL + 16 * m + 4 * fq);
        f32x4 sc4 = {__expf(bl[0]), __expf(bl[1]), __expf(bl[2]), __expf(bl[3])};
#pragma unroll
        for (int n = 0; n < 2; ++n) S[m][n] = mm_tile<true, false>(KH, QS, 16 * m, VV, QS, 32 * w + 16 * n, 32, S[m][n] * sc4);
      }
    }
  }
  {
    float* SL_ = (float*)(P.ws + WS_SLOC) + (size_t)(chain * HG_NSC + sc) * 16384;
    float* DT = (float*)(P.ws + WS_DTOT) + (size_t)(chain * HG_NSC + sc) * 128;
#pragma unroll
    for (int m = 0; m < 8; ++m)
#pragma unroll
      for (int n = 0; n < 2; ++n) *(f32x4*)(SL_ + (32 * w + 16 * n + fr) * 128 + 16 * m + 4 * fq) = S[m][n];
    if (hf == 0) DT[d] = dcum;
  }
}

DI void hg_levelB(const Params& P, int bid, int nb) {
  const float* SLOC = (const float*)(P.ws + WS_SLOC); const float* DT = (const float*)(P.ws + WS_DTOT);
  bfr* SIN = (bfr*)(P.ws + WS_SINHG);
  for (int idx = bid * NTHR + VT; idx < 8 * 16384; idx += nb * NTHR) {
    const int chain = idx >> 14, ed = idx & 16383, dd = ed & 127;
    float s = 0.f;
    for (int sc = 0; sc < HG_NSC; ++sc) {
      const size_t item = (size_t)chain * HG_NSC + sc;
      SIN[item * 16384 + ed] = f2bf(s);
      s = __expf(DT[item * 128 + dd]) * s + SLOC[item * 16384 + ed];
    }
  }
}

DI void hg_finish(const Params& P, int bid, int nb, float* OM) {
  const int tid = VT, lane = tid & 63, w = tid >> 6, fr = lane & 15, fq = lane >> 4;
  for (int it = bid; it < 512 * 4; it += nb) {
    const int tile = it >> 2, hd = it & 3;
    const int t0 = tile * 32;
    f32x4 acc[2][2];
#pragma unroll
    for (int m = 0; m < 2; ++m) { acc[m][0] = f32x4{0.f, 0.f, 0.f, 0.f}; acc[m][1] = f32x4{0.f, 0.f, 0.f, 0.f}; }
#pragma unroll
    for (int dir = 0; dir < 2; ++dir) {
      const int ci = dir ? (519 - tile) : (8 + tile);
      const int sc = hg_sc_of_chunk(ci);
      const bfr* A = (const bfr*)(P.ws + WS_QH) + (size_t)dir * T_LAT * 512 + (size_t)t0 * 512 + hd * 128;
      const bfr* O0 = (const bfr*)(P.ws + WS_O0) + (size_t)dir * T_LAT * 512 + (size_t)t0 * 512 + hd * 128;
      const bfr* Sin = (const bfr*)(P.ws + WS_SINHG) + ((size_t)(dir * 4 + hd) * HG_NSC + sc) * 16384;
#pragma unroll
      for (int m = 0; m < 2; ++m)
#pragma unroll
        for (int n = 0; n < 2; ++n) {
#pragma unroll
          for (int k0 = 0; k0 < 128; k0 += 32) {
            bf16x8 a = *(const bf16x8*)(A + (size_t)(16 * m + fr) * 512 + k0 + fq * 8);
            bf16x8 b = *(const bf16x8*)(Sin + (32 * w + 16 * n + fr) * 128 + k0 + fq * 8);
            acc[m][n] = __builtin_amdgcn_mfma_f32_16x16x32_bf16(a, b, acc[m][n], 0, 0, 0);
          }
#pragma unroll
          for (int reg = 0; reg < 4; ++reg) acc[m][n][reg] += bf2f(O0[(size_t)(16 * m + 4 * fq + reg) * 512 + 32 * w + 16 * n + fr]);
        }
    }
#pragma unroll
    for (int m = 0; m < 2; ++m)
#pragma unroll
      for (int n = 0; n < 2; ++n)
#pragma unroll
        for (int reg = 0; reg < 4; ++reg) OM[(size_t)(t0 + 16 * m + 4 * fq + reg) * 512 + hd * 128 + 32 * w + 16 * n + fr] = acc[m][n][reg];
  }
}

constexpr size_t WS_LORA = 256 * 1024;
constexpr int LORA_WD2T = 0, LORA_WA2T = 2 * 512 * 32, LORA_WG2T = LORA_WA2T + 512 * 32;
DI void phase_lora_convert(const Params& P, int part, int nparts) {
  const float* wd2 = P.in[12]; const float* wa2 = P.in[14]; const float* wg2 = P.in[15];
  bfr* L = (bfr*)(P.ws + WS_LORA);
  for (int i = part * NTHR + VT; i < 2 * 512 * 32; i += nparts * NTHR) { const int d = i >> 14, c = (i >> 5) & 511, j = i & 31; L[LORA_WD2T + i] = f2bf(wd2[(d * 32 + j) * 512 + c]); }
  for (int i = part * NTHR + VT; i < 512 * 32; i += nparts * NTHR) { const int c = i >> 5, j = i & 31; L[LORA_WA2T + i] = f2bf(wa2[j * 512 + c]); }
  for (int i = part * NTHR + VT; i < 512 * 96; i += nparts * NTHR) { const int c = i / 96, j = i % 96; L[LORA_WG2T + i] = f2bf(wg2[j * 512 + c]); }
}
#define NB_DECL(row) \
  int nb_o0, nb_o1, nb_o2, nb_o3; float nb_f0, nb_f1, nb_f2, nb_f3, nb_scale; \
  { const int r_ = (row); const bool lat_ = r_ < T_LAT; const int gr_ = r_ >> 6, gc_ = r_ & 63, s_ = r_ - T_LAT; \
    const bool v0_ = lat_ && gr_ > 0, v1_ = lat_ && gr_ < 255, v2_ = lat_ ? gc_ > 0 : s_ > 0, v3_ = lat_ ? gc_ < 63 : s_ < T_CTX - 1; \
    nb_o0 = v0_ ? -64 * DIN : 0; nb_o1 = v1_ ? 64 * DIN : 0; nb_o2 = v2_ ? -DIN : 0; nb_o3 = v3_ ? DIN : 0; \
    nb_f0 = v0_ ? 1.f : 0.f; nb_f1 = v1_ ? 1.f : 0.f; nb_f2 = v2_ ? 1.f : 0.f; nb_f3 = v3_ ? 1.f : 0.f; nb_scale = lat_ ? 0.25f : 0.5f; }
#define MIX4(pc, mup) mix4_((pc), (mup), nb_o0, nb_o1, nb_o2, nb_o3, nb_f0, nb_f1, nb_f2, nb_f3, nb_scale)
DI f32x4 ld4bf(const bfr* p) {
  const uint2 u = *(const uint2*)p;
  return f32x4{__uint_as_float(u.x << 16), __uint_as_float(u.x & 0xffff0000u), __uint_as_float(u.y << 16), __uint_as_float(u.y & 0xffff0000u)};
}
DI f32x4 mix4_(const bfr* pc, const float* mu, int o0, int o1, int o2, int o3, float f0, float f1, float f2, float f3, float scale) {
  const f32x4 c = ld4bf(pc);
  f32x4 s = ld4bf(pc + o0) * f0 + ld4bf(pc + o1) * f1 + ld4bf(pc + o2) * f2 + ld4bf(pc + o3) * f3;
  const f32x4 m = *(const f32x4*)mu;
  return c + (s * scale - c) * m;
}
DI uint2 pk4(f32x4 v) { return uint2{pack2(v[0], v[1]), pack2(v[2], v[3])}; }
constexpr int LIS = 200;
DI void phase_rwprep(const Params& P, int bid, int nb, char* smem) {
  const bfr* p = (const bfr*)(P.ws + WS_P);
  const float* mu = P.in[10]; const float* w0 = P.in[11]; const float* a0 = P.in[13];
  const float* k_k = P.in[16]; const float* k_a = P.in[17];
  const bfr* LW_ = (const bfr*)(P.ws + WS_LORA);
  bfr* R = (bfr*)(P.ws + WS_RW); bfr* K = (bfr*)(P.ws + WS_RW + RW_ARR); bfr* V = (bfr*)(P.ws + WS_RW + 2 * RW_ARR);
  bfr* KK = (bfr*)(P.ws + WS_RW + 3 * RW_ARR); bfr* A = (bfr*)(P.ws + WS_RW + 4 * RW_ARR); bfr* G = (bfr*)(P.ws + WS_RW + 5 * RW_ARR);
  float* LWF = (float*)(P.ws + WS_LW); float* LWB = (float*)(P.ws + WS_LW + LW_ARR);
  short* LI = (short*)smem;
  const int tid = VT, lane = tid & 63, w = tid >> 6, fr = lane & 15, fq = lane >> 4;
  const f32x4 z4 = {0.f, 0.f, 0.f, 0.f};
  for (int it = bid; it < (T_ALL / 32) * 4; it += nb) {
    const int tile = it >> 2, hp = it & 3;
    const int row0 = tile * 32;
    __syncthreads();
    for (int v = tid; v < 32 * 24; v += NTHR) {
      const int t = v / 24, cg = v % 24;
      const int row = row0 + t;
      NB_DECL(row);
      const bfr* pc = p + (size_t)row * DIN + HGC + 1536 + cg * 8;
      f32x4 lo = MIX4(pc, mu + 1536 + cg * 8), hi = MIX4(pc + 4, mu + 1536 + cg * 8 + 4);
#pragma unroll
      for (int e = 0; e < 4; ++e) {
        if (cg < 8) { lo[e] = tanhf(lo[e]); hi[e] = tanhf(hi[e]); }
        else if (cg >= 12) { lo[e] = sigmoidf_(lo[e]); hi[e] = sigmoidf_(hi[e]); }
      }
      const uint2 a = pk4(lo), b = pk4(hi);
      *(uint4*)(LI + t * LIS + cg * 8) = uint4{a.x, a.y, b.x, b.y};
    }
    __syncthreads();
    const int h = hp * 2 + (w >> 1), th = w & 1;
    const int row = row0 + 16 * th + fr;
    NB_DECL(row);
    f32x4 kkr[4], kraw[4], av[4];
    float ss = 0.f;
#pragma unroll
    for (int m = 0; m < 4; ++m) {
      const int c0 = 64 * h + 16 * m;
      const int ch = c0 + 4 * fq;
      f32x4 aF = mm_tile<false, true>((const short*)(LW_ + LORA_WD2T), 32, c0, LI, LIS, 16 * th, 32, z4);
      f32x4 aB = mm_tile<false, true>((const short*)(LW_ + LORA_WD2T + 512 * 32), 32, c0, LI + 32, LIS, 16 * th, 32, z4);
      f32x4 aA = mm_tile<false, true>((const short*)(LW_ + LORA_WA2T), 32, c0, LI + 64, LIS, 16 * th, 32, z4);
      f32x4 aG = mm_tile<false, true>((const short*)(LW_ + LORA_WG2T), 96, c0, LI + 96, LIS, 16 * th, 96, z4);
      const size_t o = (size_t)row * 512 + ch;
      const f32x4 w0f = *(const f32x4*)(w0 + ch), w0b = *(const f32x4*)(w0 + 512 + ch), a0v = *(const f32x4*)(a0 + ch);
      f32x4 lwf, lwb;
#pragma unroll
      for (int e = 0; e < 4; ++e) {
        lwf[e] = -RW_DECAY_SCALE * sigmoidf_(w0f[e] + aF[e]);
        lwb[e] = -RW_DECAY_SCALE * sigmoidf_(w0b[e] + aB[e]);
        av[m][e] = sigmoidf_(a0v[e] + aA[e]);
      }
      *(f32x4*)(LWF + o) = lwf; *(f32x4*)(LWB + o) = lwb;
      *(uint2*)(G + o) = pk4(aG);
      *(uint2*)(A + o) = pk4(av[m]);
      const bfr* pc = p + (size_t)row * DIN + HGC + ch;
      const f32x4 r = MIX4(pc, mu + ch);
      kraw[m] = MIX4(pc + 512, mu + 512 + ch);
      const f32x4 v = MIX4(pc + 1024, mu + 1024 + ch);
      *(uint2*)(R + o) = pk4(r); *(uint2*)(V + o) = pk4(v);
      kkr[m] = kraw[m] * *(const f32x4*)(k_k + ch);
      ss += kkr[m][0] * kkr[m][0] + kkr[m][1] * kkr[m][1] + kkr[m][2] * kkr[m][2] + kkr[m][3] * kkr[m][3];
    }
    ss += __shfl_xor(ss, 16); ss += __shfl_xor(ss, 32);
    const float rn = rsqrtf(fmaxf(ss, 1e-12f));
#pragma unroll
    for (int m = 0; m < 4; ++m) {
      const int ch = 64 * h + 16 * m + 4 * fq;
      const size_t o = (size_t)row * 512 + ch;
      const f32x4 ka = *(const f32x4*)(k_a + ch);
      f32x4 kv;
#pragma unroll
      for (int e = 0; e < 4; ++e) kv[e] = kraw[m][e] * (1.f + (av[m][e] - 1.f) * ka[e]);
      *(uint2*)(K + o) = pk4(kv);
      *(uint2*)(KK + o) = pk4(kkr[m] * rn);
    }
  }
}

DI void phase_readout(const Params& P, int bid, int nb) {
  const bfr* p = (const bfr*)(P.ws + WS_P);
  const float* Of = P.out + (size_t)T_LAT * 512;
  const float* Yf = P.out;
  const bfr* R = (const bfr*)(P.ws + WS_RW); const bfr* K = (const bfr*)(P.ws + WS_RW + RW_ARR); const bfr* V = (const bfr*)(P.ws + WS_RW + 2 * RW_ARR);
  const bfr* G = (const bfr*)(P.ws + WS_RW + 5 * RW_ARR);
  const float* hg_norm_w = P.in[9]; const float* r_k = P.in[18]; const float* gn_w = P.in[19]; const float* gn_b = P.in[20];
  bfr* mix = (bfr*)(P.ws + WS_H);
  const int wid = VT >> 6, lane = VT & 63;
  for (int t = bid * 4 + wid; t < T_LAT; t += nb * 4) {
    {
      float o[8]; float ss = 0.f;
#pragma unroll
      for (int e = 0; e < 8; ++e) { const long idx = (long)t * 512 + lane * 8 + e; o[e] = Of[idx]; ss += o[e] * o[e]; }
      ss += __shfl_xor(ss, 1); ss += __shfl_xor(ss, 2); ss += __shfl_xor(ss, 4); ss += __shfl_xor(ss, 8);
      const float rs = rsqrtf(ss * (1.f / 128.f) + 1e-6f);
      unsigned w[4];
#pragma unroll
      for (int e = 0; e < 8; e += 2) {
        const int c0 = lane * 8 + e;
        const float g0 = bf2f(p[(long)t * DIN + 2048 + c0]), g1 = bf2f(p[(long)t * DIN + 2048 + c0 + 1]);
        const float v0 = o[e] * rs * hg_norm_w[c0] * siluf_(g0);
        const float v1 = o[e + 1] * rs * hg_norm_w[c0 + 1] * siluf_(g1);
        w[e >> 1] = pack2(v0, v1);
      }
      *(uint4*)(mix + (long)t * DM + lane * 8) = uint4{w[0], w[1], w[2], w[3]};
    }
    {
      float y[8]; float s = 0.f, bs = 0.f;
      float vv[8];
#pragma unroll
      for (int e = 0; e < 8; ++e) {
        const long idx = (long)t * 512 + lane * 8 + e;
        y[e] = Yf[idx]; s += y[e];
        bs += bf2f(R[idx]) * bf2f(K[idx]) * r_k[lane * 8 + e];
        vv[e] = bf2f(V[idx]);
      }
      s += __shfl_xor(s, 1); s += __shfl_xor(s, 2); s += __shfl_xor(s, 4);
      bs += __shfl_xor(bs, 1); bs += __shfl_xor(bs, 2); bs += __shfl_xor(bs, 4);
      const float mu = s * (1.f / 64.f);
      float q = 0.f;
#pragma unroll
      for (int e = 0; e < 8; ++e) { y[e] -= mu; q += y[e] * y[e]; }
      q += __shfl_xor(q, 1); q += __shfl_xor(q, 2); q += __shfl_xor(q, 4);
      const float rs = rsqrtf(q * (1.f / 64.f) + 64e-5f);
      unsigned w[4];
#pragma unroll
      for (int e = 0; e < 8; e += 2) {
        const int c0 = lane * 8 + e;
        const long idx = (long)t * 512 + c0;
        const float v0 = (y[e] * rs * gn_w[c0] + gn_b[c0] + bs * vv[e]) * bf2f(G[idx]);
        const float v1 = (y[e + 1] * rs * gn_w[c0 + 1] + gn_b[c0 + 1] + bs * vv[e + 1]) * bf2f(G[idx + 1]);
        w[e >> 1] = pack2(v0, v1);
      }
      *(uint4*)(mix + (long)t * DM + 512 + lane * 8) = uint4{w[0], w[1], w[2], w[3]};
    }
  }
}

DI void phase_outproj(const Params& P, int bid, int nb, char* smem) {
  const bfr* mix = (const bfr*)(P.ws + WS_H);
  const float* w_out = P.in[7];
  float* y = (float*)(P.ws + WS_Y);
  short* sA = (short*)smem; short* sB = sA + 128 * LSTR;
  const int tid = VT, wid = tid >> 6, lane = tid & 63;
  const int wr = wid >> 1, wc = wid & 1, fr = lane & 15, fq = lane >> 4;
  constexpr int NT = 8, MT = T_LAT / 128;
  for (int it = bid; it < NT * MT; it += nb) {
    const int mt = it / NT, nt = it % NT;
    ALoadBf16 al; BLoadF32 bl;
#pragma unroll
    for (int i = 0; i < 4; ++i) al.rp[i] = mix + (long)(mt * 128 + (tid >> 3) + 32 * i) * DM + (tid & 7) * 8;
    bl.valid = true; bl.ldb = DM;
    bl.p = w_out + (long)((tid & 7) * 8) * DM + nt * 128 + (tid >> 3) * 4;
    f32x4 acc[4][4];
    gemm_mainloop(sA, sB, DM / 64, al, bl, acc);
#pragma unroll
    for (int m = 0; m < 4; ++m)
#pragma unroll
      for (int n = 0; n < 4; ++n)
#pragma unroll
        for (int j = 0; j < 4; ++j) {
          const int rr = mt * 128 + wr * 64 + m * 16 + fq * 4 + j, cc = nt * 128 + wc * 64 + n * 16 + fr;
          y[(long)rr * DM + cc] = acc[m][n][j];
        }
  }
}

DI void phase_ln2route(const Params& P, int bid, int nb) {
  const float* x = P.in[0];
  const float* y = (const float*)(P.ws + WS_Y);
  const float* mod = (const float*)(P.ws + WS_MOD);
  const float* ln1_g = P.in[21]; const float* ln1_b = P.in[22];
  const float* wgrp = P.in[25]; const float* bgrp = P.in[26]; const float* wrt = P.in[27]; const float* brt = P.in[28];
  float* x1 = P.out;
  bfr* h2 = (bfr*)(P.ws + WS_H2);
  int* cnt = (int*)(P.ws + WS_CNT); int* list = (int*)(P.ws + WS_LIST); float* asgw = (float*)(P.ws + WS_ASGW);
  const int wid = VT >> 6, lane = VT & 63;
  for (int t = bid * 4 + wid; t < T_LAT; t += nb * 4) {
    f32x4 v[4]; float s = 0.f;
#pragma unroll
    for (int i = 0; i < 4; ++i) {
      const int c = lane * 4 + 256 * i;
      f32x4 xv = *(const f32x4*)(x + (long)t * DM + c), yv = *(const f32x4*)(y + (long)t * DM + c), g1 = *(const f32x4*)(mod + 2048 + c);
      v[i] = xv * DN_ALPHA + g1 * yv;
      s += v[i][0] + v[i][1] + v[i][2] + v[i][3];
    }
    float mu = wave_sum(s) * (1.f / DM); float q = 0.f;
#pragma unroll
    for (int i = 0; i < 4; ++i) { v[i] -= mu; q += v[i][0] * v[i][0] + v[i][1] * v[i][1] + v[i][2] * v[i][2] + v[i][3] * v[i][3]; }
    float rs = rsqrtf(wave_sum(q) * (1.f / DM) + 1e-5f);
    s = 0.f;
#pragma unroll
    for (int i = 0; i < 4; ++i) {
      const int c = lane * 4 + 256 * i;
      f32x4 g = *(const f32x4*)(ln1_g + c), b = *(const f32x4*)(ln1_b + c);
      v[i] = v[i] * rs * g + b;
      *(f32x4*)(x1 + (long)t * DM + c) = v[i];
      s += v[i][0] + v[i][1] + v[i][2] + v[i][3];
    }
    mu = wave_sum(s) * (1.f / DM); q = 0.f;
#pragma unroll
    for (int i = 0; i < 4; ++i) { v[i] -= mu; q += v[i][0] * v[i][0] + v[i][1] * v[i][1] + v[i][2] * v[i][2] + v[i][3] * v[i][3]; }
    rs = rsqrtf(wave_sum(q) * (1.f / DM) + 1e-5f);
#pragma unroll
    for (int i = 0; i < 4; ++i) {
      const int c = lane * 4 + 256 * i;
      f32x4 sh = *(const f32x4*)(mod + 3072 + c), sc = *(const f32x4*)(mod + 4096 + c);
      v[i] = v[i] * rs * (sc + 1.f) + sh;
      uint2 w = {pack2(v[i][0], v[i][1]), pack2(v[i][2], v[i][3])};
      *(uint2*)(h2 + (long)t * DM + c) = w;
    }
    float gl[8];
#pragma unroll
    for (int g = 0; g < 8; ++g) gl[g] = 0.f;
#pragma unroll
    for (int i = 0; i < 4; ++i)
#pragma unroll
      for (int e = 0; e < 4; ++e) {
        const int k = lane * 4 + 256 * i + e;
        const f32x4 w0 = *(const f32x4*)(wgrp + k * 8), w1 = *(const f32x4*)(wgrp + k * 8 + 4);
        const float hv = v[i][e];
        gl[0] += hv * w0[0]; gl[1] += hv * w0[1]; gl[2] += hv * w0[2]; gl[3] += hv * w0[3];
        gl[4] += hv * w1[0]; gl[5] += hv * w1[1]; gl[6] += hv * w1[2]; gl[7] += hv * w1[3];
      }
    int gi = 0; float gmax = -3.4e38f;
#pragma unroll
    for (int g = 0; g < 8; ++g) { gl[g] = wave_sum(gl[g]) + bgrp[g]; if (gl[g] > gmax) { gmax = gl[g]; gi = g; } }
    float den = 0.f;
#pragma unroll
    for (int g = 0; g < 8; ++g) den += __expf(gl[g] - gmax);
    const float gprob = 1.f / den;
    float el[8];
#pragma unroll
    for (int g = 0; g < 8; ++g) el[g] = 0.f;
#pragma unroll
    for (int i = 0; i < 4; ++i)
#pragma unroll
      for (int e = 0; e < 4; ++e) {
        const int k = lane * 4 + 256 * i + e;
        const f32x4 w0 = *(const f32x4*)(wrt + k * 64 + gi * 8), w1 = *(const f32x4*)(wrt + k * 64 + gi * 8 + 4);
        const float hv = v[i][e];
        el[0] += hv * w0[0]; el[1] += hv * w0[1]; el[2] += hv * w0[2]; el[3] += hv * w0[3];
        el[4] += hv * w1[0]; el[5] += hv * w1[1]; el[6] += hv * w1[2]; el[7] += hv * w1[3];
      }
    int i1 = 0; float v1 = -3.4e38f;
#pragma unroll
    for (int g = 0; g < 8; ++g) { el[g] = wave_sum(el[g]) + brt[gi * 8 + g]; if (el[g] > v1) { v1 = el[g]; i1 = g; } }
    int i2 = 0; float v2 = -3.4e38f;
#pragma unroll
    for (int g = 0; g < 8; ++g) { if (g != i1 && el[g] > v2) { v2 = el[g]; i2 = g; } }
    const float e2 = __expf(v2 - v1);
    const float wt1 = gprob / (1.f + e2), wt2 = gprob * e2 / (1.f + e2);
    if (lane == 0) {
      const int ex1 = gi * 8 + i1, ex2 = gi * 8 + i2;
      int s1 = atomicAdd(&cnt[ex1], 1); list[ex1 * T_LAT + s1] = t * 2;
      int s2 = atomicAdd(&cnt[ex2], 1); list[ex2 * T_LAT + s2] = t * 2 + 1;
      asgw[t * 2] = wt1; asgw[t * 2 + 1] = wt2;
    }
  }
}

DI void moe_block_table(const Params& P, int* tab  ) {
  const int* cnt = (const int*)(P.ws + WS_CNT);
  const int tid = VT;
  __syncthreads();
  if (tid < 64) {
    int nbk = (cnt[tid] + 127) >> 7;
    int incl = nbk;
#pragma unroll
    for (int o = 1; o < 64; o <<= 1) { int u = __shfl_up(incl, o); if (tid >= o) incl += u; }
    tab[tid + 1] = incl;
    if (tid == 0) tab[0] = 0;
  }
  __syncthreads();
}
DI int moe_find_expert(const int* tab, int rb) {
  int e = 0;
  while (tab[e + 1] <= rb) ++e;
  return e;
}

DI void phase_moe1(const Params& P, int bid, int nb, char* smem) {
  const bfr* h2 = (const bfr*)(P.ws + WS_H2);
  const int* cnt = (const int*)(P.ws + WS_CNT); const int* list = (const int*)(P.ws + WS_LIST);
  const float* wg = P.in[29]; const float* wu = P.in[30];
  bfr* hid = (bfr*)(P.ws + WS_HID);
  short* sA = (short*)smem; short* sB = sA + 128 * LSTR;
  int* tab = (int*)(smem + GEMM_LDS_BYTES);
  const int tid = VT, wid = tid >> 6, lane = tid & 63;
  const int wr = wid >> 1, wc = wid & 1, fr = lane & 15, fq = lane >> 4;
  moe_block_table(P, tab);
  const int nrb = tab[64];
  for (int it = bid; it < nrb * 8; it += nb) {
    const int rb = it >> 3, nt = it & 7;
    const int e = moe_find_expert(tab, rb);
    const int lrb = rb - tab[e];
    const int ce = cnt[e];
    ALoadBf16 al; BLoadF32 bl;
#pragma unroll
    for (int i = 0; i < 4; ++i) {
      int r = lrb * 128 + (tid >> 3) + 32 * i;
      if (r >= ce) r = ce - 1;
      const int tok = list[e * T_LAT + r] >> 1;
      al.rp[i] = h2 + (long)tok * DM + (tid & 7) * 8;
    }
    const int n4 = tid >> 3;
    const int isup = (n4 >> 3) & 1;
    const int col = nt * 64 + (n4 >> 4) * 32 + ((4 * n4) & 31);
    bl.valid = true; bl.ldb = DEXP;
    bl.p = (isup ? wu : wg) + (long)e * DM * DEXP + (long)((tid & 7) * 8) * DEXP + col;
    f32x4 acc[4][4];
    gemm_mainloop(sA, sB, DM / 64, al, bl, acc);
#pragma unroll
    for (int m = 0; m < 4; ++m)
#pragma unroll
      for (int n = 0; n < 2; ++n)
#pragma unroll
        for (int j = 0; j < 4; ++j) {
          const int rl = wr * 64 + m * 16 + fq * 4 + j;
          const int cc = nt * 64 + wc * 32 + n * 16 + fr;
          const float gv = acc[m][n][j], uv = acc[m][n + 2][j];
          hid[((long)rb * 128 + rl) * DEXP + cc] = f2bf(siluf_(gv) * uv);
        }
  }
}

DI void phase_moe2(const Params& P, int bid, int nb, char* smem) {
  const int* cnt = (const int*)(P.ws + WS_CNT); const int* list = (const int*)(P.ws + WS_LIST);
  const float* wd = P.in[31];
  const bfr* hid = (const bfr*)(P.ws + WS_HID);
  bfr* mout = (bfr*)(P.ws + WS_MOUT);
  short* sA = (short*)smem; short* sB = sA + 128 * LSTR;
  int* tab = (int*)(smem + GEMM_LDS_BYTES);
  const int tid = VT, wid = tid >> 6, lane = tid & 63;
  const int wr = wid >> 1, wc = wid & 1, fr = lane & 15, fq = lane >> 4;
  moe_block_table(P, tab);
  const int nrb = tab[64];
  for (int it = bid; it < nrb * 8; it += nb) {
    const int rb = it >> 3, nt = it & 7;
    const int e = moe_find_expert(tab, rb);
    const int lrb = rb - tab[e];
    const int ce = cnt[e];
    ALoadBf16 al; BLoadF32 bl;
#pragma unroll
    for (int i = 0; i < 4; ++i) al.rp[i] = hid + ((long)rb * 128 + (tid >> 3) + 32 * i) * DEXP + (tid & 7) * 8;
    bl.valid = true; bl.ldb = DM;
    bl.p = wd + (long)e * DEXP * DM + (long)((tid & 7) * 8) * DM + nt * 128 + (tid >> 3) * 4;
    f32x4 acc[4][4];
    gemm_mainloop(sA, sB, DEXP / 64, al, bl, acc);
#pragma unroll
    for (int m = 0; m < 4; ++m)
#pragma unroll
      for (int j = 0; j < 4; ++j) {
        const int r = lrb * 128 + wr * 64 + m * 16 + fq * 4 + j;
        if (r < ce) {
          const int asg = list[e * T_LAT + r];
#pragma unroll
          for (int n = 0; n < 4; ++n) mout[(long)asg * DM + nt * 128 + wc * 64 + n * 16 + fr] = f2bf(acc[m][n][j]);
        }
      }
  }
}

DI void phase_final(const Params& P, int bid, int nb) {
  const float* mod = (const float*)(P.ws + WS_MOD);
  const float* ln2_g = P.in[23]; const float* ln2_b = P.in[24];
  const bfr* mout = (const bfr*)(P.ws + WS_MOUT);
  const float* asgw = (const float*)(P.ws + WS_ASGW);
  float* out = P.out;
  const int wid = VT >> 6, lane = VT & 63;
  for (int t = bid * 4 + wid; t < T_LAT; t += nb * 4) {
    const float w1 = asgw[t * 2], w2 = asgw[t * 2 + 1];
    f32x4 v[4]; float s = 0.f;
#pragma unroll
    for (int i = 0; i < 4; ++i) {
      const int c = lane * 4 + 256 * i;
      f32x4 xv = *(const f32x4*)(out + (long)t * DM + c), g2 = *(const f32x4*)(mod + 5120 + c);
      const uint2 m1 = *(const uint2*)(mout + (long)(2 * t) * DM + c), m2 = *(const uint2*)(mout + (long)(2 * t + 1) * DM + c);
      f32x4 a = {__uint_as_float(m1.x << 16), __uint_as_float(m1.x & 0xffff0000u), __uint_as_float(m1.y << 16), __uint_as_float(m1.y & 0xffff0000u)};
      f32x4 b = {__uint_as_float(m2.x << 16), __uint_as_float(m2.x & 0xffff0000u), __uint_as_float(m2.y << 16), __uint_as_float(m2.y & 0xffff0000u)};
      v[i] = xv * DN_ALPHA + g2 * (a * w1 + b * w2);
      s += v[i][0] + v[i][1] + v[i][2] + v[i][3];
    }
    const float mu = wave_sum(s) * (1.f / DM); float q = 0.f;
#pragma unroll
    for (int i = 0; i < 4; ++i) { v[i] -= mu; q += v[i][0] * v[i][0] + v[i][1] * v[i][1] + v[i][2] * v[i][2] + v[i][3] * v[i][3]; }
    const float rs = rsqrtf(wave_sum(q) * (1.f / DM) + 1e-5f);
#pragma unroll
    for (int i = 0; i < 4; ++i) {
      const int c = lane * 4 + 256 * i;
      f32x4 g = *(const f32x4*)(ln2_g + c), b = *(const f32x4*)(ln2_b + c);
      *(f32x4*)(out + (long)t * DM + c) = v[i] * rs * g + b;
    }
  }
}

namespace pg8 {
#define PG8_LAS __attribute__((address_space(3)))
typedef unsigned short bf16_t;
typedef short bf16x8 __attribute__((ext_vector_type(8)));
typedef float f32x4 __attribute__((ext_vector_type(4)));
typedef unsigned u32x4 __attribute__((ext_vector_type(4)));
constexpr int BM = 256, BK = 64, HALF = 128, HTB = HALF * BK * 2  , STAGE_BYTES = 8 * HTB, NXCD = 8, WGM = 8;

__host__ __device__ __forceinline__ int lds_byte(int r, int c) { const int st = (r >> 4) * 2 + (c >> 5), rr = r & 15, cc = c & 31, ob = rr * 64 + cc * 2; return st * 1024 + (ob ^ (((ob >> 9) & 1) << 5)); }
__host__ __device__ __forceinline__ void stage_rc(int b, int& R, int& C) { const int st = b / 1024, sb = b % 1024, swz = sb ^ (((sb >> 9) & 1) << 5); R = (st >> 1) * 16 + swz / 64; C = (st & 1) * 32 + (swz % 64) / 2; }
__host__ __device__ __forceinline__ int perm32(int rho) { const int n = rho >> 4, i = rho & 15; return 8 * (i >> 2) + 4 * n + (i & 3); }

struct Unit { int pm, pn; };
struct Gemm { const bf16_t* A; const bf16_t* Bt; int M, N, K; };

struct StaticOrder {
    int nM, nN, nwg, G, c;
    __host__ __device__ void init(int M, int N, int G_, int c_) { nM = M / BM; nN = N / BM; nwg = nM * nN; G = G_; c = c_; }
    __host__ __device__ bool next(int i, Unit& u) const {
        const long L = (long)i * G + c; if (L >= nwg) return false;
        int wgid = (int)L; { const int q = nwg / NXCD, r = nwg % NXCD, xcd = wgid % NXCD, off = wgid / NXCD; wgid = (xcd < r ? xcd * (q + 1) : r * (q + 1) + (xcd - r) * q) + off; }
        const int nig = WGM * nN, gid = wgid / nig, fm = gid * WGM, gsz = (nM - fm) < WGM ? (nM - fm) : WGM;
        u.pm = fm + ((wgid % nig) % gsz); u.pn = (wgid % nig) / gsz; return true;
    }
    __device__ __forceinline__ void a_ready(const Unit&) const {}
    __device__ __forceinline__ void done(const Unit&) const {}
};
struct CountedOrder : StaticOrder {
    const unsigned* ready; unsigned need; unsigned* tmo;
    __device__ __forceinline__ void a_ready(const Unit& u) const {
        if (threadIdx.x < 64) {
            const unsigned long long t0 = __builtin_amdgcn_s_memrealtime(); unsigned polls = 0;
            while ((unsigned)__builtin_amdgcn_readfirstlane(__hip_atomic_load(ready + 64 * u.pm, __ATOMIC_RELAXED, __HIP_MEMORY_SCOPE_AGENT)) < need) {
                if ((++polls & 255u) == 0u && __builtin_amdgcn_readfirstlane(__hip_atomic_load(tmo, __ATOMIC_RELAXED, __HIP_MEMORY_SCOPE_AGENT)) != 0u) break;
                if (__builtin_amdgcn_s_memrealtime() - t0 > 2000000ull) {
                    if (threadIdx.x == 0) { unsigned expect = 0u; __hip_atomic_compare_exchange_strong(tmo + 1, &expect, 0x600u | (unsigned)(u.pm & 0xff), __ATOMIC_RELAXED, __ATOMIC_RELAXED, __HIP_MEMORY_SCOPE_AGENT); __hip_atomic_store(tmo, 1u, __ATOMIC_RELAXED, __HIP_MEMORY_SCOPE_AGENT); }
                    break; }
                __builtin_amdgcn_s_sleep(2); }
            __builtin_amdgcn_fence(__ATOMIC_ACQUIRE, "agent");
            asm volatile("s_waitcnt vmcnt(0)" ::: "memory");
        }
#if !defined(BROKEN_HOOK_NO_BARRIER)
        asm volatile("" ::: "memory"); __builtin_amdgcn_s_barrier(); asm volatile("" ::: "memory");
#endif
    }
};
struct EpiF32 {
    static constexpr bool PERM = false, AFTER_DRAIN = false;
    float* C; int ldc; const float* bias;
    __device__ __forceinline__ void operator()(const f32x4 (&acc)[2][2][4][2], const Unit& u, int wr, int wc, int fr, int fq) const {
        const int row0 = u.pm * BM + wr * 64 + fr, col0 = u.pn * BM + wc * 32 + 4 * fq;
        f32x4 bv[2][2];
#pragma unroll
        for (int bj = 0; bj < 2; ++bj)
#pragma unroll
            for (int n = 0; n < 2; ++n) bv[bj][n] = bias ? *(const f32x4*)(bias + col0 + bj * HALF + n * 16) : (f32x4){0.f, 0.f, 0.f, 0.f};
#pragma unroll
        for (int ai = 0; ai < 2; ++ai)
#pragma unroll
            for (int m = 0; m < 4; ++m) { float* rowp = C + (size_t)(row0 + ai * HALF + m * 16) * ldc + col0;
#pragma unroll
                for (int bj = 0; bj < 2; ++bj)
#pragma unroll
                    for (int n = 0; n < 2; ++n) *(f32x4*)(rowp + bj * HALF + n * 16) = acc[ai][bj][m][n] + bv[bj][n]; }
    }
};
template <class Epi, class Sched, bool STAMP = false>
__device__ __forceinline__ void gemm_phase(PG8_LAS unsigned char* lds, const Gemm g, const Sched& S, const Epi& E, unsigned long long* stamps) {
    const int tid = threadIdx.x, wid = __builtin_amdgcn_readfirstlane(tid >> 6), lane = tid & 63, wr = wid >> 2, wc = wid & 3, fr = lane & 15, fq = lane >> 4;
    const int K = g.K, nt = K / BK;
    int ts_lo = 0, ts_hi = 0, nts = 0; const unsigned long long rt_entry = STAMP ? (unsigned long long)wall_clock64() : 0ull;
#define PG8_STAMP() do { if (STAMP && wid == 0 && nts < 64) { const unsigned long long _c = (unsigned long long)clock64(); \
        ts_lo = (lane == nts) ? (int)(unsigned)_c : ts_lo; ts_hi = (lane == nts) ? (int)(unsigned)(_c >> 32) : ts_hi; ++nts; } } while (0)
    PG8_STAMP();
    unsigned voffA[2], voffB[2];
#pragma unroll
    for (int i = 0; i < 2; ++i) { int R, C; stage_rc(tid * 16 + i * 8192, R, C); const int Rb = Epi::PERM ? ((R & ~31) + perm32(R & 31)) : R;
        voffA[i] = (unsigned)(R * K + C) * 2u; voffB[i] = (unsigned)(Rb * K + C) * 2u; }
    const size_t kstep = (size_t)(BK * 2);
    const size_t hstep = (size_t)HALF * K * 2;
    const size_t tstep = 2 * hstep;
    const unsigned ldsw = (unsigned)wid * 1024u;
    const int aoff = lds_byte(wr * 64 + fr, fq * 8), boff = lds_byte(wc * 32 + fr, fq * 8);
#define PG8_SA(b, h) (((b) * 2 + (h)) * HTB)
#define PG8_SB(b, h) ((4 + (b) * 2 + (h)) * HTB)
#define PG8_STAGE(bufoff, gbase, voff) do { _Pragma("unroll") for (int _i = 0; _i < 2; ++_i) \
        __builtin_amdgcn_global_load_lds((const unsigned*)((const char*)(gbase) + (voff)[_i]), (PG8_LAS unsigned*)(lds + (bufoff) + ldsw + _i * 8192), 16, 0, 0); } while (0)
#define PG8_LDA(dst, b, h) do { _Pragma("unroll") for (int m = 0; m < 4; ++m) _Pragma("unroll") for (int k = 0; k < 2; ++k) dst[m][k] = *(const PG8_LAS bf16x8*)(lds + PG8_SA(b, h) + aoff + m * 2048 + k * 1024); } while (0)
#define PG8_LDB(dst, b, h) do { _Pragma("unroll") for (int n = 0; n < 2; ++n) _Pragma("unroll") for (int k = 0; k < 2; ++k) dst[n][k] = *(const PG8_LAS bf16x8*)(lds + PG8_SB(b, h) + boff + n * 2048 + k * 1024); } while (0)
#define PG8_MMA(ai, bj, At, Bt) do { __builtin_amdgcn_s_setprio(1); _Pragma("unroll") for (int m = 0; m < 4; ++m) _Pragma("unroll") for (int n = 0; n < 2; ++n) _Pragma("unroll") for (int k = 0; k < 2; ++k) \
        acc[ai][bj][m][n] = __builtin_amdgcn_mfma_f32_16x16x32_bf16(Bt[n][k], At[m][k], acc[ai][bj][m][n], 0, 0, 0); __builtin_amdgcn_s_setprio(0); } while (0)
#define PG8_WAIT_V(n) asm volatile("s_waitcnt vmcnt(" #n ")" ::: "memory")
#define PG8_WAIT_L(n) asm volatile("s_waitcnt lgkmcnt(" #n ")" ::: "memory")
#define PG8_BAR __builtin_amdgcn_s_barrier()
#define PG8_SCHED __builtin_amdgcn_sched_barrier(0)
    Unit cur, nxt; int ui = 0;
    if (!S.next(0, cur)) return;
    f32x4 acc[2][2][4][2];
#pragma unroll
    for (int a = 0; a < 2; ++a)
#pragma unroll
        for (int b = 0; b < 2; ++b)
#pragma unroll
            for (int m = 0; m < 4; ++m)
#pragma unroll
                for (int n = 0; n < 2; ++n) acc[a][b][m][n] = (f32x4){0.f, 0.f, 0.f, 0.f};
    bf16x8 At[4][2], B0[2][2], B1[2][2];
    const char* cA = (const char*)g.A + (size_t)cur.pm * tstep; const char* cB = (const char*)g.Bt + (size_t)cur.pn * tstep;
    S.a_ready(cur);
    PG8_STAGE(PG8_SB(0, 0), cB, voffB); PG8_STAGE(PG8_SA(0, 0), cA, voffA); PG8_STAGE(PG8_SB(0, 1), cB + hstep, voffB); PG8_STAGE(PG8_SA(0, 1), cA + hstep, voffA);
    if (wr == 1) PG8_BAR;
    PG8_WAIT_V(4); PG8_BAR;
    PG8_STAGE(PG8_SB(1, 0), cB + kstep, voffB); PG8_STAGE(PG8_SA(1, 0), cA + kstep, voffA); PG8_STAGE(PG8_SB(1, 1), cB + hstep + kstep, voffB);
    PG8_WAIT_V(6); PG8_BAR;
    PG8_STAMP();
    for (;;) {
        const bool has_next = S.next(ui + 1, nxt);
        const char* nA = has_next ? (const char*)g.A + (size_t)nxt.pm * tstep : cA; const char* nB = has_next ? (const char*)g.Bt + (size_t)nxt.pn * tstep : cB;
        for (int t = 0; t < nt; t += 2) {
            const bool last = (t == nt - 2);
            const char* a1 = cA + (size_t)(t + 1) * kstep;
            const char* a2 = last ? nA : cA + (size_t)(t + 2) * kstep; const char* b2 = last ? nB : cB + (size_t)(t + 2) * kstep;
            const char* a3 = a2 + kstep; const char* b3 = b2 + kstep;
            if (last && has_next) S.a_ready(nxt);
            PG8_LDB(B0, 0, 0); PG8_SCHED; PG8_LDA(At, 0, 0); PG8_STAGE(PG8_SA(1, 1), a1 + hstep, voffA);
            PG8_WAIT_L(8); PG8_BAR; PG8_WAIT_L(0); PG8_MMA(0, 0, At, B0); PG8_BAR; PG8_SCHED;
            PG8_LDB(B1, 0, 1); PG8_STAGE(PG8_SB(0, 0), b2, voffB);
            PG8_BAR; PG8_WAIT_L(0); PG8_MMA(0, 1, At, B1); PG8_BAR;
            PG8_LDA(At, 0, 1); PG8_STAGE(PG8_SA(0, 0), a2, voffA);
            PG8_BAR; PG8_WAIT_L(0); PG8_MMA(1, 0, At, B0); PG8_BAR; PG8_SCHED;
            PG8_STAGE(PG8_SB(0, 1), b2 + hstep, voffB);
            PG8_WAIT_V(6); PG8_BAR; PG8_MMA(1, 1, At, B1); PG8_BAR;
            PG8_LDB(B0, 1, 0); PG8_SCHED; PG8_LDA(At, 1, 0); PG8_STAGE(PG8_SA(0, 1), a2 + hstep, voffA);
            PG8_WAIT_L(8); PG8_BAR; PG8_WAIT_L(0); PG8_MMA(0, 0, At, B0); PG8_BAR; PG8_SCHED;
            PG8_LDB(B1, 1, 1); PG8_STAGE(PG8_SB(1, 0), b3, voffB);
            PG8_BAR; PG8_WAIT_L(0); PG8_MMA(0, 1, At, B1); PG8_BAR;
            PG8_LDA(At, 1, 1); PG8_STAGE(PG8_SA(1, 0), a3, voffA);
            PG8_BAR; PG8_WAIT_L(0); PG8_MMA(1, 0, At, B0); PG8_BAR; PG8_SCHED;
            PG8_STAGE(PG8_SB(1, 1), b3 + hstep, voffB);
            PG8_WAIT_V(6); PG8_BAR; PG8_MMA(1, 1, At, B1); PG8_BAR;
        }
        PG8_STAMP();
        if constexpr (!Epi::AFTER_DRAIN) { E(acc, cur, wr, wc, fr, fq); S.done(cur); }
        PG8_STAMP();
        if (!has_next) break;
#pragma unroll
        for (int a = 0; a < 2; ++a)
#pragma unroll
            for (int b = 0; b < 2; ++b)
#pragma unroll
                for (int m = 0; m < 4; ++m)
#pragma unroll
                    for (int n = 0; n < 2; ++n) acc[a][b][m][n] = (f32x4){0.f, 0.f, 0.f, 0.f};
        cur = nxt; cA = nA; cB = nB; ++ui;
    }
    PG8_WAIT_V(0);
    if (wr == 0) PG8_BAR;
    PG8_BAR;
    if constexpr (Epi::AFTER_DRAIN) { E.fused(acc, cur, wr, wc, fr, fq, lds, wid, lane); S.done(cur); }
    PG8_STAMP();
    if (STAMP && wid == 0) { stamps[lane] = lane < nts ? (((unsigned long long)(unsigned)ts_hi << 32) | (unsigned)ts_lo) : 0ull;
        if (lane == 62) stamps[62] = rt_entry; if (lane == 63) stamps[63] = (unsigned long long)wall_clock64(); }
#undef PG8_STAMP
#undef PG8_SA
#undef PG8_SB
#undef PG8_STAGE
#undef PG8_LDA
#undef PG8_LDB
#undef PG8_MMA
#undef PG8_WAIT_V
#undef PG8_WAIT_L
#undef PG8_BAR
#undef PG8_SCHED
}
}

constexpr size_t WS_WINT = 284 * MB;
constexpr size_t WS_WOUTT = 1 * MB;
constexpr int NPAD_IN = 4352;
DI void transpose_tile(const float* W, int ldw, int k0, int n0, int nvalid, bfr* WT, int ldt, char* smem) {
  short* T = (short*)smem;
  const int tid = VT;
  __syncthreads();
  {
    const int r = tid >> 2, c4 = tid & 3;
#pragma unroll
    for (int q = 0; q < 4; ++q) {
      const int n = n0 + 16 * c4 + 4 * q;
      f32x4 v = {0.f, 0.f, 0.f, 0.f};
      if (n < nvalid) v = *(const f32x4*)(W + (size_t)(k0 + r) * ldw + n);
#pragma unroll
      for (int e = 0; e < 4; ++e) T[r * 66 + 16 * c4 + 4 * q + e] = (short)f2bf(v[e]);
    }
  }
  __syncthreads();
  {
    const int n = tid >> 2, kq = tid & 3;
    unsigned wv[8];
#pragma unroll
    for (int e = 0; e < 8; ++e) wv[e] = ((unsigned)(unsigned short)T[(16 * kq + 2 * e) * 66 + n]) | (((unsigned)(unsigned short)T[(16 * kq + 2 * e + 1) * 66 + n]) << 16);
    bfr* dst = WT + (size_t)(n0 + n) * ldt + k0 + 16 * kq;
    *(uint4*)dst = uint4{wv[0], wv[1], wv[2], wv[3]};
    *(uint4*)(dst + 8) = uint4{wv[4], wv[5], wv[6], wv[7]};
  }
}
struct EpiP {
  static constexpr bool PERM = true, AFTER_DRAIN = false;
  bfr* O;
  DI void operator()(const pg8::f32x4 (&acc)[2][2][4][2], const pg8::Unit& u, int wr, int wc, int fr, int fq) const {
    const int row0 = u.pm * 256 + wr * 64 + fr, col0 = u.pn * 256 + wc * 32 + 8 * fq;
#pragma unroll
    for (int ai = 0; ai < 2; ++ai)
#pragma unroll
      for (int m = 0; m < 4; ++m) {
        bfr* rowp = O + (size_t)(row0 + ai * 128 + m * 16) * DIN + col0;
#pragma unroll
        for (int bj = 0; bj < 2; ++bj) {
          if (col0 + bj * 128 < DIN) {
            const pg8::f32x4 v0 = acc[ai][bj][m][0], v1 = acc[ai][bj][m][1];
            *(uint4*)(rowp + bj * 128) = uint4{pack2(v0[0], v0[1]), pack2(v0[2], v0[3]), pack2(v1[0], v1[1]), pack2(v1[2], v1[3])};
          }
        }
      }
  }
};
DI void phase_pgemm8(const Params& P, char* smem_all) {
  pg8::Gemm g{(const pg8::bf16_t*)(P.ws + WS_H), (const pg8::bf16_t*)(P.ws + WS_WINT), T_ALL, NPAD_IN, DM};
  pg8::StaticOrder S; S.init(T_ALL, NPAD_IN, (int)gridDim.x, (int)blockIdx.x);
  EpiP E{(bfr*)(P.ws + WS_P)};
  pg8::gemm_phase<EpiP, pg8::StaticOrder>((PG8_LAS unsigned char*)smem_all, g, S, E, nullptr);
}
DI void phase_outproj8(const Params& P, char* smem_all) {
  pg8::Gemm g{(const pg8::bf16_t*)(P.ws + WS_H), (const pg8::bf16_t*)(P.ws + WS_WOUTT), T_LAT, DM, DM};
  pg8::StaticOrder S; S.init(T_LAT, DM, (int)gridDim.x, (int)blockIdx.x);
  pg8::EpiF32 E{(float*)(P.ws + WS_Y), DM, nullptr};
  pg8::gemm_phase<pg8::EpiF32, pg8::StaticOrder>((PG8_LAS unsigned char*)smem_all, g, S, E, nullptr);
}

#define XB_TMO      128
#define XB_XCNT(j)  (256  + 64 * (j))
#define XB_XSUB(j)  (1280 + 64 * (j))
#define XB_XGEN(j)  (2304 + 64 * (j))
#define XB_TOP      3328
#define XB_TOPGEN   3392
#define XCD_BAR_WORDS 3456
#define XB_SPIN_CAP (1u << 22)
#define LAS __attribute__((address_space(3)))
DI unsigned xb_ld(unsigned* p)              { return __hip_atomic_load(p, __ATOMIC_RELAXED, __HIP_MEMORY_SCOPE_AGENT); }
DI unsigned xb_add(unsigned* p, unsigned v) { return __hip_atomic_fetch_add(p, v, __ATOMIC_RELAXED, __HIP_MEMORY_SCOPE_AGENT); }
DI unsigned xb_xcc_id() { return (unsigned)__builtin_amdgcn_s_getreg((3 << 11) | 20) & 0xFu; }
#define XB_SPIN(cond, bar) do { unsigned _sp = 0; while (cond) { __builtin_amdgcn_s_sleep(1); \
    if ((++_sp & 255u) == 0u) { if (xb_ld(&(bar)[XB_TMO])) break; if (_sp > XB_SPIN_CAP) { atomicAdd(&(bar)[XB_TMO], 1u); break; } } } } while (0)
struct XcdBarrier { unsigned* bar; unsigned x; volatile LAS unsigned* st; };
DI XcdBarrier xcd_barrier_post(unsigned* bar, volatile LAS unsigned* st) {
  XcdBarrier b; b.bar = bar; b.x = xb_xcc_id(); b.st = st;
  if (threadIdx.x == 0) (void)xb_add(&bar[XB_XCNT(b.x)], 1u);
  return b;
}
DI void xcd_barrier_complete(unsigned* bar, unsigned x, unsigned& nloc, unsigned& nx) {
  const unsigned G = gridDim.x * gridDim.y * gridDim.z;
  unsigned sum, cnt, mine, sp = 0u;
  for (;;) {
    sum = 0u; cnt = 0u; mine = 0u;
#pragma unroll
    for (unsigned j = 0; j < 16; ++j) { const unsigned c = xb_ld(&bar[XB_XCNT(j)]); sum += c; cnt += (c > 0u) ? 1u : 0u; mine = (j == x) ? c : mine; }
    if (sum == G) break;
    __builtin_amdgcn_s_sleep(1);
    if ((++sp & 255u) == 0u) { if (xb_ld(&bar[XB_TMO])) break; if (sp > XB_SPIN_CAP) { atomicAdd(&bar[XB_TMO], 1u); break; } }
  }
  nloc = mine > 0u ? mine : 1u; nx = cnt > 0u ? cnt : 1u;
}
DI void xcd_barrier(const XcdBarrier& b) {
  asm volatile("s_waitcnt vmcnt(0)" ::: "memory");
  __syncthreads();
  if (threadIdx.x == 0) {
    unsigned* bar = b.bar;
    __builtin_amdgcn_s_waitcnt(0);
    unsigned nloc = b.st[0], nx = b.st[1];
    if (nloc == 0u) { xcd_barrier_complete(bar, b.x, nloc, nx); b.st[0] = nloc; b.st[1] = nx; }
    const unsigned old = xb_add(&bar[XB_XSUB(b.x)], 1u);
    const unsigned gen = old / nloc;
    if (old + 1u == (gen + 1u) * nloc) {
      __builtin_amdgcn_fence(__ATOMIC_RELEASE, "agent");
      asm volatile("s_waitcnt vmcnt(0)" ::: "memory");
      const unsigned og = xb_add(&bar[XB_TOP], 1u);
      const unsigned tg = og / nx;
      if (og + 1u == (tg + 1u) * nx) xb_add(&bar[XB_TOPGEN], 1u);
      else XB_SPIN(xb_ld(&bar[XB_TOPGEN]) == tg, bar);
      __builtin_amdgcn_fence(__ATOMIC_ACQUIRE, "agent");
      xb_add(&bar[XB_XGEN(b.x)], 1u);
      asm volatile("s_waitcnt vmcnt(0)" ::: "memory");
    } else {
      XB_SPIN(xb_ld(&bar[XB_XGEN(b.x)]) == gen, bar);
      __builtin_amdgcn_fence(__ATOMIC_ACQUIRE, "agent");
      asm volatile("s_waitcnt vmcnt(0)" ::: "memory");
    }
  }
  __syncthreads();
}

namespace cg = cooperative_groups;
constexpr int HALF_LDS = 78080;
constexpr int SMEM_BYTES = 2 * HALF_LDS + 16;
__global__ void __launch_bounds__(NTHR_BLOCK) k_fused(Params P) {
  __shared__ __attribute__((aligned(16))) char smem_all[SMEM_BYTES];
  cg::grid_group grid = cg::this_grid();
  const int half = threadIdx.x >> 8;
  char* smem = smem_all + half * HALF_LDS;
  const int bid = blockIdx.x * 2 + half, nb = gridDim.x * 2;
  volatile LAS unsigned* bst = (volatile LAS unsigned*)(smem_all + SMEM_BYTES - 16);
  if (threadIdx.x < 4) bst[threadIdx.x] = 0u;
  __syncthreads();
  XcdBarrier xb = xcd_barrier_post(P.bar, bst);
#define GSYNC() do { if (P.use_cg) grid.sync(); else xcd_barrier(xb); } while (0)
  phase_mod(P, bid, nb, smem);
  GSYNC();
  phase_ln1(P, bid, nb);
  GSYNC();
  phase_pgemm8(P, smem_all);
  GSYNC();
  phase_rwprep(P, bid, nb, smem);
  GSYNC();
  for (int it = bid; it < 16 * RW_NSC; it += nb) rw_levelA_item(P, it / RW_NSC, it % RW_NSC, smem);
  for (int it = bid; it < 8 * HG_NSC; it += nb) hg_levelA_item(P, it / HG_NSC, it % HG_NSC, smem);
  GSYNC();
  if (bid < 16) rw_levelB_chain(P, bid, smem); else hg_levelB(P, bid - 16, nb - 16);
  GSYNC();
  rw_finish(P, bid, nb);
  hg_finish(P, bid, nb, P.out + (size_t)T_LAT * 512);
  GSYNC();
  phase_readout(P, bid, nb);
  GSYNC();
  phase_outproj8(P, smem_all);
  GSYNC();
  phase_ln2route(P, bid, nb);
  GSYNC();
  phase_moe1(P, bid, nb, smem);
  GSYNC();
  phase_moe2(P, bid, nb, smem);
  GSYNC();
  phase_final(P, bid, nb);
}

extern "C" void kernel_launch(void* const* d_in, const int* in_sizes, int n_in, void* d_out, int out_size, void* d_ws, size_t ws_size, hipStream_t stream) {
  static int grid_blocks = 0;
  if (!grid_blocks) {
    int dev = 0, cus = 0, per_cu = 0;
    hipGetDevice(&dev);
    hipDeviceGetAttribute(&cus, hipDeviceAttributeMultiprocessorCount, dev);
    hipOccupancyMaxActiveBlocksPerMultiprocessor(&per_cu, k_fused, NTHR_BLOCK, 0);
    if (per_cu > 1) per_cu = 1;
    if (per_cu < 1) per_cu = 1;
    grid_blocks = cus * per_cu;
  }
  Params P{};
  P.bar = (unsigned*)((char*)d_ws + WS_BAR); P.use_cg = 0; P.pad = 0;
  hipMemsetAsync((char*)d_ws + WS_BAR, 0, XCD_BAR_WORDS * 4, stream);
  for (int i = 0; i < 32; ++i) P.in[i] = (const float*)d_in[i];
  P.out = (float*)d_out; P.ws = (char*)d_ws;
  void* args[] = {&P};
  hipError_t e = hipLaunchCooperativeKernel((void*)k_fused, dim3(grid_blocks), dim3(NTHR_BLOCK), args, 0, stream);
  if (e != hipSuccess) fprintf(stderr, "cooperative launch failed: %s (grid %d)\n", hipGetErrorString(e), grid_blocks);
}
```

```cpp
#include <hip/hip_runtime.h>
#include <hip/hip_cooperative_groups.h>
#include <cstdio>

typedef __attribute__((ext_vector_type(8))) short bf16x8;
typedef __attribute__((ext_vector_type(4))) short s16x4;
typedef __attribute__((ext_vector_type(4))) float f32x4;
typedef __attribute__((ext_vector_type(2))) float f32x2;
typedef __attribute__((ext_vector_type(2))) __bf16 bf16x2_t;
typedef unsigned short bfr;

#define DI __device__ __forceinline__

constexpr int T_LAT = 16384, T_CTX = 256, T_ALL = T_LAT + T_CTX;
constexpr int DM = 1024, DIN = 4288, HGC = 2560, RWC = 1728, DRW = 512, DHG = 512;
constexpr int NEXP = 64, DEXP = 512;
constexpr int NTHR = 256;
constexpr int NTHR_BLOCK = 512;
#define VT ((int)(threadIdx.x & 255))
constexpr float DN_ALPHA = 1.189207115002721f;
constexpr float RW_DECAY_SCALE = 0.6065306597126334f;

constexpr size_t MB = 1ull << 20;
constexpr size_t WS_MOD = 0;
constexpr size_t WS_MODC = 32768;
constexpr size_t WS_LB = 65536;
constexpr size_t WS_CNT = 65536 + 8192;
constexpr size_t WS_BAR = 81920;
constexpr size_t WS_ASGW = 131072;
constexpr size_t WS_LIST = 1 * MB;
constexpr size_t WS_H = 6 * MB;
constexpr size_t WS_P = 42 * MB;
constexpr size_t WS_Y = 42 * MB;
constexpr size_t WS_H2 = 106 * MB;
constexpr size_t WS_HID = 138 * MB;
constexpr size_t WS_RW = 186 * MB;
constexpr size_t RW_ARR = (size_t)T_ALL * 512 * 2;
constexpr size_t WS_X1B = 6 * MB;
constexpr size_t WS_MIX = WS_RW + 3 * RW_ARR;
constexpr size_t WS_LW = 284 * MB;
constexpr size_t LW_ARR = (size_t)T_ALL * 512 * 4;
constexpr size_t WS_YRW = 350 * MB;
constexpr size_t WS_OHG = 414 * MB;
constexpr size_t WS_MOUT = 186 * MB;

struct Params {
  const float* in[32];
  float* out;
  char* ws;
  unsigned* bar;
  int use_cg;
  int pad;
};

DI unsigned pack2(float a, float b) {
  f32x2 v = {a, b};
  bf16x2_t r = __builtin_convertvector(v, bf16x2_t);
  return __builtin_bit_cast(unsigned, r);
}
DI bfr f2bf(float a) { return (bfr)(pack2(a, 0.f) & 0xffffu); }
DI float bf2f(bfr v) { return __uint_as_float(((unsigned)v) << 16); }
DI float sigmoidf_(float x) { return 1.f / (1.f + __expf(-x)); }
DI float siluf_(float x) { return x / (1.f + __expf(-x)); }
DI f32x4 ld4bf(const bfr* p);
DI float wave_sum(float v) {
#pragma unroll
  for (int o = 32; o > 0; o >>= 1) v += __shfl_xor(v, o);
  return v;
}

constexpr int LSTR = 72;
constexpr int GEMM_LDS_BYTES = 2 * 128 * LSTR * 2;

struct ALoadBf16 {
  const bfr* rp[4];
  bf16x8 r[4];
  DI void load(int kt) {
#pragma unroll
    for (int i = 0; i < 4; ++i) r[i] = *(const bf16x8*)(rp[i] + kt * 64);
  }
  DI void store(short* sA) const {
    const int tid = VT;
#pragma unroll
    for (int i = 0; i < 4; ++i) *(bf16x8*)(sA + ((tid >> 3) + 32 * i) * LSTR + (tid & 7) * 8) = r[i];
  }
};

struct BLoadF32 {
  const float* p;
  long ldb;
  bool valid;
  f32x4 v[8];
  DI void load(int kt) {
#pragma unroll
    for (int j = 0; j < 8; ++j) {
      if (valid) v[j] = *(const f32x4*)(p + ((long)kt * 64 + j) * ldb);
      else v[j] = f32x4{0.f, 0.f, 0.f, 0.f};
    }
  }
  DI void store(short* sB) const {
    const int tid = VT, kg = tid & 7, n4 = tid >> 3;
#pragma unroll
    for (int i = 0; i < 4; ++i) {
      unsigned a0 = pack2(v[0][i], v[1][i]), a1 = pack2(v[2][i], v[3][i]);
      unsigned a2 = pack2(v[4][i], v[5][i]), a3 = pack2(v[6][i], v[7][i]);
      typedef __attribute__((ext_vector_type(4))) unsigned u32x4;
      u32x4 w = {a0, a1, a2, a3};
      *(u32x4*)(sB + (4 * n4 + i) * LSTR + kg * 8) = w;
    }
  }
};

template <class AL, class BL>
DI void gemm_mainloop(short* sA, short* sB, int nk, AL& al, BL& bl, f32x4 (&acc)[4][4]) {
  const int tid = VT, wid = tid >> 6, lane = tid & 63;
  const int wr = wid >> 1, wc = wid & 1, fr = lane & 15, fq = lane >> 4;
#pragma unroll
  for (int m = 0; m < 4; ++m)
#pragma unroll
    for (int n = 0; n < 4; ++n) acc[m][n] = f32x4{0.f, 0.f, 0.f, 0.f};
  al.load(0); bl.load(0);
  for (int kt = 0; kt < nk; ++kt) {
    __syncthreads();
    al.store(sA); bl.store(sB);
    __syncthreads();
    if (kt + 1 < nk) { al.load(kt + 1); bl.load(kt + 1); }
#pragma unroll
    for (int ks = 0; ks < 2; ++ks) {
      bf16x8 af[4], bf[4];
#pragma unroll
      for (int m = 0; m < 4; ++m) af[m] = *(const bf16x8*)(sA + (wr * 64 + m * 16 + fr) * LSTR + ks * 32 + fq * 8);
#pragma unroll
      for (int n = 0; n < 4; ++n) bf[n] = *(const bf16x8*)(sB + (wc * 64 + n * 16 + fr) * LSTR + ks * 32 + fq * 8);
#pragma unroll
      for (int m = 0; m < 4; ++m)
#pragma unroll
        for (int n = 0; n < 4; ++n) acc[m][n] = __builtin_amdgcn_mfma_f32_16x16x32_bf16(af[m], bf[n], acc[m][n], 0, 0, 0);
    }
  }
}

DI void phase_lora_convert(const Params& P, int part, int nparts);
DI void phase_wrt_convert(const Params& P, int part, int nparts);
DI void transpose_tile(const float* W, int ldw, int k0, int n0, int nvalid, bfr* WT, int ldt, char* smem);
DI void phase_mod(const Params& P, int bid, int nb, char* smem) {
  const float* c = P.in[1]; const float* cc = P.in[3];
  const float* w_mod = P.in[4]; const float* b_mod = P.in[5];
  float* mod = (float*)(P.ws + WS_MOD); float* modc = (float*)(P.ws + WS_MODC);
  float* red = (float*)smem;
  const int tid = VT;
  for (int it = bid; it < 1550; it += nb) {
    if (it < 192) {
      const int kq = tid >> 3, c4 = tid & 7;
      const int col = it * 32 + c4 * 4;
      f32x4 a1 = {0, 0, 0, 0}, a2 = {0, 0, 0, 0};
      for (int k = kq; k < DM; k += 32) {
        f32x4 w = *(const f32x4*)(w_mod + (long)k * 6144 + col);
        float s1 = siluf_(c[k]), s2 = siluf_(cc[k]);
        a1 += w * s1; a2 += w * s2;
      }
      __syncthreads();
#pragma unroll
      for (int e = 0; e < 4; ++e) { red[(kq * 32) + c4 * 4 + e] = a1[e]; red[1024 + kq * 32 + c4 * 4 + e] = a2[e]; }
      __syncthreads();
      if (tid < 64) {
        const int which = tid >> 5, cl = tid & 31;
        float s = 0.f;
        for (int q = 0; q < 32; ++q) s += red[which * 1024 + q * 32 + cl];
        const int cg = it * 32 + cl;
        s += b_mod[cg];
        if (which == 0) mod[cg] = s; else modc[cg] = s;
      }
    } else if (it == 192) {
      const float* L = P.in[8];
      float* lb = (float*)(P.ws + WS_LB);
      for (int i = tid; i < 1024; i += NTHR) {
        const int d = i >> 9, j = i & 511;
        float l0 = L[d * 1024 + j], l1 = L[d * 1024 + 512 + j];
        lb[i] = 1.f / (1.f + __expf(l1 - l0));
      }
    } else if (it == 193) {
      int* cnt = (int*)(P.ws + WS_CNT);
      if (tid < 64) cnt[tid] = 0;
    } else if (it < 198) {
      phase_lora_convert(P, it - 194, 4);
    } else if (it < 1286) {
      const int t = it - 198;
      transpose_tile(P.in[6], DIN, (t / 68) * 64, (t % 68) * 64, DIN, (bfr*)(P.ws + (284ull << 20)), DM, smem);
    } else if (it < 1542) {
      const int t = it - 1286;
      transpose_tile(P.in[7], DM, (t >> 4) * 64, (t & 15) * 64, DM, (bfr*)(P.ws + (1ull << 20)), DM, smem);
    } else {
      phase_wrt_convert(P, it - 1542, 8);
    }
  }
}

DI void phase_ln1(const Params& P, int bid, int nb) {
  const float* x = P.in[0]; const float* ctx = P.in[2];
  const float* mod = (const float*)(P.ws + WS_MOD); const float* modc = (const float*)(P.ws + WS_MODC);
  bfr* h = (bfr*)(P.ws + WS_H);
  const int wid = VT >> 6, lane = VT & 63;
  for (int row0 = (bid * 4 + wid) * 2; row0 < T_ALL; row0 += nb * 8) {
    const float* src = row0 < T_LAT ? x + (long)row0 * DM : ctx + (long)(row0 - T_LAT) * DM;
    const float* mm = row0 < T_LAT ? mod : modc;
    f32x4 v[2][4];
    float s[2] = {0.f, 0.f};
#pragma unroll
    for (int r = 0; r < 2; ++r)
#pragma unroll
      for (int i = 0; i < 4; ++i) { v[r][i] = *(const f32x4*)(src + r * DM + lane * 4 + 256 * i); s[r] += v[r][i][0] + v[r][i][1] + v[r][i][2] + v[r][i][3]; }
#pragma unroll
    for (int r = 0; r < 2; ++r) {
      const float mu = wave_sum(s[r]) * (1.f / DM);
      float q = 0.f;
#pragma unroll
      for (int i = 0; i < 4; ++i) { v[r][i] -= mu; q += v[r][i][0] * v[r][i][0] + v[r][i][1] * v[r][i][1] + v[r][i][2] * v[r][i][2] + v[r][i][3] * v[r][i][3]; }
      const float rs = rsqrtf(wave_sum(q) * (1.f / DM) + 1e-5f);
#pragma unroll
      for (int i = 0; i < 4; ++i) {
        const int cidx = lane * 4 + 256 * i;
        f32x4 sh = *(const f32x4*)(mm + cidx), sc = *(const f32x4*)(mm + 1024 + cidx);
        f32x4 o = v[r][i] * rs * (sc + 1.f) + sh;
        uint2 w = {pack2(o[0], o[1]), pack2(o[2], o[3])};
        *(uint2*)(h + (long)(row0 + r) * DM + cidx) = w;
      }
    }
  }
}

DI void phase_pgemm(const Params& P, int bid, int nb, char* smem) {
  const bfr* h = (const bfr*)(P.ws + WS_H);
  const float* w_in = P.in[6];
  bfr* p = (bfr*)(P.ws + WS_P);
  short* sA = (short*)smem; short* sB = sA + 128 * LSTR;
  const int tid = VT, wid = tid >> 6, lane = tid & 63;
  const int wr = wid >> 1, wc = wid & 1, fr = lane & 15, fq = lane >> 4;
  constexpr int NT = 34, MT = T_ALL / 128;
  for (int it = bid; it < NT * MT; it += nb) {
    const int mt = it / NT, nt = it % NT;
    ALoadBf16 al; BLoadF32 bl;
#pragma unroll
    for (int i = 0; i < 4; ++i) al.rp[i] = h + (long)(mt * 128 + (tid >> 3) + 32 * i) * DM + (tid & 7) * 8;
    const int col = nt * 128 + (tid >> 3) * 4;
    bl.valid = col < DIN; bl.ldb = DIN;
    bl.p = w_in + (long)((tid & 7) * 8) * DIN + (bl.valid ? col : 0);
    f32x4 acc[4][4];
    gemm_mainloop(sA, sB, DM / 64, al, bl, acc);
#pragma unroll
    for (int m = 0; m < 4; ++m)
#pragma unroll
      for (int n = 0; n < 4; ++n) {
        const int cc = nt * 128 + wc * 64 + n * 16 + fr;
        if (cc < DIN) {
#pragma unroll
          for (int j = 0; j < 4; ++j) {
            const int rr = mt * 128 + wr * 64 + m * 16 + fq * 4 + j;
            p[(long)rr * DIN + cc] = f2bf(acc[m][n][j]);
          }
        }
      }
  }
}

DI float rw_mixed(const bfr* p, int row, int c, const float* mu) {
  const long base = (long)row * DIN + HGC + c;
  const float pc = bf2f(p[base]);
  float nbv;
  if (row < T_LAT) {
    const int gr = row >> 6, gc = row & 63;
    float s = 0.f;
    if (gr > 0) s += bf2f(p[base - 64l * DIN]);
    if (gr < 255) s += bf2f(p[base + 64l * DIN]);
    if (gc > 0) s += bf2f(p[base - DIN]);
    if (gc < 63) s += bf2f(p[base + DIN]);
    nbv = 0.25f * s;
  } else {
    const int sidx = row - T_LAT;
    float s = 0.f;
    if (sidx > 0) s += bf2f(p[base - DIN]);
    if (sidx < T_CTX - 1) s += bf2f(p[base + DIN]);
    nbv = 0.5f * s;
  }
  return pc + (nbv - pc) * mu[c];
}

DI void rwkv_chain_naive(const Params& P, int chain, char* smem) {
  const int dir = chain >> 3, hd = chain & 7;
  const bfr* R = (const bfr*)(P.ws + WS_RW); const bfr* K = (const bfr*)(P.ws + WS_RW + RW_ARR); const bfr* V = (const bfr*)(P.ws + WS_RW + 2 * RW_ARR);
  const bfr* KK = (const bfr*)(P.ws + WS_RW + 3 * RW_ARR); const bfr* A = (const bfr*)(P.ws + WS_RW + 4 * RW_ARR);
  const float* LW = (const float*)(P.ws + WS_LW + (dir ? LW_ARR : 0));
  float* Y = (float*)(P.ws + WS_YRW) + (long)dir * T_LAT * 512;
  float* vec = (float*)smem;
  float* red = vec + 16 * 6 * 64;
  const int tid = VT, i = tid & 63, jq = tid >> 6;
  float S[16];
#pragma unroll
  for (int j = 0; j < 16; ++j) S[j] = 0.f;
  for (int s0 = 0; s0 < T_ALL; s0 += 16) {
    __syncthreads();
    for (int e = tid; e < 16 * 64; e += NTHR) {
      const int st = e >> 6, j = e & 63;
      const int s = s0 + st;
      int row;
      if (s < T_CTX) row = T_LAT + (dir ? (T_CTX - 1 - s) : s);
      else row = dir ? (T_LAT - 1 - (s - T_CTX)) : (s - T_CTX);
      const long o = (long)row * 512 + hd * 64 + j;
      float* vp = vec + st * 384;
      const float kk = bf2f(KK[o]);
      vp[j] = bf2f(R[o]); vp[64 + j] = __expf(LW[o]); vp[128 + j] = bf2f(K[o]); vp[192 + j] = bf2f(V[o]);
      vp[256 + j] = kk; vp[320 + j] = kk * bf2f(A[o]);
    }
    __syncthreads();
    for (int st = 0; st < 16; ++st) {
      const float* vp = vec + st * 384;
      const int par = st & 1;
      float sa = 0.f;
#pragma unroll
      for (int j = 0; j < 16; ++j) sa += S[j] * vp[256 + jq * 16 + j];
      red[(par * 2 + 0) * 256 + jq * 64 + i] = sa;
      __syncthreads();
      sa = red[(par * 2) * 256 + i] + red[(par * 2) * 256 + 64 + i] + red[(par * 2) * 256 + 128 + i] + red[(par * 2) * 256 + 192 + i];
      const float vi = vp[192 + i];
      float y = 0.f;
#pragma unroll
      for (int j = 0; j < 16; ++j) {
        const int jj = jq * 16 + j;
        S[j] = S[j] * vp[64 + jj] - sa * vp[320 + jj] + vi * vp[128 + jj];
        y += S[j] * vp[jj];
      }
      red[(par * 2 + 1) * 256 + jq * 64 + i] = y;
      __syncthreads();
      const int s = s0 + st;
      if (jq == 0 && s >= T_CTX) {
        y = red[(par * 2 + 1) * 256 + i] + red[(par * 2 + 1) * 256 + 64 + i] + red[(par * 2 + 1) * 256 + 128 + i] + red[(par * 2 + 1) * 256 + 192 + i];
        const int row = dir ? (T_LAT - 1 - (s - T_CTX)) : (s - T_CTX);
        Y[(long)row * 512 + hd * 64 + i] = y;
      }
    }
  }
}

DI void hgrn_chain_naive(const Params& P, int chain, char* smem) {
  const int dir = chain >> 2, hd = chain & 3;
  const bfr* p = (const bfr*)(P.ws + WS_P);
  const float* lb = (const float*)(P.ws + WS_LB) + dir * 512 + hd * 128;
  float* O = (float*)(P.ws + WS_OHG) + (long)dir * T_LAT * 512;
  float* vec = (float*)smem;
  float* red = vec + 16 * 4 * 128;
  const int tid = VT, e = tid & 127, dh = tid >> 7;
  float S[64];
#pragma unroll
  for (int d = 0; d < 64; ++d) S[d] = 0.f;
  for (int s0 = 0; s0 < T_ALL; s0 += 16) {
    __syncthreads();
    for (int x = tid; x < 16 * 128; x += NTHR) {
      const int st = x >> 7, d = x & 127;
      const int s = s0 + st;
      int row;
      if (s < T_CTX) row = T_LAT + (dir ? (T_CTX - 1 - s) : s);
      else row = dir ? (T_LAT - 1 - (s - T_CTX)) : (s - T_CTX);
      const bfr* pr = p + (long)row * DIN + hd * 128 + d;
      const float q = bf2f(pr[0]), iv = bf2f(pr[512]), z = bf2f(pr[1024 + dir * 512]);
      const float l = lb[d];
      const float f = l + (1.f - l) * sigmoidf_(z);
      float* vp = vec + st * 512;
      vp[d] = siluf_(q); vp[128 + d] = f; vp[256 + d] = (1.f - l) * sigmoidf_(-z); vp[384 + d] = iv;
    }
    __syncthreads();
    for (int st = 0; st < 16; ++st) {
      const float* vp = vec + st * 512;
      const int par = st & 1;
      const float ve = vp[384 + e];
      float o = 0.f;
#pragma unroll
      for (int d = 0; d < 64; ++d) {
        const int dd = dh * 64 + d;
        S[d] = S[d] * vp[128 + dd] + vp[256 + dd] * ve;
        o += vp[dd] * S[d];
      }
      red[par * 256 + dh * 128 + e] = o;
      __syncthreads();
      const int s = s0 + st;
      if (dh == 0 && s >= T_CTX) {
        o = red[par * 256 + e] + red[par * 256 + 128 + e];
        const int row = dir ? (T_LAT - 1 - (s - T_CTX)) : (s - T_CTX);
        O[(long)row * 512 + hd * 128 + e] = o;
      }
    }
  }
}

#define LDSP(T) __attribute__((address_space(3))) T*
DI int row_of_step(int dir, int s) {
  if (s < T_CTX) return T_LAT + (dir ? (T_CTX - 1 - s) : s);
  return dir ? (T_LAT - 1 - (s - T_CTX)) : (s - T_CTX);
}
DI bf16x8 ld_tr8(const short* base, int stride, int k0, int n0) {
  const int lane = VT & 63, g = lane >> 4, q = (lane & 15) >> 2, p = lane & 3;
  const short* a0 = base + (k0 + 8 * g + q) * stride + n0 + 4 * p;
  s16x4 lo = __builtin_amdgcn_ds_read_tr16_b64_v4i16((LDSP(s16x4))a0);
  s16x4 hi = __builtin_amdgcn_ds_read_tr16_b64_v4i16((LDSP(s16x4))(a0 + 4 * stride));
  return __builtin_shufflevector(lo, hi, 0, 1, 2, 3, 4, 5, 6, 7);
}
template <bool AT, bool BT>
DI f32x4 mm_tile(const short* A, int lda, int m0, const short* B, int ldb, int n0, int K, f32x4 acc) {
  const int lane = VT & 63, fr = lane & 15, fq = lane >> 4;
#ifdef SLOWMM
#pragma unroll
  for (int reg = 0; reg < 4; ++reg) {
    const int row = m0 + 4 * fq + reg, col = n0 + fr;
    float s = 0.f;
    for (int k = 0; k < K; ++k) {
      const float a = bf2f((bfr)(AT ? A[k * lda + row] : A[row * lda + k]));
      const float b = bf2f((bfr)(BT ? B[col * ldb + k] : B[k * ldb + col]));
      s += a * b;
    }
    acc[reg] += s;
  }
#else
  for (int k0 = 0; k0 < K; k0 += 32) {
    bf16x8 a, b;
    if (AT) a = ld_tr8(A, lda, k0, m0); else a = *(const bf16x8*)(A + (m0 + fr) * lda + k0 + fq * 8);
    if (BT) b = *(const bf16x8*)(B + (n0 + fr) * ldb + k0 + fq * 8); else b = ld_tr8(B, ldb, k0, n0);
    acc = __builtin_amdgcn_mfma_f32_16x16x32_bf16(a, b, acc, 0, 0, 0);
  }
#endif
  return acc;
}
DI void st_tile(short* C, int ldc, int m0, int n0, f32x4 acc) {
  const int lane = VT & 63, fr = lane & 15, fq = lane >> 4;
#pragma unroll
  for (int reg = 0; reg < 4; ++reg) C[(m0 + 4 * fq + reg) * ldc + n0 + fr] = (short)f2bf(acc[reg]);
}

constexpr int RW_NSC = 32;
DI int rw_sc_begin(int sc) { return sc * 16 + (sc < 8 ? sc : 8); }
DI int rw_sc_of_chunk(int ci) { return ci < 136 ? ci / 17 : 8 + (ci - 136) / 16; }
constexpr int XS = 72, SS = 40, GS = 72;
constexpr int RWL_XK = 0, RWL_XKB = 4608, RWL_XBB = 9216, RWL_XR = 13824, RWL_XV = 18432, RWL_S = 23040;
constexpr int RWL_GP = 38400, RWL_GQ = 47616, RWL_GAM = 56832, RWL_TOT = 57088, RWL_END = 58112;
constexpr size_t WS_PTOT = 6 * MB;
constexpr size_t WS_QTOT = 10 * MB;
constexpr size_t WS_SINRW = 18 * MB;
constexpr size_t WS_R2P = 350 * MB;
constexpr size_t WS_Y0P = 382 * MB;

DI void rw_levelA_item(const Params& P, int chain, int sc, char* smem) {
  const int dir = chain >> 3, hd = chain & 7;
  const bfr* Rg = (const bfr*)(P.ws + WS_RW); const bfr* Kg = (const bfr*)(P.ws + WS_RW + RW_ARR); const bfr* Vg = (const bfr*)(P.ws + WS_RW + 2 * RW_ARR);
  const bfr* KKg = (const bfr*)(P.ws + WS_RW + 3 * RW_ARR); const bfr* Ag = (const bfr*)(P.ws + WS_RW + 4 * RW_ARR);
  const float* LWg = (const float*)(P.ws + WS_LW + (dir ? LW_ARR : 0));
  bfr* R2P = (bfr*)(P.ws + WS_R2P) + (size_t)dir * T_LAT * 512;
  bfr* Y0P = (bfr*)(P.ws + WS_Y0P) + (size_t)dir * T_LAT * 512;
  short* XK = (short*)(smem + RWL_XK); short* XKB = (short*)(smem + RWL_XKB); short* XBB = (short*)(smem + RWL_XBB);
  short* XR = (short*)(smem + RWL_XR); short* XV = (short*)(smem + RWL_XV);
  short* XZ = XR; short* XR2 = XR; short* GPc = XK;
  short* SL = (short*)(smem + RWL_S); short* SAkk = SL + 32 * SS; short* SAkr = SAkk + 32 * SS; short* SM = SAkr + 32 * SS;
  short* ST = SM + 32 * SS; short* SnAbr = ST + 32 * SS;
  short* XW1 = SL; short* XW2 = SAkr;
  short* GP = (short*)(smem + RWL_GP); short* GQ = (short*)(smem + RWL_GQ);
  float* gam = (float*)(smem + RWL_GAM); float* tot = (float*)(smem + RWL_TOT);
  const int tid = VT, lane = tid & 63, w = tid >> 6, fr = lane & 15, fq = lane >> 4;
  const int tm = w >> 1, tn = w & 1;
  const f32x4 z4 = {0.f, 0.f, 0.f, 0.f};
  __syncthreads();
  for (int i = tid; i < 64 * 64; i += NTHR) { const int r = i >> 6, c = i & 63; GP[r * GS + c] = (r == c) ? (short)0x3F80 : (short)0; GQ[r * GS + c] = 0; }
  f32x4 pcum[4], qcum[4];
#pragma unroll
  for (int n = 0; n < 4; ++n) { pcum[n] = z4; qcum[n] = z4; }
  const int c_begin = rw_sc_begin(sc), c_end = rw_sc_begin(sc + 1);
  float pf_lw[8]; unsigned pf_rk[8], pf_vkk[8], pf_a[8];
#define RW_PREFETCH(cc) do { _Pragma("unroll") for (int e_ = 0; e_ < 8; ++e_) { \
      const int row_ = row_of_step(dir, (cc) * 32 + (tid >> 6) * 8 + e_); const size_t o_ = (size_t)row_ * 512 + hd * 64 + (tid & 63); \
      pf_lw[e_] = LWg[o_]; pf_rk[e_] = (unsigned)Rg[o_] | ((unsigned)Kg[o_] << 16); pf_vkk[e_] = (unsigned)Vg[o_] | ((unsigned)KKg[o_] << 16); pf_a[e_] = Ag[o_]; } } while (0)
  RW_PREFETCH(c_begin);
  for (int ci = c_begin; ci < c_end; ++ci) {
    __syncthreads();
    {
      const int j = tid & 63, qt = tid >> 6;
      float lam[8];
      float run = 0.f;
#pragma unroll
      for (int e = 0; e < 8; ++e) { run += pf_lw[e]; lam[e] = run; }
      tot[qt * 64 + j] = run;
      __syncthreads();
      float base = 0.f, total = 0.f;
#pragma unroll
      for (int q2 = 0; q2 < 4; ++q2) { const float tv = tot[q2 * 64 + j]; total += tv; if (q2 < qt) base += tv; }
#pragma unroll
      for (int e = 0; e < 8; ++e) {
        const float L = base + lam[e], Lp = L - pf_lw[e];
        const float eL = __expf(L), enL = __expf(-L), eLp = __expf(Lp);
        const float kkv = __uint_as_float(pf_vkk[e] & 0xffff0000u);
        const int t = qt * 8 + e;
        XK[t * XS + j] = (short)f2bf(kkv * eLp);
        XKB[t * XS + j] = (short)f2bf(__uint_as_float(pf_rk[e] & 0xffff0000u) * enL);
        XBB[t * XS + j] = (short)f2bf(kkv * __uint_as_float(pf_a[e] << 16) * enL);
        XR[t * XS + j] = (short)f2bf(__uint_as_float(pf_rk[e] << 16) * eL);
        XV[t * XS + j] = (short)(pf_vkk[e] & 0xffffu);
      }
      if (qt == 0) gam[j] = __expf(total);
      if (ci + 1 < c_end) RW_PREFETCH(ci + 1);
    }
    __syncthreads();
    f32x4 tacc; f32x4 rt[2];
    {
      f32x4 aL = mm_tile<false, true>(XK, XS, 16 * tm, XBB, XS, 16 * tn, 64, z4);
      f32x4 aKK = mm_tile<false, true>(XK, XS, 16 * tm, XKB, XS, 16 * tn, 64, z4);
      f32x4 aBR = mm_tile<false, true>(XR, XS, 16 * tm, XBB, XS, 16 * tn, 64, z4);
      f32x4 aKR = mm_tile<false, true>(XR, XS, 16 * tm, XKB, XS, 16 * tn, 64, z4);
#pragma unroll
      for (int reg = 0; reg < 4; ++reg) {
        const int row = 16 * tm + 4 * fq + reg, col = 16 * tn + fr;
        const bool st = col < row, inc = col <= row;
        aL[reg] = st ? aL[reg] : 0.f; aKK[reg] = st ? aKK[reg] : 0.f;
        aBR[reg] = inc ? -aBR[reg] : 0.f; aKR[reg] = inc ? aKR[reg] : 0.f;
        tacc[reg] = (row == col ? 1.f : 0.f) - aL[reg];
      }
      st_tile(SL, SS, 16 * tm, 16 * tn, aL); st_tile(ST, SS, 16 * tm, 16 * tn, tacc);
      st_tile(SAkk, SS, 16 * tm, 16 * tn, aKK); st_tile(SnAbr, SS, 16 * tm, 16 * tn, aBR); st_tile(SAkr, SS, 16 * tm, 16 * tn, aKR);
#pragma unroll
      for (int i = 0; i < 2; ++i)
#pragma unroll
        for (int reg = 0; reg < 4; ++reg) rt[i][reg] = bf2f((bfr)XR[(16 * tm + 4 * fq + reg) * XS + 16 * (2 * tn + i) + fr]);
    }
    __syncthreads();
    f32x4 y0[2];
    {
#pragma unroll
      for (int i = 0; i < 2; ++i) {
        f32x4 z = mm_tile<false, false>(SAkk, SS, 16 * tm, XV, XS, 16 * (2 * tn + i), 32, z4);
        st_tile(XZ, XS, 16 * tm, 16 * (2 * tn + i), z);
        y0[i] = mm_tile<false, false>(SAkr, SS, 16 * tm, XV, XS, 16 * (2 * tn + i), 32, z4);
      }
      f32x4 m = mm_tile<false, false>(SL, SS, 16 * tm, SL, SS, 16 * tn, 32, z4);
      st_tile(SM, SS, 16 * tm, 16 * tn, m);
    }
    __syncthreads();
#pragma unroll 1
    for (int rd = 0; rd < 4; ++rd) {
      f32x4 tnew = mm_tile<false, false>(ST, SS, 16 * tm, SM, SS, 16 * tn, 32, tacc);
      f32x4 mnew = z4;
      if (rd < 3) mnew = mm_tile<false, false>(SM, SS, 16 * tm, SM, SS, 16 * tn, 32, z4);
      __syncthreads();
      tacc = tnew;
      st_tile(ST, SS, 16 * tm, 16 * tn, tacc);
      if (rd < 3) st_tile(SM, SS, 16 * tm, 16 * tn, mnew);
      __syncthreads();
    }
    {
      f32x4 w1[2], w2[2];
#pragma unroll
      for (int i = 0; i < 2; ++i) {
        w1[i] = mm_tile<false, false>(ST, SS, 16 * tm, XK, XS, 16 * (2 * tn + i), 32, z4);
        w2[i] = mm_tile<false, false>(ST, SS, 16 * tm, XZ, XS, 16 * (2 * tn + i), 32, z4);
      }
#pragma unroll
      for (int i = 0; i < 2; ++i) { st_tile(XW1, XS, 16 * tm, 16 * (2 * tn + i), w1[i]); st_tile(XW2, XS, 16 * tm, 16 * (2 * tn + i), w2[i]); }
    }
    __syncthreads();
    f32x4 pa[4], qc[4], r2[2];
    {
#pragma unroll
      for (int n = 0; n < 4; ++n) {
        pa[n] = mm_tile<true, false>(XW1, XS, 16 * w, XBB, XS, 16 * n, 32, z4);
        f32x4 qa = mm_tile<true, false>(XV, XS, 16 * w, XKB, XS, 16 * n, 32, z4);
        f32x4 qb = mm_tile<true, false>(XW2, XS, 16 * w, XBB, XS, 16 * n, 32, z4);
        qc[n] = qa - qb;
      }
#pragma unroll
      for (int i = 0; i < 2; ++i) {
        r2[i] = mm_tile<false, false>(SnAbr, SS, 16 * tm, XW1, XS, 16 * (2 * tn + i), 32, rt[i]);
        y0[i] = mm_tile<false, false>(SnAbr, SS, 16 * tm, XW2, XS, 16 * (2 * tn + i), 32, y0[i]);
      }
    }
    __syncthreads();
    {
#pragma unroll
      for (int n = 0; n < 4; ++n) {
        const float gcol = gam[16 * n + fr];
        f32x4 pc;
#pragma unroll
        for (int reg = 0; reg < 4; ++reg) {
          const int row = 16 * w + 4 * fq + reg, col = 16 * n + fr;
          pc[reg] = ((row == col ? 1.f : 0.f) - pa[n][reg]) * gcol;
          qc[n][reg] *= gcol;
        }
        st_tile(GPc, GS, 16 * w, 16 * n, pc);
      }
#pragma unroll
      for (int i = 0; i < 2; ++i) st_tile(XR2, XS, 16 * tm, 16 * (2 * tn + i), r2[i]);
    }
    __syncthreads();
    {
      if (ci >= 8) {
#pragma unroll
        for (int i = 0; i < 2; ++i) {
          f32x4 o1 = mm_tile<false, true>(XR2, XS, 16 * tm, GP, GS, 16 * (2 * tn + i), 64, z4);
          f32x4 o2 = mm_tile<false, true>(XR2, XS, 16 * tm, GQ, GS, 16 * (2 * tn + i), 64, y0[i]);
#pragma unroll
          for (int reg = 0; reg < 4; ++reg) {
            const int row = row_of_step(dir, ci * 32 + 16 * tm + 4 * fq + reg);
            const size_t o = (size_t)row * 512 + hd * 64 + 16 * (2 * tn + i) + fr;
            R2P[o] = f2bf(o1[reg]); Y0P[o] = f2bf(o2[reg]);
          }
        }
      }
#pragma unroll
      for (int n = 0; n < 4; ++n) {
        pcum[n] = mm_tile<false, false>(GP, GS, 16 * w, GPc, GS, 16 * n, 64, z4);
        qcum[n] = mm_tile<false, false>(GQ, GS, 16 * w, GPc, GS, 16 * n, 64, qc[n]);
      }
    }
    __syncthreads();
#pragma unroll
    for (int n = 0; n < 4; ++n) { st_tile(GP, GS, 16 * w, 16 * n, pcum[n]); st_tile(GQ, GS, 16 * w, 16 * n, qcum[n]); }
  }
  {
    bfr* Pt = (bfr*)(P.ws + WS_PTOT) + (size_t)(chain * RW_NSC + sc) * 4096;
    float* Qt = (float*)(P.ws + WS_QTOT) + (size_t)(chain * RW_NSC + sc) * 4096;
#pragma unroll
    for (int n = 0; n < 4; ++n)
#pragma unroll
      for (int reg = 0; reg < 4; ++reg) {
        const int row = 16 * w + 4 * fq + reg, col = 16 * n + fr;
        Pt[row * 64 + col] = f2bf(pcum[n][reg]); Qt[row * 64 + col] = qcum[n][reg];
      }
  }
}

DI void rw_levelB_chain(const Params& P, int chain, char* smem) {
  short* SB = (short*)smem; short* PT = SB + 64 * GS;
  const bfr* Ptot = (const bfr*)(P.ws + WS_PTOT) + (size_t)chain * RW_NSC * 4096;
  const float* Qtot = (const float*)(P.ws + WS_QTOT) + (size_t)chain * RW_NSC * 4096;
  bfr* SIN = (bfr*)(P.ws + WS_SINRW) + (size_t)chain * (RW_NSC + 1) * 4096;
  const int tid = VT, lane = tid & 63, w = tid >> 6, fr = lane & 15, fq = lane >> 4;
  f32x4 S[4], qn[4];
  bf16x8 pn[2];
#pragma unroll
  for (int n = 0; n < 4; ++n) S[n] = f32x4{0.f, 0.f, 0.f, 0.f};
#pragma unroll
  for (int i = 0; i < 2; ++i) { const int e = tid + i * NTHR; pn[i] = *(const bf16x8*)(Ptot + (e >> 3) * 64 + (e & 7) * 8); }
#pragma unroll
  for (int n = 0; n < 4; ++n)
#pragma unroll
    for (int reg = 0; reg < 4; ++reg) qn[n][reg] = Qtot[(16 * w + 4 * fq + reg) * 64 + 16 * n + fr];
  for (int sc = 0; sc < RW_NSC; ++sc) {
    __syncthreads();
#pragma unroll
    for (int n = 0; n < 4; ++n) {
      st_tile(SB, GS, 16 * w, 16 * n, S[n]);
#pragma unroll
      for (int reg = 0; reg < 4; ++reg) SIN[(size_t)sc * 4096 + (16 * w + 4 * fq + reg) * 64 + 16 * n + fr] = f2bf(S[n][reg]);
    }
#pragma unroll
    for (int i = 0; i < 2; ++i) { const int e = tid + i * NTHR; *(bf16x8*)(PT + (e >> 3) * GS + (e & 7) * 8) = pn[i]; }
    f32x4 qc[4];
#pragma unroll
    for (int n = 0; n < 4; ++n) qc[n] = qn[n];
    __syncthreads();
    if (sc + 1 < RW_NSC) {
#pragma unroll
      for (int i = 0; i < 2; ++i) { const int e = tid + i * NTHR; pn[i] = *(const bf16x8*)(Ptot + (size_t)(sc + 1) * 4096 + (e >> 3) * 64 + (e & 7) * 8); }
#pragma unroll
      for (int n = 0; n < 4; ++n)
#pragma unroll
        for (int reg = 0; reg < 4; ++reg) qn[n][reg] = Qtot[(size_t)(sc + 1) * 4096 + (16 * w + 4 * fq + reg) * 64 + 16 * n + fr];
    }
#pragma unroll
    for (int n = 0; n < 4; ++n) S[n] = mm_tile<false, false>(SB, GS, 16 * w, PT, GS, 16 * n, 64, qc[n]);
  }
}

DI void rw_finish(const Params& P, int bid, int nb) {
  float* YM = P.out;
  const int tid = VT, lane = tid & 63, w = tid >> 6, fr = lane & 15, fq = lane >> 4;
  for (int it = bid; it < 512 * 4; it += nb) {
    const int tile = it >> 2, hp = it & 3;
    const int hd = hp * 2 + (w >> 1), tm = w & 1;
    const int t0 = tile * 32;
    f32x4 acc[4];
#pragma unroll
    for (int n = 0; n < 4; ++n) acc[n] = f32x4{0.f, 0.f, 0.f, 0.f};
#pragma unroll
    for (int dir = 0; dir < 2; ++dir) {
      const int ci = dir ? (519 - tile) : (8 + tile);
      const int sc = rw_sc_of_chunk(ci);
      const bfr* A = (const bfr*)(P.ws + WS_R2P) + (size_t)dir * T_LAT * 512 + (size_t)t0 * 512 + hd * 64;
      const bfr* Y0 = (const bfr*)(P.ws + WS_Y0P) + (size_t)dir * T_LAT * 512 + (size_t)t0 * 512 + hd * 64;
      const bfr* Sin = (const bfr*)(P.ws + WS_SINRW) + ((size_t)(dir * 8 + hd) * (RW_NSC + 1) + sc) * 4096;
#pragma unroll
      for (int n = 0; n < 4; ++n) {
#pragma unroll
        for (int k0 = 0; k0 < 64; k0 += 32) {
          bf16x8 a = *(const bf16x8*)(A + (size_t)(16 * tm + fr) * 512 + k0 + fq * 8);
          bf16x8 b = *(const bf16x8*)(Sin + (16 * n + fr) * 64 + k0 + fq * 8);
          acc[n] = __builtin_amdgcn_mfma_f32_16x16x32_bf16(a, b, acc[n], 0, 0, 0);
        }
#pragma unroll
        for (int reg = 0; reg < 4; ++reg) acc[n][reg] += bf2f(Y0[(size_t)(16 * tm + 4 * fq + reg) * 512 + 16 * n + fr]);
      }
    }
#pragma unroll
    for (int n = 0; n < 4; ++n)
#pragma unroll
      for (int reg = 0; reg < 4; ++reg) YM[(size_t)(t0 + 16 * tm + 4 * fq + reg) * 512 + hd * 64 + 16 * n + fr] = acc[n][reg];
  }
}

constexpr int HG_NSC = 64;
DI int hg_sc_begin(int sc) { return sc * 8 + (sc < 8 ? sc : 8); }
DI int hg_sc_of_chunk(int ci) { return ci < 72 ? ci / 9 : 8 + (ci - 72) / 8; }
constexpr int QS = 136;
constexpr int HGL_Q0 = 0, HGL_Q1 = 8704, HGL_KP = 13056, HGL_KH = 21760, HGL_VV = 30464, HGL_PM = 39168, HGL_STT = 41728;
constexpr int HGL_BL = 76544, HGL_TOT = 77056, HGL_END = 78080;
constexpr size_t WS_SINHG = 23 * MB;
constexpr size_t WS_QH = 414 * MB;
constexpr size_t WS_O0 = 446 * MB;
constexpr size_t WS_SLOC = 478 * MB;
constexpr size_t WS_DTOT = 510 * MB;

DI void hg_levelA_item(const Params& P, int chain, int sc, char* smem) {
  const int dir = chain >> 2, hd = chain & 3;
  const bfr* p = (const bfr*)(P.ws + WS_P);
  const float* lbp = (const float*)(P.ws + WS_LB) + dir * 512 + hd * 128;
  bfr* QH = (bfr*)(P.ws + WS_QH) + (size_t)dir * T_LAT * 512;
  bfr* O0 = (bfr*)(P.ws + WS_O0) + (size_t)dir * T_LAT * 512;
  short* Q0 = (short*)(smem + HGL_Q0); short* Q1 = (short*)(smem + HGL_Q1); short* KP = (short*)(smem + HGL_KP);
  short* KH = (short*)(smem + HGL_KH); short* VV = (short*)(smem + HGL_VV); short* PM = (short*)(smem + HGL_PM);
  short* STT = (short*)(smem + HGL_STT);
  float* BL = (float*)(smem + HGL_BL); float* tot = (float*)(smem + HGL_TOT);
  const int tid = VT, lane = tid & 63, w = tid >> 6, fr = lane & 15, fq = lane >> 4;
  const f32x4 z4 = {0.f, 0.f, 0.f, 0.f};
  f32x4 S[8][2];
#pragma unroll
  for (int m = 0; m < 8; ++m) { S[m][0] = z4; S[m][1] = z4; }
  const int d = tid & 127, hf = tid >> 7;
  const float lb = lbp[d];
  float dcum = 0.f;
  const int c_begin = hg_sc_begin(sc), c_end = hg_sc_begin(sc + 1);
  unsigned qv[16]; bfr zr[16];
#define HG_PREFETCH(cc) do { _Pragma("unroll") for (int e_ = 0; e_ < 16; ++e_) { \
      const int row_ = row_of_step(dir, (cc) * 32 + hf * 16 + e_); const bfr* pr_ = p + (size_t)row_ * DIN + hd * 128 + d; \
      qv[e_] = (unsigned)pr_[0] | ((unsigned)pr_[512] << 16); zr[e_] = pr_[1024 + dir * 512]; } } while (0)
  HG_PREFETCH(c_begin);
  for (int ci = c_begin; ci < c_end; ++ci) {
    __syncthreads();
    {
      float lc[16], kv[16]; float run = 0.f;
#pragma unroll
      for (int e = 0; e < 16; ++e) {
        const float sg = sigmoidf_(bf2f(zr[e]));
        const float f = lb + (1.f - lb) * sg;
        kv[e] = (1.f - lb) * (1.f - sg);
        run += __logf(f); lc[e] = run;
      }
      tot[hf * 128 + d] = run;
      __syncthreads();
      const float tot0 = tot[d], tot1 = tot[128 + d];
      const float blast = tot0 + tot1;
#pragma unroll
      for (int e = 0; e < 16; ++e) {
        const int t = hf * 16 + e;
        const float bc = lc[e] + (hf ? tot0 : 0.f);
        const float qs = siluf_(__uint_as_float(qv[e] << 16));
        Q0[t * QS + d] = (short)f2bf(qs * __expf(bc));
        if (hf) Q1[e * QS + d] = (short)f2bf(qs * __expf(lc[e]));
        KP[t * QS + d] = (short)f2bf(kv[e] * __expf(-lc[e]));
        KH[t * QS + d] = (short)f2bf(kv[e] * __expf(blast - bc));
        VV[t * QS + d] = (short)(qv[e] >> 16);
        if (ci >= 8) {
          const int row = row_of_step(dir, ci * 32 + t);
          QH[(size_t)row * 512 + hd * 128 + d] = f2bf(qs * __expf(bc + dcum));
        }
      }
      if (hf == 0) BL[d] = blast;
      dcum += blast;
      if (ci + 1 < c_end) HG_PREFETCH(ci + 1);
    }
#pragma unroll
    for (int m = 0; m < 8; ++m)
#pragma unroll
      for (int n = 0; n < 2; ++n) {
        uint2 wv = {pack2(S[m][n][0], S[m][n][1]), pack2(S[m][n][2], S[m][n][3])};
        *(uint2*)(STT + (32 * w + 16 * n + fr) * QS + 16 * m + 4 * fq) = wv;
      }
    __syncthreads();
    {
      f32x4 pt = z4;
      if (w == 0) pt = mm_tile<false, true>(Q0, QS, 0, KP, QS, 0, 128, z4);
      else if (w == 1) pt = mm_tile<false, true>(Q0, QS, 16, KP, QS, 0, 128, z4);
      else if (w == 2) pt = mm_tile<false, true>(Q1, QS, 0, KP, QS, 16, 128, z4);
      if (w == 0 || w == 2) {
#pragma unroll
        for (int reg = 0; reg < 4; ++reg) pt[reg] = (fr <= 4 * fq + reg) ? pt[reg] : 0.f;
      }
      const int ptm = (w == 0 || w == 3) ? 0 : 1, ptn = (w >= 2) ? 1 : 0;
      st_tile(PM, 40, 16 * ptm, 16 * ptn, pt);
    }
    __syncthreads();
    {
#pragma unroll
      for (int m = 0; m < 2; ++m)
#pragma unroll
        for (int n = 0; n < 2; ++n) {
          f32x4 o = mm_tile<false, true>(Q0, QS, 16 * m, STT, QS, 32 * w + 16 * n, 128, z4);
          o = mm_tile<false, false>(PM, 40, 16 * m, VV, QS, 32 * w + 16 * n, 32, o);
          if (ci >= 8) {
#pragma unroll
            for (int reg = 0; reg < 4; ++reg) {
              const int row = row_of_step(dir, ci * 32 + 16 * m + 4 * fq + reg);
              O0[(size_t)row * 512 + hd * 128 + 32 * w + 16 * n + fr] = f2bf(o[reg]);
            }
          }
        }
#pragma unroll
      for (int m = 0; m < 8; ++m) {
        const f32x4 bl = *(const f32x4*)(BL + 16 * m + 4 * fq);
        f32x4 sc4 = {__expf(bl[0]), __expf(bl[1]), __expf(bl[2]), __expf(bl[3])};
#pragma unroll
        for (int n = 0; n < 2; ++n) S[m][n] = mm_tile<true, false>(KH, QS, 16 * m, VV, QS, 32 * w + 16 * n, 32, S[m][n] * sc4);
      }
    }
  }
  {
    float* SL_ = (float*)(P.ws + WS_SLOC) + (size_t)(chain * HG_NSC + sc) * 16384;
    float* DT = (float*)(P.ws + WS_DTOT) + (size_t)(chain * HG_NSC + sc) * 128;
#pragma unroll
    for (int m = 0; m < 8; ++m)
#pragma unroll
      for (int n = 0; n < 2; ++n) *(f32x4*)(SL_ + (32 * w + 16 * n + fr) * 128 + 16 * m + 4 * fq) = S[m][n];
    if (hf == 0) DT[d] = dcum;
  }
}

DI void hg_levelB(const Params& P, int bid, int nb) {
  const float* SLOC = (const float*)(P.ws + WS_SLOC); const float* DT = (const float*)(P.ws + WS_DTOT);
  bfr* SIN = (bfr*)(P.ws + WS_SINHG);
  for (int idx = bid * NTHR + VT; idx < 8 * 16384; idx += nb * NTHR) {
    const int chain = idx >> 14, ed = idx & 16383, dd = ed & 127;
    float s = 0.f;
    for (int sc = 0; sc < HG_NSC; ++sc) {
      const size_t item = (size_t)chain * HG_NSC + sc;
      SIN[item * 16384 + ed] = f2bf(s);
      s = __expf(DT[item * 128 + dd]) * s + SLOC[item * 16384 + ed];
    }
  }
}

DI void hg_finish(const Params& P, int bid, int nb, float* OM) {
  const int tid = VT, lane = tid & 63, w = tid >> 6, fr = lane & 15, fq = lane >> 4;
  for (int it = bid; it < 512 * 4; it += nb) {
    const int tile = it >> 2, hd = it & 3;
    const int t0 = tile * 32;
    f32x4 acc[2][2];
#pragma unroll
    for (int m = 0; m < 2; ++m) { acc[m][0] = f32x4{0.f, 0.f, 0.f, 0.f}; acc[m][1] = f32x4{0.f, 0.f, 0.f, 0.f}; }
#pragma unroll
    for (int dir = 0; dir < 2; ++dir) {
      const int ci = dir ? (519 - tile) : (8 + tile);
      const int sc = hg_sc_of_chunk(ci);
      const bfr* A = (const bfr*)(P.ws + WS_QH) + (size_t)dir * T_LAT * 512 + (size_t)t0 * 512 + hd * 128;
      const bfr* O0 = (const bfr*)(P.ws + WS_O0) + (size_t)dir * T_LAT * 512 + (size_t)t0 * 512 + hd * 128;
      const bfr* Sin = (const bfr*)(P.ws + WS_SINHG) + ((size_t)(dir * 4 + hd) * HG_NSC + sc) * 16384;
#pragma unroll
      for (int m = 0; m < 2; ++m)
#pragma unroll
        for (int n = 0; n < 2; ++n) {
#pragma unroll
          for (int k0 = 0; k0 < 128; k0 += 32) {
            bf16x8 a = *(const bf16x8*)(A + (size_t)(16 * m + fr) * 512 + k0 + fq * 8);
            bf16x8 b = *(const bf16x8*)(Sin + (32 * w + 16 * n + fr) * 128 + k0 + fq * 8);
            acc[m][n] = __builtin_amdgcn_mfma_f32_16x16x32_bf16(a, b, acc[m][n], 0, 0, 0);
          }
#pragma unroll
          for (int reg = 0; reg < 4; ++reg) acc[m][n][reg] += bf2f(O0[(size_t)(16 * m + 4 * fq + reg) * 512 + 32 * w + 16 * n + fr]);
        }
    }
#pragma unroll
    for (int m = 0; m < 2; ++m)
#pragma unroll
      for (int n = 0; n < 2; ++n)
#pragma unroll
        for (int reg = 0; reg < 4; ++reg) OM[(size_t)(t0 + 16 * m + 4 * fq + reg) * 512 + hd * 128 + 32 * w + 16 * n + fr] = acc[m][n][reg];
  }
}

constexpr size_t WS_LORA = 256 * 1024;
constexpr int LORA_WD2T = 0, LORA_WA2T = 2 * 512 * 32, LORA_WG2T = LORA_WA2T + 512 * 32;
DI void phase_lora_convert(const Params& P, int part, int nparts) {
  const float* wd2 = P.in[12]; const float* wa2 = P.in[14]; const float* wg2 = P.in[15];
  bfr* L = (bfr*)(P.ws + WS_LORA);
  for (int i = part * NTHR + VT; i < 2 * 512 * 32; i += nparts * NTHR) { const int d = i >> 14, c = (i >> 5) & 511, j = i & 31; L[LORA_WD2T + i] = f2bf(wd2[(d * 32 + j) * 512 + c]); }
  for (int i = part * NTHR + VT; i < 512 * 32; i += nparts * NTHR) { const int c = i >> 5, j = i & 31; L[LORA_WA2T + i] = f2bf(wa2[j * 512 + c]); }
  for (int i = part * NTHR + VT; i < 512 * 96; i += nparts * NTHR) { const int c = i / 96, j = i % 96; L[LORA_WG2T + i] = f2bf(wg2[j * 512 + c]); }
}
#define NB_DECL(row) \
  int nb_o0, nb_o1, nb_o2, nb_o3; float nb_f0, nb_f1, nb_f2, nb_f3, nb_scale; \
  { const int r_ = (row); const bool lat_ = r_ < T_LAT; const int gr_ = r_ >> 6, gc_ = r_ & 63, s_ = r_ - T_LAT; \
    const bool v0_ = lat_ && gr_ > 0, v1_ = lat_ && gr_ < 255, v2_ = lat_ ? gc_ > 0 : s_ > 0, v3_ = lat_ ? gc_ < 63 : s_ < T_CTX - 1; \
    nb_o0 = v0_ ? -64 * DIN : 0; nb_o1 = v1_ ? 64 * DIN : 0; nb_o2 = v2_ ? -DIN : 0; nb_o3 = v3_ ? DIN : 0; \
    nb_f0 = v0_ ? 1.f : 0.f; nb_f1 = v1_ ? 1.f : 0.f; nb_f2 = v2_ ? 1.f : 0.f; nb_f3 = v3_ ? 1.f : 0.f; nb_scale = lat_ ? 0.25f : 0.5f; }
#define MIX4(pc, mup) mix4_((pc), (mup), nb_o0, nb_o1, nb_o2, nb_o3, nb_f0, nb_f1, nb_f2, nb_f3, nb_scale)
DI f32x4 ld4bf(const bfr* p) {
  const uint2 u = *(const uint2*)p;
  return f32x4{__uint_as_float(u.x << 16), __uint_as_float(u.x & 0xffff0000u), __uint_as_float(u.y << 16), __uint_as_float(u.y & 0xffff0000u)};
}
DI f32x4 mix4_(const bfr* pc, const float* mu, int o0, int o1, int o2, int o3, float f0, float f1, float f2, float f3, float scale) {
  const f32x4 c = ld4bf(pc);
  f32x4 s = ld4bf(pc + o0) * f0 + ld4bf(pc + o1) * f1 + ld4bf(pc + o2) * f2 + ld4bf(pc + o3) * f3;
  const f32x4 m = *(const f32x4*)mu;
  return c + (s * scale - c) * m;
}
DI uint2 pk4(f32x4 v) { return uint2{pack2(v[0], v[1]), pack2(v[2], v[3])}; }
constexpr int LIS = 200;
DI void rwprep_tile(const Params& P, int tile, int unit0, int nunits, char* smem) {
  const bfr* p = (const bfr*)(P.ws + WS_P);
  const float* mu = P.in[10]; const float* w0 = P.in[11]; const float* a0 = P.in[13];
  const float* k_k = P.in[16]; const float* k_a = P.in[17];
  const bfr* LW_ = (const bfr*)(P.ws + WS_LORA);
  bfr* R = (bfr*)(P.ws + WS_RW); bfr* K = (bfr*)(P.ws + WS_RW + RW_ARR); bfr* V = (bfr*)(P.ws + WS_RW + 2 * RW_ARR);
  bfr* KK = (bfr*)(P.ws + WS_RW + 3 * RW_ARR); bfr* A = (bfr*)(P.ws + WS_RW + 4 * RW_ARR); bfr* G = (bfr*)(P.ws + WS_RW + 5 * RW_ARR);
  float* LWF = (float*)(P.ws + WS_LW); float* LWB = (float*)(P.ws + WS_LW + LW_ARR);
  short* LI = (short*)smem;
  const int tid = VT, lane = tid & 63, fr = lane & 15, fq = lane >> 4;
  const f32x4 z4 = {0.f, 0.f, 0.f, 0.f};
  const int row0 = tile * 32;
  __syncthreads();
  for (int v = tid; v < 32 * 24; v += NTHR) {
    const int t = v / 24, cg = v % 24;
    const int row = row0 + t;
    NB_DECL(row);
    const bfr* pc = p + (size_t)row * DIN + HGC + 1536 + cg * 8;
    f32x4 lo = MIX4(pc, mu + 1536 + cg * 8), hi = MIX4(pc + 4, mu + 1536 + cg * 8 + 4);
#pragma unroll
    for (int e = 0; e < 4; ++e) {
      if (cg < 8) { lo[e] = tanhf(lo[e]); hi[e] = tanhf(hi[e]); }
      else if (cg >= 12) { lo[e] = sigmoidf_(lo[e]); hi[e] = sigmoidf_(hi[e]); }
    }
    const uint2 a = pk4(lo), b = pk4(hi);
    *(uint4*)(LI + t * LIS + cg * 8) = uint4{a.x, a.y, b.x, b.y};
  }
  __syncthreads();
#pragma unroll 1
  for (int u = unit0; u < unit0 + nunits; ++u) {
    const int h = u >> 1, th = u & 1;
    const int row = row0 + 16 * th + fr;
    NB_DECL(row);
    f32x4 kkr[4], kraw[4], av[4];
    float ss = 0.f;
#pragma unroll
    for (int m = 0; m < 4; ++m) {
      const int c0 = 64 * h + 16 * m;
      const int ch = c0 + 4 * fq;
      const bfr* pc = p + (size_t)row * DIN + HGC + ch;
      const f32x4 r = MIX4(pc, mu + ch);
      kraw[m] = MIX4(pc + 512, mu + 512 + ch);
      const f32x4 v = MIX4(pc + 1024, mu + 1024 + ch);
      f32x4 aF = mm_tile<false, true>((const short*)(LW_ + LORA_WD2T), 32, c0, LI, LIS, 16 * th, 32, z4);
      f32x4 aB = mm_tile<false, true>((const short*)(LW_ + LORA_WD2T + 512 * 32), 32, c0, LI + 32, LIS, 16 * th, 32, z4);
      f32x4 aA = mm_tile<false, true>((const short*)(LW_ + LORA_WA2T), 32, c0, LI + 64, LIS, 16 * th, 32, z4);
      f32x4 aG = mm_tile<false, true>((const short*)(LW_ + LORA_WG2T), 96, c0, LI + 96, LIS, 16 * th, 96, z4);
      const size_t o = (size_t)row * 512 + ch;
      const f32x4 w0f = *(const f32x4*)(w0 + ch), w0b = *(const f32x4*)(w0 + 512 + ch), a0v = *(const f32x4*)(a0 + ch);
      f32x4 lwf, lwb;
#pragma unroll
      for (int e = 0; e < 4; ++e) {
        lwf[e] = -RW_DECAY_SCALE * sigmoidf_(w0f[e] + aF[e]);
        lwb[e] = -RW_DECAY_SCALE * sigmoidf_(w0b[e] + aB[e]);
        av[m][e] = sigmoidf_(a0v[e] + aA[e]);
      }
      *(f32x4*)(LWF + o) = lwf; *(f32x4*)(LWB + o) = lwb;
      *(uint2*)(G + o) = pk4(aG);
      *(uint2*)(A + o) = pk4(av[m]);
      *(uint2*)(R + o) = pk4(r); *(uint2*)(V + o) = pk4(v);
      kkr[m] = kraw[m] * *(const f32x4*)(k_k + ch);
      ss += kkr[m][0] * kkr[m][0] + kkr[m][1] * kkr[m][1] + kkr[m][2] * kkr[m][2] + kkr[m][3] * kkr[m][3];
    }
    ss += __shfl_xor(ss, 16); ss += __shfl_xor(ss, 32);
    const float rn = rsqrtf(fmaxf(ss, 1e-12f));
#pragma unroll
    for (int m = 0; m < 4; ++m) {
      const int ch = 64 * h + 16 * m + 4 * fq;
      const size_t o = (size_t)row * 512 + ch;
      const f32x4 ka = *(const f32x4*)(k_a + ch);
      f32x4 kv;
#pragma unroll
      for (int e = 0; e < 4; ++e) kv[e] = kraw[m][e] * (1.f + (av[m][e] - 1.f) * ka[e]);
      *(uint2*)(K + o) = pk4(kv);
      *(uint2*)(KK + o) = pk4(kkr[m] * rn);
    }
  }
}
DI void phase_rwprep(const Params& P, int bid, int nb, char* smem) {
  const int w = VT >> 6;
  for (int it = bid; it < (T_ALL / 32) * 4; it += nb) rwprep_tile(P, it >> 2, (it & 3) * 4 + w, 1, smem);
}

DI void phase_readout(const Params& P, int bid, int nb) {
  const bfr* p = (const bfr*)(P.ws + WS_P);
  const float* Of = P.out + (size_t)T_LAT * 512;
  const float* Yf = P.out;
  const bfr* R = (const bfr*)(P.ws + WS_RW); const bfr* K = (const bfr*)(P.ws + WS_RW + RW_ARR); const bfr* V = (const bfr*)(P.ws + WS_RW + 2 * RW_ARR);
  const bfr* G = (const bfr*)(P.ws + WS_RW + 5 * RW_ARR);
  const float* hg_norm_w = P.in[9]; const float* r_k = P.in[18]; const float* gn_w = P.in[19]; const float* gn_b = P.in[20];
  bfr* mix = (bfr*)(P.ws + WS_H);
  const int wid = VT >> 6, lane = VT & 63;
  for (int t = bid * 4 + wid; t < T_LAT; t += nb * 4) {
    {
      float o[8]; float ss = 0.f;
#pragma unroll
      for (int e = 0; e < 8; ++e) { const long idx = (long)t * 512 + lane * 8 + e; o[e] = Of[idx]; ss += o[e] * o[e]; }
      ss += __shfl_xor(ss, 1); ss += __shfl_xor(ss, 2); ss += __shfl_xor(ss, 4); ss += __shfl_xor(ss, 8);
      const float rs = rsqrtf(ss * (1.f / 128.f) + 1e-6f);
      unsigned w[4];
#pragma unroll
      for (int e = 0; e < 8; e += 2) {
        const int c0 = lane * 8 + e;
        const float g0 = bf2f(p[(long)t * DIN + 2048 + c0]), g1 = bf2f(p[(long)t * DIN + 2048 + c0 + 1]);
        const float v0 = o[e] * rs * hg_norm_w[c0] * siluf_(g0);
        const float v1 = o[e + 1] * rs * hg_norm_w[c0 + 1] * siluf_(g1);
        w[e >> 1] = pack2(v0, v1);
      }
      *(uint4*)(mix + (long)t * DM + lane * 8) = uint4{w[0], w[1], w[2], w[3]};
    }
    {
      float y[8]; float s = 0.f, bs = 0.f;
      float vv[8];
#pragma unroll
      for (int e = 0; e < 8; ++e) {
        const long idx = (long)t * 512 + lane * 8 + e;
        y[e] = Yf[idx]; s += y[e];
        bs += bf2f(R[idx]) * bf2f(K[idx]) * r_k[lane * 8 + e];
        vv[e] = bf2f(V[idx]);
      }
      s += __shfl_xor(s, 1); s += __shfl_xor(s, 2); s += __shfl_xor(s, 4);
      bs += __shfl_xor(bs, 1); bs += __shfl_xor(bs, 2); bs += __shfl_xor(bs, 4);
      const float mu = s * (1.f / 64.f);
      float q = 0.f;
#pragma unroll
      for (int e = 0; e < 8; ++e) { y[e] -= mu; q += y[e] * y[e]; }
      q += __shfl_xor(q, 1); q += __shfl_xor(q, 2); q += __shfl_xor(q, 4);
      const float rs = rsqrtf(q * (1.f / 64.f) + 64e-5f);
      unsigned w[4];
#pragma unroll
      for (int e = 0; e < 8; e += 2) {
        const int c0 = lane * 8 + e;
        const long idx = (long)t * 512 + c0;
        const float v0 = (y[e] * rs * gn_w[c0] + gn_b[c0] + bs * vv[e]) * bf2f(G[idx]);
        const float v1 = (y[e + 1] * rs * gn_w[c0 + 1] + gn_b[c0 + 1] + bs * vv[e + 1]) * bf2f(G[idx + 1]);
        w[e >> 1] = pack2(v0, v1);
      }
      *(uint4*)(mix + (long)t * DM + 512 + lane * 8) = uint4{w[0], w[1], w[2], w[3]};
    }
  }
}

DI void phase_outproj(const Params& P, int bid, int nb, char* smem) {
  const bfr* mix = (const bfr*)(P.ws + WS_H);
  const float* w_out = P.in[7];
  float* y = (float*)(P.ws + WS_Y);
  short* sA = (short*)smem; short* sB = sA + 128 * LSTR;
  const int tid = VT, wid = tid >> 6, lane = tid & 63;
  const int wr = wid >> 1, wc = wid & 1, fr = lane & 15, fq = lane >> 4;
  constexpr int NT = 8, MT = T_LAT / 128;
  for (int it = bid; it < NT * MT; it += nb) {
    const int mt = it / NT, nt = it % NT;
    ALoadBf16 al; BLoadF32 bl;
#pragma unroll
    for (int i = 0; i < 4; ++i) al.rp[i] = mix + (long)(mt * 128 + (tid >> 3) + 32 * i) * DM + (tid & 7) * 8;
    bl.valid = true; bl.ldb = DM;
    bl.p = w_out + (long)((tid & 7) * 8) * DM + nt * 128 + (tid >> 3) * 4;
    f32x4 acc[4][4];
    gemm_mainloop(sA, sB, DM / 64, al, bl, acc);
#pragma unroll
    for (int m = 0; m < 4; ++m)
#pragma unroll
      for (int n = 0; n < 4; ++n)
#pragma unroll
        for (int j = 0; j < 4; ++j) {
          const int rr = mt * 128 + wr * 64 + m * 16 + fq * 4 + j, cc = nt * 128 + wc * 64 + n * 16 + fr;
          y[(long)rr * DM + cc] = acc[m][n][j];
        }
  }
}

constexpr size_t WS_WRT = 512 * 1024;
DI void phase_wrt_convert(const Params& P, int part, int nparts) {
  const float* wgrp = P.in[25]; const float* wrt = P.in[27];
  bfr* Whi = (bfr*)(P.ws + WS_WRT); bfr* Wlo = Whi + 80 * 1024;
  for (int i = part * NTHR + VT; i < 80 * 1024; i += nparts * NTHR) {
    const int o = i >> 10, k = i & 1023;
    float wv = 0.f;
    if (o < 8) wv = wgrp[k * 8 + o]; else if (o < 72) wv = wrt[k * 64 + (o - 8)];
    const bfr hi = f2bf(wv);
    Whi[i] = hi; Wlo[i] = f2bf(wv - bf2f(hi));
  }
}
constexpr int HLS = 1032;
DI void phase_ln2route(const Params& P, int bid, int nb, char* smem) {
  const float* x = P.in[0];
  const bfr* y = (const bfr*)(P.ws + WS_Y);
  const float* mod = (const float*)(P.ws + WS_MOD);
  const float* ln1_g = P.in[21]; const float* ln1_b = P.in[22];
  const float* bgrp = P.in[26]; const float* brt = P.in[28];
  const bfr* Whi = (const bfr*)(P.ws + WS_WRT); const bfr* Wlo = Whi + 80 * 1024;
  bfr* x1 = (bfr*)(P.ws + WS_X1B);
  bfr* h2 = (bfr*)(P.ws + WS_H2);
  int* cnt = (int*)(P.ws + WS_CNT); int* list = (int*)(P.ws + WS_LIST); float* asgw = (float*)(P.ws + WS_ASGW);
  short* HI = (short*)smem; short* LO = HI + 16 * HLS; float* LG = (float*)(smem + 2 * 16 * HLS * 2);
  const int tid = VT, wid = tid >> 6, lane = tid & 63, fr = lane & 15, fq = lane >> 4;
  for (int grp = bid; grp < T_LAT / 16; grp += nb) {
    const int t0 = grp * 16;
    __syncthreads();
#pragma unroll 1
    for (int tt = 0; tt < 4; ++tt) {
      const int tl = wid * 4 + tt, t = t0 + tl;
      f32x4 v[4]; float s = 0.f;
#pragma unroll
      for (int i = 0; i < 4; ++i) {
        const int c = lane * 4 + 256 * i;
        f32x4 xv = *(const f32x4*)(x + (long)t * DM + c), yv = ld4bf(y + (long)t * DM + c), g1 = *(const f32x4*)(mod + 2048 + c);
        v[i] = xv * DN_ALPHA + g1 * yv;
        s += v[i][0] + v[i][1] + v[i][2] + v[i][3];
      }
      float mu = wave_sum(s) * (1.f / DM); float q = 0.f;
#pragma unroll
      for (int i = 0; i < 4; ++i) { v[i] -= mu; q += v[i][0] * v[i][0] + v[i][1] * v[i][1] + v[i][2] * v[i][2] + v[i][3] * v[i][3]; }
      float rs = rsqrtf(wave_sum(q) * (1.f / DM) + 1e-5f);
      s = 0.f;
#pragma unroll
      for (int i = 0; i < 4; ++i) {
        const int c = lane * 4 + 256 * i;
        f32x4 g = *(const f32x4*)(ln1_g + c), b = *(const f32x4*)(ln1_b + c);
        v[i] = v[i] * rs * g + b;
        *(uint2*)(x1 + (long)t * DM + c) = pk4(v[i]);
        s += v[i][0] + v[i][1] + v[i][2] + v[i][3];
      }
      mu = wave_sum(s) * (1.f / DM); q = 0.f;
#pragma unroll
      for (int i = 0; i < 4; ++i) { v[i] -= mu; q += v[i][0] * v[i][0] + v[i][1] * v[i][1] + v[i][2] * v[i][2] + v[i][3] * v[i][3]; }
      rs = rsqrtf(wave_sum(q) * (1.f / DM) + 1e-5f);
#pragma unroll
      for (int i = 0; i < 4; ++i) {
        const int c = lane * 4 + 256 * i;
        f32x4 sh = *(const f32x4*)(mod + 3072 + c), sc = *(const f32x4*)(mod + 4096 + c);
        v[i] = v[i] * rs * (sc + 1.f) + sh;
        const uint2 whi = {pack2(v[i][0], v[i][1]), pack2(v[i][2], v[i][3])};
        f32x4 r;
        r[0] = v[i][0] - __uint_as_float(whi.x << 16); r[1] = v[i][1] - __uint_as_float(whi.x & 0xffff0000u);
        r[2] = v[i][2] - __uint_as_float(whi.y << 16); r[3] = v[i][3] - __uint_as_float(whi.y & 0xffff0000u);
        const uint2 wlo = {pack2(r[0], r[1]), pack2(r[2], r[3])};
        *(uint2*)(h2 + (long)t * DM + c) = whi;
        *(uint2*)(HI + tl * HLS + c) = whi;
        *(uint2*)(LO + tl * HLS + c) = wlo;
      }
    }
    __syncthreads();
    if (wid < 3) {
      const int nm = wid < 2 ? 2 : 1;
      f32x4 acc[2] = {f32x4{0.f, 0.f, 0.f, 0.f}, f32x4{0.f, 0.f, 0.f, 0.f}};
#pragma unroll 1
      for (int pass = 0; pass < 3; ++pass) {
        const bfr* Wp = pass == 1 ? Wlo : Whi;
        const short* Hp = pass == 2 ? LO : HI;
#pragma unroll 4
        for (int k0 = 0; k0 < 1024; k0 += 32) {
          const bf16x8 b = *(const bf16x8*)(Hp + fr * HLS + k0 + fq * 8);
          const bf16x8 a0 = *(const bf16x8*)(Wp + (size_t)(32 * wid + fr) * 1024 + k0 + fq * 8);
          acc[0] = __builtin_amdgcn_mfma_f32_16x16x32_bf16(a0, b, acc[0], 0, 0, 0);
          if (nm == 2) {
            const bf16x8 a1 = *(const bf16x8*)(Wp + (size_t)(32 * wid + 16 + fr) * 1024 + k0 + fq * 8);
            acc[1] = __builtin_amdgcn_mfma_f32_16x16x32_bf16(a1, b, acc[1], 0, 0, 0);
          }
        }
      }
#pragma unroll
      for (int mi = 0; mi < 2; ++mi)
        if (mi < nm) {
#pragma unroll
          for (int reg = 0; reg < 4; ++reg) LG[fr * 80 + 32 * wid + 16 * mi + 4 * fq + reg] = acc[mi][reg];
        }
    }
    __syncthreads();
    if (tid < 16) {
      const int t = t0 + tid;
      const float* lg = LG + tid * 80;
      int gi = 0; float gmax = -3.4e38f; float gl[8];
#pragma unroll
      for (int g = 0; g < 8; ++g) { gl[g] = lg[g] + bgrp[g]; if (gl[g] > gmax) { gmax = gl[g]; gi = g; } }
      float den = 0.f;
#pragma unroll
      for (int g = 0; g < 8; ++g) den += __expf(gl[g] - gmax);
      const float gprob = 1.f / den;
      int i1 = 0; float v1 = -3.4e38f; float el[8];
#pragma unroll
      for (int g = 0; g < 8; ++g) { el[g] = lg[8 + gi * 8 + g] + brt[gi * 8 + g]; if (el[g] > v1) { v1 = el[g]; i1 = g; } }
      int i2 = 0; float v2 = -3.4e38f;
#pragma unroll
      for (int g = 0; g < 8; ++g) { if (g != i1 && el[g] > v2) { v2 = el[g]; i2 = g; } }
      const float e2 = __expf(v2 - v1);
      const float wt1 = gprob / (1.f + e2), wt2 = gprob * e2 / (1.f + e2);
      const int ex1 = gi * 8 + i1, ex2 = gi * 8 + i2;
      int s1 = atomicAdd(&cnt[ex1], 1); list[ex1 * T_LAT + s1] = t * 2;
      int s2 = atomicAdd(&cnt[ex2], 1); list[ex2 * T_LAT + s2] = t * 2 + 1;
      asgw[t * 2] = wt1; asgw[t * 2 + 1] = wt2;
    }
  }
}

DI void moe_block_table(const Params& P, int* tab  ) {
  const int* cnt = (const int*)(P.ws + WS_CNT);
  const int tid = VT;
  __syncthreads();
  if (tid < 64) {
    int nbk = (cnt[tid] + 127) >> 7;
    int incl = nbk;
#pragma unroll
    for (int o = 1; o < 64; o <<= 1) { int u = __shfl_up(incl, o); if (tid >= o) incl += u; }
    tab[tid + 1] = incl;
    if (tid == 0) tab[0] = 0;
  }
  __syncthreads();
}
DI int moe_find_expert(const int* tab, int rb) {
  int e = 0;
  while (tab[e + 1] <= rb) ++e;
  return e;
}

DI void phase_moe1(const Params& P, int bid, int nb, char* smem) {
  const bfr* h2 = (const bfr*)(P.ws + WS_H2);
  const int* cnt = (const int*)(P.ws + WS_CNT); const int* list = (const int*)(P.ws + WS_LIST);
  const float* wg = P.in[29]; const float* wu = P.in[30];
  bfr* hid = (bfr*)(P.ws + WS_HID);
  short* sA = (short*)smem; short* sB = sA + 128 * LSTR;
  int* tab = (int*)(smem + GEMM_LDS_BYTES);
  const int tid = VT, wid = tid >> 6, lane = tid & 63;
  const int wr = wid >> 1, wc = wid & 1, fr = lane & 15, fq = lane >> 4;
  moe_block_table(P, tab);
  const int nrb = tab[64];
  for (int it = bid; it < nrb * 8; it += nb) {
    const int rb = it >> 3, nt = it & 7;
    const int e = moe_find_expert(tab, rb);
    const int lrb = rb - tab[e];
    const int ce = cnt[e];
    ALoadBf16 al; BLoadF32 bl;
#pragma unroll
    for (int i = 0; i < 4; ++i) {
      int r = lrb * 128 + (tid >> 3) + 32 * i;
      if (r >= ce) r = ce - 1;
      const int tok = list[e * T_LAT + r] >> 1;
      al.rp[i] = h2 + (long)tok * DM + (tid & 7) * 8;
    }
    const int n4 = tid >> 3;
    const int isup = (n4 >> 3) & 1;
    const int col = nt * 64 + (n4 >> 4) * 32 + ((4 * n4) & 31);
    bl.valid = true; bl.ldb = DEXP;
    bl.p = (isup ? wu : wg) + (long)e * DM * DEXP + (long)((tid & 7) * 8) * DEXP + col;
    f32x4 acc[4][4];
    gemm_mainloop(sA, sB, DM / 64, al, bl, acc);
#pragma unroll
    for (int m = 0; m < 4; ++m)
#pragma unroll
      for (int n = 0; n < 2; ++n)
#pragma unroll
        for (int j = 0; j < 4; ++j) {
          const int rl = wr * 64 + m * 16 + fq * 4 + j;
          const int cc = nt * 64 + wc * 32 + n * 16 + fr;
          const float gv = acc[m][n][j], uv = acc[m][n + 2][j];
          hid[((long)rb * 128 + rl) * DEXP + cc] = f2bf(siluf_(gv) * uv);
        }
  }
}

DI void phase_moe2(const Params& P, int bid, int nb, char* smem) {
  const int* cnt = (const int*)(P.ws + WS_CNT); const int* list = (const int*)(P.ws + WS_LIST);
  const float* wd = P.in[31];
  const bfr* hid = (const bfr*)(P.ws + WS_HID);
  bfr* mout = (bfr*)(P.ws + WS_MOUT);
  short* sA = (short*)smem; short* sB = sA + 128 * LSTR;
  int* tab = (int*)(smem + GEMM_LDS_BYTES);
  const int tid = VT, wid = tid >> 6, lane = tid & 63;
  const int wr = wid >> 1, wc = wid & 1, fr = lane & 15, fq = lane >> 4;
  moe_block_table(P, tab);
  const int nrb = tab[64];
  for (int it = bid; it < nrb * 8; it += nb) {
    const int rb = it >> 3, nt = it & 7;
    const int e = moe_find_expert(tab, rb);
    const int lrb = rb - tab[e];
    const int ce = cnt[e];
    ALoadBf16 al; BLoadF32 bl;
#pragma unroll
    for (int i = 0; i < 4; ++i) al.rp[i] = hid + ((long)rb * 128 + (tid >> 3) + 32 * i) * DEXP + (tid & 7) * 8;
    bl.valid = true; bl.ldb = DM;
    bl.p = wd + (long)e * DEXP * DM + (long)((tid & 7) * 8) * DM + nt * 128 + (tid >> 3) * 4;
    f32x4 acc[4][4];
    gemm_mainloop(sA, sB, DEXP / 64, al, bl, acc);
#pragma unroll
    for (int m = 0; m < 4; ++m)
#pragma unroll
      for (int j = 0; j < 4; ++j) {
        const int r = lrb * 128 + wr * 64 + m * 16 + fq * 4 + j;
        if (r < ce) {
          const int asg = list[e * T_LAT + r];
#pragma unroll
          for (int n = 0; n < 4; ++n) mout[(long)asg * DM + nt * 128 + wc * 64 + n * 16 + fr] = f2bf(acc[m][n][j]);
        }
      }
  }
}

DI void phase_final(const Params& P, int bid, int nb) {
  const float* mod = (const float*)(P.ws + WS_MOD);
  const float* ln2_g = P.in[23]; const float* ln2_b = P.in[24];
  const bfr* mout = (const bfr*)(P.ws + (42ull << 20));
  const bfr* x1b = (const bfr*)(P.ws + WS_X1B);
  const float* asgw = (const float*)(P.ws + WS_ASGW);
  float* out = P.out;
  const int wid = VT >> 6, lane = VT & 63;
  for (int t0 = (bid * 4 + wid) * 2; t0 < T_LAT; t0 += nb * 8) {
    f32x4 v[2][4]; float s[2] = {0.f, 0.f};
#pragma unroll
    for (int r = 0; r < 2; ++r) {
      const int t = t0 + r;
      const float w1 = asgw[t * 2], w2 = asgw[t * 2 + 1];
#pragma unroll
      for (int i = 0; i < 4; ++i) {
        const int c = lane * 4 + 256 * i;
        const f32x4 xv = ld4bf(x1b + (long)t * DM + c), g2 = *(const f32x4*)(mod + 5120 + c);
        const f32x4 a = ld4bf(mout + (long)(2 * t) * DM + c), b = ld4bf(mout + (long)(2 * t + 1) * DM + c);
        v[r][i] = xv * DN_ALPHA + g2 * (a * w1 + b * w2);
        s[r] += v[r][i][0] + v[r][i][1] + v[r][i][2] + v[r][i][3];
      }
    }
#pragma unroll
    for (int r = 0; r < 2; ++r) {
      const float mu = wave_sum(s[r]) * (1.f / DM); float q = 0.f;
#pragma unroll
      for (int i = 0; i < 4; ++i) { v[r][i] -= mu; q += v[r][i][0] * v[r][i][0] + v[r][i][1] * v[r][i][1] + v[r][i][2] * v[r][i][2] + v[r][i][3] * v[r][i][3]; }
      const float rs = rsqrtf(wave_sum(q) * (1.f / DM) + 1e-5f);
#pragma unroll
      for (int i = 0; i < 4; ++i) {
        const int c = lane * 4 + 256 * i;
        f32x4 g = *(const f32x4*)(ln2_g + c), b = *(const f32x4*)(ln2_b + c);
        *(f32x4*)(out + (long)(t0 + r) * DM + c) = v[r][i] * rs * g + b;
      }
    }
  }
}

DI void phase_readout_fused(const Params& P, int bid, int nb) {
  const bfr* p = (const bfr*)(P.ws + WS_P);
  const bfr* R = (const bfr*)(P.ws + WS_RW); const bfr* K = (const bfr*)(P.ws + WS_RW + RW_ARR); const bfr* V = (const bfr*)(P.ws + WS_RW + 2 * RW_ARR);
  const bfr* G = (const bfr*)(P.ws + WS_RW + 5 * RW_ARR);
  const float* hg_norm_w = P.in[9]; const float* r_k = P.in[18]; const float* gn_w = P.in[19]; const float* gn_b = P.in[20];
  bfr* mix = (bfr*)(P.ws + WS_MIX);
  const int tid = VT, lane = tid & 63, w = tid >> 6, fr = lane & 15, fq = lane >> 4;
  const f32x4 z4 = {0.f, 0.f, 0.f, 0.f};
  for (int tile = bid; tile < T_LAT / 32; tile += nb) {
    const int t0 = tile * 32;
#pragma unroll 1
    for (int hh = 0; hh < 2; ++hh) {
      const int hd = 2 * w + hh;
      f32x4 acc[4][2];
#pragma unroll
      for (int m = 0; m < 4; ++m) { acc[m][0] = z4; acc[m][1] = z4; }
#pragma unroll
      for (int dir = 0; dir < 2; ++dir) {
        const int ci = dir ? (519 - tile) : (8 + tile);
        const int sc = rw_sc_of_chunk(ci);
        const bfr* Bq = (const bfr*)(P.ws + WS_R2P) + (size_t)dir * T_LAT * 512 + (size_t)t0 * 512 + hd * 64;
        const bfr* Y0 = (const bfr*)(P.ws + WS_Y0P) + (size_t)dir * T_LAT * 512 + (size_t)t0 * 512 + hd * 64;
        const bfr* Sin = (const bfr*)(P.ws + WS_SINRW) + ((size_t)(dir * 8 + hd) * (RW_NSC + 1) + sc) * 4096;
#pragma unroll
        for (int k0 = 0; k0 < 64; k0 += 32) {
          bf16x8 bq[2];
#pragma unroll
          for (int n = 0; n < 2; ++n) bq[n] = *(const bf16x8*)(Bq + (size_t)(16 * n + fr) * 512 + k0 + fq * 8);
#pragma unroll
          for (int m = 0; m < 4; ++m) {
            const bf16x8 a = *(const bf16x8*)(Sin + (16 * m + fr) * 64 + k0 + fq * 8);
#pragma unroll
            for (int n = 0; n < 2; ++n) acc[m][n] = __builtin_amdgcn_mfma_f32_16x16x32_bf16(a, bq[n], acc[m][n], 0, 0, 0);
          }
        }
#pragma unroll
        for (int m = 0; m < 4; ++m)
#pragma unroll
          for (int n = 0; n < 2; ++n) acc[m][n] += ld4bf(Y0 + (size_t)(16 * n + fr) * 512 + 16 * m + 4 * fq);
      }
#pragma unroll
      for (int n = 0; n < 2; ++n) {
        const size_t trow = (size_t)(t0 + 16 * n + fr) * 512 + hd * 64;
        float s = 0.f, bs = 0.f;
        f32x4 vv[4];
#pragma unroll
        for (int m = 0; m < 4; ++m) {
          const int c = 16 * m + 4 * fq;
          s += acc[m][n][0] + acc[m][n][1] + acc[m][n][2] + acc[m][n][3];
          const f32x4 rr = ld4bf(R + trow + c), kk2 = ld4bf(K + trow + c), rk = *(const f32x4*)(r_k + hd * 64 + c);
          vv[m] = ld4bf(V + trow + c);
          bs += rr[0] * kk2[0] * rk[0] + rr[1] * kk2[1] * rk[1] + rr[2] * kk2[2] * rk[2] + rr[3] * kk2[3] * rk[3];
        }
        s += __shfl_xor(s, 16); s += __shfl_xor(s, 32);
        bs += __shfl_xor(bs, 16); bs += __shfl_xor(bs, 32);
        const float mu = s * (1.f / 64.f);
        float q = 0.f;
#pragma unroll
        for (int m = 0; m < 4; ++m) { acc[m][n] -= mu; q += acc[m][n][0] * acc[m][n][0] + acc[m][n][1] * acc[m][n][1] + acc[m][n][2] * acc[m][n][2] + acc[m][n][3] * acc[m][n][3]; }
        q += __shfl_xor(q, 16); q += __shfl_xor(q, 32);
        const float rs = rsqrtf(q * (1.f / 64.f) + 64e-5f);
#pragma unroll
        for (int m = 0; m < 4; ++m) {
          const int c = hd * 64 + 16 * m + 4 * fq;
          const f32x4 gw = *(const f32x4*)(gn_w + c), gb = *(const f32x4*)(gn_b + c), gg = ld4bf(G + trow + 16 * m + 4 * fq);
          const f32x4 o = (acc[m][n] * rs * gw + gb + vv[m] * bs) * gg;
          *(uint2*)(mix + (size_t)(t0 + 16 * n + fr) * DM + 512 + c) = pk4(o);
        }
      }
    }
    {
      const int hd = w;
      f32x4 acc[8][2];
#pragma unroll
      for (int m = 0; m < 8; ++m) { acc[m][0] = z4; acc[m][1] = z4; }
#pragma unroll
      for (int dir = 0; dir < 2; ++dir) {
        const int ci = dir ? (519 - tile) : (8 + tile);
        const int sc = hg_sc_of_chunk(ci);
        const bfr* Bq = (const bfr*)(P.ws + WS_QH) + (size_t)dir * T_LAT * 512 + (size_t)t0 * 512 + hd * 128;
        const bfr* O0 = (const bfr*)(P.ws + WS_O0) + (size_t)dir * T_LAT * 512 + (size_t)t0 * 512 + hd * 128;
        const bfr* Sin = (const bfr*)(P.ws + WS_SINHG) + ((size_t)(dir * 4 + hd) * HG_NSC + sc) * 16384;
#pragma unroll
        for (int k0 = 0; k0 < 128; k0 += 32) {
          bf16x8 bq[2];
#pragma unroll
          for (int n = 0; n < 2; ++n) bq[n] = *(const bf16x8*)(Bq + (size_t)(16 * n + fr) * 512 + k0 + fq * 8);
#pragma unroll
          for (int m = 0; m < 8; ++m) {
            const bf16x8 a = *(const bf16x8*)(Sin + (16 * m + fr) * 128 + k0 + fq * 8);
#pragma unroll
            for (int n = 0; n < 2; ++n) acc[m][n] = __builtin_amdgcn_mfma_f32_16x16x32_bf16(a, bq[n], acc[m][n], 0, 0, 0);
          }
        }
#pragma unroll
        for (int m = 0; m < 8; ++m)
#pragma unroll
          for (int n = 0; n < 2; ++n) acc[m][n] += ld4bf(O0 + (size_t)(16 * n + fr) * 512 + 16 * m + 4 * fq);
      }
#pragma unroll
      for (int n = 0; n < 2; ++n) {
        const int t = t0 + 16 * n + fr;
        float ss = 0.f;
#pragma unroll
        for (int m = 0; m < 8; ++m) ss += acc[m][n][0] * acc[m][n][0] + acc[m][n][1] * acc[m][n][1] + acc[m][n][2] * acc[m][n][2] + acc[m][n][3] * acc[m][n][3];
        ss += __shfl_xor(ss, 16); ss += __shfl_xor(ss, 32);
        const float rs = rsqrtf(ss * (1.f / 128.f) + 1e-6f);
#pragma unroll
        for (int m = 0; m < 8; ++m) {
          const int c = hd * 128 + 16 * m + 4 * fq;
          const f32x4 nw = *(const f32x4*)(hg_norm_w + c), gg = ld4bf(p + (size_t)t * DIN + 2048 + c);
          f32x4 o;
#pragma unroll
          for (int e = 0; e < 4; ++e) o[e] = acc[m][n][e] * rs * nw[e] * siluf_(gg[e]);
          *(uint2*)(mix + (size_t)t * DM + c) = pk4(o);
        }
      }
    }
  }
}

namespace pg8 {
#define PG8_LAS __attribute__((address_space(3)))
typedef unsigned short bf16_t;
typedef short bf16x8 __attribute__((ext_vector_type(8)));
typedef float f32x4 __attribute__((ext_vector_type(4)));
typedef unsigned u32x4 __attribute__((ext_vector_type(4)));
constexpr int BM = 256, BK = 64, HALF = 128, HTB = HALF * BK * 2  , STAGE_BYTES = 8 * HTB, NXCD = 8, WGM = 8;

__host__ __device__ __forceinline__ int lds_byte(int r, int c) { const int st = (r >> 4) * 2 + (c >> 5), rr = r & 15, cc = c & 31, ob = rr * 64 + cc * 2; return st * 1024 + (ob ^ (((ob >> 9) & 1) << 5)); }
__host__ __device__ __forceinline__ void stage_rc(int b, int& R, int& C) { const int st = b / 1024, sb = b % 1024, swz = sb ^ (((sb >> 9) & 1) << 5); R = (st >> 1) * 16 + swz / 64; C = (st & 1) * 32 + (swz % 64) / 2; }
__host__ __device__ __forceinline__ int perm32(int rho) { const int n = rho >> 4, i = rho & 15; return 8 * (i >> 2) + 4 * n + (i & 3); }

struct Unit { int pm, pn; };
struct Gemm { const bf16_t* A; const bf16_t* Bt; int M, N, K; };

struct StaticOrder {
    int nM, nN, nwg, G, c;
    __host__ __device__ void init(int M, int N, int G_, int c_) { nM = M / BM; nN = N / BM; nwg = nM * nN; G = G_; c = c_; }
    __host__ __device__ bool next(int i, Unit& u) const {
        const long L = (long)i * G + c; if (L >= nwg) return false;
        int wgid = (int)L; { const int q = nwg / NXCD, r = nwg % NXCD, xcd = wgid % NXCD, off = wgid / NXCD; wgid = (xcd < r ? xcd * (q + 1) : r * (q + 1) + (xcd - r) * q) + off; }
        const int nig = WGM * nN, gid = wgid / nig, fm = gid * WGM, gsz = (nM - fm) < WGM ? (nM - fm) : WGM;
        u.pm = fm + ((wgid % nig) % gsz); u.pn = (wgid % nig) / gsz; return true;
    }
    __device__ __forceinline__ void a_ready(const Unit&) const {}
    __device__ __forceinline__ void done(const Unit&) const {}
};
struct CountedOrder : StaticOrder {
    const unsigned* ready; unsigned need; unsigned* tmo;
    __device__ __forceinline__ void a_ready(const Unit& u) const {
        if (threadIdx.x < 64) {
            const unsigned long long t0 = __builtin_amdgcn_s_memrealtime(); unsigned polls = 0;
            while ((unsigned)__builtin_amdgcn_readfirstlane(__hip_atomic_load(ready + 64 * u.pm, __ATOMIC_RELAXED, __HIP_MEMORY_SCOPE_AGENT)) < need) {
                if ((++polls & 255u) == 0u && __builtin_amdgcn_readfirstlane(__hip_atomic_load(tmo, __ATOMIC_RELAXED, __HIP_MEMORY_SCOPE_AGENT)) != 0u) break;
                if (__builtin_amdgcn_s_memrealtime() - t0 > 2000000ull) {
                    if (threadIdx.x == 0) { unsigned expect = 0u; __hip_atomic_compare_exchange_strong(tmo + 1, &expect, 0x600u | (unsigned)(u.pm & 0xff), __ATOMIC_RELAXED, __ATOMIC_RELAXED, __HIP_MEMORY_SCOPE_AGENT); __hip_atomic_store(tmo, 1u, __ATOMIC_RELAXED, __HIP_MEMORY_SCOPE_AGENT); }
                    break; }
                __builtin_amdgcn_s_sleep(2); }
            __builtin_amdgcn_fence(__ATOMIC_ACQUIRE, "agent");
            asm volatile("s_waitcnt vmcnt(0)" ::: "memory");
        }
#if !defined(BROKEN_HOOK_NO_BARRIER)
        asm volatile("" ::: "memory"); __builtin_amdgcn_s_barrier(); asm volatile("" ::: "memory");
#endif
    }
};
struct EpiF32 {
    static constexpr bool PERM = false, AFTER_DRAIN = false;
    float* C; int ldc; const float* bias;
    __device__ __forceinline__ void operator()(const f32x4 (&acc)[2][2][4][2], const Unit& u, int wr, int wc, int fr, int fq) const {
        const int row0 = u.pm * BM + wr * 64 + fr, col0 = u.pn * BM + wc * 32 + 4 * fq;
        f32x4 bv[2][2];
#pragma unroll
        for (int bj = 0; bj < 2; ++bj)
#pragma unroll
            for (int n = 0; n < 2; ++n) bv[bj][n] = bias ? *(const f32x4*)(bias + col0 + bj * HALF + n * 16) : (f32x4){0.f, 0.f, 0.f, 0.f};
#pragma unroll
        for (int ai = 0; ai < 2; ++ai)
#pragma unroll
            for (int m = 0; m < 4; ++m) { float* rowp = C + (size_t)(row0 + ai * HALF + m * 16) * ldc + col0;
#pragma unroll
                for (int bj = 0; bj < 2; ++bj)
#pragma unroll
                    for (int n = 0; n < 2; ++n) *(f32x4*)(rowp + bj * HALF + n * 16) = acc[ai][bj][m][n] + bv[bj][n]; }
    }
};
template <class Epi, class Sched, bool STAMP = false>
__device__ __forceinline__ void gemm_phase(PG8_LAS unsigned char* lds, const Gemm g, const Sched& S, const Epi& E, unsigned long long* stamps) {
    int tid_ = threadIdx.x; asm volatile("" : "+v"(tid_));
    const int tid = tid_, wid = __builtin_amdgcn_readfirstlane(tid >> 6), lane = tid & 63, wr = wid >> 2, wc = wid & 3, fr = lane & 15, fq = lane >> 4;
    const int K = g.K, nt = K / BK;
    int ts_lo = 0, ts_hi = 0, nts = 0; const unsigned long long rt_entry = STAMP ? (unsigned long long)wall_clock64() : 0ull;
#define PG8_STAMP() do { if (STAMP && wid == 0 && nts < 64) { const unsigned long long _c = (unsigned long long)clock64(); \
        ts_lo = (lane == nts) ? (int)(unsigned)_c : ts_lo; ts_hi = (lane == nts) ? (int)(unsigned)(_c >> 32) : ts_hi; ++nts; } } while (0)
    PG8_STAMP();
    unsigned voffA[2], voffB[2];
#pragma unroll
    for (int i = 0; i < 2; ++i) { int R, C; stage_rc(tid * 16 + i * 8192, R, C); const int Rb = Epi::PERM ? ((R & ~31) + perm32(R & 31)) : R;
        voffA[i] = (unsigned)(R * K + C) * 2u; voffB[i] = (unsigned)(Rb * K + C) * 2u; }
    const size_t kstep = (size_t)(BK * 2);
    const size_t hstep = (size_t)HALF * K * 2;
    const size_t tstep = 2 * hstep;
    const unsigned ldsw = (unsigned)wid * 1024u;
    const int aoff = lds_byte(wr * 64 + fr, fq * 8), boff = lds_byte(wc * 32 + fr, fq * 8);
#define PG8_SA(b, h) (((b) * 2 + (h)) * HTB)
#define PG8_SB(b, h) ((4 + (b) * 2 + (h)) * HTB)
#define PG8_STAGE(bufoff, gbase, voff) do { _Pragma("unroll") for (int _i = 0; _i < 2; ++_i) \
        __builtin_amdgcn_global_load_lds((const unsigned*)((const char*)(gbase) + (voff)[_i]), (PG8_LAS unsigned*)(lds + (bufoff) + ldsw + _i * 8192), 16, 0, 0); } while (0)
#define PG8_LDA(dst, b, h) do { _Pragma("unroll") for (int m = 0; m < 4; ++m) _Pragma("unroll") for (int k = 0; k < 2; ++k) dst[m][k] = *(const PG8_LAS bf16x8*)(lds + PG8_SA(b, h) + aoff + m * 2048 + k * 1024); } while (0)
#define PG8_LDB(dst, b, h) do { _Pragma("unroll") for (int n = 0; n < 2; ++n) _Pragma("unroll") for (int k = 0; k < 2; ++k) dst[n][k] = *(const PG8_LAS bf16x8*)(lds + PG8_SB(b, h) + boff + n * 2048 + k * 1024); } while (0)
#define PG8_MMA(ai, bj, At, Bt) do { __builtin_amdgcn_s_setprio(1); _Pragma("unroll") for (int m = 0; m < 4; ++m) _Pragma("unroll") for (int n = 0; n < 2; ++n) _Pragma("unroll") for (int k = 0; k < 2; ++k) \
        acc[ai][bj][m][n] = __builtin_amdgcn_mfma_f32_16x16x32_bf16(Bt[n][k], At[m][k], acc[ai][bj][m][n], 0, 0, 0); __builtin_amdgcn_s_setprio(0); } while (0)
#define PG8_WAIT_V(n) asm volatile("s_waitcnt vmcnt(" #n ")" ::: "memory")
#define PG8_WAIT_L(n) asm volatile("s_waitcnt lgkmcnt(" #n ")" ::: "memory")
#define PG8_BAR __builtin_amdgcn_s_barrier()
#define PG8_SCHED __builtin_amdgcn_sched_barrier(0)
    Unit cur, nxt; int ui = 0;
    if (!S.next(0, cur)) return;
    f32x4 acc[2][2][4][2];
#pragma unroll
    for (int a = 0; a < 2; ++a)
#pragma unroll
        for (int b = 0; b < 2; ++b)
#pragma unroll
            for (int m = 0; m < 4; ++m)
#pragma unroll
                for (int n = 0; n < 2; ++n) acc[a][b][m][n] = (f32x4){0.f, 0.f, 0.f, 0.f};
    bf16x8 At[4][2], B0[2][2], B1[2][2];
    const char* cA = (const char*)g.A + (size_t)cur.pm * tstep; const char* cB = (const char*)g.Bt + (size_t)cur.pn * tstep;
    S.a_ready(cur);
    PG8_STAGE(PG8_SB(0, 0), cB, voffB); PG8_STAGE(PG8_SA(0, 0), cA, voffA); PG8_STAGE(PG8_SB(0, 1), cB + hstep, voffB); PG8_STAGE(PG8_SA(0, 1), cA + hstep, voffA);
    if (wr == 1) PG8_BAR;
    PG8_WAIT_V(4); PG8_BAR;
    PG8_STAGE(PG8_SB(1, 0), cB + kstep, voffB); PG8_STAGE(PG8_SA(1, 0), cA + kstep, voffA); PG8_STAGE(PG8_SB(1, 1), cB + hstep + kstep, voffB);
    PG8_WAIT_V(6); PG8_BAR;
    PG8_STAMP();
    for (;;) {
        const bool has_next = S.next(ui + 1, nxt);
        const char* nA = has_next ? (const char*)g.A + (size_t)nxt.pm * tstep : cA; const char* nB = has_next ? (const char*)g.Bt + (size_t)nxt.pn * tstep : cB;
        for (int t = 0; t < nt; t += 2) {
            const bool last = (t == nt - 2);
            const char* a1 = cA + (size_t)(t + 1) * kstep;
            const char* a2 = last ? nA : cA + (size_t)(t + 2) * kstep; const char* b2 = last ? nB : cB + (size_t)(t + 2) * kstep;
            const char* a3 = a2 + kstep; const char* b3 = b2 + kstep;
            if (last && has_next) S.a_ready(nxt);
            PG8_LDB(B0, 0, 0); PG8_SCHED; PG8_LDA(At, 0, 0); PG8_STAGE(PG8_SA(1, 1), a1 + hstep, voffA);
            PG8_WAIT_L(8); PG8_BAR; PG8_WAIT_L(0); PG8_MMA(0, 0, At, B0); PG8_BAR; PG8_SCHED;
            PG8_LDB(B1, 0, 1); PG8_STAGE(PG8_SB(0, 0), b2, voffB);
            PG8_BAR; PG8_WAIT_L(0); PG8_MMA(0, 1, At, B1); PG8_BAR;
            PG8_LDA(At, 0, 1); PG8_STAGE(PG8_SA(0, 0), a2, voffA);
            PG8_BAR; PG8_WAIT_L(0); PG8_MMA(1, 0, At, B0); PG8_BAR; PG8_SCHED;
            PG8_STAGE(PG8_SB(0, 1), b2 + hstep, voffB);
            PG8_WAIT_V(6); PG8_BAR; PG8_MMA(1, 1, At, B1); PG8_BAR;
            PG8_LDB(B0, 1, 0); PG8_SCHED; PG8_LDA(At, 1, 0); PG8_STAGE(PG8_SA(0, 1), a2 + hstep, voffA);
            PG8_WAIT_L(8); PG8_BAR; PG8_WAIT_L(0); PG8_MMA(0, 0, At, B0); PG8_BAR; PG8_SCHED;
            PG8_LDB(B1, 1, 1); PG8_STAGE(PG8_SB(1, 0), b3, voffB);
            PG8_BAR; PG8_WAIT_L(0); PG8_MMA(0, 1, At, B1); PG8_BAR;
            PG8_LDA(At, 1, 1); PG8_STAGE(PG8_SA(1, 0), a3, voffA);
            PG8_BAR; PG8_WAIT_L(0); PG8_MMA(1, 0, At, B0); PG8_BAR; PG8_SCHED;
            PG8_STAGE(PG8_SB(1, 1), b3 + hstep, voffB);
            PG8_WAIT_V(6); PG8_BAR; PG8_MMA(1, 1, At, B1); PG8_BAR;
        }
        PG8_STAMP();
        if constexpr (!Epi::AFTER_DRAIN) { E(acc, cur, wr, wc, fr, fq); S.done(cur); }
        PG8_STAMP();
        if (!has_next) break;
#pragma unroll
        for (int a = 0; a < 2; ++a)
#pragma unroll
            for (int b = 0; b < 2; ++b)
#pragma unroll
                for (int m = 0; m < 4; ++m)
#pragma unroll
                    for (int n = 0; n < 2; ++n) acc[a][b][m][n] = (f32x4){0.f, 0.f, 0.f, 0.f};
        cur = nxt; cA = nA; cB = nB; ++ui;
    }
    PG8_WAIT_V(0);
    if (wr == 0) PG8_BAR;
    PG8_BAR;
    if constexpr (Epi::AFTER_DRAIN) { E.fused(acc, cur, wr, wc, fr, fq, lds, wid, lane); S.done(cur); }
    PG8_STAMP();
    if (STAMP && wid == 0) { stamps[lane] = lane < nts ? (((unsigned long long)(unsigned)ts_hi << 32) | (unsigned)ts_lo) : 0ull;
        if (lane == 62) stamps[62] = rt_entry; if (lane == 63) stamps[63] = (unsigned long long)wall_clock64(); }
#undef PG8_STAMP
#undef PG8_SA
#undef PG8_SB
#undef PG8_STAGE
#undef PG8_LDA
#undef PG8_LDB
#undef PG8_MMA
#undef PG8_WAIT_V
#undef PG8_WAIT_L
#undef PG8_BAR
#undef PG8_SCHED
}
}

constexpr size_t WS_WINT = 284 * MB;
constexpr size_t WS_WOUTT = 1 * MB;
constexpr int NPAD_IN = 4352;
DI void transpose_tile(const float* W, int ldw, int k0, int n0, int nvalid, bfr* WT, int ldt, char* smem) {
  short* T = (short*)smem;
  const int tid = VT;
  __syncthreads();
  {
    const int r = tid >> 2, c4 = tid & 3;
#pragma unroll
    for (int q = 0; q < 4; ++q) {
      const int n = n0 + 16 * c4 + 4 * q;
      f32x4 v = {0.f, 0.f, 0.f, 0.f};
      if (n < nvalid) v = *(const f32x4*)(W + (size_t)(k0 + r) * ldw + n);
#pragma unroll
      for (int e = 0; e < 4; ++e) T[r * 66 + 16 * c4 + 4 * q + e] = (short)f2bf(v[e]);
    }
  }
  __syncthreads();
  {
    const int n = tid >> 2, kq = tid & 3;
    unsigned wv[8];
#pragma unroll
    for (int e = 0; e < 8; ++e) wv[e] = ((unsigned)(unsigned short)T[(16 * kq + 2 * e) * 66 + n]) | (((unsigned)(unsigned short)T[(16 * kq + 2 * e + 1) * 66 + n]) << 16);
    bfr* dst = WT + (size_t)(n0 + n) * ldt + k0 + 16 * kq;
    *(uint4*)dst = uint4{wv[0], wv[1], wv[2], wv[3]};
    *(uint4*)(dst + 8) = uint4{wv[4], wv[5], wv[6], wv[7]};
  }
}
template <int LDC, int NVALID> struct EpiBf16T {
  static constexpr bool PERM = true, AFTER_DRAIN = false;
  bfr* O;
  DI void operator()(const pg8::f32x4 (&acc)[2][2][4][2], const pg8::Unit& u, int wr, int wc, int fr, int fq) const {
    const int row0 = u.pm * 256 + wr * 64 + fr, col0 = u.pn * 256 + wc * 32 + 8 * fq;
#pragma unroll
    for (int ai = 0; ai < 2; ++ai)
#pragma unroll
      for (int m = 0; m < 4; ++m) {
        bfr* rowp = O + (size_t)(row0 + ai * 128 + m * 16) * LDC + col0;
#pragma unroll
        for (int bj = 0; bj < 2; ++bj) {
          if (col0 + bj * 128 < NVALID) {
            const pg8::f32x4 v0 = acc[ai][bj][m][0], v1 = acc[ai][bj][m][1];
            *(uint4*)(rowp + bj * 128) = uint4{pack2(v0[0], v0[1]), pack2(v0[2], v0[3]), pack2(v1[0], v1[1]), pack2(v1[2], v1[3])};
          }
        }
      }
  }
};
DI void phase_pgemm8(const Params& P, char* smem_all) {
  pg8::Gemm g{(const pg8::bf16_t*)(P.ws + WS_H), (const pg8::bf16_t*)(P.ws + WS_WINT), T_ALL, NPAD_IN, DM};
  pg8::StaticOrder S; S.init(T_ALL, NPAD_IN, (int)gridDim.x, (int)blockIdx.x);
  typedef EpiBf16T<DIN, DIN> EpiP;
  EpiP E{(bfr*)(P.ws + WS_P)};
  pg8::gemm_phase<EpiP, pg8::StaticOrder>((PG8_LAS unsigned char*)smem_all, g, S, E, nullptr);
}
DI void phase_outproj8(const Params& P, char* smem_all) {
  pg8::Gemm g{(const pg8::bf16_t*)(P.ws + WS_MIX), (const pg8::bf16_t*)(P.ws + WS_WOUTT), T_LAT, DM, DM};
  pg8::StaticOrder S; S.init(T_LAT, DM, (int)gridDim.x, (int)blockIdx.x);
  typedef EpiBf16T<DM, DM> EpiY;
  EpiY E{(bfr*)(P.ws + WS_Y)};
  pg8::gemm_phase<EpiY, pg8::StaticOrder>((PG8_LAS unsigned char*)smem_all, g, S, E, nullptr);
}


constexpr size_t WS_BTGU = 350 * MB;
constexpr size_t WS_BTD = 284 * MB;
constexpr size_t WS_XB = 186 * MB;
constexpr size_t WS_HID8 = 138 * MB;
constexpr size_t WS_MOUT8 = 42 * MB;
constexpr int TAB_LDS_OFF = 131072 + 1024;

DI void transpose_quad(const float* W, int ldw, int k0, int n0, bfr* WT, int ldt, int dr0, int dr1, int dr2, int dr3, char* smem) {
  short* T = (short*)smem;
  const int tid = VT;
  const int r = tid >> 2, c4 = tid & 3;
  f32x4 v[4][4];
#pragma unroll
  for (int j = 0; j < 4; ++j)
#pragma unroll
    for (int q = 0; q < 4; ++q) v[j][q] = *(const f32x4*)(W + (size_t)(k0 + r) * ldw + n0 + j * 64 + 16 * c4 + 4 * q);
  __syncthreads();
#pragma unroll
  for (int j = 0; j < 4; ++j)
#pragma unroll
    for (int q = 0; q < 4; ++q)
#pragma unroll
      for (int e = 0; e < 4; ++e) T[j * 64 * 66 + r * 66 + 16 * c4 + 4 * q + e] = (short)f2bf(v[j][q][e]);
  __syncthreads();
  const int n = tid >> 2, kq = tid & 3;
#pragma unroll
  for (int j = 0; j < 4; ++j) {
    unsigned wv[8];
#pragma unroll
    for (int e = 0; e < 8; ++e) wv[e] = ((unsigned)(unsigned short)T[j * 64 * 66 + (16 * kq + 2 * e) * 66 + n]) | (((unsigned)(unsigned short)T[j * 64 * 66 + (16 * kq + 2 * e + 1) * 66 + n]) << 16);
    const int dr = j == 0 ? dr0 : j == 1 ? dr1 : j == 2 ? dr2 : dr3;
    bfr* dst = WT + (size_t)(dr + n) * ldt + k0 + 16 * kq;
    *(uint4*)dst = uint4{wv[0], wv[1], wv[2], wv[3]};
    *(uint4*)(dst + 8) = uint4{wv[4], wv[5], wv[6], wv[7]};
  }
}
DI void phase_moe_convert_gu(const Params& P, int bid, int nb, char* smem) {
  for (int it = bid; it < 64 * 64; it += nb) {
    const int e = it >> 6, s = it & 63;
    const int isup = s >> 5, kt = (s & 31) >> 1, nq = s & 1;
    const float* W = (isup ? P.in[30] : P.in[29]) + (size_t)e * DM * DEXP;
    bfr* WT = (bfr*)(P.ws + WS_BTGU) + (size_t)e * 1024 * 1024;
    const int b = nq * 4;
    transpose_quad(W, DEXP, kt * 64, nq * 256, WT, 1024,
                   ((b + 0) >> 1) * 256 + isup * 128 + ((b + 0) & 1) * 64, ((b + 1) >> 1) * 256 + isup * 128 + ((b + 1) & 1) * 64,
                   ((b + 2) >> 1) * 256 + isup * 128 + ((b + 2) & 1) * 64, ((b + 3) >> 1) * 256 + isup * 128 + ((b + 3) & 1) * 64, smem);
  }
}
DI void phase_moe_convert_d(const Params& P, int bid, int nb, char* smem) {
  for (int it = bid; it < 64 * 32; it += nb) {
    const int e = it >> 5, s2 = it & 31, kt = s2 >> 2, nq = s2 & 3;
    const float* W = P.in[31] + (size_t)e * DEXP * DM;
    bfr* WT = (bfr*)(P.ws + WS_BTD) + (size_t)e * 1024 * 512;
    transpose_quad(W, DM, kt * 64, nq * 256, WT, 512, nq * 256, nq * 256 + 64, nq * 256 + 128, nq * 256 + 192, smem);
  }
}
DI void moe_block_table256(const Params& P, int* tab  ) {
  const int* cnt = (const int*)(P.ws + WS_CNT);
  __syncthreads();
  if (threadIdx.x < 64) {
    const int t = threadIdx.x;
    int incl = (cnt[t] + 255) >> 8;
#pragma unroll
    for (int o = 1; o < 64; o <<= 1) { int u = __shfl_up(incl, o); if (t >= o) incl += u; }
    tab[t + 1] = incl;
    if (t == 0) tab[0] = 0;
  }
  __syncthreads();
}
DI void phase_moe_gather(const Params& P, char* smem_all) {
  const bfr* h2 = (const bfr*)(P.ws + WS_H2);
  const int* cnt = (const int*)(P.ws + WS_CNT); const int* list = (const int*)(P.ws + WS_LIST);
  bfr* xb = (bfr*)(P.ws + WS_XB);
  int* tab = (int*)(smem_all + TAB_LDS_OFF);
  moe_block_table256(P, tab);
  const int nrows = tab[64] * 256;
  const int wv = threadIdx.x >> 6, lane = threadIdx.x & 63;
  for (int row0 = (blockIdx.x * 8 + wv) * 4; row0 < nrows; row0 += gridDim.x * 32) {
    const int rb = row0 >> 8;
    int e = 0; while (tab[e + 1] <= rb) ++e;
    const int idx0 = (rb - tab[e]) * 256 + (row0 & 255), ce = cnt[e];
    const int* lp = list + e * T_LAT + idx0;
    const int t0 = idx0 + 0 < ce ? (lp[0] >> 1) : -1, t1 = idx0 + 1 < ce ? (lp[1] >> 1) : -1, t2 = idx0 + 2 < ce ? (lp[2] >> 1) : -1, t3 = idx0 + 3 < ce ? (lp[3] >> 1) : -1;
    const bfr* s0 = h2 + (size_t)(t0 < 0 ? 0 : t0) * DM + lane * 8; const bfr* s1 = h2 + (size_t)(t1 < 0 ? 0 : t1) * DM + lane * 8;
    const bfr* s2 = h2 + (size_t)(t2 < 0 ? 0 : t2) * DM + lane * 8; const bfr* s3 = h2 + (size_t)(t3 < 0 ? 0 : t3) * DM + lane * 8;
    const uint4 a0 = *(const uint4*)s0, b0 = *(const uint4*)(s0 + 512), a1 = *(const uint4*)s1, b1 = *(const uint4*)(s1 + 512);
    const uint4 a2 = *(const uint4*)s2, b2 = *(const uint4*)(s2 + 512), a3 = *(const uint4*)s3, b3 = *(const uint4*)(s3 + 512);
    bfr* d = xb + (size_t)row0 * DM + lane * 8;
    if (t0 >= 0) { *(uint4*)d = a0; *(uint4*)(d + 512) = b0; }
    if (t1 >= 0) { *(uint4*)(d + DM) = a1; *(uint4*)(d + DM + 512) = b1; }
    if (t2 >= 0) { *(uint4*)(d + 2 * DM) = a2; *(uint4*)(d + 2 * DM + 512) = b2; }
    if (t3 >= 0) { *(uint4*)(d + 3 * DM) = a3; *(uint4*)(d + 3 * DM + 512) = b3; }
  }
}
struct MoeOrder {
  const int* tab; int nunits, G, c;
  DI bool next(int i, pg8::Unit& u) const {
    const int L = i * G + c; if (L >= nunits) return false;
    const int rb = L >> 2; int e = 0; while (tab[e + 1] <= rb) ++e;
    u.pm = rb; u.pn = e * 4 + (L & 3); return true;
  }
  DI void a_ready(const pg8::Unit&) const {}
  DI void done(const pg8::Unit&) const {}
};
struct EpiHid {
  static constexpr bool PERM = true, AFTER_DRAIN = false;
  bfr* H;
  DI void operator()(const pg8::f32x4 (&acc)[2][2][4][2], const pg8::Unit& u, int wr, int wc, int fr, int fq) const {
    const int row0 = u.pm * 256 + wr * 64 + fr, col0 = (u.pn & 3) * 128 + wc * 32 + 8 * fq;
#pragma unroll
    for (int ai = 0; ai < 2; ++ai)
#pragma unroll
      for (int m = 0; m < 4; ++m) {
        float hv[8];
#pragma unroll
        for (int n = 0; n < 2; ++n)
#pragma unroll
          for (int j = 0; j < 4; ++j) hv[4 * n + j] = siluf_(acc[ai][0][m][n][j]) * acc[ai][1][m][n][j];
        *(uint4*)(H + (size_t)(row0 + ai * 128 + m * 16) * DEXP + col0) = uint4{pack2(hv[0], hv[1]), pack2(hv[2], hv[3]), pack2(hv[4], hv[5]), pack2(hv[6], hv[7])};
      }
  }
};
struct EpiMout {
  static constexpr bool PERM = true, AFTER_DRAIN = false;
  bfr* O; const int* tab; const int* cnt; const int* list;
  DI void operator()(const pg8::f32x4 (&acc)[2][2][4][2], const pg8::Unit& u, int wr, int wc, int fr, int fq) const {
    const int e = u.pn >> 2, pnl = u.pn & 3;
    const int lrow0 = (u.pm - tab[e]) * 256 + wr * 64 + fr, ce = cnt[e];
    const int col0 = pnl * 256 + wc * 32 + 8 * fq;
#pragma unroll
    for (int ai = 0; ai < 2; ++ai)
#pragma unroll
      for (int m = 0; m < 4; ++m) {
        const int idx = lrow0 + ai * 128 + m * 16;
        if (idx < ce) {
          const int asg = list[e * T_LAT + idx];
          bfr* rowp = O + (size_t)asg * DM + col0;
#pragma unroll
          for (int bj = 0; bj < 2; ++bj) {
            const pg8::f32x4 v0 = acc[ai][bj][m][0], v1 = acc[ai][bj][m][1];
            *(uint4*)(rowp + bj * 128) = uint4{pack2(v0[0], v0[1]), pack2(v0[2], v0[3]), pack2(v1[0], v1[1]), pack2(v1[2], v1[3])};
          }
        }
      }
  }
};
DI void phase_moe1_8(const Params& P, char* smem_all) {
  int* tab = (int*)(smem_all + TAB_LDS_OFF);
  moe_block_table256(P, tab);
  const int nrb = tab[64];
  pg8::Gemm g{(const pg8::bf16_t*)(P.ws + WS_XB), (const pg8::bf16_t*)(P.ws + WS_BTGU), nrb * 256, 64 * 1024, DM};
  MoeOrder S{tab, nrb * 4, (int)gridDim.x, (int)blockIdx.x};
  EpiHid E{(bfr*)(P.ws + WS_HID8)};
  pg8::gemm_phase<EpiHid, MoeOrder>((PG8_LAS unsigned char*)smem_all, g, S, E, nullptr);
}
DI void phase_moe2_8(const Params& P, char* smem_all) {
  int* tab = (int*)(smem_all + TAB_LDS_OFF);
  moe_block_table256(P, tab);
  const int nrb = tab[64];
  pg8::Gemm g{(const pg8::bf16_t*)(P.ws + WS_HID8), (const pg8::bf16_t*)(P.ws + WS_BTD), nrb * 256, 64 * 1024, DEXP};
  MoeOrder S{tab, nrb * 4, (int)gridDim.x, (int)blockIdx.x};
  EpiMout E{(bfr*)(P.ws + WS_MOUT8), tab, (const int*)(P.ws + WS_CNT), (const int*)(P.ws + WS_LIST)};
  pg8::gemm_phase<EpiMout, MoeOrder>((PG8_LAS unsigned char*)smem_all, g, S, E, nullptr);
}

#define XB_TMO      128
#define XB_XCNT(j)  (256  + 64 * (j))
#define XB_XSUB(j)  (1280 + 64 * (j))
#define XB_XGEN(j)  (2304 + 64 * (j))
#define XB_TOP      3328
#define XB_TOPGEN   3392
#define XCD_BAR_WORDS 3456
#define XB_SPIN_CAP (1u << 22)
#define LAS __attribute__((address_space(3)))
DI unsigned xb_ld(unsigned* p)              { return __hip_atomic_load(p, __ATOMIC_RELAXED, __HIP_MEMORY_SCOPE_AGENT); }
DI unsigned xb_add(unsigned* p, unsigned v) { return __hip_atomic_fetch_add(p, v, __ATOMIC_RELAXED, __HIP_MEMORY_SCOPE_AGENT); }
DI unsigned xb_xcc_id() { return (unsigned)__builtin_amdgcn_s_getreg((3 << 11) | 20) & 0xFu; }
#define XB_SPIN(cond, bar) do { unsigned _sp = 0; while (cond) { __builtin_amdgcn_s_sleep(1); \
    if ((++_sp & 255u) == 0u) { if (xb_ld(&(bar)[XB_TMO])) break; if (_sp > XB_SPIN_CAP) { atomicAdd(&(bar)[XB_TMO], 1u); break; } } } } while (0)
struct XcdBarrier { unsigned* bar; unsigned x; volatile LAS unsigned* st; };
DI XcdBarrier xcd_barrier_post(unsigned* bar, volatile LAS unsigned* st) {
  XcdBarrier b; b.bar = bar; b.x = xb_xcc_id(); b.st = st;
  if (threadIdx.x == 0) (void)xb_add(&bar[XB_XCNT(b.x)], 1u);
  return b;
}
DI void xcd_barrier_complete(unsigned* bar, unsigned x, unsigned& nloc, unsigned& nx) {
  const unsigned G = gridDim.x * gridDim.y * gridDim.z;
  unsigned sum, cnt, mine, sp = 0u;
  for (;;) {
    sum = 0u; cnt = 0u; mine = 0u;
#pragma unroll
    for (unsigned j = 0; j < 16; ++j) { const unsigned c = xb_ld(&bar[XB_XCNT(j)]); sum += c; cnt += (c > 0u) ? 1u : 0u; mine = (j == x) ? c : mine; }
    if (sum == G) break;
    __builtin_amdgcn_s_sleep(1);
    if ((++sp & 255u) == 0u) { if (xb_ld(&bar[XB_TMO])) break; if (sp > XB_SPIN_CAP) { atomicAdd(&bar[XB_TMO], 1u); break; } }
  }
  nloc = mine > 0u ? mine : 1u; nx = cnt > 0u ? cnt : 1u;
}
DI void xcd_barrier(const XcdBarrier& b) {
  asm volatile("s_waitcnt vmcnt(0)" ::: "memory");
  __syncthreads();
  if (threadIdx.x == 0) {
    unsigned* bar = b.bar;
    __builtin_amdgcn_s_waitcnt(0);
    unsigned nloc = b.st[0], nx = b.st[1];
    if (nloc == 0u) { xcd_barrier_complete(bar, b.x, nloc, nx); b.st[0] = nloc; b.st[1] = nx; }
    const unsigned old = xb_add(&bar[XB_XSUB(b.x)], 1u);
    const unsigned gen = old / nloc;
    if (old + 1u == (gen + 1u) * nloc) {
      __builtin_amdgcn_fence(__ATOMIC_RELEASE, "agent");
      asm volatile("s_waitcnt vmcnt(0)" ::: "memory");
      const unsigned og = xb_add(&bar[XB_TOP], 1u);
      const unsigned tg = og / nx;
      if (og + 1u == (tg + 1u) * nx) xb_add(&bar[XB_TOPGEN], 1u);
      else XB_SPIN(xb_ld(&bar[XB_TOPGEN]) == tg, bar);
      __builtin_amdgcn_fence(__ATOMIC_ACQUIRE, "agent");
      xb_add(&bar[XB_XGEN(b.x)], 1u);
      asm volatile("s_waitcnt vmcnt(0)" ::: "memory");
    } else {
      XB_SPIN(xb_ld(&bar[XB_XGEN(b.x)]) == gen, bar);
      __builtin_amdgcn_fence(__ATOMIC_ACQUIRE, "agent");
      asm volatile("s_waitcnt vmcnt(0)" ::: "memory");
    }
  }
  __syncthreads();
}

namespace cg = cooperative_groups;
constexpr int HALF_LDS = 78080;
constexpr int SMEM_BYTES = 2 * HALF_LDS + 16;
__global__ void __launch_bounds__(NTHR_BLOCK) k_fused(Params P) {
  __shared__ __attribute__((aligned(16))) char smem_all[SMEM_BYTES];
  cg::grid_group grid = cg::this_grid();
  const int half = __builtin_amdgcn_readfirstlane((int)(threadIdx.x >> 8));
  char* smem = smem_all + half * HALF_LDS;
  const int bid = blockIdx.x * 2 + half, nb = gridDim.x * 2;
  volatile LAS unsigned* bst = (volatile LAS unsigned*)(smem_all + SMEM_BYTES - 16);
  if (threadIdx.x < 4) bst[threadIdx.x] = 0u;
  __syncthreads();
  XcdBarrier xb = xcd_barrier_post(P.bar, bst);
#define GSYNC() do { if (P.use_cg) grid.sync(); else xcd_barrier(xb); } while (0)
  phase_mod(P, bid, nb, smem);
  GSYNC();
  phase_ln1(P, bid, nb);
  GSYNC();
  phase_pgemm8(P, smem_all);
  GSYNC();
  phase_rwprep(P, bid, nb, smem);
  GSYNC();
  for (int it = bid; it < 16 * RW_NSC; it += nb) rw_levelA_item(P, it / RW_NSC, it % RW_NSC, smem);
  for (int it = bid; it < 8 * HG_NSC; it += nb) hg_levelA_item(P, it / HG_NSC, it % HG_NSC, smem);
  GSYNC();
  if (bid < 16) rw_levelB_chain(P, bid, smem); else { hg_levelB(P, bid - 16, nb - 16); phase_moe_convert_d(P, bid - 16, nb - 16, smem); }
  GSYNC();
  phase_readout_fused(P, bid, nb);
  GSYNC();
  phase_outproj8(P, smem_all);
  phase_moe_convert_gu(P, bid, nb, smem);
  GSYNC();
  phase_ln2route(P, bid, nb, smem);
  GSYNC();
  phase_moe_gather(P, smem_all);
  GSYNC();
  phase_moe1_8(P, smem_all);
  GSYNC();
  phase_moe2_8(P, smem_all);
  GSYNC();
  phase_final(P, bid, nb);
}

extern "C" void kernel_launch(void* const* d_in, const int* in_sizes, int n_in, void* d_out, int out_size, void* d_ws, size_t ws_size, hipStream_t stream) {
  static int grid_blocks = 0;
  if (!grid_blocks) {
    int dev = 0, cus = 0, per_cu = 0;
    hipGetDevice(&dev);
    hipDeviceGetAttribute(&cus, hipDeviceAttributeMultiprocessorCount, dev);
    hipOccupancyMaxActiveBlocksPerMultiprocessor(&per_cu, k_fused, NTHR_BLOCK, 0);
    if (per_cu > 1) per_cu = 1;
    if (per_cu < 1) per_cu = 1;
    grid_blocks = cus * per_cu;
  }
  Params P{};
  P.bar = (unsigned*)((char*)d_ws + WS_BAR); P.use_cg = 0; P.pad = 0;
  hipMemsetAsync((char*)d_ws + WS_BAR, 0, XCD_BAR_WORDS * 4, stream);
  for (int i = 0; i < 32; ++i) P.in[i] = (const float*)d_in[i];
  P.out = (float*)d_out; P.ws = (char*)d_ws;
  void* args[] = {&P};
  hipError_t e = hipLaunchCooperativeKernel((void*)k_fused, dim3(grid_blocks), dim3(NTHR_BLOCK), args, 0, stream);
  if (e != hipSuccess) fprintf(stderr, "cooperative launch failed: %s (grid %d)\n", hipGetErrorString(e), grid_blocks);
}
```

```cpp
#include <hip/hip_runtime.h>
#include <hip/hip_cooperative_groups.h>
#include <cstdio>

typedef __attribute__((ext_vector_type(8))) short bf16x8;
typedef __attribute__((ext_vector_type(4))) short s16x4;
typedef __attribute__((ext_vector_type(4))) float f32x4;
typedef __attribute__((ext_vector_type(2))) float f32x2;
typedef __attribute__((ext_vector_type(2))) __bf16 bf16x2_t;
typedef unsigned short bfr;

#define DI __device__ __forceinline__

constexpr int T_LAT = 16384, T_CTX = 256, T_ALL = T_LAT + T_CTX;
constexpr int DM = 1024, DIN = 4288, HGC = 2560, RWC = 1728, DRW = 512, DHG = 512;
constexpr int NEXP = 64, DEXP = 512;
constexpr int NTHR = 256;
constexpr int NTHR_BLOCK = 512;
#define VT ((int)(threadIdx.x & 255))
__device__ __forceinline__ int tx_() { int t = (int)threadIdx.x; asm volatile("" : "+v"(t)); return t; }
constexpr float DN_ALPHA = 1.189207115002721f;
constexpr float RW_DECAY_SCALE = 0.6065306597126334f;

constexpr size_t MB = 1ull << 20;
constexpr size_t WS_MOD = 0;
constexpr size_t WS_MODC = 32768;
constexpr size_t WS_LB = 65536;
constexpr size_t WS_CNT = 65536 + 8192;
constexpr size_t WS_BAR = 81920;
constexpr size_t WS_ASGW = 131072;
constexpr size_t WS_LIST = 1 * MB;
constexpr size_t WS_H = 6 * MB;
constexpr size_t WS_P = 42 * MB;
constexpr size_t WS_Y = 42 * MB;
constexpr size_t WS_H2 = 106 * MB;
constexpr size_t WS_HID = 138 * MB;
constexpr size_t WS_RW = 186 * MB;
constexpr size_t RW_ARR = (size_t)T_ALL * 512 * 2;
constexpr size_t WS_X1B = 6 * MB;
constexpr size_t WS_MIX = WS_RW + 3 * RW_ARR;
constexpr size_t WS_LW = 284 * MB;
constexpr size_t LW_ARR = (size_t)T_ALL * 512 * 4;
constexpr size_t WS_YRW = 350 * MB;
constexpr size_t WS_OHG = 414 * MB;
constexpr size_t WS_MOUT = 186 * MB;

struct Params {
  const float* in[32];
  float* out;
  char* ws;
  unsigned* bar;
  int use_cg;
  int pad;
};
typedef const __attribute__((address_space(4))) Params CParams;

DI unsigned pack2(float a, float b) {
  f32x2 v = {a, b};
  bf16x2_t r = __builtin_convertvector(v, bf16x2_t);
  return __builtin_bit_cast(unsigned, r);
}
DI bfr f2bf(float a) { return (bfr)(pack2(a, 0.f) & 0xffffu); }
DI float bf2f(bfr v) { return __uint_as_float(((unsigned)v) << 16); }
DI float frcp_(float x) { return __builtin_amdgcn_rcpf(x); }
DI float sigmoidf_(float x) { return frcp_(1.f + __expf(-x)); }
DI float siluf_(float x) { return x * frcp_(1.f + __expf(-x)); }
DI f32x4 ld4bf(const bfr* p);
DI float wave_sum(float v) {
#pragma unroll
  for (int o = 32; o > 0; o >>= 1) v += __shfl_xor(v, o);
  return v;
}

constexpr int LSTR = 72;
constexpr int GEMM_LDS_BYTES = 2 * 128 * LSTR * 2;

struct ALoadBf16 {
  const bfr* rp[4];
  bf16x8 r[4];
  DI void load(int kt) {
#pragma unroll
    for (int i = 0; i < 4; ++i) r[i] = *(const bf16x8*)(rp[i] + kt * 64);
  }
  DI void store(short* sA) const {
    const int tid = VT;
#pragma unroll
    for (int i = 0; i < 4; ++i) *(bf16x8*)(sA + ((tid >> 3) + 32 * i) * LSTR + (tid & 7) * 8) = r[i];
  }
};

struct BLoadF32 {
  const float* p;
  long ldb;
  bool valid;
  f32x4 v[8];
  DI void load(int kt) {
#pragma unroll
    for (int j = 0; j < 8; ++j) {
      if (valid) v[j] = *(const f32x4*)(p + ((long)kt * 64 + j) * ldb);
      else v[j] = f32x4{0.f, 0.f, 0.f, 0.f};
    }
  }
  DI void store(short* sB) const {
    const int tid = VT, kg = tid & 7, n4 = tid >> 3;
#pragma unroll
    for (int i = 0; i < 4; ++i) {
      unsigned a0 = pack2(v[0][i], v[1][i]), a1 = pack2(v[2][i], v[3][i]);
      unsigned a2 = pack2(v[4][i], v[5][i]), a3 = pack2(v[6][i], v[7][i]);
      typedef __attribute__((ext_vector_type(4))) unsigned u32x4;
      u32x4 w = {a0, a1, a2, a3};
      *(u32x4*)(sB + (4 * n4 + i) * LSTR + kg * 8) = w;
    }
  }
};

template <class AL, class BL>
DI void gemm_mainloop(short* sA, short* sB, int nk, AL& al, BL& bl, f32x4 (&acc)[4][4]) {
  const int tid = VT, wid = tid >> 6, lane = tid & 63;
  const int wr = wid >> 1, wc = wid & 1, fr = lane & 15, fq = lane >> 4;
#pragma unroll
  for (int m = 0; m < 4; ++m)
#pragma unroll
    for (int n = 0; n < 4; ++n) acc[m][n] = f32x4{0.f, 0.f, 0.f, 0.f};
  al.load(0); bl.load(0);
  for (int kt = 0; kt < nk; ++kt) {
    __syncthreads();
    al.store(sA); bl.store(sB);
    __syncthreads();
    if (kt + 1 < nk) { al.load(kt + 1); bl.load(kt + 1); }
#pragma unroll
    for (int ks = 0; ks < 2; ++ks) {
      bf16x8 af[4], bf[4];
#pragma unroll
      for (int m = 0; m < 4; ++m) af[m] = *(const bf16x8*)(sA + (wr * 64 + m * 16 + fr) * LSTR + ks * 32 + fq * 8);
#pragma unroll
      for (int n = 0; n < 4; ++n) bf[n] = *(const bf16x8*)(sB + (wc * 64 + n * 16 + fr) * LSTR + ks * 32 + fq * 8);
#pragma unroll
      for (int m = 0; m < 4; ++m)
#pragma unroll
        for (int n = 0; n < 4; ++n) acc[m][n] = __builtin_amdgcn_mfma_f32_16x16x32_bf16(af[m], bf[n], acc[m][n], 0, 0, 0);
    }
  }
}

DI void phase_lora_convert(CParams& P, int part, int nparts);
DI void phase_wrt_convert(CParams& P, int part, int nparts);
DI void transpose_tile(const float* W, int ldw, int k0, int n0, int nvalid, bfr* WT, int ldt, char* smem);
DI void phase_mod(CParams& P, int bid, int nb, char* smem) {
  const float* c = P.in[1]; const float* cc = P.in[3];
  const float* w_mod = P.in[4]; const float* b_mod = P.in[5];
  float* mod = (float*)(P.ws + WS_MOD); float* modc = (float*)(P.ws + WS_MODC);
  float* red = (float*)smem;
  const int tid = VT;
  for (int it = bid; it < 1550; it += nb) {
    if (it < 192) {
      const int kq = tid >> 3, c4 = tid & 7;
      const int col = it * 32 + c4 * 4;
      f32x4 a1 = {0, 0, 0, 0}, a2 = {0, 0, 0, 0};
      for (int k = kq; k < DM; k += 32) {
        f32x4 w = *(const f32x4*)(w_mod + (long)k * 6144 + col);
        float s1 = siluf_(c[k]), s2 = siluf_(cc[k]);
        a1 += w * s1; a2 += w * s2;
      }
      __syncthreads();
#pragma unroll
      for (int e = 0; e < 4; ++e) { red[(kq * 32) + c4 * 4 + e] = a1[e]; red[1024 + kq * 32 + c4 * 4 + e] = a2[e]; }
      __syncthreads();
      if (tid < 64) {
        const int which = tid >> 5, cl = tid & 31;
        float s = 0.f;
        for (int q = 0; q < 32; ++q) s += red[which * 1024 + q * 32 + cl];
        const int cg = it * 32 + cl;
        s += b_mod[cg];
        if (which == 0) mod[cg] = s; else modc[cg] = s;
      }
    } else if (it == 192) {
      const float* L = P.in[8];
      float* lb = (float*)(P.ws + WS_LB);
      for (int i = tid; i < 1024; i += NTHR) {
        const int d = i >> 9, j = i & 511;
        float l0 = L[d * 1024 + j], l1 = L[d * 1024 + 512 + j];
        lb[i] = 1.f / (1.f + __expf(l1 - l0));
      }
    } else if (it == 193) {
      int* cnt = (int*)(P.ws + WS_CNT);
      if (tid < 64) cnt[tid] = 0;
    } else if (it < 198) {
      phase_lora_convert(P, it - 194, 4);
    } else if (it < 1286) {
      const int t = it - 198;
      transpose_tile(P.in[6], DIN, (t / 68) * 64, (t % 68) * 64, DIN, (bfr*)(P.ws + (284ull << 20)), DM, smem);
    } else if (it < 1542) {
      const int t = it - 1286;
      transpose_tile(P.in[7], DM, (t >> 4) * 64, (t & 15) * 64, DM, (bfr*)(P.ws + (1ull << 20)), DM, smem);
    } else {
      phase_wrt_convert(P, it - 1542, 8);
    }
  }
}

DI void phase_ln1(CParams& P, int bid, int nb) {
  const float* x = P.in[0]; const float* ctx = P.in[2];
  const float* mod = (const float*)(P.ws + WS_MOD); const float* modc = (const float*)(P.ws + WS_MODC);
  bfr* h = (bfr*)(P.ws + WS_H);
  const int wid = VT >> 6, lane = VT & 63;
  for (int row0 = (bid * 4 + wid) * 2; row0 < T_ALL; row0 += nb * 8) {
    const float* src = row0 < T_LAT ? x + (long)row0 * DM : ctx + (long)(row0 - T_LAT) * DM;
    const float* mm = row0 < T_LAT ? mod : modc;
    f32x4 v[2][4];
    float s[2] = {0.f, 0.f};
#pragma unroll
    for (int r = 0; r < 2; ++r)
#pragma unroll
      for (int i = 0; i < 4; ++i) { v[r][i] = *(const f32x4*)(src + r * DM + lane * 4 + 256 * i); s[r] += v[r][i][0] + v[r][i][1] + v[r][i][2] + v[r][i][3]; }
#pragma unroll
    for (int r = 0; r < 2; ++r) {
      const float mu = wave_sum(s[r]) * (1.f / DM);
      float q = 0.f;
#pragma unroll
      for (int i = 0; i < 4; ++i) { v[r][i] -= mu; q += v[r][i][0] * v[r][i][0] + v[r][i][1] * v[r][i][1] + v[r][i][2] * v[r][i][2] + v[r][i][3] * v[r][i][3]; }
      const float rs = rsqrtf(wave_sum(q) * (1.f / DM) + 1e-5f);
#pragma unroll
      for (int i = 0; i < 4; ++i) {
        const int cidx = lane * 4 + 256 * i;
        f32x4 sh = *(const f32x4*)(mm + cidx), sc = *(const f32x4*)(mm + 1024 + cidx);
        f32x4 o = v[r][i] * rs * (sc + 1.f) + sh;
        uint2 w = {pack2(o[0], o[1]), pack2(o[2], o[3])};
        *(uint2*)(h + (long)(row0 + r) * DM + cidx) = w;
      }
    }
  }
}

DI void phase_pgemm(CParams& P, int bid, int nb, char* smem) {
  const bfr* h = (const bfr*)(P.ws + WS_H);
  const float* w_in = P.in[6];
  bfr* p = (bfr*)(P.ws + WS_P);
  short* sA = (short*)smem; short* sB = sA + 128 * LSTR;
  const int tid = VT, wid = tid >> 6, lane = tid & 63;
  const int wr = wid >> 1, wc = wid & 1, fr = lane & 15, fq = lane >> 4;
  constexpr int NT = 34, MT = T_ALL / 128;
  for (int it = bid; it < NT * MT; it += nb) {
    const int mt = it / NT, nt = it % NT;
    ALoadBf16 al; BLoadF32 bl;
#pragma unroll
    for (int i = 0; i < 4; ++i) al.rp[i] = h + (long)(mt * 128 + (tid >> 3) + 32 * i) * DM + (tid & 7) * 8;
    const int col = nt * 128 + (tid >> 3) * 4;
    bl.valid = col < DIN; bl.ldb = DIN;
    bl.p = w_in + (long)((tid & 7) * 8) * DIN + (bl.valid ? col : 0);
    f32x4 acc[4][4];
    gemm_mainloop(sA, sB, DM / 64, al, bl, acc);
#pragma unroll
    for (int m = 0; m < 4; ++m)
#pragma unroll
      for (int n = 0; n < 4; ++n) {
        const int cc = nt * 128 + wc * 64 + n * 16 + fr;
        if (cc < DIN) {
#pragma unroll
          for (int j = 0; j < 4; ++j) {
            const int rr = mt * 128 + wr * 64 + m * 16 + fq * 4 + j;
            p[(long)rr * DIN + cc] = f2bf(acc[m][n][j]);
          }
        }
      }
  }
}

DI float rw_mixed(const bfr* p, int row, int c, const float* mu) {
  const long base = (long)row * DIN + HGC + c;
  const float pc = bf2f(p[base]);
  float nbv;
  if (row < T_LAT) {
    const int gr = row >> 6, gc = row & 63;
    float s = 0.f;
    if (gr > 0) s += bf2f(p[base - 64l * DIN]);
    if (gr < 255) s += bf2f(p[base + 64l * DIN]);
    if (gc > 0) s += bf2f(p[base - DIN]);
    if (gc < 63) s += bf2f(p[base + DIN]);
    nbv = 0.25f * s;
  } else {
    const int sidx = row - T_LAT;
    float s = 0.f;
    if (sidx > 0) s += bf2f(p[base - DIN]);
    if (sidx < T_CTX - 1) s += bf2f(p[base + DIN]);
    nbv = 0.5f * s;
  }
  return pc + (nbv - pc) * mu[c];
}

DI void rwkv_chain_naive(CParams& P, int chain, char* smem) {
  const int dir = chain >> 3, hd = chain & 7;
  const bfr* R = (const bfr*)(P.ws + WS_RW); const bfr* K = (const bfr*)(P.ws + WS_RW + RW_ARR); const bfr* V = (const bfr*)(P.ws + WS_RW + 2 * RW_ARR);
  const bfr* KK = (const bfr*)(P.ws + WS_RW + 3 * RW_ARR); const bfr* A = (const bfr*)(P.ws + WS_RW + 4 * RW_ARR);
  const float* LW = (const float*)(P.ws + WS_LW + (dir ? LW_ARR : 0));
  float* Y = (float*)(P.ws + WS_YRW) + (long)dir * T_LAT * 512;
  float* vec = (float*)smem;
  float* red = vec + 16 * 6 * 64;
  const int tid = VT, i = tid & 63, jq = tid >> 6;
  float S[16];
#pragma unroll
  for (int j = 0; j < 16; ++j) S[j] = 0.f;
  for (int s0 = 0; s0 < T_ALL; s0 += 16) {
    __syncthreads();
    for (int e = tid; e < 16 * 64; e += NTHR) {
      const int st = e >> 6, j = e & 63;
      const int s = s0 + st;
      int row;
      if (s < T_CTX) row = T_LAT + (dir ? (T_CTX - 1 - s) : s);
      else row = dir ? (T_LAT - 1 - (s - T_CTX)) : (s - T_CTX);
      const long o = (long)row * 512 + hd * 64 + j;
      float* vp = vec + st * 384;
      const float kk = bf2f(KK[o]);
      vp[j] = bf2f(R[o]); vp[64 + j] = __expf(LW[o]); vp[128 + j] = bf2f(K[o]); vp[192 + j] = bf2f(V[o]);
      vp[256 + j] = kk; vp[320 + j] = kk * bf2f(A[o]);
    }
    __syncthreads();
    for (int st = 0; st < 16; ++st) {
      const float* vp = vec + st * 384;
      const int par = st & 1;
      float sa = 0.f;
#pragma unroll
      for (int j = 0; j < 16; ++j) sa += S[j] * vp[256 + jq * 16 + j];
      red[(par * 2 + 0) * 256 + jq * 64 + i] = sa;
      __syncthreads();
      sa = red[(par * 2) * 256 + i] + red[(par * 2) * 256 + 64 + i] + red[(par * 2) * 256 + 128 + i] + red[(par * 2) * 256 + 192 + i];
      const float vi = vp[192 + i];
      float y = 0.f;
#pragma unroll
      for (int j = 0; j < 16; ++j) {
        const int jj = jq * 16 + j;
        S[j] = S[j] * vp[64 + jj] - sa * vp[320 + jj] + vi * vp[128 + jj];
        y += S[j] * vp[jj];
      }
      red[(par * 2 + 1) * 256 + jq * 64 + i] = y;
      __syncthreads();
      const int s = s0 + st;
      if (jq == 0 && s >= T_CTX) {
        y = red[(par * 2 + 1) * 256 + i] + red[(par * 2 + 1) * 256 + 64 + i] + red[(par * 2 + 1) * 256 + 128 + i] + red[(par * 2 + 1) * 256 + 192 + i];
        const int row = dir ? (T_LAT - 1 - (s - T_CTX)) : (s - T_CTX);
        Y[(long)row * 512 + hd * 64 + i] = y;
      }
    }
  }
}

DI void hgrn_chain_naive(CParams& P, int chain, char* smem) {
  const int dir = chain >> 2, hd = chain & 3;
  const bfr* p = (const bfr*)(P.ws + WS_P);
  const float* lb = (const float*)(P.ws + WS_LB) + dir * 512 + hd * 128;
  float* O = (float*)(P.ws + WS_OHG) + (long)dir * T_LAT * 512;
  float* vec = (float*)smem;
  float* red = vec + 16 * 4 * 128;
  const int tid = VT, e = tid & 127, dh = tid >> 7;
  float S[64];
#pragma unroll
  for (int d = 0; d < 64; ++d) S[d] = 0.f;
  for (int s0 = 0; s0 < T_ALL; s0 += 16) {
    __syncthreads();
    for (int x = tid; x < 16 * 128; x += NTHR) {
      const int st = x >> 7, d = x & 127;
      const int s = s0 + st;
      int row;
      if (s < T_CTX) row = T_LAT + (dir ? (T_CTX - 1 - s) : s);
      else row = dir ? (T_LAT - 1 - (s - T_CTX)) : (s - T_CTX);
      const bfr* pr = p + (long)row * DIN + hd * 128 + d;
      const float q = bf2f(pr[0]), iv = bf2f(pr[512]), z = bf2f(pr[1024 + dir * 512]);
      const float l = lb[d];
      const float f = l + (1.f - l) * sigmoidf_(z);
      float* vp = vec + st * 512;
      vp[d] = siluf_(q); vp[128 + d] = f; vp[256 + d] = (1.f - l) * sigmoidf_(-z); vp[384 + d] = iv;
    }
    __syncthreads();
    for (int st = 0; st < 16; ++st) {
      const float* vp = vec + st * 512;
      const int par = st & 1;
      const float ve = vp[384 + e];
      float o = 0.f;
#pragma unroll
      for (int d = 0; d < 64; ++d) {
        const int dd = dh * 64 + d;
        S[d] = S[d] * vp[128 + dd] + vp[256 + dd] * ve;
        o += vp[dd] * S[d];
      }
      red[par * 256 + dh * 128 + e] = o;
      __syncthreads();
      const int s = s0 + st;
      if (dh == 0 && s >= T_CTX) {
        o = red[par * 256 + e] + red[par * 256 + 128 + e];
        const int row = dir ? (T_LAT - 1 - (s - T_CTX)) : (s - T_CTX);
        O[(long)row * 512 + hd * 128 + e] = o;
      }
    }
  }
}

#define LDSP(T) __attribute__((address_space(3))) T*
DI int row_of_step(int dir, int s) {
  if (s < T_CTX) return T_LAT + (dir ? (T_CTX - 1 - s) : s);
  return dir ? (T_LAT - 1 - (s - T_CTX)) : (s - T_CTX);
}
DI bf16x8 ld_tr8(const short* base, int stride, int k0, int n0) {
  const int lane = VT & 63, g = lane >> 4, q = (lane & 15) >> 2, p = lane & 3;
  const short* a0 = base + (k0 + 8 * g + q) * stride + n0 + 4 * p;
  s16x4 lo = __builtin_amdgcn_ds_read_tr16_b64_v4i16((LDSP(s16x4))a0);
  s16x4 hi = __builtin_amdgcn_ds_read_tr16_b64_v4i16((LDSP(s16x4))(a0 + 4 * stride));
  return __builtin_shufflevector(lo, hi, 0, 1, 2, 3, 4, 5, 6, 7);
}
template <bool AT, bool BT>
DI f32x4 mm_tile(const short* A, int lda, int m0, const short* B, int ldb, int n0, int K, f32x4 acc) {
  const int lane = VT & 63, fr = lane & 15, fq = lane >> 4;
#ifdef SLOWMM
#pragma unroll
  for (int reg = 0; reg < 4; ++reg) {
    const int row = m0 + 4 * fq + reg, col = n0 + fr;
    float s = 0.f;
    for (int k = 0; k < K; ++k) {
      const float a = bf2f((bfr)(AT ? A[k * lda + row] : A[row * lda + k]));
      const float b = bf2f((bfr)(BT ? B[col * ldb + k] : B[k * ldb + col]));
      s += a * b;
    }
    acc[reg] += s;
  }
#else
  for (int k0 = 0; k0 < K; k0 += 32) {
    bf16x8 a, b;
    if (AT) a = ld_tr8(A, lda, k0, m0); else a = *(const bf16x8*)(A + (m0 + fr) * lda + k0 + fq * 8);
    if (BT) b = *(const bf16x8*)(B + (n0 + fr) * ldb + k0 + fq * 8); else b = ld_tr8(B, ldb, k0, n0);
    acc = __builtin_amdgcn_mfma_f32_16x16x32_bf16(a, b, acc, 0, 0, 0);
  }
#endif
  return acc;
}
DI void st_tile(short* C, int ldc, int m0, int n0, f32x4 acc) {
  const int lane = VT & 63, fr = lane & 15, fq = lane >> 4;
#pragma unroll
  for (int reg = 0; reg < 4; ++reg) C[(m0 + 4 * fq + reg) * ldc + n0 + fr] = (short)f2bf(acc[reg]);
}

constexpr int RW_NSC = 32;
DI int rw_sc_begin(int sc) { return sc * 16 + (sc < 8 ? sc : 8); }
DI int rw_sc_of_chunk(int ci) { return ci < 136 ? ci / 17 : 8 + (ci - 136) / 16; }
constexpr int XS = 72, SS = 40, GS = 72;
constexpr int RWL_XK = 0, RWL_XKB = 4608, RWL_XBB = 9216, RWL_XR = 13824, RWL_XV = 18432, RWL_S = 23040;
constexpr int RWL_GP = 38400, RWL_GQ = 47616, RWL_GAM = 56832, RWL_TOT = 57088, RWL_END = 58112;
constexpr size_t WS_PTOT = 6 * MB;
constexpr size_t WS_QTOT = 10 * MB;
constexpr size_t WS_SINRW = 18 * MB;
constexpr size_t WS_R2P = 350 * MB;
constexpr size_t WS_Y0P = 382 * MB;

constexpr int RTS = 40, RGS = 72;
constexpr int RWT_XK = 0, RWT_XKB = 5120, RWT_XBB = 10240, RWT_XR = 15360, RWT_XV = 20480, RWT_S = 25600;
constexpr int RWT_GP = 40960, RWT_GQ = 50176, RWT_GAM = 59392, RWT_TOT = 59648;
DI void st_tile_T(short* C, int ldc, int m0, int n0, f32x4 acc) {
  const int lane = (int)(threadIdx.x & 63), fr = lane & 15, fq = lane >> 4;
  *(uint2*)(C + (n0 + fr) * ldc + m0 + 4 * fq) = uint2{pack2(acc[0], acc[1]), pack2(acc[2], acc[3])};
}
DI void rw_levelA_item(CParams& P, int chain, int sc, char* smem) {
  const int dir = chain >> 3, hd = chain & 7;
  const bfr* Rg = (const bfr*)(P.ws + WS_RW); const bfr* Kg = (const bfr*)(P.ws + WS_RW + RW_ARR); const bfr* Vg = (const bfr*)(P.ws + WS_RW + 2 * RW_ARR);
  const bfr* KKg = (const bfr*)(P.ws + WS_RW + 3 * RW_ARR); const bfr* Ag = (const bfr*)(P.ws + WS_RW + 4 * RW_ARR);
  const float* LWg = (const float*)(P.ws + WS_LW + (dir ? LW_ARR : 0));
  bfr* R2P = (bfr*)(P.ws + WS_R2P) + (size_t)dir * T_LAT * 512;
  bfr* Y0P = (bfr*)(P.ws + WS_Y0P) + (size_t)dir * T_LAT * 512;
  short* XKt = (short*)(smem + RWT_XK); short* XKBt = (short*)(smem + RWT_XKB); short* XBBt = (short*)(smem + RWT_XBB);
  short* XRt = (short*)(smem + RWT_XR); short* XVt = (short*)(smem + RWT_XV);
  short* ZT = XRt; short* R2T = XRt; short* PcT = XKt;
  short* SLt = (short*)(smem + RWT_S); short* SAkkT = SLt + 32 * RTS; short* SAkrT = SAkkT + 32 * RTS; short* SMt = SAkrT + 32 * RTS;
  short* STt = SMt + 32 * RTS; short* SnAbrT = STt + 32 * RTS;
  short* W1T = SLt; short* W2T = SAkrT;
  short* GPT = (short*)(smem + RWT_GP); short* GQT = (short*)(smem + RWT_GQ);
  float* gam = (float*)(smem + RWT_GAM); float* tot = (float*)(smem + RWT_TOT);
  const int tid = VT, lane = tid & 63, w = tid >> 6, fr = lane & 15, fq = lane >> 4;
  const int tm = w >> 1, tn = w & 1;
  const int sgn = dir ? -1 : 1;
  const f32x4 z4 = {0.f, 0.f, 0.f, 0.f};
  __syncthreads();
  for (int i = tid; i < 64 * 64; i += NTHR) { const int r = i >> 6, c = i & 63; GPT[r * RGS + c] = (r == c) ? (short)0x3F80 : (short)0; GQT[r * RGS + c] = 0; }
  f32x4 pcum[4], qcum[4];
#pragma unroll
  for (int n = 0; n < 4; ++n) { pcum[n] = z4; qcum[n] = z4; }
  const int c_begin = rw_sc_begin(sc), c_end = rw_sc_begin(sc + 1);
  float pf_lw[8]; unsigned pf_rk[8], pf_vkk[8], pf_a[8];
#define RW_PREFETCH(cc) do { const long o0_ = (long)row_of_step(dir, (cc) * 32 + (tid >> 6) * 8) * 512 + hd * 64 + (tid & 63); \
      _Pragma("unroll") for (int e_ = 0; e_ < 8; ++e_) { const long o_ = o0_ + (long)(sgn * e_) * 512; \
      pf_lw[e_] = LWg[o_]; pf_rk[e_] = (unsigned)Rg[o_] | ((unsigned)Kg[o_] << 16); pf_vkk[e_] = (unsigned)Vg[o_] | ((unsigned)KKg[o_] << 16); pf_a[e_] = Ag[o_]; } } while (0)
  RW_PREFETCH(c_begin);
  for (int ci = c_begin; ci < c_end; ++ci) {
    __syncthreads();
    {
      const int j = tid & 63, qt = tid >> 6;
      float lam[8];
      float run = 0.f;
#pragma unroll
      for (int e = 0; e < 8; ++e) { run += pf_lw[e]; lam[e] = run; }
      tot[qt * 64 + j] = run;
      __syncthreads();
      float base = 0.f, total = 0.f;
#pragma unroll
      for (int q2 = 0; q2 < 4; ++q2) { const float tv = tot[q2 * 64 + j]; total += tv; if (q2 < qt) base += tv; }
      unsigned wk[4], wkb[4], wbb[4], wr_[4], wv[4];
#pragma unroll
      for (int e2 = 0; e2 < 4; ++e2) {
        float vk[2], vkb[2], vbb[2], vr[2];
#pragma unroll
        for (int u = 0; u < 2; ++u) {
          const int e = 2 * e2 + u;
          const float L = base + lam[e];
          const float eL = __expf(L), enL = frcp_(eL), eLp = eL * __expf(-pf_lw[e]);
          const float kkv = __uint_as_float(pf_vkk[e] & 0xffff0000u);
          vk[u] = kkv * eLp;
          vkb[u] = __uint_as_float(pf_rk[e] & 0xffff0000u) * enL;
          vbb[u] = kkv * __uint_as_float(pf_a[e] << 16) * enL;
          vr[u] = __uint_as_float(pf_rk[e] << 16) * eL;
        }
        wk[e2] = pack2(vk[0], vk[1]); wkb[e2] = pack2(vkb[0], vkb[1]); wbb[e2] = pack2(vbb[0], vbb[1]); wr_[e2] = pack2(vr[0], vr[1]);
        wv[e2] = (pf_vkk[2 * e2] & 0xffffu) | (pf_vkk[2 * e2 + 1] << 16);
      }
      const int co = j * RTS + 8 * qt;
      *(uint4*)(XKt + co) = uint4{wk[0], wk[1], wk[2], wk[3]};
      *(uint4*)(XKBt + co) = uint4{wkb[0], wkb[1], wkb[2], wkb[3]};
      *(uint4*)(XBBt + co) = uint4{wbb[0], wbb[1], wbb[2], wbb[3]};
      *(uint4*)(XRt + co) = uint4{wr_[0], wr_[1], wr_[2], wr_[3]};
      *(uint4*)(XVt + co) = uint4{wv[0], wv[1], wv[2], wv[3]};
      if (qt == 0) gam[j] = __expf(total);
      if (ci + 1 < c_end) RW_PREFETCH(ci + 1);
    }
    __syncthreads();
    f32x4 tacc; f32x4 rt[2];
    {
      f32x4 aL = mm_tile<true, false>(XKt, RTS, 16 * tm, XBBt, RTS, 16 * tn, 64, z4);
      f32x4 aKK = mm_tile<true, false>(XKt, RTS, 16 * tm, XKBt, RTS, 16 * tn, 64, z4);
      f32x4 aBR = mm_tile<true, false>(XRt, RTS, 16 * tm, XBBt, RTS, 16 * tn, 64, z4);
      f32x4 aKR = mm_tile<true, false>(XRt, RTS, 16 * tm, XKBt, RTS, 16 * tn, 64, z4);
#pragma unroll
      for (int reg = 0; reg < 4; ++reg) {
        const int row = 16 * tm + 4 * fq + reg, col = 16 * tn + fr;
        const bool st = col < row, inc = col <= row;
        aL[reg] = st ? aL[reg] : 0.f; aKK[reg] = st ? aKK[reg] : 0.f;
        aBR[reg] = inc ? -aBR[reg] : 0.f; aKR[reg] = inc ? aKR[reg] : 0.f;
        tacc[reg] = (row == col ? 1.f : 0.f) - aL[reg];
      }
      st_tile_T(SLt, RTS, 16 * tm, 16 * tn, aL); st_tile_T(STt, RTS, 16 * tm, 16 * tn, tacc);
      st_tile_T(SAkkT, RTS, 16 * tm, 16 * tn, aKK); st_tile_T(SnAbrT, RTS, 16 * tm, 16 * tn, aBR); st_tile_T(SAkrT, RTS, 16 * tm, 16 * tn, aKR);
#pragma unroll
      for (int i = 0; i < 2; ++i) rt[i] = ld4bf((const bfr*)(XRt + (16 * (2 * tn + i) + fr) * RTS + 16 * tm + 4 * fq));
    }
    __syncthreads();
    f32x4 y0[2];
    {
#pragma unroll
      for (int i = 0; i < 2; ++i) {
        f32x4 z = mm_tile<true, true>(SAkkT, RTS, 16 * tm, XVt, RTS, 16 * (2 * tn + i), 32, z4);
        st_tile_T(ZT, RTS, 16 * tm, 16 * (2 * tn + i), z);
        y0[i] = mm_tile<true, true>(SAkrT, RTS, 16 * tm, XVt, RTS, 16 * (2 * tn + i), 32, z4);
      }
      f32x4 m = mm_tile<true, true>(SLt, RTS, 16 * tm, SLt, RTS, 16 * tn, 32, z4);
      st_tile_T(SMt, RTS, 16 * tm, 16 * tn, m);
    }
    __syncthreads();
#pragma unroll 1
    for (int rd = 0; rd < 4; ++rd) {
      f32x4 tnew = mm_tile<true, true>(STt, RTS, 16 * tm, SMt, RTS, 16 * tn, 32, tacc);
      f32x4 mnew = z4;
      if (rd < 3) mnew = mm_tile<true, true>(SMt, RTS, 16 * tm, SMt, RTS, 16 * tn, 32, z4);
      __syncthreads();
      tacc = tnew;
      st_tile_T(STt, RTS, 16 * tm, 16 * tn, tacc);
      if (rd < 3) st_tile_T(SMt, RTS, 16 * tm, 16 * tn, mnew);
      __syncthreads();
    }
    {
      f32x4 w1[2], w2[2];
#pragma unroll
      for (int i = 0; i < 2; ++i) {
        w1[i] = mm_tile<true, true>(STt, RTS, 16 * tm, XKt, RTS, 16 * (2 * tn + i), 32, z4);
        w2[i] = mm_tile<true, true>(STt, RTS, 16 * tm, ZT, RTS, 16 * (2 * tn + i), 32, z4);
      }
#pragma unroll
      for (int i = 0; i < 2; ++i) { st_tile_T(W1T, RTS, 16 * tm, 16 * (2 * tn + i), w1[i]); st_tile_T(W2T, RTS, 16 * tm, 16 * (2 * tn + i), w2[i]); }
    }
    __syncthreads();
    f32x4 pa[4], qc[4], r2[2];
    {
#pragma unroll
      for (int n = 0; n < 4; ++n) {
        pa[n] = mm_tile<false, true>(W1T, RTS, 16 * w, XBBt, RTS, 16 * n, 32, z4);
        f32x4 qa = mm_tile<false, true>(XVt, RTS, 16 * w, XKBt, RTS, 16 * n, 32, z4);
        f32x4 qb = mm_tile<false, true>(W2T, RTS, 16 * w, XBBt, RTS, 16 * n, 32, z4);
        qc[n] = qa - qb;
      }
#pragma unroll
      for (int i = 0; i < 2; ++i) {
        r2[i] = mm_tile<true, true>(SnAbrT, RTS, 16 * tm, W1T, RTS, 16 * (2 * tn + i), 32, rt[i]);
        y0[i] = mm_tile<true, true>(SnAbrT, RTS, 16 * tm, W2T, RTS, 16 * (2 * tn + i), 32, y0[i]);
      }
    }
    __syncthreads();
    {
#pragma unroll
      for (int n = 0; n < 4; ++n) {
        const float gcol = gam[16 * n + fr];
        f32x4 pc;
#pragma unroll
        for (int reg = 0; reg < 4; ++reg) {
          const int row = 16 * w + 4 * fq + reg, col = 16 * n + fr;
          pc[reg] = ((row == col ? 1.f : 0.f) - pa[n][reg]) * gcol;
          qc[n][reg] *= gcol;
        }
        st_tile_T(PcT, RGS, 16 * w, 16 * n, pc);
      }
#pragma unroll
      for (int i = 0; i < 2; ++i) st_tile_T(R2T, RTS, 16 * tm, 16 * (2 * tn + i), r2[i]);
    }
    __syncthreads();
    {
      if (ci >= 8) {
        const long orow = (long)row_of_step(dir, ci * 32 + 16 * tm + 4 * fq) * 512 + hd * 64 + fr;
#pragma unroll
        for (int i = 0; i < 2; ++i) {
          f32x4 o1 = mm_tile<true, false>(R2T, RTS, 16 * tm, GPT, RGS, 16 * (2 * tn + i), 64, z4);
          f32x4 o2 = mm_tile<true, false>(R2T, RTS, 16 * tm, GQT, RGS, 16 * (2 * tn + i), 64, y0[i]);
#pragma unroll
          for (int reg = 0; reg < 4; ++reg) {
            const long o = orow + (long)(sgn * reg) * 512 + 16 * (2 * tn + i);
            R2P[o] = f2bf(o1[reg]); Y0P[o] = f2bf(o2[reg]);
          }
        }
      }
#pragma unroll
      for (int n = 0; n < 4; ++n) {
        pcum[n] = mm_tile<true, true>(GPT, RGS, 16 * w, PcT, RGS, 16 * n, 64, z4);
        qcum[n] = mm_tile<true, true>(GQT, RGS, 16 * w, PcT, RGS, 16 * n, 64, qc[n]);
      }
    }
    __syncthreads();
#pragma unroll
    for (int n = 0; n < 4; ++n) { st_tile_T(GPT, RGS, 16 * w, 16 * n, pcum[n]); st_tile_T(GQT, RGS, 16 * w, 16 * n, qcum[n]); }
  }
  {
    bfr* Pt = (bfr*)(P.ws + WS_PTOT) + (size_t)(chain * RW_NSC + sc) * 4096;
    float* Qt = (float*)(P.ws + WS_QTOT) + (size_t)(chain * RW_NSC + sc) * 4096;
#pragma unroll
    for (int n = 0; n < 4; ++n)
#pragma unroll
      for (int reg = 0; reg < 4; ++reg) {
        const int row = 16 * w + 4 * fq + reg, col = 16 * n + fr;
        Pt[row * 64 + col] = f2bf(pcum[n][reg]); Qt[row * 64 + col] = qcum[n][reg];
      }
  }
}

DI void rw_levelB_chain(CParams& P, int chain, char* smem) {
  short* SB = (short*)smem; short* PT = SB + 64 * GS;
  const bfr* Ptot = (const bfr*)(P.ws + WS_PTOT) + (size_t)chain * RW_NSC * 4096;
  const float* Qtot = (const float*)(P.ws + WS_QTOT) + (size_t)chain * RW_NSC * 4096;
  bfr* SIN = (bfr*)(P.ws + WS_SINRW) + (size_t)chain * (RW_NSC + 1) * 4096;
  const int tid = VT, lane = tid & 63, w = tid >> 6, fr = lane & 15, fq = lane >> 4;
  f32x4 S[4], qn[4];
  bf16x8 pn[2];
#pragma unroll
  for (int n = 0; n < 4; ++n) S[n] = f32x4{0.f, 0.f, 0.f, 0.f};
#pragma unroll
  for (int i = 0; i < 2; ++i) { const int e = tid + i * NTHR; pn[i] = *(const bf16x8*)(Ptot + (e >> 3) * 64 + (e & 7) * 8); }
#pragma unroll
  for (int n = 0; n < 4; ++n)
#pragma unroll
    for (int reg = 0; reg < 4; ++reg) qn[n][reg] = Qtot[(16 * w + 4 * fq + reg) * 64 + 16 * n + fr];
  for (int sc = 0; sc < RW_NSC; ++sc) {
    __syncthreads();
#pragma unroll
    for (int n = 0; n < 4; ++n) {
      st_tile(SB, GS, 16 * w, 16 * n, S[n]);
#pragma unroll
      for (int reg = 0; reg < 4; ++reg) SIN[(size_t)sc * 4096 + (16 * w + 4 * fq + reg) * 64 + 16 * n + fr] = f2bf(S[n][reg]);
    }
#pragma unroll
    for (int i = 0; i < 2; ++i) { const int e = tid + i * NTHR; *(bf16x8*)(PT + (e >> 3) * GS + (e & 7) * 8) = pn[i]; }
    f32x4 qc[4];
#pragma unroll
    for (int n = 0; n < 4; ++n) qc[n] = qn[n];
    __syncthreads();
    if (sc + 1 < RW_NSC) {
#pragma unroll
      for (int i = 0; i < 2; ++i) { const int e = tid + i * NTHR; pn[i] = *(const bf16x8*)(Ptot + (size_t)(sc + 1) * 4096 + (e >> 3) * 64 + (e & 7) * 8); }
#pragma unroll
      for (int n = 0; n < 4; ++n)
#pragma unroll
        for (int reg = 0; reg < 4; ++reg) qn[n][reg] = Qtot[(size_t)(sc + 1) * 4096 + (16 * w + 4 * fq + reg) * 64 + 16 * n + fr];
    }
#pragma unroll
    for (int n = 0; n < 4; ++n) S[n] = mm_tile<false, false>(SB, GS, 16 * w, PT, GS, 16 * n, 64, qc[n]);
  }
}

DI void rw_finish(CParams& P, int bid, int nb) {
  float* YM = P.out;
  const int tid = VT, lane = tid & 63, w = tid >> 6, fr = lane & 15, fq = lane >> 4;
  for (int it = bid; it < 512 * 4; it += nb) {
    const int tile = it >> 2, hp = it & 3;
    const int hd = hp * 2 + (w >> 1), tm = w & 1;
    const int t0 = tile * 32;
    f32x4 acc[4];
#pragma unroll
    for (int n = 0; n < 4; ++n) acc[n] = f32x4{0.f, 0.f, 0.f, 0.f};
#pragma unroll
    for (int dir = 0; dir < 2; ++dir) {
      const int ci = dir ? (519 - tile) : (8 + tile);
      const int sc = rw_sc_of_chunk(ci);
      const bfr* A = (const bfr*)(P.ws + WS_R2P) + (size_t)dir * T_LAT * 512 + (size_t)t0 * 512 + hd * 64;
      const bfr* Y0 = (const bfr*)(P.ws + WS_Y0P) + (size_t)dir * T_LAT * 512 + (size_t)t0 * 512 + hd * 64;
      const bfr* Sin = (const bfr*)(P.ws + WS_SINRW) + ((size_t)(dir * 8 + hd) * (RW_NSC + 1) + sc) * 4096;
#pragma unroll
      for (int n = 0; n < 4; ++n) {
#pragma unroll
        for (int k0 = 0; k0 < 64; k0 += 32) {
          bf16x8 a = *(const bf16x8*)(A + (size_t)(16 * tm + fr) * 512 + k0 + fq * 8);
          bf16x8 b = *(const bf16x8*)(Sin + (16 * n + fr) * 64 + k0 + fq * 8);
          acc[n] = __builtin_amdgcn_mfma_f32_16x16x32_bf16(a, b, acc[n], 0, 0, 0);
        }
#pragma unroll
        for (int reg = 0; reg < 4; ++reg) acc[n][reg] += bf2f(Y0[(size_t)(16 * tm + 4 * fq + reg) * 512 + 16 * n + fr]);
      }
    }
#pragma unroll
    for (int n = 0; n < 4; ++n)
#pragma unroll
      for (int reg = 0; reg < 4; ++reg) YM[(size_t)(t0 + 16 * tm + 4 * fq + reg) * 512 + hd * 64 + 16 * n + fr] = acc[n][reg];
  }
}

constexpr int HG_NSC = 64;
DI int hg_sc_begin(int sc) { return sc * 8 + (sc < 8 ? sc : 8); }
DI int hg_sc_of_chunk(int ci) { return ci < 72 ? ci / 9 : 8 + (ci - 72) / 8; }
constexpr int QS = 136;
constexpr int HGL_Q0 = 0, HGL_Q1 = 8704, HGL_KP = 13056, HGL_KH = 21760, HGL_VV = 30464, HGL_PM = 39168, HGL_STT = 41728;
constexpr int HGL_BL = 76544, HGL_TOT = 77056, HGL_END = 78080;
constexpr size_t WS_SINHG = 23 * MB;
constexpr size_t WS_QH = 414 * MB;
constexpr size_t WS_O0 = 446 * MB;
constexpr size_t WS_SLOC = 478 * MB;
constexpr size_t WS_DTOT = 510 * MB;

constexpr int HTS = 40, HT1S = 24;
constexpr int HGT_Q0 = 0, HGT_Q1 = 10240, HGT_KP = 16384, HGT_KH = 26624, HGT_VV = 36864, HGT_PM = 47104, HGT_BL = 49664, HGT_TOT = 50176;
DI bf16x8 ld_tr8p(const short* base, int stride, int k0, int n0) {
  const int lane = (int)(threadIdx.x & 63), g = lane >> 4, q = (lane & 15) >> 2, p = lane & 3;
  const short* a0 = base + (k0 + 4 * g + q) * stride + n0 + 4 * p;
  s16x4 lo = __builtin_amdgcn_ds_read_tr16_b64_v4i16((LDSP(s16x4))a0);
  s16x4 hi = __builtin_amdgcn_ds_read_tr16_b64_v4i16((LDSP(s16x4))(a0 + 16 * stride));
  return __builtin_shufflevector(lo, hi, 0, 1, 2, 3, 4, 5, 6, 7);
}
DI void hg_levelA_item(CParams& P, int chain, int sc, char* smem) {
  const int dir = chain >> 2, hd = chain & 3;
  const bfr* p = (const bfr*)(P.ws + WS_P);
  const float* lbp = (const float*)(P.ws + WS_LB) + dir * 512 + hd * 128;
  bfr* QH = (bfr*)(P.ws + WS_QH) + (size_t)dir * T_LAT * 512;
  bfr* O0 = (bfr*)(P.ws + WS_O0) + (size_t)dir * T_LAT * 512;
  short* Q0T = (short*)(smem + HGT_Q0); short* Q1T = (short*)(smem + HGT_Q1); short* KPT = (short*)(smem + HGT_KP);
  short* KHT = (short*)(smem + HGT_KH); short* VVT = (short*)(smem + HGT_VV); short* PMT = (short*)(smem + HGT_PM);
  float* BL = (float*)(smem + HGT_BL); float* tot = (float*)(smem + HGT_TOT);
  const int tid = VT, lane = tid & 63, w = tid >> 6, fr = lane & 15, fq = lane >> 4;
  const f32x4 z4 = {0.f, 0.f, 0.f, 0.f};
  f32x4 S[8][2];
#pragma unroll
  for (int m = 0; m < 8; ++m) { S[m][0] = z4; S[m][1] = z4; }
  const int d = tid & 127, hf = tid >> 7;
  const float lb = lbp[d];
  float dcum = 0.f;
  const int sgn = dir ? -1 : 1;
  const int c_begin = hg_sc_begin(sc), c_end = hg_sc_begin(sc + 1);
  unsigned qv[16]; bfr zr[16];
#define HG_PREFETCH(cc) do { const bfr* pr0_ = p + (size_t)row_of_step(dir, (cc) * 32 + hf * 16) * DIN + hd * 128 + d; \
      _Pragma("unroll") for (int e_ = 0; e_ < 16; ++e_) { const bfr* pr_ = pr0_ + (long)(sgn * e_) * DIN; \
      qv[e_] = (unsigned)pr_[0] | ((unsigned)pr_[512] << 16); zr[e_] = pr_[1024 + dir * 512]; } } while (0)
  HG_PREFETCH(c_begin);
  for (int ci = c_begin; ci < c_end; ++ci) {
    __syncthreads();
    {
      float lc[16], kv[16]; float run = 0.f;
#pragma unroll
      for (int e = 0; e < 16; ++e) {
        const float sg = sigmoidf_(bf2f(zr[e]));
        const float f = lb + (1.f - lb) * sg;
        kv[e] = (1.f - lb) * (1.f - sg);
        run += __logf(f); lc[e] = run;
      }
      tot[hf * 128 + d] = run;
      __syncthreads();
      const float tot0 = tot[d], tot1 = tot[128 + d];
      const float blast = tot0 + tot1;
      const float e0f = hf ? __expf(tot0) : 1.f;
      const float ehf = __expf(blast - (hf ? tot0 : 0.f));
      const float edc = __expf(dcum);
      bfr* qh0 = QH + (size_t)row_of_step(dir, ci * 32 + hf * 16) * 512 + hd * 128 + d;
#pragma unroll
      for (int hq = 0; hq < 2; ++hq) {
        unsigned q0w[4], q1w[4], kpw[4], khw[4], vvw[4];
#pragma unroll
        for (int e2 = 0; e2 < 4; ++e2) {
          float q0v[2], q1v[2], kpv[2], khv[2];
#pragma unroll
          for (int u = 0; u < 2; ++u) {
            const int e = 8 * hq + 2 * e2 + u;
            const float el = __expf(lc[e]), eil = frcp_(el);
            const float qs = siluf_(__uint_as_float(qv[e] << 16));
            q1v[u] = qs * el; q0v[u] = q1v[u] * e0f;
            kpv[u] = kv[e] * eil; khv[u] = kpv[u] * ehf;
            if (ci >= 8) qh0[(long)(sgn * e) * 512] = f2bf(q0v[u] * edc);
          }
          q0w[e2] = pack2(q0v[0], q0v[1]); q1w[e2] = pack2(q1v[0], q1v[1]); kpw[e2] = pack2(kpv[0], kpv[1]); khw[e2] = pack2(khv[0], khv[1]);
          vvw[e2] = (qv[8 * hq + 2 * e2] >> 16) | (qv[8 * hq + 2 * e2 + 1] & 0xffff0000u);
        }
        const int co = 16 * hf + 8 * hq;
        *(uint4*)(Q0T + d * HTS + co) = uint4{q0w[0], q0w[1], q0w[2], q0w[3]};
        if (hf) *(uint4*)(Q1T + d * HT1S + 8 * hq) = uint4{q1w[0], q1w[1], q1w[2], q1w[3]};
        *(uint4*)(KPT + d * HTS + co) = uint4{kpw[0], kpw[1], kpw[2], kpw[3]};
        *(uint4*)(KHT + d * HTS + co) = uint4{khw[0], khw[1], khw[2], khw[3]};
        *(uint4*)(VVT + d * HTS + co) = uint4{vvw[0], vvw[1], vvw[2], vvw[3]};
      }
      if (hf == 0) BL[d] = blast;
      dcum += blast;
      if (ci + 1 < c_end) HG_PREFETCH(ci + 1);
    }
    __syncthreads();
    {
      f32x4 pt = z4;
      if (w == 0) pt = mm_tile<true, false>(Q0T, HTS, 0, KPT, HTS, 0, 128, z4);
      else if (w == 1) pt = mm_tile<true, false>(Q0T, HTS, 16, KPT, HTS, 0, 128, z4);
      else if (w == 2) pt = mm_tile<true, false>(Q1T, HT1S, 0, KPT, HTS, 16, 128, z4);
      if (w == 0 || w == 2) {
#pragma unroll
        for (int reg = 0; reg < 4; ++reg) pt[reg] = (fr <= 4 * fq + reg) ? pt[reg] : 0.f;
      }
      const int ptm = (w == 0 || w == 3) ? 0 : 1, ptn = (w >= 2) ? 1 : 0;
      *(uint2*)(PMT + (16 * ptn + fr) * HTS + 16 * ptm + 4 * fq) = uint2{pack2(pt[0], pt[1]), pack2(pt[2], pt[3])};
    }
    __syncthreads();
    {
      bf16x8 vfr[2];
#pragma unroll
      for (int n = 0; n < 2; ++n) vfr[n] = *(const bf16x8*)(VVT + (32 * w + 16 * n + fr) * HTS + fq * 8);
      f32x4 o[2][2];
#pragma unroll
      for (int m = 0; m < 2; ++m) { o[m][0] = z4; o[m][1] = z4; }
#pragma unroll
      for (int ks = 0; ks < 4; ++ks) {
        bf16x8 sfr[2];
#pragma unroll
        for (int n = 0; n < 2; ++n) {
          typedef __attribute__((ext_vector_type(4))) unsigned u32x4_;
          u32x4_ wv = {pack2(S[2 * ks][n][0], S[2 * ks][n][1]), pack2(S[2 * ks][n][2], S[2 * ks][n][3]), pack2(S[2 * ks + 1][n][0], S[2 * ks + 1][n][1]), pack2(S[2 * ks + 1][n][2], S[2 * ks + 1][n][3])};
          sfr[n] = __builtin_bit_cast(bf16x8, wv);
        }
#pragma unroll
        for (int m = 0; m < 2; ++m) {
          const bf16x8 a = ld_tr8p(Q0T, HTS, 32 * ks, 16 * m);
#pragma unroll
          for (int n = 0; n < 2; ++n) o[m][n] = __builtin_amdgcn_mfma_f32_16x16x32_bf16(a, sfr[n], o[m][n], 0, 0, 0);
        }
      }
#pragma unroll
      for (int m = 0; m < 2; ++m) {
        const bf16x8 a = ld_tr8(PMT, HTS, 0, 16 * m);
#pragma unroll
        for (int n = 0; n < 2; ++n) {
          o[m][n] = __builtin_amdgcn_mfma_f32_16x16x32_bf16(a, vfr[n], o[m][n], 0, 0, 0);
          if (ci >= 8) {
            bfr* orow = O0 + (size_t)row_of_step(dir, ci * 32 + 16 * m + 4 * fq) * 512 + hd * 128 + 32 * w + 16 * n + fr;
#pragma unroll
            for (int reg = 0; reg < 4; ++reg) orow[(long)(sgn * reg) * 512] = f2bf(o[m][n][reg]);
          }
        }
      }
#pragma unroll
      for (int m = 0; m < 8; ++m) {
        const f32x4 bl = *(const f32x4*)(BL + 16 * m + 4 * fq);
        f32x4 sc4 = {__expf(bl[0]), __expf(bl[1]), __expf(bl[2]), __expf(bl[3])};
        const bf16x8 a = *(const bf16x8*)(KHT + (16 * m + fr) * HTS + fq * 8);
#pragma unroll
        for (int n = 0; n < 2; ++n) S[m][n] = __builtin_amdgcn_mfma_f32_16x16x32_bf16(a, vfr[n], S[m][n] * sc4, 0, 0, 0);
      }
    }
  }
  {
    float* SL_ = (float*)(P.ws + WS_SLOC) + (size_t)(chain * HG_NSC + sc) * 16384;
    float* DT = (float*)(P.ws + WS_DTOT) + (size_t)(chain * HG_NSC + sc) * 128;
#pragma unroll
    for (int m = 0; m < 8; ++m)
#pragma unroll
      for (int n = 0; n < 2; ++n) *(f32x4*)(SL_ + (32 * w + 16 * n + fr) * 128 + 16 * m + 4 * fq) = S[m][n];
    if (hf == 0) DT[d] = dcum;
  }
}

DI void hg_levelB(CParams& P, int bid, int nb) {
  const float* SLOC = (const float*)(P.ws + WS_SLOC); const float* DT = (const float*)(P.ws + WS_DTOT);
  bfr* SIN = (bfr*)(P.ws + WS_SINHG);
  for (int idx = bid * NTHR + VT; idx < 8 * 16384; idx += nb * NTHR) {
    const int chain = idx >> 14, ed = idx & 16383, dd = ed & 127;
    float s = 0.f;
    for (int sc = 0; sc < HG_NSC; ++sc) {
      const size_t item = (size_t)chain * HG_NSC + sc;
      SIN[item * 16384 + ed] = f2bf(s);
      s = __expf(DT[item * 128 + dd]) * s + SLOC[item * 16384 + ed];
    }
  }
}

DI void hg_finish(CParams& P, int bid, int nb, float* OM) {
  const int tid = VT, lane = tid & 63, w = tid >> 6, fr = lane & 15, fq = lane >> 4;
  for (int it = bid; it < 512 * 4; it += nb) {
    const int tile = it >> 2, hd = it & 3;
    const int t0 = tile * 32;
    f32x4 acc[2][2];
#pragma unroll
    for (int m = 0; m < 2; ++m) { acc[m][0] = f32x4{0.f, 0.f, 0.f, 0.f}; acc[m][1] = f32x4{0.f, 0.f, 0.f, 0.f}; }
#pragma unroll
    for (int dir = 0; dir < 2; ++dir) {
      const int ci = dir ? (519 - tile) : (8 + tile);
      const int sc = hg_sc_of_chunk(ci);
      const bfr* A = (const bfr*)(P.ws + WS_QH) + (size_t)dir * T_LAT * 512 + (size_t)t0 * 512 + hd * 128;
      const bfr* O0 = (const bfr*)(P.ws + WS_O0) + (size_t)dir * T_LAT * 512 + (size_t)t0 * 512 + hd * 128;
      const bfr* Sin = (const bfr*)(P.ws + WS_SINHG) + ((size_t)(dir * 4 + hd) * HG_NSC + sc) * 16384;
#pragma unroll
      for (int m = 0; m < 2; ++m)
#pragma unroll
        for (int n = 0; n < 2; ++n) {
#pragma unroll
          for (int k0 = 0; k0 < 128; k0 += 32) {
            bf16x8 a = *(const bf16x8*)(A + (size_t)(16 * m + fr) * 512 + k0 + fq * 8);
            bf16x8 b = *(const bf16x8*)(Sin + (32 * w + 16 * n + fr) * 128 + k0 + fq * 8);
            acc[m][n] = __builtin_amdgcn_mfma_f32_16x16x32_bf16(a, b, acc[m][n], 0, 0, 0);
          }
#pragma unroll
          for (int reg = 0; reg < 4; ++reg) acc[m][n][reg] += bf2f(O0[(size_t)(16 * m + 4 * fq + reg) * 512 + 32 * w + 16 * n + fr]);
        }
    }
#pragma unroll
    for (int m = 0; m < 2; ++m)
#pragma unroll
      for (int n = 0; n < 2; ++n)
#pragma unroll
        for (int reg = 0; reg < 4; ++reg) OM[(size_t)(t0 + 16 * m + 4 * fq + reg) * 512 + hd * 128 + 32 * w + 16 * n + fr] = acc[m][n][reg];
  }
}

constexpr size_t WS_LORA = 256 * 1024;
constexpr int LORA_WD2T = 0, LORA_WA2T = 2 * 512 * 32, LORA_WG2T = LORA_WA2T + 512 * 32;
DI void phase_lora_convert(CParams& P, int part, int nparts) {
  const float* wd2 = P.in[12]; const float* wa2 = P.in[14]; const float* wg2 = P.in[15];
  bfr* L = (bfr*)(P.ws + WS_LORA);
  for (int i = part * NTHR + VT; i < 2 * 512 * 32; i += nparts * NTHR) { const int d = i >> 14, c = (i >> 5) & 511, j = i & 31; L[LORA_WD2T + i] = f2bf(wd2[(d * 32 + j) * 512 + c]); }
  for (int i = part * NTHR + VT; i < 512 * 32; i += nparts * NTHR) { const int c = i >> 5, j = i & 31; L[LORA_WA2T + i] = f2bf(wa2[j * 512 + c]); }
  for (int i = part * NTHR + VT; i < 512 * 96; i += nparts * NTHR) { const int c = i / 96, j = i % 96; L[LORA_WG2T + i] = f2bf(wg2[j * 512 + c]); }
}
#define NB_DECL(row) \
  int nb_o0, nb_o1, nb_o2, nb_o3; float nb_f0, nb_f1, nb_f2, nb_f3, nb_scale; \
  { const int r_ = (row); const bool lat_ = r_ < T_LAT; const int gr_ = r_ >> 6, gc_ = r_ & 63, s_ = r_ - T_LAT; \
    const bool v0_ = lat_ && gr_ > 0, v1_ = lat_ && gr_ < 255, v2_ = lat_ ? gc_ > 0 : s_ > 0, v3_ = lat_ ? gc_ < 63 : s_ < T_CTX - 1; \
    nb_o0 = v0_ ? -64 * DIN : 0; nb_o1 = v1_ ? 64 * DIN : 0; nb_o2 = v2_ ? -DIN : 0; nb_o3 = v3_ ? DIN : 0; \
    nb_f0 = v0_ ? 1.f : 0.f; nb_f1 = v1_ ? 1.f : 0.f; nb_f2 = v2_ ? 1.f : 0.f; nb_f3 = v3_ ? 1.f : 0.f; nb_scale = lat_ ? 0.25f : 0.5f; }
#define MIX4(pc, mup) mix4_((pc), (mup), nb_o0, nb_o1, nb_o2, nb_o3, nb_f0, nb_f1, nb_f2, nb_f3, nb_scale)
DI f32x4 ld4bf(const bfr* p) {
  const uint2 u = *(const uint2*)p;
  return f32x4{__uint_as_float(u.x << 16), __uint_as_float(u.x & 0xffff0000u), __uint_as_float(u.y << 16), __uint_as_float(u.y & 0xffff0000u)};
}
DI f32x4 mix4_(const bfr* pc, const float* mu, int o0, int o1, int o2, int o3, float f0, float f1, float f2, float f3, float scale) {
  const f32x4 c = ld4bf(pc);
  f32x4 s = ld4bf(pc + o0) * f0 + ld4bf(pc + o1) * f1 + ld4bf(pc + o2) * f2 + ld4bf(pc + o3) * f3;
  const f32x4 m = *(const f32x4*)mu;
  return c + (s * scale - c) * m;
}
DI uint2 pk4(f32x4 v) { return uint2{pack2(v[0], v[1]), pack2(v[2], v[3])}; }
constexpr int LIS = 200;
DI void rwprep_tile(CParams& P, int tile, int unit0, int nunits, char* smem) {
  const bfr* p = (const bfr*)(P.ws + WS_P);
  const float* mu = P.in[10]; const float* w0 = P.in[11]; const float* a0 = P.in[13];
  const float* k_k = P.in[16]; const float* k_a = P.in[17];
  const bfr* LW_ = (const bfr*)(P.ws + WS_LORA);
  bfr* R = (bfr*)(P.ws + WS_RW); bfr* K = (bfr*)(P.ws + WS_RW + RW_ARR); bfr* V = (bfr*)(P.ws + WS_RW + 2 * RW_ARR);
  bfr* KK = (bfr*)(P.ws + WS_RW + 3 * RW_ARR); bfr* A = (bfr*)(P.ws + WS_RW + 4 * RW_ARR); bfr* G = (bfr*)(P.ws + WS_RW + 5 * RW_ARR);
  float* LWF = (float*)(P.ws + WS_LW); float* LWB = (float*)(P.ws + WS_LW + LW_ARR);
  short* LI = (short*)smem;
  const int tid = VT, lane = tid & 63, fr = lane & 15, fq = lane >> 4;
  const f32x4 z4 = {0.f, 0.f, 0.f, 0.f};
  const int row0 = tile * 32;
  __syncthreads();
  for (int v = tid; v < 32 * 24; v += NTHR) {
    const int t = v / 24, cg = v % 24;
    const int row = row0 + t;
    NB_DECL(row);
    const bfr* pc = p + (size_t)row * DIN + HGC + 1536 + cg * 8;
    f32x4 lo = MIX4(pc, mu + 1536 + cg * 8), hi = MIX4(pc + 4, mu + 1536 + cg * 8 + 4);
#pragma unroll
    for (int e = 0; e < 4; ++e) {
      if (cg < 8) { lo[e] = tanhf(lo[e]); hi[e] = tanhf(hi[e]); }
      else if (cg >= 12) { lo[e] = sigmoidf_(lo[e]); hi[e] = sigmoidf_(hi[e]); }
    }
    const uint2 a = pk4(lo), b = pk4(hi);
    *(uint4*)(LI + t * LIS + cg * 8) = uint4{a.x, a.y, b.x, b.y};
  }
  __syncthreads();
#pragma unroll 1
  for (int u = unit0; u < unit0 + nunits; ++u) {
    const int h = u >> 1, th = u & 1;
    const int row = row0 + 16 * th + fr;
    NB_DECL(row);
    f32x4 kkr[4], kraw[4], av[4];
    float ss = 0.f;
#pragma unroll
    for (int m = 0; m < 4; ++m) {
      const int c0 = 64 * h + 16 * m;
      const int ch = c0 + 4 * fq;
      const bfr* pc = p + (size_t)row * DIN + HGC + ch;
      const f32x4 r = MIX4(pc, mu + ch);
      kraw[m] = MIX4(pc + 512, mu + 512 + ch);
      const f32x4 v = MIX4(pc + 1024, mu + 1024 + ch);
      f32x4 aF = mm_tile<false, true>((const short*)(LW_ + LORA_WD2T), 32, c0, LI, LIS, 16 * th, 32, z4);
      f32x4 aB = mm_tile<false, true>((const short*)(LW_ + LORA_WD2T + 512 * 32), 32, c0, LI + 32, LIS, 16 * th, 32, z4);
      f32x4 aA = mm_tile<false, true>((const short*)(LW_ + LORA_WA2T), 32, c0, LI + 64, LIS, 16 * th, 32, z4);
      f32x4 aG = mm_tile<false, true>((const short*)(LW_ + LORA_WG2T), 96, c0, LI + 96, LIS, 16 * th, 96, z4);
      const size_t o = (size_t)row * 512 + ch;
      const f32x4 w0f = *(const f32x4*)(w0 + ch), w0b = *(const f32x4*)(w0 + 512 + ch), a0v = *(const f32x4*)(a0 + ch);
      f32x4 lwf, lwb;
#pragma unroll
      for (int e = 0; e < 4; ++e) {
        lwf[e] = -RW_DECAY_SCALE * sigmoidf_(w0f[e] + aF[e]);
        lwb[e] = -RW_DECAY_SCALE * sigmoidf_(w0b[e] + aB[e]);
        av[m][e] = sigmoidf_(a0v[e] + aA[e]);
      }
      *(f32x4*)(LWF + o) = lwf; *(f32x4*)(LWB + o) = lwb;
      *(uint2*)(G + o) = pk4(aG);
      *(uint2*)(A + o) = pk4(av[m]);
      *(uint2*)(R + o) = pk4(r); *(uint2*)(V + o) = pk4(v);
      kkr[m] = kraw[m] * *(const f32x4*)(k_k + ch);
      ss += kkr[m][0] * kkr[m][0] + kkr[m][1] * kkr[m][1] + kkr[m][2] * kkr[m][2] + kkr[m][3] * kkr[m][3];
    }
    ss += __shfl_xor(ss, 16); ss += __shfl_xor(ss, 32);
    const float rn = rsqrtf(fmaxf(ss, 1e-12f));
#pragma unroll
    for (int m = 0; m < 4; ++m) {
      const int ch = 64 * h + 16 * m + 4 * fq;
      const size_t o = (size_t)row * 512 + ch;
      const f32x4 ka = *(const f32x4*)(k_a + ch);
      f32x4 kv;
#pragma unroll
      for (int e = 0; e < 4; ++e) kv[e] = kraw[m][e] * (1.f + (av[m][e] - 1.f) * ka[e]);
      *(uint2*)(K + o) = pk4(kv);
      *(uint2*)(KK + o) = pk4(kkr[m] * rn);
    }
  }
}
DI void phase_rwprep(CParams& P, int bid, int nb, char* smem) {
  const int w = VT >> 6;
  for (int it = bid; it < (T_ALL / 32) * 4; it += nb) rwprep_tile(P, it >> 2, (it & 3) * 4 + w, 1, smem);
}

DI void phase_readout(CParams& P, int bid, int nb) {
  const bfr* p = (const bfr*)(P.ws + WS_P);
  const float* Of = P.out + (size_t)T_LAT * 512;
  const float* Yf = P.out;
  const bfr* R = (const bfr*)(P.ws + WS_RW); const bfr* K = (const bfr*)(P.ws + WS_RW + RW_ARR); const bfr* V = (const bfr*)(P.ws + WS_RW + 2 * RW_ARR);
  const bfr* G = (const bfr*)(P.ws + WS_RW + 5 * RW_ARR);
  const float* hg_norm_w = P.in[9]; const float* r_k = P.in[18]; const float* gn_w = P.in[19]; const float* gn_b = P.in[20];
  bfr* mix = (bfr*)(P.ws + WS_H);
  const int wid = VT >> 6, lane = VT & 63;
  for (int t = bid * 4 + wid; t < T_LAT; t += nb * 4) {
    {
      float o[8]; float ss = 0.f;
#pragma unroll
      for (int e = 0; e < 8; ++e) { const long idx = (long)t * 512 + lane * 8 + e; o[e] = Of[idx]; ss += o[e] * o[e]; }
      ss += __shfl_xor(ss, 1); ss += __shfl_xor(ss, 2); ss += __shfl_xor(ss, 4); ss += __shfl_xor(ss, 8);
      const float rs = rsqrtf(ss * (1.f / 128.f) + 1e-6f);
      unsigned w[4];
#pragma unroll
      for (int e = 0; e < 8; e += 2) {
        const int c0 = lane * 8 + e;
        const float g0 = bf2f(p[(long)t * DIN + 2048 + c0]), g1 = bf2f(p[(long)t * DIN + 2048 + c0 + 1]);
        const float v0 = o[e] * rs * hg_norm_w[c0] * siluf_(g0);
        const float v1 = o[e + 1] * rs * hg_norm_w[c0 + 1] * siluf_(g1);
        w[e >> 1] = pack2(v0, v1);
      }
      *(uint4*)(mix + (long)t * DM + lane * 8) = uint4{w[0], w[1], w[2], w[3]};
    }
    {
      float y[8]; float s = 0.f, bs = 0.f;
      float vv[8];
#pragma unroll
      for (int e = 0; e < 8; ++e) {
        const long idx = (long)t * 512 + lane * 8 + e;
        y[e] = Yf[idx]; s += y[e];
        bs += bf2f(R[idx]) * bf2f(K[idx]) * r_k[lane * 8 + e];
        vv[e] = bf2f(V[idx]);
      }
      s += __shfl_xor(s, 1); s += __shfl_xor(s, 2); s += __shfl_xor(s, 4);
      bs += __shfl_xor(bs, 1); bs += __shfl_xor(bs, 2); bs += __shfl_xor(bs, 4);
      const float mu = s * (1.f / 64.f);
      float q = 0.f;
#pragma unroll
      for (int e = 0; e < 8; ++e) { y[e] -= mu; q += y[e] * y[e]; }
      q += __shfl_xor(q, 1); q += __shfl_xor(q, 2); q += __shfl_xor(q, 4);
      const float rs = rsqrtf(q * (1.f / 64.f) + 64e-5f);
      unsigned w[4];
#pragma unroll
      for (int e = 0; e < 8; e += 2) {
        const int c0 = lane * 8 + e;
        const long idx = (long)t * 512 + c0;
        const float v0 = (y[e] * rs * gn_w[c0] + gn_b[c0] + bs * vv[e]) * bf2f(G[idx]);
        const float v1 = (y[e + 1] * rs * gn_w[c0 + 1] + gn_b[c0 + 1] + bs * vv[e + 1]) * bf2f(G[idx + 1]);
        w[e >> 1] = pack2(v0, v1);
      }
      *(uint4*)(mix + (long)t * DM + 512 + lane * 8) = uint4{w[0], w[1], w[2], w[3]};
    }
  }
}

DI void phase_outproj(CParams& P, int bid, int nb, char* smem) {
  const bfr* mix = (const bfr*)(P.ws + WS_H);
  const float* w_out = P.in[7];
  float* y = (float*)(P.ws + WS_Y);
  short* sA = (short*)smem; short* sB = sA + 128 * LSTR;
  const int tid = VT, wid = tid >> 6, lane = tid & 63;
  const int wr = wid >> 1, wc = wid & 1, fr = lane & 15, fq = lane >> 4;
  constexpr int NT = 8, MT = T_LAT / 128;
  for (int it = bid; it < NT * MT; it += nb) {
    const int mt = it / NT, nt = it % NT;
    ALoadBf16 al; BLoadF32 bl;
#pragma unroll
    for (int i = 0; i < 4; ++i) al.rp[i] = mix + (long)(mt * 128 + (tid >> 3) + 32 * i) * DM + (tid & 7) * 8;
    bl.valid = true; bl.ldb = DM;
    bl.p = w_out + (long)((tid & 7) * 8) * DM + nt * 128 + (tid >> 3) * 4;
    f32x4 acc[4][4];
    gemm_mainloop(sA, sB, DM / 64, al, bl, acc);
#pragma unroll
    for (int m = 0; m < 4; ++m)
#pragma unroll
      for (int n = 0; n < 4; ++n)
#pragma unroll
        for (int j = 0; j < 4; ++j) {
          const int rr = mt * 128 + wr * 64 + m * 16 + fq * 4 + j, cc = nt * 128 + wc * 64 + n * 16 + fr;
          y[(long)rr * DM + cc] = acc[m][n][j];
        }
  }
}

constexpr size_t WS_WRT = 512 * 1024;
DI void phase_wrt_convert(CParams& P, int part, int nparts) {
  const float* wgrp = P.in[25]; const float* wrt = P.in[27];
  bfr* Whi = (bfr*)(P.ws + WS_WRT); bfr* Wlo = Whi + 80 * 1024;
  for (int i = part * NTHR + VT; i < 80 * 1024; i += nparts * NTHR) {
    const int o = i >> 10, k = i & 1023;
    float wv = 0.f;
    if (o < 8) wv = wgrp[k * 8 + o]; else if (o < 72) wv = wrt[k * 64 + (o - 8)];
    const bfr hi = f2bf(wv);
    Whi[i] = hi; Wlo[i] = f2bf(wv - bf2f(hi));
  }
}
constexpr int HLS = 1032;
DI void phase_ln2route(CParams& P, char* smem_all) {
  const float* x = P.in[0];
  const bfr* y = (const bfr*)(P.ws + WS_Y);
  const float* mod = (const float*)(P.ws + WS_MOD);
  const float* ln1_g = P.in[21]; const float* ln1_b = P.in[22];
  const float* bgrp = P.in[26]; const float* brt = P.in[28];
  const bfr* Whi = (const bfr*)(P.ws + WS_WRT); const bfr* Wlo = Whi + 80 * 1024;
  bfr* x1 = (bfr*)(P.ws + WS_X1B);
  bfr* h2 = (bfr*)(P.ws + WS_H2);
  int* cnt = (int*)(P.ws + WS_CNT); int* list = (int*)(P.ws + WS_LIST); float* asgw = (float*)(P.ws + WS_ASGW);
  short* HI = (short*)smem_all; short* LO = HI + 32 * HLS;
  float* LG = (float*)(smem_all + 2 * 32 * HLS * 2);
  float* PS = LG + 32 * 80;
  const int tid = tx_(), wid = tid >> 6, lane = tid & 63, fr = lane & 15, fq = lane >> 4;
  for (int grp = blockIdx.x; grp < T_LAT / 32; grp += gridDim.x) {
    const int t0 = grp * 32;
    __syncthreads();
    f32x4 xin[4][4]; uint2 yin[4][4];
#pragma unroll
    for (int tt = 0; tt < 4; ++tt)
#pragma unroll
      for (int i = 0; i < 4; ++i) {
        const long o = (long)(t0 + wid * 4 + tt) * DM + lane * 4 + 256 * i;
        xin[tt][i] = *(const f32x4*)(x + o); yin[tt][i] = *(const uint2*)(y + o);
      }
#pragma unroll
    for (int tt = 0; tt < 4; ++tt) {
      const int tl = wid * 4 + tt, t = t0 + tl;
      f32x4 v[4]; float s = 0.f;
#pragma unroll
      for (int i = 0; i < 4; ++i) {
        const int c = lane * 4 + 256 * i;
        const f32x4 g1 = *(const f32x4*)(mod + 2048 + c);
        const uint2 u = yin[tt][i];
        const f32x4 yv = {__uint_as_float(u.x << 16), __uint_as_float(u.x & 0xffff0000u), __uint_as_float(u.y << 16), __uint_as_float(u.y & 0xffff0000u)};
        v[i] = xin[tt][i] * DN_ALPHA + g1 * yv;
        s += v[i][0] + v[i][1] + v[i][2] + v[i][3];
      }
      float mu = wave_sum(s) * (1.f / DM); float q = 0.f;
#pragma unroll
      for (int i = 0; i < 4; ++i) { v[i] -= mu; q += v[i][0] * v[i][0] + v[i][1] * v[i][1] + v[i][2] * v[i][2] + v[i][3] * v[i][3]; }
      float rs = rsqrtf(wave_sum(q) * (1.f / DM) + 1e-5f);
      s = 0.f;
#pragma unroll
      for (int i = 0; i < 4; ++i) {
        const int c = lane * 4 + 256 * i;
        f32x4 g = *(const f32x4*)(ln1_g + c), b = *(const f32x4*)(ln1_b + c);
        v[i] = v[i] * rs * g + b;
        *(uint2*)(x1 + (long)t * DM + c) = pk4(v[i]);
        s += v[i][0] + v[i][1] + v[i][2] + v[i][3];
      }
      mu = wave_sum(s) * (1.f / DM); q = 0.f;
#pragma unroll
      for (int i = 0; i < 4; ++i) { v[i] -= mu; q += v[i][0] * v[i][0] + v[i][1] * v[i][1] + v[i][2] * v[i][2] + v[i][3] * v[i][3]; }
      rs = rsqrtf(wave_sum(q) * (1.f / DM) + 1e-5f);
#pragma unroll
      for (int i = 0; i < 4; ++i) {
        const int c = lane * 4 + 256 * i;
        f32x4 sh = *(const f32x4*)(mod + 3072 + c), sc = *(const f32x4*)(mod + 4096 + c);
        v[i] = v[i] * rs * (sc + 1.f) + sh;
        const uint2 whi = {pack2(v[i][0], v[i][1]), pack2(v[i][2], v[i][3])};
        f32x4 r;
        r[0] = v[i][0] - __uint_as_float(whi.x << 16); r[1] = v[i][1] - __uint_as_float(whi.x & 0xffff0000u);
        r[2] = v[i][2] - __uint_as_float(whi.y << 16); r[3] = v[i][3] - __uint_as_float(whi.y & 0xffff0000u);
        const uint2 wlo = {pack2(r[0], r[1]), pack2(r[2], r[3])};
        *(uint2*)(h2 + (long)t * DM + c) = whi;
        *(uint2*)(HI + tl * HLS + c) = whi;
        *(uint2*)(LO + tl * HLS + c) = wlo;
      }
    }
    __syncthreads();
    {
      const int own = wid < 4;
      const int mrow = own ? 16 * wid : 64;
      f32x4 acc0 = {0.f, 0.f, 0.f, 0.f}, acc1 = {0.f, 0.f, 0.f, 0.f};
      bf16x8 a[8], an[8];
      const int nbatch = own ? 12 : 3;
#define RT_LOAD(bi_, dst) do { const int ps_ = own ? ((bi_) >> 2) : (bi_), kb_ = own ? (((bi_) & 3) * 8) : ((wid - 4) * 8); const bfr* Wp_ = ps_ == 1 ? Wlo : Whi; \
        _Pragma("unroll") for (int u = 0; u < 8; ++u) dst[u] = *(const bf16x8*)(Wp_ + (size_t)(mrow + fr) * 1024 + (kb_ + u) * 32 + fq * 8); } while (0)
      RT_LOAD(0, a);
#pragma unroll 1
      for (int bi = 0; bi < nbatch; ++bi) {
        if (bi + 1 < nbatch) RT_LOAD(bi + 1, an);
        const int ps = own ? (bi >> 2) : bi, kb = own ? ((bi & 3) * 8) : ((wid - 4) * 8);
        const short* Hp = ps == 2 ? LO : HI;
#pragma unroll
        for (int u = 0; u < 8; ++u) {
          const bf16x8 b0 = *(const bf16x8*)(Hp + fr * HLS + (kb + u) * 32 + fq * 8);
          const bf16x8 b1 = *(const bf16x8*)(Hp + (16 + fr) * HLS + (kb + u) * 32 + fq * 8);
          acc0 = __builtin_amdgcn_mfma_f32_16x16x32_bf16(a[u], b0, acc0, 0, 0, 0);
          acc1 = __builtin_amdgcn_mfma_f32_16x16x32_bf16(a[u], b1, acc1, 0, 0, 0);
        }
#pragma unroll
        for (int u = 0; u < 8; ++u) a[u] = an[u];
      }
#undef RT_LOAD
      if (own) {
#pragma unroll
        for (int reg = 0; reg < 4; ++reg) { LG[fr * 80 + mrow + 4 * fq + reg] = acc0[reg]; LG[(16 + fr) * 80 + mrow + 4 * fq + reg] = acc1[reg]; }
      } else {
#pragma unroll
        for (int reg = 0; reg < 4; ++reg) { PS[((wid - 4) * 32 + fr) * 16 + 4 * fq + reg] = acc0[reg]; PS[((wid - 4) * 32 + 16 + fr) * 16 + 4 * fq + reg] = acc1[reg]; }
      }
    }
    __syncthreads();
    {
      const int tk = tid >> 4, o = tid & 15;
      LG[tk * 80 + 64 + o] = (PS[(0 * 32 + tk) * 16 + o] + PS[(1 * 32 + tk) * 16 + o]) + (PS[(2 * 32 + tk) * 16 + o] + PS[(3 * 32 + tk) * 16 + o]);
    }
    __syncthreads();
    if (tid < 32) {
      const int t = t0 + tid;
      const float* lg = LG + tid * 80;
      int gi = 0; float gmax = -3.4e38f; float gl[8];
#pragma unroll
      for (int g = 0; g < 8; ++g) { gl[g] = lg[g] + bgrp[g]; if (gl[g] > gmax) { gmax = gl[g]; gi = g; } }
      float den = 0.f;
#pragma unroll
      for (int g = 0; g < 8; ++g) den += __expf(gl[g] - gmax);
      const float gprob = 1.f / den;
      int i1 = 0; float v1 = -3.4e38f; float el[8];
#pragma unroll
      for (int g = 0; g < 8; ++g) { el[g] = lg[8 + gi * 8 + g] + brt[gi * 8 + g]; if (el[g] > v1) { v1 = el[g]; i1 = g; } }
      int i2 = 0; float v2 = -3.4e38f;
#pragma unroll
      for (int g = 0; g < 8; ++g) { if (g != i1 && el[g] > v2) { v2 = el[g]; i2 = g; } }
      const float e2 = __expf(v2 - v1);
      const float wt1 = gprob / (1.f + e2), wt2 = gprob * e2 / (1.f + e2);
      const int ex1 = gi * 8 + i1, ex2 = gi * 8 + i2;
      int s1 = atomicAdd(&cnt[ex1], 1); list[ex1 * T_LAT + s1] = t * 2;
      int s2 = atomicAdd(&cnt[ex2], 1); list[ex2 * T_LAT + s2] = t * 2 + 1;
      asgw[t * 2] = wt1; asgw[t * 2 + 1] = wt2;
    }
  }
}

DI void moe_block_table(CParams& P, int* tab  ) {
  const int* cnt = (const int*)(P.ws + WS_CNT);
  const int tid = VT;
  __syncthreads();
  if (tid < 64) {
    int nbk = (cnt[tid] + 127) >> 7;
    int incl = nbk;
#pragma unroll
    for (int o = 1; o < 64; o <<= 1) { int u = __shfl_up(incl, o); if (tid >= o) incl += u; }
    tab[tid + 1] = incl;
    if (tid == 0) tab[0] = 0;
  }
  __syncthreads();
}
DI int moe_find_expert(const int* tab, int rb) {
  int e = 0;
  while (tab[e + 1] <= rb) ++e;
  return e;
}

DI void phase_moe1(CParams& P, int bid, int nb, char* smem) {
  const bfr* h2 = (const bfr*)(P.ws + WS_H2);
  const int* cnt = (const int*)(P.ws + WS_CNT); const int* list = (const int*)(P.ws + WS_LIST);
  const float* wg = P.in[29]; const float* wu = P.in[30];
  bfr* hid = (bfr*)(P.ws + WS_HID);
  short* sA = (short*)smem; short* sB = sA + 128 * LSTR;
  int* tab = (int*)(smem + GEMM_LDS_BYTES);
  const int tid = VT, wid = tid >> 6, lane = tid & 63;
  const int wr = wid >> 1, wc = wid & 1, fr = lane & 15, fq = lane >> 4;
  moe_block_table(P, tab);
  const int nrb = tab[64];
  for (int it = bid; it < nrb * 8; it += nb) {
    const int rb = it >> 3, nt = it & 7;
    const int e = moe_find_expert(tab, rb);
    const int lrb = rb - tab[e];
    const int ce = cnt[e];
    ALoadBf16 al; BLoadF32 bl;
#pragma unroll
    for (int i = 0; i < 4; ++i) {
      int r = lrb * 128 + (tid >> 3) + 32 * i;
      if (r >= ce) r = ce - 1;
      const int tok = list[e * T_LAT + r] >> 1;
      al.rp[i] = h2 + (long)tok * DM + (tid & 7) * 8;
    }
    const int n4 = tid >> 3;
    const int isup = (n4 >> 3) & 1;
    const int col = nt * 64 + (n4 >> 4) * 32 + ((4 * n4) & 31);
    bl.valid = true; bl.ldb = DEXP;
    bl.p = (isup ? wu : wg) + (long)e * DM * DEXP + (long)((tid & 7) * 8) * DEXP + col;
    f32x4 acc[4][4];
    gemm_mainloop(sA, sB, DM / 64, al, bl, acc);
#pragma unroll
    for (int m = 0; m < 4; ++m)
#pragma unroll
      for (int n = 0; n < 2; ++n)
#pragma unroll
        for (int j = 0; j < 4; ++j) {
          const int rl = wr * 64 + m * 16 + fq * 4 + j;
          const int cc = nt * 64 + wc * 32 + n * 16 + fr;
          const float gv = acc[m][n][j], uv = acc[m][n + 2][j];
          hid[((long)rb * 128 + rl) * DEXP + cc] = f2bf(siluf_(gv) * uv);
        }
  }
}

DI void phase_moe2(CParams& P, int bid, int nb, char* smem) {
  const int* cnt = (const int*)(P.ws + WS_CNT); const int* list = (const int*)(P.ws + WS_LIST);
  const float* wd = P.in[31];
  const bfr* hid = (const bfr*)(P.ws + WS_HID);
  bfr* mout = (bfr*)(P.ws + WS_MOUT);
  short* sA = (short*)smem; short* sB = sA + 128 * LSTR;
  int* tab = (int*)(smem + GEMM_LDS_BYTES);
  const int tid = VT, wid = tid >> 6, lane = tid & 63;
  const int wr = wid >> 1, wc = wid & 1, fr = lane & 15, fq = lane >> 4;
  moe_block_table(P, tab);
  const int nrb = tab[64];
  for (int it = bid; it < nrb * 8; it += nb) {
    const int rb = it >> 3, nt = it & 7;
    const int e = moe_find_expert(tab, rb);
    const int lrb = rb - tab[e];
    const int ce = cnt[e];
    ALoadBf16 al; BLoadF32 bl;
#pragma unroll
    for (int i = 0; i < 4; ++i) al.rp[i] = hid + ((long)rb * 128 + (tid >> 3) + 32 * i) * DEXP + (tid & 7) * 8;
    bl.valid = true; bl.ldb = DM;
    bl.p = wd + (long)e * DEXP * DM + (long)((tid & 7) * 8) * DM + nt * 128 + (tid >> 3) * 4;
    f32x4 acc[4][4];
    gemm_mainloop(sA, sB, DEXP / 64, al, bl, acc);
#pragma unroll
    for (int m = 0; m < 4; ++m)
#pragma unroll
      for (int j = 0; j < 4; ++j) {
        const int r = lrb * 128 + wr * 64 + m * 16 + fq * 4 + j;
        if (r < ce) {
          const int asg = list[e * T_LAT + r];
#pragma unroll
          for (int n = 0; n < 4; ++n) mout[(long)asg * DM + nt * 128 + wc * 64 + n * 16 + fr] = f2bf(acc[m][n][j]);
        }
      }
  }
}

DI void phase_final(CParams& P, int bid, int nb) {
  const float* mod = (const float*)(P.ws + WS_MOD);
  const float* ln2_g = P.in[23]; const float* ln2_b = P.in[24];
  const bfr* mout = (const bfr*)(P.ws + (42ull << 20));
  const bfr* x1b = (const bfr*)(P.ws + WS_X1B);
  const float* asgw = (const float*)(P.ws + WS_ASGW);
  float* out = P.out;
  const int wid = VT >> 6, lane = VT & 63;
  for (int t0 = (bid * 4 + wid) * 2; t0 < T_LAT; t0 += nb * 8) {
    f32x4 v[2][4]; float s[2] = {0.f, 0.f};
#pragma unroll
    for (int r = 0; r < 2; ++r) {
      const int t = t0 + r;
      const float w1 = asgw[t * 2], w2 = asgw[t * 2 + 1];
#pragma unroll
      for (int i = 0; i < 4; ++i) {
        const int c = lane * 4 + 256 * i;
        const f32x4 xv = ld4bf(x1b + (long)t * DM + c), g2 = *(const f32x4*)(mod + 5120 + c);
        const f32x4 a = ld4bf(mout + (long)(2 * t) * DM + c), b = ld4bf(mout + (long)(2 * t + 1) * DM + c);
        v[r][i] = xv * DN_ALPHA + g2 * (a * w1 + b * w2);
        s[r] += v[r][i][0] + v[r][i][1] + v[r][i][2] + v[r][i][3];
      }
    }
#pragma unroll
    for (int r = 0; r < 2; ++r) {
      const float mu = wave_sum(s[r]) * (1.f / DM); float q = 0.f;
#pragma unroll
      for (int i = 0; i < 4; ++i) { v[r][i] -= mu; q += v[r][i][0] * v[r][i][0] + v[r][i][1] * v[r][i][1] + v[r][i][2] * v[r][i][2] + v[r][i][3] * v[r][i][3]; }
      const float rs = rsqrtf(wave_sum(q) * (1.f / DM) + 1e-5f);
#pragma unroll
      for (int i = 0; i < 4; ++i) {
        const int c = lane * 4 + 256 * i;
        f32x4 g = *(const f32x4*)(ln2_g + c), b = *(const f32x4*)(ln2_b + c);
        *(f32x4*)(out + (long)(t0 + r) * DM + c) = v[r][i] * rs * g + b;
      }
    }
  }
}

DI void phase_readout_fused(CParams& P, int bid, int nb) {
  const bfr* p = (const bfr*)(P.ws + WS_P);
  const bfr* R = (const bfr*)(P.ws + WS_RW); const bfr* K = (const bfr*)(P.ws + WS_RW + RW_ARR); const bfr* V = (const bfr*)(P.ws + WS_RW + 2 * RW_ARR);
  const bfr* G = (const bfr*)(P.ws + WS_RW + 5 * RW_ARR);
  const float* hg_norm_w = P.in[9]; const float* r_k = P.in[18]; const float* gn_w = P.in[19]; const float* gn_b = P.in[20];
  bfr* mix = (bfr*)(P.ws + WS_MIX);
  const int tid = VT, lane = tid & 63, w = tid >> 6, fr = lane & 15, fq = lane >> 4;
  const f32x4 z4 = {0.f, 0.f, 0.f, 0.f};
  for (int tile = bid; tile < T_LAT / 32; tile += nb) {
    const int t0 = tile * 32;
#pragma unroll 1
    for (int hh = 0; hh < 2; ++hh) {
      const int hd = 2 * w + hh;
      f32x4 acc[4][2];
#pragma unroll
      for (int m = 0; m < 4; ++m) { acc[m][0] = z4; acc[m][1] = z4; }
#pragma unroll
      for (int dir = 0; dir < 2; ++dir) {
        const int ci = dir ? (519 - tile) : (8 + tile);
        const int sc = rw_sc_of_chunk(ci);
        const bfr* Bq = (const bfr*)(P.ws + WS_R2P) + (size_t)dir * T_LAT * 512 + (size_t)t0 * 512 + hd * 64;
        const bfr* Y0 = (const bfr*)(P.ws + WS_Y0P) + (size_t)dir * T_LAT * 512 + (size_t)t0 * 512 + hd * 64;
        const bfr* Sin = (const bfr*)(P.ws + WS_SINRW) + ((size_t)(dir * 8 + hd) * (RW_NSC + 1) + sc) * 4096;
#pragma unroll
        for (int k0 = 0; k0 < 64; k0 += 32) {
          bf16x8 bq[2];
#pragma unroll
          for (int n = 0; n < 2; ++n) bq[n] = *(const bf16x8*)(Bq + (size_t)(16 * n + fr) * 512 + k0 + fq * 8);
#pragma unroll
          for (int m = 0; m < 4; ++m) {
            const bf16x8 a = *(const bf16x8*)(Sin + (16 * m + fr) * 64 + k0 + fq * 8);
#pragma unroll
            for (int n = 0; n < 2; ++n) acc[m][n] = __builtin_amdgcn_mfma_f32_16x16x32_bf16(a, bq[n], acc[m][n], 0, 0, 0);
          }
        }
#pragma unroll
        for (int m = 0; m < 4; ++m)
#pragma unroll
          for (int n = 0; n < 2; ++n) acc[m][n] += ld4bf(Y0 + (size_t)(16 * n + fr) * 512 + 16 * m + 4 * fq);
      }
#pragma unroll
      for (int n = 0; n < 2; ++n) {
        const size_t trow = (size_t)(t0 + 16 * n + fr) * 512 + hd * 64;
        float s = 0.f, bs = 0.f;
        f32x4 vv[4];
#pragma unroll
        for (int m = 0; m < 4; ++m) {
          const int c = 16 * m + 4 * fq;
          s += acc[m][n][0] + acc[m][n][1] + acc[m][n][2] + acc[m][n][3];
          const f32x4 rr = ld4bf(R + trow + c), kk2 = ld4bf(K + trow + c), rk = *(const f32x4*)(r_k + hd * 64 + c);
          vv[m] = ld4bf(V + trow + c);
          bs += rr[0] * kk2[0] * rk[0] + rr[1] * kk2[1] * rk[1] + rr[2] * kk2[2] * rk[2] + rr[3] * kk2[3] * rk[3];
        }
        s += __shfl_xor(s, 16); s += __shfl_xor(s, 32);
        bs += __shfl_xor(bs, 16); bs += __shfl_xor(bs, 32);
        const float mu = s * (1.f / 64.f);
        float q = 0.f;
#pragma unroll
        for (int m = 0; m < 4; ++m) { acc[m][n] -= mu; q += acc[m][n][0] * acc[m][n][0] + acc[m][n][1] * acc[m][n][1] + acc[m][n][2] * acc[m][n][2] + acc[m][n][3] * acc[m][n][3]; }
        q += __shfl_xor(q, 16); q += __shfl_xor(q, 32);
        const float rs = rsqrtf(q * (1.f / 64.f) + 64e-5f);
#pragma unroll
        for (int m = 0; m < 4; ++m) {
          const int c = hd * 64 + 16 * m + 4 * fq;
          const f32x4 gw = *(const f32x4*)(gn_w + c), gb = *(const f32x4*)(gn_b + c), gg = ld4bf(G + trow + 16 * m + 4 * fq);
          const f32x4 o = (acc[m][n] * rs * gw + gb + vv[m] * bs) * gg;
          *(uint2*)(mix + (size_t)(t0 + 16 * n + fr) * DM + 512 + c) = pk4(o);
        }
      }
    }
    {
      const int hd = w;
      f32x4 acc[8][2];
#pragma unroll
      for (int m = 0; m < 8; ++m) { acc[m][0] = z4; acc[m][1] = z4; }
#pragma unroll
      for (int dir = 0; dir < 2; ++dir) {
        const int ci = dir ? (519 - tile) : (8 + tile);
        const int sc = hg_sc_of_chunk(ci);
        const bfr* Bq = (const bfr*)(P.ws + WS_QH) + (size_t)dir * T_LAT * 512 + (size_t)t0 * 512 + hd * 128;
        const bfr* O0 = (const bfr*)(P.ws + WS_O0) + (size_t)dir * T_LAT * 512 + (size_t)t0 * 512 + hd * 128;
        const bfr* Sin = (const bfr*)(P.ws + WS_SINHG) + ((size_t)(dir * 4 + hd) * HG_NSC + sc) * 16384;
#pragma unroll
        for (int k0 = 0; k0 < 128; k0 += 32) {
          bf16x8 bq[2];
#pragma unroll
          for (int n = 0; n < 2; ++n) bq[n] = *(const bf16x8*)(Bq + (size_t)(16 * n + fr) * 512 + k0 + fq * 8);
#pragma unroll
          for (int m = 0; m < 8; ++m) {
            const bf16x8 a = *(const bf16x8*)(Sin + (16 * m + fr) * 128 + k0 + fq * 8);
#pragma unroll
            for (int n = 0; n < 2; ++n) acc[m][n] = __builtin_amdgcn_mfma_f32_16x16x32_bf16(a, bq[n], acc[m][n], 0, 0, 0);
          }
        }
#pragma unroll
        for (int m = 0; m < 8; ++m)
#pragma unroll
          for (int n = 0; n < 2; ++n) acc[m][n] += ld4bf(O0 + (size_t)(16 * n + fr) * 512 + 16 * m + 4 * fq);
      }
#pragma unroll
      for (int n = 0; n < 2; ++n) {
        const int t = t0 + 16 * n + fr;
        float ss = 0.f;
#pragma unroll
        for (int m = 0; m < 8; ++m) ss += acc[m][n][0] * acc[m][n][0] + acc[m][n][1] * acc[m][n][1] + acc[m][n][2] * acc[m][n][2] + acc[m][n][3] * acc[m][n][3];
        ss += __shfl_xor(ss, 16); ss += __shfl_xor(ss, 32);
        const float rs = rsqrtf(ss * (1.f / 128.f) + 1e-6f);
#pragma unroll
        for (int m = 0; m < 8; ++m) {
          const int c = hd * 128 + 16 * m + 4 * fq;
          const f32x4 nw = *(const f32x4*)(hg_norm_w + c), gg = ld4bf(p + (size_t)t * DIN + 2048 + c);
          f32x4 o;
#pragma unroll
          for (int e = 0; e < 4; ++e) o[e] = acc[m][n][e] * rs * nw[e] * siluf_(gg[e]);
          *(uint2*)(mix + (size_t)t * DM + c) = pk4(o);
        }
      }
    }
  }
}

namespace pg8 {
#define PG8_LAS __attribute__((address_space(3)))
typedef unsigned short bf16_t;
typedef short bf16x8 __attribute__((ext_vector_type(8)));
typedef float f32x4 __attribute__((ext_vector_type(4)));
typedef unsigned u32x4 __attribute__((ext_vector_type(4)));
constexpr int BM = 256, BK = 64, HALF = 128, HTB = HALF * BK * 2  , STAGE_BYTES = 8 * HTB, NXCD = 8, WGM = 8;

__host__ __device__ __forceinline__ int lds_byte(int r, int c) { const int st = (r >> 4) * 2 + (c >> 5), rr = r & 15, cc = c & 31, ob = rr * 64 + cc * 2; return st * 1024 + (ob ^ (((ob >> 9) & 1) << 5)); }
__host__ __device__ __forceinline__ void stage_rc(int b, int& R, int& C) { const int st = b / 1024, sb = b % 1024, swz = sb ^ (((sb >> 9) & 1) << 5); R = (st >> 1) * 16 + swz / 64; C = (st & 1) * 32 + (swz % 64) / 2; }
__host__ __device__ __forceinline__ int perm32(int rho) { const int n = rho >> 4, i = rho & 15; return 8 * (i >> 2) + 4 * n + (i & 3); }

struct Unit { int pm, pn; };
struct Gemm { const bf16_t* A; const bf16_t* Bt; int M, N, K; };

struct StaticOrder {
    int nM, nN, nwg, G, c;
    __host__ __device__ void init(int M, int N, int G_, int c_) { nM = M / BM; nN = N / BM; nwg = nM * nN; G = G_; c = c_; }
    __host__ __device__ bool next(int i, Unit& u) const {
        const long L = (long)i * G + c; if (L >= nwg) return false;
        int wgid = (int)L; { const int q = nwg / NXCD, r = nwg % NXCD, xcd = wgid % NXCD, off = wgid / NXCD; wgid = (xcd < r ? xcd * (q + 1) : r * (q + 1) + (xcd - r) * q) + off; }
        const int nig = WGM * nN, gid = wgid / nig, fm = gid * WGM, gsz = (nM - fm) < WGM ? (nM - fm) : WGM;
        u.pm = fm + ((wgid % nig) % gsz); u.pn = (wgid % nig) / gsz; return true;
    }
    __device__ __forceinline__ void a_ready(const Unit&) const {}
    __device__ __forceinline__ void done(const Unit&) const {}
};
struct CountedOrder : StaticOrder {
    const unsigned* ready; unsigned need; unsigned* tmo;
    __device__ __forceinline__ void a_ready(const Unit& u) const {
        if (threadIdx.x < 64) {
            const unsigned long long t0 = __builtin_amdgcn_s_memrealtime(); unsigned polls = 0;
            while ((unsigned)__builtin_amdgcn_readfirstlane(__hip_atomic_load(ready + 64 * u.pm, __ATOMIC_RELAXED, __HIP_MEMORY_SCOPE_AGENT)) < need) {
                if ((++polls & 255u) == 0u && __builtin_amdgcn_readfirstlane(__hip_atomic_load(tmo, __ATOMIC_RELAXED, __HIP_MEMORY_SCOPE_AGENT)) != 0u) break;
                if (__builtin_amdgcn_s_memrealtime() - t0 > 2000000ull) {
                    if (threadIdx.x == 0) { unsigned expect = 0u; __hip_atomic_compare_exchange_strong(tmo + 1, &expect, 0x600u | (unsigned)(u.pm & 0xff), __ATOMIC_RELAXED, __ATOMIC_RELAXED, __HIP_MEMORY_SCOPE_AGENT); __hip_atomic_store(tmo, 1u, __ATOMIC_RELAXED, __HIP_MEMORY_SCOPE_AGENT); }
                    break; }
                __builtin_amdgcn_s_sleep(2); }
            __builtin_amdgcn_fence(__ATOMIC_ACQUIRE, "agent");
            asm volatile("s_waitcnt vmcnt(0)" ::: "memory");
        }
#if !defined(BROKEN_HOOK_NO_BARRIER)
        asm volatile("" ::: "memory"); __builtin_amdgcn_s_barrier(); asm volatile("" ::: "memory");
#endif
    }
};
struct EpiF32 {
    static constexpr bool PERM = false, AFTER_DRAIN = false;
    float* C; int ldc; const float* bias;
    __device__ __forceinline__ void operator()(const f32x4 (&acc)[2][2][4][2], const Unit& u, int wr, int wc, int fr, int fq) const {
        const int row0 = u.pm * BM + wr * 64 + fr, col0 = u.pn * BM + wc * 32 + 4 * fq;
        f32x4 bv[2][2];
#pragma unroll
        for (int bj = 0; bj < 2; ++bj)
#pragma unroll
            for (int n = 0; n < 2; ++n) bv[bj][n] = bias ? *(const f32x4*)(bias + col0 + bj * HALF + n * 16) : (f32x4){0.f, 0.f, 0.f, 0.f};
#pragma unroll
        for (int ai = 0; ai < 2; ++ai)
#pragma unroll
            for (int m = 0; m < 4; ++m) { float* rowp = C + (size_t)(row0 + ai * HALF + m * 16) * ldc + col0;
#pragma unroll
                for (int bj = 0; bj < 2; ++bj)
#pragma unroll
                    for (int n = 0; n < 2; ++n) *(f32x4*)(rowp + bj * HALF + n * 16) = acc[ai][bj][m][n] + bv[bj][n]; }
    }
};
template <class Epi, class Sched, bool STAMP = false>
__device__ __forceinline__ void gemm_phase(PG8_LAS unsigned char* lds, const Gemm g, const Sched& S, const Epi& E, unsigned long long* stamps) {
    int tid_ = threadIdx.x; asm volatile("" : "+v"(tid_));
    const int tid = tid_, wid = __builtin_amdgcn_readfirstlane(tid >> 6), lane = tid & 63, wr = wid >> 2, wc = wid & 3, fr = lane & 15, fq = lane >> 4;
    const int K = g.K, nt = K / BK;
    int ts_lo = 0, ts_hi = 0, nts = 0; const unsigned long long rt_entry = STAMP ? (unsigned long long)wall_clock64() : 0ull;
#define PG8_STAMP() do { if (STAMP && wid == 0 && nts < 64) { const unsigned long long _c = (unsigned long long)clock64(); \
        ts_lo = (lane == nts) ? (int)(unsigned)_c : ts_lo; ts_hi = (lane == nts) ? (int)(unsigned)(_c >> 32) : ts_hi; ++nts; } } while (0)
    PG8_STAMP();
    unsigned voffA[2], voffB[2];
#pragma unroll
    for (int i = 0; i < 2; ++i) { int R, C; stage_rc(tid * 16 + i * 8192, R, C); const int Rb = Epi::PERM ? ((R & ~31) + perm32(R & 31)) : R;
        voffA[i] = (unsigned)(R * K + C) * 2u; voffB[i] = (unsigned)(Rb * K + C) * 2u; }
    const size_t kstep = (size_t)(BK * 2);
    const size_t hstep = (size_t)HALF * K * 2;
    const size_t tstep = 2 * hstep;
    const unsigned ldsw = (unsigned)wid * 1024u;
    const int aoff = lds_byte(wr * 64 + fr, fq * 8), boff = lds_byte(wc * 32 + fr, fq * 8);
#define PG8_SA(b, h) (((b) * 2 + (h)) * HTB)
#define PG8_SB(b, h) ((4 + (b) * 2 + (h)) * HTB)
#define PG8_STAGE(bufoff, gbase, voff) do { _Pragma("unroll") for (int _i = 0; _i < 2; ++_i) \
        __builtin_amdgcn_global_load_lds((const unsigned*)((const char*)(gbase) + (voff)[_i]), (PG8_LAS unsigned*)(lds + (bufoff) + ldsw + _i * 8192), 16, 0, 0); } while (0)
#define PG8_LDA(dst, b, h) do { _Pragma("unroll") for (int m = 0; m < 4; ++m) _Pragma("unroll") for (int k = 0; k < 2; ++k) dst[m][k] = *(const PG8_LAS bf16x8*)(lds + PG8_SA(b, h) + aoff + m * 2048 + k * 1024); } while (0)
#define PG8_LDB(dst, b, h) do { _Pragma("unroll") for (int n = 0; n < 2; ++n) _Pragma("unroll") for (int k = 0; k < 2; ++k) dst[n][k] = *(const PG8_LAS bf16x8*)(lds + PG8_SB(b, h) + boff + n * 2048 + k * 1024); } while (0)
#define PG8_MMA(ai, bj, At, Bt) do { __builtin_amdgcn_s_setprio(1); _Pragma("unroll") for (int m = 0; m < 4; ++m) _Pragma("unroll") for (int n = 0; n < 2; ++n) _Pragma("unroll") for (int k = 0; k < 2; ++k) \
        acc[ai][bj][m][n] = __builtin_amdgcn_mfma_f32_16x16x32_bf16(Bt[n][k], At[m][k], acc[ai][bj][m][n], 0, 0, 0); __builtin_amdgcn_s_setprio(0); } while (0)
#define PG8_WAIT_V(n) asm volatile("s_waitcnt vmcnt(" #n ")" ::: "memory")
#define PG8_WAIT_L(n) asm volatile("s_waitcnt lgkmcnt(" #n ")" ::: "memory")
#define PG8_BAR __builtin_amdgcn_s_barrier()
#define PG8_SCHED __builtin_amdgcn_sched_barrier(0)
    Unit cur, nxt; int ui = 0;
    if (!S.next(0, cur)) return;
    f32x4 acc[2][2][4][2];
#pragma unroll
    for (int a = 0; a < 2; ++a)
#pragma unroll
        for (int b = 0; b < 2; ++b)
#pragma unroll
            for (int m = 0; m < 4; ++m)
#pragma unroll
                for (int n = 0; n < 2; ++n) acc[a][b][m][n] = (f32x4){0.f, 0.f, 0.f, 0.f};
    bf16x8 At[4][2], B0[2][2], B1[2][2];
    const char* cA = (const char*)g.A + (size_t)cur.pm * tstep; const char* cB = (const char*)g.Bt + (size_t)cur.pn * tstep;
    S.a_ready(cur);
    PG8_STAGE(PG8_SB(0, 0), cB, voffB); PG8_STAGE(PG8_SA(0, 0), cA, voffA); PG8_STAGE(PG8_SB(0, 1), cB + hstep, voffB); PG8_STAGE(PG8_SA(0, 1), cA + hstep, voffA);
    if (wr == 1) PG8_BAR;
    PG8_WAIT_V(4); PG8_BAR;
    PG8_STAGE(PG8_SB(1, 0), cB + kstep, voffB); PG8_STAGE(PG8_SA(1, 0), cA + kstep, voffA); PG8_STAGE(PG8_SB(1, 1), cB + hstep + kstep, voffB);
    PG8_WAIT_V(6); PG8_BAR;
    PG8_STAMP();
    for (;;) {
        const bool has_next = S.next(ui + 1, nxt);
        const char* nA = has_next ? (const char*)g.A + (size_t)nxt.pm * tstep : cA; const char* nB = has_next ? (const char*)g.Bt + (size_t)nxt.pn * tstep : cB;
        for (int t = 0; t < nt; t += 2) {
            const bool last = (t == nt - 2);
            const char* a1 = cA + (size_t)(t + 1) * kstep;
            const char* a2 = last ? nA : cA + (size_t)(t + 2) * kstep; const char* b2 = last ? nB : cB + (size_t)(t + 2) * kstep;
            const char* a3 = a2 + kstep; const char* b3 = b2 + kstep;
            if (last && has_next) S.a_ready(nxt);
            PG8_LDB(B0, 0, 0); PG8_SCHED; PG8_LDA(At, 0, 0); PG8_STAGE(PG8_SA(1, 1), a1 + hstep, voffA);
            PG8_WAIT_L(8); PG8_BAR; PG8_WAIT_L(0); PG8_MMA(0, 0, At, B0); PG8_BAR; PG8_SCHED;
            PG8_LDB(B1, 0, 1); PG8_STAGE(PG8_SB(0, 0), b2, voffB);
            PG8_BAR; PG8_WAIT_L(0); PG8_MMA(0, 1, At, B1); PG8_BAR;
            PG8_LDA(At, 0, 1); PG8_STAGE(PG8_SA(0, 0), a2, voffA);
            PG8_BAR; PG8_WAIT_L(0); PG8_MMA(1, 0, At, B0); PG8_BAR; PG8_SCHED;
            PG8_STAGE(PG8_SB(0, 1), b2 + hstep, voffB);
            PG8_WAIT_V(6); PG8_BAR; PG8_MMA(1, 1, At, B1); PG8_BAR;
            PG8_LDB(B0, 1, 0); PG8_SCHED; PG8_LDA(At, 1, 0); PG8_STAGE(PG8_SA(0, 1), a2 + hstep, voffA);
            PG8_WAIT_L(8); PG8_BAR; PG8_WAIT_L(0); PG8_MMA(0, 0, At, B0); PG8_BAR; PG8_SCHED;
            PG8_LDB(B1, 1, 1); PG8_STAGE(PG8_SB(1, 0), b3, voffB);
            PG8_BAR; PG8_WAIT_L(0); PG8_MMA(0, 1, At, B1); PG8_BAR;
            PG8_LDA(At, 1, 1); PG8_STAGE(PG8_SA(1, 0), a3, voffA);
            PG8_BAR; PG8_WAIT_L(0); PG8_MMA(1, 0, At, B0); PG8_BAR; PG8_SCHED;
            PG8_STAGE(PG8_SB(1, 1), b3 + hstep, voffB);
            PG8_WAIT_V(6); PG8_BAR; PG8_MMA(1, 1, At, B1); PG8_BAR;
        }
        PG8_STAMP();
        if constexpr (!Epi::AFTER_DRAIN) { E(acc, cur, wr, wc, fr, fq); S.done(cur); }
        PG8_STAMP();
        if (!has_next) break;
#pragma unroll
        for (int a = 0; a < 2; ++a)
#pragma unroll
            for (int b = 0; b < 2; ++b)
#pragma unroll
                for (int m = 0; m < 4; ++m)
#pragma unroll
                    for (int n = 0; n < 2; ++n) acc[a][b][m][n] = (f32x4){0.f, 0.f, 0.f, 0.f};
        cur = nxt; cA = nA; cB = nB; ++ui;
    }
    PG8_WAIT_V(0);
    if (wr == 0) PG8_BAR;
    PG8_BAR;
    if constexpr (Epi::AFTER_DRAIN) { E.fused(acc, cur, wr, wc, fr, fq, lds, wid, lane); S.done(cur); }
    PG8_STAMP();
    if (STAMP && wid == 0) { stamps[lane] = lane < nts ? (((unsigned long long)(unsigned)ts_hi << 32) | (unsigned)ts_lo) : 0ull;
        if (lane == 62) stamps[62] = rt_entry; if (lane == 63) stamps[63] = (unsigned long long)wall_clock64(); }
#undef PG8_STAMP
#undef PG8_SA
#undef PG8_SB
#undef PG8_STAGE
#undef PG8_LDA
#undef PG8_LDB
#undef PG8_MMA
#undef PG8_WAIT_V
#undef PG8_WAIT_L
#undef PG8_BAR
#undef PG8_SCHED
}
}

constexpr size_t WS_WINT = 284 * MB;
constexpr size_t WS_WOUTT = 1 * MB;
constexpr int NPAD_IN = 4352;
DI void transpose_tile(const float* W, int ldw, int k0, int n0, int nvalid, bfr* WT, int ldt, char* smem) {
  short* T = (short*)smem;
  const int tid = VT;
  __syncthreads();
  {
    const int r = tid >> 2, c4 = tid & 3;
#pragma unroll
    for (int q = 0; q < 4; ++q) {
      const int n = n0 + 16 * c4 + 4 * q;
      f32x4 v = {0.f, 0.f, 0.f, 0.f};
      if (n < nvalid) v = *(const f32x4*)(W + (size_t)(k0 + r) * ldw + n);
#pragma unroll
      for (int e = 0; e < 4; ++e) T[r * 66 + 16 * c4 + 4 * q + e] = (short)f2bf(v[e]);
    }
  }
  __syncthreads();
  {
    const int n = tid >> 2, kq = tid & 3;
    unsigned wv[8];
#pragma unroll
    for (int e = 0; e < 8; ++e) wv[e] = ((unsigned)(unsigned short)T[(16 * kq + 2 * e) * 66 + n]) | (((unsigned)(unsigned short)T[(16 * kq + 2 * e + 1) * 66 + n]) << 16);
    bfr* dst = WT + (size_t)(n0 + n) * ldt + k0 + 16 * kq;
    *(uint4*)dst = uint4{wv[0], wv[1], wv[2], wv[3]};
    *(uint4*)(dst + 8) = uint4{wv[4], wv[5], wv[6], wv[7]};
  }
}
template <int LDC, int NVALID> struct EpiBf16T {
  static constexpr bool PERM = true, AFTER_DRAIN = false;
  bfr* O;
  DI void operator()(const pg8::f32x4 (&acc)[2][2][4][2], const pg8::Unit& u, int wr, int wc, int fr, int fq) const {
    const int row0 = u.pm * 256 + wr * 64 + fr, col0 = u.pn * 256 + wc * 32 + 8 * fq;
#pragma unroll
    for (int ai = 0; ai < 2; ++ai)
#pragma unroll
      for (int m = 0; m < 4; ++m) {
        bfr* rowp = O + (size_t)(row0 + ai * 128 + m * 16) * LDC + col0;
#pragma unroll
        for (int bj = 0; bj < 2; ++bj) {
          if (col0 + bj * 128 < NVALID) {
            const pg8::f32x4 v0 = acc[ai][bj][m][0], v1 = acc[ai][bj][m][1];
            *(uint4*)(rowp + bj * 128) = uint4{pack2(v0[0], v0[1]), pack2(v0[2], v0[3]), pack2(v1[0], v1[1]), pack2(v1[2], v1[3])};
          }
        }
      }
  }
};
DI void phase_pgemm8(CParams& P, char* smem_all) {
  pg8::Gemm g{(const pg8::bf16_t*)(P.ws + WS_H), (const pg8::bf16_t*)(P.ws + WS_WINT), T_ALL, NPAD_IN, DM};
  pg8::StaticOrder S; S.init(T_ALL, NPAD_IN, (int)gridDim.x, (int)blockIdx.x);
  typedef EpiBf16T<DIN, DIN> EpiP;
  EpiP E{(bfr*)(P.ws + WS_P)};
  pg8::gemm_phase<EpiP, pg8::StaticOrder>((PG8_LAS unsigned char*)smem_all, g, S, E, nullptr);
}
DI void phase_outproj8(CParams& P, char* smem_all) {
  pg8::Gemm g{(const pg8::bf16_t*)(P.ws + WS_MIX), (const pg8::bf16_t*)(P.ws + WS_WOUTT), T_LAT, DM, DM};
  pg8::StaticOrder S; S.init(T_LAT, DM, (int)gridDim.x, (int)blockIdx.x);
  typedef EpiBf16T<DM, DM> EpiY;
  EpiY E{(bfr*)(P.ws + WS_Y)};
  pg8::gemm_phase<EpiY, pg8::StaticOrder>((PG8_LAS unsigned char*)smem_all, g, S, E, nullptr);
}


constexpr size_t WS_BTGU = 350 * MB;
constexpr size_t WS_BTD = 284 * MB;
constexpr size_t WS_XB = 186 * MB;
constexpr size_t WS_HID8 = 138 * MB;
constexpr size_t WS_MOUT8 = 42 * MB;
constexpr int TAB_LDS_OFF = 131072 + 1024;

DI void transpose_quad(const float* W, int ldw, int k0, int n0, bfr* WT, int ldt, int dr0, int dr1, int dr2, int dr3, char* smem) {
  short* T = (short*)smem;
  const int tid = VT;
  const int r = tid >> 2, c4 = tid & 3;
  f32x4 v[4][4];
#pragma unroll
  for (int j = 0; j < 4; ++j)
#pragma unroll
    for (int q = 0; q < 4; ++q) v[j][q] = *(const f32x4*)(W + (size_t)(k0 + r) * ldw + n0 + j * 64 + 16 * c4 + 4 * q);
  __syncthreads();
#pragma unroll
  for (int j = 0; j < 4; ++j)
#pragma unroll
    for (int q = 0; q < 4; ++q)
#pragma unroll
      for (int e = 0; e < 4; ++e) T[j * 64 * 66 + r * 66 + 16 * c4 + 4 * q + e] = (short)f2bf(v[j][q][e]);
  __syncthreads();
  const int n = tid >> 2, kq = tid & 3;
#pragma unroll
  for (int j = 0; j < 4; ++j) {
    unsigned wv[8];
#pragma unroll
    for (int e = 0; e < 8; ++e) wv[e] = ((unsigned)(unsigned short)T[j * 64 * 66 + (16 * kq + 2 * e) * 66 + n]) | (((unsigned)(unsigned short)T[j * 64 * 66 + (16 * kq + 2 * e + 1) * 66 + n]) << 16);
    const int dr = j == 0 ? dr0 : j == 1 ? dr1 : j == 2 ? dr2 : dr3;
    bfr* dst = WT + (size_t)(dr + n) * ldt + k0 + 16 * kq;
    *(uint4*)dst = uint4{wv[0], wv[1], wv[2], wv[3]};
    *(uint4*)(dst + 8) = uint4{wv[4], wv[5], wv[6], wv[7]};
  }
}
DI void phase_moe_convert_gu(CParams& P, int bid, int nb, char* smem) {
  for (int it = bid; it < 64 * 64; it += nb) {
    const int e = it >> 6, s = it & 63;
    const int isup = s >> 5, kt = (s & 31) >> 1, nq = s & 1;
    const float* W = (isup ? P.in[30] : P.in[29]) + (size_t)e * DM * DEXP;
    bfr* WT = (bfr*)(P.ws + WS_BTGU) + (size_t)e * 1024 * 1024;
    const int b = nq * 4;
    transpose_quad(W, DEXP, kt * 64, nq * 256, WT, 1024,
                   ((b + 0) >> 1) * 256 + isup * 128 + ((b + 0) & 1) * 64, ((b + 1) >> 1) * 256 + isup * 128 + ((b + 1) & 1) * 64,
                   ((b + 2) >> 1) * 256 + isup * 128 + ((b + 2) & 1) * 64, ((b + 3) >> 1) * 256 + isup * 128 + ((b + 3) & 1) * 64, smem);
  }
}
DI void phase_moe_convert_d(CParams& P, int bid, int nb, char* smem) {
  for (int it = bid; it < 64 * 32; it += nb) {
    const int e = it >> 5, s2 = it & 31, kt = s2 >> 2, nq = s2 & 3;
    const float* W = P.in[31] + (size_t)e * DEXP * DM;
    bfr* WT = (bfr*)(P.ws + WS_BTD) + (size_t)e * 1024 * 512;
    transpose_quad(W, DM, kt * 64, nq * 256, WT, 512, nq * 256, nq * 256 + 64, nq * 256 + 128, nq * 256 + 192, smem);
  }
}
DI void moe_block_table256(CParams& P, int* tab  ) {
  const int* cnt = (const int*)(P.ws + WS_CNT);
  __syncthreads();
  const int t = tx_();
  if (t < 64) {
    int incl = (cnt[t] + 255) >> 8;
#pragma unroll
    for (int o = 1; o < 64; o <<= 1) { int u = __shfl_up(incl, o); if (t >= o) incl += u; }
    tab[t + 1] = incl;
    if (t == 0) tab[0] = 0;
  }
  __syncthreads();
}
DI void phase_moe_gather(CParams& P, char* smem_all) {
  const bfr* h2 = (const bfr*)(P.ws + WS_H2);
  const int* cnt = (const int*)(P.ws + WS_CNT); const int* list = (const int*)(P.ws + WS_LIST);
  bfr* xb = (bfr*)(P.ws + WS_XB);
  int* tab = (int*)(smem_all + TAB_LDS_OFF);
  moe_block_table256(P, tab);
  const int nrows = tab[64] * 256;
  const int wv = threadIdx.x >> 6, lane = threadIdx.x & 63;
  for (int row0 = (blockIdx.x * 8 + wv) * 4; row0 < nrows; row0 += gridDim.x * 32) {
    const int rb = row0 >> 8;
    int e = 0; while (tab[e + 1] <= rb) ++e;
    const int idx0 = (rb - tab[e]) * 256 + (row0 & 255), ce = cnt[e];
    const int* lp = list + e * T_LAT + idx0;
    const int t0 = idx0 + 0 < ce ? (lp[0] >> 1) : -1, t1 = idx0 + 1 < ce ? (lp[1] >> 1) : -1, t2 = idx0 + 2 < ce ? (lp[2] >> 1) : -1, t3 = idx0 + 3 < ce ? (lp[3] >> 1) : -1;
    const bfr* s0 = h2 + (size_t)(t0 < 0 ? 0 : t0) * DM + lane * 8; const bfr* s1 = h2 + (size_t)(t1 < 0 ? 0 : t1) * DM + lane * 8;
    const bfr* s2 = h2 + (size_t)(t2 < 0 ? 0 : t2) * DM + lane * 8; const bfr* s3 = h2 + (size_t)(t3 < 0 ? 0 : t3) * DM + lane * 8;
    const uint4 a0 = *(const uint4*)s0, b0 = *(const uint4*)(s0 + 512), a1 = *(const uint4*)s1, b1 = *(const uint4*)(s1 + 512);
    const uint4 a2 = *(const uint4*)s2, b2 = *(const uint4*)(s2 + 512), a3 = *(const uint4*)s3, b3 = *(const uint4*)(s3 + 512);
    bfr* d = xb + (size_t)row0 * DM + lane * 8;
    if (t0 >= 0) { *(uint4*)d = a0; *(uint4*)(d + 512) = b0; }
    if (t1 >= 0) { *(uint4*)(d + DM) = a1; *(uint4*)(d + DM + 512) = b1; }
    if (t2 >= 0) { *(uint4*)(d + 2 * DM) = a2; *(uint4*)(d + 2 * DM + 512) = b2; }
    if (t3 >= 0) { *(uint4*)(d + 3 * DM) = a3; *(uint4*)(d + 3 * DM + 512) = b3; }
  }
}
struct MoeOrder {
  const int* tab; int nunits, G, c;
  DI bool next(int i, pg8::Unit& u) const {
    const int L = i * G + c; if (L >= nunits) return false;
    const int rb = L >> 2; int e = 0; while (tab[e + 1] <= rb) ++e;
    u.pm = rb; u.pn = e * 4 + (L & 3); return true;
  }
  DI void a_ready(const pg8::Unit&) const {}
  DI void done(const pg8::Unit&) const {}
};
struct EpiHid {
  static constexpr bool PERM = true, AFTER_DRAIN = false;
  bfr* H;
  DI void operator()(const pg8::f32x4 (&acc)[2][2][4][2], const pg8::Unit& u, int wr, int wc, int fr, int fq) const {
    const int row0 = u.pm * 256 + wr * 64 + fr, col0 = (u.pn & 3) * 128 + wc * 32 + 8 * fq;
#pragma unroll
    for (int ai = 0; ai < 2; ++ai)
#pragma unroll
      for (int m = 0; m < 4; ++m) {
        float hv[8];
#pragma unroll
        for (int n = 0; n < 2; ++n)
#pragma unroll
          for (int j = 0; j < 4; ++j) hv[4 * n + j] = siluf_(acc[ai][0][m][n][j]) * acc[ai][1][m][n][j];
        *(uint4*)(H + (size_t)(row0 + ai * 128 + m * 16) * DEXP + col0) = uint4{pack2(hv[0], hv[1]), pack2(hv[2], hv[3]), pack2(hv[4], hv[5]), pack2(hv[6], hv[7])};
      }
  }
};
struct EpiMout {
  static constexpr bool PERM = true, AFTER_DRAIN = false;
  bfr* O; const int* tab; const int* cnt; const int* list;
  DI void operator()(const pg8::f32x4 (&acc)[2][2][4][2], const pg8::Unit& u, int wr, int wc, int fr, int fq) const {
    const int e = u.pn >> 2, pnl = u.pn & 3;
    const int lrow0 = (u.pm - tab[e]) * 256 + wr * 64 + fr, ce = cnt[e];
    const int col0 = pnl * 256 + wc * 32 + 8 * fq;
#pragma unroll
    for (int ai = 0; ai < 2; ++ai)
#pragma unroll
      for (int m = 0; m < 4; ++m) {
        const int idx = lrow0 + ai * 128 + m * 16;
        if (idx < ce) {
          const int asg = list[e * T_LAT + idx];
          bfr* rowp = O + (size_t)asg * DM + col0;
#pragma unroll
          for (int bj = 0; bj < 2; ++bj) {
            const pg8::f32x4 v0 = acc[ai][bj][m][0], v1 = acc[ai][bj][m][1];
            *(uint4*)(rowp + bj * 128) = uint4{pack2(v0[0], v0[1]), pack2(v0[2], v0[3]), pack2(v1[0], v1[1]), pack2(v1[2], v1[3])};
          }
        }
      }
  }
};
DI void phase_moe1_8(CParams& P, char* smem_all) {
  int* tab = (int*)(smem_all + TAB_LDS_OFF);
  moe_block_table256(P, tab);
  const int nrb = tab[64];
  pg8::Gemm g{(const pg8::bf16_t*)(P.ws + WS_XB), (const pg8::bf16_t*)(P.ws + WS_BTGU), nrb * 256, 64 * 1024, DM};
  MoeOrder S{tab, nrb * 4, (int)gridDim.x, (int)blockIdx.x};
  EpiHid E{(bfr*)(P.ws + WS_HID8)};
  pg8::gemm_phase<EpiHid, MoeOrder>((PG8_LAS unsigned char*)smem_all, g, S, E, nullptr);
}
DI void phase_moe2_8(CParams& P, char* smem_all) {
  int* tab = (int*)(smem_all + TAB_LDS_OFF);
  moe_block_table256(P, tab);
  const int nrb = tab[64];
  pg8::Gemm g{(const pg8::bf16_t*)(P.ws + WS_HID8), (const pg8::bf16_t*)(P.ws + WS_BTD), nrb * 256, 64 * 1024, DEXP};
  MoeOrder S{tab, nrb * 4, (int)gridDim.x, (int)blockIdx.x};
  EpiMout E{(bfr*)(P.ws + WS_MOUT8), tab, (const int*)(P.ws + WS_CNT), (const int*)(P.ws + WS_LIST)};
  pg8::gemm_phase<EpiMout, MoeOrder>((PG8_LAS unsigned char*)smem_all, g, S, E, nullptr);
}

#define XB_TMO      128
#define XB_XCNT(j)  (256  + 64 * (j))
#define XB_XSUB(j)  (1280 + 64 * (j))
#define XB_XGEN(j)  (2304 + 64 * (j))
#define XB_TOP      3328
#define XB_TOPGEN   3392
#define XCD_BAR_WORDS 3456
#define XB_SPIN_CAP (1u << 22)
#define LAS __attribute__((address_space(3)))
DI unsigned xb_ld(unsigned* p)              { return __hip_atomic_load(p, __ATOMIC_RELAXED, __HIP_MEMORY_SCOPE_AGENT); }
DI unsigned xb_add(unsigned* p, unsigned v) { return __hip_atomic_fetch_add(p, v, __ATOMIC_RELAXED, __HIP_MEMORY_SCOPE_AGENT); }
DI unsigned xb_xcc_id() { return (unsigned)__builtin_amdgcn_s_getreg((3 << 11) | 20) & 0xFu; }
#define XB_SPIN(cond, bar) do { unsigned _sp = 0; while (cond) { __builtin_amdgcn_s_sleep(1); \
    if ((++_sp & 255u) == 0u) { if (xb_ld(&(bar)[XB_TMO])) break; if (_sp > XB_SPIN_CAP) { atomicAdd(&(bar)[XB_TMO], 1u); break; } } } } while (0)
struct XcdBarrier { unsigned* bar; unsigned x; volatile LAS unsigned* st; };
DI XcdBarrier xcd_barrier_post(unsigned* bar, volatile LAS unsigned* st) {
  XcdBarrier b; b.bar = bar; b.x = xb_xcc_id(); b.st = st;
  if (threadIdx.x == 0) (void)xb_add(&bar[XB_XCNT(b.x)], 1u);
  return b;
}
DI void xcd_barrier_complete(unsigned* bar, unsigned x, unsigned& nloc, unsigned& nx) {
  const unsigned G = gridDim.x * gridDim.y * gridDim.z;
  unsigned sum, cnt, mine, sp = 0u;
  for (;;) {
    sum = 0u; cnt = 0u; mine = 0u;
#pragma unroll
    for (unsigned j = 0; j < 16; ++j) { const unsigned c = xb_ld(&bar[XB_XCNT(j)]); sum += c; cnt += (c > 0u) ? 1u : 0u; mine = (j == x) ? c : mine; }
    if (sum == G) break;
    __builtin_amdgcn_s_sleep(1);
    if ((++sp & 255u) == 0u) { if (xb_ld(&bar[XB_TMO])) break; if (sp > XB_SPIN_CAP) { atomicAdd(&bar[XB_TMO], 1u); break; } }
  }
  nloc = mine > 0u ? mine : 1u; nx = cnt > 0u ? cnt : 1u;
}
DI void xcd_barrier(const XcdBarrier& b) {
  asm volatile("s_waitcnt vmcnt(0)" ::: "memory");
  __syncthreads();
  if (threadIdx.x == 0) {
    unsigned* bar = b.bar;
    __builtin_amdgcn_s_waitcnt(0);
    unsigned nloc = b.st[0], nx = b.st[1];
    if (nloc == 0u) { xcd_barrier_complete(bar, b.x, nloc, nx); b.st[0] = nloc; b.st[1] = nx; }
    const unsigned old = xb_add(&bar[XB_XSUB(b.x)], 1u);
    const unsigned gen = old / nloc;
    if (old + 1u == (gen + 1u) * nloc) {
      __builtin_amdgcn_fence(__ATOMIC_RELEASE, "agent");
      asm volatile("s_waitcnt vmcnt(0)" ::: "memory");
      const unsigned og = xb_add(&bar[XB_TOP], 1u);
      const unsigned tg = og / nx;
      if (og + 1u == (tg + 1u) * nx) xb_add(&bar[XB_TOPGEN], 1u);
      else XB_SPIN(xb_ld(&bar[XB_TOPGEN]) == tg, bar);
      __builtin_amdgcn_fence(__ATOMIC_ACQUIRE, "agent");
      xb_add(&bar[XB_XGEN(b.x)], 1u);
      asm volatile("s_waitcnt vmcnt(0)" ::: "memory");
    } else {
      XB_SPIN(xb_ld(&bar[XB_XGEN(b.x)]) == gen, bar);
      __builtin_amdgcn_fence(__ATOMIC_ACQUIRE, "agent");
      asm volatile("s_waitcnt vmcnt(0)" ::: "memory");
    }
  }
  __syncthreads();
}

namespace cg = cooperative_groups;
constexpr int HALF_LDS = 78080;
constexpr int SMEM_BYTES = 2 * HALF_LDS + 16;
__global__ void __launch_bounds__(NTHR_BLOCK) k_fused(Params Pval) {
  __shared__ __attribute__((aligned(16))) char smem_all[SMEM_BYTES];
  cg::grid_group grid = cg::this_grid();
  CParams* kp0 = (CParams*)__builtin_amdgcn_kernarg_segment_ptr();
#define PH(call) do { CParams* kp_ = kp0; asm volatile("" : "+s"(kp_)); CParams& P = *kp_; \
    int half = __builtin_amdgcn_readfirstlane((int)(threadIdx.x >> 8)); asm volatile("" : "+s"(half)); \
    char* smem = smem_all + half * HALF_LDS; const int bid = blockIdx.x * 2 + half, nb = gridDim.x * 2; (void)smem; (void)bid; (void)nb; call; } while (0)
  volatile LAS unsigned* bst = (volatile LAS unsigned*)(smem_all + SMEM_BYTES - 16);
  if (threadIdx.x < 4) bst[threadIdx.x] = 0u;
  __syncthreads();
  XcdBarrier xb = xcd_barrier_post(Pval.bar, bst);
#define GSYNC() do { if (Pval.use_cg) grid.sync(); else xcd_barrier(xb); } while (0)
  PH(phase_mod(P, bid, nb, smem));
  GSYNC();
  PH(phase_ln1(P, bid, nb));
  GSYNC();
  PH(phase_pgemm8(P, smem_all));
  GSYNC();
  PH(phase_rwprep(P, bid, nb, smem));
  GSYNC();
  PH(for (int it = bid; it < 16 * RW_NSC; it += nb) rw_levelA_item(P, it / RW_NSC, it % RW_NSC, smem));
  PH(for (int it = bid; it < 8 * HG_NSC; it += nb) hg_levelA_item(P, it / HG_NSC, it % HG_NSC, smem));
  GSYNC();
  PH(if (bid < 16) rw_levelB_chain(P, bid, smem); else { hg_levelB(P, bid - 16, nb - 16); phase_moe_convert_d(P, bid - 16, nb - 16, smem); });
  GSYNC();
  PH(phase_readout_fused(P, bid, nb));
  GSYNC();
  PH(phase_outproj8(P, smem_all));
  PH(phase_moe_convert_gu(P, bid, nb, smem));
  GSYNC();
  PH(phase_ln2route(P, smem_all));
  GSYNC();
  PH(phase_moe_gather(P, smem_all));
  GSYNC();
  PH(phase_moe1_8(P, smem_all));
  GSYNC();
  PH(phase_moe2_8(P, smem_all));
  GSYNC();
  PH(phase_final(P, bid, nb));
}

extern "C" void kernel_launch(void* const* d_in, const int* in_sizes, int n_in, void* d_out, int out_size, void* d_ws, size_t ws_size, hipStream_t stream) {
  static int grid_blocks = 0;
  if (!grid_blocks) {
    int dev = 0, cus = 0, per_cu = 0;
    hipGetDevice(&dev);
    hipDeviceGetAttribute(&cus, hipDeviceAttributeMultiprocessorCount, dev);
    hipOccupancyMaxActiveBlocksPerMultiprocessor(&per_cu, k_fused, NTHR_BLOCK, 0);
    if (per_cu > 1) per_cu = 1;
    if (per_cu < 1) per_cu = 1;
    grid_blocks = cus * per_cu;
  }
  Params P{};
  P.bar = (unsigned*)((char*)d_ws + WS_BAR); P.use_cg = 0; P.pad = 0;
  hipMemsetAsync((char*)d_ws + WS_BAR, 0, XCD_BAR_WORDS * 4, stream);
  for (int i = 0; i < 32; ++i) P.in[i] = (const float*)d_in[i];
  P.out = (float*)d_out; P.ws = (char*)d_ws;
  void* args[] = {&P};
  hipError_t e = hipLaunchCooperativeKernel((void*)k_fused, dim3(grid_blocks), dim3(NTHR_BLOCK), args, 0, stream);
  if (e != hipSuccess) fprintf(stderr, "cooperative launch failed: %s (grid %d)\n", hipGetErrorString(e), grid_blocks);
}
```

```cpp
#include <hip/hip_runtime.h>
#include <hip/hip_cooperative_groups.h>
#include <cstdio>

typedef __attribute__((ext_vector_type(8))) short bf16x8;
typedef __attribute__((ext_vector_type(4))) short s16x4;
typedef __attribute__((ext_vector_type(4))) float f32x4;
typedef __attribute__((ext_vector_type(2))) float f32x2;
typedef __attribute__((ext_vector_type(2))) __bf16 bf16x2_t;
typedef unsigned short bfr;

#define DI __device__ __forceinline__

constexpr int T_LAT = 16384, T_CTX = 256, T_ALL = T_LAT + T_CTX;
constexpr int DM = 1024, DIN = 4288, HGC = 2560, RWC = 1728, DRW = 512, DHG = 512;
constexpr int NEXP = 64, DEXP = 512;
constexpr int NTHR = 256;
constexpr int NTHR_BLOCK = 512;
#define VT ((int)(threadIdx.x & 255))
__device__ __forceinline__ int tx_() { int t = (int)threadIdx.x; asm volatile("" : "+v"(t)); return t; }
constexpr float DN_ALPHA = 1.189207115002721f;
constexpr float RW_DECAY_SCALE = 0.6065306597126334f;

constexpr size_t MB = 1ull << 20;
constexpr size_t WS_MOD = 0;
constexpr size_t WS_MODC = 32768;
constexpr size_t WS_LB = 65536;
constexpr size_t WS_CNT = 65536 + 8192;
constexpr size_t WS_BAR = 81920;
constexpr size_t WS_ASGW = 131072;
constexpr size_t WS_LIST = 1 * MB;
constexpr size_t WS_H = 6 * MB;
constexpr size_t WS_P = 42 * MB;
constexpr size_t WS_Y = 42 * MB;
constexpr size_t WS_H2 = 106 * MB;
constexpr size_t WS_HID = 138 * MB;
constexpr size_t WS_RW = 186 * MB;
constexpr size_t RW_ARR = (size_t)T_ALL * 512 * 2;
constexpr size_t WS_X1B = 6 * MB;
constexpr size_t WS_MIX = WS_RW + 3 * RW_ARR;
constexpr size_t WS_LW = 284 * MB;
constexpr size_t LW_ARR = (size_t)T_ALL * 512 * 4;
constexpr size_t WS_YRW = 350 * MB;
constexpr size_t WS_OHG = 414 * MB;
constexpr size_t WS_MOUT = 186 * MB;

struct Params {
  const float* in[32];
  float* out;
  char* ws;
  unsigned* bar;
  int use_cg;
  int pad;
};
typedef const __attribute__((address_space(4))) Params CParams;

DI unsigned pack2(float a, float b) {
  f32x2 v = {a, b};
  bf16x2_t r = __builtin_convertvector(v, bf16x2_t);
  return __builtin_bit_cast(unsigned, r);
}
DI bfr f2bf(float a) { return (bfr)(pack2(a, 0.f) & 0xffffu); }
DI float bf2f(bfr v) { return __uint_as_float(((unsigned)v) << 16); }
DI float frcp_(float x) { return __builtin_amdgcn_rcpf(x); }
DI float sigmoidf_(float x) { return frcp_(1.f + __expf(-x)); }
DI float siluf_(float x) { return x * frcp_(1.f + __expf(-x)); }
DI f32x4 ld4bf(const bfr* p);
DI float wave_sum(float v) {
#pragma unroll
  for (int o = 32; o > 0; o >>= 1) v += __shfl_xor(v, o);
  return v;
}

constexpr int LSTR = 72;
constexpr int GEMM_LDS_BYTES = 2 * 128 * LSTR * 2;

struct ALoadBf16 {
  const bfr* rp[4];
  bf16x8 r[4];
  DI void load(int kt) {
#pragma unroll
    for (int i = 0; i < 4; ++i) r[i] = *(const bf16x8*)(rp[i] + kt * 64);
  }
  DI void store(short* sA) const {
    const int tid = VT;
#pragma unroll
    for (int i = 0; i < 4; ++i) *(bf16x8*)(sA + ((tid >> 3) + 32 * i) * LSTR + (tid & 7) * 8) = r[i];
  }
};

struct BLoadF32 {
  const float* p;
  long ldb;
  bool valid;
  f32x4 v[8];
  DI void load(int kt) {
#pragma unroll
    for (int j = 0; j < 8; ++j) {
      if (valid) v[j] = *(const f32x4*)(p + ((long)kt * 64 + j) * ldb);
      else v[j] = f32x4{0.f, 0.f, 0.f, 0.f};
    }
  }
  DI void store(short* sB) const {
    const int tid = VT, kg = tid & 7, n4 = tid >> 3;
#pragma unroll
    for (int i = 0; i < 4; ++i) {
      unsigned a0 = pack2(v[0][i], v[1][i]), a1 = pack2(v[2][i], v[3][i]);
      unsigned a2 = pack2(v[4][i], v[5][i]), a3 = pack2(v[6][i], v[7][i]);
      typedef __attribute__((ext_vector_type(4))) unsigned u32x4;
      u32x4 w = {a0, a1, a2, a3};
      *(u32x4*)(sB + (4 * n4 + i) * LSTR + kg * 8) = w;
    }
  }
};

template <class AL, class BL>
DI void gemm_mainloop(short* sA, short* sB, int nk, AL& al, BL& bl, f32x4 (&acc)[4][4]) {
  const int tid = VT, wid = tid >> 6, lane = tid & 63;
  const int wr = wid >> 1, wc = wid & 1, fr = lane & 15, fq = lane >> 4;
#pragma unroll
  for (int m = 0; m < 4; ++m)
#pragma unroll
    for (int n = 0; n < 4; ++n) acc[m][n] = f32x4{0.f, 0.f, 0.f, 0.f};
  al.load(0); bl.load(0);
  for (int kt = 0; kt < nk; ++kt) {
    __syncthreads();
    al.store(sA); bl.store(sB);
    __syncthreads();
    if (kt + 1 < nk) { al.load(kt + 1); bl.load(kt + 1); }
#pragma unroll
    for (int ks = 0; ks < 2; ++ks) {
      bf16x8 af[4], bf[4];
#pragma unroll
      for (int m = 0; m < 4; ++m) af[m] = *(const bf16x8*)(sA + (wr * 64 + m * 16 + fr) * LSTR + ks * 32 + fq * 8);
#pragma unroll
      for (int n = 0; n < 4; ++n) bf[n] = *(const bf16x8*)(sB + (wc * 64 + n * 16 + fr) * LSTR + ks * 32 + fq * 8);
#pragma unroll
      for (int m = 0; m < 4; ++m)
#pragma unroll
        for (int n = 0; n < 4; ++n) acc[m][n] = __builtin_amdgcn_mfma_f32_16x16x32_bf16(af[m], bf[n], acc[m][n], 0, 0, 0);
    }
  }
}

DI void phase_lora_convert(CParams& P, int part, int nparts);
DI void phase_wrt_convert(CParams& P, int part, int nparts);
DI void transpose_tile(const float* W, int ldw, int k0, int n0, int nvalid, bfr* WT, int ldt, char* smem);
DI void transpose_quad(const float* W, int ldw, int k0, int n0, bfr* WT, int ldt, int dr0, int dr1, int dr2, int dr3, char* smem, int nvalid);
DI void phase_mod(CParams& P, int bid, int nb, char* smem) {
  const float* c = P.in[1]; const float* cc = P.in[3];
  const float* w_mod = P.in[4]; const float* b_mod = P.in[5];
  float* mod = (float*)(P.ws + WS_MOD); float* modc = (float*)(P.ws + WS_MODC);
  float* red = (float*)smem;
  const int tid = VT;
  for (int it = bid; it < 542; it += nb) {
    if (it < 192) {
      const int kq = tid >> 3, c4 = tid & 7;
      const int col = it * 32 + c4 * 4;
      f32x4 a1 = {0, 0, 0, 0}, a2 = {0, 0, 0, 0};
      for (int k = kq; k < DM; k += 32) {
        f32x4 w = *(const f32x4*)(w_mod + (long)k * 6144 + col);
        float s1 = siluf_(c[k]), s2 = siluf_(cc[k]);
        a1 += w * s1; a2 += w * s2;
      }
      __syncthreads();
#pragma unroll
      for (int e = 0; e < 4; ++e) { red[(kq * 32) + c4 * 4 + e] = a1[e]; red[1024 + kq * 32 + c4 * 4 + e] = a2[e]; }
      __syncthreads();
      if (tid < 64) {
        const int which = tid >> 5, cl = tid & 31;
        float s = 0.f;
        for (int q = 0; q < 32; ++q) s += red[which * 1024 + q * 32 + cl];
        const int cg = it * 32 + cl;
        s += b_mod[cg];
        if (which == 0) mod[cg] = s; else modc[cg] = s;
      }
    } else if (it == 192) {
      const float* L = P.in[8];
      float* lb = (float*)(P.ws + WS_LB);
      for (int i = tid; i < 1024; i += NTHR) {
        const int d = i >> 9, j = i & 511;
        float l0 = L[d * 1024 + j], l1 = L[d * 1024 + 512 + j];
        lb[i] = 1.f / (1.f + __expf(l1 - l0));
      }
    } else if (it == 193) {
      int* cnt = (int*)(P.ws + WS_CNT);
      if (tid < 64) cnt[tid] = 0;
    } else if (it < 198) {
      phase_lora_convert(P, it - 194, 4);
    } else if (it < 470) {
      const int t = it - 198, kt = t / 17, nq = t % 17;
      transpose_quad(P.in[6], DIN, kt * 64, nq * 256, (bfr*)(P.ws + (284ull << 20)), DM, nq * 256, nq * 256 + 64, nq * 256 + 128, nq * 256 + 192, smem, DIN);
    } else if (it < 534) {
      const int t = it - 470, kt = t >> 2, nq = t & 3;
      transpose_quad(P.in[7], DM, kt * 64, nq * 256, (bfr*)(P.ws + (1ull << 20)), DM, nq * 256, nq * 256 + 64, nq * 256 + 128, nq * 256 + 192, smem, DM);
    } else {
      phase_wrt_convert(P, it - 534, 8);
    }
  }
}

DI void phase_ln1(CParams& P, int bid, int nb) {
  const float* x = P.in[0]; const float* ctx = P.in[2];
  const float* mod = (const float*)(P.ws + WS_MOD); const float* modc = (const float*)(P.ws + WS_MODC);
  bfr* h = (bfr*)(P.ws + WS_H);
  const int wid = VT >> 6, lane = VT & 63;
  for (int row0 = (bid * 4 + wid) * 2; row0 < T_ALL; row0 += nb * 8) {
    const float* src = row0 < T_LAT ? x + (long)row0 * DM : ctx + (long)(row0 - T_LAT) * DM;
    const float* mm = row0 < T_LAT ? mod : modc;
    f32x4 v[2][4];
    float s[2] = {0.f, 0.f};
#pragma unroll
    for (int r = 0; r < 2; ++r)
#pragma unroll
      for (int i = 0; i < 4; ++i) { v[r][i] = *(const f32x4*)(src + r * DM + lane * 4 + 256 * i); s[r] += v[r][i][0] + v[r][i][1] + v[r][i][2] + v[r][i][3]; }
#pragma unroll
    for (int r = 0; r < 2; ++r) {
      const float mu = wave_sum(s[r]) * (1.f / DM);
      float q = 0.f;
#pragma unroll
      for (int i = 0; i < 4; ++i) { v[r][i] -= mu; q += v[r][i][0] * v[r][i][0] + v[r][i][1] * v[r][i][1] + v[r][i][2] * v[r][i][2] + v[r][i][3] * v[r][i][3]; }
      const float rs = rsqrtf(wave_sum(q) * (1.f / DM) + 1e-5f);
#pragma unroll
      for (int i = 0; i < 4; ++i) {
        const int cidx = lane * 4 + 256 * i;
        f32x4 sh = *(const f32x4*)(mm + cidx), sc = *(const f32x4*)(mm + 1024 + cidx);
        f32x4 o = v[r][i] * rs * (sc + 1.f) + sh;
        uint2 w = {pack2(o[0], o[1]), pack2(o[2], o[3])};
        *(uint2*)(h + (long)(row0 + r) * DM + cidx) = w;
      }
    }
  }
}

DI void phase_pgemm(CParams& P, int bid, int nb, char* smem) {
  const bfr* h = (const bfr*)(P.ws + WS_H);
  const float* w_in = P.in[6];
  bfr* p = (bfr*)(P.ws + WS_P);
  short* sA = (short*)smem; short* sB = sA + 128 * LSTR;
  const int tid = VT, wid = tid >> 6, lane = tid & 63;
  const int wr = wid >> 1, wc = wid & 1, fr = lane & 15, fq = lane >> 4;
  constexpr int NT = 34, MT = T_ALL / 128;
  for (int it = bid; it < NT * MT; it += nb) {
    const int mt = it / NT, nt = it % NT;
    ALoadBf16 al; BLoadF32 bl;
#pragma unroll
    for (int i = 0; i < 4; ++i) al.rp[i] = h + (long)(mt * 128 + (tid >> 3) + 32 * i) * DM + (tid & 7) * 8;
    const int col = nt * 128 + (tid >> 3) * 4;
    bl.valid = col < DIN; bl.ldb = DIN;
    bl.p = w_in + (long)((tid & 7) * 8) * DIN + (bl.valid ? col : 0);
    f32x4 acc[4][4];
    gemm_mainloop(sA, sB, DM / 64, al, bl, acc);
#pragma unroll
    for (int m = 0; m < 4; ++m)
#pragma unroll
      for (int n = 0; n < 4; ++n) {
        const int cc = nt * 128 + wc * 64 + n * 16 + fr;
        if (cc < DIN) {
#pragma unroll
          for (int j = 0; j < 4; ++j) {
            const int rr = mt * 128 + wr * 64 + m * 16 + fq * 4 + j;
            p[(long)rr * DIN + cc] = f2bf(acc[m][n][j]);
          }
        }
      }
  }
}

DI float rw_mixed(const bfr* p, int row, int c, const float* mu) {
  const long base = (long)row * DIN + HGC + c;
  const float pc = bf2f(p[base]);
  float nbv;
  if (row < T_LAT) {
    const int gr = row >> 6, gc = row & 63;
    float s = 0.f;
    if (gr > 0) s += bf2f(p[base - 64l * DIN]);
    if (gr < 255) s += bf2f(p[base + 64l * DIN]);
    if (gc > 0) s += bf2f(p[base - DIN]);
    if (gc < 63) s += bf2f(p[base + DIN]);
    nbv = 0.25f * s;
  } else {
    const int sidx = row - T_LAT;
    float s = 0.f;
    if (sidx > 0) s += bf2f(p[base - DIN]);
    if (sidx < T_CTX - 1) s += bf2f(p[base + DIN]);
    nbv = 0.5f * s;
  }
  return pc + (nbv - pc) * mu[c];
}

DI void rwkv_chain_naive(CParams& P, int chain, char* smem) {
  const int dir = chain >> 3, hd = chain & 7;
  const bfr* R = (const bfr*)(P.ws + WS_RW); const bfr* K = (const bfr*)(P.ws + WS_RW + RW_ARR); const bfr* V = (const bfr*)(P.ws + WS_RW + 2 * RW_ARR);
  const bfr* KK = (const bfr*)(P.ws + WS_RW + 3 * RW_ARR); const bfr* A = (const bfr*)(P.ws + WS_RW + 4 * RW_ARR);
  const float* LW = (const float*)(P.ws + WS_LW + (dir ? LW_ARR : 0));
  float* Y = (float*)(P.ws + WS_YRW) + (long)dir * T_LAT * 512;
  float* vec = (float*)smem;
  float* red = vec + 16 * 6 * 64;
  const int tid = VT, i = tid & 63, jq = tid >> 6;
  float S[16];
#pragma unroll
  for (int j = 0; j < 16; ++j) S[j] = 0.f;
  for (int s0 = 0; s0 < T_ALL; s0 += 16) {
    __syncthreads();
    for (int e = tid; e < 16 * 64; e += NTHR) {
      const int st = e >> 6, j = e & 63;
      const int s = s0 + st;
      int row;
      if (s < T_CTX) row = T_LAT + (dir ? (T_CTX - 1 - s) : s);
      else row = dir ? (T_LAT - 1 - (s - T_CTX)) : (s - T_CTX);
      const long o = (long)row * 512 + hd * 64 + j;
      float* vp = vec + st * 384;
      const float kk = bf2f(KK[o]);
      vp[j] = bf2f(R[o]); vp[64 + j] = __expf(LW[o]); vp[128 + j] = bf2f(K[o]); vp[192 + j] = bf2f(V[o]);
      vp[256 + j] = kk; vp[320 + j] = kk * bf2f(A[o]);
    }
    __syncthreads();
    for (int st = 0; st < 16; ++st) {
      const float* vp = vec + st * 384;
      const int par = st & 1;
      float sa = 0.f;
#pragma unroll
      for (int j = 0; j < 16; ++j) sa += S[j] * vp[256 + jq * 16 + j];
      red[(par * 2 + 0) * 256 + jq * 64 + i] = sa;
      __syncthreads();
      sa = red[(par * 2) * 256 + i] + red[(par * 2) * 256 + 64 + i] + red[(par * 2) * 256 + 128 + i] + red[(par * 2) * 256 + 192 + i];
      const float vi = vp[192 + i];
      float y = 0.f;
#pragma unroll
      for (int j = 0; j < 16; ++j) {
        const int jj = jq * 16 + j;
        S[j] = S[j] * vp[64 + jj] - sa * vp[320 + jj] + vi * vp[128 + jj];
        y += S[j] * vp[jj];
      }
      red[(par * 2 + 1) * 256 + jq * 64 + i] = y;
      __syncthreads();
      const int s = s0 + st;
      if (jq == 0 && s >= T_CTX) {
        y = red[(par * 2 + 1) * 256 + i] + red[(par * 2 + 1) * 256 + 64 + i] + red[(par * 2 + 1) * 256 + 128 + i] + red[(par * 2 + 1) * 256 + 192 + i];
        const int row = dir ? (T_LAT - 1 - (s - T_CTX)) : (s - T_CTX);
        Y[(long)row * 512 + hd * 64 + i] = y;
      }
    }
  }
}

DI void hgrn_chain_naive(CParams& P, int chain, char* smem) {
  const int dir = chain >> 2, hd = chain & 3;
  const bfr* p = (const bfr*)(P.ws + WS_P);
  const float* lb = (const float*)(P.ws + WS_LB) + dir * 512 + hd * 128;
  float* O = (float*)(P.ws + WS_OHG) + (long)dir * T_LAT * 512;
  float* vec = (float*)smem;
  float* red = vec + 16 * 4 * 128;
  const int tid = VT, e = tid & 127, dh = tid >> 7;
  float S[64];
#pragma unroll
  for (int d = 0; d < 64; ++d) S[d] = 0.f;
  for (int s0 = 0; s0 < T_ALL; s0 += 16) {
    __syncthreads();
    for (int x = tid; x < 16 * 128; x += NTHR) {
      const int st = x >> 7, d = x & 127;
      const int s = s0 + st;
      int row;
      if (s < T_CTX) row = T_LAT + (dir ? (T_CTX - 1 - s) : s);
      else row = dir ? (T_LAT - 1 - (s - T_CTX)) : (s - T_CTX);
      const bfr* pr = p + (long)row * DIN + hd * 128 + d;
      const float q = bf2f(pr[0]), iv = bf2f(pr[512]), z = bf2f(pr[1024 + dir * 512]);
      const float l = lb[d];
      const float f = l + (1.f - l) * sigmoidf_(z);
      float* vp = vec + st * 512;
      vp[d] = siluf_(q); vp[128 + d] = f; vp[256 + d] = (1.f - l) * sigmoidf_(-z); vp[384 + d] = iv;
    }
    __syncthreads();
    for (int st = 0; st < 16; ++st) {
      const float* vp = vec + st * 512;
      const int par = st & 1;
      const float ve = vp[384 + e];
      float o = 0.f;
#pragma unroll
      for (int d = 0; d < 64; ++d) {
        const int dd = dh * 64 + d;
        S[d] = S[d] * vp[128 + dd] + vp[256 + dd] * ve;
        o += vp[dd] * S[d];
      }
      red[par * 256 + dh * 128 + e] = o;
      __syncthreads();
      const int s = s0 + st;
      if (dh == 0 && s >= T_CTX) {
        o = red[par * 256 + e] + red[par * 256 + 128 + e];
        const int row = dir ? (T_LAT - 1 - (s - T_CTX)) : (s - T_CTX);
        O[(long)row * 512 + hd * 128 + e] = o;
      }
    }
  }
}

#define LDSP(T) __attribute__((address_space(3))) T*
DI int row_of_step(int dir, int s) {
  if (s < T_CTX) return T_LAT + (dir ? (T_CTX - 1 - s) : s);
  return dir ? (T_LAT - 1 - (s - T_CTX)) : (s - T_CTX);
}
DI bf16x8 ld_tr8(const short* base, int stride, int k0, int n0) {
  const int lane = VT & 63, g = lane >> 4, q = (lane & 15) >> 2, p = lane & 3;
  const short* a0 = base + (k0 + 8 * g + q) * stride + n0 + 4 * p;
  s16x4 lo = __builtin_amdgcn_ds_read_tr16_b64_v4i16((LDSP(s16x4))a0);
  s16x4 hi = __builtin_amdgcn_ds_read_tr16_b64_v4i16((LDSP(s16x4))(a0 + 4 * stride));
  return __builtin_shufflevector(lo, hi, 0, 1, 2, 3, 4, 5, 6, 7);
}
template <bool AT, bool BT>
DI f32x4 mm_tile(const short* A, int lda, int m0, const short* B, int ldb, int n0, int K, f32x4 acc) {
  const int lane = VT & 63, fr = lane & 15, fq = lane >> 4;
#ifdef SLOWMM
#pragma unroll
  for (int reg = 0; reg < 4; ++reg) {
    const int row = m0 + 4 * fq + reg, col = n0 + fr;
    float s = 0.f;
    for (int k = 0; k < K; ++k) {
      const float a = bf2f((bfr)(AT ? A[k * lda + row] : A[row * lda + k]));
      const float b = bf2f((bfr)(BT ? B[col * ldb + k] : B[k * ldb + col]));
      s += a * b;
    }
    acc[reg] += s;
  }
#else
  for (int k0 = 0; k0 < K; k0 += 32) {
    bf16x8 a, b;
    if (AT) a = ld_tr8(A, lda, k0, m0); else a = *(const bf16x8*)(A + (m0 + fr) * lda + k0 + fq * 8);
    if (BT) b = *(const bf16x8*)(B + (n0 + fr) * ldb + k0 + fq * 8); else b = ld_tr8(B, ldb, k0, n0);
    acc = __builtin_amdgcn_mfma_f32_16x16x32_bf16(a, b, acc, 0, 0, 0);
  }
#endif
  return acc;
}
DI void st_tile(short* C, int ldc, int m0, int n0, f32x4 acc) {
  const int lane = VT & 63, fr = lane & 15, fq = lane >> 4;
#pragma unroll
  for (int reg = 0; reg < 4; ++reg) C[(m0 + 4 * fq + reg) * ldc + n0 + fr] = (short)f2bf(acc[reg]);
}

constexpr int RW_NSC = 32;
DI int rw_sc_begin(int sc) { return sc * 16 + (sc < 8 ? sc : 8); }
DI int rw_sc_of_chunk(int ci) { return ci < 136 ? ci / 17 : 8 + (ci - 136) / 16; }
constexpr int XS = 72, SS = 40, GS = 72;
constexpr int RWL_XK = 0, RWL_XKB = 4608, RWL_XBB = 9216, RWL_XR = 13824, RWL_XV = 18432, RWL_S = 23040;
constexpr int RWL_GP = 38400, RWL_GQ = 47616, RWL_GAM = 56832, RWL_TOT = 57088, RWL_END = 58112;
constexpr size_t WS_PTOT = 6 * MB;
constexpr size_t WS_QTOT = 10 * MB;
constexpr size_t WS_SINRW = 18 * MB;
constexpr size_t WS_R2P = 350 * MB;
constexpr size_t WS_Y0P = 382 * MB;

constexpr int RTS = 40, RGS = 72;
constexpr int RWT_XK = 0, RWT_XKB = 5120, RWT_XBB = 10240, RWT_XR = 15360, RWT_XV = 20480, RWT_S = 25600;
constexpr int RWT_GP = 40960, RWT_GQ = 50176, RWT_GAM = 59392, RWT_TOT = 59648;
DI void st_tile_T(short* C, int ldc, int m0, int n0, f32x4 acc) {
  const int lane = (int)(threadIdx.x & 63), fr = lane & 15, fq = lane >> 4;
  *(uint2*)(C + (n0 + fr) * ldc + m0 + 4 * fq) = uint2{pack2(acc[0], acc[1]), pack2(acc[2], acc[3])};
}
DI void rw_levelA_item(CParams& P, int chain, int sc, char* smem) {
  const int dir = chain >> 3, hd = chain & 7;
  const bfr* Rg = (const bfr*)(P.ws + WS_RW); const bfr* Kg = (const bfr*)(P.ws + WS_RW + RW_ARR); const bfr* Vg = (const bfr*)(P.ws + WS_RW + 2 * RW_ARR);
  const bfr* KKg = (const bfr*)(P.ws + WS_RW + 3 * RW_ARR); const bfr* Ag = (const bfr*)(P.ws + WS_RW + 4 * RW_ARR);
  const float* LWg = (const float*)(P.ws + WS_LW + (dir ? LW_ARR : 0));
  bfr* R2P = (bfr*)(P.ws + WS_R2P) + (size_t)dir * T_LAT * 512;
  bfr* Y0P = (bfr*)(P.ws + WS_Y0P) + (size_t)dir * T_LAT * 512;
  short* XKt = (short*)(smem + RWT_XK); short* XKBt = (short*)(smem + RWT_XKB); short* XBBt = (short*)(smem + RWT_XBB);
  short* XRt = (short*)(smem + RWT_XR); short* XVt = (short*)(smem + RWT_XV);
  short* ZT = XRt; short* R2T = XRt; short* PcT = XKt;
  short* SLt = (short*)(smem + RWT_S); short* SAkkT = SLt + 32 * RTS; short* SAkrT = SAkkT + 32 * RTS; short* SMt = SAkrT + 32 * RTS;
  short* STt = SMt + 32 * RTS; short* SnAbrT = STt + 32 * RTS;
  short* W1T = SLt; short* W2T = SAkrT;
  short* GPT = (short*)(smem + RWT_GP); short* GQT = (short*)(smem + RWT_GQ);
  float* gam = (float*)(smem + RWT_GAM); float* tot = (float*)(smem + RWT_TOT);
  const int tid = VT, lane = tid & 63, w = tid >> 6, fr = lane & 15, fq = lane >> 4;
  const int tm = w >> 1, tn = w & 1;
  const int sgn = dir ? -1 : 1;
  const f32x4 z4 = {0.f, 0.f, 0.f, 0.f};
  __syncthreads();
  for (int i = tid; i < 64 * 64; i += NTHR) { const int r = i >> 6, c = i & 63; GPT[r * RGS + c] = (r == c) ? (short)0x3F80 : (short)0; GQT[r * RGS + c] = 0; }
  f32x4 pcum[4], qcum[4];
#pragma unroll
  for (int n = 0; n < 4; ++n) { pcum[n] = z4; qcum[n] = z4; }
  const int c_begin = rw_sc_begin(sc), c_end = rw_sc_begin(sc + 1);
  float pf_lw[8]; unsigned pf_rk[8], pf_vkk[8], pf_a[8];
#define RW_PREFETCH(cc) do { const long o0_ = (long)row_of_step(dir, (cc) * 32 + (tid >> 6) * 8) * 512 + hd * 64 + (tid & 63); \
      _Pragma("unroll") for (int e_ = 0; e_ < 8; ++e_) { const long o_ = o0_ + (long)(sgn * e_) * 512; \
      pf_lw[e_] = LWg[o_]; pf_rk[e_] = (unsigned)Rg[o_] | ((unsigned)Kg[o_] << 16); pf_vkk[e_] = (unsigned)Vg[o_] | ((unsigned)KKg[o_] << 16); pf_a[e_] = Ag[o_]; } } while (0)
  RW_PREFETCH(c_begin);
  for (int ci = c_begin; ci < c_end; ++ci) {
    __syncthreads();
    {
      const int j = tid & 63, qt = tid >> 6;
      float lam[8];
      float run = 0.f;
#pragma unroll
      for (int e = 0; e < 8; ++e) { run += pf_lw[e]; lam[e] = run; }
      tot[qt * 64 + j] = run;
      __syncthreads();
      float base = 0.f, total = 0.f;
#pragma unroll
      for (int q2 = 0; q2 < 4; ++q2) { const float tv = tot[q2 * 64 + j]; total += tv; if (q2 < qt) base += tv; }
      unsigned wk[4], wkb[4], wbb[4], wr_[4], wv[4];
#pragma unroll
      for (int e2 = 0; e2 < 4; ++e2) {
        float vk[2], vkb[2], vbb[2], vr[2];
#pragma unroll
        for (int u = 0; u < 2; ++u) {
          const int e = 2 * e2 + u;
          const float L = base + lam[e];
          const float eL = __expf(L), enL = frcp_(eL), eLp = eL * __expf(-pf_lw[e]);
          const float kkv = __uint_as_float(pf_vkk[e] & 0xffff0000u);
          vk[u] = kkv * eLp;
          vkb[u] = __uint_as_float(pf_rk[e] & 0xffff0000u) * enL;
          vbb[u] = kkv * __uint_as_float(pf_a[e] << 16) * enL;
          vr[u] = __uint_as_float(pf_rk[e] << 16) * eL;
        }
        wk[e2] = pack2(vk[0], vk[1]); wkb[e2] = pack2(vkb[0], vkb[1]); wbb[e2] = pack2(vbb[0], vbb[1]); wr_[e2] = pack2(vr[0], vr[1]);
        wv[e2] = (pf_vkk[2 * e2] & 0xffffu) | (pf_vkk[2 * e2 + 1] << 16);
      }
      const int co = j * RTS + 8 * qt;
      *(uint4*)(XKt + co) = uint4{wk[0], wk[1], wk[2], wk[3]};
      *(uint4*)(XKBt + co) = uint4{wkb[0], wkb[1], wkb[2], wkb[3]};
      *(uint4*)(XBBt + co) = uint4{wbb[0], wbb[1], wbb[2], wbb[3]};
      *(uint4*)(XRt + co) = uint4{wr_[0], wr_[1], wr_[2], wr_[3]};
      *(uint4*)(XVt + co) = uint4{wv[0], wv[1], wv[2], wv[3]};
      if (qt == 0) gam[j] = __expf(total);
      if (ci + 1 < c_end) RW_PREFETCH(ci + 1);
    }
    __syncthreads();
    f32x4 tacc; f32x4 rt[2];
    {
      f32x4 aL = mm_tile<true, false>(XKt, RTS, 16 * tm, XBBt, RTS, 16 * tn, 64, z4);
      f32x4 aKK = mm_tile<true, false>(XKt, RTS, 16 * tm, XKBt, RTS, 16 * tn, 64, z4);
      f32x4 aBR = mm_tile<true, false>(XRt, RTS, 16 * tm, XBBt, RTS, 16 * tn, 64, z4);
      f32x4 aKR = mm_tile<true, false>(XRt, RTS, 16 * tm, XKBt, RTS, 16 * tn, 64, z4);
#pragma unroll
      for (int reg = 0; reg < 4; ++reg) {
        const int row = 16 * tm + 4 * fq + reg, col = 16 * tn + fr;
        const bool st = col < row, inc = col <= row;
        aL[reg] = st ? aL[reg] : 0.f; aKK[reg] = st ? aKK[reg] : 0.f;
        aBR[reg] = inc ? -aBR[reg] : 0.f; aKR[reg] = inc ? aKR[reg] : 0.f;
        tacc[reg] = (row == col ? 1.f : 0.f) - aL[reg];
      }
      st_tile_T(SLt, RTS, 16 * tm, 16 * tn, aL); st_tile_T(STt, RTS, 16 * tm, 16 * tn, tacc);
      st_tile_T(SAkkT, RTS, 16 * tm, 16 * tn, aKK); st_tile_T(SnAbrT, RTS, 16 * tm, 16 * tn, aBR); st_tile_T(SAkrT, RTS, 16 * tm, 16 * tn, aKR);
#pragma unroll
      for (int i = 0; i < 2; ++i) rt[i] = ld4bf((const bfr*)(XRt + (16 * (2 * tn + i) + fr) * RTS + 16 * tm + 4 * fq));
    }
    __syncthreads();
    f32x4 y0[2];
    {
#pragma unroll
      for (int i = 0; i < 2; ++i) {
        f32x4 z = mm_tile<true, true>(SAkkT, RTS, 16 * tm, XVt, RTS, 16 * (2 * tn + i), 32, z4);
        st_tile_T(ZT, RTS, 16 * tm, 16 * (2 * tn + i), z);
        y0[i] = mm_tile<true, true>(SAkrT, RTS, 16 * tm, XVt, RTS, 16 * (2 * tn + i), 32, z4);
      }
      f32x4 m = mm_tile<true, true>(SLt, RTS, 16 * tm, SLt, RTS, 16 * tn, 32, z4);
      st_tile_T(SMt, RTS, 16 * tm, 16 * tn, m);
    }
    __syncthreads();
#pragma unroll 1
    for (int rd = 0; rd < 4; ++rd) {
      f32x4 tnew = mm_tile<true, true>(STt, RTS, 16 * tm, SMt, RTS, 16 * tn, 32, tacc);
      f32x4 mnew = z4;
      if (rd < 3) mnew = mm_tile<true, true>(SMt, RTS, 16 * tm, SMt, RTS, 16 * tn, 32, z4);
      __syncthreads();
      tacc = tnew;
      st_tile_T(STt, RTS, 16 * tm, 16 * tn, tacc);
      if (rd < 3) st_tile_T(SMt, RTS, 16 * tm, 16 * tn, mnew);
      __syncthreads();
    }
    {
      f32x4 w1[2], w2[2];
#pragma unroll
      for (int i = 0; i < 2; ++i) {
        w1[i] = mm_tile<true, true>(STt, RTS, 16 * tm, XKt, RTS, 16 * (2 * tn + i), 32, z4);
        w2[i] = mm_tile<true, true>(STt, RTS, 16 * tm, ZT, RTS, 16 * (2 * tn + i), 32, z4);
      }
#pragma unroll
      for (int i = 0; i < 2; ++i) { st_tile_T(W1T, RTS, 16 * tm, 16 * (2 * tn + i), w1[i]); st_tile_T(W2T, RTS, 16 * tm, 16 * (2 * tn + i), w2[i]); }
    }
    __syncthreads();
    f32x4 pa[4], qc[4], r2[2];
    {
#pragma unroll
      for (int n = 0; n < 4; ++n) {
        pa[n] = mm_tile<false, true>(W1T, RTS, 16 * w, XBBt, RTS, 16 * n, 32, z4);
        f32x4 qa = mm_tile<false, true>(XVt, RTS, 16 * w, XKBt, RTS, 16 * n, 32, z4);
        f32x4 qb = mm_tile<false, true>(W2T, RTS, 16 * w, XBBt, RTS, 16 * n, 32, z4);
        qc[n] = qa - qb;
      }
#pragma unroll
      for (int i = 0; i < 2; ++i) {
        r2[i] = mm_tile<true, true>(SnAbrT, RTS, 16 * tm, W1T, RTS, 16 * (2 * tn + i), 32, rt[i]);
        y0[i] = mm_tile<true, true>(SnAbrT, RTS, 16 * tm, W2T, RTS, 16 * (2 * tn + i), 32, y0[i]);
      }
    }
    __syncthreads();
    {
#pragma unroll
      for (int n = 0; n < 4; ++n) {
        const float gcol = gam[16 * n + fr];
        f32x4 pc;
#pragma unroll
        for (int reg = 0; reg < 4; ++reg) {
          const int row = 16 * w + 4 * fq + reg, col = 16 * n + fr;
          pc[reg] = ((row == col ? 1.f : 0.f) - pa[n][reg]) * gcol;
          qc[n][reg] *= gcol;
        }
        st_tile_T(PcT, RGS, 16 * w, 16 * n, pc);
      }
#pragma unroll
      for (int i = 0; i < 2; ++i) st_tile_T(R2T, RTS, 16 * tm, 16 * (2 * tn + i), r2[i]);
    }
    __syncthreads();
    {
      if (ci >= 8) {
        const long orow = (long)row_of_step(dir, ci * 32 + 16 * tm + 4 * fq) * 512 + hd * 64 + fr;
#pragma unroll
        for (int i = 0; i < 2; ++i) {
          f32x4 o1 = mm_tile<true, false>(R2T, RTS, 16 * tm, GPT, RGS, 16 * (2 * tn + i), 64, z4);
          f32x4 o2 = mm_tile<true, false>(R2T, RTS, 16 * tm, GQT, RGS, 16 * (2 * tn + i), 64, y0[i]);
#pragma unroll
          for (int reg = 0; reg < 4; ++reg) {
            const long o = orow + (long)(sgn * reg) * 512 + 16 * (2 * tn + i);
            R2P[o] = f2bf(o1[reg]); Y0P[o] = f2bf(o2[reg]);
          }
        }
      }
#pragma unroll
      for (int n = 0; n < 4; ++n) {
        pcum[n] = mm_tile<true, true>(GPT, RGS, 16 * w, PcT, RGS, 16 * n, 64, z4);
        qcum[n] = mm_tile<true, true>(GQT, RGS, 16 * w, PcT, RGS, 16 * n, 64, qc[n]);
      }
    }
    __syncthreads();
#pragma unroll
    for (int n = 0; n < 4; ++n) { st_tile_T(GPT, RGS, 16 * w, 16 * n, pcum[n]); st_tile_T(GQT, RGS, 16 * w, 16 * n, qcum[n]); }
  }
  {
    bfr* Pt = (bfr*)(P.ws + WS_PTOT) + (size_t)(chain * RW_NSC + sc) * 4096;
    float* Qt = (float*)(P.ws + WS_QTOT) + (size_t)(chain * RW_NSC + sc) * 4096;
#pragma unroll
    for (int n = 0; n < 4; ++n)
#pragma unroll
      for (int reg = 0; reg < 4; ++reg) {
        const int row = 16 * w + 4 * fq + reg, col = 16 * n + fr;
        Pt[row * 64 + col] = f2bf(pcum[n][reg]);
      }
#pragma unroll
    for (int n = 0; n < 4; ++n) *(f32x4*)(Qt + (16 * n + fr) * 64 + 16 * w + 4 * fq) = qcum[n];
  }
}

DI void rw_levelB_chain(CParams& P, int chain, char* smem) {
  short* SB = (short*)smem; short* PT = SB + 64 * GS;
  const bfr* Ptot = (const bfr*)(P.ws + WS_PTOT) + (size_t)chain * RW_NSC * 4096;
  const float* Qtot = (const float*)(P.ws + WS_QTOT) + (size_t)chain * RW_NSC * 4096;
  bfr* SIN = (bfr*)(P.ws + WS_SINRW) + (size_t)chain * (RW_NSC + 1) * 4096;
  const int tid = VT, lane = tid & 63, w = tid >> 6, fr = lane & 15, fq = lane >> 4;
  f32x4 S[4];
#pragma unroll
  for (int n = 0; n < 4; ++n) S[n] = f32x4{0.f, 0.f, 0.f, 0.f};
  bf16x8 pr[4][2]; f32x4 qr[4][4];
#define LB_LOAD(slot, sc_) do { _Pragma("unroll") for (int i_ = 0; i_ < 2; ++i_) { const int e_ = tid + i_ * NTHR; pr[slot][i_] = *(const bf16x8*)(Ptot + (size_t)(sc_) * 4096 + (e_ >> 3) * 64 + (e_ & 7) * 8); } \
    _Pragma("unroll") for (int n_ = 0; n_ < 4; ++n_) qr[slot][n_] = *(const f32x4*)(Qtot + (size_t)(sc_) * 4096 + (16 * n_ + fr) * 64 + 16 * w + 4 * fq); } while (0)
  LB_LOAD(0, 0); LB_LOAD(1, 1); LB_LOAD(2, 2); LB_LOAD(3, 3);
#define LB_STEP(u) do { const int sc = sc0 + (u); \
      __syncthreads(); \
      _Pragma("unroll") for (int n = 0; n < 4; ++n) { st_tile(SB, GS, 16 * w, 16 * n, S[n]); \
        _Pragma("unroll") for (int reg = 0; reg < 4; ++reg) SIN[(size_t)sc * 4096 + (16 * w + 4 * fq + reg) * 64 + 16 * n + fr] = f2bf(S[n][reg]); } \
      _Pragma("unroll") for (int i = 0; i < 2; ++i) { const int e = tid + i * NTHR; *(bf16x8*)(PT + (e >> 3) * GS + (e & 7) * 8) = pr[u][i]; } \
      const f32x4 qc0 = qr[u][0], qc1 = qr[u][1], qc2 = qr[u][2], qc3 = qr[u][3]; \
      __syncthreads(); \
      if (sc + 4 < RW_NSC) LB_LOAD(u, sc + 4); \
      S[0] = mm_tile<false, false>(SB, GS, 16 * w, PT, GS, 0, 64, qc0); S[1] = mm_tile<false, false>(SB, GS, 16 * w, PT, GS, 16, 64, qc1); \
      S[2] = mm_tile<false, false>(SB, GS, 16 * w, PT, GS, 32, 64, qc2); S[3] = mm_tile<false, false>(SB, GS, 16 * w, PT, GS, 48, 64, qc3); } while (0)
  for (int sc0 = 0; sc0 < RW_NSC; sc0 += 4) { LB_STEP(0); LB_STEP(1); LB_STEP(2); LB_STEP(3); }
#undef LB_STEP
#undef LB_LOAD
}

DI void rw_finish(CParams& P, int bid, int nb) {
  float* YM = P.out;
  const int tid = VT, lane = tid & 63, w = tid >> 6, fr = lane & 15, fq = lane >> 4;
  for (int it = bid; it < 512 * 4; it += nb) {
    const int tile = it >> 2, hp = it & 3;
    const int hd = hp * 2 + (w >> 1), tm = w & 1;
    const int t0 = tile * 32;
    f32x4 acc[4];
#pragma unroll
    for (int n = 0; n < 4; ++n) acc[n] = f32x4{0.f, 0.f, 0.f, 0.f};
#pragma unroll
    for (int dir = 0; dir < 2; ++dir) {
      const int ci = dir ? (519 - tile) : (8 + tile);
      const int sc = rw_sc_of_chunk(ci);
      const bfr* A = (const bfr*)(P.ws + WS_R2P) + (size_t)dir * T_LAT * 512 + (size_t)t0 * 512 + hd * 64;
      const bfr* Y0 = (const bfr*)(P.ws + WS_Y0P) + (size_t)dir * T_LAT * 512 + (size_t)t0 * 512 + hd * 64;
      const bfr* Sin = (const bfr*)(P.ws + WS_SINRW) + ((size_t)(dir * 8 + hd) * (RW_NSC + 1) + sc) * 4096;
#pragma unroll
      for (int n = 0; n < 4; ++n) {
#pragma unroll
        for (int k0 = 0; k0 < 64; k0 += 32) {
          bf16x8 a = *(const bf16x8*)(A + (size_t)(16 * tm + fr) * 512 + k0 + fq * 8);
          bf16x8 b = *(const bf16x8*)(Sin + (16 * n + fr) * 64 + k0 + fq * 8);
          acc[n] = __builtin_amdgcn_mfma_f32_16x16x32_bf16(a, b, acc[n], 0, 0, 0);
        }
#pragma unroll
        for (int reg = 0; reg < 4; ++reg) acc[n][reg] += bf2f(Y0[(size_t)(16 * tm + 4 * fq + reg) * 512 + 16 * n + fr]);
      }
    }
#pragma unroll
    for (int n = 0; n < 4; ++n)
#pragma unroll
      for (int reg = 0; reg < 4; ++reg) YM[(size_t)(t0 + 16 * tm + 4 * fq + reg) * 512 + hd * 64 + 16 * n + fr] = acc[n][reg];
  }
}

constexpr int HG_NSC = 64;
DI int hg_sc_begin(int sc) { return sc * 8 + (sc < 8 ? sc : 8); }
DI int hg_sc_of_chunk(int ci) { return ci < 72 ? ci / 9 : 8 + (ci - 72) / 8; }
constexpr int QS = 136;
constexpr int HGL_Q0 = 0, HGL_Q1 = 8704, HGL_KP = 13056, HGL_KH = 21760, HGL_VV = 30464, HGL_PM = 39168, HGL_STT = 41728;
constexpr int HGL_BL = 76544, HGL_TOT = 77056, HGL_END = 78080;
constexpr size_t WS_SINHG = 23 * MB;
constexpr size_t WS_QH = 414 * MB;
constexpr size_t WS_O0 = 446 * MB;
constexpr size_t WS_SLOC = 478 * MB;
constexpr size_t WS_DTOT = 510 * MB;

constexpr int HTS = 40, HT1S = 24;
constexpr int HGT_Q0 = 0, HGT_Q1 = 10240, HGT_KP = 16384, HGT_KH = 26624, HGT_VV = 36864, HGT_PM = 47104, HGT_BL = 49664, HGT_TOT = 50176;
DI bf16x8 ld_tr8p(const short* base, int stride, int k0, int n0) {
  const int lane = (int)(threadIdx.x & 63), g = lane >> 4, q = (lane & 15) >> 2, p = lane & 3;
  const short* a0 = base + (k0 + 4 * g + q) * stride + n0 + 4 * p;
  s16x4 lo = __builtin_amdgcn_ds_read_tr16_b64_v4i16((LDSP(s16x4))a0);
  s16x4 hi = __builtin_amdgcn_ds_read_tr16_b64_v4i16((LDSP(s16x4))(a0 + 16 * stride));
  return __builtin_shufflevector(lo, hi, 0, 1, 2, 3, 4, 5, 6, 7);
}
DI void hg_levelA_item(CParams& P, int chain, int sc, char* smem) {
  const int dir = chain >> 2, hd = chain & 3;
  const bfr* p = (const bfr*)(P.ws + WS_P);
  const float* lbp = (const float*)(P.ws + WS_LB) + dir * 512 + hd * 128;
  bfr* QH = (bfr*)(P.ws + WS_QH) + (size_t)dir * T_LAT * 512;
  bfr* O0 = (bfr*)(P.ws + WS_O0) + (size_t)dir * T_LAT * 512;
  short* Q0T = (short*)(smem + HGT_Q0); short* Q1T = (short*)(smem + HGT_Q1); short* KPT = (short*)(smem + HGT_KP);
  short* KHT = (short*)(smem + HGT_KH); short* VVT = (short*)(smem + HGT_VV); short* PMT = (short*)(smem + HGT_PM);
  float* BL = (float*)(smem + HGT_BL); float* tot = (float*)(smem + HGT_TOT);
  const int tid = VT, lane = tid & 63, w = tid >> 6, fr = lane & 15, fq = lane >> 4;
  const f32x4 z4 = {0.f, 0.f, 0.f, 0.f};
  f32x4 S[8][2];
#pragma unroll
  for (int m = 0; m < 8; ++m) { S[m][0] = z4; S[m][1] = z4; }
  const int d = tid & 127, hf = tid >> 7;
  const float lb = lbp[d];
  float dcum = 0.f;
  const int sgn = dir ? -1 : 1;
  const int c_begin = hg_sc_begin(sc), c_end = hg_sc_begin(sc + 1);
  unsigned qv[16]; bfr zr[16];
#define HG_PREFETCH(cc) do { const bfr* pr0_ = p + (size_t)row_of_step(dir, (cc) * 32 + hf * 16) * DIN + hd * 128 + d; \
      _Pragma("unroll") for (int e_ = 0; e_ < 16; ++e_) { const bfr* pr_ = pr0_ + (long)(sgn * e_) * DIN; \
      qv[e_] = (unsigned)pr_[0] | ((unsigned)pr_[512] << 16); zr[e_] = pr_[1024 + dir * 512]; } } while (0)
  HG_PREFETCH(c_begin);
  for (int ci = c_begin; ci < c_end; ++ci) {
    __syncthreads();
    {
      float lc[16], kv[16]; float run = 0.f;
#pragma unroll
      for (int e = 0; e < 16; ++e) {
        const float sg = sigmoidf_(bf2f(zr[e]));
        const float f = lb + (1.f - lb) * sg;
        kv[e] = (1.f - lb) * (1.f - sg);
        run += __logf(f); lc[e] = run;
      }
      tot[hf * 128 + d] = run;
      __syncthreads();
      const float tot0 = tot[d], tot1 = tot[128 + d];
      const float blast = tot0 + tot1;
      const float e0f = hf ? __expf(tot0) : 1.f;
      const float ehf = __expf(blast - (hf ? tot0 : 0.f));
      const float edc = __expf(dcum);
      bfr* qh0 = QH + (size_t)row_of_step(dir, ci * 32 + hf * 16) * 512 + hd * 128 + d;
#pragma unroll
      for (int hq = 0; hq < 2; ++hq) {
        unsigned q0w[4], q1w[4], kpw[4], khw[4], vvw[4];
#pragma unroll
        for (int e2 = 0; e2 < 4; ++e2) {
          float q0v[2], q1v[2], kpv[2], khv[2];
#pragma unroll
          for (int u = 0; u < 2; ++u) {
            const int e = 8 * hq + 2 * e2 + u;
            const float el = __expf(lc[e]), eil = frcp_(el);
            const float qs = siluf_(__uint_as_float(qv[e] << 16));
            q1v[u] = qs * el; q0v[u] = q1v[u] * e0f;
            kpv[u] = kv[e] * eil; khv[u] = kpv[u] * ehf;
            if (ci >= 8) qh0[(long)(sgn * e) * 512] = f2bf(q0v[u] * edc);
          }
          q0w[e2] = pack2(q0v[0], q0v[1]); q1w[e2] = pack2(q1v[0], q1v[1]); kpw[e2] = pack2(kpv[0], kpv[1]); khw[e2] = pack2(khv[0], khv[1]);
          vvw[e2] = (qv[8 * hq + 2 * e2] >> 16) | (qv[8 * hq + 2 * e2 + 1] & 0xffff0000u);
        }
        const int co = 16 * hf + 8 * hq;
        *(uint4*)(Q0T + d * HTS + co) = uint4{q0w[0], q0w[1], q0w[2], q0w[3]};
        if (hf) *(uint4*)(Q1T + d * HT1S + 8 * hq) = uint4{q1w[0], q1w[1], q1w[2], q1w[3]};
        *(uint4*)(KPT + d * HTS + co) = uint4{kpw[0], kpw[1], kpw[2], kpw[3]};
        *(uint4*)(KHT + d * HTS + co) = uint4{khw[0], khw[1], khw[2], khw[3]};
        *(uint4*)(VVT + d * HTS + co) = uint4{vvw[0], vvw[1], vvw[2], vvw[3]};
      }
      if (hf == 0) BL[d] = blast;
      dcum += blast;
      if (ci + 1 < c_end) HG_PREFETCH(ci + 1);
    }
    __syncthreads();
    {
      f32x4 pt = z4;
      if (w == 0) pt = mm_tile<true, false>(Q0T, HTS, 0, KPT, HTS, 0, 128, z4);
      else if (w == 1) pt = mm_tile<true, false>(Q0T, HTS, 16, KPT, HTS, 0, 128, z4);
      else if (w == 2) pt = mm_tile<true, false>(Q1T, HT1S, 0, KPT, HTS, 16, 128, z4);
      if (w == 0 || w == 2) {
#pragma unroll
        for (int reg = 0; reg < 4; ++reg) pt[reg] = (fr <= 4 * fq + reg) ? pt[reg] : 0.f;
      }
      const int ptm = (w == 0 || w == 3) ? 0 : 1, ptn = (w >= 2) ? 1 : 0;
      *(uint2*)(PMT + (16 * ptn + fr) * HTS + 16 * ptm + 4 * fq) = uint2{pack2(pt[0], pt[1]), pack2(pt[2], pt[3])};
    }
    __syncthreads();
    {
      bf16x8 vfr[2];
#pragma unroll
      for (int n = 0; n < 2; ++n) vfr[n] = *(const bf16x8*)(VVT + (32 * w + 16 * n + fr) * HTS + fq * 8);
      f32x4 o[2][2];
#pragma unroll
      for (int m = 0; m < 2; ++m) { o[m][0] = z4; o[m][1] = z4; }
#pragma unroll
      for (int ks = 0; ks < 4; ++ks) {
        bf16x8 sfr[2];
#pragma unroll
        for (int n = 0; n < 2; ++n) {
          typedef __attribute__((ext_vector_type(4))) unsigned u32x4_;
          u32x4_ wv = {pack2(S[2 * ks][n][0], S[2 * ks][n][1]), pack2(S[2 * ks][n][2], S[2 * ks][n][3]), pack2(S[2 * ks + 1][n][0], S[2 * ks + 1][n][1]), pack2(S[2 * ks + 1][n][2], S[2 * ks + 1][n][3])};
          sfr[n] = __builtin_bit_cast(bf16x8, wv);
        }
#pragma unroll
        for (int m = 0; m < 2; ++m) {
          const bf16x8 a = ld_tr8p(Q0T, HTS, 32 * ks, 16 * m);
#pragma unroll
          for (int n = 0; n < 2; ++n) o[m][n] = __builtin_amdgcn_mfma_f32_16x16x32_bf16(a, sfr[n], o[m][n], 0, 0, 0);
        }
      }
#pragma unroll
      for (int m = 0; m < 2; ++m) {
        const bf16x8 a = ld_tr8(PMT, HTS, 0, 16 * m);
#pragma unroll
        for (int n = 0; n < 2; ++n) {
          o[m][n] = __builtin_amdgcn_mfma_f32_16x16x32_bf16(a, vfr[n], o[m][n], 0, 0, 0);
          if (ci >= 8) {
            bfr* orow = O0 + (size_t)row_of_step(dir, ci * 32 + 16 * m + 4 * fq) * 512 + hd * 128 + 32 * w + 16 * n + fr;
#pragma unroll
            for (int reg = 0; reg < 4; ++reg) orow[(long)(sgn * reg) * 512] = f2bf(o[m][n][reg]);
          }
        }
      }
#pragma unroll
      for (int m = 0; m < 8; ++m) {
        const f32x4 bl = *(const f32x4*)(BL + 16 * m + 4 * fq);
        f32x4 sc4 = {__expf(bl[0]), __expf(bl[1]), __expf(bl[2]), __expf(bl[3])};
        const bf16x8 a = *(const bf16x8*)(KHT + (16 * m + fr) * HTS + fq * 8);
#pragma unroll
        for (int n = 0; n < 2; ++n) S[m][n] = __builtin_amdgcn_mfma_f32_16x16x32_bf16(a, vfr[n], S[m][n] * sc4, 0, 0, 0);
      }
    }
  }
  {
    float* SL_ = (float*)(P.ws + WS_SLOC) + (size_t)(chain * HG_NSC + sc) * 16384;
    float* DT = (float*)(P.ws + WS_DTOT) + (size_t)(chain * HG_NSC + sc) * 128;
#pragma unroll
    for (int m = 0; m < 8; ++m)
#pragma unroll
      for (int n = 0; n < 2; ++n) *(f32x4*)(SL_ + (32 * w + 16 * n + fr) * 128 + 16 * m + 4 * fq) = S[m][n];
    if (hf == 0) DT[d] = dcum;
  }
}

DI void hg_levelB(CParams& P, int bid, int nb) {
  const float* SLOC = (const float*)(P.ws + WS_SLOC); const float* DT = (const float*)(P.ws + WS_DTOT);
  bfr* SIN = (bfr*)(P.ws + WS_SINHG);
  for (int idx = bid * NTHR + VT; idx < 8 * 16384; idx += nb * NTHR) {
    const int chain = idx >> 14, ed = idx & 16383, dd = ed & 127;
    float s = 0.f;
    for (int sc = 0; sc < HG_NSC; ++sc) {
      const size_t item = (size_t)chain * HG_NSC + sc;
      SIN[item * 16384 + ed] = f2bf(s);
      s = __expf(DT[item * 128 + dd]) * s + SLOC[item * 16384 + ed];
    }
  }
}

DI void hg_finish(CParams& P, int bid, int nb, float* OM) {
  const int tid = VT, lane = tid & 63, w = tid >> 6, fr = lane & 15, fq = lane >> 4;
  for (int it = bid; it < 512 * 4; it += nb) {
    const int tile = it >> 2, hd = it & 3;
    const int t0 = tile * 32;
    f32x4 acc[2][2];
#pragma unroll
    for (int m = 0; m < 2; ++m) { acc[m][0] = f32x4{0.f, 0.f, 0.f, 0.f}; acc[m][1] = f32x4{0.f, 0.f, 0.f, 0.f}; }
#pragma unroll
    for (int dir = 0; dir < 2; ++dir) {
      const int ci = dir ? (519 - tile) : (8 + tile);
      const int sc = hg_sc_of_chunk(ci);
      const bfr* A = (const bfr*)(P.ws + WS_QH) + (size_t)dir * T_LAT * 512 + (size_t)t0 * 512 + hd * 128;
      const bfr* O0 = (const bfr*)(P.ws + WS_O0) + (size_t)dir * T_LAT * 512 + (size_t)t0 * 512 + hd * 128;
      const bfr* Sin = (const bfr*)(P.ws + WS_SINHG) + ((size_t)(dir * 4 + hd) * HG_NSC + sc) * 16384;
#pragma unroll
      for (int m = 0; m < 2; ++m)
#pragma unroll
        for (int n = 0; n < 2; ++n) {
#pragma unroll
          for (int k0 = 0; k0 < 128; k0 += 32) {
            bf16x8 a = *(const bf16x8*)(A + (size_t)(16 * m + fr) * 512 + k0 + fq * 8);
            bf16x8 b = *(const bf16x8*)(Sin + (32 * w + 16 * n + fr) * 128 + k0 + fq * 8);
            acc[m][n] = __builtin_amdgcn_mfma_f32_16x16x32_bf16(a, b, acc[m][n], 0, 0, 0);
          }
#pragma unroll
          for (int reg = 0; reg < 4; ++reg) acc[m][n][reg] += bf2f(O0[(size_t)(16 * m + 4 * fq + reg) * 512 + 32 * w + 16 * n + fr]);
        }
    }
#pragma unroll
    for (int m = 0; m < 2; ++m)
#pragma unroll
      for (int n = 0; n < 2; ++n)
#pragma unroll
        for (int reg = 0; reg < 4; ++reg) OM[(size_t)(t0 + 16 * m + 4 * fq + reg) * 512 + hd * 128 + 32 * w + 16 * n + fr] = acc[m][n][reg];
  }
}

constexpr size_t WS_LORA = 256 * 1024;
constexpr int LORA_WD2T = 0, LORA_WA2T = 2 * 512 * 32, LORA_WG2T = LORA_WA2T + 512 * 32;
DI void phase_lora_convert(CParams& P, int part, int nparts) {
  const float* wd2 = P.in[12]; const float* wa2 = P.in[14]; const float* wg2 = P.in[15];
  bfr* L = (bfr*)(P.ws + WS_LORA);
  for (int i = part * NTHR + VT; i < 2 * 512 * 32; i += nparts * NTHR) { const int d = i >> 14, c = (i >> 5) & 511, j = i & 31; L[LORA_WD2T + i] = f2bf(wd2[(d * 32 + j) * 512 + c]); }
  for (int i = part * NTHR + VT; i < 512 * 32; i += nparts * NTHR) { const int c = i >> 5, j = i & 31; L[LORA_WA2T + i] = f2bf(wa2[j * 512 + c]); }
  for (int i = part * NTHR + VT; i < 512 * 96; i += nparts * NTHR) { const int c = i / 96, j = i % 96; L[LORA_WG2T + i] = f2bf(wg2[j * 512 + c]); }
}
#define NB_DECL(row) \
  int nb_o0, nb_o1, nb_o2, nb_o3; float nb_f0, nb_f1, nb_f2, nb_f3, nb_scale; \
  { const int r_ = (row); const bool lat_ = r_ < T_LAT; const int gr_ = r_ >> 6, gc_ = r_ & 63, s_ = r_ - T_LAT; \
    const bool v0_ = lat_ && gr_ > 0, v1_ = lat_ && gr_ < 255, v2_ = lat_ ? gc_ > 0 : s_ > 0, v3_ = lat_ ? gc_ < 63 : s_ < T_CTX - 1; \
    nb_o0 = v0_ ? -64 * DIN : 0; nb_o1 = v1_ ? 64 * DIN : 0; nb_o2 = v2_ ? -DIN : 0; nb_o3 = v3_ ? DIN : 0; \
    nb_f0 = v0_ ? 1.f : 0.f; nb_f1 = v1_ ? 1.f : 0.f; nb_f2 = v2_ ? 1.f : 0.f; nb_f3 = v3_ ? 1.f : 0.f; nb_scale = lat_ ? 0.25f : 0.5f; }
#define MIX4(pc, mup) mix4_((pc), (mup), nb_o0, nb_o1, nb_o2, nb_o3, nb_f0, nb_f1, nb_f2, nb_f3, nb_scale)
DI f32x4 ld4bf(const bfr* p) {
  const uint2 u = *(const uint2*)p;
  return f32x4{__uint_as_float(u.x << 16), __uint_as_float(u.x & 0xffff0000u), __uint_as_float(u.y << 16), __uint_as_float(u.y & 0xffff0000u)};
}
DI f32x4 mix4_(const bfr* pc, const float* mu, int o0, int o1, int o2, int o3, float f0, float f1, float f2, float f3, float scale) {
  const f32x4 c = ld4bf(pc);
  f32x4 s = ld4bf(pc + o0) * f0 + ld4bf(pc + o1) * f1 + ld4bf(pc + o2) * f2 + ld4bf(pc + o3) * f3;
  const f32x4 m = *(const f32x4*)mu;
  return c + (s * scale - c) * m;
}
DI void ld8bf(const bfr* p, f32x4& lo, f32x4& hi) {
  const uint4 u = *(const uint4*)p;
  lo = f32x4{__uint_as_float(u.x << 16), __uint_as_float(u.x & 0xffff0000u), __uint_as_float(u.y << 16), __uint_as_float(u.y & 0xffff0000u)};
  hi = f32x4{__uint_as_float(u.z << 16), __uint_as_float(u.z & 0xffff0000u), __uint_as_float(u.w << 16), __uint_as_float(u.w & 0xffff0000u)};
}
DI void mix8_(const bfr* pc, const float* mu, int o0, int o1, int o2, int o3, float f0, float f1, float f2, float f3, float scale, f32x4& lo, f32x4& hi) {
  f32x4 cl, chh, al, ah, bl, bh, dl, dh, el, eh;
  ld8bf(pc, cl, chh); ld8bf(pc + o0, al, ah); ld8bf(pc + o1, bl, bh); ld8bf(pc + o2, dl, dh); ld8bf(pc + o3, el, eh);
  const f32x4 sl = al * f0 + bl * f1 + dl * f2 + el * f3, sh = ah * f0 + bh * f1 + dh * f2 + eh * f3;
  const f32x4 ml = *(const f32x4*)mu, mh = *(const f32x4*)(mu + 4);
  lo = cl + (sl * scale - cl) * ml; hi = chh + (sh * scale - chh) * mh;
}
#define MIX8(pc, mup, lo, hi) mix8_((pc), (mup), nb_o0, nb_o1, nb_o2, nb_o3, nb_f0, nb_f1, nb_f2, nb_f3, nb_scale, lo, hi)
DI float ftanh_(float x) { const float e = __expf(2.f * x); return 1.f - 2.f * frcp_(e + 1.f); }
DI uint2 pk4(f32x4 v) { return uint2{pack2(v[0], v[1]), pack2(v[2], v[3])}; }
constexpr int LIS = 200;
constexpr int MXS = 388;
DI void rwprep_item(CParams& P, int tile, int hp, char* smem) {
  const bfr* p = (const bfr*)(P.ws + WS_P);
  const float* mu = P.in[10]; const float* w0 = P.in[11]; const float* a0 = P.in[13];
  const float* k_k = P.in[16]; const float* k_a = P.in[17];
  const bfr* LW_ = (const bfr*)(P.ws + WS_LORA);
  bfr* R = (bfr*)(P.ws + WS_RW); bfr* K = (bfr*)(P.ws + WS_RW + RW_ARR); bfr* V = (bfr*)(P.ws + WS_RW + 2 * RW_ARR);
  bfr* KK = (bfr*)(P.ws + WS_RW + 3 * RW_ARR); bfr* A = (bfr*)(P.ws + WS_RW + 4 * RW_ARR); bfr* G = (bfr*)(P.ws + WS_RW + 5 * RW_ARR);
  float* LWF = (float*)(P.ws + WS_LW); float* LWB = (float*)(P.ws + WS_LW + LW_ARR);
  short* LI = (short*)smem;
  float* MX = (float*)(smem + 32 * LIS * 2);
  const int tid = VT, lane = tid & 63, w = tid >> 6, fr = lane & 15, fq = lane >> 4;
  const f32x4 z4 = {0.f, 0.f, 0.f, 0.f};
  const int row0 = tile * 32;
  __syncthreads();
  for (int v = tid; v < 32 * 72; v += NTHR) {
    const int t = v / 72, g = v % 72;
    const int row = row0 + t;
    NB_DECL(row);
    f32x4 lo, hi;
    if (g < 24) {
      const bfr* pc = p + (size_t)row * DIN + HGC + 1536 + g * 8;
      MIX8(pc, mu + 1536 + g * 8, lo, hi);
#pragma unroll
      for (int e = 0; e < 4; ++e) {
        if (g < 8) { lo[e] = ftanh_(lo[e]); hi[e] = ftanh_(hi[e]); }
        else if (g >= 12) { lo[e] = sigmoidf_(lo[e]); hi[e] = sigmoidf_(hi[e]); }
      }
      const uint2 a = pk4(lo), b = pk4(hi);
      *(uint4*)(LI + t * LIS + g * 8) = uint4{a.x, a.y, b.x, b.y};
    } else {
      const int cg = g - 24, a = cg >> 4, c8 = cg & 15;
      const int col = a * 512 + hp * 128 + c8 * 8;
      MIX8(p + (size_t)row * DIN + HGC + col, mu + col, lo, hi);
      *(f32x4*)(MX + t * MXS + a * 128 + c8 * 8) = lo; *(f32x4*)(MX + t * MXS + a * 128 + c8 * 8 + 4) = hi;
    }
  }
  __syncthreads();
  {
    const int hl = w >> 1, th = w & 1, h = hp * 2 + hl;
    const int row = row0 + 16 * th + fr;
    const float* mrow = MX + (16 * th + fr) * MXS + hl * 64 + 4 * fq;
    f32x4 kkr[4], kraw[4], av[4];
    float ss = 0.f;
#pragma unroll
    for (int m = 0; m < 4; ++m) {
      const int c0 = 64 * h + 16 * m;
      const int ch = c0 + 4 * fq;
      const f32x4 r = *(const f32x4*)(mrow + 16 * m);
      kraw[m] = *(const f32x4*)(mrow + 128 + 16 * m);
      const f32x4 v = *(const f32x4*)(mrow + 256 + 16 * m);
      f32x4 aF = mm_tile<false, true>((const short*)(LW_ + LORA_WD2T), 32, c0, LI, LIS, 16 * th, 32, z4);
      f32x4 aB = mm_tile<false, true>((const short*)(LW_ + LORA_WD2T + 512 * 32), 32, c0, LI + 32, LIS, 16 * th, 32, z4);
      f32x4 aA = mm_tile<false, true>((const short*)(LW_ + LORA_WA2T), 32, c0, LI + 64, LIS, 16 * th, 32, z4);
      f32x4 aG = mm_tile<false, true>((const short*)(LW_ + LORA_WG2T), 96, c0, LI + 96, LIS, 16 * th, 96, z4);
      const size_t o = (size_t)row * 512 + ch;
      const f32x4 w0f = *(const f32x4*)(w0 + ch), w0b = *(const f32x4*)(w0 + 512 + ch), a0v = *(const f32x4*)(a0 + ch);
      f32x4 lwf, lwb;
#pragma unroll
      for (int e = 0; e < 4; ++e) {
        lwf[e] = -RW_DECAY_SCALE * sigmoidf_(w0f[e] + aF[e]);
        lwb[e] = -RW_DECAY_SCALE * sigmoidf_(w0b[e] + aB[e]);
        av[m][e] = sigmoidf_(a0v[e] + aA[e]);
      }
      *(f32x4*)(LWF + o) = lwf; *(f32x4*)(LWB + o) = lwb;
      *(uint2*)(G + o) = pk4(aG);
      *(uint2*)(A + o) = pk4(av[m]);
      *(uint2*)(R + o) = pk4(r); *(uint2*)(V + o) = pk4(v);
      kkr[m] = kraw[m] * *(const f32x4*)(k_k + ch);
      ss += kkr[m][0] * kkr[m][0] + kkr[m][1] * kkr[m][1] + kkr[m][2] * kkr[m][2] + kkr[m][3] * kkr[m][3];
    }
    ss += __shfl_xor(ss, 16); ss += __shfl_xor(ss, 32);
    const float rn = rsqrtf(fmaxf(ss, 1e-12f));
#pragma unroll
    for (int m = 0; m < 4; ++m) {
      const int ch = 64 * h + 16 * m + 4 * fq;
      const size_t o = (size_t)row * 512 + ch;
      const f32x4 ka = *(const f32x4*)(k_a + ch);
      f32x4 kv;
#pragma unroll
      for (int e = 0; e < 4; ++e) kv[e] = kraw[m][e] * (1.f + (av[m][e] - 1.f) * ka[e]);
      *(uint2*)(K + o) = pk4(kv);
      *(uint2*)(KK + o) = pk4(kkr[m] * rn);
    }
  }
}
DI void phase_rwprep(CParams& P, int bid, int nb, char* smem) {
  for (int it = bid; it < (T_ALL / 32) * 4; it += nb) rwprep_item(P, it >> 2, it & 3, smem);
}

DI void phase_readout(CParams& P, int bid, int nb) {
  const bfr* p = (const bfr*)(P.ws + WS_P);
  const float* Of = P.out + (size_t)T_LAT * 512;
  const float* Yf = P.out;
  const bfr* R = (const bfr*)(P.ws + WS_RW); const bfr* K = (const bfr*)(P.ws + WS_RW + RW_ARR); const bfr* V = (const bfr*)(P.ws + WS_RW + 2 * RW_ARR);
  const bfr* G = (const bfr*)(P.ws + WS_RW + 5 * RW_ARR);
  const float* hg_norm_w = P.in[9]; const float* r_k = P.in[18]; const float* gn_w = P.in[19]; const float* gn_b = P.in[20];
  bfr* mix = (bfr*)(P.ws + WS_H);
  const int wid = VT >> 6, lane = VT & 63;
  for (int t = bid * 4 + wid; t < T_LAT; t += nb * 4) {
    {
      float o[8]; float ss = 0.f;
#pragma unroll
      for (int e = 0; e < 8; ++e) { const long idx = (long)t * 512 + lane * 8 + e; o[e] = Of[idx]; ss += o[e] * o[e]; }
      ss += __shfl_xor(ss, 1); ss += __shfl_xor(ss, 2); ss += __shfl_xor(ss, 4); ss += __shfl_xor(ss, 8);
      const float rs = rsqrtf(ss * (1.f / 128.f) + 1e-6f);
      unsigned w[4];
#pragma unroll
      for (int e = 0; e < 8; e += 2) {
        const int c0 = lane * 8 + e;
        const float g0 = bf2f(p[(long)t * DIN + 2048 + c0]), g1 = bf2f(p[(long)t * DIN + 2048 + c0 + 1]);
        const float v0 = o[e] * rs * hg_norm_w[c0] * siluf_(g0);
        const float v1 = o[e + 1] * rs * hg_norm_w[c0 + 1] * siluf_(g1);
        w[e >> 1] = pack2(v0, v1);
      }
      *(uint4*)(mix + (long)t * DM + lane * 8) = uint4{w[0], w[1], w[2], w[3]};
    }
    {
      float y[8]; float s = 0.f, bs = 0.f;
      float vv[8];
#pragma unroll
      for (int e = 0; e < 8; ++e) {
        const long idx = (long)t * 512 + lane * 8 + e;
        y[e] = Yf[idx]; s += y[e];
        bs += bf2f(R[idx]) * bf2f(K[idx]) * r_k[lane * 8 + e];
        vv[e] = bf2f(V[idx]);
      }
      s += __shfl_xor(s, 1); s += __shfl_xor(s, 2); s += __shfl_xor(s, 4);
      bs += __shfl_xor(bs, 1); bs += __shfl_xor(bs, 2); bs += __shfl_xor(bs, 4);
      const float mu = s * (1.f / 64.f);
      float q = 0.f;
#pragma unroll
      for (int e = 0; e < 8; ++e) { y[e] -= mu; q += y[e] * y[e]; }
      q += __shfl_xor(q, 1); q += __shfl_xor(q, 2); q += __shfl_xor(q, 4);
      const float rs = rsqrtf(q * (1.f / 64.f) + 64e-5f);
      unsigned w[4];
#pragma unroll
      for (int e = 0; e < 8; e += 2) {
        const int c0 = lane * 8 + e;
        const long idx = (long)t * 512 + c0;
        const float v0 = (y[e] * rs * gn_w[c0] + gn_b[c0] + bs * vv[e]) * bf2f(G[idx]);
        const float v1 = (y[e + 1] * rs * gn_w[c0 + 1] + gn_b[c0 + 1] + bs * vv[e + 1]) * bf2f(G[idx + 1]);
        w[e >> 1] = pack2(v0, v1);
      }
      *(uint4*)(mix + (long)t * DM + 512 + lane * 8) = uint4{w[0], w[1], w[2], w[3]};
    }
  }
}

DI void phase_outproj(CParams& P, int bid, int nb, char* smem) {
  const bfr* mix = (const bfr*)(P.ws + WS_H);
  const float* w_out = P.in[7];
  float* y = (float*)(P.ws + WS_Y);
  short* sA = (short*)smem; short* sB = sA + 128 * LSTR;
  const int tid = VT, wid = tid >> 6, lane = tid & 63;
  const int wr = wid >> 1, wc = wid & 1, fr = lane & 15, fq = lane >> 4;
  constexpr int NT = 8, MT = T_LAT / 128;
  for (int it = bid; it < NT * MT; it += nb) {
    const int mt = it / NT, nt = it % NT;
    ALoadBf16 al; BLoadF32 bl;
#pragma unroll
    for (int i = 0; i < 4; ++i) al.rp[i] = mix + (long)(mt * 128 + (tid >> 3) + 32 * i) * DM + (tid & 7) * 8;
    bl.valid = true; bl.ldb = DM;
    bl.p = w_out + (long)((tid & 7) * 8) * DM + nt * 128 + (tid >> 3) * 4;
    f32x4 acc[4][4];
    gemm_mainloop(sA, sB, DM / 64, al, bl, acc);
#pragma unroll
    for (int m = 0; m < 4; ++m)
#pragma unroll
      for (int n = 0; n < 4; ++n)
#pragma unroll
        for (int j = 0; j < 4; ++j) {
          const int rr = mt * 128 + wr * 64 + m * 16 + fq * 4 + j, cc = nt * 128 + wc * 64 + n * 16 + fr;
          y[(long)rr * DM + cc] = acc[m][n][j];
        }
  }
}

constexpr size_t WS_WRT = 512 * 1024;
DI void phase_wrt_convert(CParams& P, int part, int nparts) {
  const float* wgrp = P.in[25]; const float* wrt = P.in[27];
  bfr* Whi = (bfr*)(P.ws + WS_WRT); bfr* Wlo = Whi + 80 * 1024;
  for (int i = part * NTHR + VT; i < 80 * 1024; i += nparts * NTHR) {
    const int o = i >> 10, k = i & 1023;
    float wv = 0.f;
    if (o < 8) wv = wgrp[k * 8 + o]; else if (o < 72) wv = wrt[k * 64 + (o - 8)];
    const bfr hi = f2bf(wv);
    Whi[i] = hi; Wlo[i] = f2bf(wv - bf2f(hi));
  }
}
constexpr int HLS = 1032;
DI void phase_ln2route(CParams& P, char* smem_all) {
  const float* x = P.in[0];
  const bfr* y = (const bfr*)(P.ws + WS_Y);
  const float* mod = (const float*)(P.ws + WS_MOD);
  const float* ln1_g = P.in[21]; const float* ln1_b = P.in[22];
  const float* bgrp = P.in[26]; const float* brt = P.in[28];
  const bfr* Whi = (const bfr*)(P.ws + WS_WRT); const bfr* Wlo = Whi + 80 * 1024;
  bfr* x1 = (bfr*)(P.ws + WS_X1B);
  bfr* h2 = (bfr*)(P.ws + WS_H2);
  int* cnt = (int*)(P.ws + WS_CNT); int* list = (int*)(P.ws + WS_LIST); float* asgw = (float*)(P.ws + WS_ASGW);
  short* HI = (short*)smem_all; short* LO = HI + 32 * HLS;
  float* LG = (float*)(smem_all + 2 * 32 * HLS * 2);
  float* PS = LG + 32 * 80;
  const int tid = tx_(), wid = tid >> 6, lane = tid & 63, fr = lane & 15, fq = lane >> 4;
  for (int grp = blockIdx.x; grp < T_LAT / 32; grp += gridDim.x) {
    const int t0 = grp * 32;
    __syncthreads();
    f32x4 xin[4][4]; uint2 yin[4][4];
#pragma unroll
    for (int tt = 0; tt < 4; ++tt)
#pragma unroll
      for (int i = 0; i < 4; ++i) {
        const long o = (long)(t0 + wid * 4 + tt) * DM + lane * 4 + 256 * i;
        xin[tt][i] = *(const f32x4*)(x + o); yin[tt][i] = *(const uint2*)(y + o);
      }
#pragma unroll
    for (int tt = 0; tt < 4; ++tt) {
      const int tl = wid * 4 + tt, t = t0 + tl;
      f32x4 v[4]; float s = 0.f;
#pragma unroll
      for (int i = 0; i < 4; ++i) {
        const int c = lane * 4 + 256 * i;
        const f32x4 g1 = *(const f32x4*)(mod + 2048 + c);
        const uint2 u = yin[tt][i];
        const f32x4 yv = {__uint_as_float(u.x << 16), __uint_as_float(u.x & 0xffff0000u), __uint_as_float(u.y << 16), __uint_as_float(u.y & 0xffff0000u)};
        v[i] = xin[tt][i] * DN_ALPHA + g1 * yv;
        s += v[i][0] + v[i][1] + v[i][2] + v[i][3];
      }
      float mu = wave_sum(s) * (1.f / DM); float q = 0.f;
#pragma unroll
      for (int i = 0; i < 4; ++i) { v[i] -= mu; q += v[i][0] * v[i][0] + v[i][1] * v[i][1] + v[i][2] * v[i][2] + v[i][3] * v[i][3]; }
      float rs = rsqrtf(wave_sum(q) * (1.f / DM) + 1e-5f);
      s = 0.f;
#pragma unroll
      for (int i = 0; i < 4; ++i) {
        const int c = lane * 4 + 256 * i;
        f32x4 g = *(const f32x4*)(ln1_g + c), b = *(const f32x4*)(ln1_b + c);
        v[i] = v[i] * rs * g + b;
        *(uint2*)(x1 + (long)t * DM + c) = pk4(v[i]);
        s += v[i][0] + v[i][1] + v[i][2] + v[i][3];
      }
      mu = wave_sum(s) * (1.f / DM); q = 0.f;
#pragma unroll
      for (int i = 0; i < 4; ++i) { v[i] -= mu; q += v[i][0] * v[i][0] + v[i][1] * v[i][1] + v[i][2] * v[i][2] + v[i][3] * v[i][3]; }
      rs = rsqrtf(wave_sum(q) * (1.f / DM) + 1e-5f);
#pragma unroll
      for (int i = 0; i < 4; ++i) {
        const int c = lane * 4 + 256 * i;
        f32x4 sh = *(const f32x4*)(mod + 3072 + c), sc = *(const f32x4*)(mod + 4096 + c);
        v[i] = v[i] * rs * (sc + 1.f) + sh;
        const uint2 whi = {pack2(v[i][0], v[i][1]), pack2(v[i][2], v[i][3])};
        f32x4 r;
        r[0] = v[i][0] - __uint_as_float(whi.x << 16); r[1] = v[i][1] - __uint_as_float(whi.x & 0xffff0000u);
        r[2] = v[i][2] - __uint_as_float(whi.y << 16); r[3] = v[i][3] - __uint_as_float(whi.y & 0xffff0000u);
        const uint2 wlo = {pack2(r[0], r[1]), pack2(r[2], r[3])};
        *(uint2*)(h2 + (long)t * DM + c) = whi;
        *(uint2*)(HI + tl * HLS + c) = whi;
        *(uint2*)(LO + tl * HLS + c) = wlo;
      }
    }
    __syncthreads();
    {
      const int own = wid < 4;
      const int mrow = own ? 16 * wid : 64;
      f32x4 acc0 = {0.f, 0.f, 0.f, 0.f}, acc1 = {0.f, 0.f, 0.f, 0.f};
      bf16x8 a[8], an[8];
      const int nbatch = own ? 12 : 3;
#define RT_LOAD(bi_, dst) do { const int ps_ = own ? ((bi_) >> 2) : (bi_), kb_ = own ? (((bi_) & 3) * 8) : ((wid - 4) * 8); const bfr* Wp_ = ps_ == 1 ? Wlo : Whi; \
        _Pragma("unroll") for (int u = 0; u < 8; ++u) dst[u] = *(const bf16x8*)(Wp_ + (size_t)(mrow + fr) * 1024 + (kb_ + u) * 32 + fq * 8); } while (0)
      RT_LOAD(0, a);
#pragma unroll 1
      for (int bi = 0; bi < nbatch; ++bi) {
        if (bi + 1 < nbatch) RT_LOAD(bi + 1, an);
        const int ps = own ? (bi >> 2) : bi, kb = own ? ((bi & 3) * 8) : ((wid - 4) * 8);
        const short* Hp = ps == 2 ? LO : HI;
#pragma unroll
        for (int u = 0; u < 8; ++u) {
          const bf16x8 b0 = *(const bf16x8*)(Hp + fr * HLS + (kb + u) * 32 + fq * 8);
          const bf16x8 b1 = *(const bf16x8*)(Hp + (16 + fr) * HLS + (kb + u) * 32 + fq * 8);
          acc0 = __builtin_amdgcn_mfma_f32_16x16x32_bf16(a[u], b0, acc0, 0, 0, 0);
          acc1 = __builtin_amdgcn_mfma_f32_16x16x32_bf16(a[u], b1, acc1, 0, 0, 0);
        }
#pragma unroll
        for (int u = 0; u < 8; ++u) a[u] = an[u];
      }
#undef RT_LOAD
      if (own) {
#pragma unroll
        for (int reg = 0; reg < 4; ++reg) { LG[fr * 80 + mrow + 4 * fq + reg] = acc0[reg]; LG[(16 + fr) * 80 + mrow + 4 * fq + reg] = acc1[reg]; }
      } else {
#pragma unroll
        for (int reg = 0; reg < 4; ++reg) { PS[((wid - 4) * 32 + fr) * 16 + 4 * fq + reg] = acc0[reg]; PS[((wid - 4) * 32 + 16 + fr) * 16 + 4 * fq + reg] = acc1[reg]; }
      }
    }
    __syncthreads();
    {
      const int tk = tid >> 4, o = tid & 15;
      LG[tk * 80 + 64 + o] = (PS[(0 * 32 + tk) * 16 + o] + PS[(1 * 32 + tk) * 16 + o]) + (PS[(2 * 32 + tk) * 16 + o] + PS[(3 * 32 + tk) * 16 + o]);
    }
    __syncthreads();
    if (tid < 32) {
      const int t = t0 + tid;
      const float* lg = LG + tid * 80;
      int gi = 0; float gmax = -3.4e38f; float gl[8];
#pragma unroll
      for (int g = 0; g < 8; ++g) { gl[g] = lg[g] + bgrp[g]; if (gl[g] > gmax) { gmax = gl[g]; gi = g; } }
      float den = 0.f;
#pragma unroll
      for (int g = 0; g < 8; ++g) den += __expf(gl[g] - gmax);
      const float gprob = 1.f / den;
      int i1 = 0; float v1 = -3.4e38f; float el[8];
#pragma unroll
      for (int g = 0; g < 8; ++g) { el[g] = lg[8 + gi * 8 + g] + brt[gi * 8 + g]; if (el[g] > v1) { v1 = el[g]; i1 = g; } }
      int i2 = 0; float v2 = -3.4e38f;
#pragma unroll
      for (int g = 0; g < 8; ++g) { if (g != i1 && el[g] > v2) { v2 = el[g]; i2 = g; } }
      const float e2 = __expf(v2 - v1);
      const float wt1 = gprob / (1.f + e2), wt2 = gprob * e2 / (1.f + e2);
      const int ex1 = gi * 8 + i1, ex2 = gi * 8 + i2;
      int s1 = atomicAdd(&cnt[ex1], 1); list[ex1 * T_LAT + s1] = t * 2;
      int s2 = atomicAdd(&cnt[ex2], 1); list[ex2 * T_LAT + s2] = t * 2 + 1;
      asgw[t * 2] = wt1; asgw[t * 2 + 1] = wt2;
    }
  }
}

DI void moe_block_table(CParams& P, int* tab  ) {
  const int* cnt = (const int*)(P.ws + WS_CNT);
  const int tid = VT;
  __syncthreads();
  if (tid < 64) {
    int nbk = (cnt[tid] + 127) >> 7;
    int incl = nbk;
#pragma unroll
    for (int o = 1; o < 64; o <<= 1) { int u = __shfl_up(incl, o); if (tid >= o) incl += u; }
    tab[tid + 1] = incl;
    if (tid == 0) tab[0] = 0;
  }
  __syncthreads();
}
DI int moe_find_expert(const int* tab, int rb) {
  int e = 0;
  while (tab[e + 1] <= rb) ++e;
  return e;
}

DI void phase_moe1(CParams& P, int bid, int nb, char* smem) {
  const bfr* h2 = (const bfr*)(P.ws + WS_H2);
  const int* cnt = (const int*)(P.ws + WS_CNT); const int* list = (const int*)(P.ws + WS_LIST);
  const float* wg = P.in[29]; const float* wu = P.in[30];
  bfr* hid = (bfr*)(P.ws + WS_HID);
  short* sA = (short*)smem; short* sB = sA + 128 * LSTR;
  int* tab = (int*)(smem + GEMM_LDS_BYTES);
  const int tid = VT, wid = tid >> 6, lane = tid & 63;
  const int wr = wid >> 1, wc = wid & 1, fr = lane & 15, fq = lane >> 4;
  moe_block_table(P, tab);
  const int nrb = tab[64];
  for (int it = bid; it < nrb * 8; it += nb) {
    const int rb = it >> 3, nt = it & 7;
    const int e = moe_find_expert(tab, rb);
    const int lrb = rb - tab[e];
    const int ce = cnt[e];
    ALoadBf16 al; BLoadF32 bl;
#pragma unroll
    for (int i = 0; i < 4; ++i) {
      int r = lrb * 128 + (tid >> 3) + 32 * i;
      if (r >= ce) r = ce - 1;
      const int tok = list[e * T_LAT + r] >> 1;
      al.rp[i] = h2 + (long)tok * DM + (tid & 7) * 8;
    }
    const int n4 = tid >> 3;
    const int isup = (n4 >> 3) & 1;
    const int col = nt * 64 + (n4 >> 4) * 32 + ((4 * n4) & 31);
    bl.valid = true; bl.ldb = DEXP;
    bl.p = (isup ? wu : wg) + (long)e * DM * DEXP + (long)((tid & 7) * 8) * DEXP + col;
    f32x4 acc[4][4];
    gemm_mainloop(sA, sB, DM / 64, al, bl, acc);
#pragma unroll
    for (int m = 0; m < 4; ++m)
#pragma unroll
      for (int n = 0; n < 2; ++n)
#pragma unroll
        for (int j = 0; j < 4; ++j) {
          const int rl = wr * 64 + m * 16 + fq * 4 + j;
          const int cc = nt * 64 + wc * 32 + n * 16 + fr;
          const float gv = acc[m][n][j], uv = acc[m][n + 2][j];
          hid[((long)rb * 128 + rl) * DEXP + cc] = f2bf(siluf_(gv) * uv);
        }
  }
}

DI void phase_moe2(CParams& P, int bid, int nb, char* smem) {
  const int* cnt = (const int*)(P.ws + WS_CNT); const int* list = (const int*)(P.ws + WS_LIST);
  const float* wd = P.in[31];
  const bfr* hid = (const bfr*)(P.ws + WS_HID);
  bfr* mout = (bfr*)(P.ws + WS_MOUT);
  short* sA = (short*)smem; short* sB = sA + 128 * LSTR;
  int* tab = (int*)(smem + GEMM_LDS_BYTES);
  const int tid = VT, wid = tid >> 6, lane = tid & 63;
  const int wr = wid >> 1, wc = wid & 1, fr = lane & 15, fq = lane >> 4;
  moe_block_table(P, tab);
  const int nrb = tab[64];
  for (int it = bid; it < nrb * 8; it += nb) {
    const int rb = it >> 3, nt = it & 7;
    const int e = moe_find_expert(tab, rb);
    const int lrb = rb - tab[e];
    const int ce = cnt[e];
    ALoadBf16 al; BLoadF32 bl;
#pragma unroll
    for (int i = 0; i < 4; ++i) al.rp[i] = hid + ((long)rb * 128 + (tid >> 3) + 32 * i) * DEXP + (tid & 7) * 8;
    bl.valid = true; bl.ldb = DM;
    bl.p = wd + (long)e * DEXP * DM + (long)((tid & 7) * 8) * DM + nt * 128 + (tid >> 3) * 4;
    f32x4 acc[4][4];
    gemm_mainloop(sA, sB, DEXP / 64, al, bl, acc);
#pragma unroll
    for (int m = 0; m < 4; ++m)
#pragma unroll
      for (int j = 0; j < 4; ++j) {
        const int r = lrb * 128 + wr * 64 + m * 16 + fq * 4 + j;
        if (r < ce) {
          const int asg = list[e * T_LAT + r];
#pragma unroll
          for (int n = 0; n < 4; ++n) mout[(long)asg * DM + nt * 128 + wc * 64 + n * 16 + fr] = f2bf(acc[m][n][j]);
        }
      }
  }
}

DI void phase_final(CParams& P, int bid, int nb) {
  const float* mod = (const float*)(P.ws + WS_MOD);
  const float* ln2_g = P.in[23]; const float* ln2_b = P.in[24];
  const bfr* mout = (const bfr*)(P.ws + (42ull << 20));
  const bfr* x1b = (const bfr*)(P.ws + WS_X1B);
  const float* asgw = (const float*)(P.ws + WS_ASGW);
  float* out = P.out;
  const int wid = VT >> 6, lane = VT & 63;
  for (int t0 = (bid * 4 + wid) * 2; t0 < T_LAT; t0 += nb * 8) {
    f32x4 v[2][4]; float s[2] = {0.f, 0.f};
#pragma unroll
    for (int r = 0; r < 2; ++r) {
      const int t = t0 + r;
      const float w1 = asgw[t * 2], w2 = asgw[t * 2 + 1];
#pragma unroll
      for (int i = 0; i < 4; ++i) {
        const int c = lane * 4 + 256 * i;
        const f32x4 xv = ld4bf(x1b + (long)t * DM + c), g2 = *(const f32x4*)(mod + 5120 + c);
        const f32x4 a = ld4bf(mout + (long)(2 * t) * DM + c), b = ld4bf(mout + (long)(2 * t + 1) * DM + c);
        v[r][i] = xv * DN_ALPHA + g2 * (a * w1 + b * w2);
        s[r] += v[r][i][0] + v[r][i][1] + v[r][i][2] + v[r][i][3];
      }
    }
#pragma unroll
    for (int r = 0; r < 2; ++r) {
      const float mu = wave_sum(s[r]) * (1.f / DM); float q = 0.f;
#pragma unroll
      for (int i = 0; i < 4; ++i) { v[r][i] -= mu; q += v[r][i][0] * v[r][i][0] + v[r][i][1] * v[r][i][1] + v[r][i][2] * v[r][i][2] + v[r][i][3] * v[r][i][3]; }
      const float rs = rsqrtf(wave_sum(q) * (1.f / DM) + 1e-5f);
#pragma unroll
      for (int i = 0; i < 4; ++i) {
        const int c = lane * 4 + 256 * i;
        f32x4 g = *(const f32x4*)(ln2_g + c), b = *(const f32x4*)(ln2_b + c);
        *(f32x4*)(out + (long)(t0 + r) * DM + c) = v[r][i] * rs * g + b;
      }
    }
  }
}

DI void phase_readout_fused(CParams& P, int bid, int nb) {
  const bfr* p = (const bfr*)(P.ws + WS_P);
  const bfr* R = (const bfr*)(P.ws + WS_RW); const bfr* K = (const bfr*)(P.ws + WS_RW + RW_ARR); const bfr* V = (const bfr*)(P.ws + WS_RW + 2 * RW_ARR);
  const bfr* G = (const bfr*)(P.ws + WS_RW + 5 * RW_ARR);
  const float* hg_norm_w = P.in[9]; const float* r_k = P.in[18]; const float* gn_w = P.in[19]; const float* gn_b = P.in[20];
  bfr* mix = (bfr*)(P.ws + WS_MIX);
  const int tid = VT, lane = tid & 63, w = tid >> 6, fr = lane & 15, fq = lane >> 4;
  const f32x4 z4 = {0.f, 0.f, 0.f, 0.f};
  for (int tile = bid; tile < T_LAT / 32; tile += nb) {
    const int t0 = tile * 32;
#pragma unroll 1
    for (int hh = 0; hh < 2; ++hh) {
      const int hd = 2 * w + hh;
      f32x4 acc[4][2];
#pragma unroll
      for (int m = 0; m < 4; ++m) { acc[m][0] = z4; acc[m][1] = z4; }
#pragma unroll
      for (int dir = 0; dir < 2; ++dir) {
        const int ci = dir ? (519 - tile) : (8 + tile);
        const int sc = rw_sc_of_chunk(ci);
        const bfr* Bq = (const bfr*)(P.ws + WS_R2P) + (size_t)dir * T_LAT * 512 + (size_t)t0 * 512 + hd * 64;
        const bfr* Y0 = (const bfr*)(P.ws + WS_Y0P) + (size_t)dir * T_LAT * 512 + (size_t)t0 * 512 + hd * 64;
        const bfr* Sin = (const bfr*)(P.ws + WS_SINRW) + ((size_t)(dir * 8 + hd) * (RW_NSC + 1) + sc) * 4096;
#pragma unroll
        for (int k0 = 0; k0 < 64; k0 += 32) {
          bf16x8 bq[2];
#pragma unroll
          for (int n = 0; n < 2; ++n) bq[n] = *(const bf16x8*)(Bq + (size_t)(16 * n + fr) * 512 + k0 + fq * 8);
#pragma unroll
          for (int m = 0; m < 4; ++m) {
            const bf16x8 a = *(const bf16x8*)(Sin + (16 * m + fr) * 64 + k0 + fq * 8);
#pragma unroll
            for (int n = 0; n < 2; ++n) acc[m][n] = __builtin_amdgcn_mfma_f32_16x16x32_bf16(a, bq[n], acc[m][n], 0, 0, 0);
          }
        }
#pragma unroll
        for (int m = 0; m < 4; ++m)
#pragma unroll
          for (int n = 0; n < 2; ++n) acc[m][n] += ld4bf(Y0 + (size_t)(16 * n + fr) * 512 + 16 * m + 4 * fq);
      }
#pragma unroll
      for (int n = 0; n < 2; ++n) {
        const size_t trow = (size_t)(t0 + 16 * n + fr) * 512 + hd * 64;
        float s = 0.f, bs = 0.f;
        f32x4 vv[4];
#pragma unroll
        for (int m = 0; m < 4; ++m) {
          const int c = 16 * m + 4 * fq;
          s += acc[m][n][0] + acc[m][n][1] + acc[m][n][2] + acc[m][n][3];
          const f32x4 rr = ld4bf(R + trow + c), kk2 = ld4bf(K + trow + c), rk = *(const f32x4*)(r_k + hd * 64 + c);
          vv[m] = ld4bf(V + trow + c);
          bs += rr[0] * kk2[0] * rk[0] + rr[1] * kk2[1] * rk[1] + rr[2] * kk2[2] * rk[2] + rr[3] * kk2[3] * rk[3];
        }
        s += __shfl_xor(s, 16); s += __shfl_xor(s, 32);
        bs += __shfl_xor(bs, 16); bs += __shfl_xor(bs, 32);
        const float mu = s * (1.f / 64.f);
        float q = 0.f;
#pragma unroll
        for (int m = 0; m < 4; ++m) { acc[m][n] -= mu; q += acc[m][n][0] * acc[m][n][0] + acc[m][n][1] * acc[m][n][1] + acc[m][n][2] * acc[m][n][2] + acc[m][n][3] * acc[m][n][3]; }
        q += __shfl_xor(q, 16); q += __shfl_xor(q, 32);
        const float rs = rsqrtf(q * (1.f / 64.f) + 64e-5f);
#pragma unroll
        for (int m = 0; m < 4; ++m) {
          const int c = hd * 64 + 16 * m + 4 * fq;
          const f32x4 gw = *(const f32x4*)(gn_w + c), gb = *(const f32x4*)(gn_b + c), gg = ld4bf(G + trow + 16 * m + 4 * fq);
          const f32x4 o = (acc[m][n] * rs * gw + gb + vv[m] * bs) * gg;
          *(uint2*)(mix + (size_t)(t0 + 16 * n + fr) * DM + 512 + c) = pk4(o);
        }
      }
    }
    {
      const int hd = w;
      f32x4 acc[8][2];
#pragma unroll
      for (int m = 0; m < 8; ++m) { acc[m][0] = z4; acc[m][1] = z4; }
#pragma unroll
      for (int dir = 0; dir < 2; ++dir) {
        const int ci = dir ? (519 - tile) : (8 + tile);
        const int sc = hg_sc_of_chunk(ci);
        const bfr* Bq = (const bfr*)(P.ws + WS_QH) + (size_t)dir * T_LAT * 512 + (size_t)t0 * 512 + hd * 128;
        const bfr* O0 = (const bfr*)(P.ws + WS_O0) + (size_t)dir * T_LAT * 512 + (size_t)t0 * 512 + hd * 128;
        const bfr* Sin = (const bfr*)(P.ws + WS_SINHG) + ((size_t)(dir * 4 + hd) * HG_NSC + sc) * 16384;
#pragma unroll
        for (int k0 = 0; k0 < 128; k0 += 32) {
          bf16x8 bq[2];
#pragma unroll
          for (int n = 0; n < 2; ++n) bq[n] = *(const bf16x8*)(Bq + (size_t)(16 * n + fr) * 512 + k0 + fq * 8);
#pragma unroll
          for (int m = 0; m < 8; ++m) {
            const bf16x8 a = *(const bf16x8*)(Sin + (16 * m + fr) * 128 + k0 + fq * 8);
#pragma unroll
            for (int n = 0; n < 2; ++n) acc[m][n] = __builtin_amdgcn_mfma_f32_16x16x32_bf16(a, bq[n], acc[m][n], 0, 0, 0);
          }
        }
#pragma unroll
        for (int m = 0; m < 8; ++m)
#pragma unroll
          for (int n = 0; n < 2; ++n) acc[m][n] += ld4bf(O0 + (size_t)(16 * n + fr) * 512 + 16 * m + 4 * fq);
      }
#pragma unroll
      for (int n = 0; n < 2; ++n) {
        const int t = t0 + 16 * n + fr;
        float ss = 0.f;
#pragma unroll
        for (int m = 0; m < 8; ++m) ss += acc[m][n][0] * acc[m][n][0] + acc[m][n][1] * acc[m][n][1] + acc[m][n][2] * acc[m][n][2] + acc[m][n][3] * acc[m][n][3];
        ss += __shfl_xor(ss, 16); ss += __shfl_xor(ss, 32);
        const float rs = rsqrtf(ss * (1.f / 128.f) + 1e-6f);
#pragma unroll
        for (int m = 0; m < 8; ++m) {
          const int c = hd * 128 + 16 * m + 4 * fq;
          const f32x4 nw = *(const f32x4*)(hg_norm_w + c), gg = ld4bf(p + (size_t)t * DIN + 2048 + c);
          f32x4 o;
#pragma unroll
          for (int e = 0; e < 4; ++e) o[e] = acc[m][n][e] * rs * nw[e] * siluf_(gg[e]);
          *(uint2*)(mix + (size_t)t * DM + c) = pk4(o);
        }
      }
    }
  }
}

namespace pg8 {
#define PG8_LAS __attribute__((address_space(3)))
typedef unsigned short bf16_t;
typedef short bf16x8 __attribute__((ext_vector_type(8)));
typedef float f32x4 __attribute__((ext_vector_type(4)));
typedef unsigned u32x4 __attribute__((ext_vector_type(4)));
constexpr int BM = 256, BK = 64, HALF = 128, HTB = HALF * BK * 2  , STAGE_BYTES = 8 * HTB, NXCD = 8, WGM = 8;

__host__ __device__ __forceinline__ int lds_byte(int r, int c) { const int st = (r >> 4) * 2 + (c >> 5), rr = r & 15, cc = c & 31, ob = rr * 64 + cc * 2; return st * 1024 + (ob ^ (((ob >> 9) & 1) << 5)); }
__host__ __device__ __forceinline__ void stage_rc(int b, int& R, int& C) { const int st = b / 1024, sb = b % 1024, swz = sb ^ (((sb >> 9) & 1) << 5); R = (st >> 1) * 16 + swz / 64; C = (st & 1) * 32 + (swz % 64) / 2; }
__host__ __device__ __forceinline__ int perm32(int rho) { const int n = rho >> 4, i = rho & 15; return 8 * (i >> 2) + 4 * n + (i & 3); }

struct Unit { int pm, pn; };
struct Gemm { const bf16_t* A; const bf16_t* Bt; int M, N, K; };

struct StaticOrder {
    int nM, nN, nwg, G, c;
    __host__ __device__ void init(int M, int N, int G_, int c_) { nM = M / BM; nN = N / BM; nwg = nM * nN; G = G_; c = c_; }
    __host__ __device__ bool next(int i, Unit& u) const {
        const long L = (long)i * G + c; if (L >= nwg) return false;
        int wgid = (int)L; { const int q = nwg / NXCD, r = nwg % NXCD, xcd = wgid % NXCD, off = wgid / NXCD; wgid = (xcd < r ? xcd * (q + 1) : r * (q + 1) + (xcd - r) * q) + off; }
        const int nig = WGM * nN, gid = wgid / nig, fm = gid * WGM, gsz = (nM - fm) < WGM ? (nM - fm) : WGM;
        u.pm = fm + ((wgid % nig) % gsz); u.pn = (wgid % nig) / gsz; return true;
    }
    __device__ __forceinline__ void a_ready(const Unit&) const {}
    __device__ __forceinline__ void done(const Unit&) const {}
};
struct CountedOrder : StaticOrder {
    const unsigned* ready; unsigned need; unsigned* tmo;
    __device__ __forceinline__ void a_ready(const Unit& u) const {
        if (threadIdx.x < 64) {
            const unsigned long long t0 = __builtin_amdgcn_s_memrealtime(); unsigned polls = 0;
            while ((unsigned)__builtin_amdgcn_readfirstlane(__hip_atomic_load(ready + 64 * u.pm, __ATOMIC_RELAXED, __HIP_MEMORY_SCOPE_AGENT)) < need) {
                if ((++polls & 255u) == 0u && __builtin_amdgcn_readfirstlane(__hip_atomic_load(tmo, __ATOMIC_RELAXED, __HIP_MEMORY_SCOPE_AGENT)) != 0u) break;
                if (__builtin_amdgcn_s_memrealtime() - t0 > 2000000ull) {
                    if (threadIdx.x == 0) { unsigned expect = 0u; __hip_atomic_compare_exchange_strong(tmo + 1, &expect, 0x600u | (unsigned)(u.pm & 0xff), __ATOMIC_RELAXED, __ATOMIC_RELAXED, __HIP_MEMORY_SCOPE_AGENT); __hip_atomic_store(tmo, 1u, __ATOMIC_RELAXED, __HIP_MEMORY_SCOPE_AGENT); }
                    break; }
                __builtin_amdgcn_s_sleep(2); }
            __builtin_amdgcn_fence(__ATOMIC_ACQUIRE, "agent");
            asm volatile("s_waitcnt vmcnt(0)" ::: "memory");
        }
#if !defined(BROKEN_HOOK_NO_BARRIER)
        asm volatile("" ::: "memory"); __builtin_amdgcn_s_barrier(); asm volatile("" ::: "memory");
#endif
    }
};
struct EpiF32 {
    static constexpr bool PERM = false, AFTER_DRAIN = false;
    float* C; int ldc; const float* bias;
    __device__ __forceinline__ void operator()(const f32x4 (&acc)[2][2][4][2], const Unit& u, int wr, int wc, int fr, int fq) const {
        const int row0 = u.pm * BM + wr * 64 + fr, col0 = u.pn * BM + wc * 32 + 4 * fq;
        f32x4 bv[2][2];
#pragma unroll
        for (int bj = 0; bj < 2; ++bj)
#pragma unroll
            for (int n = 0; n < 2; ++n) bv[bj][n] = bias ? *(const f32x4*)(bias + col0 + bj * HALF + n * 16) : (f32x4){0.f, 0.f, 0.f, 0.f};
#pragma unroll
        for (int ai = 0; ai < 2; ++ai)
#pragma unroll
            for (int m = 0; m < 4; ++m) { float* rowp = C + (size_t)(row0 + ai * HALF + m * 16) * ldc + col0;
#pragma unroll
                for (int bj = 0; bj < 2; ++bj)
#pragma unroll
                    for (int n = 0; n < 2; ++n) *(f32x4*)(rowp + bj * HALF + n * 16) = acc[ai][bj][m][n] + bv[bj][n]; }
    }
};
template <class Epi, class Sched, bool STAMP = false>
__device__ __forceinline__ void gemm_phase(PG8_LAS unsigned char* lds, const Gemm g, const Sched& S, const Epi& E, unsigned long long* stamps) {
    int tid_ = threadIdx.x; asm volatile("" : "+v"(tid_));
    const int tid = tid_, wid = __builtin_amdgcn_readfirstlane(tid >> 6), lane = tid & 63, wr = wid >> 2, wc = wid & 3, fr = lane & 15, fq = lane >> 4;
    const int K = g.K, nt = K / BK;
    int ts_lo = 0, ts_hi = 0, nts = 0; const unsigned long long rt_entry = STAMP ? (unsigned long long)wall_clock64() : 0ull;
#define PG8_STAMP() do { if (STAMP && wid == 0 && nts < 64) { const unsigned long long _c = (unsigned long long)clock64(); \
        ts_lo = (lane == nts) ? (int)(unsigned)_c : ts_lo; ts_hi = (lane == nts) ? (int)(unsigned)(_c >> 32) : ts_hi; ++nts; } } while (0)
    PG8_STAMP();
    unsigned voffA[2], voffB[2];
#pragma unroll
    for (int i = 0; i < 2; ++i) { int R, C; stage_rc(tid * 16 + i * 8192, R, C); const int Rb = Epi::PERM ? ((R & ~31) + perm32(R & 31)) : R;
        voffA[i] = (unsigned)(R * K + C) * 2u; voffB[i] = (unsigned)(Rb * K + C) * 2u; }
    const size_t kstep = (size_t)(BK * 2);
    const size_t hstep = (size_t)HALF * K * 2;
    const size_t tstep = 2 * hstep;
    const unsigned ldsw = (unsigned)wid * 1024u;
    const int aoff = lds_byte(wr * 64 + fr, fq * 8), boff = lds_byte(wc * 32 + fr, fq * 8);
#define PG8_SA(b, h) (((b) * 2 + (h)) * HTB)
#define PG8_SB(b, h) ((4 + (b) * 2 + (h)) * HTB)
#define PG8_STAGE(bufoff, gbase, voff) do { _Pragma("unroll") for (int _i = 0; _i < 2; ++_i) \
        __builtin_amdgcn_global_load_lds((const unsigned*)((const char*)(gbase) + (voff)[_i]), (PG8_LAS unsigned*)(lds + (bufoff) + ldsw + _i * 8192), 16, 0, 0); } while (0)
#define PG8_LDA(dst, b, h) do { _Pragma("unroll") for (int m = 0; m < 4; ++m) _Pragma("unroll") for (int k = 0; k < 2; ++k) dst[m][k] = *(const PG8_LAS bf16x8*)(lds + PG8_SA(b, h) + aoff + m * 2048 + k * 1024); } while (0)
#define PG8_LDB(dst, b, h) do { _Pragma("unroll") for (int n = 0; n < 2; ++n) _Pragma("unroll") for (int k = 0; k < 2; ++k) dst[n][k] = *(const PG8_LAS bf16x8*)(lds + PG8_SB(b, h) + boff + n * 2048 + k * 1024); } while (0)
#define PG8_MMA(ai, bj, At, Bt) do { __builtin_amdgcn_s_setprio(1); _Pragma("unroll") for (int m = 0; m < 4; ++m) _Pragma("unroll") for (int n = 0; n < 2; ++n) _Pragma("unroll") for (int k = 0; k < 2; ++k) \
        acc[ai][bj][m][n] = __builtin_amdgcn_mfma_f32_16x16x32_bf16(Bt[n][k], At[m][k], acc[ai][bj][m][n], 0, 0, 0); __builtin_amdgcn_s_setprio(0); } while (0)
#define PG8_WAIT_V(n) asm volatile("s_waitcnt vmcnt(" #n ")" ::: "memory")
#define PG8_WAIT_L(n) asm volatile("s_waitcnt lgkmcnt(" #n ")" ::: "memory")
#define PG8_BAR __builtin_amdgcn_s_barrier()
#define PG8_SCHED __builtin_amdgcn_sched_barrier(0)
    Unit cur, nxt; int ui = 0;
    if (!S.next(0, cur)) return;
    f32x4 acc[2][2][4][2];
#pragma unroll
    for (int a = 0; a < 2; ++a)
#pragma unroll
        for (int b = 0; b < 2; ++b)
#pragma unroll
            for (int m = 0; m < 4; ++m)
#pragma unroll
                for (int n = 0; n < 2; ++n) acc[a][b][m][n] = (f32x4){0.f, 0.f, 0.f, 0.f};
    bf16x8 At[4][2], B0[2][2], B1[2][2];
    const char* cA = (const char*)g.A + (size_t)cur.pm * tstep; const char* cB = (const char*)g.Bt + (size_t)cur.pn * tstep;
    S.a_ready(cur);
    PG8_STAGE(PG8_SB(0, 0), cB, voffB); PG8_STAGE(PG8_SA(0, 0), cA, voffA); PG8_STAGE(PG8_SB(0, 1), cB + hstep, voffB); PG8_STAGE(PG8_SA(0, 1), cA + hstep, voffA);
    if (wr == 1) PG8_BAR;
    PG8_WAIT_V(4); PG8_BAR;
    PG8_STAGE(PG8_SB(1, 0), cB + kstep, voffB); PG8_STAGE(PG8_SA(1, 0), cA + kstep, voffA); PG8_STAGE(PG8_SB(1, 1), cB + hstep + kstep, voffB);
    PG8_WAIT_V(6); PG8_BAR;
    PG8_STAMP();
    for (;;) {
        const bool has_next = S.next(ui + 1, nxt);
        const char* nA = has_next ? (const char*)g.A + (size_t)nxt.pm * tstep : cA; const char* nB = has_next ? (const char*)g.Bt + (size_t)nxt.pn * tstep : cB;
        for (int t = 0; t < nt; t += 2) {
            const bool last = (t == nt - 2);
            const char* a1 = cA + (size_t)(t + 1) * kstep;
            const char* a2 = last ? nA : cA + (size_t)(t + 2) * kstep; const char* b2 = last ? nB : cB + (size_t)(t + 2) * kstep;
            const char* a3 = a2 + kstep; const char* b3 = b2 + kstep;
            if (last && has_next) S.a_ready(nxt);
            PG8_LDB(B0, 0, 0); PG8_SCHED; PG8_LDA(At, 0, 0); PG8_STAGE(PG8_SA(1, 1), a1 + hstep, voffA);
            PG8_WAIT_L(8); PG8_BAR; PG8_WAIT_L(0); PG8_MMA(0, 0, At, B0); PG8_BAR; PG8_SCHED;
            PG8_LDB(B1, 0, 1); PG8_STAGE(PG8_SB(0, 0), b2, voffB);
            PG8_BAR; PG8_WAIT_L(0); PG8_MMA(0, 1, At, B1); PG8_BAR;
            PG8_LDA(At, 0, 1); PG8_STAGE(PG8_SA(0, 0), a2, voffA);
            PG8_BAR; PG8_WAIT_L(0); PG8_MMA(1, 0, At, B0); PG8_BAR; PG8_SCHED;
            PG8_STAGE(PG8_SB(0, 1), b2 + hstep, voffB);
            PG8_WAIT_V(6); PG8_BAR; PG8_MMA(1, 1, At, B1); PG8_BAR;
            PG8_LDB(B0, 1, 0); PG8_SCHED; PG8_LDA(At, 1, 0); PG8_STAGE(PG8_SA(0, 1), a2 + hstep, voffA);
            PG8_WAIT_L(8); PG8_BAR; PG8_WAIT_L(0); PG8_MMA(0, 0, At, B0); PG8_BAR; PG8_SCHED;
            PG8_LDB(B1, 1, 1); PG8_STAGE(PG8_SB(1, 0), b3, voffB);
            PG8_BAR; PG8_WAIT_L(0); PG8_MMA(0, 1, At, B1); PG8_BAR;
            PG8_LDA(At, 1, 1); PG8_STAGE(PG8_SA(1, 0), a3, voffA);
            PG8_BAR; PG8_WAIT_L(0); PG8_MMA(1, 0, At, B0); PG8_BAR; PG8_SCHED;
            PG8_STAGE(PG8_SB(1, 1), b3 + hstep, voffB);
            PG8_WAIT_V(6); PG8_BAR; PG8_MMA(1, 1, At, B1); PG8_BAR;
        }
        PG8_STAMP();
        if constexpr (!Epi::AFTER_DRAIN) { E(acc, cur, wr, wc, fr, fq); S.done(cur); }
        PG8_STAMP();
        if (!has_next) break;
#pragma unroll
        for (int a = 0; a < 2; ++a)
#pragma unroll
            for (int b = 0; b < 2; ++b)
#pragma unroll
                for (int m = 0; m < 4; ++m)
#pragma unroll
                    for (int n = 0; n < 2; ++n) acc[a][b][m][n] = (f32x4){0.f, 0.f, 0.f, 0.f};
        cur = nxt; cA = nA; cB = nB; ++ui;
    }
    PG8_WAIT_V(0);
    if (wr == 0) PG8_BAR;
    PG8_BAR;
    if constexpr (Epi::AFTER_DRAIN) { E.fused(acc, cur, wr, wc, fr, fq, lds, wid, lane); S.done(cur); }
    PG8_STAMP();
    if (STAMP && wid == 0) { stamps[lane] = lane < nts ? (((unsigned long long)(unsigned)ts_hi << 32) | (unsigned)ts_lo) : 0ull;
        if (lane == 62) stamps[62] = rt_entry; if (lane == 63) stamps[63] = (unsigned long long)wall_clock64(); }
#undef PG8_STAMP
#undef PG8_SA
#undef PG8_SB
#undef PG8_STAGE
#undef PG8_LDA
#undef PG8_LDB
#undef PG8_MMA
#undef PG8_WAIT_V
#undef PG8_WAIT_L
#undef PG8_BAR
#undef PG8_SCHED
}
}

constexpr size_t WS_WINT = 284 * MB;
constexpr size_t WS_WOUTT = 1 * MB;
constexpr int NPAD_IN = 4352;
DI void transpose_tile(const float* W, int ldw, int k0, int n0, int nvalid, bfr* WT, int ldt, char* smem) {
  short* T = (short*)smem;
  const int tid = VT;
  __syncthreads();
  {
    const int r = tid >> 2, c4 = tid & 3;
#pragma unroll
    for (int q = 0; q < 4; ++q) {
      const int n = n0 + 16 * c4 + 4 * q;
      f32x4 v = {0.f, 0.f, 0.f, 0.f};
      if (n < nvalid) v = *(const f32x4*)(W + (size_t)(k0 + r) * ldw + n);
#pragma unroll
      for (int e = 0; e < 4; ++e) T[r * 66 + 16 * c4 + 4 * q + e] = (short)f2bf(v[e]);
    }
  }
  __syncthreads();
  {
    const int n = tid >> 2, kq = tid & 3;
    unsigned wv[8];
#pragma unroll
    for (int e = 0; e < 8; ++e) wv[e] = ((unsigned)(unsigned short)T[(16 * kq + 2 * e) * 66 + n]) | (((unsigned)(unsigned short)T[(16 * kq + 2 * e + 1) * 66 + n]) << 16);
    bfr* dst = WT + (size_t)(n0 + n) * ldt + k0 + 16 * kq;
    *(uint4*)dst = uint4{wv[0], wv[1], wv[2], wv[3]};
    *(uint4*)(dst + 8) = uint4{wv[4], wv[5], wv[6], wv[7]};
  }
}
template <int LDC, int NVALID> struct EpiBf16T {
  static constexpr bool PERM = true, AFTER_DRAIN = false;
  bfr* O;
  DI void operator()(const pg8::f32x4 (&acc)[2][2][4][2], const pg8::Unit& u, int wr, int wc, int fr, int fq) const {
    const int row0 = u.pm * 256 + wr * 64 + fr, col0 = u.pn * 256 + wc * 32 + 8 * fq;
#pragma unroll
    for (int ai = 0; ai < 2; ++ai)
#pragma unroll
      for (int m = 0; m < 4; ++m) {
        bfr* rowp = O + (size_t)(row0 + ai * 128 + m * 16) * LDC + col0;
#pragma unroll
        for (int bj = 0; bj < 2; ++bj) {
          if (col0 + bj * 128 < NVALID) {
            const pg8::f32x4 v0 = acc[ai][bj][m][0], v1 = acc[ai][bj][m][1];
            *(uint4*)(rowp + bj * 128) = uint4{pack2(v0[0], v0[1]), pack2(v0[2], v0[3]), pack2(v1[0], v1[1]), pack2(v1[2], v1[3])};
          }
        }
      }
  }
};
DI void phase_pgemm8(CParams& P, char* smem_all) {
  pg8::Gemm g{(const pg8::bf16_t*)(P.ws + WS_H), (const pg8::bf16_t*)(P.ws + WS_WINT), T_ALL, NPAD_IN, DM};
  pg8::StaticOrder S; S.init(T_ALL, NPAD_IN, (int)gridDim.x, (int)blockIdx.x);
  typedef EpiBf16T<DIN, DIN> EpiP;
  EpiP E{(bfr*)(P.ws + WS_P)};
  pg8::gemm_phase<EpiP, pg8::StaticOrder>((PG8_LAS unsigned char*)smem_all, g, S, E, nullptr);
}
DI void phase_outproj8(CParams& P, char* smem_all) {
  pg8::Gemm g{(const pg8::bf16_t*)(P.ws + WS_MIX), (const pg8::bf16_t*)(P.ws + WS_WOUTT), T_LAT, DM, DM};
  pg8::StaticOrder S; S.init(T_LAT, DM, (int)gridDim.x, (int)blockIdx.x);
  typedef EpiBf16T<DM, DM> EpiY;
  EpiY E{(bfr*)(P.ws + WS_Y)};
  pg8::gemm_phase<EpiY, pg8::StaticOrder>((PG8_LAS unsigned char*)smem_all, g, S, E, nullptr);
}


constexpr size_t WS_BTGU = 350 * MB;
constexpr size_t WS_BTD = 284 * MB;
constexpr size_t WS_XB = 186 * MB;
constexpr size_t WS_HID8 = 138 * MB;
constexpr size_t WS_MOUT8 = 42 * MB;
constexpr int TAB_LDS_OFF = 131072 + 1024;

DI void transpose_quad(const float* W, int ldw, int k0, int n0, bfr* WT, int ldt, int dr0, int dr1, int dr2, int dr3, char* smem, int nvalid = 1 << 30) {
  short* T = (short*)smem;
  const int tid = VT;
  const int r = tid >> 2, c4 = tid & 3;
  f32x4 v[4][4];
#pragma unroll
  for (int j = 0; j < 4; ++j)
#pragma unroll
    for (int q = 0; q < 4; ++q) { const int n_ = n0 + j * 64 + 16 * c4 + 4 * q; v[j][q] = n_ < nvalid ? *(const f32x4*)(W + (size_t)(k0 + r) * ldw + n_) : f32x4{0.f, 0.f, 0.f, 0.f}; }
  __syncthreads();
#pragma unroll
  for (int j = 0; j < 4; ++j)
#pragma unroll
    for (int q = 0; q < 4; ++q)
#pragma unroll
      for (int e = 0; e < 4; ++e) T[j * 64 * 66 + r * 66 + 16 * c4 + 4 * q + e] = (short)f2bf(v[j][q][e]);
  __syncthreads();
  const int n = tid >> 2, kq = tid & 3;
#pragma unroll
  for (int j = 0; j < 4; ++j) {
    unsigned wv[8];
#pragma unroll
    for (int e = 0; e < 8; ++e) wv[e] = ((unsigned)(unsigned short)T[j * 64 * 66 + (16 * kq + 2 * e) * 66 + n]) | (((unsigned)(unsigned short)T[j * 64 * 66 + (16 * kq + 2 * e + 1) * 66 + n]) << 16);
    const int dr = j == 0 ? dr0 : j == 1 ? dr1 : j == 2 ? dr2 : dr3;
    bfr* dst = WT + (size_t)(dr + n) * ldt + k0 + 16 * kq;
    *(uint4*)dst = uint4{wv[0], wv[1], wv[2], wv[3]};
    *(uint4*)(dst + 8) = uint4{wv[4], wv[5], wv[6], wv[7]};
  }
}
DI void phase_moe_convert_gu(CParams& P, int bid, int nb, char* smem) {
  for (int it = bid; it < 64 * 64; it += nb) {
    const int e = it >> 6, s = it & 63;
    const int isup = s >> 5, kt = (s & 31) >> 1, nq = s & 1;
    const float* W = (isup ? P.in[30] : P.in[29]) + (size_t)e * DM * DEXP;
    bfr* WT = (bfr*)(P.ws + WS_BTGU) + (size_t)e * 1024 * 1024;
    const int b = nq * 4;
    transpose_quad(W, DEXP, kt * 64, nq * 256, WT, 1024,
                   ((b + 0) >> 1) * 256 + isup * 128 + ((b + 0) & 1) * 64, ((b + 1) >> 1) * 256 + isup * 128 + ((b + 1) & 1) * 64,
                   ((b + 2) >> 1) * 256 + isup * 128 + ((b + 2) & 1) * 64, ((b + 3) >> 1) * 256 + isup * 128 + ((b + 3) & 1) * 64, smem);
  }
}
DI void phase_moe_convert_d(CParams& P, int bid, int nb, char* smem) {
  for (int it = bid; it < 64 * 32; it += nb) {
    const int e = it >> 5, s2 = it & 31, kt = s2 >> 2, nq = s2 & 3;
    const float* W = P.in[31] + (size_t)e * DEXP * DM;
    bfr* WT = (bfr*)(P.ws + WS_BTD) + (size_t)e * 1024 * 512;
    transpose_quad(W, DM, kt * 64, nq * 256, WT, 512, nq * 256, nq * 256 + 64, nq * 256 + 128, nq * 256 + 192, smem);
  }
}
DI void moe_block_table256(CParams& P, int* tab  ) {
  const int* cnt = (const int*)(P.ws + WS_CNT);
  __syncthreads();
  const int t = tx_();
  if (t < 64) {
    int incl = (cnt[t] + 255) >> 8;
#pragma unroll
    for (int o = 1; o < 64; o <<= 1) { int u = __shfl_up(incl, o); if (t >= o) incl += u; }
    tab[t + 1] = incl;
    if (t == 0) tab[0] = 0;
  }
  __syncthreads();
}
DI void phase_moe_gather(CParams& P, char* smem_all) {
  const bfr* h2 = (const bfr*)(P.ws + WS_H2);
  const int* cnt = (const int*)(P.ws + WS_CNT); const int* list = (const int*)(P.ws + WS_LIST);
  bfr* xb = (bfr*)(P.ws + WS_XB);
  int* tab = (int*)(smem_all + TAB_LDS_OFF);
  moe_block_table256(P, tab);
  const int nrows = tab[64] * 256;
  const int wv = threadIdx.x >> 6, lane = threadIdx.x & 63;
  for (int row0 = (blockIdx.x * 8 + wv) * 4; row0 < nrows; row0 += gridDim.x * 32) {
    const int rb = row0 >> 8;
    int e = 0; while (tab[e + 1] <= rb) ++e;
    const int idx0 = (rb - tab[e]) * 256 + (row0 & 255), ce = cnt[e];
    const int* lp = list + e * T_LAT + idx0;
    const int t0 = idx0 + 0 < ce ? (lp[0] >> 1) : -1, t1 = idx0 + 1 < ce ? (lp[1] >> 1) : -1, t2 = idx0 + 2 < ce ? (lp[2] >> 1) : -1, t3 = idx0 + 3 < ce ? (lp[3] >> 1) : -1;
    const bfr* s0 = h2 + (size_t)(t0 < 0 ? 0 : t0) * DM + lane * 8; const bfr* s1 = h2 + (size_t)(t1 < 0 ? 0 : t1) * DM + lane * 8;
    const bfr* s2 = h2 + (size_t)(t2 < 0 ? 0 : t2) * DM + lane * 8; const bfr* s3 = h2 + (size_t)(t3 < 0 ? 0 : t3) * DM + lane * 8;
    const uint4 a0 = *(const uint4*)s0, b0 = *(const uint4*)(s0 + 512), a1 = *(const uint4*)s1, b1 = *(const uint4*)(s1 + 512);
    const uint4 a2 = *(const uint4*)s2, b2 = *(const uint4*)(s2 + 512), a3 = *(const uint4*)s3, b3 = *(const uint4*)(s3 + 512);
    bfr* d = xb + (size_t)row0 * DM + lane * 8;
    if (t0 >= 0) { *(uint4*)d = a0; *(uint4*)(d + 512) = b0; }
    if (t1 >= 0) { *(uint4*)(d + DM) = a1; *(uint4*)(d + DM + 512) = b1; }
    if (t2 >= 0) { *(uint4*)(d + 2 * DM) = a2; *(uint4*)(d + 2 * DM + 512) = b2; }
    if (t3 >= 0) { *(uint4*)(d + 3 * DM) = a3; *(uint4*)(d + 3 * DM + 512) = b3; }
  }
}
struct MoeOrder {
  const int* tab; int nunits, G, c;
  DI bool next(int i, pg8::Unit& u) const {
    const int L = i * G + c; if (L >= nunits) return false;
    const int rb = L >> 2; int e = 0; while (tab[e + 1] <= rb) ++e;
    u.pm = rb; u.pn = e * 4 + (L & 3); return true;
  }
  DI void a_ready(const pg8::Unit&) const {}
  DI void done(const pg8::Unit&) const {}
};
struct EpiHid {
  static constexpr bool PERM = true, AFTER_DRAIN = false;
  bfr* H;
  DI void operator()(const pg8::f32x4 (&acc)[2][2][4][2], const pg8::Unit& u, int wr, int wc, int fr, int fq) const {
    const int row0 = u.pm * 256 + wr * 64 + fr, col0 = (u.pn & 3) * 128 + wc * 32 + 8 * fq;
#pragma unroll
    for (int ai = 0; ai < 2; ++ai)
#pragma unroll
      for (int m = 0; m < 4; ++m) {
        float hv[8];
#pragma unroll
        for (int n = 0; n < 2; ++n)
#pragma unroll
          for (int j = 0; j < 4; ++j) hv[4 * n + j] = siluf_(acc[ai][0][m][n][j]) * acc[ai][1][m][n][j];
        *(uint4*)(H + (size_t)(row0 + ai * 128 + m * 16) * DEXP + col0) = uint4{pack2(hv[0], hv[1]), pack2(hv[2], hv[3]), pack2(hv[4], hv[5]), pack2(hv[6], hv[7])};
      }
  }
};
struct EpiMout {
  static constexpr bool PERM = true, AFTER_DRAIN = false;
  bfr* O; const int* tab; const int* cnt; const int* list;
  DI void operator()(const pg8::f32x4 (&acc)[2][2][4][2], const pg8::Unit& u, int wr, int wc, int fr, int fq) const {
    const int e = u.pn >> 2, pnl = u.pn & 3;
    const int lrow0 = (u.pm - tab[e]) * 256 + wr * 64 + fr, ce = cnt[e];
    const int col0 = pnl * 256 + wc * 32 + 8 * fq;
#pragma unroll
    for (int ai = 0; ai < 2; ++ai)
#pragma unroll
      for (int m = 0; m < 4; ++m) {
        const int idx = lrow0 + ai * 128 + m * 16;
        if (idx < ce) {
          const int asg = list[e * T_LAT + idx];
          bfr* rowp = O + (size_t)asg * DM + col0;
#pragma unroll
          for (int bj = 0; bj < 2; ++bj) {
            const pg8::f32x4 v0 = acc[ai][bj][m][0], v1 = acc[ai][bj][m][1];
            *(uint4*)(rowp + bj * 128) = uint4{pack2(v0[0], v0[1]), pack2(v0[2], v0[3]), pack2(v1[0], v1[1]), pack2(v1[2], v1[3])};
          }
        }
      }
  }
};
DI void phase_moe1_8(CParams& P, char* smem_all) {
  int* tab = (int*)(smem_all + TAB_LDS_OFF);
  moe_block_table256(P, tab);
  const int nrb = tab[64];
  pg8::Gemm g{(const pg8::bf16_t*)(P.ws + WS_XB), (const pg8::bf16_t*)(P.ws + WS_BTGU), nrb * 256, 64 * 1024, DM};
  MoeOrder S{tab, nrb * 4, (int)gridDim.x, (int)blockIdx.x};
  EpiHid E{(bfr*)(P.ws + WS_HID8)};
  pg8::gemm_phase<EpiHid, MoeOrder>((PG8_LAS unsigned char*)smem_all, g, S, E, nullptr);
}
DI void phase_moe2_8(CParams& P, char* smem_all) {
  int* tab = (int*)(smem_all + TAB_LDS_OFF);
  moe_block_table256(P, tab);
  const int nrb = tab[64];
  pg8::Gemm g{(const pg8::bf16_t*)(P.ws + WS_HID8), (const pg8::bf16_t*)(P.ws + WS_BTD), nrb * 256, 64 * 1024, DEXP};
  MoeOrder S{tab, nrb * 4, (int)gridDim.x, (int)blockIdx.x};
  EpiMout E{(bfr*)(P.ws + WS_MOUT8), tab, (const int*)(P.ws + WS_CNT), (const int*)(P.ws + WS_LIST)};
  pg8::gemm_phase<EpiMout, MoeOrder>((PG8_LAS unsigned char*)smem_all, g, S, E, nullptr);
}

#define XB_TMO      128
#define XB_XCNT(j)  (256  + 64 * (j))
#define XB_XSUB(j)  (1280 + 64 * (j))
#define XB_XGEN(j)  (2304 + 64 * (j))
#define XB_TOP      3328
#define XB_TOPGEN   3392
#define XCD_BAR_WORDS 3456
#define XB_SPIN_CAP (1u << 22)
#define LAS __attribute__((address_space(3)))
DI unsigned xb_ld(unsigned* p)              { return __hip_atomic_load(p, __ATOMIC_RELAXED, __HIP_MEMORY_SCOPE_AGENT); }
DI unsigned xb_add(unsigned* p, unsigned v) { return __hip_atomic_fetch_add(p, v, __ATOMIC_RELAXED, __HIP_MEMORY_SCOPE_AGENT); }
DI unsigned xb_xcc_id() { return (unsigned)__builtin_amdgcn_s_getreg((3 << 11) | 20) & 0xFu; }
#define XB_SPIN(cond, bar) do { unsigned _sp = 0; while (cond) { __builtin_amdgcn_s_sleep(1); \
    if ((++_sp & 255u) == 0u) { if (xb_ld(&(bar)[XB_TMO])) break; if (_sp > XB_SPIN_CAP) { atomicAdd(&(bar)[XB_TMO], 1u); break; } } } } while (0)
struct XcdBarrier { unsigned* bar; unsigned x; volatile LAS unsigned* st; };
DI XcdBarrier xcd_barrier_post(unsigned* bar, volatile LAS unsigned* st) {
  XcdBarrier b; b.bar = bar; b.x = xb_xcc_id(); b.st = st;
  if (threadIdx.x == 0) (void)xb_add(&bar[XB_XCNT(b.x)], 1u);
  return b;
}
DI void xcd_barrier_complete(unsigned* bar, unsigned x, unsigned& nloc, unsigned& nx) {
  const unsigned G = gridDim.x * gridDim.y * gridDim.z;
  unsigned sum, cnt, mine, sp = 0u;
  for (;;) {
    sum = 0u; cnt = 0u; mine = 0u;
#pragma unroll
    for (unsigned j = 0; j < 16; ++j) { const unsigned c = xb_ld(&bar[XB_XCNT(j)]); sum += c; cnt += (c > 0u) ? 1u : 0u; mine = (j == x) ? c : mine; }
    if (sum == G) break;
    __builtin_amdgcn_s_sleep(1);
    if ((++sp & 255u) == 0u) { if (xb_ld(&bar[XB_TMO])) break; if (sp > XB_SPIN_CAP) { atomicAdd(&bar[XB_TMO], 1u); break; } }
  }
  nloc = mine > 0u ? mine : 1u; nx = cnt > 0u ? cnt : 1u;
}
DI void xcd_barrier(const XcdBarrier& b) {
  asm volatile("s_waitcnt vmcnt(0)" ::: "memory");
  __syncthreads();
  if (threadIdx.x == 0) {
    unsigned* bar = b.bar;
    __builtin_amdgcn_s_waitcnt(0);
    unsigned nloc = b.st[0], nx = b.st[1];
    if (nloc == 0u) { xcd_barrier_complete(bar, b.x, nloc, nx); b.st[0] = nloc; b.st[1] = nx; }
    const unsigned old = xb_add(&bar[XB_XSUB(b.x)], 1u);
    const unsigned gen = old / nloc;
    if (old + 1u == (gen + 1u) * nloc) {
      __builtin_amdgcn_fence(__ATOMIC_RELEASE, "agent");
      asm volatile("s_waitcnt vmcnt(0)" ::: "memory");
      const unsigned og = xb_add(&bar[XB_TOP], 1u);
      const unsigned tg = og / nx;
      if (og + 1u == (tg + 1u) * nx) xb_add(&bar[XB_TOPGEN], 1u);
      else XB_SPIN(xb_ld(&bar[XB_TOPGEN]) == tg, bar);
      __builtin_amdgcn_fence(__ATOMIC_ACQUIRE, "agent");
      xb_add(&bar[XB_XGEN(b.x)], 1u);
      asm volatile("s_waitcnt vmcnt(0)" ::: "memory");
    } else {
      XB_SPIN(xb_ld(&bar[XB_XGEN(b.x)]) == gen, bar);
      __builtin_amdgcn_fence(__ATOMIC_ACQUIRE, "agent");
      asm volatile("s_waitcnt vmcnt(0)" ::: "memory");
    }
  }
  __syncthreads();
}

namespace cg = cooperative_groups;
constexpr int HALF_LDS = 78080;
constexpr int SMEM_BYTES = 2 * HALF_LDS + 16;
__global__ void __launch_bounds__(NTHR_BLOCK) k_fused(Params Pval) {
  __shared__ __attribute__((aligned(16))) char smem_all[SMEM_BYTES];
  cg::grid_group grid = cg::this_grid();
  CParams* kp0 = (CParams*)__builtin_amdgcn_kernarg_segment_ptr();
#define PH(call) do { CParams* kp_ = kp0; asm volatile("" : "+s"(kp_)); CParams& P = *kp_; \
    int half = __builtin_amdgcn_readfirstlane((int)(threadIdx.x >> 8)); asm volatile("" : "+s"(half)); \
    char* smem = smem_all + half * HALF_LDS; const int bid = blockIdx.x * 2 + half, nb = gridDim.x * 2; (void)smem; (void)bid; (void)nb; call; } while (0)
  volatile LAS unsigned* bst = (volatile LAS unsigned*)(smem_all + SMEM_BYTES - 16);
  if (threadIdx.x < 4) bst[threadIdx.x] = 0u;
  __syncthreads();
  XcdBarrier xb = xcd_barrier_post(Pval.bar, bst);
#define GSYNC() do { if (Pval.use_cg) grid.sync(); else xcd_barrier(xb); } while (0)
  PH(phase_mod(P, bid, nb, smem));
  GSYNC();
  PH(phase_ln1(P, bid, nb));
  GSYNC();
  PH(phase_pgemm8(P, smem_all));
  GSYNC();
  PH(phase_rwprep(P, bid, nb, smem));
  GSYNC();
  PH(for (int it = bid; it < 16 * RW_NSC; it += nb) rw_levelA_item(P, it / RW_NSC, it % RW_NSC, smem));
  PH(for (int it = bid; it < 8 * HG_NSC; it += nb) hg_levelA_item(P, it / HG_NSC, it % HG_NSC, smem));
  GSYNC();
  PH(if (bid < 16) rw_levelB_chain(P, bid, smem); else { hg_levelB(P, bid - 16, nb - 16); phase_moe_convert_d(P, bid - 16, nb - 16, smem); });
  GSYNC();
  PH(phase_readout_fused(P, bid, nb));
  GSYNC();
  PH(phase_outproj8(P, smem_all));
  PH(phase_moe_convert_gu(P, bid, nb, smem));
  GSYNC();
  PH(phase_ln2route(P, smem_all));
  GSYNC();
  PH(phase_moe_gather(P, smem_all));
  GSYNC();
  PH(phase_moe1_8(P, smem_all));
  GSYNC();
  PH(phase_moe2_8(P, smem_all));
  GSYNC();
  PH(phase_final(P, bid, nb));
}

extern "C" void kernel_launch(void* const* d_in, const int* in_sizes, int n_in, void* d_out, int out_size, void* d_ws, size_t ws_size, hipStream_t stream) {
  static int grid_blocks = 0;
  if (!grid_blocks) {
    int dev = 0, cus = 0, per_cu = 0;
    hipGetDevice(&dev);
    hipDeviceGetAttribute(&cus, hipDeviceAttributeMultiprocessorCount, dev);
    hipOccupancyMaxActiveBlocksPerMultiprocessor(&per_cu, k_fused, NTHR_BLOCK, 0);
    if (per_cu > 1) per_cu = 1;
    if (per_cu < 1) per_cu = 1;
    grid_blocks = cus * per_cu;
  }
  Params P{};
  P.bar = (unsigned*)((char*)d_ws + WS_BAR); P.use_cg = 0; P.pad = 0;
  hipMemsetAsync((char*)d_ws + WS_BAR, 0, XCD_BAR_WORDS * 4, stream);
  for (int i = 0; i < 32; ++i) P.in[i] = (const float*)d_in[i];
  P.out = (float*)d_out; P.ws = (char*)d_ws;
  void* args[] = {&P};
  hipError_t e = hipLaunchCooperativeKernel((void*)k_fused, dim3(grid_blocks), dim3(NTHR_BLOCK), args, 0, stream);
  if (e != hipSuccess) fprintf(stderr, "cooperative launch failed: %s (grid %d)\n", hipGetErrorString(e), grid_blocks);
}
```

```cpp
#include <hip/hip_runtime.h>
#include <hip/hip_cooperative_groups.h>
#include <cstdio>

typedef __attribute__((ext_vector_type(8))) short bf16x8;
typedef __attribute__((ext_vector_type(4))) short s16x4;
typedef __attribute__((ext_vector_type(4))) float f32x4;
typedef __attribute__((ext_vector_type(2))) float f32x2;
typedef __attribute__((ext_vector_type(2))) __bf16 bf16x2_t;
typedef unsigned short bfr;

#define DI __device__ __forceinline__

constexpr int T_LAT = 16384, T_CTX = 256, T_ALL = T_LAT + T_CTX;
constexpr int DM = 1024, DIN = 4288, HGC = 2560, RWC = 1728, DRW = 512, DHG = 512;
constexpr int NEXP = 64, DEXP = 512;
constexpr int NTHR = 256;
constexpr int NTHR_BLOCK = 512;
#define VT ((int)(threadIdx.x & 255))
__device__ __forceinline__ int tx_() { int t = (int)threadIdx.x; asm volatile("" : "+v"(t)); return t; }
constexpr float DN_ALPHA = 1.189207115002721f;
constexpr float RW_DECAY_SCALE = 0.6065306597126334f;

constexpr size_t MB = 1ull << 20;
constexpr size_t WS_MOD = 0;
constexpr size_t WS_MODC = 32768;
constexpr size_t WS_LB = 65536;
constexpr size_t WS_CNT = 65536 + 8192;
constexpr size_t WS_BAR = 81920;
constexpr size_t WS_ASGW = 131072;
constexpr size_t WS_LIST = 1 * MB;
constexpr size_t WS_H = 6 * MB;
constexpr size_t WS_P = 42 * MB;
constexpr size_t WS_Y = 42 * MB;
constexpr size_t WS_H2 = 106 * MB;
constexpr size_t WS_HID = 138 * MB;
constexpr size_t WS_RW = 186 * MB;
constexpr size_t RW_ARR = (size_t)T_ALL * 512 * 2;
constexpr size_t WS_X1B = 6 * MB;
constexpr size_t WS_MIX = WS_RW + 3 * RW_ARR;
constexpr size_t WS_LW = 284 * MB;
constexpr size_t LW_ARR = (size_t)T_ALL * 512 * 4;
constexpr size_t WS_YRW = 350 * MB;
constexpr size_t WS_OHG = 414 * MB;
constexpr size_t WS_MOUT = 186 * MB;

struct Params {
  const float* in[32];
  float* out;
  char* ws;
  unsigned* bar;
  int use_cg;
  int pad;
};
typedef const __attribute__((address_space(4))) Params CParams;

DI unsigned pack2(float a, float b) {
  f32x2 v = {a, b};
  bf16x2_t r = __builtin_convertvector(v, bf16x2_t);
  return __builtin_bit_cast(unsigned, r);
}
DI bfr f2bf(float a) { return (bfr)(pack2(a, 0.f) & 0xffffu); }
DI float bf2f(bfr v) { return __uint_as_float(((unsigned)v) << 16); }
DI float frcp_(float x) { return __builtin_amdgcn_rcpf(x); }
DI float sigmoidf_(float x) { return frcp_(1.f + __expf(-x)); }
DI float siluf_(float x) { return x * frcp_(1.f + __expf(-x)); }
DI f32x4 ld4bf(const bfr* p);
DI float wave_sum(float v) {
#pragma unroll
  for (int o = 32; o > 0; o >>= 1) v += __shfl_xor(v, o);
  return v;
}

constexpr int LSTR = 72;
constexpr int GEMM_LDS_BYTES = 2 * 128 * LSTR * 2;

struct ALoadBf16 {
  const bfr* rp[4];
  bf16x8 r[4];
  DI void load(int kt) {
#pragma unroll
    for (int i = 0; i < 4; ++i) r[i] = *(const bf16x8*)(rp[i] + kt * 64);
  }
  DI void store(short* sA) const {
    const int tid = VT;
#pragma unroll
    for (int i = 0; i < 4; ++i) *(bf16x8*)(sA + ((tid >> 3) + 32 * i) * LSTR + (tid & 7) * 8) = r[i];
  }
};

struct BLoadF32 {
  const float* p;
  long ldb;
  bool valid;
  f32x4 v[8];
  DI void load(int kt) {
#pragma unroll
    for (int j = 0; j < 8; ++j) {
      if (valid) v[j] = *(const f32x4*)(p + ((long)kt * 64 + j) * ldb);
      else v[j] = f32x4{0.f, 0.f, 0.f, 0.f};
    }
  }
  DI void store(short* sB) const {
    const int tid = VT, kg = tid & 7, n4 = tid >> 3;
#pragma unroll
    for (int i = 0; i < 4; ++i) {
      unsigned a0 = pack2(v[0][i], v[1][i]), a1 = pack2(v[2][i], v[3][i]);
      unsigned a2 = pack2(v[4][i], v[5][i]), a3 = pack2(v[6][i], v[7][i]);
      typedef __attribute__((ext_vector_type(4))) unsigned u32x4;
      u32x4 w = {a0, a1, a2, a3};
      *(u32x4*)(sB + (4 * n4 + i) * LSTR + kg * 8) = w;
    }
  }
};

template <class AL, class BL>
DI void gemm_mainloop(short* sA, short* sB, int nk, AL& al, BL& bl, f32x4 (&acc)[4][4]) {
  const int tid = VT, wid = tid >> 6, lane = tid & 63;
  const int wr = wid >> 1, wc = wid & 1, fr = lane & 15, fq = lane >> 4;
#pragma unroll
  for (int m = 0; m < 4; ++m)
#pragma unroll
    for (int n = 0; n < 4; ++n) acc[m][n] = f32x4{0.f, 0.f, 0.f, 0.f};
  al.load(0); bl.load(0);
  for (int kt = 0; kt < nk; ++kt) {
    __syncthreads();
    al.store(sA); bl.store(sB);
    __syncthreads();
    if (kt + 1 < nk) { al.load(kt + 1); bl.load(kt + 1); }
#pragma unroll
    for (int ks = 0; ks < 2; ++ks) {
      bf16x8 af[4], bf[4];
#pragma unroll
      for (int m = 0; m < 4; ++m) af[m] = *(const bf16x8*)(sA + (wr * 64 + m * 16 + fr) * LSTR + ks * 32 + fq * 8);
#pragma unroll
      for (int n = 0; n < 4; ++n) bf[n] = *(const bf16x8*)(sB + (wc * 64 + n * 16 + fr) * LSTR + ks * 32 + fq * 8);
#pragma unroll
      for (int m = 0; m < 4; ++m)
#pragma unroll
        for (int n = 0; n < 4; ++n) acc[m][n] = __builtin_amdgcn_mfma_f32_16x16x32_bf16(af[m], bf[n], acc[m][n], 0, 0, 0);
    }
  }
}

DI void phase_lora_convert(CParams& P, int part, int nparts);
DI void phase_wrt_convert(CParams& P, int part, int nparts);
DI void transpose_tile(const float* W, int ldw, int k0, int n0, int nvalid, bfr* WT, int ldt, char* smem);
DI void transpose_quad(const float* W, int ldw, int k0, int n0, bfr* WT, int ldt, int dr0, int dr1, int dr2, int dr3, char* smem, int nvalid);
DI void phase_mod(CParams& P, int bid, int nb, char* smem) {
  const float* c = P.in[1]; const float* cc = P.in[3];
  const float* w_mod = P.in[4]; const float* b_mod = P.in[5];
  float* mod = (float*)(P.ws + WS_MOD); float* modc = (float*)(P.ws + WS_MODC);
  float* red = (float*)smem;
  const int tid = VT;
  for (int it = bid; it < 542; it += nb) {
    if (it < 192) {
      const int kq = tid >> 3, c4 = tid & 7;
      const int col = it * 32 + c4 * 4;
      f32x4 a1 = {0, 0, 0, 0}, a2 = {0, 0, 0, 0};
      for (int k = kq; k < DM; k += 32) {
        f32x4 w = *(const f32x4*)(w_mod + (long)k * 6144 + col);
        float s1 = siluf_(c[k]), s2 = siluf_(cc[k]);
        a1 += w * s1; a2 += w * s2;
      }
      __syncthreads();
#pragma unroll
      for (int e = 0; e < 4; ++e) { red[(kq * 32) + c4 * 4 + e] = a1[e]; red[1024 + kq * 32 + c4 * 4 + e] = a2[e]; }
      __syncthreads();
      if (tid < 64) {
        const int which = tid >> 5, cl = tid & 31;
        float s = 0.f;
        for (int q = 0; q < 32; ++q) s += red[which * 1024 + q * 32 + cl];
        const int cg = it * 32 + cl;
        s += b_mod[cg];
        if (which == 0) mod[cg] = s; else modc[cg] = s;
      }
    } else if (it == 192) {
      const float* L = P.in[8];
      float* lb = (float*)(P.ws + WS_LB);
      for (int i = tid; i < 1024; i += NTHR) {
        const int d = i >> 9, j = i & 511;
        float l0 = L[d * 1024 + j], l1 = L[d * 1024 + 512 + j];
        lb[i] = 1.f / (1.f + __expf(l1 - l0));
      }
    } else if (it == 193) {
      int* cnt = (int*)(P.ws + WS_CNT);
      if (tid < 64) cnt[tid] = 0;
    } else if (it < 198) {
      phase_lora_convert(P, it - 194, 4);
    } else if (it < 470) {
      const int t = it - 198, kt = t / 17, nq = t % 17;
      transpose_quad(P.in[6], DIN, kt * 64, nq * 256, (bfr*)(P.ws + (284ull << 20)), DM, nq * 256, nq * 256 + 64, nq * 256 + 128, nq * 256 + 192, smem, DIN);
    } else if (it < 534) {
      const int t = it - 470, kt = t >> 2, nq = t & 3;
      transpose_quad(P.in[7], DM, kt * 64, nq * 256, (bfr*)(P.ws + (1ull << 20)), DM, nq * 256, nq * 256 + 64, nq * 256 + 128, nq * 256 + 192, smem, DM);
    } else {
      phase_wrt_convert(P, it - 534, 8);
    }
  }
}

DI void phase_ln1(CParams& P, int bid, int nb) {
  const float* x = P.in[0]; const float* ctx = P.in[2];
  const float* mod = (const float*)(P.ws + WS_MOD); const float* modc = (const float*)(P.ws + WS_MODC);
  bfr* h = (bfr*)(P.ws + WS_H);
  const int wid = VT >> 6, lane = VT & 63;
  for (int row0 = (bid * 4 + wid) * 2; row0 < T_ALL; row0 += nb * 8) {
    const float* src = row0 < T_LAT ? x + (long)row0 * DM : ctx + (long)(row0 - T_LAT) * DM;
    const float* mm = row0 < T_LAT ? mod : modc;
    f32x4 v[2][4];
    float s[2] = {0.f, 0.f};
#pragma unroll
    for (int r = 0; r < 2; ++r)
#pragma unroll
      for (int i = 0; i < 4; ++i) { v[r][i] = *(const f32x4*)(src + r * DM + lane * 4 + 256 * i); s[r] += v[r][i][0] + v[r][i][1] + v[r][i][2] + v[r][i][3]; }
#pragma unroll
    for (int r = 0; r < 2; ++r) {
      const float mu = wave_sum(s[r]) * (1.f / DM);
      float q = 0.f;
#pragma unroll
      for (int i = 0; i < 4; ++i) { v[r][i] -= mu; q += v[r][i][0] * v[r][i][0] + v[r][i][1] * v[r][i][1] + v[r][i][2] * v[r][i][2] + v[r][i][3] * v[r][i][3]; }
      const float rs = rsqrtf(wave_sum(q) * (1.f / DM) + 1e-5f);
#pragma unroll
      for (int i = 0; i < 4; ++i) {
        const int cidx = lane * 4 + 256 * i;
        f32x4 sh = *(const f32x4*)(mm + cidx), sc = *(const f32x4*)(mm + 1024 + cidx);
        f32x4 o = v[r][i] * rs * (sc + 1.f) + sh;
        uint2 w = {pack2(o[0], o[1]), pack2(o[2], o[3])};
        *(uint2*)(h + (long)(row0 + r) * DM + cidx) = w;
      }
    }
  }
}

DI void phase_pgemm(CParams& P, int bid, int nb, char* smem) {
  const bfr* h = (const bfr*)(P.ws + WS_H);
  const float* w_in = P.in[6];
  bfr* p = (bfr*)(P.ws + WS_P);
  short* sA = (short*)smem; short* sB = sA + 128 * LSTR;
  const int tid = VT, wid = tid >> 6, lane = tid & 63;
  const int wr = wid >> 1, wc = wid & 1, fr = lane & 15, fq = lane >> 4;
  constexpr int NT = 34, MT = T_ALL / 128;
  for (int it = bid; it < NT * MT; it += nb) {
    const int mt = it / NT, nt = it % NT;
    ALoadBf16 al; BLoadF32 bl;
#pragma unroll
    for (int i = 0; i < 4; ++i) al.rp[i] = h + (long)(mt * 128 + (tid >> 3) + 32 * i) * DM + (tid & 7) * 8;
    const int col = nt * 128 + (tid >> 3) * 4;
    bl.valid = col < DIN; bl.ldb = DIN;
    bl.p = w_in + (long)((tid & 7) * 8) * DIN + (bl.valid ? col : 0);
    f32x4 acc[4][4];
    gemm_mainloop(sA, sB, DM / 64, al, bl, acc);
#pragma unroll
    for (int m = 0; m < 4; ++m)
#pragma unroll
      for (int n = 0; n < 4; ++n) {
        const int cc = nt * 128 + wc * 64 + n * 16 + fr;
        if (cc < DIN) {
#pragma unroll
          for (int j = 0; j < 4; ++j) {
            const int rr = mt * 128 + wr * 64 + m * 16 + fq * 4 + j;
            p[(long)rr * DIN + cc] = f2bf(acc[m][n][j]);
          }
        }
      }
  }
}

DI float rw_mixed(const bfr* p, int row, int c, const float* mu) {
  const long base = (long)row * DIN + HGC + c;
  const float pc = bf2f(p[base]);
  float nbv;
  if (row < T_LAT) {
    const int gr = row >> 6, gc = row & 63;
    float s = 0.f;
    if (gr > 0) s += bf2f(p[base - 64l * DIN]);
    if (gr < 255) s += bf2f(p[base + 64l * DIN]);
    if (gc > 0) s += bf2f(p[base - DIN]);
    if (gc < 63) s += bf2f(p[base + DIN]);
    nbv = 0.25f * s;
  } else {
    const int sidx = row - T_LAT;
    float s = 0.f;
    if (sidx > 0) s += bf2f(p[base - DIN]);
    if (sidx < T_CTX - 1) s += bf2f(p[base + DIN]);
    nbv = 0.5f * s;
  }
  return pc + (nbv - pc) * mu[c];
}

DI void rwkv_chain_naive(CParams& P, int chain, char* smem) {
  const int dir = chain >> 3, hd = chain & 7;
  const bfr* R = (const bfr*)(P.ws + WS_RW); const bfr* K = (const bfr*)(P.ws + WS_RW + RW_ARR); const bfr* V = (const bfr*)(P.ws + WS_RW + 2 * RW_ARR);
  const bfr* KK = (const bfr*)(P.ws + WS_RW + 3 * RW_ARR); const bfr* A = (const bfr*)(P.ws + WS_RW + 4 * RW_ARR);
  const float* LW = (const float*)(P.ws + WS_LW + (dir ? LW_ARR : 0));
  float* Y = (float*)(P.ws + WS_YRW) + (long)dir * T_LAT * 512;
  float* vec = (float*)smem;
  float* red = vec + 16 * 6 * 64;
  const int tid = VT, i = tid & 63, jq = tid >> 6;
  float S[16];
#pragma unroll
  for (int j = 0; j < 16; ++j) S[j] = 0.f;
  for (int s0 = 0; s0 < T_ALL; s0 += 16) {
    __syncthreads();
    for (int e = tid; e < 16 * 64; e += NTHR) {
      const int st = e >> 6, j = e & 63;
      const int s = s0 + st;
      int row;
      if (s < T_CTX) row = T_LAT + (dir ? (T_CTX - 1 - s) : s);
      else row = dir ? (T_LAT - 1 - (s - T_CTX)) : (s - T_CTX);
      const long o = (long)row * 512 + hd * 64 + j;
      float* vp = vec + st * 384;
      const float kk = bf2f(KK[o]);
      vp[j] = bf2f(R[o]); vp[64 + j] = __expf(LW[o]); vp[128 + j] = bf2f(K[o]); vp[192 + j] = bf2f(V[o]);
      vp[256 + j] = kk; vp[320 + j] = kk * bf2f(A[o]);
    }
    __syncthreads();
    for (int st = 0; st < 16; ++st) {
      const float* vp = vec + st * 384;
      const int par = st & 1;
      float sa = 0.f;
#pragma unroll
      for (int j = 0; j < 16; ++j) sa += S[j] * vp[256 + jq * 16 + j];
      red[(par * 2 + 0) * 256 + jq * 64 + i] = sa;
      __syncthreads();
      sa = red[(par * 2) * 256 + i] + red[(par * 2) * 256 + 64 + i] + red[(par * 2) * 256 + 128 + i] + red[(par * 2) * 256 + 192 + i];
      const float vi = vp[192 + i];
      float y = 0.f;
#pragma unroll
      for (int j = 0; j < 16; ++j) {
        const int jj = jq * 16 + j;
        S[j] = S[j] * vp[64 + jj] - sa * vp[320 + jj] + vi * vp[128 + jj];
        y += S[j] * vp[jj];
      }
      red[(par * 2 + 1) * 256 + jq * 64 + i] = y;
      __syncthreads();
      const int s = s0 + st;
      if (jq == 0 && s >= T_CTX) {
        y = red[(par * 2 + 1) * 256 + i] + red[(par * 2 + 1) * 256 + 64 + i] + red[(par * 2 + 1) * 256 + 128 + i] + red[(par * 2 + 1) * 256 + 192 + i];
        const int row = dir ? (T_LAT - 1 - (s - T_CTX)) : (s - T_CTX);
        Y[(long)row * 512 + hd * 64 + i] = y;
      }
    }
  }
}

DI void hgrn_chain_naive(CParams& P, int chain, char* smem) {
  const int dir = chain >> 2, hd = chain & 3;
  const bfr* p = (const bfr*)(P.ws + WS_P);
  const float* lb = (const float*)(P.ws + WS_LB) + dir * 512 + hd * 128;
  float* O = (float*)(P.ws + WS_OHG) + (long)dir * T_LAT * 512;
  float* vec = (float*)smem;
  float* red = vec + 16 * 4 * 128;
  const int tid = VT, e = tid & 127, dh = tid >> 7;
  float S[64];
#pragma unroll
  for (int d = 0; d < 64; ++d) S[d] = 0.f;
  for (int s0 = 0; s0 < T_ALL; s0 += 16) {
    __syncthreads();
    for (int x = tid; x < 16 * 128; x += NTHR) {
      const int st = x >> 7, d = x & 127;
      const int s = s0 + st;
      int row;
      if (s < T_CTX) row = T_LAT + (dir ? (T_CTX - 1 - s) : s);
      else row = dir ? (T_LAT - 1 - (s - T_CTX)) : (s - T_CTX);
      const bfr* pr = p + (long)row * DIN + hd * 128 + d;
      const float q = bf2f(pr[0]), iv = bf2f(pr[512]), z = bf2f(pr[1024 + dir * 512]);
      const float l = lb[d];
      const float f = l + (1.f - l) * sigmoidf_(z);
      float* vp = vec + st * 512;
      vp[d] = siluf_(q); vp[128 + d] = f; vp[256 + d] = (1.f - l) * sigmoidf_(-z); vp[384 + d] = iv;
    }
    __syncthreads();
    for (int st = 0; st < 16; ++st) {
      const float* vp = vec + st * 512;
      const int par = st & 1;
      const float ve = vp[384 + e];
      float o = 0.f;
#pragma unroll
      for (int d = 0; d < 64; ++d) {
        const int dd = dh * 64 + d;
        S[d] = S[d] * vp[128 + dd] + vp[256 + dd] * ve;
        o += vp[dd] * S[d];
      }
      red[par * 256 + dh * 128 + e] = o;
      __syncthreads();
      const int s = s0 + st;
      if (dh == 0 && s >= T_CTX) {
        o = red[par * 256 + e] + red[par * 256 + 128 + e];
        const int row = dir ? (T_LAT - 1 - (s - T_CTX)) : (s - T_CTX);
        O[(long)row * 512 + hd * 128 + e] = o;
      }
    }
  }
}

#define LDSP(T) __attribute__((address_space(3))) T*
DI int row_of_step(int dir, int s) {
  if (s < T_CTX) return T_LAT + (dir ? (T_CTX - 1 - s) : s);
  return dir ? (T_LAT - 1 - (s - T_CTX)) : (s - T_CTX);
}
DI bf16x8 ld_tr8(const short* base, int stride, int k0, int n0) {
  const int lane = VT & 63, g = lane >> 4, q = (lane & 15) >> 2, p = lane & 3;
  const short* a0 = base + (k0 + 8 * g + q) * stride + n0 + 4 * p;
  s16x4 lo = __builtin_amdgcn_ds_read_tr16_b64_v4i16((LDSP(s16x4))a0);
  s16x4 hi = __builtin_amdgcn_ds_read_tr16_b64_v4i16((LDSP(s16x4))(a0 + 4 * stride));
  return __builtin_shufflevector(lo, hi, 0, 1, 2, 3, 4, 5, 6, 7);
}
template <bool AT, bool BT>
DI f32x4 mm_tile(const short* A, int lda, int m0, const short* B, int ldb, int n0, int K, f32x4 acc) {
  const int lane = VT & 63, fr = lane & 15, fq = lane >> 4;
#ifdef SLOWMM
#pragma unroll
  for (int reg = 0; reg < 4; ++reg) {
    const int row = m0 + 4 * fq + reg, col = n0 + fr;
    float s = 0.f;
    for (int k = 0; k < K; ++k) {
      const float a = bf2f((bfr)(AT ? A[k * lda + row] : A[row * lda + k]));
      const float b = bf2f((bfr)(BT ? B[col * ldb + k] : B[k * ldb + col]));
      s += a * b;
    }
    acc[reg] += s;
  }
#else
  for (int k0 = 0; k0 < K; k0 += 32) {
    bf16x8 a, b;
    if (AT) a = ld_tr8(A, lda, k0, m0); else a = *(const bf16x8*)(A + (m0 + fr) * lda + k0 + fq * 8);
    if (BT) b = *(const bf16x8*)(B + (n0 + fr) * ldb + k0 + fq * 8); else b = ld_tr8(B, ldb, k0, n0);
    acc = __builtin_amdgcn_mfma_f32_16x16x32_bf16(a, b, acc, 0, 0, 0);
  }
#endif
  return acc;
}
DI void st_tile(short* C, int ldc, int m0, int n0, f32x4 acc) {
  const int lane = VT & 63, fr = lane & 15, fq = lane >> 4;
#pragma unroll
  for (int reg = 0; reg < 4; ++reg) C[(m0 + 4 * fq + reg) * ldc + n0 + fr] = (short)f2bf(acc[reg]);
}

constexpr int RW_NSC = 32;
DI int rw_sc_begin(int sc) { return sc * 16 + (sc < 8 ? sc : 8); }
DI int rw_sc_of_chunk(int ci) { return ci < 136 ? ci / 17 : 8 + (ci - 136) / 16; }
constexpr int XS = 72, SS = 40, GS = 72;
constexpr int RWL_XK = 0, RWL_XKB = 4608, RWL_XBB = 9216, RWL_XR = 13824, RWL_XV = 18432, RWL_S = 23040;
constexpr int RWL_GP = 38400, RWL_GQ = 47616, RWL_GAM = 56832, RWL_TOT = 57088, RWL_END = 58112;
constexpr size_t WS_PTOT = 6 * MB;
constexpr size_t WS_QTOT = 10 * MB;
constexpr size_t WS_SINRW = 18 * MB;
constexpr size_t WS_R2P = 350 * MB;
constexpr size_t WS_Y0P = 382 * MB;

constexpr int RTS = 40, RGS = 72;
constexpr int RWT_XK = 0, RWT_XKB = 5120, RWT_XBB = 10240, RWT_XR = 15360, RWT_XV = 20480, RWT_S = 25600;
constexpr int RWT_GP = 40960, RWT_GQ = 50176, RWT_GAM = 59392, RWT_TOT = 59648;
DI void st_tile_T(short* C, int ldc, int m0, int n0, f32x4 acc) {
  const int lane = (int)(threadIdx.x & 63), fr = lane & 15, fq = lane >> 4;
  *(uint2*)(C + (n0 + fr) * ldc + m0 + 4 * fq) = uint2{pack2(acc[0], acc[1]), pack2(acc[2], acc[3])};
}
DI void rw_levelA_item(CParams& P, int chain, int sc, char* smem) {
  const int dir = chain >> 3, hd = chain & 7;
  const bfr* Rg = (const bfr*)(P.ws + WS_RW); const bfr* Kg = (const bfr*)(P.ws + WS_RW + RW_ARR); const bfr* Vg = (const bfr*)(P.ws + WS_RW + 2 * RW_ARR);
  const bfr* KKg = (const bfr*)(P.ws + WS_RW + 3 * RW_ARR); const bfr* Ag = (const bfr*)(P.ws + WS_RW + 4 * RW_ARR);
  const float* LWg = (const float*)(P.ws + WS_LW + (dir ? LW_ARR : 0));
  bfr* R2P = (bfr*)(P.ws + WS_R2P) + (size_t)dir * T_LAT * 512;
  bfr* Y0P = (bfr*)(P.ws + WS_Y0P) + (size_t)dir * T_LAT * 512;
  short* XKt = (short*)(smem + RWT_XK); short* XKBt = (short*)(smem + RWT_XKB); short* XBBt = (short*)(smem + RWT_XBB);
  short* XRt = (short*)(smem + RWT_XR); short* XVt = (short*)(smem + RWT_XV);
  short* ZT = XRt; short* R2T = XRt; short* PcT = XKt;
  short* SLt = (short*)(smem + RWT_S); short* SAkkT = SLt + 32 * RTS; short* SAkrT = SAkkT + 32 * RTS; short* SMt = SAkrT + 32 * RTS;
  short* STt = SMt + 32 * RTS; short* SnAbrT = STt + 32 * RTS;
  short* W1T = SLt; short* W2T = SAkrT;
  short* GPT = (short*)(smem + RWT_GP); short* GQT = (short*)(smem + RWT_GQ);
  float* gam = (float*)(smem + RWT_GAM); float* tot = (float*)(smem + RWT_TOT);
  const int tid = VT, lane = tid & 63, w = tid >> 6, fr = lane & 15, fq = lane >> 4;
  const int tm = w >> 1, tn = w & 1;
  const int sgn = dir ? -1 : 1;
  const f32x4 z4 = {0.f, 0.f, 0.f, 0.f};
  __syncthreads();
  for (int i = tid; i < 64 * 64; i += NTHR) { const int r = i >> 6, c = i & 63; GPT[r * RGS + c] = (r == c) ? (short)0x3F80 : (short)0; GQT[r * RGS + c] = 0; }
  f32x4 pcum[4], qcum[4];
#pragma unroll
  for (int n = 0; n < 4; ++n) { pcum[n] = z4; qcum[n] = z4; }
  const int c_begin = rw_sc_begin(sc), c_end = rw_sc_begin(sc + 1);
  float pf_lw[8]; unsigned pf_rk[8], pf_vkk[8], pf_a[8];
#define RW_PREFETCH(cc) do { const unsigned o0_ = (unsigned)(row_of_step(dir, (cc) * 32 + (tid >> 6) * 8) * 512 + hd * 64 + (tid & 63)); \
      _Pragma("unroll") for (int e_ = 0; e_ < 8; ++e_) { const unsigned o_ = o0_ + (unsigned)(sgn * e_ * 512); \
      pf_lw[e_] = LWg[o_]; pf_rk[e_] = (unsigned)Rg[o_] | ((unsigned)Kg[o_] << 16); pf_vkk[e_] = (unsigned)Vg[o_] | ((unsigned)KKg[o_] << 16); pf_a[e_] = Ag[o_]; } } while (0)
  RW_PREFETCH(c_begin);
  for (int ci = c_begin; ci < c_end; ++ci) {
    __syncthreads();
    {
      const int j = tid & 63, qt = tid >> 6;
      float lam[8];
      float run = 0.f;
#pragma unroll
      for (int e = 0; e < 8; ++e) { run += pf_lw[e]; lam[e] = run; }
      tot[qt * 64 + j] = run;
      __syncthreads();
      float base = 0.f, total = 0.f;
#pragma unroll
      for (int q2 = 0; q2 < 4; ++q2) { const float tv = tot[q2 * 64 + j]; total += tv; if (q2 < qt) base += tv; }
      unsigned wk[4], wkb[4], wbb[4], wr_[4], wv[4];
#pragma unroll
      for (int e2 = 0; e2 < 4; ++e2) {
        float vk[2], vkb[2], vbb[2], vr[2];
#pragma unroll
        for (int u = 0; u < 2; ++u) {
          const int e = 2 * e2 + u;
          const float L = base + lam[e];
          const float eL = __expf(L), enL = frcp_(eL), eLp = eL * __expf(-pf_lw[e]);
          const float kkv = __uint_as_float(pf_vkk[e] & 0xffff0000u);
          vk[u] = kkv * eLp;
          vkb[u] = __uint_as_float(pf_rk[e] & 0xffff0000u) * enL;
          vbb[u] = kkv * __uint_as_float(pf_a[e] << 16) * enL;
          vr[u] = __uint_as_float(pf_rk[e] << 16) * eL;
        }
        wk[e2] = pack2(vk[0], vk[1]); wkb[e2] = pack2(vkb[0], vkb[1]); wbb[e2] = pack2(vbb[0], vbb[1]); wr_[e2] = pack2(vr[0], vr[1]);
        wv[e2] = (pf_vkk[2 * e2] & 0xffffu) | (pf_vkk[2 * e2 + 1] << 16);
      }
      const int co = j * RTS + 8 * qt;
      *(uint4*)(XKt + co) = uint4{wk[0], wk[1], wk[2], wk[3]};
      *(uint4*)(XKBt + co) = uint4{wkb[0], wkb[1], wkb[2], wkb[3]};
      *(uint4*)(XBBt + co) = uint4{wbb[0], wbb[1], wbb[2], wbb[3]};
      *(uint4*)(XRt + co) = uint4{wr_[0], wr_[1], wr_[2], wr_[3]};
      *(uint4*)(XVt + co) = uint4{wv[0], wv[1], wv[2], wv[3]};
      if (qt == 0) gam[j] = __expf(total);
      if (ci + 1 < c_end) RW_PREFETCH(ci + 1);
    }
    __syncthreads();
    f32x4 tacc; f32x4 rt[2];
    {
      f32x4 aL = mm_tile<true, false>(XKt, RTS, 16 * tm, XBBt, RTS, 16 * tn, 64, z4);
      f32x4 aKK = mm_tile<true, false>(XKt, RTS, 16 * tm, XKBt, RTS, 16 * tn, 64, z4);
      f32x4 aBR = mm_tile<true, false>(XRt, RTS, 16 * tm, XBBt, RTS, 16 * tn, 64, z4);
      f32x4 aKR = mm_tile<true, false>(XRt, RTS, 16 * tm, XKBt, RTS, 16 * tn, 64, z4);
#pragma unroll
      for (int reg = 0; reg < 4; ++reg) {
        const int row = 16 * tm + 4 * fq + reg, col = 16 * tn + fr;
        const bool st = col < row, inc = col <= row;
        aL[reg] = st ? aL[reg] : 0.f; aKK[reg] = st ? aKK[reg] : 0.f;
        aBR[reg] = inc ? -aBR[reg] : 0.f; aKR[reg] = inc ? aKR[reg] : 0.f;
        tacc[reg] = (row == col ? 1.f : 0.f) - aL[reg];
      }
      st_tile_T(SLt, RTS, 16 * tm, 16 * tn, aL); st_tile_T(STt, RTS, 16 * tm, 16 * tn, tacc);
      st_tile_T(SAkkT, RTS, 16 * tm, 16 * tn, aKK); st_tile_T(SnAbrT, RTS, 16 * tm, 16 * tn, aBR); st_tile_T(SAkrT, RTS, 16 * tm, 16 * tn, aKR);
#pragma unroll
      for (int i = 0; i < 2; ++i) rt[i] = ld4bf((const bfr*)(XRt + (16 * (2 * tn + i) + fr) * RTS + 16 * tm + 4 * fq));
    }
    __syncthreads();
    f32x4 y0[2];
    {
#pragma unroll
      for (int i = 0; i < 2; ++i) {
        f32x4 z = mm_tile<true, true>(SAkkT, RTS, 16 * tm, XVt, RTS, 16 * (2 * tn + i), 32, z4);
        st_tile_T(ZT, RTS, 16 * tm, 16 * (2 * tn + i), z);
        y0[i] = mm_tile<true, true>(SAkrT, RTS, 16 * tm, XVt, RTS, 16 * (2 * tn + i), 32, z4);
      }
      f32x4 m = mm_tile<true, true>(SLt, RTS, 16 * tm, SLt, RTS, 16 * tn, 32, z4);
      st_tile_T(SMt, RTS, 16 * tm, 16 * tn, m);
    }
    __syncthreads();
#pragma unroll 1
    for (int rd = 0; rd < 4; ++rd) {
      f32x4 tnew = mm_tile<true, true>(STt, RTS, 16 * tm, SMt, RTS, 16 * tn, 32, tacc);
      f32x4 mnew = z4;
      if (rd < 3) mnew = mm_tile<true, true>(SMt, RTS, 16 * tm, SMt, RTS, 16 * tn, 32, z4);
      __syncthreads();
      tacc = tnew;
      st_tile_T(STt, RTS, 16 * tm, 16 * tn, tacc);
      if (rd < 3) st_tile_T(SMt, RTS, 16 * tm, 16 * tn, mnew);
      __syncthreads();
    }
    {
      f32x4 w1[2], w2[2];
#pragma unroll
      for (int i = 0; i < 2; ++i) {
        w1[i] = mm_tile<true, true>(STt, RTS, 16 * tm, XKt, RTS, 16 * (2 * tn + i), 32, z4);
        w2[i] = mm_tile<true, true>(STt, RTS, 16 * tm, ZT, RTS, 16 * (2 * tn + i), 32, z4);
      }
#pragma unroll
      for (int i = 0; i < 2; ++i) { st_tile_T(W1T, RTS, 16 * tm, 16 * (2 * tn + i), w1[i]); st_tile_T(W2T, RTS, 16 * tm, 16 * (2 * tn + i), w2[i]); }
    }
    __syncthreads();
    f32x4 pa[4], qc[4], r2[2];
    {
#pragma unroll
      for (int n = 0; n < 4; ++n) {
        pa[n] = mm_tile<false, true>(W1T, RTS, 16 * w, XBBt, RTS, 16 * n, 32, z4);
        f32x4 qa = mm_tile<false, true>(XVt, RTS, 16 * w, XKBt, RTS, 16 * n, 32, z4);
        f32x4 qb = mm_tile<false, true>(W2T, RTS, 16 * w, XBBt, RTS, 16 * n, 32, z4);
        qc[n] = qa - qb;
      }
#pragma unroll
      for (int i = 0; i < 2; ++i) {
        r2[i] = mm_tile<true, true>(SnAbrT, RTS, 16 * tm, W1T, RTS, 16 * (2 * tn + i), 32, rt[i]);
        y0[i] = mm_tile<true, true>(SnAbrT, RTS, 16 * tm, W2T, RTS, 16 * (2 * tn + i), 32, y0[i]);
      }
    }
    __syncthreads();
    {
#pragma unroll
      for (int n = 0; n < 4; ++n) {
        const float gcol = gam[16 * n + fr];
        f32x4 pc;
#pragma unroll
        for (int reg = 0; reg < 4; ++reg) {
          const int row = 16 * w + 4 * fq + reg, col = 16 * n + fr;
          pc[reg] = ((row == col ? 1.f : 0.f) - pa[n][reg]) * gcol;
          qc[n][reg] *= gcol;
        }
        st_tile_T(PcT, RGS, 16 * w, 16 * n, pc);
      }
#pragma unroll
      for (int i = 0; i < 2; ++i) st_tile_T(R2T, RTS, 16 * tm, 16 * (2 * tn + i), r2[i]);
    }
    __syncthreads();
    {
      if (ci >= 8) {
        const unsigned orow = (unsigned)(row_of_step(dir, ci * 32 + 16 * tm + 4 * fq) * 512 + hd * 64 + fr);
#pragma unroll
        for (int i = 0; i < 2; ++i) {
          f32x4 o1 = mm_tile<true, false>(R2T, RTS, 16 * tm, GPT, RGS, 16 * (2 * tn + i), 64, z4);
          f32x4 o2 = mm_tile<true, false>(R2T, RTS, 16 * tm, GQT, RGS, 16 * (2 * tn + i), 64, y0[i]);
#pragma unroll
          for (int reg = 0; reg < 4; ++reg) {
            const unsigned o = orow + (unsigned)(sgn * reg * 512 + 16 * (2 * tn + i));
            R2P[o] = f2bf(o1[reg]); Y0P[o] = f2bf(o2[reg]);
          }
        }
      }
#pragma unroll
      for (int n = 0; n < 4; ++n) {
        pcum[n] = mm_tile<true, true>(GPT, RGS, 16 * w, PcT, RGS, 16 * n, 64, z4);
        qcum[n] = mm_tile<true, true>(GQT, RGS, 16 * w, PcT, RGS, 16 * n, 64, qc[n]);
      }
    }
    __syncthreads();
#pragma unroll
    for (int n = 0; n < 4; ++n) { st_tile_T(GPT, RGS, 16 * w, 16 * n, pcum[n]); st_tile_T(GQT, RGS, 16 * w, 16 * n, qcum[n]); }
  }
  {
    bfr* Pt = (bfr*)(P.ws + WS_PTOT) + (size_t)(chain * RW_NSC + sc) * 4096;
    float* Qt = (float*)(P.ws + WS_QTOT) + (size_t)(chain * RW_NSC + sc) * 4096;
#pragma unroll
    for (int n = 0; n < 4; ++n)
#pragma unroll
      for (int reg = 0; reg < 4; ++reg) {
        const int row = 16 * w + 4 * fq + reg, col = 16 * n + fr;
        Pt[row * 64 + col] = f2bf(pcum[n][reg]);
      }
#pragma unroll
    for (int n = 0; n < 4; ++n) *(f32x4*)(Qt + (16 * n + fr) * 64 + 16 * w + 4 * fq) = qcum[n];
  }
}

DI void rw_levelB_chain(CParams& P, int chain, char* smem) {
  short* SB = (short*)smem; short* PT = SB + 64 * GS;
  const bfr* Ptot = (const bfr*)(P.ws + WS_PTOT) + (size_t)chain * RW_NSC * 4096;
  const float* Qtot = (const float*)(P.ws + WS_QTOT) + (size_t)chain * RW_NSC * 4096;
  bfr* SIN = (bfr*)(P.ws + WS_SINRW) + (size_t)chain * (RW_NSC + 1) * 4096;
  const int tid = VT, lane = tid & 63, w = tid >> 6, fr = lane & 15, fq = lane >> 4;
  f32x4 S[4];
#pragma unroll
  for (int n = 0; n < 4; ++n) S[n] = f32x4{0.f, 0.f, 0.f, 0.f};
  bf16x8 pr[4][2]; f32x4 qr[4][4];
#define LB_LOAD(slot, sc_) do { _Pragma("unroll") for (int i_ = 0; i_ < 2; ++i_) { const int e_ = tid + i_ * NTHR; pr[slot][i_] = *(const bf16x8*)(Ptot + (size_t)(sc_) * 4096 + (e_ >> 3) * 64 + (e_ & 7) * 8); } \
    _Pragma("unroll") for (int n_ = 0; n_ < 4; ++n_) qr[slot][n_] = *(const f32x4*)(Qtot + (size_t)(sc_) * 4096 + (16 * n_ + fr) * 64 + 16 * w + 4 * fq); } while (0)
  LB_LOAD(0, 0); LB_LOAD(1, 1); LB_LOAD(2, 2); LB_LOAD(3, 3);
#define LB_STEP(u) do { const int sc = sc0 + (u); \
      __syncthreads(); \
      _Pragma("unroll") for (int n = 0; n < 4; ++n) { st_tile(SB, GS, 16 * w, 16 * n, S[n]); \
        _Pragma("unroll") for (int reg = 0; reg < 4; ++reg) SIN[(size_t)sc * 4096 + (16 * w + 4 * fq + reg) * 64 + 16 * n + fr] = f2bf(S[n][reg]); } \
      _Pragma("unroll") for (int i = 0; i < 2; ++i) { const int e = tid + i * NTHR; *(bf16x8*)(PT + (e >> 3) * GS + (e & 7) * 8) = pr[u][i]; } \
      const f32x4 qc0 = qr[u][0], qc1 = qr[u][1], qc2 = qr[u][2], qc3 = qr[u][3]; \
      __syncthreads(); \
      if (sc + 4 < RW_NSC) LB_LOAD(u, sc + 4); \
      S[0] = mm_tile<false, false>(SB, GS, 16 * w, PT, GS, 0, 64, qc0); S[1] = mm_tile<false, false>(SB, GS, 16 * w, PT, GS, 16, 64, qc1); \
      S[2] = mm_tile<false, false>(SB, GS, 16 * w, PT, GS, 32, 64, qc2); S[3] = mm_tile<false, false>(SB, GS, 16 * w, PT, GS, 48, 64, qc3); } while (0)
  for (int sc0 = 0; sc0 < RW_NSC; sc0 += 4) { LB_STEP(0); LB_STEP(1); LB_STEP(2); LB_STEP(3); }
#undef LB_STEP
#undef LB_LOAD
}

DI void rw_finish(CParams& P, int bid, int nb) {
  float* YM = P.out;
  const int tid = VT, lane = tid & 63, w = tid >> 6, fr = lane & 15, fq = lane >> 4;
  for (int it = bid; it < 512 * 4; it += nb) {
    const int tile = it >> 2, hp = it & 3;
    const int hd = hp * 2 + (w >> 1), tm = w & 1;
    const int t0 = tile * 32;
    f32x4 acc[4];
#pragma unroll
    for (int n = 0; n < 4; ++n) acc[n] = f32x4{0.f, 0.f, 0.f, 0.f};
#pragma unroll
    for (int dir = 0; dir < 2; ++dir) {
      const int ci = dir ? (519 - tile) : (8 + tile);
      const int sc = rw_sc_of_chunk(ci);
      const bfr* A = (const bfr*)(P.ws + WS_R2P) + (size_t)dir * T_LAT * 512 + (size_t)t0 * 512 + hd * 64;
      const bfr* Y0 = (const bfr*)(P.ws + WS_Y0P) + (size_t)dir * T_LAT * 512 + (size_t)t0 * 512 + hd * 64;
      const bfr* Sin = (const bfr*)(P.ws + WS_SINRW) + ((size_t)(dir * 8 + hd) * (RW_NSC + 1) + sc) * 4096;
#pragma unroll
      for (int n = 0; n < 4; ++n) {
#pragma unroll
        for (int k0 = 0; k0 < 64; k0 += 32) {
          bf16x8 a = *(const bf16x8*)(A + (size_t)(16 * tm + fr) * 512 + k0 + fq * 8);
          bf16x8 b = *(const bf16x8*)(Sin + (16 * n + fr) * 64 + k0 + fq * 8);
          acc[n] = __builtin_amdgcn_mfma_f32_16x16x32_bf16(a, b, acc[n], 0, 0, 0);
        }
#pragma unroll
        for (int reg = 0; reg < 4; ++reg) acc[n][reg] += bf2f(Y0[(size_t)(16 * tm + 4 * fq + reg) * 512 + 16 * n + fr]);
      }
    }
#pragma unroll
    for (int n = 0; n < 4; ++n)
#pragma unroll
      for (int reg = 0; reg < 4; ++reg) YM[(size_t)(t0 + 16 * tm + 4 * fq + reg) * 512 + hd * 64 + 16 * n + fr] = acc[n][reg];
  }
}

constexpr int HG_NSC = 64;
DI int hg_sc_begin(int sc) { return sc * 8 + (sc < 8 ? sc : 8); }
DI int hg_sc_of_chunk(int ci) { return ci < 72 ? ci / 9 : 8 + (ci - 72) / 8; }
constexpr int QS = 136;
constexpr int HGL_Q0 = 0, HGL_Q1 = 8704, HGL_KP = 13056, HGL_KH = 21760, HGL_VV = 30464, HGL_PM = 39168, HGL_STT = 41728;
constexpr int HGL_BL = 76544, HGL_TOT = 77056, HGL_END = 78080;
constexpr size_t WS_SINHG = 23 * MB;
constexpr size_t WS_QH = 414 * MB;
constexpr size_t WS_O0 = 446 * MB;
constexpr size_t WS_SLOC = 478 * MB;
constexpr size_t WS_DTOT = 510 * MB;

constexpr int HTS = 40, HT1S = 24;
constexpr int HGT_Q0 = 0, HGT_Q1 = 10240, HGT_KP = 16384, HGT_KH = 26624, HGT_VV = 36864, HGT_PM = 47104, HGT_BL = 49664, HGT_TOT = 50176;
DI bf16x8 ld_tr8p(const short* base, int stride, int k0, int n0) {
  const int lane = (int)(threadIdx.x & 63), g = lane >> 4, q = (lane & 15) >> 2, p = lane & 3;
  const short* a0 = base + (k0 + 4 * g + q) * stride + n0 + 4 * p;
  s16x4 lo = __builtin_amdgcn_ds_read_tr16_b64_v4i16((LDSP(s16x4))a0);
  s16x4 hi = __builtin_amdgcn_ds_read_tr16_b64_v4i16((LDSP(s16x4))(a0 + 16 * stride));
  return __builtin_shufflevector(lo, hi, 0, 1, 2, 3, 4, 5, 6, 7);
}
DI void hg_levelA_item(CParams& P, int chain, int sc, char* smem) {
  const int dir = chain >> 2, hd = chain & 3;
  const bfr* p = (const bfr*)(P.ws + WS_P);
  const float* lbp = (const float*)(P.ws + WS_LB) + dir * 512 + hd * 128;
  bfr* QH = (bfr*)(P.ws + WS_QH) + (size_t)dir * T_LAT * 512;
  bfr* O0 = (bfr*)(P.ws + WS_O0) + (size_t)dir * T_LAT * 512;
  short* Q0T = (short*)(smem + HGT_Q0); short* Q1T = (short*)(smem + HGT_Q1); short* KPT = (short*)(smem + HGT_KP);
  short* KHT = (short*)(smem + HGT_KH); short* VVT = (short*)(smem + HGT_VV); short* PMT = (short*)(smem + HGT_PM);
  float* BL = (float*)(smem + HGT_BL); float* tot = (float*)(smem + HGT_TOT);
  const int tid = VT, lane = tid & 63, w = tid >> 6, fr = lane & 15, fq = lane >> 4;
  const f32x4 z4 = {0.f, 0.f, 0.f, 0.f};
  f32x4 S[8][2];
#pragma unroll
  for (int m = 0; m < 8; ++m) { S[m][0] = z4; S[m][1] = z4; }
  const int d = tid & 127, hf = tid >> 7;
  const float lb = lbp[d];
  float dcum = 0.f;
  const int sgn = dir ? -1 : 1;
  const int c_begin = hg_sc_begin(sc), c_end = hg_sc_begin(sc + 1);
  unsigned qv[16]; bfr zr[16];
#define HG_PREFETCH(cc) do { const unsigned po0_ = (unsigned)(row_of_step(dir, (cc) * 32 + hf * 16) * DIN + hd * 128 + d); \
      _Pragma("unroll") for (int e_ = 0; e_ < 16; ++e_) { const unsigned po_ = po0_ + (unsigned)(sgn * e_ * DIN); \
      qv[e_] = (unsigned)p[po_] | ((unsigned)p[po_ + 512] << 16); zr[e_] = p[po_ + 1024 + dir * 512]; } } while (0)
  HG_PREFETCH(c_begin);
  for (int ci = c_begin; ci < c_end; ++ci) {
    __syncthreads();
    {
      float lc[16], kv[16]; float run = 0.f;
#pragma unroll
      for (int e = 0; e < 16; ++e) {
        const float sg = sigmoidf_(bf2f(zr[e]));
        const float f = lb + (1.f - lb) * sg;
        kv[e] = (1.f - lb) * (1.f - sg);
        run += __logf(f); lc[e] = run;
      }
      tot[hf * 128 + d] = run;
      __syncthreads();
      const float tot0 = tot[d], tot1 = tot[128 + d];
      const float blast = tot0 + tot1;
      const float e0f = hf ? __expf(tot0) : 1.f;
      const float ehf = __expf(blast - (hf ? tot0 : 0.f));
      const float edc = __expf(dcum);
      const unsigned qh0 = (unsigned)(row_of_step(dir, ci * 32 + hf * 16) * 512 + hd * 128 + d);
#pragma unroll
      for (int hq = 0; hq < 2; ++hq) {
        unsigned q0w[4], q1w[4], kpw[4], khw[4], vvw[4];
#pragma unroll
        for (int e2 = 0; e2 < 4; ++e2) {
          float q0v[2], q1v[2], kpv[2], khv[2];
#pragma unroll
          for (int u = 0; u < 2; ++u) {
            const int e = 8 * hq + 2 * e2 + u;
            const float el = __expf(lc[e]), eil = frcp_(el);
            const float qs = siluf_(__uint_as_float(qv[e] << 16));
            q1v[u] = qs * el; q0v[u] = q1v[u] * e0f;
            kpv[u] = kv[e] * eil; khv[u] = kpv[u] * ehf;
            if (ci >= 8) QH[qh0 + (unsigned)(sgn * e * 512)] = f2bf(q0v[u] * edc);
          }
          q0w[e2] = pack2(q0v[0], q0v[1]); q1w[e2] = pack2(q1v[0], q1v[1]); kpw[e2] = pack2(kpv[0], kpv[1]); khw[e2] = pack2(khv[0], khv[1]);
          vvw[e2] = (qv[8 * hq + 2 * e2] >> 16) | (qv[8 * hq + 2 * e2 + 1] & 0xffff0000u);
        }
        const int co = 16 * hf + 8 * hq;
        *(uint4*)(Q0T + d * HTS + co) = uint4{q0w[0], q0w[1], q0w[2], q0w[3]};
        if (hf) *(uint4*)(Q1T + d * HT1S + 8 * hq) = uint4{q1w[0], q1w[1], q1w[2], q1w[3]};
        *(uint4*)(KPT + d * HTS + co) = uint4{kpw[0], kpw[1], kpw[2], kpw[3]};
        *(uint4*)(KHT + d * HTS + co) = uint4{khw[0], khw[1], khw[2], khw[3]};
        *(uint4*)(VVT + d * HTS + co) = uint4{vvw[0], vvw[1], vvw[2], vvw[3]};
      }
      if (hf == 0) BL[d] = blast;
      dcum += blast;
      if (ci + 1 < c_end) HG_PREFETCH(ci + 1);
    }
    __syncthreads();
    {
      f32x4 pt = z4;
      if (w == 0) pt = mm_tile<true, false>(Q0T, HTS, 0, KPT, HTS, 0, 128, z4);
      else if (w == 1) pt = mm_tile<true, false>(Q0T, HTS, 16, KPT, HTS, 0, 128, z4);
      else if (w == 2) pt = mm_tile<true, false>(Q1T, HT1S, 0, KPT, HTS, 16, 128, z4);
      if (w == 0 || w == 2) {
#pragma unroll
        for (int reg = 0; reg < 4; ++reg) pt[reg] = (fr <= 4 * fq + reg) ? pt[reg] : 0.f;
      }
      const int ptm = (w == 0 || w == 3) ? 0 : 1, ptn = (w >= 2) ? 1 : 0;
      *(uint2*)(PMT + (16 * ptn + fr) * HTS + 16 * ptm + 4 * fq) = uint2{pack2(pt[0], pt[1]), pack2(pt[2], pt[3])};
    }
    __syncthreads();
    {
      bf16x8 vfr[2];
#pragma unroll
      for (int n = 0; n < 2; ++n) vfr[n] = *(const bf16x8*)(VVT + (32 * w + 16 * n + fr) * HTS + fq * 8);
      f32x4 o[2][2];
#pragma unroll
      for (int m = 0; m < 2; ++m) { o[m][0] = z4; o[m][1] = z4; }
#pragma unroll
      for (int ks = 0; ks < 4; ++ks) {
        bf16x8 sfr[2];
#pragma unroll
        for (int n = 0; n < 2; ++n) {
          typedef __attribute__((ext_vector_type(4))) unsigned u32x4_;
          u32x4_ wv = {pack2(S[2 * ks][n][0], S[2 * ks][n][1]), pack2(S[2 * ks][n][2], S[2 * ks][n][3]), pack2(S[2 * ks + 1][n][0], S[2 * ks + 1][n][1]), pack2(S[2 * ks + 1][n][2], S[2 * ks + 1][n][3])};
          sfr[n] = __builtin_bit_cast(bf16x8, wv);
        }
#pragma unroll
        for (int m = 0; m < 2; ++m) {
          const bf16x8 a = ld_tr8p(Q0T, HTS, 32 * ks, 16 * m);
#pragma unroll
          for (int n = 0; n < 2; ++n) o[m][n] = __builtin_amdgcn_mfma_f32_16x16x32_bf16(a, sfr[n], o[m][n], 0, 0, 0);
        }
      }
#pragma unroll
      for (int m = 0; m < 2; ++m) {
        const bf16x8 a = ld_tr8(PMT, HTS, 0, 16 * m);
#pragma unroll
        for (int n = 0; n < 2; ++n) {
          o[m][n] = __builtin_amdgcn_mfma_f32_16x16x32_bf16(a, vfr[n], o[m][n], 0, 0, 0);
          if (ci >= 8) {
            const unsigned orow = (unsigned)(row_of_step(dir, ci * 32 + 16 * m + 4 * fq) * 512 + hd * 128 + 32 * w + 16 * n + fr);
#pragma unroll
            for (int reg = 0; reg < 4; ++reg) O0[orow + (unsigned)(sgn * reg * 512)] = f2bf(o[m][n][reg]);
          }
        }
      }
#pragma unroll
      for (int m = 0; m < 8; ++m) {
        const f32x4 bl = *(const f32x4*)(BL + 16 * m + 4 * fq);
        f32x4 sc4 = {__expf(bl[0]), __expf(bl[1]), __expf(bl[2]), __expf(bl[3])};
        const bf16x8 a = *(const bf16x8*)(KHT + (16 * m + fr) * HTS + fq * 8);
#pragma unroll
        for (int n = 0; n < 2; ++n) S[m][n] = __builtin_amdgcn_mfma_f32_16x16x32_bf16(a, vfr[n], S[m][n] * sc4, 0, 0, 0);
      }
    }
  }
  {
    float* SL_ = (float*)(P.ws + WS_SLOC) + (size_t)(chain * HG_NSC + sc) * 16384;
    float* DT = (float*)(P.ws + WS_DTOT) + (size_t)(chain * HG_NSC + sc) * 128;
#pragma unroll
    for (int m = 0; m < 8; ++m)
#pragma unroll
      for (int n = 0; n < 2; ++n) *(f32x4*)(SL_ + (32 * w + 16 * n + fr) * 128 + 16 * m + 4 * fq) = S[m][n];
    if (hf == 0) DT[d] = dcum;
  }
}

DI void hg_levelB(CParams& P, int bid, int nb) {
  const float* SLOC = (const float*)(P.ws + WS_SLOC); const float* DT = (const float*)(P.ws + WS_DTOT);
  bfr* SIN = (bfr*)(P.ws + WS_SINHG);
  for (int idx = bid * NTHR + VT; idx < 8 * 16384; idx += nb * NTHR) {
    const int chain = idx >> 14, ed = idx & 16383, dd = ed & 127;
    float s = 0.f;
    for (int sc = 0; sc < HG_NSC; ++sc) {
      const size_t item = (size_t)chain * HG_NSC + sc;
      SIN[item * 16384 + ed] = f2bf(s);
      s = __expf(DT[item * 128 + dd]) * s + SLOC[item * 16384 + ed];
    }
  }
}

DI void hg_finish(CParams& P, int bid, int nb, float* OM) {
  const int tid = VT, lane = tid & 63, w = tid >> 6, fr = lane & 15, fq = lane >> 4;
  for (int it = bid; it < 512 * 4; it += nb) {
    const int tile = it >> 2, hd = it & 3;
    const int t0 = tile * 32;
    f32x4 acc[2][2];
#pragma unroll
    for (int m = 0; m < 2; ++m) { acc[m][0] = f32x4{0.f, 0.f, 0.f, 0.f}; acc[m][1] = f32x4{0.f, 0.f, 0.f, 0.f}; }
#pragma unroll
    for (int dir = 0; dir < 2; ++dir) {
      const int ci = dir ? (519 - tile) : (8 + tile);
      const int sc = hg_sc_of_chunk(ci);
      const bfr* A = (const bfr*)(P.ws + WS_QH) + (size_t)dir * T_LAT * 512 + (size_t)t0 * 512 + hd * 128;
      const bfr* O0 = (const bfr*)(P.ws + WS_O0) + (size_t)dir * T_LAT * 512 + (size_t)t0 * 512 + hd * 128;
      const bfr* Sin = (const bfr*)(P.ws + WS_SINHG) + ((size_t)(dir * 4 + hd) * HG_NSC + sc) * 16384;
#pragma unroll
      for (int m = 0; m < 2; ++m)
#pragma unroll
        for (int n = 0; n < 2; ++n) {
#pragma unroll
          for (int k0 = 0; k0 < 128; k0 += 32) {
            bf16x8 a = *(const bf16x8*)(A + (size_t)(16 * m + fr) * 512 + k0 + fq * 8);
            bf16x8 b = *(const bf16x8*)(Sin + (32 * w + 16 * n + fr) * 128 + k0 + fq * 8);
            acc[m][n] = __builtin_amdgcn_mfma_f32_16x16x32_bf16(a, b, acc[m][n], 0, 0, 0);
          }
#pragma unroll
          for (int reg = 0; reg < 4; ++reg) acc[m][n][reg] += bf2f(O0[(size_t)(16 * m + 4 * fq + reg) * 512 + 32 * w + 16 * n + fr]);
        }
    }
#pragma unroll
    for (int m = 0; m < 2; ++m)
#pragma unroll
      for (int n = 0; n < 2; ++n)
#pragma unroll
        for (int reg = 0; reg < 4; ++reg) OM[(size_t)(t0 + 16 * m + 4 * fq + reg) * 512 + hd * 128 + 32 * w + 16 * n + fr] = acc[m][n][reg];
  }
}

constexpr size_t WS_LORA = 256 * 1024;
constexpr int LORA_WD2T = 0, LORA_WA2T = 2 * 512 * 32, LORA_WG2T = LORA_WA2T + 512 * 32;
DI void phase_lora_convert(CParams& P, int part, int nparts) {
  const float* wd2 = P.in[12]; const float* wa2 = P.in[14]; const float* wg2 = P.in[15];
  bfr* L = (bfr*)(P.ws + WS_LORA);
  for (int i = part * NTHR + VT; i < 2 * 512 * 32; i += nparts * NTHR) { const int d = i >> 14, c = (i >> 5) & 511, j = i & 31; L[LORA_WD2T + i] = f2bf(wd2[(d * 32 + j) * 512 + c]); }
  for (int i = part * NTHR + VT; i < 512 * 32; i += nparts * NTHR) { const int c = i >> 5, j = i & 31; L[LORA_WA2T + i] = f2bf(wa2[j * 512 + c]); }
  for (int i = part * NTHR + VT; i < 512 * 96; i += nparts * NTHR) { const int c = i / 96, j = i % 96; L[LORA_WG2T + i] = f2bf(wg2[j * 512 + c]); }
}
#define NB_DECL(row) \
  int nb_o0, nb_o1, nb_o2, nb_o3; float nb_f0, nb_f1, nb_f2, nb_f3, nb_scale; \
  { const int r_ = (row); const bool lat_ = r_ < T_LAT; const int gr_ = r_ >> 6, gc_ = r_ & 63, s_ = r_ - T_LAT; \
    const bool v0_ = lat_ && gr_ > 0, v1_ = lat_ && gr_ < 255, v2_ = lat_ ? gc_ > 0 : s_ > 0, v3_ = lat_ ? gc_ < 63 : s_ < T_CTX - 1; \
    nb_o0 = v0_ ? -64 * DIN : 0; nb_o1 = v1_ ? 64 * DIN : 0; nb_o2 = v2_ ? -DIN : 0; nb_o3 = v3_ ? DIN : 0; \
    nb_f0 = v0_ ? 1.f : 0.f; nb_f1 = v1_ ? 1.f : 0.f; nb_f2 = v2_ ? 1.f : 0.f; nb_f3 = v3_ ? 1.f : 0.f; nb_scale = lat_ ? 0.25f : 0.5f; }
#define MIX4(pc, mup) mix4_((pc), (mup), nb_o0, nb_o1, nb_o2, nb_o3, nb_f0, nb_f1, nb_f2, nb_f3, nb_scale)
DI f32x4 ld4bf(const bfr* p) {
  const uint2 u = *(const uint2*)p;
  return f32x4{__uint_as_float(u.x << 16), __uint_as_float(u.x & 0xffff0000u), __uint_as_float(u.y << 16), __uint_as_float(u.y & 0xffff0000u)};
}
DI f32x4 mix4_(const bfr* pc, const float* mu, int o0, int o1, int o2, int o3, float f0, float f1, float f2, float f3, float scale) {
  const f32x4 c = ld4bf(pc);
  f32x4 s = ld4bf(pc + o0) * f0 + ld4bf(pc + o1) * f1 + ld4bf(pc + o2) * f2 + ld4bf(pc + o3) * f3;
  const f32x4 m = *(const f32x4*)mu;
  return c + (s * scale - c) * m;
}
DI void ld8bf(const bfr* p, f32x4& lo, f32x4& hi) {
  const uint4 u = *(const uint4*)p;
  lo = f32x4{__uint_as_float(u.x << 16), __uint_as_float(u.x & 0xffff0000u), __uint_as_float(u.y << 16), __uint_as_float(u.y & 0xffff0000u)};
  hi = f32x4{__uint_as_float(u.z << 16), __uint_as_float(u.z & 0xffff0000u), __uint_as_float(u.w << 16), __uint_as_float(u.w & 0xffff0000u)};
}
DI void mix8_(const bfr* pc, const float* mu, int o0, int o1, int o2, int o3, float f0, float f1, float f2, float f3, float scale, f32x4& lo, f32x4& hi) {
  f32x4 cl, chh, al, ah, bl, bh, dl, dh, el, eh;
  ld8bf(pc, cl, chh); ld8bf(pc + o0, al, ah); ld8bf(pc + o1, bl, bh); ld8bf(pc + o2, dl, dh); ld8bf(pc + o3, el, eh);
  const f32x4 sl = al * f0 + bl * f1 + dl * f2 + el * f3, sh = ah * f0 + bh * f1 + dh * f2 + eh * f3;
  const f32x4 ml = *(const f32x4*)mu, mh = *(const f32x4*)(mu + 4);
  lo = cl + (sl * scale - cl) * ml; hi = chh + (sh * scale - chh) * mh;
}
#define MIX8(pc, mup, lo, hi) mix8_((pc), (mup), nb_o0, nb_o1, nb_o2, nb_o3, nb_f0, nb_f1, nb_f2, nb_f3, nb_scale, lo, hi)
DI float ftanh_(float x) { const float e = __expf(2.f * x); return 1.f - 2.f * frcp_(e + 1.f); }
DI uint2 pk4(f32x4 v) { return uint2{pack2(v[0], v[1]), pack2(v[2], v[3])}; }
constexpr int LIS = 200;
constexpr int MXS = 388;
DI void phase_rwprep(CParams& P, int bid, int nb, char* smem) {
  const bfr* p = (const bfr*)(P.ws + WS_P);
  const float* mu = P.in[10]; const float* w0 = P.in[11]; const float* a0 = P.in[13];
  const float* k_k = P.in[16]; const float* k_a = P.in[17];
  const bfr* LW_ = (const bfr*)(P.ws + WS_LORA);
  bfr* R = (bfr*)(P.ws + WS_RW); bfr* K = (bfr*)(P.ws + WS_RW + RW_ARR); bfr* V = (bfr*)(P.ws + WS_RW + 2 * RW_ARR);
  bfr* KK = (bfr*)(P.ws + WS_RW + 3 * RW_ARR); bfr* A = (bfr*)(P.ws + WS_RW + 4 * RW_ARR); bfr* G = (bfr*)(P.ws + WS_RW + 5 * RW_ARR);
  float* LWF = (float*)(P.ws + WS_LW); float* LWB = (float*)(P.ws + WS_LW + LW_ARR);
  short* LI = (short*)smem;
  float* MX = (float*)(smem + 32 * LIS * 2);
  const int tid = VT, lane = tid & 63, w = tid >> 6, fr = lane & 15, fq = lane >> 4;
  const f32x4 z4 = {0.f, 0.f, 0.f, 0.f};
  const int hp = bid & 3;
  bf16x8 afr[4][6];
  {
    const int h = hp * 2 + (w >> 1);
#pragma unroll
    for (int m = 0; m < 4; ++m) {
      const int c0 = 64 * h + 16 * m;
      afr[m][0] = *(const bf16x8*)(LW_ + LORA_WD2T + (c0 + fr) * 32 + fq * 8);
      afr[m][1] = *(const bf16x8*)(LW_ + LORA_WD2T + 512 * 32 + (c0 + fr) * 32 + fq * 8);
      afr[m][2] = *(const bf16x8*)(LW_ + LORA_WA2T + (c0 + fr) * 32 + fq * 8);
#pragma unroll
      for (int ks = 0; ks < 3; ++ks) afr[m][3 + ks] = *(const bf16x8*)(LW_ + LORA_WG2T + (c0 + fr) * 96 + ks * 32 + fq * 8);
    }
  }
  for (int it = bid; it < (T_ALL / 32) * 4; it += nb) {
  const int tile = it >> 2;
  const int row0 = tile * 32;
  __syncthreads();
  for (int v = tid; v < 32 * 72; v += NTHR) {
    const int t = v / 72, g = v % 72;
    const int row = row0 + t;
    NB_DECL(row);
    f32x4 lo, hi;
    if (g < 24) {
      const bfr* pc = p + (size_t)row * DIN + HGC + 1536 + g * 8;
      MIX8(pc, mu + 1536 + g * 8, lo, hi);
#pragma unroll
      for (int e = 0; e < 4; ++e) {
        if (g < 8) { lo[e] = ftanh_(lo[e]); hi[e] = ftanh_(hi[e]); }
        else if (g >= 12) { lo[e] = sigmoidf_(lo[e]); hi[e] = sigmoidf_(hi[e]); }
      }
      const uint2 a = pk4(lo), b = pk4(hi);
      *(uint4*)(LI + t * LIS + g * 8) = uint4{a.x, a.y, b.x, b.y};
    } else {
      const int cg = g - 24, a = cg >> 4, c8 = cg & 15;
      const int col = a * 512 + hp * 128 + c8 * 8;
      MIX8(p + (size_t)row * DIN + HGC + col, mu + col, lo, hi);
      *(f32x4*)(MX + t * MXS + a * 128 + c8 * 8) = lo; *(f32x4*)(MX + t * MXS + a * 128 + c8 * 8 + 4) = hi;
    }
  }
  __syncthreads();
  {
    const int hl = w >> 1, th = w & 1, h = hp * 2 + hl;
    const int row = row0 + 16 * th + fr;
    const float* mrow = MX + (16 * th + fr) * MXS + hl * 64 + 4 * fq;
    f32x4 kkr[4], kraw[4], av[4];
    float ss = 0.f;
#pragma unroll
    for (int m = 0; m < 4; ++m) {
      const int c0 = 64 * h + 16 * m;
      const int ch = c0 + 4 * fq;
      const f32x4 r = *(const f32x4*)(mrow + 16 * m);
      kraw[m] = *(const f32x4*)(mrow + 128 + 16 * m);
      const f32x4 v = *(const f32x4*)(mrow + 256 + 16 * m);
      const short* lrow = LI + (16 * th + fr) * LIS + fq * 8;
      f32x4 aF = __builtin_amdgcn_mfma_f32_16x16x32_bf16(afr[m][0], *(const bf16x8*)(lrow), z4, 0, 0, 0);
      f32x4 aB = __builtin_amdgcn_mfma_f32_16x16x32_bf16(afr[m][1], *(const bf16x8*)(lrow + 32), z4, 0, 0, 0);
      f32x4 aA = __builtin_amdgcn_mfma_f32_16x16x32_bf16(afr[m][2], *(const bf16x8*)(lrow + 64), z4, 0, 0, 0);
      f32x4 aG = z4;
#pragma unroll
      for (int ks = 0; ks < 3; ++ks) aG = __builtin_amdgcn_mfma_f32_16x16x32_bf16(afr[m][3 + ks], *(const bf16x8*)(lrow + 96 + ks * 32), aG, 0, 0, 0);
      const size_t o = (size_t)row * 512 + ch;
      const f32x4 w0f = *(const f32x4*)(w0 + ch), w0b = *(const f32x4*)(w0 + 512 + ch), a0v = *(const f32x4*)(a0 + ch);
      f32x4 lwf, lwb;
#pragma unroll
      for (int e = 0; e < 4; ++e) {
        lwf[e] = -RW_DECAY_SCALE * sigmoidf_(w0f[e] + aF[e]);
        lwb[e] = -RW_DECAY_SCALE * sigmoidf_(w0b[e] + aB[e]);
        av[m][e] = sigmoidf_(a0v[e] + aA[e]);
      }
      *(f32x4*)(LWF + o) = lwf; *(f32x4*)(LWB + o) = lwb;
      *(uint2*)(G + o) = pk4(aG);
      *(uint2*)(A + o) = pk4(av[m]);
      *(uint2*)(R + o) = pk4(r); *(uint2*)(V + o) = pk4(v);
      kkr[m] = kraw[m] * *(const f32x4*)(k_k + ch);
      ss += kkr[m][0] * kkr[m][0] + kkr[m][1] * kkr[m][1] + kkr[m][2] * kkr[m][2] + kkr[m][3] * kkr[m][3];
    }
    ss += __shfl_xor(ss, 16); ss += __shfl_xor(ss, 32);
    const float rn = rsqrtf(fmaxf(ss, 1e-12f));
#pragma unroll
    for (int m = 0; m < 4; ++m) {
      const int ch = 64 * h + 16 * m + 4 * fq;
      const size_t o = (size_t)row * 512 + ch;
      const f32x4 ka = *(const f32x4*)(k_a + ch);
      f32x4 kv;
#pragma unroll
      for (int e = 0; e < 4; ++e) kv[e] = kraw[m][e] * (1.f + (av[m][e] - 1.f) * ka[e]);
      *(uint2*)(K + o) = pk4(kv);
      *(uint2*)(KK + o) = pk4(kkr[m] * rn);
    }
  }
  }
}

DI void phase_readout(CParams& P, int bid, int nb) {
  const bfr* p = (const bfr*)(P.ws + WS_P);
  const float* Of = P.out + (size_t)T_LAT * 512;
  const float* Yf = P.out;
  const bfr* R = (const bfr*)(P.ws + WS_RW); const bfr* K = (const bfr*)(P.ws + WS_RW + RW_ARR); const bfr* V = (const bfr*)(P.ws + WS_RW + 2 * RW_ARR);
  const bfr* G = (const bfr*)(P.ws + WS_RW + 5 * RW_ARR);
  const float* hg_norm_w = P.in[9]; const float* r_k = P.in[18]; const float* gn_w = P.in[19]; const float* gn_b = P.in[20];
  bfr* mix = (bfr*)(P.ws + WS_H);
  const int wid = VT >> 6, lane = VT & 63;
  for (int t = bid * 4 + wid; t < T_LAT; t += nb * 4) {
    {
      float o[8]; float ss = 0.f;
#pragma unroll
      for (int e = 0; e < 8; ++e) { const long idx = (long)t * 512 + lane * 8 + e; o[e] = Of[idx]; ss += o[e] * o[e]; }
      ss += __shfl_xor(ss, 1); ss += __shfl_xor(ss, 2); ss += __shfl_xor(ss, 4); ss += __shfl_xor(ss, 8);
      const float rs = rsqrtf(ss * (1.f / 128.f) + 1e-6f);
      unsigned w[4];
#pragma unroll
      for (int e = 0; e < 8; e += 2) {
        const int c0 = lane * 8 + e;
        const float g0 = bf2f(p[(long)t * DIN + 2048 + c0]), g1 = bf2f(p[(long)t * DIN + 2048 + c0 + 1]);
        const float v0 = o[e] * rs * hg_norm_w[c0] * siluf_(g0);
        const float v1 = o[e + 1] * rs * hg_norm_w[c0 + 1] * siluf_(g1);
        w[e >> 1] = pack2(v0, v1);
      }
      *(uint4*)(mix + (long)t * DM + lane * 8) = uint4{w[0], w[1], w[2], w[3]};
    }
    {
      float y[8]; float s = 0.f, bs = 0.f;
      float vv[8];
#pragma unroll
      for (int e = 0; e < 8; ++e) {
        const long idx = (long)t * 512 + lane * 8 + e;
        y[e] = Yf[idx]; s += y[e];
        bs += bf2f(R[idx]) * bf2f(K[idx]) * r_k[lane * 8 + e];
        vv[e] = bf2f(V[idx]);
      }
      s += __shfl_xor(s, 1); s += __shfl_xor(s, 2); s += __shfl_xor(s, 4);
      bs += __shfl_xor(bs, 1); bs += __shfl_xor(bs, 2); bs += __shfl_xor(bs, 4);
      const float mu = s * (1.f / 64.f);
      float q = 0.f;
#pragma unroll
      for (int e = 0; e < 8; ++e) { y[e] -= mu; q += y[e] * y[e]; }
      q += __shfl_xor(q, 1); q += __shfl_xor(q, 2); q += __shfl_xor(q, 4);
      const float rs = rsqrtf(q * (1.f / 64.f) + 64e-5f);
      unsigned w[4];
#pragma unroll
      for (int e = 0; e < 8; e += 2) {
        const int c0 = lane * 8 + e;
        const long idx = (long)t * 512 + c0;
        const float v0 = (y[e] * rs * gn_w[c0] + gn_b[c0] + bs * vv[e]) * bf2f(G[idx]);
        const float v1 = (y[e + 1] * rs * gn_w[c0 + 1] + gn_b[c0 + 1] + bs * vv[e + 1]) * bf2f(G[idx + 1]);
        w[e >> 1] = pack2(v0, v1);
      }
      *(uint4*)(mix + (long)t * DM + 512 + lane * 8) = uint4{w[0], w[1], w[2], w[3]};
    }
  }
}

DI void phase_outproj(CParams& P, int bid, int nb, char* smem) {
  const bfr* mix = (const bfr*)(P.ws + WS_H);
  const float* w_out = P.in[7];
  float* y = (float*)(P.ws + WS_Y);
  short* sA = (short*)smem; short* sB = sA + 128 * LSTR;
  const int tid = VT, wid = tid >> 6, lane = tid & 63;
  const int wr = wid >> 1, wc = wid & 1, fr = lane & 15, fq = lane >> 4;
  constexpr int NT = 8, MT = T_LAT / 128;
  for (int it = bid; it < NT * MT; it += nb) {
    const int mt = it / NT, nt = it % NT;
    ALoadBf16 al; BLoadF32 bl;
#pragma unroll
    for (int i = 0; i < 4; ++i) al.rp[i] = mix + (long)(mt * 128 + (tid >> 3) + 32 * i) * DM + (tid & 7) * 8;
    bl.valid = true; bl.ldb = DM;
    bl.p = w_out + (long)((tid & 7) * 8) * DM + nt * 128 + (tid >> 3) * 4;
    f32x4 acc[4][4];
    gemm_mainloop(sA, sB, DM / 64, al, bl, acc);
#pragma unroll
    for (int m = 0; m < 4; ++m)
#pragma unroll
      for (int n = 0; n < 4; ++n)
#pragma unroll
        for (int j = 0; j < 4; ++j) {
          const int rr = mt * 128 + wr * 64 + m * 16 + fq * 4 + j, cc = nt * 128 + wc * 64 + n * 16 + fr;
          y[(long)rr * DM + cc] = acc[m][n][j];
        }
  }
}

constexpr size_t WS_WRT = 512 * 1024;
DI void phase_wrt_convert(CParams& P, int part, int nparts) {
  const float* wgrp = P.in[25]; const float* wrt = P.in[27];
  bfr* Whi = (bfr*)(P.ws + WS_WRT); bfr* Wlo = Whi + 80 * 1024;
  for (int i = part * NTHR + VT; i < 80 * 1024; i += nparts * NTHR) {
    const int o = i >> 10, k = i & 1023;
    float wv = 0.f;
    if (o < 8) wv = wgrp[k * 8 + o]; else if (o < 72) wv = wrt[k * 64 + (o - 8)];
    const bfr hi = f2bf(wv);
    Whi[i] = hi; Wlo[i] = f2bf(wv - bf2f(hi));
  }
}
constexpr int HLS = 1032;
DI void phase_ln2route(CParams& P, char* smem_all) {
  const float* x = P.in[0];
  const bfr* y = (const bfr*)(P.ws + WS_Y);
  const float* mod = (const float*)(P.ws + WS_MOD);
  const float* ln1_g = P.in[21]; const float* ln1_b = P.in[22];
  const float* bgrp = P.in[26]; const float* brt = P.in[28];
  const bfr* Whi = (const bfr*)(P.ws + WS_WRT); const bfr* Wlo = Whi + 80 * 1024;
  bfr* x1 = (bfr*)(P.ws + WS_X1B);
  bfr* h2 = (bfr*)(P.ws + WS_H2);
  int* cnt = (int*)(P.ws + WS_CNT); int* list = (int*)(P.ws + WS_LIST); float* asgw = (float*)(P.ws + WS_ASGW);
  short* HI = (short*)smem_all; short* LO = HI + 32 * HLS;
  float* LG = (float*)(smem_all + 2 * 32 * HLS * 2);
  float* PS = LG + 32 * 80;
  const int tid = tx_(), wid = tid >> 6, lane = tid & 63, fr = lane & 15, fq = lane >> 4;
  for (int grp = blockIdx.x; grp < T_LAT / 32; grp += gridDim.x) {
    const int t0 = grp * 32;
    __syncthreads();
    f32x4 xin[4][4]; uint2 yin[4][4];
#pragma unroll
    for (int tt = 0; tt < 4; ++tt)
#pragma unroll
      for (int i = 0; i < 4; ++i) {
        const long o = (long)(t0 + wid * 4 + tt) * DM + lane * 4 + 256 * i;
        xin[tt][i] = *(const f32x4*)(x + o); yin[tt][i] = *(const uint2*)(y + o);
      }
#pragma unroll
    for (int tt = 0; tt < 4; ++tt) {
      const int tl = wid * 4 + tt, t = t0 + tl;
      f32x4 v[4]; float s = 0.f;
#pragma unroll
      for (int i = 0; i < 4; ++i) {
        const int c = lane * 4 + 256 * i;
        const f32x4 g1 = *(const f32x4*)(mod + 2048 + c);
        const uint2 u = yin[tt][i];
        const f32x4 yv = {__uint_as_float(u.x << 16), __uint_as_float(u.x & 0xffff0000u), __uint_as_float(u.y << 16), __uint_as_float(u.y & 0xffff0000u)};
        v[i] = xin[tt][i] * DN_ALPHA + g1 * yv;
        s += v[i][0] + v[i][1] + v[i][2] + v[i][3];
      }
      float mu = wave_sum(s) * (1.f / DM); float q = 0.f;
#pragma unroll
      for (int i = 0; i < 4; ++i) { v[i] -= mu; q += v[i][0] * v[i][0] + v[i][1] * v[i][1] + v[i][2] * v[i][2] + v[i][3] * v[i][3]; }
      float rs = rsqrtf(wave_sum(q) * (1.f / DM) + 1e-5f);
      s = 0.f;
#pragma unroll
      for (int i = 0; i < 4; ++i) {
        const int c = lane * 4 + 256 * i;
        f32x4 g = *(const f32x4*)(ln1_g + c), b = *(const f32x4*)(ln1_b + c);
        v[i] = v[i] * rs * g + b;
        *(uint2*)(x1 + (long)t * DM + c) = pk4(v[i]);
        s += v[i][0] + v[i][1] + v[i][2] + v[i][3];
      }
      mu = wave_sum(s) * (1.f / DM); q = 0.f;
#pragma unroll
      for (int i = 0; i < 4; ++i) { v[i] -= mu; q += v[i][0] * v[i][0] + v[i][1] * v[i][1] + v[i][2] * v[i][2] + v[i][3] * v[i][3]; }
      rs = rsqrtf(wave_sum(q) * (1.f / DM) + 1e-5f);
#pragma unroll
      for (int i = 0; i < 4; ++i) {
        const int c = lane * 4 + 256 * i;
        f32x4 sh = *(const f32x4*)(mod + 3072 + c), sc = *(const f32x4*)(mod + 4096 + c);
        v[i] = v[i] * rs * (sc + 1.f) + sh;
        const uint2 whi = {pack2(v[i][0], v[i][1]), pack2(v[i][2], v[i][3])};
        f32x4 r;
        r[0] = v[i][0] - __uint_as_float(whi.x << 16); r[1] = v[i][1] - __uint_as_float(whi.x & 0xffff0000u);
        r[2] = v[i][2] - __uint_as_float(whi.y << 16); r[3] = v[i][3] - __uint_as_float(whi.y & 0xffff0000u);
        const uint2 wlo = {pack2(r[0], r[1]), pack2(r[2], r[3])};
        *(uint2*)(h2 + (long)t * DM + c) = whi;
        *(uint2*)(HI + tl * HLS + c) = whi;
        *(uint2*)(LO + tl * HLS + c) = wlo;
      }
    }
    __syncthreads();
    {
      const int own = wid < 4;
      const int mrow = own ? 16 * wid : 64;
      f32x4 acc0 = {0.f, 0.f, 0.f, 0.f}, acc1 = {0.f, 0.f, 0.f, 0.f};
      bf16x8 a[8], an[8];
      const int nbatch = own ? 12 : 3;
#define RT_LOAD(bi_, dst) do { const int ps_ = own ? ((bi_) >> 2) : (bi_), kb_ = own ? (((bi_) & 3) * 8) : ((wid - 4) * 8); const bfr* Wp_ = ps_ == 1 ? Wlo : Whi; \
        _Pragma("unroll") for (int u = 0; u < 8; ++u) dst[u] = *(const bf16x8*)(Wp_ + (size_t)(mrow + fr) * 1024 + (kb_ + u) * 32 + fq * 8); } while (0)
      RT_LOAD(0, a);
#pragma unroll 1
      for (int bi = 0; bi < nbatch; ++bi) {
        if (bi + 1 < nbatch) RT_LOAD(bi + 1, an);
        const int ps = own ? (bi >> 2) : bi, kb = own ? ((bi & 3) * 8) : ((wid - 4) * 8);
        const short* Hp = ps == 2 ? LO : HI;
#pragma unroll
        for (int u = 0; u < 8; ++u) {
          const bf16x8 b0 = *(const bf16x8*)(Hp + fr * HLS + (kb + u) * 32 + fq * 8);
          const bf16x8 b1 = *(const bf16x8*)(Hp + (16 + fr) * HLS + (kb + u) * 32 + fq * 8);
          acc0 = __builtin_amdgcn_mfma_f32_16x16x32_bf16(a[u], b0, acc0, 0, 0, 0);
          acc1 = __builtin_amdgcn_mfma_f32_16x16x32_bf16(a[u], b1, acc1, 0, 0, 0);
        }
#pragma unroll
        for (int u = 0; u < 8; ++u) a[u] = an[u];
      }
#undef RT_LOAD
      if (own) {
#pragma unroll
        for (int reg = 0; reg < 4; ++reg) { LG[fr * 80 + mrow + 4 * fq + reg] = acc0[reg]; LG[(16 + fr) * 80 + mrow + 4 * fq + reg] = acc1[reg]; }
      } else {
#pragma unroll
        for (int reg = 0; reg < 4; ++reg) { PS[((wid - 4) * 32 + fr) * 16 + 4 * fq + reg] = acc0[reg]; PS[((wid - 4) * 32 + 16 + fr) * 16 + 4 * fq + reg] = acc1[reg]; }
      }
    }
    __syncthreads();
    {
      const int tk = tid >> 4, o = tid & 15;
      LG[tk * 80 + 64 + o] = (PS[(0 * 32 + tk) * 16 + o] + PS[(1 * 32 + tk) * 16 + o]) + (PS[(2 * 32 + tk) * 16 + o] + PS[(3 * 32 + tk) * 16 + o]);
    }
    __syncthreads();
    if (tid < 32) {
      const int t = t0 + tid;
      const float* lg = LG + tid * 80;
      int gi = 0; float gmax = -3.4e38f; float gl[8];
#pragma unroll
      for (int g = 0; g < 8; ++g) { gl[g] = lg[g] + bgrp[g]; if (gl[g] > gmax) { gmax = gl[g]; gi = g; } }
      float den = 0.f;
#pragma unroll
      for (int g = 0; g < 8; ++g) den += __expf(gl[g] - gmax);
      const float gprob = 1.f / den;
      int i1 = 0; float v1 = -3.4e38f; float el[8];
#pragma unroll
      for (int g = 0; g < 8; ++g) { el[g] = lg[8 + gi * 8 + g] + brt[gi * 8 + g]; if (el[g] > v1) { v1 = el[g]; i1 = g; } }
      int i2 = 0; float v2 = -3.4e38f;
#pragma unroll
      for (int g = 0; g < 8; ++g) { if (g != i1 && el[g] > v2) { v2 = el[g]; i2 = g; } }
      const float e2 = __expf(v2 - v1);
      const float wt1 = gprob / (1.f + e2), wt2 = gprob * e2 / (1.f + e2);
      const int ex1 = gi * 8 + i1, ex2 = gi * 8 + i2;
      int s1 = atomicAdd(&cnt[ex1], 1); list[ex1 * T_LAT + s1] = t * 2;
      int s2 = atomicAdd(&cnt[ex2], 1); list[ex2 * T_LAT + s2] = t * 2 + 1;
      asgw[t * 2] = wt1; asgw[t * 2 + 1] = wt2;
    }
  }
}

DI void moe_block_table(CParams& P, int* tab  ) {
  const int* cnt = (const int*)(P.ws + WS_CNT);
  const int tid = VT;
  __syncthreads();
  if (tid < 64) {
    int nbk = (cnt[tid] + 127) >> 7;
    int incl = nbk;
#pragma unroll
    for (int o = 1; o < 64; o <<= 1) { int u = __shfl_up(incl, o); if (tid >= o) incl += u; }
    tab[tid + 1] = incl;
    if (tid == 0) tab[0] = 0;
  }
  __syncthreads();
}
DI int moe_find_expert(const int* tab, int rb) {
  int e = 0;
  while (tab[e + 1] <= rb) ++e;
  return e;
}

DI void phase_moe1(CParams& P, int bid, int nb, char* smem) {
  const bfr* h2 = (const bfr*)(P.ws + WS_H2);
  const int* cnt = (const int*)(P.ws + WS_CNT); const int* list = (const int*)(P.ws + WS_LIST);
  const float* wg = P.in[29]; const float* wu = P.in[30];
  bfr* hid = (bfr*)(P.ws + WS_HID);
  short* sA = (short*)smem; short* sB = sA + 128 * LSTR;
  int* tab = (int*)(smem + GEMM_LDS_BYTES);
  const int tid = VT, wid = tid >> 6, lane = tid & 63;
  const int wr = wid >> 1, wc = wid & 1, fr = lane & 15, fq = lane >> 4;
  moe_block_table(P, tab);
  const int nrb = tab[64];
  for (int it = bid; it < nrb * 8; it += nb) {
    const int rb = it >> 3, nt = it & 7;
    const int e = moe_find_expert(tab, rb);
    const int lrb = rb - tab[e];
    const int ce = cnt[e];
    ALoadBf16 al; BLoadF32 bl;
#pragma unroll
    for (int i = 0; i < 4; ++i) {
      int r = lrb * 128 + (tid >> 3) + 32 * i;
      if (r >= ce) r = ce - 1;
      const int tok = list[e * T_LAT + r] >> 1;
      al.rp[i] = h2 + (long)tok * DM + (tid & 7) * 8;
    }
    const int n4 = tid >> 3;
    const int isup = (n4 >> 3) & 1;
    const int col = nt * 64 + (n4 >> 4) * 32 + ((4 * n4) & 31);
    bl.valid = true; bl.ldb = DEXP;
    bl.p = (isup ? wu : wg) + (long)e * DM * DEXP + (long)((tid & 7) * 8) * DEXP + col;
    f32x4 acc[4][4];
    gemm_mainloop(sA, sB, DM / 64, al, bl, acc);
#pragma unroll
    for (int m = 0; m < 4; ++m)
#pragma unroll
      for (int n = 0; n < 2; ++n)
#pragma unroll
        for (int j = 0; j < 4; ++j) {
          const int rl = wr * 64 + m * 16 + fq * 4 + j;
          const int cc = nt * 64 + wc * 32 + n * 16 + fr;
          const float gv = acc[m][n][j], uv = acc[m][n + 2][j];
          hid[((long)rb * 128 + rl) * DEXP + cc] = f2bf(siluf_(gv) * uv);
        }
  }
}

DI void phase_moe2(CParams& P, int bid, int nb, char* smem) {
  const int* cnt = (const int*)(P.ws + WS_CNT); const int* list = (const int*)(P.ws + WS_LIST);
  const float* wd = P.in[31];
  const bfr* hid = (const bfr*)(P.ws + WS_HID);
  bfr* mout = (bfr*)(P.ws + WS_MOUT);
  short* sA = (short*)smem; short* sB = sA + 128 * LSTR;
  int* tab = (int*)(smem + GEMM_LDS_BYTES);
  const int tid = VT, wid = tid >> 6, lane = tid & 63;
  const int wr = wid >> 1, wc = wid & 1, fr = lane & 15, fq = lane >> 4;
  moe_block_table(P, tab);
  const int nrb = tab[64];
  for (int it = bid; it < nrb * 8; it += nb) {
    const int rb = it >> 3, nt = it & 7;
    const int e = moe_find_expert(tab, rb);
    const int lrb = rb - tab[e];
    const int ce = cnt[e];
    ALoadBf16 al; BLoadF32 bl;
#pragma unroll
    for (int i = 0; i < 4; ++i) al.rp[i] = hid + ((long)rb * 128 + (tid >> 3) + 32 * i) * DEXP + (tid & 7) * 8;
    bl.valid = true; bl.ldb = DM;
    bl.p = wd + (long)e * DEXP * DM + (long)((tid & 7) * 8) * DM + nt * 128 + (tid >> 3) * 4;
    f32x4 acc[4][4];
    gemm_mainloop(sA, sB, DEXP / 64, al, bl, acc);
#pragma unroll
    for (int m = 0; m < 4; ++m)
#pragma unroll
      for (int j = 0; j < 4; ++j) {
        const int r = lrb * 128 + wr * 64 + m * 16 + fq * 4 + j;
        if (r < ce) {
          const int asg = list[e * T_LAT + r];
#pragma unroll
          for (int n = 0; n < 4; ++n) mout[(long)asg * DM + nt * 128 + wc * 64 + n * 16 + fr] = f2bf(acc[m][n][j]);
        }
      }
  }
}

DI void phase_final(CParams& P, int bid, int nb) {
  const float* mod = (const float*)(P.ws + WS_MOD);
  const float* ln2_g = P.in[23]; const float* ln2_b = P.in[24];
  const bfr* mout = (const bfr*)(P.ws + (42ull << 20));
  const bfr* x1b = (const bfr*)(P.ws + WS_X1B);
  const float* asgw = (const float*)(P.ws + WS_ASGW);
  float* out = P.out;
  const int wid = VT >> 6, lane = VT & 63;
  for (int t0 = (bid * 4 + wid) * 2; t0 < T_LAT; t0 += nb * 8) {
    f32x4 v[2][4]; float s[2] = {0.f, 0.f};
#pragma unroll
    for (int r = 0; r < 2; ++r) {
      const int t = t0 + r;
      const float w1 = asgw[t * 2], w2 = asgw[t * 2 + 1];
#pragma unroll
      for (int i = 0; i < 4; ++i) {
        const int c = lane * 4 + 256 * i;
        const f32x4 xv = ld4bf(x1b + (long)t * DM + c), g2 = *(const f32x4*)(mod + 5120 + c);
        const f32x4 a = ld4bf(mout + (long)(2 * t) * DM + c), b = ld4bf(mout + (long)(2 * t + 1) * DM + c);
        v[r][i] = xv * DN_ALPHA + g2 * (a * w1 + b * w2);
        s[r] += v[r][i][0] + v[r][i][1] + v[r][i][2] + v[r][i][3];
      }
    }
#pragma unroll
    for (int r = 0; r < 2; ++r) {
      const float mu = wave_sum(s[r]) * (1.f / DM); float q = 0.f;
#pragma unroll
      for (int i = 0; i < 4; ++i) { v[r][i] -= mu; q += v[r][i][0] * v[r][i][0] + v[r][i][1] * v[r][i][1] + v[r][i][2] * v[r][i][2] + v[r][i][3] * v[r][i][3]; }
      const float rs = rsqrtf(wave_sum(q) * (1.f / DM) + 1e-5f);
#pragma unroll
      for (int i = 0; i < 4; ++i) {
        const int c = lane * 4 + 256 * i;
        f32x4 g = *(const f32x4*)(ln2_g + c), b = *(const f32x4*)(ln2_b + c);
        *(f32x4*)(out + (long)(t0 + r) * DM + c) = v[r][i] * rs * g + b;
      }
    }
  }
}

DI void phase_readout_fused(CParams& P, int bid, int nb) {
  const bfr* p = (const bfr*)(P.ws + WS_P);
  const bfr* R = (const bfr*)(P.ws + WS_RW); const bfr* K = (const bfr*)(P.ws + WS_RW + RW_ARR); const bfr* V = (const bfr*)(P.ws + WS_RW + 2 * RW_ARR);
  const bfr* G = (const bfr*)(P.ws + WS_RW + 5 * RW_ARR);
  const float* hg_norm_w = P.in[9]; const float* r_k = P.in[18]; const float* gn_w = P.in[19]; const float* gn_b = P.in[20];
  bfr* mix = (bfr*)(P.ws + WS_MIX);
  const int tid = VT, lane = tid & 63, w = tid >> 6, fr = lane & 15, fq = lane >> 4;
  const f32x4 z4 = {0.f, 0.f, 0.f, 0.f};
  for (int tile = bid; tile < T_LAT / 32; tile += nb) {
    const int t0 = tile * 32;
#pragma unroll 1
    for (int hh = 0; hh < 2; ++hh) {
      const int hd = 2 * w + hh;
      f32x4 acc[4][2];
#pragma unroll
      for (int m = 0; m < 4; ++m) { acc[m][0] = z4; acc[m][1] = z4; }
#pragma unroll
      for (int dir = 0; dir < 2; ++dir) {
        const int ci = dir ? (519 - tile) : (8 + tile);
        const int sc = rw_sc_of_chunk(ci);
        const bfr* Bq = (const bfr*)(P.ws + WS_R2P) + (size_t)dir * T_LAT * 512 + (size_t)t0 * 512 + hd * 64;
        const bfr* Y0 = (const bfr*)(P.ws + WS_Y0P) + (size_t)dir * T_LAT * 512 + (size_t)t0 * 512 + hd * 64;
        const bfr* Sin = (const bfr*)(P.ws + WS_SINRW) + ((size_t)(dir * 8 + hd) * (RW_NSC + 1) + sc) * 4096;
#pragma unroll
        for (int k0 = 0; k0 < 64; k0 += 32) {
          bf16x8 bq[2];
#pragma unroll
          for (int n = 0; n < 2; ++n) bq[n] = *(const bf16x8*)(Bq + (size_t)(16 * n + fr) * 512 + k0 + fq * 8);
#pragma unroll
          for (int m = 0; m < 4; ++m) {
            const bf16x8 a = *(const bf16x8*)(Sin + (16 * m + fr) * 64 + k0 + fq * 8);
#pragma unroll
            for (int n = 0; n < 2; ++n) acc[m][n] = __builtin_amdgcn_mfma_f32_16x16x32_bf16(a, bq[n], acc[m][n], 0, 0, 0);
          }
        }
#pragma unroll
        for (int m = 0; m < 4; ++m)
#pragma unroll
          for (int n = 0; n < 2; ++n) acc[m][n] += ld4bf(Y0 + (size_t)(16 * n + fr) * 512 + 16 * m + 4 * fq);
      }
#pragma unroll
      for (int n = 0; n < 2; ++n) {
        const size_t trow = (size_t)(t0 + 16 * n + fr) * 512 + hd * 64;
        float s = 0.f, bs = 0.f;
        f32x4 vv[4];
#pragma unroll
        for (int m = 0; m < 4; ++m) {
          const int c = 16 * m + 4 * fq;
          s += acc[m][n][0] + acc[m][n][1] + acc[m][n][2] + acc[m][n][3];
          const f32x4 rr = ld4bf(R + trow + c), kk2 = ld4bf(K + trow + c), rk = *(const f32x4*)(r_k + hd * 64 + c);
          vv[m] = ld4bf(V + trow + c);
          bs += rr[0] * kk2[0] * rk[0] + rr[1] * kk2[1] * rk[1] + rr[2] * kk2[2] * rk[2] + rr[3] * kk2[3] * rk[3];
        }
        s += __shfl_xor(s, 16); s += __shfl_xor(s, 32);
        bs += __shfl_xor(bs, 16); bs += __shfl_xor(bs, 32);
        const float mu = s * (1.f / 64.f);
        float q = 0.f;
#pragma unroll
        for (int m = 0; m < 4; ++m) { acc[m][n] -= mu; q += acc[m][n][0] * acc[m][n][0] + acc[m][n][1] * acc[m][n][1] + acc[m][n][2] * acc[m][n][2] + acc[m][n][3] * acc[m][n][3]; }
        q += __shfl_xor(q, 16); q += __shfl_xor(q, 32);
        const float rs = rsqrtf(q * (1.f / 64.f) + 64e-5f);
#pragma unroll
        for (int m = 0; m < 4; ++m) {
          const int c = hd * 64 + 16 * m + 4 * fq;
          const f32x4 gw = *(const f32x4*)(gn_w + c), gb = *(const f32x4*)(gn_b + c), gg = ld4bf(G + trow + 16 * m + 4 * fq);
          const f32x4 o = (acc[m][n] * rs * gw + gb + vv[m] * bs) * gg;
          *(uint2*)(mix + (size_t)(t0 + 16 * n + fr) * DM + 512 + c) = pk4(o);
        }
      }
    }
    {
      const int hd = w;
      f32x4 acc[8][2];
#pragma unroll
      for (int m = 0; m < 8; ++m) { acc[m][0] = z4; acc[m][1] = z4; }
#pragma unroll
      for (int dir = 0; dir < 2; ++dir) {
        const int ci = dir ? (519 - tile) : (8 + tile);
        const int sc = hg_sc_of_chunk(ci);
        const bfr* Bq = (const bfr*)(P.ws + WS_QH) + (size_t)dir * T_LAT * 512 + (size_t)t0 * 512 + hd * 128;
        const bfr* O0 = (const bfr*)(P.ws + WS_O0) + (size_t)dir * T_LAT * 512 + (size_t)t0 * 512 + hd * 128;
        const bfr* Sin = (const bfr*)(P.ws + WS_SINHG) + ((size_t)(dir * 4 + hd) * HG_NSC + sc) * 16384;
#pragma unroll
        for (int k0 = 0; k0 < 128; k0 += 32) {
          bf16x8 bq[2];
#pragma unroll
          for (int n = 0; n < 2; ++n) bq[n] = *(const bf16x8*)(Bq + (size_t)(16 * n + fr) * 512 + k0 + fq * 8);
#pragma unroll
          for (int m = 0; m < 8; ++m) {
            const bf16x8 a = *(const bf16x8*)(Sin + (16 * m + fr) * 128 + k0 + fq * 8);
#pragma unroll
            for (int n = 0; n < 2; ++n) acc[m][n] = __builtin_amdgcn_mfma_f32_16x16x32_bf16(a, bq[n], acc[m][n], 0, 0, 0);
          }
        }
#pragma unroll
        for (int m = 0; m < 8; ++m)
#pragma unroll
          for (int n = 0; n < 2; ++n) acc[m][n] += ld4bf(O0 + (size_t)(16 * n + fr) * 512 + 16 * m + 4 * fq);
      }
#pragma unroll
      for (int n = 0; n < 2; ++n) {
        const int t = t0 + 16 * n + fr;
        float ss = 0.f;
#pragma unroll
        for (int m = 0; m < 8; ++m) ss += acc[m][n][0] * acc[m][n][0] + acc[m][n][1] * acc[m][n][1] + acc[m][n][2] * acc[m][n][2] + acc[m][n][3] * acc[m][n][3];
        ss += __shfl_xor(ss, 16); ss += __shfl_xor(ss, 32);
        const float rs = rsqrtf(ss * (1.f / 128.f) + 1e-6f);
#pragma unroll
        for (int m = 0; m < 8; ++m) {
          const int c = hd * 128 + 16 * m + 4 * fq;
          const f32x4 nw = *(const f32x4*)(hg_norm_w + c), gg = ld4bf(p + (size_t)t * DIN + 2048 + c);
          f32x4 o;
#pragma unroll
          for (int e = 0; e < 4; ++e) o[e] = acc[m][n][e] * rs * nw[e] * siluf_(gg[e]);
          *(uint2*)(mix + (size_t)t * DM + c) = pk4(o);
        }
      }
    }
  }
}

namespace pg8 {
#define PG8_LAS __attribute__((address_space(3)))
typedef unsigned short bf16_t;
typedef short bf16x8 __attribute__((ext_vector_type(8)));
typedef float f32x4 __attribute__((ext_vector_type(4)));
typedef unsigned u32x4 __attribute__((ext_vector_type(4)));
constexpr int BM = 256, BK = 64, HALF = 128, HTB = HALF * BK * 2  , STAGE_BYTES = 8 * HTB, NXCD = 8, WGM = 8;

__host__ __device__ __forceinline__ int lds_byte(int r, int c) { const int st = (r >> 4) * 2 + (c >> 5), rr = r & 15, cc = c & 31, ob = rr * 64 + cc * 2; return st * 1024 + (ob ^ (((ob >> 9) & 1) << 5)); }
__host__ __device__ __forceinline__ void stage_rc(int b, int& R, int& C) { const int st = b / 1024, sb = b % 1024, swz = sb ^ (((sb >> 9) & 1) << 5); R = (st >> 1) * 16 + swz / 64; C = (st & 1) * 32 + (swz % 64) / 2; }
__host__ __device__ __forceinline__ int perm32(int rho) { const int n = rho >> 4, i = rho & 15; return 8 * (i >> 2) + 4 * n + (i & 3); }

struct Unit { int pm, pn; };
struct Gemm { const bf16_t* A; const bf16_t* Bt; int M, N, K; };

struct StaticOrder {
    int nM, nN, nwg, G, c;
    __host__ __device__ void init(int M, int N, int G_, int c_) { nM = M / BM; nN = N / BM; nwg = nM * nN; G = G_; c = c_; }
    __host__ __device__ bool next(int i, Unit& u) const {
        const long L = (long)i * G + c; if (L >= nwg) return false;
        int wgid = (int)L; { const int q = nwg / NXCD, r = nwg % NXCD, xcd = wgid % NXCD, off = wgid / NXCD; wgid = (xcd < r ? xcd * (q + 1) : r * (q + 1) + (xcd - r) * q) + off; }
        const int nig = WGM * nN, gid = wgid / nig, fm = gid * WGM, gsz = (nM - fm) < WGM ? (nM - fm) : WGM;
        u.pm = fm + ((wgid % nig) % gsz); u.pn = (wgid % nig) / gsz; return true;
    }
    __device__ __forceinline__ void a_ready(const Unit&) const {}
    __device__ __forceinline__ void done(const Unit&) const {}
};
struct CountedOrder : StaticOrder {
    const unsigned* ready; unsigned need; unsigned* tmo;
    __device__ __forceinline__ void a_ready(const Unit& u) const {
        if (threadIdx.x < 64) {
            const unsigned long long t0 = __builtin_amdgcn_s_memrealtime(); unsigned polls = 0;
            while ((unsigned)__builtin_amdgcn_readfirstlane(__hip_atomic_load(ready + 64 * u.pm, __ATOMIC_RELAXED, __HIP_MEMORY_SCOPE_AGENT)) < need) {
                if ((++polls & 255u) == 0u && __builtin_amdgcn_readfirstlane(__hip_atomic_load(tmo, __ATOMIC_RELAXED, __HIP_MEMORY_SCOPE_AGENT)) != 0u) break;
                if (__builtin_amdgcn_s_memrealtime() - t0 > 2000000ull) {
                    if (threadIdx.x == 0) { unsigned expect = 0u; __hip_atomic_compare_exchange_strong(tmo + 1, &expect, 0x600u | (unsigned)(u.pm & 0xff), __ATOMIC_RELAXED, __ATOMIC_RELAXED, __HIP_MEMORY_SCOPE_AGENT); __hip_atomic_store(tmo, 1u, __ATOMIC_RELAXED, __HIP_MEMORY_SCOPE_AGENT); }
                    break; }
                __builtin_amdgcn_s_sleep(2); }
            __builtin_amdgcn_fence(__ATOMIC_ACQUIRE, "agent");
            asm volatile("s_waitcnt vmcnt(0)" ::: "memory");
        }
#if !defined(BROKEN_HOOK_NO_BARRIER)
        asm volatile("" ::: "memory"); __builtin_amdgcn_s_barrier(); asm volatile("" ::: "memory");
#endif
    }
};
struct EpiF32 {
    static constexpr bool PERM = false, AFTER_DRAIN = false;
    float* C; int ldc; const float* bias;
    __device__ __forceinline__ void operator()(const f32x4 (&acc)[2][2][4][2], const Unit& u, int wr, int wc, int fr, int fq) const {
        const int row0 = u.pm * BM + wr * 64 + fr, col0 = u.pn * BM + wc * 32 + 4 * fq;
        f32x4 bv[2][2];
#pragma unroll
        for (int bj = 0; bj < 2; ++bj)
#pragma unroll
            for (int n = 0; n < 2; ++n) bv[bj][n] = bias ? *(const f32x4*)(bias + col0 + bj * HALF + n * 16) : (f32x4){0.f, 0.f, 0.f, 0.f};
#pragma unroll
        for (int ai = 0; ai < 2; ++ai)
#pragma unroll
            for (int m = 0; m < 4; ++m) { float* rowp = C + (size_t)(row0 + ai * HALF + m * 16) * ldc + col0;
#pragma unroll
                for (int bj = 0; bj < 2; ++bj)
#pragma unroll
                    for (int n = 0; n < 2; ++n) *(f32x4*)(rowp + bj * HALF + n * 16) = acc[ai][bj][m][n] + bv[bj][n]; }
    }
};
template <class Epi, class Sched, bool STAMP = false>
__device__ __forceinline__ void gemm_phase(PG8_LAS unsigned char* lds, const Gemm g, const Sched& S, const Epi& E, unsigned long long* stamps) {
    int tid_ = threadIdx.x; asm volatile("" : "+v"(tid_));
    const int tid = tid_, wid = __builtin_amdgcn_readfirstlane(tid >> 6), lane = tid & 63, wr = wid >> 2, wc = wid & 3, fr = lane & 15, fq = lane >> 4;
    const int K = g.K, nt = K / BK;
    int ts_lo = 0, ts_hi = 0, nts = 0; const unsigned long long rt_entry = STAMP ? (unsigned long long)wall_clock64() : 0ull;
#define PG8_STAMP() do { if (STAMP && wid == 0 && nts < 64) { const unsigned long long _c = (unsigned long long)clock64(); \
        ts_lo = (lane == nts) ? (int)(unsigned)_c : ts_lo; ts_hi = (lane == nts) ? (int)(unsigned)(_c >> 32) : ts_hi; ++nts; } } while (0)
    PG8_STAMP();
    unsigned voffA[2], voffB[2];
#pragma unroll
    for (int i = 0; i < 2; ++i) { int R, C; stage_rc(tid * 16 + i * 8192, R, C); const int Rb = Epi::PERM ? ((R & ~31) + perm32(R & 31)) : R;
        voffA[i] = (unsigned)(R * K + C) * 2u; voffB[i] = (unsigned)(Rb * K + C) * 2u; }
    const size_t kstep = (size_t)(BK * 2);
    const size_t hstep = (size_t)HALF * K * 2;
    const size_t tstep = 2 * hstep;
    const unsigned ldsw = (unsigned)wid * 1024u;
    const int aoff = lds_byte(wr * 64 + fr, fq * 8), boff = lds_byte(wc * 32 + fr, fq * 8);
#define PG8_SA(b, h) (((b) * 2 + (h)) * HTB)
#define PG8_SB(b, h) ((4 + (b) * 2 + (h)) * HTB)
#define PG8_STAGE(bufoff, gbase, voff) do { _Pragma("unroll") for (int _i = 0; _i < 2; ++_i) \
        __builtin_amdgcn_global_load_lds((const unsigned*)((const char*)(gbase) + (voff)[_i]), (PG8_LAS unsigned*)(lds + (bufoff) + ldsw + _i * 8192), 16, 0, 0); } while (0)
#define PG8_LDA(dst, b, h) do { _Pragma("unroll") for (int m = 0; m < 4; ++m) _Pragma("unroll") for (int k = 0; k < 2; ++k) dst[m][k] = *(const PG8_LAS bf16x8*)(lds + PG8_SA(b, h) + aoff + m * 2048 + k * 1024); } while (0)
#define PG8_LDB(dst, b, h) do { _Pragma("unroll") for (int n = 0; n < 2; ++n) _Pragma("unroll") for (int k = 0; k < 2; ++k) dst[n][k] = *(const PG8_LAS bf16x8*)(lds + PG8_SB(b, h) + boff + n * 2048 + k * 1024); } while (0)
#define PG8_MMA(ai, bj, At, Bt) do { __builtin_amdgcn_s_setprio(1); _Pragma("unroll") for (int m = 0; m < 4; ++m) _Pragma("unroll") for (int n = 0; n < 2; ++n) _Pragma("unroll") for (int k = 0; k < 2; ++k) \
        acc[ai][bj][m][n] = __builtin_amdgcn_mfma_f32_16x16x32_bf16(Bt[n][k], At[m][k], acc[ai][bj][m][n], 0, 0, 0); __builtin_amdgcn_s_setprio(0); } while (0)
#define PG8_WAIT_V(n) asm volatile("s_waitcnt vmcnt(" #n ")" ::: "memory")
#define PG8_WAIT_L(n) asm volatile("s_waitcnt lgkmcnt(" #n ")" ::: "memory")
#define PG8_BAR __builtin_amdgcn_s_barrier()
#define PG8_SCHED __builtin_amdgcn_sched_barrier(0)
    Unit cur, nxt; int ui = 0;
    if (!S.next(0, cur)) return;
    f32x4 acc[2][2][4][2];
#pragma unroll
    for (int a = 0; a < 2; ++a)
#pragma unroll
        for (int b = 0; b < 2; ++b)
#pragma unroll
            for (int m = 0; m < 4; ++m)
#pragma unroll
                for (int n = 0; n < 2; ++n) acc[a][b][m][n] = (f32x4){0.f, 0.f, 0.f, 0.f};
    bf16x8 At[4][2], B0[2][2], B1[2][2];
    const char* cA = (const char*)g.A + (size_t)cur.pm * tstep; const char* cB = (const char*)g.Bt + (size_t)cur.pn * tstep;
    S.a_ready(cur);
    PG8_STAGE(PG8_SB(0, 0), cB, voffB); PG8_STAGE(PG8_SA(0, 0), cA, voffA); PG8_STAGE(PG8_SB(0, 1), cB + hstep, voffB); PG8_STAGE(PG8_SA(0, 1), cA + hstep, voffA);
    if (wr == 1) PG8_BAR;
    PG8_WAIT_V(4); PG8_BAR;
    PG8_STAGE(PG8_SB(1, 0), cB + kstep, voffB); PG8_STAGE(PG8_SA(1, 0), cA + kstep, voffA); PG8_STAGE(PG8_SB(1, 1), cB + hstep + kstep, voffB);
    PG8_WAIT_V(6); PG8_BAR;
    PG8_STAMP();
    for (;;) {
        const bool has_next = S.next(ui + 1, nxt);
        const char* nA = has_next ? (const char*)g.A + (size_t)nxt.pm * tstep : cA; const char* nB = has_next ? (const char*)g.Bt + (size_t)nxt.pn * tstep : cB;
        for (int t = 0; t < nt; t += 2) {
            const bool last = (t == nt - 2);
            const char* a1 = cA + (size_t)(t + 1) * kstep;
            const char* a2 = last ? nA : cA + (size_t)(t + 2) * kstep; const char* b2 = last ? nB : cB + (size_t)(t + 2) * kstep;
            const char* a3 = a2 + kstep; const char* b3 = b2 + kstep;
            if (last && has_next) S.a_ready(nxt);
            PG8_LDB(B0, 0, 0); PG8_SCHED; PG8_LDA(At, 0, 0); PG8_STAGE(PG8_SA(1, 1), a1 + hstep, voffA);
            PG8_WAIT_L(8); PG8_BAR; PG8_WAIT_L(0); PG8_MMA(0, 0, At, B0); PG8_BAR; PG8_SCHED;
            PG8_LDB(B1, 0, 1); PG8_STAGE(PG8_SB(0, 0), b2, voffB);
            PG8_BAR; PG8_WAIT_L(0); PG8_MMA(0, 1, At, B1); PG8_BAR;
            PG8_LDA(At, 0, 1); PG8_STAGE(PG8_SA(0, 0), a2, voffA);
            PG8_BAR; PG8_WAIT_L(0); PG8_MMA(1, 0, At, B0); PG8_BAR; PG8_SCHED;
            PG8_STAGE(PG8_SB(0, 1), b2 + hstep, voffB);
            PG8_WAIT_V(6); PG8_BAR; PG8_MMA(1, 1, At, B1); PG8_BAR;
            PG8_LDB(B0, 1, 0); PG8_SCHED; PG8_LDA(At, 1, 0); PG8_STAGE(PG8_SA(0, 1), a2 + hstep, voffA);
            PG8_WAIT_L(8); PG8_BAR; PG8_WAIT_L(0); PG8_MMA(0, 0, At, B0); PG8_BAR; PG8_SCHED;
            PG8_LDB(B1, 1, 1); PG8_STAGE(PG8_SB(1, 0), b3, voffB);
            PG8_BAR; PG8_WAIT_L(0); PG8_MMA(0, 1, At, B1); PG8_BAR;
            PG8_LDA(At, 1, 1); PG8_STAGE(PG8_SA(1, 0), a3, voffA);
            PG8_BAR; PG8_WAIT_L(0); PG8_MMA(1, 0, At, B0); PG8_BAR; PG8_SCHED;
            PG8_STAGE(PG8_SB(1, 1), b3 + hstep, voffB);
            PG8_WAIT_V(6); PG8_BAR; PG8_MMA(1, 1, At, B1); PG8_BAR;
        }
        PG8_STAMP();
        if constexpr (!Epi::AFTER_DRAIN) { E(acc, cur, wr, wc, fr, fq); S.done(cur); }
        PG8_STAMP();
        if (!has_next) break;
#pragma unroll
        for (int a = 0; a < 2; ++a)
#pragma unroll
            for (int b = 0; b < 2; ++b)
#pragma unroll
                for (int m = 0; m < 4; ++m)
#pragma unroll
                    for (int n = 0; n < 2; ++n) acc[a][b][m][n] = (f32x4){0.f, 0.f, 0.f, 0.f};
        cur = nxt; cA = nA; cB = nB; ++ui;
    }
    PG8_WAIT_V(0);
    if (wr == 0) PG8_BAR;
    PG8_BAR;
    if constexpr (Epi::AFTER_DRAIN) { E.fused(acc, cur, wr, wc, fr, fq, lds, wid, lane); S.done(cur); }
    PG8_STAMP();
    if (STAMP && wid == 0) { stamps[lane] = lane < nts ? (((unsigned long long)(unsigned)ts_hi << 32) | (unsigned)ts_lo) : 0ull;
        if (lane == 62) stamps[62] = rt_entry; if (lane == 63) stamps[63] = (unsigned long long)wall_clock64(); }
#undef PG8_STAMP
#undef PG8_SA
#undef PG8_SB
#undef PG8_STAGE
#undef PG8_LDA
#undef PG8_LDB
#undef PG8_MMA
#undef PG8_WAIT_V
#undef PG8_WAIT_L
#undef PG8_BAR
#undef PG8_SCHED
}
template <class Epi, class Sched, class Gat, bool STAMP = false>
__device__ __forceinline__ void gemm_phase_gather(PG8_LAS unsigned char* lds, const Gemm g, const Sched& S, const Epi& E, const Gat& G, unsigned long long* stamps) {
    int tid_ = threadIdx.x; asm volatile("" : "+v"(tid_));
    const int tid = tid_, wid = __builtin_amdgcn_readfirstlane(tid >> 6), lane = tid & 63, wr = wid >> 2, wc = wid & 3, fr = lane & 15, fq = lane >> 4;
    const int K = g.K, nt = K / BK;
    int ts_lo = 0, ts_hi = 0, nts = 0; const unsigned long long rt_entry = STAMP ? (unsigned long long)wall_clock64() : 0ull;
#define PG8_STAMP() do { if (STAMP && wid == 0 && nts < 64) { const unsigned long long _c = (unsigned long long)clock64(); \
        ts_lo = (lane == nts) ? (int)(unsigned)_c : ts_lo; ts_hi = (lane == nts) ? (int)(unsigned)(_c >> 32) : ts_hi; ++nts; } } while (0)
    PG8_STAMP();
    unsigned voffA[2], voffB[2]; int RA[2]; unsigned CA2[2];
#pragma unroll
    for (int i = 0; i < 2; ++i) { int R, C; stage_rc(tid * 16 + i * 8192, R, C); const int Rb = Epi::PERM ? ((R & ~31) + perm32(R & 31)) : R;
        voffA[i] = (unsigned)(R * K + C) * 2u; voffB[i] = (unsigned)(Rb * K + C) * 2u; RA[i] = R; CA2[i] = (unsigned)C * 2u; }
    const size_t kstep = (size_t)(BK * 2);
    const size_t hstep = (size_t)HALF * K * 2;
    const size_t tstep = 2 * hstep;
    const unsigned ldsw = (unsigned)wid * 1024u;
    const int aoff = lds_byte(wr * 64 + fr, fq * 8), boff = lds_byte(wc * 32 + fr, fq * 8);
#define PG8_SA(b, h) (((b) * 2 + (h)) * HTB)
#define PG8_SB(b, h) ((4 + (b) * 2 + (h)) * HTB)
#define PG8_STAGE(bufoff, gbase, voff) do { _Pragma("unroll") for (int _i = 0; _i < 2; ++_i) \
        __builtin_amdgcn_global_load_lds((const unsigned*)((const char*)(gbase) + (voff)[_i]), (PG8_LAS unsigned*)(lds + (bufoff) + ldsw + _i * 8192), 16, 0, 0); } while (0)
#define PG8_LDA(dst, b, h) do { _Pragma("unroll") for (int m = 0; m < 4; ++m) _Pragma("unroll") for (int k = 0; k < 2; ++k) dst[m][k] = *(const PG8_LAS bf16x8*)(lds + PG8_SA(b, h) + aoff + m * 2048 + k * 1024); } while (0)
#define PG8_LDB(dst, b, h) do { _Pragma("unroll") for (int n = 0; n < 2; ++n) _Pragma("unroll") for (int k = 0; k < 2; ++k) dst[n][k] = *(const PG8_LAS bf16x8*)(lds + PG8_SB(b, h) + boff + n * 2048 + k * 1024); } while (0)
#define PG8_MMA(ai, bj, At, Bt) do { __builtin_amdgcn_s_setprio(1); _Pragma("unroll") for (int m = 0; m < 4; ++m) _Pragma("unroll") for (int n = 0; n < 2; ++n) _Pragma("unroll") for (int k = 0; k < 2; ++k) \
        acc[ai][bj][m][n] = __builtin_amdgcn_mfma_f32_16x16x32_bf16(Bt[n][k], At[m][k], acc[ai][bj][m][n], 0, 0, 0); __builtin_amdgcn_s_setprio(0); } while (0)
#define PG8_WAIT_V(n) asm volatile("s_waitcnt vmcnt(" #n ")" ::: "memory")
#define PG8_WAIT_L(n) asm volatile("s_waitcnt lgkmcnt(" #n ")" ::: "memory")
#define PG8_BAR __builtin_amdgcn_s_barrier()
#define PG8_SCHED __builtin_amdgcn_sched_barrier(0)
    Unit cur, nxt; int ui = 0;
    if (!S.next(0, cur)) return;
    f32x4 acc[2][2][4][2];
#pragma unroll
    for (int a = 0; a < 2; ++a)
#pragma unroll
        for (int b = 0; b < 2; ++b)
#pragma unroll
            for (int m = 0; m < 4; ++m)
#pragma unroll
                for (int n = 0; n < 2; ++n) acc[a][b][m][n] = (f32x4){0.f, 0.f, 0.f, 0.f};
    bf16x8 At[4][2], B0[2][2], B1[2][2];
    const char* Ab = (const char*)g.A; const char* cB = (const char*)g.Bt + (size_t)cur.pn * tstep;
    unsigned gc0[2], gc1[2], gn0[2], gn1[2];
#pragma unroll
    for (int i = 0; i < 2; ++i) { gc0[i] = G.rowoff(cur, RA[i]) + CA2[i]; gc1[i] = G.rowoff(cur, RA[i] + 128) + CA2[i]; }
    (void)voffA;
    S.a_ready(cur);
    PG8_STAGE(PG8_SB(0, 0), cB, voffB); PG8_STAGE(PG8_SA(0, 0), Ab, gc0); PG8_STAGE(PG8_SB(0, 1), cB + hstep, voffB); PG8_STAGE(PG8_SA(0, 1), Ab, gc1);
    if (wr == 1) PG8_BAR;
    PG8_WAIT_V(4); PG8_BAR;
    PG8_STAGE(PG8_SB(1, 0), cB + kstep, voffB); PG8_STAGE(PG8_SA(1, 0), Ab + kstep, gc0); PG8_STAGE(PG8_SB(1, 1), cB + hstep + kstep, voffB);
    PG8_WAIT_V(6); PG8_BAR;
    PG8_STAMP();
    for (;;) {
        const bool has_next = S.next(ui + 1, nxt);
        const char* nB = has_next ? (const char*)g.Bt + (size_t)nxt.pn * tstep : cB;
#pragma unroll
        for (int i = 0; i < 2; ++i) { gn0[i] = has_next ? G.rowoff(nxt, RA[i]) + CA2[i] : gc0[i]; gn1[i] = has_next ? G.rowoff(nxt, RA[i] + 128) + CA2[i] : gc1[i]; }
        for (int t = 0; t < nt; t += 2) {
            const bool last = (t == nt - 2);
            const char* a1 = Ab + (size_t)(t + 1) * kstep;
            const char* a2 = last ? Ab : Ab + (size_t)(t + 2) * kstep; const char* b2 = last ? nB : cB + (size_t)(t + 2) * kstep;
            unsigned g2a[2], g2b[2];
#pragma unroll
            for (int i = 0; i < 2; ++i) { g2a[i] = last ? gn0[i] : gc0[i]; g2b[i] = last ? gn1[i] : gc1[i]; }
            const char* a3 = a2 + kstep; const char* b3 = b2 + kstep;
            if (last && has_next) S.a_ready(nxt);
            PG8_LDB(B0, 0, 0); PG8_SCHED; PG8_LDA(At, 0, 0); PG8_STAGE(PG8_SA(1, 1), a1, gc1);
            PG8_WAIT_L(8); PG8_BAR; PG8_WAIT_L(0); PG8_MMA(0, 0, At, B0); PG8_BAR; PG8_SCHED;
            PG8_LDB(B1, 0, 1); PG8_STAGE(PG8_SB(0, 0), b2, voffB);
            PG8_BAR; PG8_WAIT_L(0); PG8_MMA(0, 1, At, B1); PG8_BAR;
            PG8_LDA(At, 0, 1); PG8_STAGE(PG8_SA(0, 0), a2, g2a);
            PG8_BAR; PG8_WAIT_L(0); PG8_MMA(1, 0, At, B0); PG8_BAR; PG8_SCHED;
            PG8_STAGE(PG8_SB(0, 1), b2 + hstep, voffB);
            PG8_WAIT_V(6); PG8_BAR; PG8_MMA(1, 1, At, B1); PG8_BAR;
            PG8_LDB(B0, 1, 0); PG8_SCHED; PG8_LDA(At, 1, 0); PG8_STAGE(PG8_SA(0, 1), a2, g2b);
            PG8_WAIT_L(8); PG8_BAR; PG8_WAIT_L(0); PG8_MMA(0, 0, At, B0); PG8_BAR; PG8_SCHED;
            PG8_LDB(B1, 1, 1); PG8_STAGE(PG8_SB(1, 0), b3, voffB);
            PG8_BAR; PG8_WAIT_L(0); PG8_MMA(0, 1, At, B1); PG8_BAR;
            PG8_LDA(At, 1, 1); PG8_STAGE(PG8_SA(1, 0), a3, g2a);
            PG8_BAR; PG8_WAIT_L(0); PG8_MMA(1, 0, At, B0); PG8_BAR; PG8_SCHED;
            PG8_STAGE(PG8_SB(1, 1), b3 + hstep, voffB);
            PG8_WAIT_V(6); PG8_BAR; PG8_MMA(1, 1, At, B1); PG8_BAR;
        }
        PG8_STAMP();
        if constexpr (!Epi::AFTER_DRAIN) { E(acc, cur, wr, wc, fr, fq); S.done(cur); }
        PG8_STAMP();
        if (!has_next) break;
#pragma unroll
        for (int a = 0; a < 2; ++a)
#pragma unroll
            for (int b = 0; b < 2; ++b)
#pragma unroll
                for (int m = 0; m < 4; ++m)
#pragma unroll
                    for (int n = 0; n < 2; ++n) acc[a][b][m][n] = (f32x4){0.f, 0.f, 0.f, 0.f};
        cur = nxt; cB = nB; ++ui;
#pragma unroll
        for (int i = 0; i < 2; ++i) { gc0[i] = gn0[i]; gc1[i] = gn1[i]; }
    }
    PG8_WAIT_V(0);
    if (wr == 0) PG8_BAR;
    PG8_BAR;
    if constexpr (Epi::AFTER_DRAIN) { E.fused(acc, cur, wr, wc, fr, fq, lds, wid, lane); S.done(cur); }
    PG8_STAMP();
    if (STAMP && wid == 0) { stamps[lane] = lane < nts ? (((unsigned long long)(unsigned)ts_hi << 32) | (unsigned)ts_lo) : 0ull;
        if (lane == 62) stamps[62] = rt_entry; if (lane == 63) stamps[63] = (unsigned long long)wall_clock64(); }
#undef PG8_STAMP
#undef PG8_SA
#undef PG8_SB
#undef PG8_STAGE
#undef PG8_LDA
#undef PG8_LDB
#undef PG8_MMA
#undef PG8_WAIT_V
#undef PG8_WAIT_L
#undef PG8_BAR
#undef PG8_SCHED
}
}

constexpr size_t WS_WINT = 284 * MB;
constexpr size_t WS_WOUTT = 1 * MB;
constexpr int NPAD_IN = 4352;
DI void transpose_tile(const float* W, int ldw, int k0, int n0, int nvalid, bfr* WT, int ldt, char* smem) {
  short* T = (short*)smem;
  const int tid = VT;
  __syncthreads();
  {
    const int r = tid >> 2, c4 = tid & 3;
#pragma unroll
    for (int q = 0; q < 4; ++q) {
      const int n = n0 + 16 * c4 + 4 * q;
      f32x4 v = {0.f, 0.f, 0.f, 0.f};
      if (n < nvalid) v = *(const f32x4*)(W + (size_t)(k0 + r) * ldw + n);
#pragma unroll
      for (int e = 0; e < 4; ++e) T[r * 66 + 16 * c4 + 4 * q + e] = (short)f2bf(v[e]);
    }
  }
  __syncthreads();
  {
    const int n = tid >> 2, kq = tid & 3;
    unsigned wv[8];
#pragma unroll
    for (int e = 0; e < 8; ++e) wv[e] = ((unsigned)(unsigned short)T[(16 * kq + 2 * e) * 66 + n]) | (((unsigned)(unsigned short)T[(16 * kq + 2 * e + 1) * 66 + n]) << 16);
    bfr* dst = WT + (size_t)(n0 + n) * ldt + k0 + 16 * kq;
    *(uint4*)dst = uint4{wv[0], wv[1], wv[2], wv[3]};
    *(uint4*)(dst + 8) = uint4{wv[4], wv[5], wv[6], wv[7]};
  }
}
template <int LDC, int NVALID> struct EpiBf16T {
  static constexpr bool PERM = true, AFTER_DRAIN = false;
  bfr* O;
  DI void operator()(const pg8::f32x4 (&acc)[2][2][4][2], const pg8::Unit& u, int wr, int wc, int fr, int fq) const {
    const int row0 = u.pm * 256 + wr * 64 + fr, col0 = u.pn * 256 + wc * 32 + 8 * fq;
#pragma unroll
    for (int ai = 0; ai < 2; ++ai)
#pragma unroll
      for (int m = 0; m < 4; ++m) {
        bfr* rowp = O + (size_t)(row0 + ai * 128 + m * 16) * LDC + col0;
#pragma unroll
        for (int bj = 0; bj < 2; ++bj) {
          if (col0 + bj * 128 < NVALID) {
            const pg8::f32x4 v0 = acc[ai][bj][m][0], v1 = acc[ai][bj][m][1];
            *(uint4*)(rowp + bj * 128) = uint4{pack2(v0[0], v0[1]), pack2(v0[2], v0[3]), pack2(v1[0], v1[1]), pack2(v1[2], v1[3])};
          }
        }
      }
  }
};
DI void phase_pgemm8(CParams& P, char* smem_all) {
  pg8::Gemm g{(const pg8::bf16_t*)(P.ws + WS_H), (const pg8::bf16_t*)(P.ws + WS_WINT), T_ALL, NPAD_IN, DM};
  pg8::StaticOrder S; S.init(T_ALL, NPAD_IN, (int)gridDim.x, (int)blockIdx.x);
  typedef EpiBf16T<DIN, DIN> EpiP;
  EpiP E{(bfr*)(P.ws + WS_P)};
  pg8::gemm_phase<EpiP, pg8::StaticOrder>((PG8_LAS unsigned char*)smem_all, g, S, E, nullptr);
}
DI void phase_outproj8(CParams& P, char* smem_all) {
  pg8::Gemm g{(const pg8::bf16_t*)(P.ws + WS_MIX), (const pg8::bf16_t*)(P.ws + WS_WOUTT), T_LAT, DM, DM};
  pg8::StaticOrder S; S.init(T_LAT, DM, (int)gridDim.x, (int)blockIdx.x);
  typedef EpiBf16T<DM, DM> EpiY;
  EpiY E{(bfr*)(P.ws + WS_Y)};
  pg8::gemm_phase<EpiY, pg8::StaticOrder>((PG8_LAS unsigned char*)smem_all, g, S, E, nullptr);
}


constexpr size_t WS_BTGU = 350 * MB;
constexpr size_t WS_BTD = 284 * MB;
constexpr size_t WS_XB = 186 * MB;
constexpr size_t WS_HID8 = 138 * MB;
constexpr size_t WS_MOUT8 = 42 * MB;
constexpr int TAB_LDS_OFF = 131072 + 1024;

DI void transpose_quad(const float* W, int ldw, int k0, int n0, bfr* WT, int ldt, int dr0, int dr1, int dr2, int dr3, char* smem, int nvalid = 1 << 30) {
  short* T = (short*)smem;
  const int tid = VT;
  const int r = tid >> 2, c4 = tid & 3;
  f32x4 v[4][4];
#pragma unroll
  for (int j = 0; j < 4; ++j)
#pragma unroll
    for (int q = 0; q < 4; ++q) { const int n_ = n0 + j * 64 + 16 * c4 + 4 * q; v[j][q] = n_ < nvalid ? *(const f32x4*)(W + (size_t)(k0 + r) * ldw + n_) : f32x4{0.f, 0.f, 0.f, 0.f}; }
  __syncthreads();
#pragma unroll
  for (int j = 0; j < 4; ++j)
#pragma unroll
    for (int q = 0; q < 4; ++q)
#pragma unroll
      for (int e = 0; e < 4; ++e) T[j * 64 * 66 + r * 66 + 16 * c4 + 4 * q + e] = (short)f2bf(v[j][q][e]);
  __syncthreads();
  const int n = tid >> 2, kq = tid & 3;
#pragma unroll
  for (int j = 0; j < 4; ++j) {
    unsigned wv[8];
#pragma unroll
    for (int e = 0; e < 8; ++e) wv[e] = ((unsigned)(unsigned short)T[j * 64 * 66 + (16 * kq + 2 * e) * 66 + n]) | (((unsigned)(unsigned short)T[j * 64 * 66 + (16 * kq + 2 * e + 1) * 66 + n]) << 16);
    const int dr = j == 0 ? dr0 : j == 1 ? dr1 : j == 2 ? dr2 : dr3;
    bfr* dst = WT + (size_t)(dr + n) * ldt + k0 + 16 * kq;
    *(uint4*)dst = uint4{wv[0], wv[1], wv[2], wv[3]};
    *(uint4*)(dst + 8) = uint4{wv[4], wv[5], wv[6], wv[7]};
  }
}
DI void phase_moe_convert_gu(CParams& P, int bid, int nb, char* smem) {
  for (int it = bid; it < 64 * 64; it += nb) {
    const int e = it >> 6, s = it & 63;
    const int isup = s >> 5, kt = (s & 31) >> 1, nq = s & 1;
    const float* W = (isup ? P.in[30] : P.in[29]) + (size_t)e * DM * DEXP;
    bfr* WT = (bfr*)(P.ws + WS_BTGU) + (size_t)e * 1024 * 1024;
    const int b = nq * 4;
    transpose_quad(W, DEXP, kt * 64, nq * 256, WT, 1024,
                   ((b + 0) >> 1) * 256 + isup * 128 + ((b + 0) & 1) * 64, ((b + 1) >> 1) * 256 + isup * 128 + ((b + 1) & 1) * 64,
                   ((b + 2) >> 1) * 256 + isup * 128 + ((b + 2) & 1) * 64, ((b + 3) >> 1) * 256 + isup * 128 + ((b + 3) & 1) * 64, smem);
  }
}
DI void phase_moe_convert_d(CParams& P, int bid, int nb, char* smem) {
  for (int it = bid; it < 64 * 32; it += nb) {
    const int e = it >> 5, s2 = it & 31, kt = s2 >> 2, nq = s2 & 3;
    const float* W = P.in[31] + (size_t)e * DEXP * DM;
    bfr* WT = (bfr*)(P.ws + WS_BTD) + (size_t)e * 1024 * 512;
    transpose_quad(W, DM, kt * 64, nq * 256, WT, 512, nq * 256, nq * 256 + 64, nq * 256 + 128, nq * 256 + 192, smem);
  }
}
DI void moe_block_table256(CParams& P, int* tab  ) {
  const int* cnt = (const int*)(P.ws + WS_CNT);
  __syncthreads();
  const int t = tx_();
  if (t < 64) {
    int incl = (cnt[t] + 255) >> 8;
#pragma unroll
    for (int o = 1; o < 64; o <<= 1) { int u = __shfl_up(incl, o); if (t >= o) incl += u; }
    tab[t + 1] = incl;
    if (t == 0) tab[0] = 0;
  }
  __syncthreads();
}
DI void phase_moe_gather(CParams& P, char* smem_all) {
  const bfr* h2 = (const bfr*)(P.ws + WS_H2);
  const int* cnt = (const int*)(P.ws + WS_CNT); const int* list = (const int*)(P.ws + WS_LIST);
  bfr* xb = (bfr*)(P.ws + WS_XB);
  int* tab = (int*)(smem_all + TAB_LDS_OFF);
  moe_block_table256(P, tab);
  const int nrows = tab[64] * 256;
  const int wv = threadIdx.x >> 6, lane = threadIdx.x & 63;
  for (int row0 = (blockIdx.x * 8 + wv) * 4; row0 < nrows; row0 += gridDim.x * 32) {
    const int rb = row0 >> 8;
    int e = 0; while (tab[e + 1] <= rb) ++e;
    const int idx0 = (rb - tab[e]) * 256 + (row0 & 255), ce = cnt[e];
    const int* lp = list + e * T_LAT + idx0;
    const int t0 = idx0 + 0 < ce ? (lp[0] >> 1) : -1, t1 = idx0 + 1 < ce ? (lp[1] >> 1) : -1, t2 = idx0 + 2 < ce ? (lp[2] >> 1) : -1, t3 = idx0 + 3 < ce ? (lp[3] >> 1) : -1;
    const bfr* s0 = h2 + (size_t)(t0 < 0 ? 0 : t0) * DM + lane * 8; const bfr* s1 = h2 + (size_t)(t1 < 0 ? 0 : t1) * DM + lane * 8;
    const bfr* s2 = h2 + (size_t)(t2 < 0 ? 0 : t2) * DM + lane * 8; const bfr* s3 = h2 + (size_t)(t3 < 0 ? 0 : t3) * DM + lane * 8;
    const uint4 a0 = *(const uint4*)s0, b0 = *(const uint4*)(s0 + 512), a1 = *(const uint4*)s1, b1 = *(const uint4*)(s1 + 512);
    const uint4 a2 = *(const uint4*)s2, b2 = *(const uint4*)(s2 + 512), a3 = *(const uint4*)s3, b3 = *(const uint4*)(s3 + 512);
    bfr* d = xb + (size_t)row0 * DM + lane * 8;
    if (t0 >= 0) { *(uint4*)d = a0; *(uint4*)(d + 512) = b0; }
    if (t1 >= 0) { *(uint4*)(d + DM) = a1; *(uint4*)(d + DM + 512) = b1; }
    if (t2 >= 0) { *(uint4*)(d + 2 * DM) = a2; *(uint4*)(d + 2 * DM + 512) = b2; }
    if (t3 >= 0) { *(uint4*)(d + 3 * DM) = a3; *(uint4*)(d + 3 * DM + 512) = b3; }
  }
}
struct MoeOrder {
  const int* tab; int nunits, G, c;
  DI bool next(int i, pg8::Unit& u) const {
    const int L = i * G + c; if (L >= nunits) return false;
    const int rb = L >> 2; int e = 0; while (tab[e + 1] <= rb) ++e;
    u.pm = rb; u.pn = e * 4 + (L & 3); return true;
  }
  DI void a_ready(const pg8::Unit&) const {}
  DI void done(const pg8::Unit&) const {}
};
struct EpiHid {
  static constexpr bool PERM = true, AFTER_DRAIN = false;
  bfr* H;
  DI void operator()(const pg8::f32x4 (&acc)[2][2][4][2], const pg8::Unit& u, int wr, int wc, int fr, int fq) const {
    const int row0 = u.pm * 256 + wr * 64 + fr, col0 = (u.pn & 3) * 128 + wc * 32 + 8 * fq;
#pragma unroll
    for (int ai = 0; ai < 2; ++ai)
#pragma unroll
      for (int m = 0; m < 4; ++m) {
        float hv[8];
#pragma unroll
        for (int n = 0; n < 2; ++n)
#pragma unroll
          for (int j = 0; j < 4; ++j) hv[4 * n + j] = siluf_(acc[ai][0][m][n][j]) * acc[ai][1][m][n][j];
        *(uint4*)(H + (size_t)(row0 + ai * 128 + m * 16) * DEXP + col0) = uint4{pack2(hv[0], hv[1]), pack2(hv[2], hv[3]), pack2(hv[4], hv[5]), pack2(hv[6], hv[7])};
      }
  }
};
struct EpiMout {
  static constexpr bool PERM = true, AFTER_DRAIN = false;
  bfr* O; const int* tab; const int* cnt; const int* list;
  DI void operator()(const pg8::f32x4 (&acc)[2][2][4][2], const pg8::Unit& u, int wr, int wc, int fr, int fq) const {
    const int e = u.pn >> 2, pnl = u.pn & 3;
    const int lrow0 = (u.pm - tab[e]) * 256 + wr * 64 + fr, ce = cnt[e];
    const int col0 = pnl * 256 + wc * 32 + 8 * fq;
#pragma unroll
    for (int ai = 0; ai < 2; ++ai)
#pragma unroll
      for (int m = 0; m < 4; ++m) {
        const int idx = lrow0 + ai * 128 + m * 16;
        if (idx < ce) {
          const int asg = list[e * T_LAT + idx];
          bfr* rowp = O + (size_t)asg * DM + col0;
#pragma unroll
          for (int bj = 0; bj < 2; ++bj) {
            const pg8::f32x4 v0 = acc[ai][bj][m][0], v1 = acc[ai][bj][m][1];
            *(uint4*)(rowp + bj * 128) = uint4{pack2(v0[0], v0[1]), pack2(v0[2], v0[3]), pack2(v1[0], v1[1]), pack2(v1[2], v1[3])};
          }
        }
      }
  }
};
struct MoeGather {
  const int* tab; const int* cnt; const int* list;
  DI unsigned rowoff(const pg8::Unit& u, int r) const {
    const int e = u.pn >> 2, idx = (u.pm - tab[e]) * 256 + r;
    const int tok = idx < cnt[e] ? (list[e * T_LAT + idx] >> 1) : 0;
    return (unsigned)tok * (unsigned)(DM * 2);
  }
};
DI void phase_moe1_8(CParams& P, char* smem_all) {
  int* tab = (int*)(smem_all + TAB_LDS_OFF);
  moe_block_table256(P, tab);
  const int nrb = tab[64];
  pg8::Gemm g{(const pg8::bf16_t*)(P.ws + WS_H2), (const pg8::bf16_t*)(P.ws + WS_BTGU), nrb * 256, 64 * 1024, DM};
  MoeOrder S{tab, nrb * 4, (int)gridDim.x, (int)blockIdx.x};
  EpiHid E{(bfr*)(P.ws + WS_HID8)};
  MoeGather G{tab, (const int*)(P.ws + WS_CNT), (const int*)(P.ws + WS_LIST)};
  pg8::gemm_phase_gather<EpiHid, MoeOrder, MoeGather>((PG8_LAS unsigned char*)smem_all, g, S, E, G, nullptr);
}
DI void phase_moe2_8(CParams& P, char* smem_all) {
  int* tab = (int*)(smem_all + TAB_LDS_OFF);
  moe_block_table256(P, tab);
  const int nrb = tab[64];
  pg8::Gemm g{(const pg8::bf16_t*)(P.ws + WS_HID8), (const pg8::bf16_t*)(P.ws + WS_BTD), nrb * 256, 64 * 1024, DEXP};
  MoeOrder S{tab, nrb * 4, (int)gridDim.x, (int)blockIdx.x};
  EpiMout E{(bfr*)(P.ws + WS_MOUT8), tab, (const int*)(P.ws + WS_CNT), (const int*)(P.ws + WS_LIST)};
  pg8::gemm_phase<EpiMout, MoeOrder>((PG8_LAS unsigned char*)smem_all, g, S, E, nullptr);
}

#define XB_TMO      128
#define XB_XCNT(j)  (256  + 64 * (j))
#define XB_XSUB(j)  (1280 + 64 * (j))
#define XB_XGEN(j)  (2304 + 64 * (j))
#define XB_TOP      3328
#define XB_TOPGEN   3392
#define XCD_BAR_WORDS 3456
#define XB_SPIN_CAP (1u << 22)
#define LAS __attribute__((address_space(3)))
DI unsigned xb_ld(unsigned* p)              { return __hip_atomic_load(p, __ATOMIC_RELAXED, __HIP_MEMORY_SCOPE_AGENT); }
DI unsigned xb_add(unsigned* p, unsigned v) { return __hip_atomic_fetch_add(p, v, __ATOMIC_RELAXED, __HIP_MEMORY_SCOPE_AGENT); }
DI unsigned xb_xcc_id() { return (unsigned)__builtin_amdgcn_s_getreg((3 << 11) | 20) & 0xFu; }
#define XB_SPIN(cond, bar) do { unsigned _sp = 0; while (cond) { __builtin_amdgcn_s_sleep(1); \
    if ((++_sp & 255u) == 0u) { if (xb_ld(&(bar)[XB_TMO])) break; if (_sp > XB_SPIN_CAP) { atomicAdd(&(bar)[XB_TMO], 1u); break; } } } } while (0)
struct XcdBarrier { unsigned* bar; unsigned x; volatile LAS unsigned* st; };
DI XcdBarrier xcd_barrier_post(unsigned* bar, volatile LAS unsigned* st) {
  XcdBarrier b; b.bar = bar; b.x = xb_xcc_id(); b.st = st;
  if (threadIdx.x == 0) (void)xb_add(&bar[XB_XCNT(b.x)], 1u);
  return b;
}
DI void xcd_barrier_complete(unsigned* bar, unsigned x, unsigned& nloc, unsigned& nx) {
  const unsigned G = gridDim.x * gridDim.y * gridDim.z;
  unsigned sum, cnt, mine, sp = 0u;
  for (;;) {
    sum = 0u; cnt = 0u; mine = 0u;
#pragma unroll
    for (unsigned j = 0; j < 16; ++j) { const unsigned c = xb_ld(&bar[XB_XCNT(j)]); sum += c; cnt += (c > 0u) ? 1u : 0u; mine = (j == x) ? c : mine; }
    if (sum == G) break;
    __builtin_amdgcn_s_sleep(1);
    if ((++sp & 255u) == 0u) { if (xb_ld(&bar[XB_TMO])) break; if (sp > XB_SPIN_CAP) { atomicAdd(&bar[XB_TMO], 1u); break; } }
  }
  nloc = mine > 0u ? mine : 1u; nx = cnt > 0u ? cnt : 1u;
}
DI void xcd_barrier(const XcdBarrier& b) {
  asm volatile("s_waitcnt vmcnt(0)" ::: "memory");
  __syncthreads();
  if (threadIdx.x == 0) {
    unsigned* bar = b.bar;
    __builtin_amdgcn_s_waitcnt(0);
    unsigned nloc = b.st[0], nx = b.st[1];
    if (nloc == 0u) { xcd_barrier_complete(bar, b.x, nloc, nx); b.st[0] = nloc; b.st[1] = nx; }
    const unsigned old = xb_add(&bar[XB_XSUB(b.x)], 1u);
    const unsigned gen = old / nloc;
    if (old + 1u == (gen + 1u) * nloc) {
      __builtin_amdgcn_fence(__ATOMIC_RELEASE, "agent");
      asm volatile("s_waitcnt vmcnt(0)" ::: "memory");
      const unsigned og = xb_add(&bar[XB_TOP], 1u);
      const unsigned tg = og / nx;
      if (og + 1u == (tg + 1u) * nx) xb_add(&bar[XB_TOPGEN], 1u);
      else XB_SPIN(xb_ld(&bar[XB_TOPGEN]) == tg, bar);
      __builtin_amdgcn_fence(__ATOMIC_ACQUIRE, "agent");
      xb_add(&bar[XB_XGEN(b.x)], 1u);
      asm volatile("s_waitcnt vmcnt(0)" ::: "memory");
    } else {
      XB_SPIN(xb_ld(&bar[XB_XGEN(b.x)]) == gen, bar);
      __builtin_amdgcn_fence(__ATOMIC_ACQUIRE, "agent");
      asm volatile("s_waitcnt vmcnt(0)" ::: "memory");
    }
  }
  __syncthreads();
}

namespace cg = cooperative_groups;
constexpr int HALF_LDS = 78080;
constexpr int SMEM_BYTES = 2 * HALF_LDS + 16;
__global__ void __launch_bounds__(NTHR_BLOCK) k_fused(Params Pval) {
  __shared__ __attribute__((aligned(16))) char smem_all[SMEM_BYTES];
  cg::grid_group grid = cg::this_grid();
  CParams* kp0 = (CParams*)__builtin_amdgcn_kernarg_segment_ptr();
#define PH(call) do { CParams* kp_ = kp0; asm volatile("" : "+s"(kp_)); CParams& P = *kp_; \
    int half = __builtin_amdgcn_readfirstlane((int)(threadIdx.x >> 8)); asm volatile("" : "+s"(half)); \
    char* smem = smem_all + half * HALF_LDS; const int bid = blockIdx.x * 2 + half, nb = gridDim.x * 2; (void)smem; (void)bid; (void)nb; call; } while (0)
  volatile LAS unsigned* bst = (volatile LAS unsigned*)(smem_all + SMEM_BYTES - 16);
  if (threadIdx.x < 4) bst[threadIdx.x] = 0u;
  __syncthreads();
  XcdBarrier xb = xcd_barrier_post(Pval.bar, bst);
#define GSYNC() do { if (Pval.use_cg) grid.sync(); else xcd_barrier(xb); } while (0)
  PH(phase_mod(P, bid, nb, smem));
  GSYNC();
  PH(phase_ln1(P, bid, nb));
  GSYNC();
  PH(phase_pgemm8(P, smem_all));
  GSYNC();
  PH(phase_rwprep(P, bid, nb, smem));
  GSYNC();
  PH(for (int it = bid; it < 16 * RW_NSC; it += nb) rw_levelA_item(P, it / RW_NSC, it % RW_NSC, smem));
  PH(for (int it = bid; it < 8 * HG_NSC; it += nb) hg_levelA_item(P, it / HG_NSC, it % HG_NSC, smem));
  GSYNC();
  PH(if (bid < 16) rw_levelB_chain(P, bid, smem); else { hg_levelB(P, bid - 16, nb - 16); phase_moe_convert_d(P, bid - 16, nb - 16, smem); });
  GSYNC();
  PH(phase_readout_fused(P, bid, nb));
  GSYNC();
  PH(phase_outproj8(P, smem_all));
  PH(phase_moe_convert_gu(P, bid, nb, smem));
  GSYNC();
  PH(phase_ln2route(P, smem_all));
  GSYNC();
  PH(phase_moe1_8(P, smem_all));
  GSYNC();
  PH(phase_moe2_8(P, smem_all));
  GSYNC();
  PH(phase_final(P, bid, nb));
}

extern "C" void kernel_launch(void* const* d_in, const int* in_sizes, int n_in, void* d_out, int out_size, void* d_ws, size_t ws_size, hipStream_t stream) {
  static int grid_blocks = 0;
  if (!grid_blocks) {
    int dev = 0, cus = 0, per_cu = 0;
    hipGetDevice(&dev);
    hipDeviceGetAttribute(&cus, hipDeviceAttributeMultiprocessorCount, dev);
    hipOccupancyMaxActiveBlocksPerMultiprocessor(&per_cu, k_fused, NTHR_BLOCK, 0);
    if (per_cu > 1) per_cu = 1;
    if (per_cu < 1) per_cu = 1;
    grid_blocks = cus * per_cu;
  }
  Params P{};
  P.bar = (unsigned*)((char*)d_ws + WS_BAR); P.use_cg = 0; P.pad = 0;
  hipMemsetAsync((char*)d_ws + WS_BAR, 0, XCD_BAR_WORDS * 4, stream);
  for (int i = 0; i < 32; ++i) P.in[i] = (const float*)d_in[i];
  P.out = (float*)d_out; P.ws = (char*)d_ws;
  void* args[] = {&P};
  hipError_t e = hipLaunchCooperativeKernel((void*)k_fused, dim3(grid_blocks), dim3(NTHR_BLOCK), args, 0, stream);
  if (e != hipSuccess) fprintf(stderr, "cooperative launch failed: %s (grid %d)\n", hipGetErrorString(e), grid_blocks);
}
```

```cpp
#include <hip/hip_runtime.h>
#include <hip/hip_cooperative_groups.h>
#include <cstdio>

typedef __attribute__((ext_vector_type(8))) short bf16x8;
typedef __attribute__((ext_vector_type(4))) short s16x4;
typedef __attribute__((ext_vector_type(4))) float f32x4;
typedef __attribute__((ext_vector_type(2))) float f32x2;
typedef __attribute__((ext_vector_type(2))) __bf16 bf16x2_t;
typedef unsigned short bfr;

#define DI __device__ __forceinline__

constexpr int T_LAT = 16384, T_CTX = 256, T_ALL = T_LAT + T_CTX;
constexpr int DM = 1024, DIN = 4288, HGC = 2560, RWC = 1728, DRW = 512, DHG = 512;
constexpr int NEXP = 64, DEXP = 512;
constexpr int NTHR = 256;
constexpr int NTHR_BLOCK = 512;
#define VT ((int)(threadIdx.x & 255))
__device__ __forceinline__ int tx_() { int t = (int)threadIdx.x; asm volatile("" : "+v"(t)); return t; }
constexpr float DN_ALPHA = 1.189207115002721f;
constexpr float RW_DECAY_SCALE = 0.6065306597126334f;

constexpr size_t MB = 1ull << 20;
constexpr size_t WS_MOD = 0;
constexpr size_t WS_MODC = 32768;
constexpr size_t WS_LB = 65536;
constexpr size_t WS_CNT = 65536 + 8192;
constexpr size_t WS_BAR = 81920;
constexpr size_t WS_ASGW = 131072;
constexpr size_t WS_LIST = 1 * MB;
constexpr size_t WS_H = 6 * MB;
constexpr size_t WS_P = 42 * MB;
constexpr size_t WS_Y = 42 * MB;
constexpr size_t WS_H2 = 106 * MB;
constexpr size_t WS_RW = 186 * MB;
constexpr size_t RW_ARR = (size_t)T_ALL * 512 * 2;
constexpr size_t WS_X1B = 6 * MB;
constexpr size_t WS_MIX = WS_RW + 3 * RW_ARR;
constexpr size_t WS_LW = 284 * MB;
constexpr size_t LW_ARR = (size_t)T_ALL * 512 * 4;

struct Params {
  const float* in[32];
  float* out;
  char* ws;
  unsigned* bar;
  int use_cg;
  int pad;
};
typedef const __attribute__((address_space(4))) Params CParams;

DI unsigned pack2(float a, float b) {
  f32x2 v = {a, b};
  bf16x2_t r = __builtin_convertvector(v, bf16x2_t);
  return __builtin_bit_cast(unsigned, r);
}
DI bfr f2bf(float a) { return (bfr)(pack2(a, 0.f) & 0xffffu); }
DI float bf2f(bfr v) { return __uint_as_float(((unsigned)v) << 16); }
DI float frcp_(float x) { return __builtin_amdgcn_rcpf(x); }
DI float sigmoidf_(float x) { return frcp_(1.f + __expf(-x)); }
DI float siluf_(float x) { return x * frcp_(1.f + __expf(-x)); }
DI f32x4 ld4bf(const bfr* p);
DI float wave_sum(float v) {
#pragma unroll
  for (int o = 32; o > 0; o >>= 1) v += __shfl_xor(v, o);
  return v;
}

DI void phase_lora_convert(CParams& P, int part, int nparts);
DI void phase_wrt_convert(CParams& P, int part, int nparts);
DI void transpose_tile(const float* W, int ldw, int k0, int n0, int nvalid, bfr* WT, int ldt, char* smem);
DI void transpose_quad(const float* W, int ldw, int k0, int n0, bfr* WT, int ldt, int dr0, int dr1, int dr2, int dr3, char* smem, int nvalid);
DI void phase_mod(CParams& P, int bid, int nb, char* smem) {
  const float* c = P.in[1]; const float* cc = P.in[3];
  const float* w_mod = P.in[4]; const float* b_mod = P.in[5];
  float* mod = (float*)(P.ws + WS_MOD); float* modc = (float*)(P.ws + WS_MODC);
  float* red = (float*)smem;
  const int tid = VT;
  for (int it = bid; it < 542; it += nb) {
    if (it < 192) {
      const int kq = tid >> 3, c4 = tid & 7;
      const int col = it * 32 + c4 * 4;
      f32x4 a1 = {0, 0, 0, 0}, a2 = {0, 0, 0, 0};
      for (int k = kq; k < DM; k += 32) {
        f32x4 w = *(const f32x4*)(w_mod + (long)k * 6144 + col);
        float s1 = siluf_(c[k]), s2 = siluf_(cc[k]);
        a1 += w * s1; a2 += w * s2;
      }
      __syncthreads();
#pragma unroll
      for (int e = 0; e < 4; ++e) { red[(kq * 32) + c4 * 4 + e] = a1[e]; red[1024 + kq * 32 + c4 * 4 + e] = a2[e]; }
      __syncthreads();
      if (tid < 64) {
        const int which = tid >> 5, cl = tid & 31;
        float s = 0.f;
        for (int q = 0; q < 32; ++q) s += red[which * 1024 + q * 32 + cl];
        const int cg = it * 32 + cl;
        s += b_mod[cg];
        if (which == 0) mod[cg] = s; else modc[cg] = s;
      }
    } else if (it == 192) {
      const float* L = P.in[8];
      float* lb = (float*)(P.ws + WS_LB);
      for (int i = tid; i < 1024; i += NTHR) {
        const int d = i >> 9, j = i & 511;
        float l0 = L[d * 1024 + j], l1 = L[d * 1024 + 512 + j];
        lb[i] = 1.f / (1.f + __expf(l1 - l0));
      }
    } else if (it == 193) {
      int* cnt = (int*)(P.ws + WS_CNT);
      if (tid < 64) cnt[tid] = 0;
    } else if (it < 198) {
      phase_lora_convert(P, it - 194, 4);
    } else if (it < 470) {
      const int t = it - 198, kt = t / 17, nq = t % 17;
      transpose_quad(P.in[6], DIN, kt * 64, nq * 256, (bfr*)(P.ws + (284ull << 20)), DM, nq * 256, nq * 256 + 64, nq * 256 + 128, nq * 256 + 192, smem, DIN);
    } else if (it < 534) {
      const int t = it - 470, kt = t >> 2, nq = t & 3;
      transpose_quad(P.in[7], DM, kt * 64, nq * 256, (bfr*)(P.ws + (1ull << 20)), DM, nq * 256, nq * 256 + 64, nq * 256 + 128, nq * 256 + 192, smem, DM);
    } else {
      phase_wrt_convert(P, it - 534, 8);
    }
  }
}

DI void phase_ln1(CParams& P, int bid, int nb) {
  const float* x = P.in[0]; const float* ctx = P.in[2];
  const float* mod = (const float*)(P.ws + WS_MOD); const float* modc = (const float*)(P.ws + WS_MODC);
  bfr* h = (bfr*)(P.ws + WS_H);
  const int wid = VT >> 6, lane = VT & 63;
  for (int row0 = (bid * 4 + wid) * 2; row0 < T_ALL; row0 += nb * 8) {
    const float* src = row0 < T_LAT ? x + (long)row0 * DM : ctx + (long)(row0 - T_LAT) * DM;
    const float* mm = row0 < T_LAT ? mod : modc;
    f32x4 v[2][4];
    float s[2] = {0.f, 0.f};
#pragma unroll
    for (int r = 0; r < 2; ++r)
#pragma unroll
      for (int i = 0; i < 4; ++i) { v[r][i] = *(const f32x4*)(src + r * DM + lane * 4 + 256 * i); s[r] += v[r][i][0] + v[r][i][1] + v[r][i][2] + v[r][i][3]; }
#pragma unroll
    for (int r = 0; r < 2; ++r) {
      const float mu = wave_sum(s[r]) * (1.f / DM);
      float q = 0.f;
#pragma unroll
      for (int i = 0; i < 4; ++i) { v[r][i] -= mu; q += v[r][i][0] * v[r][i][0] + v[r][i][1] * v[r][i][1] + v[r][i][2] * v[r][i][2] + v[r][i][3] * v[r][i][3]; }
      const float rs = rsqrtf(wave_sum(q) * (1.f / DM) + 1e-5f);
#pragma unroll
      for (int i = 0; i < 4; ++i) {
        const int cidx = lane * 4 + 256 * i;
        f32x4 sh = *(const f32x4*)(mm + cidx), sc = *(const f32x4*)(mm + 1024 + cidx);
        f32x4 o = v[r][i] * rs * (sc + 1.f) + sh;
        uint2 w = {pack2(o[0], o[1]), pack2(o[2], o[3])};
        *(uint2*)(h + (long)(row0 + r) * DM + cidx) = w;
      }
    }
  }
}

#define LDSP(T) __attribute__((address_space(3))) T*
DI int row_of_step(int dir, int s) {
  if (s < T_CTX) return T_LAT + (dir ? (T_CTX - 1 - s) : s);
  return dir ? (T_LAT - 1 - (s - T_CTX)) : (s - T_CTX);
}
DI bf16x8 ld_tr8(const short* base, int stride, int k0, int n0) {
  const int lane = VT & 63, g = lane >> 4, q = (lane & 15) >> 2, p = lane & 3;
  const short* a0 = base + (k0 + 8 * g + q) * stride + n0 + 4 * p;
  s16x4 lo = __builtin_amdgcn_ds_read_tr16_b64_v4i16((LDSP(s16x4))a0);
  s16x4 hi = __builtin_amdgcn_ds_read_tr16_b64_v4i16((LDSP(s16x4))(a0 + 4 * stride));
  return __builtin_shufflevector(lo, hi, 0, 1, 2, 3, 4, 5, 6, 7);
}
template <bool AT, bool BT>
DI f32x4 mm_tile(const short* A, int lda, int m0, const short* B, int ldb, int n0, int K, f32x4 acc) {
  const int lane = VT & 63, fr = lane & 15, fq = lane >> 4;
#ifdef SLOWMM
#pragma unroll
  for (int reg = 0; reg < 4; ++reg) {
    const int row = m0 + 4 * fq + reg, col = n0 + fr;
    float s = 0.f;
    for (int k = 0; k < K; ++k) {
      const float a = bf2f((bfr)(AT ? A[k * lda + row] : A[row * lda + k]));
      const float b = bf2f((bfr)(BT ? B[col * ldb + k] : B[k * ldb + col]));
      s += a * b;
    }
    acc[reg] += s;
  }
#else
  for (int k0 = 0; k0 < K; k0 += 32) {
    bf16x8 a, b;
    if (AT) a = ld_tr8(A, lda, k0, m0); else a = *(const bf16x8*)(A + (m0 + fr) * lda + k0 + fq * 8);
    if (BT) b = *(const bf16x8*)(B + (n0 + fr) * ldb + k0 + fq * 8); else b = ld_tr8(B, ldb, k0, n0);
    acc = __builtin_amdgcn_mfma_f32_16x16x32_bf16(a, b, acc, 0, 0, 0);
  }
#endif
  return acc;
}
DI void st_tile(short* C, int ldc, int m0, int n0, f32x4 acc) {
  const int lane = VT & 63, fr = lane & 15, fq = lane >> 4;
#pragma unroll
  for (int reg = 0; reg < 4; ++reg) C[(m0 + 4 * fq + reg) * ldc + n0 + fr] = (short)f2bf(acc[reg]);
}

constexpr int RW_NSC = 32;
DI int rw_sc_begin(int sc) { return sc * 16 + (sc < 8 ? sc : 8); }
DI int rw_sc_of_chunk(int ci) { return ci < 136 ? ci / 17 : 8 + (ci - 136) / 16; }
constexpr int XS = 72, SS = 40, GS = 72;
constexpr int RWL_XK = 0, RWL_XKB = 4608, RWL_XBB = 9216, RWL_XR = 13824, RWL_XV = 18432, RWL_S = 23040;
constexpr int RWL_GP = 38400, RWL_GQ = 47616, RWL_GAM = 56832, RWL_TOT = 57088, RWL_END = 58112;
constexpr size_t WS_PTOT = 6 * MB;
constexpr size_t WS_QTOT = 10 * MB;
constexpr size_t WS_SINRW = 18 * MB;
constexpr size_t WS_R2P = 350 * MB;
constexpr size_t WS_Y0P = 382 * MB;

constexpr int RTS = 40, RGS = 72;
constexpr int RWT_XK = 0, RWT_XKB = 5120, RWT_XBB = 10240, RWT_XR = 15360, RWT_XV = 20480, RWT_S = 25600;
constexpr int RWT_GP = 40960, RWT_GQ = 50176, RWT_GAM = 59392, RWT_TOT = 59648;
DI void st_tile_T(short* C, int ldc, int m0, int n0, f32x4 acc) {
  const int lane = (int)(threadIdx.x & 63), fr = lane & 15, fq = lane >> 4;
  *(uint2*)(C + (n0 + fr) * ldc + m0 + 4 * fq) = uint2{pack2(acc[0], acc[1]), pack2(acc[2], acc[3])};
}
DI void rw_levelA_item(CParams& P, int chain, int sc, char* smem) {
  const int dir = chain >> 3, hd = chain & 7;
  const bfr* Rg = (const bfr*)(P.ws + WS_RW); const bfr* Kg = (const bfr*)(P.ws + WS_RW + RW_ARR); const bfr* Vg = (const bfr*)(P.ws + WS_RW + 2 * RW_ARR);
  const bfr* KKg = (const bfr*)(P.ws + WS_RW + 3 * RW_ARR); const bfr* Ag = (const bfr*)(P.ws + WS_RW + 4 * RW_ARR);
  const float* LWg = (const float*)(P.ws + WS_LW + (dir ? LW_ARR : 0));
  bfr* R2P = (bfr*)(P.ws + WS_R2P) + (size_t)dir * T_LAT * 512;
  bfr* Y0P = (bfr*)(P.ws + WS_Y0P) + (size_t)dir * T_LAT * 512;
  short* XKt = (short*)(smem + RWT_XK); short* XKBt = (short*)(smem + RWT_XKB); short* XBBt = (short*)(smem + RWT_XBB);
  short* XRt = (short*)(smem + RWT_XR); short* XVt = (short*)(smem + RWT_XV);
  short* ZT = XRt; short* R2T = XRt; short* PcT = XKt;
  short* SLt = (short*)(smem + RWT_S); short* SAkkT = SLt + 32 * RTS; short* SAkrT = SAkkT + 32 * RTS; short* SMt = SAkrT + 32 * RTS;
  short* STt = SMt + 32 * RTS; short* SnAbrT = STt + 32 * RTS;
  short* W1T = SLt; short* W2T = SAkrT;
  short* GPT = (short*)(smem + RWT_GP); short* GQT = (short*)(smem + RWT_GQ);
  float* gam = (float*)(smem + RWT_GAM); float* tot = (float*)(smem + RWT_TOT);
  const int tid = VT, lane = tid & 63, w = tid >> 6, fr = lane & 15, fq = lane >> 4;
  const int tm = w >> 1, tn = w & 1;
  const int sgn = dir ? -1 : 1;
  const f32x4 z4 = {0.f, 0.f, 0.f, 0.f};
  __syncthreads();
  for (int i = tid; i < 64 * 64; i += NTHR) { const int r = i >> 6, c = i & 63; GPT[r * RGS + c] = (r == c) ? (short)0x3F80 : (short)0; GQT[r * RGS + c] = 0; }
  f32x4 pcum[4], qcum[4];
#pragma unroll
  for (int n = 0; n < 4; ++n) { pcum[n] = z4; qcum[n] = z4; }
  const int c_begin = rw_sc_begin(sc), c_end = rw_sc_begin(sc + 1);
  float pf_lw[8]; unsigned pf_rk[8], pf_vkk[8], pf_a[8];
#define RW_PREFETCH(cc) do { const unsigned o0_ = (unsigned)(row_of_step(dir, (cc) * 32 + (tid >> 6) * 8) * 512 + hd * 64 + (tid & 63)); \
      _Pragma("unroll") for (int e_ = 0; e_ < 8; ++e_) { const unsigned o_ = o0_ + (unsigned)(sgn * e_ * 512); \
      pf_lw[e_] = LWg[o_]; pf_rk[e_] = (unsigned)Rg[o_] | ((unsigned)Kg[o_] << 16); pf_vkk[e_] = (unsigned)Vg[o_] | ((unsigned)KKg[o_] << 16); pf_a[e_] = Ag[o_]; } } while (0)
  RW_PREFETCH(c_begin);
  for (int ci = c_begin; ci < c_end; ++ci) {
    __syncthreads();
    {
      const int j = tid & 63, qt = tid >> 6;
      float lam[8];
      float run = 0.f;
#pragma unroll
      for (int e = 0; e < 8; ++e) { run += pf_lw[e]; lam[e] = run; }
      tot[qt * 64 + j] = run;
      __syncthreads();
      float base = 0.f, total = 0.f;
#pragma unroll
      for (int q2 = 0; q2 < 4; ++q2) { const float tv = tot[q2 * 64 + j]; total += tv; if (q2 < qt) base += tv; }
      unsigned wk[4], wkb[4], wbb[4], wr_[4], wv[4];
#pragma unroll
      for (int e2 = 0; e2 < 4; ++e2) {
        float vk[2], vkb[2], vbb[2], vr[2];
#pragma unroll
        for (int u = 0; u < 2; ++u) {
          const int e = 2 * e2 + u;
          const float L = base + lam[e];
          const float eL = __expf(L), enL = frcp_(eL), eLp = eL * __expf(-pf_lw[e]);
          const float kkv = __uint_as_float(pf_vkk[e] & 0xffff0000u);
          vk[u] = kkv * eLp;
          vkb[u] = __uint_as_float(pf_rk[e] & 0xffff0000u) * enL;
          vbb[u] = kkv * __uint_as_float(pf_a[e] << 16) * enL;
          vr[u] = __uint_as_float(pf_rk[e] << 16) * eL;
        }
        wk[e2] = pack2(vk[0], vk[1]); wkb[e2] = pack2(vkb[0], vkb[1]); wbb[e2] = pack2(vbb[0], vbb[1]); wr_[e2] = pack2(vr[0], vr[1]);
        wv[e2] = (pf_vkk[2 * e2] & 0xffffu) | (pf_vkk[2 * e2 + 1] << 16);
      }
      const int co = j * RTS + 8 * qt;
      *(uint4*)(XKt + co) = uint4{wk[0], wk[1], wk[2], wk[3]};
      *(uint4*)(XKBt + co) = uint4{wkb[0], wkb[1], wkb[2], wkb[3]};
      *(uint4*)(XBBt + co) = uint4{wbb[0], wbb[1], wbb[2], wbb[3]};
      *(uint4*)(XRt + co) = uint4{wr_[0], wr_[1], wr_[2], wr_[3]};
      *(uint4*)(XVt + co) = uint4{wv[0], wv[1], wv[2], wv[3]};
      if (qt == 0) gam[j] = __expf(total);
      if (ci + 1 < c_end) RW_PREFETCH(ci + 1);
    }
    __syncthreads();
    f32x4 tacc; f32x4 rt[2];
    {
      f32x4 aL = mm_tile<true, false>(XKt, RTS, 16 * tm, XBBt, RTS, 16 * tn, 64, z4);
      f32x4 aKK = mm_tile<true, false>(XKt, RTS, 16 * tm, XKBt, RTS, 16 * tn, 64, z4);
      f32x4 aBR = mm_tile<true, false>(XRt, RTS, 16 * tm, XBBt, RTS, 16 * tn, 64, z4);
      f32x4 aKR = mm_tile<true, false>(XRt, RTS, 16 * tm, XKBt, RTS, 16 * tn, 64, z4);
#pragma unroll
      for (int reg = 0; reg < 4; ++reg) {
        const int row = 16 * tm + 4 * fq + reg, col = 16 * tn + fr;
        const bool st = col < row, inc = col <= row;
        aL[reg] = st ? aL[reg] : 0.f; aKK[reg] = st ? aKK[reg] : 0.f;
        aBR[reg] = inc ? -aBR[reg] : 0.f; aKR[reg] = inc ? aKR[reg] : 0.f;
        tacc[reg] = (row == col ? 1.f : 0.f) - aL[reg];
      }
      st_tile_T(SLt, RTS, 16 * tm, 16 * tn, aL); st_tile_T(STt, RTS, 16 * tm, 16 * tn, tacc);
      st_tile_T(SAkkT, RTS, 16 * tm, 16 * tn, aKK); st_tile_T(SnAbrT, RTS, 16 * tm, 16 * tn, aBR); st_tile_T(SAkrT, RTS, 16 * tm, 16 * tn, aKR);
#pragma unroll
      for (int i = 0; i < 2; ++i) rt[i] = ld4bf((const bfr*)(XRt + (16 * (2 * tn + i) + fr) * RTS + 16 * tm + 4 * fq));
    }
    __syncthreads();
    f32x4 y0[2];
    {
#pragma unroll
      for (int i = 0; i < 2; ++i) {
        f32x4 z = mm_tile<true, true>(SAkkT, RTS, 16 * tm, XVt, RTS, 16 * (2 * tn + i), 32, z4);
        st_tile_T(ZT, RTS, 16 * tm, 16 * (2 * tn + i), z);
        y0[i] = mm_tile<true, true>(SAkrT, RTS, 16 * tm, XVt, RTS, 16 * (2 * tn + i), 32, z4);
      }
      f32x4 m = mm_tile<true, true>(SLt, RTS, 16 * tm, SLt, RTS, 16 * tn, 32, z4);
      st_tile_T(SMt, RTS, 16 * tm, 16 * tn, m);
    }
    __syncthreads();
#pragma unroll 1
    for (int rd = 0; rd < 4; ++rd) {
      f32x4 tnew = mm_tile<true, true>(STt, RTS, 16 * tm, SMt, RTS, 16 * tn, 32, tacc);
      f32x4 mnew = z4;
      if (rd < 3) mnew = mm_tile<true, true>(SMt, RTS, 16 * tm, SMt, RTS, 16 * tn, 32, z4);
      __syncthreads();
      tacc = tnew;
      st_tile_T(STt, RTS, 16 * tm, 16 * tn, tacc);
      if (rd < 3) st_tile_T(SMt, RTS, 16 * tm, 16 * tn, mnew);
      __syncthreads();
    }
    {
      f32x4 w1[2], w2[2];
#pragma unroll
      for (int i = 0; i < 2; ++i) {
        w1[i] = mm_tile<true, true>(STt, RTS, 16 * tm, XKt, RTS, 16 * (2 * tn + i), 32, z4);
        w2[i] = mm_tile<true, true>(STt, RTS, 16 * tm, ZT, RTS, 16 * (2 * tn + i), 32, z4);
      }
#pragma unroll
      for (int i = 0; i < 2; ++i) { st_tile_T(W1T, RTS, 16 * tm, 16 * (2 * tn + i), w1[i]); st_tile_T(W2T, RTS, 16 * tm, 16 * (2 * tn + i), w2[i]); }
    }
    __syncthreads();
    f32x4 pa[4], qc[4], r2[2];
    {
#pragma unroll
      for (int n = 0; n < 4; ++n) {
        pa[n] = mm_tile<false, true>(W1T, RTS, 16 * w, XBBt, RTS, 16 * n, 32, z4);
        f32x4 qa = mm_tile<false, true>(XVt, RTS, 16 * w, XKBt, RTS, 16 * n, 32, z4);
        f32x4 qb = mm_tile<false, true>(W2T, RTS, 16 * w, XBBt, RTS, 16 * n, 32, z4);
        qc[n] = qa - qb;
      }
#pragma unroll
      for (int i = 0; i < 2; ++i) {
        r2[i] = mm_tile<true, true>(SnAbrT, RTS, 16 * tm, W1T, RTS, 16 * (2 * tn + i), 32, rt[i]);
        y0[i] = mm_tile<true, true>(SnAbrT, RTS, 16 * tm, W2T, RTS, 16 * (2 * tn + i), 32, y0[i]);
      }
    }
    __syncthreads();
    {
#pragma unroll
      for (int n = 0; n < 4; ++n) {
        const float gcol = gam[16 * n + fr];
        f32x4 pc;
#pragma unroll
        for (int reg = 0; reg < 4; ++reg) {
          const int row = 16 * w + 4 * fq + reg, col = 16 * n + fr;
          pc[reg] = ((row == col ? 1.f : 0.f) - pa[n][reg]) * gcol;
          qc[n][reg] *= gcol;
        }
        st_tile_T(PcT, RGS, 16 * w, 16 * n, pc);
      }
#pragma unroll
      for (int i = 0; i < 2; ++i) st_tile_T(R2T, RTS, 16 * tm, 16 * (2 * tn + i), r2[i]);
    }
    __syncthreads();
    {
      if (ci >= 8) {
        const unsigned orow = (unsigned)(row_of_step(dir, ci * 32 + 16 * tm + 4 * fq) * 512 + hd * 64 + fr);
#pragma unroll
        for (int i = 0; i < 2; ++i) {
          f32x4 o1 = mm_tile<true, false>(R2T, RTS, 16 * tm, GPT, RGS, 16 * (2 * tn + i), 64, z4);
          f32x4 o2 = mm_tile<true, false>(R2T, RTS, 16 * tm, GQT, RGS, 16 * (2 * tn + i), 64, y0[i]);
#pragma unroll
          for (int reg = 0; reg < 4; ++reg) {
            const unsigned o = orow + (unsigned)(sgn * reg * 512 + 16 * (2 * tn + i));
            R2P[o] = f2bf(o1[reg]); Y0P[o] = f2bf(o2[reg]);
          }
        }
      }
#pragma unroll
      for (int n = 0; n < 4; ++n) {
        pcum[n] = mm_tile<true, true>(GPT, RGS, 16 * w, PcT, RGS, 16 * n, 64, z4);
        qcum[n] = mm_tile<true, true>(GQT, RGS, 16 * w, PcT, RGS, 16 * n, 64, qc[n]);
      }
    }
    __syncthreads();
#pragma unroll
    for (int n = 0; n < 4; ++n) { st_tile_T(GPT, RGS, 16 * w, 16 * n, pcum[n]); st_tile_T(GQT, RGS, 16 * w, 16 * n, qcum[n]); }
  }
  {
    bfr* Pt = (bfr*)(P.ws + WS_PTOT) + (size_t)(chain * RW_NSC + sc) * 4096;
    float* Qt = (float*)(P.ws + WS_QTOT) + (size_t)(chain * RW_NSC + sc) * 4096;
#pragma unroll
    for (int n = 0; n < 4; ++n)
#pragma unroll
      for (int reg = 0; reg < 4; ++reg) {
        const int row = 16 * w + 4 * fq + reg, col = 16 * n + fr;
        Pt[row * 64 + col] = f2bf(pcum[n][reg]);
      }
#pragma unroll
    for (int n = 0; n < 4; ++n) *(f32x4*)(Qt + (16 * n + fr) * 64 + 16 * w + 4 * fq) = qcum[n];
  }
}

DI void rw_levelB_chain(CParams& P, int chain, char* smem) {
  short* SB = (short*)smem; short* PT = SB + 64 * GS;
  const bfr* Ptot = (const bfr*)(P.ws + WS_PTOT) + (size_t)chain * RW_NSC * 4096;
  const float* Qtot = (const float*)(P.ws + WS_QTOT) + (size_t)chain * RW_NSC * 4096;
  bfr* SIN = (bfr*)(P.ws + WS_SINRW) + (size_t)chain * (RW_NSC + 1) * 4096;
  const int tid = VT, lane = tid & 63, w = tid >> 6, fr = lane & 15, fq = lane >> 4;
  f32x4 S[4];
#pragma unroll
  for (int n = 0; n < 4; ++n) S[n] = f32x4{0.f, 0.f, 0.f, 0.f};
  bf16x8 pr[4][2]; f32x4 qr[4][4];
#define LB_LOAD(slot, sc_) do { _Pragma("unroll") for (int i_ = 0; i_ < 2; ++i_) { const int e_ = tid + i_ * NTHR; pr[slot][i_] = *(const bf16x8*)(Ptot + (size_t)(sc_) * 4096 + (e_ >> 3) * 64 + (e_ & 7) * 8); } \
    _Pragma("unroll") for (int n_ = 0; n_ < 4; ++n_) qr[slot][n_] = *(const f32x4*)(Qtot + (size_t)(sc_) * 4096 + (16 * n_ + fr) * 64 + 16 * w + 4 * fq); } while (0)
  LB_LOAD(0, 0); LB_LOAD(1, 1); LB_LOAD(2, 2); LB_LOAD(3, 3);
#define LB_STEP(u) do { const int sc = sc0 + (u); \
      __syncthreads(); \
      _Pragma("unroll") for (int n = 0; n < 4; ++n) { st_tile(SB, GS, 16 * w, 16 * n, S[n]); \
        _Pragma("unroll") for (int reg = 0; reg < 4; ++reg) SIN[(size_t)sc * 4096 + (16 * w + 4 * fq + reg) * 64 + 16 * n + fr] = f2bf(S[n][reg]); } \
      _Pragma("unroll") for (int i = 0; i < 2; ++i) { const int e = tid + i * NTHR; *(bf16x8*)(PT + (e >> 3) * GS + (e & 7) * 8) = pr[u][i]; } \
      const f32x4 qc0 = qr[u][0], qc1 = qr[u][1], qc2 = qr[u][2], qc3 = qr[u][3]; \
      __syncthreads(); \
      if (sc + 4 < RW_NSC) LB_LOAD(u, sc + 4); \
      S[0] = mm_tile<false, false>(SB, GS, 16 * w, PT, GS, 0, 64, qc0); S[1] = mm_tile<false, false>(SB, GS, 16 * w, PT, GS, 16, 64, qc1); \
      S[2] = mm_tile<false, false>(SB, GS, 16 * w, PT, GS, 32, 64, qc2); S[3] = mm_tile<false, false>(SB, GS, 16 * w, PT, GS, 48, 64, qc3); } while (0)
  for (int sc0 = 0; sc0 < RW_NSC; sc0 += 4) { LB_STEP(0); LB_STEP(1); LB_STEP(2); LB_STEP(3); }
#undef LB_STEP
#undef LB_LOAD
}

constexpr int HG_NSC = 64;
DI int hg_sc_begin(int sc) { return sc * 8 + (sc < 8 ? sc : 8); }
DI int hg_sc_of_chunk(int ci) { return ci < 72 ? ci / 9 : 8 + (ci - 72) / 8; }
constexpr int QS = 136;
constexpr int HGL_Q0 = 0, HGL_Q1 = 8704, HGL_KP = 13056, HGL_KH = 21760, HGL_VV = 30464, HGL_PM = 39168, HGL_STT = 41728;
constexpr int HGL_BL = 76544, HGL_TOT = 77056, HGL_END = 78080;
constexpr size_t WS_SINHG = 23 * MB;
constexpr size_t WS_QH = 414 * MB;
constexpr size_t WS_O0 = 446 * MB;
constexpr size_t WS_SLOC = 478 * MB;
constexpr size_t WS_DTOT = 510 * MB;

constexpr int HTS = 40, HT1S = 24;
constexpr int HGT_Q0 = 0, HGT_Q1 = 10240, HGT_KP = 16384, HGT_KH = 26624, HGT_VV = 36864, HGT_PM = 47104, HGT_BL = 49664, HGT_TOT = 50176;
DI bf16x8 ld_tr8p(const short* base, int stride, int k0, int n0) {
  const int lane = (int)(threadIdx.x & 63), g = lane >> 4, q = (lane & 15) >> 2, p = lane & 3;
  const short* a0 = base + (k0 + 4 * g + q) * stride + n0 + 4 * p;
  s16x4 lo = __builtin_amdgcn_ds_read_tr16_b64_v4i16((LDSP(s16x4))a0);
  s16x4 hi = __builtin_amdgcn_ds_read_tr16_b64_v4i16((LDSP(s16x4))(a0 + 16 * stride));
  return __builtin_shufflevector(lo, hi, 0, 1, 2, 3, 4, 5, 6, 7);
}
DI void hg_levelA_item(CParams& P, int chain, int sc, char* smem) {
  const int dir = chain >> 2, hd = chain & 3;
  const bfr* p = (const bfr*)(P.ws + WS_P);
  const float* lbp = (const float*)(P.ws + WS_LB) + dir * 512 + hd * 128;
  bfr* QH = (bfr*)(P.ws + WS_QH) + (size_t)dir * T_LAT * 512;
  bfr* O0 = (bfr*)(P.ws + WS_O0) + (size_t)dir * T_LAT * 512;
  short* Q0T = (short*)(smem + HGT_Q0); short* Q1T = (short*)(smem + HGT_Q1); short* KPT = (short*)(smem + HGT_KP);
  short* KHT = (short*)(smem + HGT_KH); short* VVT = (short*)(smem + HGT_VV); short* PMT = (short*)(smem + HGT_PM);
  float* BL = (float*)(smem + HGT_BL); float* tot = (float*)(smem + HGT_TOT);
  const int tid = VT, lane = tid & 63, w = tid >> 6, fr = lane & 15, fq = lane >> 4;
  const f32x4 z4 = {0.f, 0.f, 0.f, 0.f};
  f32x4 S[8][2];
#pragma unroll
  for (int m = 0; m < 8; ++m) { S[m][0] = z4; S[m][1] = z4; }
  const int d = tid & 127, hf = tid >> 7;
  const float lb = lbp[d];
  float dcum = 0.f;
  const int sgn = dir ? -1 : 1;
  const int c_begin = hg_sc_begin(sc), c_end = hg_sc_begin(sc + 1);
  unsigned qv[16]; bfr zr[16];
#define HG_PREFETCH(cc) do { const unsigned po0_ = (unsigned)(row_of_step(dir, (cc) * 32 + hf * 16) * DIN + hd * 128 + d); \
      _Pragma("unroll") for (int e_ = 0; e_ < 16; ++e_) { const unsigned po_ = po0_ + (unsigned)(sgn * e_ * DIN); \
      qv[e_] = (unsigned)p[po_] | ((unsigned)p[po_ + 512] << 16); zr[e_] = p[po_ + 1024 + dir * 512]; } } while (0)
  HG_PREFETCH(c_begin);
  for (int ci = c_begin; ci < c_end; ++ci) {
    __syncthreads();
    {
      float lc[16], kv[16]; float run = 0.f;
#pragma unroll
      for (int e = 0; e < 16; ++e) {
        const float sg = sigmoidf_(bf2f(zr[e]));
        const float f = lb + (1.f - lb) * sg;
        kv[e] = (1.f - lb) * (1.f - sg);
        run += __logf(f); lc[e] = run;
      }
      tot[hf * 128 + d] = run;
      __syncthreads();
      const float tot0 = tot[d], tot1 = tot[128 + d];
      const float blast = tot0 + tot1;
      const float e0f = hf ? __expf(tot0) : 1.f;
      const float ehf = __expf(blast - (hf ? tot0 : 0.f));
      const float edc = __expf(dcum);
      const unsigned qh0 = (unsigned)(row_of_step(dir, ci * 32 + hf * 16) * 512 + hd * 128 + d);
#pragma unroll
      for (int hq = 0; hq < 2; ++hq) {
        unsigned q0w[4], q1w[4], kpw[4], khw[4], vvw[4];
#pragma unroll
        for (int e2 = 0; e2 < 4; ++e2) {
          float q0v[2], q1v[2], kpv[2], khv[2];
#pragma unroll
          for (int u = 0; u < 2; ++u) {
            const int e = 8 * hq + 2 * e2 + u;
            const float el = __expf(lc[e]), eil = frcp_(el);
            const float qs = siluf_(__uint_as_float(qv[e] << 16));
            q1v[u] = qs * el; q0v[u] = q1v[u] * e0f;
            kpv[u] = kv[e] * eil; khv[u] = kpv[u] * ehf;
            if (ci >= 8) QH[qh0 + (unsigned)(sgn * e * 512)] = f2bf(q0v[u] * edc);
          }
          q0w[e2] = pack2(q0v[0], q0v[1]); q1w[e2] = pack2(q1v[0], q1v[1]); kpw[e2] = pack2(kpv[0], kpv[1]); khw[e2] = pack2(khv[0], khv[1]);
          vvw[e2] = (qv[8 * hq + 2 * e2] >> 16) | (qv[8 * hq + 2 * e2 + 1] & 0xffff0000u);
        }
        const int co = 16 * hf + 8 * hq;
        *(uint4*)(Q0T + d * HTS + co) = uint4{q0w[0], q0w[1], q0w[2], q0w[3]};
        if (hf) *(uint4*)(Q1T + d * HT1S + 8 * hq) = uint4{q1w[0], q1w[1], q1w[2], q1w[3]};
        *(uint4*)(KPT + d * HTS + co) = uint4{kpw[0], kpw[1], kpw[2], kpw[3]};
        *(uint4*)(KHT + d * HTS + co) = uint4{khw[0], khw[1], khw[2], khw[3]};
        *(uint4*)(VVT + d * HTS + co) = uint4{vvw[0], vvw[1], vvw[2], vvw[3]};
      }
      if (hf == 0) BL[d] = blast;
      dcum += blast;
      if (ci + 1 < c_end) HG_PREFETCH(ci + 1);
    }
    __syncthreads();
    {
      f32x4 pt = z4;
      if (w == 0) pt = mm_tile<true, false>(Q0T, HTS, 0, KPT, HTS, 0, 128, z4);
      else if (w == 1) pt = mm_tile<true, false>(Q0T, HTS, 16, KPT, HTS, 0, 128, z4);
      else if (w == 2) pt = mm_tile<true, false>(Q1T, HT1S, 0, KPT, HTS, 16, 128, z4);
      if (w == 0 || w == 2) {
#pragma unroll
        for (int reg = 0; reg < 4; ++reg) pt[reg] = (fr <= 4 * fq + reg) ? pt[reg] : 0.f;
      }
      const int ptm = (w == 0 || w == 3) ? 0 : 1, ptn = (w >= 2) ? 1 : 0;
      *(uint2*)(PMT + (16 * ptn + fr) * HTS + 16 * ptm + 4 * fq) = uint2{pack2(pt[0], pt[1]), pack2(pt[2], pt[3])};
    }
    __syncthreads();
    {
      bf16x8 vfr[2];
#pragma unroll
      for (int n = 0; n < 2; ++n) vfr[n] = *(const bf16x8*)(VVT + (32 * w + 16 * n + fr) * HTS + fq * 8);
      f32x4 o[2][2];
#pragma unroll
      for (int m = 0; m < 2; ++m) { o[m][0] = z4; o[m][1] = z4; }
#pragma unroll
      for (int ks = 0; ks < 4; ++ks) {
        bf16x8 sfr[2];
#pragma unroll
        for (int n = 0; n < 2; ++n) {
          typedef __attribute__((ext_vector_type(4))) unsigned u32x4_;
          u32x4_ wv = {pack2(S[2 * ks][n][0], S[2 * ks][n][1]), pack2(S[2 * ks][n][2], S[2 * ks][n][3]), pack2(S[2 * ks + 1][n][0], S[2 * ks + 1][n][1]), pack2(S[2 * ks + 1][n][2], S[2 * ks + 1][n][3])};
          sfr[n] = __builtin_bit_cast(bf16x8, wv);
        }
#pragma unroll
        for (int m = 0; m < 2; ++m) {
          const bf16x8 a = ld_tr8p(Q0T, HTS, 32 * ks, 16 * m);
#pragma unroll
          for (int n = 0; n < 2; ++n) o[m][n] = __builtin_amdgcn_mfma_f32_16x16x32_bf16(a, sfr[n], o[m][n], 0, 0, 0);
        }
      }
#pragma unroll
      for (int m = 0; m < 2; ++m) {
        const bf16x8 a = ld_tr8(PMT, HTS, 0, 16 * m);
#pragma unroll
        for (int n = 0; n < 2; ++n) {
          o[m][n] = __builtin_amdgcn_mfma_f32_16x16x32_bf16(a, vfr[n], o[m][n], 0, 0, 0);
          if (ci >= 8) {
            const unsigned orow = (unsigned)(row_of_step(dir, ci * 32 + 16 * m + 4 * fq) * 512 + hd * 128 + 32 * w + 16 * n + fr);
#pragma unroll
            for (int reg = 0; reg < 4; ++reg) O0[orow + (unsigned)(sgn * reg * 512)] = f2bf(o[m][n][reg]);
          }
        }
      }
#pragma unroll
      for (int m = 0; m < 8; ++m) {
        const f32x4 bl = *(const f32x4*)(BL + 16 * m + 4 * fq);
        f32x4 sc4 = {__expf(bl[0]), __expf(bl[1]), __expf(bl[2]), __expf(bl[3])};
        const bf16x8 a = *(const bf16x8*)(KHT + (16 * m + fr) * HTS + fq * 8);
#pragma unroll
        for (int n = 0; n < 2; ++n) S[m][n] = __builtin_amdgcn_mfma_f32_16x16x32_bf16(a, vfr[n], S[m][n] * sc4, 0, 0, 0);
      }
    }
  }
  {
    float* SL_ = (float*)(P.ws + WS_SLOC) + (size_t)(chain * HG_NSC + sc) * 16384;
    float* DT = (float*)(P.ws + WS_DTOT) + (size_t)(chain * HG_NSC + sc) * 128;
#pragma unroll
    for (int m = 0; m < 8; ++m)
#pragma unroll
      for (int n = 0; n < 2; ++n) *(f32x4*)(SL_ + (32 * w + 16 * n + fr) * 128 + 16 * m + 4 * fq) = S[m][n];
    if (hf == 0) DT[d] = dcum;
  }
}

DI void hg_levelB(CParams& P, int bid, int nb) {
  const float* SLOC = (const float*)(P.ws + WS_SLOC); const float* DT = (const float*)(P.ws + WS_DTOT);
  bfr* SIN = (bfr*)(P.ws + WS_SINHG);
  for (int idx = bid * NTHR + VT; idx < 8 * 16384; idx += nb * NTHR) {
    const int chain = idx >> 14, ed = idx & 16383, dd = ed & 127;
    float s = 0.f;
    for (int sc = 0; sc < HG_NSC; ++sc) {
      const size_t item = (size_t)chain * HG_NSC + sc;
      SIN[item * 16384 + ed] = f2bf(s);
      s = __expf(DT[item * 128 + dd]) * s + SLOC[item * 16384 + ed];
    }
  }
}

constexpr size_t WS_LORA = 256 * 1024;
constexpr int LORA_WD2T = 0, LORA_WA2T = 2 * 512 * 32, LORA_WG2T = LORA_WA2T + 512 * 32;
DI void phase_lora_convert(CParams& P, int part, int nparts) {
  const float* wd2 = P.in[12]; const float* wa2 = P.in[14]; const float* wg2 = P.in[15];
  bfr* L = (bfr*)(P.ws + WS_LORA);
  for (int i = part * NTHR + VT; i < 2 * 512 * 32; i += nparts * NTHR) { const int d = i >> 14, c = (i >> 5) & 511, j = i & 31; L[LORA_WD2T + i] = f2bf(wd2[(d * 32 + j) * 512 + c]); }
  for (int i = part * NTHR + VT; i < 512 * 32; i += nparts * NTHR) { const int c = i >> 5, j = i & 31; L[LORA_WA2T + i] = f2bf(wa2[j * 512 + c]); }
  for (int i = part * NTHR + VT; i < 512 * 96; i += nparts * NTHR) { const int c = i / 96, j = i % 96; L[LORA_WG2T + i] = f2bf(wg2[j * 512 + c]); }
}
#define NB_DECL(row) \
  int nb_o0, nb_o1, nb_o2, nb_o3; float nb_f0, nb_f1, nb_f2, nb_f3, nb_scale; \
  { const int r_ = (row); const bool lat_ = r_ < T_LAT; const int gr_ = r_ >> 6, gc_ = r_ & 63, s_ = r_ - T_LAT; \
    const bool v0_ = lat_ && gr_ > 0, v1_ = lat_ && gr_ < 255, v2_ = lat_ ? gc_ > 0 : s_ > 0, v3_ = lat_ ? gc_ < 63 : s_ < T_CTX - 1; \
    nb_o0 = v0_ ? -64 * DIN : 0; nb_o1 = v1_ ? 64 * DIN : 0; nb_o2 = v2_ ? -DIN : 0; nb_o3 = v3_ ? DIN : 0; \
    nb_f0 = v0_ ? 1.f : 0.f; nb_f1 = v1_ ? 1.f : 0.f; nb_f2 = v2_ ? 1.f : 0.f; nb_f3 = v3_ ? 1.f : 0.f; nb_scale = lat_ ? 0.25f : 0.5f; }
#define MIX4(pc, mup) mix4_((pc), (mup), nb_o0, nb_o1, nb_o2, nb_o3, nb_f0, nb_f1, nb_f2, nb_f3, nb_scale)
DI f32x4 ld4bf(const bfr* p) {
  const uint2 u = *(const uint2*)p;
  return f32x4{__uint_as_float(u.x << 16), __uint_as_float(u.x & 0xffff0000u), __uint_as_float(u.y << 16), __uint_as_float(u.y & 0xffff0000u)};
}
DI f32x4 mix4_(const bfr* pc, const float* mu, int o0, int o1, int o2, int o3, float f0, float f1, float f2, float f3, float scale) {
  const f32x4 c = ld4bf(pc);
  f32x4 s = ld4bf(pc + o0) * f0 + ld4bf(pc + o1) * f1 + ld4bf(pc + o2) * f2 + ld4bf(pc + o3) * f3;
  const f32x4 m = *(const f32x4*)mu;
  return c + (s * scale - c) * m;
}
DI void ld8bf(const bfr* p, f32x4& lo, f32x4& hi) {
  const uint4 u = *(const uint4*)p;
  lo = f32x4{__uint_as_float(u.x << 16), __uint_as_float(u.x & 0xffff0000u), __uint_as_float(u.y << 16), __uint_as_float(u.y & 0xffff0000u)};
  hi = f32x4{__uint_as_float(u.z << 16), __uint_as_float(u.z & 0xffff0000u), __uint_as_float(u.w << 16), __uint_as_float(u.w & 0xffff0000u)};
}
DI void mix8_(const bfr* pc, const float* mu, int o0, int o1, int o2, int o3, float f0, float f1, float f2, float f3, float scale, f32x4& lo, f32x4& hi) {
  f32x4 cl, chh, al, ah, bl, bh, dl, dh, el, eh;
  ld8bf(pc, cl, chh); ld8bf(pc + o0, al, ah); ld8bf(pc + o1, bl, bh); ld8bf(pc + o2, dl, dh); ld8bf(pc + o3, el, eh);
  const f32x4 sl = al * f0 + bl * f1 + dl * f2 + el * f3, sh = ah * f0 + bh * f1 + dh * f2 + eh * f3;
  const f32x4 ml = *(const f32x4*)mu, mh = *(const f32x4*)(mu + 4);
  lo = cl + (sl * scale - cl) * ml; hi = chh + (sh * scale - chh) * mh;
}
#define MIX8(pc, mup, lo, hi) mix8_((pc), (mup), nb_o0, nb_o1, nb_o2, nb_o3, nb_f0, nb_f1, nb_f2, nb_f3, nb_scale, lo, hi)
DI float ftanh_(float x) { const float e = __expf(2.f * x); return 1.f - 2.f * frcp_(e + 1.f); }
DI uint2 pk4(f32x4 v) { return uint2{pack2(v[0], v[1]), pack2(v[2], v[3])}; }
constexpr int LIS = 200;
constexpr int MXS = 388;
DI void phase_rwprep(CParams& P, int bid, int nb, char* smem) {
  const bfr* p = (const bfr*)(P.ws + WS_P);
  const float* mu = P.in[10]; const float* w0 = P.in[11]; const float* a0 = P.in[13];
  const float* k_k = P.in[16]; const float* k_a = P.in[17];
  const bfr* LW_ = (const bfr*)(P.ws + WS_LORA);
  bfr* R = (bfr*)(P.ws + WS_RW); bfr* K = (bfr*)(P.ws + WS_RW + RW_ARR); bfr* V = (bfr*)(P.ws + WS_RW + 2 * RW_ARR);
  bfr* KK = (bfr*)(P.ws + WS_RW + 3 * RW_ARR); bfr* A = (bfr*)(P.ws + WS_RW + 4 * RW_ARR); bfr* G = (bfr*)(P.ws + WS_RW + 5 * RW_ARR);
  float* LWF = (float*)(P.ws + WS_LW); float* LWB = (float*)(P.ws + WS_LW + LW_ARR);
  short* LI = (short*)smem;
  float* MX = (float*)(smem + 32 * LIS * 2);
  const int tid = VT, lane = tid & 63, w = tid >> 6, fr = lane & 15, fq = lane >> 4;
  const f32x4 z4 = {0.f, 0.f, 0.f, 0.f};
  const int hp = bid & 3;
  bf16x8 afr[4][6];
  {
    const int h = hp * 2 + (w >> 1);
#pragma unroll
    for (int m = 0; m < 4; ++m) {
      const int c0 = 64 * h + 16 * m;
      afr[m][0] = *(const bf16x8*)(LW_ + LORA_WD2T + (c0 + fr) * 32 + fq * 8);
      afr[m][1] = *(const bf16x8*)(LW_ + LORA_WD2T + 512 * 32 + (c0 + fr) * 32 + fq * 8);
      afr[m][2] = *(const bf16x8*)(LW_ + LORA_WA2T + (c0 + fr) * 32 + fq * 8);
#pragma unroll
      for (int ks = 0; ks < 3; ++ks) afr[m][3 + ks] = *(const bf16x8*)(LW_ + LORA_WG2T + (c0 + fr) * 96 + ks * 32 + fq * 8);
    }
  }
  for (int it = bid; it < (T_ALL / 32) * 4; it += nb) {
  const int tile = it >> 2;
  const int row0 = tile * 32;
  __syncthreads();
  for (int v = tid; v < 32 * 72; v += NTHR) {
    const int t = v / 72, g = v % 72;
    const int row = row0 + t;
    NB_DECL(row);
    f32x4 lo, hi;
    if (g < 24) {
      const bfr* pc = p + (size_t)row * DIN + HGC + 1536 + g * 8;
      MIX8(pc, mu + 1536 + g * 8, lo, hi);
#pragma unroll
      for (int e = 0; e < 4; ++e) {
        if (g < 8) { lo[e] = ftanh_(lo[e]); hi[e] = ftanh_(hi[e]); }
        else if (g >= 12) { lo[e] = sigmoidf_(lo[e]); hi[e] = sigmoidf_(hi[e]); }
      }
      const uint2 a = pk4(lo), b = pk4(hi);
      *(uint4*)(LI + t * LIS + g * 8) = uint4{a.x, a.y, b.x, b.y};
    } else {
      const int cg = g - 24, a = cg >> 4, c8 = cg & 15;
      const int col = a * 512 + hp * 128 + c8 * 8;
      MIX8(p + (size_t)row * DIN + HGC + col, mu + col, lo, hi);
      *(f32x4*)(MX + t * MXS + a * 128 + c8 * 8) = lo; *(f32x4*)(MX + t * MXS + a * 128 + c8 * 8 + 4) = hi;
    }
  }
  __syncthreads();
  {
    const int hl = w >> 1, th = w & 1, h = hp * 2 + hl;
    const int row = row0 + 16 * th + fr;
    const float* mrow = MX + (16 * th + fr) * MXS + hl * 64 + 4 * fq;
    f32x4 kkr[4], kraw[4], av[4];
    float ss = 0.f;
#pragma unroll
    for (int m = 0; m < 4; ++m) {
      const int c0 = 64 * h + 16 * m;
      const int ch = c0 + 4 * fq;
      const f32x4 r = *(const f32x4*)(mrow + 16 * m);
      kraw[m] = *(const f32x4*)(mrow + 128 + 16 * m);
      const f32x4 v = *(const f32x4*)(mrow + 256 + 16 * m);
      const short* lrow = LI + (16 * th + fr) * LIS + fq * 8;
      f32x4 aF = __builtin_amdgcn_mfma_f32_16x16x32_bf16(afr[m][0], *(const bf16x8*)(lrow), z4, 0, 0, 0);
      f32x4 aB = __builtin_amdgcn_mfma_f32_16x16x32_bf16(afr[m][1], *(const bf16x8*)(lrow + 32), z4, 0, 0, 0);
      f32x4 aA = __builtin_amdgcn_mfma_f32_16x16x32_bf16(afr[m][2], *(const bf16x8*)(lrow + 64), z4, 0, 0, 0);
      f32x4 aG = z4;
#pragma unroll
      for (int ks = 0; ks < 3; ++ks) aG = __builtin_amdgcn_mfma_f32_16x16x32_bf16(afr[m][3 + ks], *(const bf16x8*)(lrow + 96 + ks * 32), aG, 0, 0, 0);
      const size_t o = (size_t)row * 512 + ch;
      const f32x4 w0f = *(const f32x4*)(w0 + ch), w0b = *(const f32x4*)(w0 + 512 + ch), a0v = *(const f32x4*)(a0 + ch);
      f32x4 lwf, lwb;
#pragma unroll
      for (int e = 0; e < 4; ++e) {
        lwf[e] = -RW_DECAY_SCALE * sigmoidf_(w0f[e] + aF[e]);
        lwb[e] = -RW_DECAY_SCALE * sigmoidf_(w0b[e] + aB[e]);
        av[m][e] = sigmoidf_(a0v[e] + aA[e]);
      }
      *(f32x4*)(LWF + o) = lwf; *(f32x4*)(LWB + o) = lwb;
      *(uint2*)(G + o) = pk4(aG);
      *(uint2*)(A + o) = pk4(av[m]);
      *(uint2*)(R + o) = pk4(r); *(uint2*)(V + o) = pk4(v);
      kkr[m] = kraw[m] * *(const f32x4*)(k_k + ch);
      ss += kkr[m][0] * kkr[m][0] + kkr[m][1] * kkr[m][1] + kkr[m][2] * kkr[m][2] + kkr[m][3] * kkr[m][3];
    }
    ss += __shfl_xor(ss, 16); ss += __shfl_xor(ss, 32);
    const float rn = rsqrtf(fmaxf(ss, 1e-12f));
#pragma unroll
    for (int m = 0; m < 4; ++m) {
      const int ch = 64 * h + 16 * m + 4 * fq;
      const size_t o = (size_t)row * 512 + ch;
      const f32x4 ka = *(const f32x4*)(k_a + ch);
      f32x4 kv;
#pragma unroll
      for (int e = 0; e < 4; ++e) kv[e] = kraw[m][e] * (1.f + (av[m][e] - 1.f) * ka[e]);
      *(uint2*)(K + o) = pk4(kv);
      *(uint2*)(KK + o) = pk4(kkr[m] * rn);
    }
  }
  }
}

constexpr size_t WS_WRT = 512 * 1024;
DI void phase_wrt_convert(CParams& P, int part, int nparts) {
  const float* wgrp = P.in[25]; const float* wrt = P.in[27];
  bfr* Whi = (bfr*)(P.ws + WS_WRT); bfr* Wlo = Whi + 80 * 1024;
  for (int i = part * NTHR + VT; i < 80 * 1024; i += nparts * NTHR) {
    const int o = i >> 10, k = i & 1023;
    float wv = 0.f;
    if (o < 8) wv = wgrp[k * 8 + o]; else if (o < 72) wv = wrt[k * 64 + (o - 8)];
    const bfr hi = f2bf(wv);
    Whi[i] = hi; Wlo[i] = f2bf(wv - bf2f(hi));
  }
}
constexpr int HLS = 1032;
DI void phase_ln2route(CParams& P, char* smem_all) {
  const float* x = P.in[0];
  const bfr* y = (const bfr*)(P.ws + WS_Y);
  const float* mod = (const float*)(P.ws + WS_MOD);
  const float* ln1_g = P.in[21]; const float* ln1_b = P.in[22];
  const float* bgrp = P.in[26]; const float* brt = P.in[28];
  const bfr* Whi = (const bfr*)(P.ws + WS_WRT); const bfr* Wlo = Whi + 80 * 1024;
  bfr* x1 = (bfr*)(P.ws + WS_X1B);
  bfr* h2 = (bfr*)(P.ws + WS_H2);
  int* cnt = (int*)(P.ws + WS_CNT); int* list = (int*)(P.ws + WS_LIST); float* asgw = (float*)(P.ws + WS_ASGW);
  short* HI = (short*)smem_all; short* LO = HI + 32 * HLS;
  float* LG = (float*)(smem_all + 2 * 32 * HLS * 2);
  float* PS = LG + 32 * 80;
  const int tid = tx_(), wid = tid >> 6, lane = tid & 63, fr = lane & 15, fq = lane >> 4;
  for (int grp = blockIdx.x; grp < T_LAT / 32; grp += gridDim.x) {
    const int t0 = grp * 32;
    __syncthreads();
    f32x4 xin[4][4]; uint2 yin[4][4];
#pragma unroll
    for (int tt = 0; tt < 4; ++tt)
#pragma unroll
      for (int i = 0; i < 4; ++i) {
        const long o = (long)(t0 + wid * 4 + tt) * DM + lane * 4 + 256 * i;
        xin[tt][i] = *(const f32x4*)(x + o); yin[tt][i] = *(const uint2*)(y + o);
      }
#pragma unroll
    for (int tt = 0; tt < 4; ++tt) {
      const int tl = wid * 4 + tt, t = t0 + tl;
      f32x4 v[4]; float s = 0.f;
#pragma unroll
      for (int i = 0; i < 4; ++i) {
        const int c = lane * 4 + 256 * i;
        const f32x4 g1 = *(const f32x4*)(mod + 2048 + c);
        const uint2 u = yin[tt][i];
        const f32x4 yv = {__uint_as_float(u.x << 16), __uint_as_float(u.x & 0xffff0000u), __uint_as_float(u.y << 16), __uint_as_float(u.y & 0xffff0000u)};
        v[i] = xin[tt][i] * DN_ALPHA + g1 * yv;
        s += v[i][0] + v[i][1] + v[i][2] + v[i][3];
      }
      float mu = wave_sum(s) * (1.f / DM); float q = 0.f;
#pragma unroll
      for (int i = 0; i < 4; ++i) { v[i] -= mu; q += v[i][0] * v[i][0] + v[i][1] * v[i][1] + v[i][2] * v[i][2] + v[i][3] * v[i][3]; }
      float rs = rsqrtf(wave_sum(q) * (1.f / DM) + 1e-5f);
      s = 0.f;
#pragma unroll
      for (int i = 0; i < 4; ++i) {
        const int c = lane * 4 + 256 * i;
        f32x4 g = *(const f32x4*)(ln1_g + c), b = *(const f32x4*)(ln1_b + c);
        v[i] = v[i] * rs * g + b;
        *(uint2*)(x1 + (long)t * DM + c) = pk4(v[i]);
        s += v[i][0] + v[i][1] + v[i][2] + v[i][3];
      }
      mu = wave_sum(s) * (1.f / DM); q = 0.f;
#pragma unroll
      for (int i = 0; i < 4; ++i) { v[i] -= mu; q += v[i][0] * v[i][0] + v[i][1] * v[i][1] + v[i][2] * v[i][2] + v[i][3] * v[i][3]; }
      rs = rsqrtf(wave_sum(q) * (1.f / DM) + 1e-5f);
#pragma unroll
      for (int i = 0; i < 4; ++i) {
        const int c = lane * 4 + 256 * i;
        f32x4 sh = *(const f32x4*)(mod + 3072 + c), sc = *(const f32x4*)(mod + 4096 + c);
        v[i] = v[i] * rs * (sc + 1.f) + sh;
        const uint2 whi = {pack2(v[i][0], v[i][1]), pack2(v[i][2], v[i][3])};
        f32x4 r;
        r[0] = v[i][0] - __uint_as_float(whi.x << 16); r[1] = v[i][1] - __uint_as_float(whi.x & 0xffff0000u);
        r[2] = v[i][2] - __uint_as_float(whi.y << 16); r[3] = v[i][3] - __uint_as_float(whi.y & 0xffff0000u);
        const uint2 wlo = {pack2(r[0], r[1]), pack2(r[2], r[3])};
        *(uint2*)(h2 + (long)t * DM + c) = whi;
        *(uint2*)(HI + tl * HLS + c) = whi;
        *(uint2*)(LO + tl * HLS + c) = wlo;
      }
    }
    __syncthreads();
    {
      const int own = wid < 4;
      const int mrow = own ? 16 * wid : 64;
      f32x4 acc0 = {0.f, 0.f, 0.f, 0.f}, acc1 = {0.f, 0.f, 0.f, 0.f};
      bf16x8 a[8], an[8];
      const int nbatch = own ? 12 : 3;
#define RT_LOAD(bi_, dst) do { const int ps_ = own ? ((bi_) >> 2) : (bi_), kb_ = own ? (((bi_) & 3) * 8) : ((wid - 4) * 8); const bfr* Wp_ = ps_ == 1 ? Wlo : Whi; \
        _Pragma("unroll") for (int u = 0; u < 8; ++u) dst[u] = *(const bf16x8*)(Wp_ + (size_t)(mrow + fr) * 1024 + (kb_ + u) * 32 + fq * 8); } while (0)
      RT_LOAD(0, a);
#pragma unroll 1
      for (int bi = 0; bi < nbatch; ++bi) {
        if (bi + 1 < nbatch) RT_LOAD(bi + 1, an);
        const int ps = own ? (bi >> 2) : bi, kb = own ? ((bi & 3) * 8) : ((wid - 4) * 8);
        const short* Hp = ps == 2 ? LO : HI;
#pragma unroll
        for (int u = 0; u < 8; ++u) {
          const bf16x8 b0 = *(const bf16x8*)(Hp + fr * HLS + (kb + u) * 32 + fq * 8);
          const bf16x8 b1 = *(const bf16x8*)(Hp + (16 + fr) * HLS + (kb + u) * 32 + fq * 8);
          acc0 = __builtin_amdgcn_mfma_f32_16x16x32_bf16(a[u], b0, acc0, 0, 0, 0);
          acc1 = __builtin_amdgcn_mfma_f32_16x16x32_bf16(a[u], b1, acc1, 0, 0, 0);
        }
#pragma unroll
        for (int u = 0; u < 8; ++u) a[u] = an[u];
      }
#undef RT_LOAD
      if (own) {
#pragma unroll
        for (int reg = 0; reg < 4; ++reg) { LG[fr * 80 + mrow + 4 * fq + reg] = acc0[reg]; LG[(16 + fr) * 80 + mrow + 4 * fq + reg] = acc1[reg]; }
      } else {
#pragma unroll
        for (int reg = 0; reg < 4; ++reg) { PS[((wid - 4) * 32 + fr) * 16 + 4 * fq + reg] = acc0[reg]; PS[((wid - 4) * 32 + 16 + fr) * 16 + 4 * fq + reg] = acc1[reg]; }
      }
    }
    __syncthreads();
    {
      const int tk = tid >> 4, o = tid & 15;
      LG[tk * 80 + 64 + o] = (PS[(0 * 32 + tk) * 16 + o] + PS[(1 * 32 + tk) * 16 + o]) + (PS[(2 * 32 + tk) * 16 + o] + PS[(3 * 32 + tk) * 16 + o]);
    }
    __syncthreads();
    if (tid < 32) {
      const int t = t0 + tid;
      const float* lg = LG + tid * 80;
      int gi = 0; float gmax = -3.4e38f; float gl[8];
#pragma unroll
      for (int g = 0; g < 8; ++g) { gl[g] = lg[g] + bgrp[g]; if (gl[g] > gmax) { gmax = gl[g]; gi = g; } }
      float den = 0.f;
#pragma unroll
      for (int g = 0; g < 8; ++g) den += __expf(gl[g] - gmax);
      const float gprob = 1.f / den;
      int i1 = 0; float v1 = -3.4e38f; float el[8];
#pragma unroll
      for (int g = 0; g < 8; ++g) { el[g] = lg[8 + gi * 8 + g] + brt[gi * 8 + g]; if (el[g] > v1) { v1 = el[g]; i1 = g; } }
      int i2 = 0; float v2 = -3.4e38f;
#pragma unroll
      for (int g = 0; g < 8; ++g) { if (g != i1 && el[g] > v2) { v2 = el[g]; i2 = g; } }
      const float e2 = __expf(v2 - v1);
      const float wt1 = gprob / (1.f + e2), wt2 = gprob * e2 / (1.f + e2);
      const int ex1 = gi * 8 + i1, ex2 = gi * 8 + i2;
      int s1 = atomicAdd(&cnt[ex1], 1); list[ex1 * T_LAT + s1] = t * 2;
      int s2 = atomicAdd(&cnt[ex2], 1); list[ex2 * T_LAT + s2] = t * 2 + 1;
      asgw[t * 2] = wt1; asgw[t * 2 + 1] = wt2;
    }
  }
}

DI void phase_final(CParams& P, int bid, int nb) {
  const float* mod = (const float*)(P.ws + WS_MOD);
  const float* ln2_g = P.in[23]; const float* ln2_b = P.in[24];
  const bfr* mout = (const bfr*)(P.ws + (42ull << 20));
  const bfr* x1b = (const bfr*)(P.ws + WS_X1B);
  const float* asgw = (const float*)(P.ws + WS_ASGW);
  float* out = P.out;
  const int wid = VT >> 6, lane = VT & 63;
  for (int t0 = (bid * 4 + wid) * 2; t0 < T_LAT; t0 += nb * 8) {
    f32x4 v[2][4]; float s[2] = {0.f, 0.f};
#pragma unroll
    for (int r = 0; r < 2; ++r) {
      const int t = t0 + r;
      const float w1 = asgw[t * 2], w2 = asgw[t * 2 + 1];
#pragma unroll
      for (int i = 0; i < 4; ++i) {
        const int c = lane * 4 + 256 * i;
        const f32x4 xv = ld4bf(x1b + (long)t * DM + c), g2 = *(const f32x4*)(mod + 5120 + c);
        const f32x4 a = ld4bf(mout + (long)(2 * t) * DM + c), b = ld4bf(mout + (long)(2 * t + 1) * DM + c);
        v[r][i] = xv * DN_ALPHA + g2 * (a * w1 + b * w2);
        s[r] += v[r][i][0] + v[r][i][1] + v[r][i][2] + v[r][i][3];
      }
    }
#pragma unroll
    for (int r = 0; r < 2; ++r) {
      const float mu = wave_sum(s[r]) * (1.f / DM); float q = 0.f;
#pragma unroll
      for (int i = 0; i < 4; ++i) { v[r][i] -= mu; q += v[r][i][0] * v[r][i][0] + v[r][i][1] * v[r][i][1] + v[r][i][2] * v[r][i][2] + v[r][i][3] * v[r][i][3]; }
      const float rs = rsqrtf(wave_sum(q) * (1.f / DM) + 1e-5f);
#pragma unroll
      for (int i = 0; i < 4; ++i) {
        const int c = lane * 4 + 256 * i;
        f32x4 g = *(const f32x4*)(ln2_g + c), b = *(const f32x4*)(ln2_b + c);
        *(f32x4*)(out + (long)(t0 + r) * DM + c) = v[r][i] * rs * g + b;
      }
    }
  }
}

DI void phase_readout_fused(CParams& P, int bid, int nb) {
  const bfr* p = (const bfr*)(P.ws + WS_P);
  const bfr* R = (const bfr*)(P.ws + WS_RW); const bfr* K = (const bfr*)(P.ws + WS_RW + RW_ARR); const bfr* V = (const bfr*)(P.ws + WS_RW + 2 * RW_ARR);
  const bfr* G = (const bfr*)(P.ws + WS_RW + 5 * RW_ARR);
  const float* hg_norm_w = P.in[9]; const float* r_k = P.in[18]; const float* gn_w = P.in[19]; const float* gn_b = P.in[20];
  bfr* mix = (bfr*)(P.ws + WS_MIX);
  const int tid = VT, lane = tid & 63, w = tid >> 6, fr = lane & 15, fq = lane >> 4;
  const f32x4 z4 = {0.f, 0.f, 0.f, 0.f};
  for (int tile = bid; tile < T_LAT / 32; tile += nb) {
    const int t0 = tile * 32;
#pragma unroll 1
    for (int hh = 0; hh < 2; ++hh) {
      const int hd = 2 * w + hh;
      f32x4 acc[4][2];
#pragma unroll
      for (int m = 0; m < 4; ++m) { acc[m][0] = z4; acc[m][1] = z4; }
#pragma unroll
      for (int dir = 0; dir < 2; ++dir) {
        const int ci = dir ? (519 - tile) : (8 + tile);
        const int sc = rw_sc_of_chunk(ci);
        const bfr* Bq = (const bfr*)(P.ws + WS_R2P) + (size_t)dir * T_LAT * 512 + (size_t)t0 * 512 + hd * 64;
        const bfr* Y0 = (const bfr*)(P.ws + WS_Y0P) + (size_t)dir * T_LAT * 512 + (size_t)t0 * 512 + hd * 64;
        const bfr* Sin = (const bfr*)(P.ws + WS_SINRW) + ((size_t)(dir * 8 + hd) * (RW_NSC + 1) + sc) * 4096;
#pragma unroll
        for (int k0 = 0; k0 < 64; k0 += 32) {
          bf16x8 bq[2];
#pragma unroll
          for (int n = 0; n < 2; ++n) bq[n] = *(const bf16x8*)(Bq + (size_t)(16 * n + fr) * 512 + k0 + fq * 8);
#pragma unroll
          for (int m = 0; m < 4; ++m) {
            const bf16x8 a = *(const bf16x8*)(Sin + (16 * m + fr) * 64 + k0 + fq * 8);
#pragma unroll
            for (int n = 0; n < 2; ++n) acc[m][n] = __builtin_amdgcn_mfma_f32_16x16x32_bf16(a, bq[n], acc[m][n], 0, 0, 0);
          }
        }
#pragma unroll
        for (int m = 0; m < 4; ++m)
#pragma unroll
          for (int n = 0; n < 2; ++n) acc[m][n] += ld4bf(Y0 + (size_t)(16 * n + fr) * 512 + 16 * m + 4 * fq);
      }
#pragma unroll
      for (int n = 0; n < 2; ++n) {
        const size_t trow = (size_t)(t0 + 16 * n + fr) * 512 + hd * 64;
        float s = 0.f, bs = 0.f;
        f32x4 vv[4];
#pragma unroll
        for (int m = 0; m < 4; ++m) {
          const int c = 16 * m + 4 * fq;
          s += acc[m][n][0] + acc[m][n][1] + acc[m][n][2] + acc[m][n][3];
          const f32x4 rr = ld4bf(R + trow + c), kk2 = ld4bf(K + trow + c), rk = *(const f32x4*)(r_k + hd * 64 + c);
          vv[m] = ld4bf(V + trow + c);
          bs += rr[0] * kk2[0] * rk[0] + rr[1] * kk2[1] * rk[1] + rr[2] * kk2[2] * rk[2] + rr[3] * kk2[3] * rk[3];
        }
        s += __shfl_xor(s, 16); s += __shfl_xor(s, 32);
        bs += __shfl_xor(bs, 16); bs += __shfl_xor(bs, 32);
        const float mu = s * (1.f / 64.f);
        float q = 0.f;
#pragma unroll
        for (int m = 0; m < 4; ++m) { acc[m][n] -= mu; q += acc[m][n][0] * acc[m][n][0] + acc[m][n][1] * acc[m][n][1] + acc[m][n][2] * acc[m][n][2] + acc[m][n][3] * acc[m][n][3]; }
        q += __shfl_xor(q, 16); q += __shfl_xor(q, 32);
        const float rs = rsqrtf(q * (1.f / 64.f) + 64e-5f);
#pragma unroll
        for (int m = 0; m < 4; ++m) {
          const int c = hd * 64 + 16 * m + 4 * fq;
          const f32x4 gw = *(const f32x4*)(gn_w + c), gb = *(const f32x4*)(gn_b + c), gg = ld4bf(G + trow + 16 * m + 4 * fq);
          const f32x4 o = (acc[m][n] * rs * gw + gb + vv[m] * bs) * gg;
          *(uint2*)(mix + (size_t)(t0 + 16 * n + fr) * DM + 512 + c) = pk4(o);
        }
      }
    }
    {
      const int hd = w;
      f32x4 acc[8][2];
#pragma unroll
      for (int m = 0; m < 8; ++m) { acc[m][0] = z4; acc[m][1] = z4; }
#pragma unroll
      for (int dir = 0; dir < 2; ++dir) {
        const int ci = dir ? (519 - tile) : (8 + tile);
        const int sc = hg_sc_of_chunk(ci);
        const bfr* Bq = (const bfr*)(P.ws + WS_QH) + (size_t)dir * T_LAT * 512 + (size_t)t0 * 512 + hd * 128;
        const bfr* O0 = (const bfr*)(P.ws + WS_O0) + (size_t)dir * T_LAT * 512 + (size_t)t0 * 512 + hd * 128;
        const bfr* Sin = (const bfr*)(P.ws + WS_SINHG) + ((size_t)(dir * 4 + hd) * HG_NSC + sc) * 16384;
#pragma unroll
        for (int k0 = 0; k0 < 128; k0 += 32) {
          bf16x8 bq[2];
#pragma unroll
          for (int n = 0; n < 2; ++n) bq[n] = *(const bf16x8*)(Bq + (size_t)(16 * n + fr) * 512 + k0 + fq * 8);
#pragma unroll
          for (int m = 0; m < 8; ++m) {
            const bf16x8 a = *(const bf16x8*)(Sin + (16 * m + fr) * 128 + k0 + fq * 8);
#pragma unroll
            for (int n = 0; n < 2; ++n) acc[m][n] = __builtin_amdgcn_mfma_f32_16x16x32_bf16(a, bq[n], acc[m][n], 0, 0, 0);
          }
        }
#pragma unroll
        for (int m = 0; m < 8; ++m)
#pragma unroll
          for (int n = 0; n < 2; ++n) acc[m][n] += ld4bf(O0 + (size_t)(16 * n + fr) * 512 + 16 * m + 4 * fq);
      }
#pragma unroll
      for (int n = 0; n < 2; ++n) {
        const int t = t0 + 16 * n + fr;
        float ss = 0.f;
#pragma unroll
        for (int m = 0; m < 8; ++m) ss += acc[m][n][0] * acc[m][n][0] + acc[m][n][1] * acc[m][n][1] + acc[m][n][2] * acc[m][n][2] + acc[m][n][3] * acc[m][n][3];
        ss += __shfl_xor(ss, 16); ss += __shfl_xor(ss, 32);
        const float rs = rsqrtf(ss * (1.f / 128.f) + 1e-6f);
#pragma unroll
        for (int m = 0; m < 8; ++m) {
          const int c = hd * 128 + 16 * m + 4 * fq;
          const f32x4 nw = *(const f32x4*)(hg_norm_w + c), gg = ld4bf(p + (size_t)t * DIN + 2048 + c);
          f32x4 o;
#pragma unroll
          for (int e = 0; e < 4; ++e) o[e] = acc[m][n][e] * rs * nw[e] * siluf_(gg[e]);
          *(uint2*)(mix + (size_t)t * DM + c) = pk4(o);
        }
      }
    }
  }
}

namespace pg8 {
#define PG8_LAS __attribute__((address_space(3)))
typedef unsigned short bf16_t;
typedef short bf16x8 __attribute__((ext_vector_type(8)));
typedef float f32x4 __attribute__((ext_vector_type(4)));
typedef unsigned u32x4 __attribute__((ext_vector_type(4)));
constexpr int BM = 256, BK = 64, HALF = 128, HTB = HALF * BK * 2  , STAGE_BYTES = 8 * HTB, NXCD = 8, WGM = 8;

__host__ __device__ __forceinline__ int lds_byte(int r, int c) { const int st = (r >> 4) * 2 + (c >> 5), rr = r & 15, cc = c & 31, ob = rr * 64 + cc * 2; return st * 1024 + (ob ^ (((ob >> 9) & 1) << 5)); }
__host__ __device__ __forceinline__ void stage_rc(int b, int& R, int& C) { const int st = b / 1024, sb = b % 1024, swz = sb ^ (((sb >> 9) & 1) << 5); R = (st >> 1) * 16 + swz / 64; C = (st & 1) * 32 + (swz % 64) / 2; }
__host__ __device__ __forceinline__ int perm32(int rho) { const int n = rho >> 4, i = rho & 15; return 8 * (i >> 2) + 4 * n + (i & 3); }

struct Unit { int pm, pn; };
struct Gemm { const bf16_t* A; const bf16_t* Bt; int M, N, K; };

struct StaticOrder {
    int nM, nN, nwg, G, c;
    __host__ __device__ void init(int M, int N, int G_, int c_) { nM = M / BM; nN = N / BM; nwg = nM * nN; G = G_; c = c_; }
    __host__ __device__ bool next(int i, Unit& u) const {
        const long L = (long)i * G + c; if (L >= nwg) return false;
        int wgid = (int)L; { const int q = nwg / NXCD, r = nwg % NXCD, xcd = wgid % NXCD, off = wgid / NXCD; wgid = (xcd < r ? xcd * (q + 1) : r * (q + 1) + (xcd - r) * q) + off; }
        const int nig = WGM * nN, gid = wgid / nig, fm = gid * WGM, gsz = (nM - fm) < WGM ? (nM - fm) : WGM;
        u.pm = fm + ((wgid % nig) % gsz); u.pn = (wgid % nig) / gsz; return true;
    }
    __device__ __forceinline__ void a_ready(const Unit&) const {}
    __device__ __forceinline__ void done(const Unit&) const {}
};
struct CountedOrder : StaticOrder {
    const unsigned* ready; unsigned need; unsigned* tmo;
    __device__ __forceinline__ void a_ready(const Unit& u) const {
        if (threadIdx.x < 64) {
            const unsigned long long t0 = __builtin_amdgcn_s_memrealtime(); unsigned polls = 0;
            while ((unsigned)__builtin_amdgcn_readfirstlane(__hip_atomic_load(ready + 64 * u.pm, __ATOMIC_RELAXED, __HIP_MEMORY_SCOPE_AGENT)) < need) {
                if ((++polls & 255u) == 0u && __builtin_amdgcn_readfirstlane(__hip_atomic_load(tmo, __ATOMIC_RELAXED, __HIP_MEMORY_SCOPE_AGENT)) != 0u) break;
                if (__builtin_amdgcn_s_memrealtime() - t0 > 2000000ull) {
                    if (threadIdx.x == 0) { unsigned expect = 0u; __hip_atomic_compare_exchange_strong(tmo + 1, &expect, 0x600u | (unsigned)(u.pm & 0xff), __ATOMIC_RELAXED, __ATOMIC_RELAXED, __HIP_MEMORY_SCOPE_AGENT); __hip_atomic_store(tmo, 1u, __ATOMIC_RELAXED, __HIP_MEMORY_SCOPE_AGENT); }
                    break; }
                __builtin_amdgcn_s_sleep(2); }
            __builtin_amdgcn_fence(__ATOMIC_ACQUIRE, "agent");
            asm volatile("s_waitcnt vmcnt(0)" ::: "memory");
        }
#if !defined(BROKEN_HOOK_NO_BARRIER)
        asm volatile("" ::: "memory"); __builtin_amdgcn_s_barrier(); asm volatile("" ::: "memory");
#endif
    }
};
struct EpiF32 {
    static constexpr bool PERM = false, AFTER_DRAIN = false;
    float* C; int ldc; const float* bias;
    __device__ __forceinline__ void operator()(const f32x4 (&acc)[2][2][4][2], const Unit& u, int wr, int wc, int fr, int fq) const {
        const int row0 = u.pm * BM + wr * 64 + fr, col0 = u.pn * BM + wc * 32 + 4 * fq;
        f32x4 bv[2][2];
#pragma unroll
        for (int bj = 0; bj < 2; ++bj)
#pragma unroll
            for (int n = 0; n < 2; ++n) bv[bj][n] = bias ? *(const f32x4*)(bias + col0 + bj * HALF + n * 16) : (f32x4){0.f, 0.f, 0.f, 0.f};
#pragma unroll
        for (int ai = 0; ai < 2; ++ai)
#pragma unroll
            for (int m = 0; m < 4; ++m) { float* rowp = C + (size_t)(row0 + ai * HALF + m * 16) * ldc + col0;
#pragma unroll
                for (int bj = 0; bj < 2; ++bj)
#pragma unroll
                    for (int n = 0; n < 2; ++n) *(f32x4*)(rowp + bj * HALF + n * 16) = acc[ai][bj][m][n] + bv[bj][n]; }
    }
};
template <class Epi, class Sched, bool STAMP = false>
__device__ __forceinline__ void gemm_phase(PG8_LAS unsigned char* lds, const Gemm g, const Sched& S, const Epi& E, unsigned long long* stamps) {
    int tid_ = threadIdx.x; asm volatile("" : "+v"(tid_));
    const int tid = tid_, wid = __builtin_amdgcn_readfirstlane(tid >> 6), lane = tid & 63, wr = wid >> 2, wc = wid & 3, fr = lane & 15, fq = lane >> 4;
    const int K = g.K, nt = K / BK;
    int ts_lo = 0, ts_hi = 0, nts = 0; const unsigned long long rt_entry = STAMP ? (unsigned long long)wall_clock64() : 0ull;
#define PG8_STAMP() do { if (STAMP && wid == 0 && nts < 64) { const unsigned long long _c = (unsigned long long)clock64(); \
        ts_lo = (lane == nts) ? (int)(unsigned)_c : ts_lo; ts_hi = (lane == nts) ? (int)(unsigned)(_c >> 32) : ts_hi; ++nts; } } while (0)
    PG8_STAMP();
    unsigned voffA[2], voffB[2];
#pragma unroll
    for (int i = 0; i < 2; ++i) { int R, C; stage_rc(tid * 16 + i * 8192, R, C); const int Rb = Epi::PERM ? ((R & ~31) + perm32(R & 31)) : R;
        voffA[i] = (unsigned)(R * K + C) * 2u; voffB[i] = (unsigned)(Rb * K + C) * 2u; }
    const size_t kstep = (size_t)(BK * 2);
    const size_t hstep = (size_t)HALF * K * 2;
    const size_t tstep = 2 * hstep;
    const unsigned ldsw = (unsigned)wid * 1024u;
    const int aoff = lds_byte(wr * 64 + fr, fq * 8), boff = lds_byte(wc * 32 + fr, fq * 8);
#define PG8_SA(b, h) (((b) * 2 + (h)) * HTB)
#define PG8_SB(b, h) ((4 + (b) * 2 + (h)) * HTB)
#define PG8_STAGE(bufoff, gbase, voff) do { _Pragma("unroll") for (int _i = 0; _i < 2; ++_i) \
        __builtin_amdgcn_global_load_lds((const unsigned*)((const char*)(gbase) + (voff)[_i]), (PG8_LAS unsigned*)(lds + (bufoff) + ldsw + _i * 8192), 16, 0, 0); } while (0)
#define PG8_LDA(dst, b, h) do { _Pragma("unroll") for (int m = 0; m < 4; ++m) _Pragma("unroll") for (int k = 0; k < 2; ++k) dst[m][k] = *(const PG8_LAS bf16x8*)(lds + PG8_SA(b, h) + aoff + m * 2048 + k * 1024); } while (0)
#define PG8_LDB(dst, b, h) do { _Pragma("unroll") for (int n = 0; n < 2; ++n) _Pragma("unroll") for (int k = 0; k < 2; ++k) dst[n][k] = *(const PG8_LAS bf16x8*)(lds + PG8_SB(b, h) + boff + n * 2048 + k * 1024); } while (0)
#define PG8_MMA(ai, bj, At, Bt) do { __builtin_amdgcn_s_setprio(1); _Pragma("unroll") for (int m = 0; m < 4; ++m) _Pragma("unroll") for (int n = 0; n < 2; ++n) _Pragma("unroll") for (int k = 0; k < 2; ++k) \
        acc[ai][bj][m][n] = __builtin_amdgcn_mfma_f32_16x16x32_bf16(Bt[n][k], At[m][k], acc[ai][bj][m][n], 0, 0, 0); __builtin_amdgcn_s_setprio(0); } while (0)
#define PG8_WAIT_V(n) asm volatile("s_waitcnt vmcnt(" #n ")" ::: "memory")
#define PG8_WAIT_L(n) asm volatile("s_waitcnt lgkmcnt(" #n ")" ::: "memory")
#define PG8_BAR __builtin_amdgcn_s_barrier()
#define PG8_SCHED __builtin_amdgcn_sched_barrier(0)
    Unit cur, nxt; int ui = 0;
    if (!S.next(0, cur)) return;
    f32x4 acc[2][2][4][2];
#pragma unroll
    for (int a = 0; a < 2; ++a)
#pragma unroll
        for (int b = 0; b < 2; ++b)
#pragma unroll
            for (int m = 0; m < 4; ++m)
#pragma unroll
                for (int n = 0; n < 2; ++n) acc[a][b][m][n] = (f32x4){0.f, 0.f, 0.f, 0.f};
    bf16x8 At[4][2], B0[2][2], B1[2][2];
    const char* cA = (const char*)g.A + (size_t)cur.pm * tstep; const char* cB = (const char*)g.Bt + (size_t)cur.pn * tstep;
    S.a_ready(cur);
    PG8_STAGE(PG8_SB(0, 0), cB, voffB); PG8_STAGE(PG8_SA(0, 0), cA, voffA); PG8_STAGE(PG8_SB(0, 1), cB + hstep, voffB); PG8_STAGE(PG8_SA(0, 1), cA + hstep, voffA);
    if (wr == 1) PG8_BAR;
    PG8_WAIT_V(4); PG8_BAR;
    PG8_STAGE(PG8_SB(1, 0), cB + kstep, voffB); PG8_STAGE(PG8_SA(1, 0), cA + kstep, voffA); PG8_STAGE(PG8_SB(1, 1), cB + hstep + kstep, voffB);
    PG8_WAIT_V(6); PG8_BAR;
    PG8_STAMP();
    for (;;) {
        const bool has_next = S.next(ui + 1, nxt);
        const char* nA = has_next ? (const char*)g.A + (size_t)nxt.pm * tstep : cA; const char* nB = has_next ? (const char*)g.Bt + (size_t)nxt.pn * tstep : cB;
        for (int t = 0; t < nt; t += 2) {
            const bool last = (t == nt - 2);
            const char* a1 = cA + (size_t)(t + 1) * kstep;
            const char* a2 = last ? nA : cA + (size_t)(t + 2) * kstep; const char* b2 = last ? nB : cB + (size_t)(t + 2) * kstep;
            const char* a3 = a2 + kstep; const char* b3 = b2 + kstep;
            if (last && has_next) S.a_ready(nxt);
            PG8_LDB(B0, 0, 0); PG8_SCHED; PG8_LDA(At, 0, 0); PG8_STAGE(PG8_SA(1, 1), a1 + hstep, voffA);
            PG8_WAIT_L(8); PG8_BAR; PG8_WAIT_L(0); PG8_MMA(0, 0, At, B0); PG8_BAR; PG8_SCHED;
            PG8_LDB(B1, 0, 1); PG8_STAGE(PG8_SB(0, 0), b2, voffB);
            PG8_BAR; PG8_WAIT_L(0); PG8_MMA(0, 1, At, B1); PG8_BAR;
            PG8_LDA(At, 0, 1); PG8_STAGE(PG8_SA(0, 0), a2, voffA);
            PG8_BAR; PG8_WAIT_L(0); PG8_MMA(1, 0, At, B0); PG8_BAR; PG8_SCHED;
            PG8_STAGE(PG8_SB(0, 1), b2 + hstep, voffB);
            PG8_WAIT_V(6); PG8_BAR; PG8_MMA(1, 1, At, B1); PG8_BAR;
            PG8_LDB(B0, 1, 0); PG8_SCHED; PG8_LDA(At, 1, 0); PG8_STAGE(PG8_SA(0, 1), a2 + hstep, voffA);
            PG8_WAIT_L(8); PG8_BAR; PG8_WAIT_L(0); PG8_MMA(0, 0, At, B0); PG8_BAR; PG8_SCHED;
            PG8_LDB(B1, 1, 1); PG8_STAGE(PG8_SB(1, 0), b3, voffB);
            PG8_BAR; PG8_WAIT_L(0); PG8_MMA(0, 1, At, B1); PG8_BAR;
            PG8_LDA(At, 1, 1); PG8_STAGE(PG8_SA(1, 0), a3, voffA);
            PG8_BAR; PG8_WAIT_L(0); PG8_MMA(1, 0, At, B0); PG8_BAR; PG8_SCHED;
            PG8_STAGE(PG8_SB(1, 1), b3 + hstep, voffB);
            PG8_WAIT_V(6); PG8_BAR; PG8_MMA(1, 1, At, B1); PG8_BAR;
        }
        PG8_STAMP();
        if constexpr (!Epi::AFTER_DRAIN) { E(acc, cur, wr, wc, fr, fq); S.done(cur); }
        PG8_STAMP();
        if (!has_next) break;
#pragma unroll
        for (int a = 0; a < 2; ++a)
#pragma unroll
            for (int b = 0; b < 2; ++b)
#pragma unroll
                for (int m = 0; m < 4; ++m)
#pragma unroll
                    for (int n = 0; n < 2; ++n) acc[a][b][m][n] = (f32x4){0.f, 0.f, 0.f, 0.f};
        cur = nxt; cA = nA; cB = nB; ++ui;
    }
    PG8_WAIT_V(0);
    if (wr == 0) PG8_BAR;
    PG8_BAR;
    if constexpr (Epi::AFTER_DRAIN) { E.fused(acc, cur, wr, wc, fr, fq, lds, wid, lane); S.done(cur); }
    PG8_STAMP();
    if (STAMP && wid == 0) { stamps[lane] = lane < nts ? (((unsigned long long)(unsigned)ts_hi << 32) | (unsigned)ts_lo) : 0ull;
        if (lane == 62) stamps[62] = rt_entry; if (lane == 63) stamps[63] = (unsigned long long)wall_clock64(); }
#undef PG8_STAMP
#undef PG8_SA
#undef PG8_SB
#undef PG8_STAGE
#undef PG8_LDA
#undef PG8_LDB
#undef PG8_MMA
#undef PG8_WAIT_V
#undef PG8_WAIT_L
#undef PG8_BAR
#undef PG8_SCHED
}
template <class Epi, class Sched, class Gat, bool STAMP = false>
__device__ __forceinline__ void gemm_phase_gather(PG8_LAS unsigned char* lds, const Gemm g, const Sched& S, const Epi& E, const Gat& G, unsigned long long* stamps) {
    int tid_ = threadIdx.x; asm volatile("" : "+v"(tid_));
    const int tid = tid_, wid = __builtin_amdgcn_readfirstlane(tid >> 6), lane = tid & 63, wr = wid >> 2, wc = wid & 3, fr = lane & 15, fq = lane >> 4;
    const int K = g.K, nt = K / BK;
    int ts_lo = 0, ts_hi = 0, nts = 0; const unsigned long long rt_entry = STAMP ? (unsigned long long)wall_clock64() : 0ull;
#define PG8_STAMP() do { if (STAMP && wid == 0 && nts < 64) { const unsigned long long _c = (unsigned long long)clock64(); \
        ts_lo = (lane == nts) ? (int)(unsigned)_c : ts_lo; ts_hi = (lane == nts) ? (int)(unsigned)(_c >> 32) : ts_hi; ++nts; } } while (0)
    PG8_STAMP();
    unsigned voffA[2], voffB[2]; int RA[2]; unsigned CA2[2];
#pragma unroll
    for (int i = 0; i < 2; ++i) { int R, C; stage_rc(tid * 16 + i * 8192, R, C); const int Rb = Epi::PERM ? ((R & ~31) + perm32(R & 31)) : R;
        voffA[i] = (unsigned)(R * K + C) * 2u; voffB[i] = (unsigned)(Rb * K + C) * 2u; RA[i] = R; CA2[i] = (unsigned)C * 2u; }
    const size_t kstep = (size_t)(BK * 2);
    const size_t hstep = (size_t)HALF * K * 2;
    const size_t tstep = 2 * hstep;
    const unsigned ldsw = (unsigned)wid * 1024u;
    const int aoff = lds_byte(wr * 64 + fr, fq * 8), boff = lds_byte(wc * 32 + fr, fq * 8);
#define PG8_SA(b, h) (((b) * 2 + (h)) * HTB)
#define PG8_SB(b, h) ((4 + (b) * 2 + (h)) * HTB)
#define PG8_STAGE(bufoff, gbase, voff) do { _Pragma("unroll") for (int _i = 0; _i < 2; ++_i) \
        __builtin_amdgcn_global_load_lds((const unsigned*)((const char*)(gbase) + (voff)[_i]), (PG8_LAS unsigned*)(lds + (bufoff) + ldsw + _i * 8192), 16, 0, 0); } while (0)
#define PG8_LDA(dst, b, h) do { _Pragma("unroll") for (int m = 0; m < 4; ++m) _Pragma("unroll") for (int k = 0; k < 2; ++k) dst[m][k] = *(const PG8_LAS bf16x8*)(lds + PG8_SA(b, h) + aoff + m * 2048 + k * 1024); } while (0)
#define PG8_LDB(dst, b, h) do { _Pragma("unroll") for (int n = 0; n < 2; ++n) _Pragma("unroll") for (int k = 0; k < 2; ++k) dst[n][k] = *(const PG8_LAS bf16x8*)(lds + PG8_SB(b, h) + boff + n * 2048 + k * 1024); } while (0)
#define PG8_MMA(ai, bj, At, Bt) do { __builtin_amdgcn_s_setprio(1); _Pragma("unroll") for (int m = 0; m < 4; ++m) _Pragma("unroll") for (int n = 0; n < 2; ++n) _Pragma("unroll") for (int k = 0; k < 2; ++k) \
        acc[ai][bj][m][n] = __builtin_amdgcn_mfma_f32_16x16x32_bf16(Bt[n][k], At[m][k], acc[ai][bj][m][n], 0, 0, 0); __builtin_amdgcn_s_setprio(0); } while (0)
#define PG8_WAIT_V(n) asm volatile("s_waitcnt vmcnt(" #n ")" ::: "memory")
#define PG8_WAIT_L(n) asm volatile("s_waitcnt lgkmcnt(" #n ")" ::: "memory")
#define PG8_BAR __builtin_amdgcn_s_barrier()
#define PG8_SCHED __builtin_amdgcn_sched_barrier(0)
    Unit cur, nxt; int ui = 0;
    if (!S.next(0, cur)) return;
    f32x4 acc[2][2][4][2];
#pragma unroll
    for (int a = 0; a < 2; ++a)
#pragma unroll
        for (int b = 0; b < 2; ++b)
#pragma unroll
            for (int m = 0; m < 4; ++m)
#pragma unroll
                for (int n = 0; n < 2; ++n) acc[a][b][m][n] = (f32x4){0.f, 0.f, 0.f, 0.f};
    bf16x8 At[4][2], B0[2][2], B1[2][2];
    const char* Ab = (const char*)g.A; const char* cB = (const char*)g.Bt + (size_t)cur.pn * tstep;
    unsigned gc0[2], gc1[2], gn0[2], gn1[2];
#pragma unroll
    for (int i = 0; i < 2; ++i) { gc0[i] = G.rowoff(cur, RA[i]) + CA2[i]; gc1[i] = G.rowoff(cur, RA[i] + 128) + CA2[i]; }
    (void)voffA;
    S.a_ready(cur);
    PG8_STAGE(PG8_SB(0, 0), cB, voffB); PG8_STAGE(PG8_SA(0, 0), Ab, gc0); PG8_STAGE(PG8_SB(0, 1), cB + hstep, voffB); PG8_STAGE(PG8_SA(0, 1), Ab, gc1);
    if (wr == 1) PG8_BAR;
    PG8_WAIT_V(4); PG8_BAR;
    PG8_STAGE(PG8_SB(1, 0), cB + kstep, voffB); PG8_STAGE(PG8_SA(1, 0), Ab + kstep, gc0); PG8_STAGE(PG8_SB(1, 1), cB + hstep + kstep, voffB);
    PG8_WAIT_V(6); PG8_BAR;
    PG8_STAMP();
    for (;;) {
        const bool has_next = S.next(ui + 1, nxt);
        const char* nB = has_next ? (const char*)g.Bt + (size_t)nxt.pn * tstep : cB;
#pragma unroll
        for (int i = 0; i < 2; ++i) { gn0[i] = has_next ? G.rowoff(nxt, RA[i]) + CA2[i] : gc0[i]; gn1[i] = has_next ? G.rowoff(nxt, RA[i] + 128) + CA2[i] : gc1[i]; }
        for (int t = 0; t < nt; t += 2) {
            const bool last = (t == nt - 2);
            const char* a1 = Ab + (size_t)(t + 1) * kstep;
            const char* a2 = last ? Ab : Ab + (size_t)(t + 2) * kstep; const char* b2 = last ? nB : cB + (size_t)(t + 2) * kstep;
            unsigned g2a[2], g2b[2];
#pragma unroll
            for (int i = 0; i < 2; ++i) { g2a[i] = last ? gn0[i] : gc0[i]; g2b[i] = last ? gn1[i] : gc1[i]; }
            const char* a3 = a2 + kstep; const char* b3 = b2 + kstep;
            if (last && has_next) S.a_ready(nxt);
            PG8_LDB(B0, 0, 0); PG8_SCHED; PG8_LDA(At, 0, 0); PG8_STAGE(PG8_SA(1, 1), a1, gc1);
            PG8_WAIT_L(8); PG8_BAR; PG8_WAIT_L(0); PG8_MMA(0, 0, At, B0); PG8_BAR; PG8_SCHED;
            PG8_LDB(B1, 0, 1); PG8_STAGE(PG8_SB(0, 0), b2, voffB);
            PG8_BAR; PG8_WAIT_L(0); PG8_MMA(0, 1, At, B1); PG8_BAR;
            PG8_LDA(At, 0, 1); PG8_STAGE(PG8_SA(0, 0), a2, g2a);
            PG8_BAR; PG8_WAIT_L(0); PG8_MMA(1, 0, At, B0); PG8_BAR; PG8_SCHED;
            PG8_STAGE(PG8_SB(0, 1), b2 + hstep, voffB);
            PG8_WAIT_V(6); PG8_BAR; PG8_MMA(1, 1, At, B1); PG8_BAR;
            PG8_LDB(B0, 1, 0); PG8_SCHED; PG8_LDA(At, 1, 0); PG8_STAGE(PG8_SA(0, 1), a2, g2b);
            PG8_WAIT_L(8); PG8_BAR; PG8_WAIT_L(0); PG8_MMA(0, 0, At, B0); PG8_BAR; PG8_SCHED;
            PG8_LDB(B1, 1, 1); PG8_STAGE(PG8_SB(1, 0), b3, voffB);
            PG8_BAR; PG8_WAIT_L(0); PG8_MMA(0, 1, At, B1); PG8_BAR;
            PG8_LDA(At, 1, 1); PG8_STAGE(PG8_SA(1, 0), a3, g2a);
            PG8_BAR; PG8_WAIT_L(0); PG8_MMA(1, 0, At, B0); PG8_BAR; PG8_SCHED;
            PG8_STAGE(PG8_SB(1, 1), b3 + hstep, voffB);
            PG8_WAIT_V(6); PG8_BAR; PG8_MMA(1, 1, At, B1); PG8_BAR;
        }
        PG8_STAMP();
        if constexpr (!Epi::AFTER_DRAIN) { E(acc, cur, wr, wc, fr, fq); S.done(cur); }
        PG8_STAMP();
        if (!has_next) break;
#pragma unroll
        for (int a = 0; a < 2; ++a)
#pragma unroll
            for (int b = 0; b < 2; ++b)
#pragma unroll
                for (int m = 0; m < 4; ++m)
#pragma unroll
                    for (int n = 0; n < 2; ++n) acc[a][b][m][n] = (f32x4){0.f, 0.f, 0.f, 0.f};
        cur = nxt; cB = nB; ++ui;
#pragma unroll
        for (int i = 0; i < 2; ++i) { gc0[i] = gn0[i]; gc1[i] = gn1[i]; }
    }
    PG8_WAIT_V(0);
    if (wr == 0) PG8_BAR;
    PG8_BAR;
    if constexpr (Epi::AFTER_DRAIN) { E.fused(acc, cur, wr, wc, fr, fq, lds, wid, lane); S.done(cur); }
    PG8_STAMP();
    if (STAMP && wid == 0) { stamps[lane] = lane < nts ? (((unsigned long long)(unsigned)ts_hi << 32) | (unsigned)ts_lo) : 0ull;
        if (lane == 62) stamps[62] = rt_entry; if (lane == 63) stamps[63] = (unsigned long long)wall_clock64(); }
#undef PG8_STAMP
#undef PG8_SA
#undef PG8_SB
#undef PG8_STAGE
#undef PG8_LDA
#undef PG8_LDB
#undef PG8_MMA
#undef PG8_WAIT_V
#undef PG8_WAIT_L
#undef PG8_BAR
#undef PG8_SCHED
}
}

constexpr size_t WS_WINT = 284 * MB;
constexpr size_t WS_WOUTT = 1 * MB;
constexpr int NPAD_IN = 4352;
DI void transpose_tile(const float* W, int ldw, int k0, int n0, int nvalid, bfr* WT, int ldt, char* smem) {
  short* T = (short*)smem;
  const int tid = VT;
  __syncthreads();
  {
    const int r = tid >> 2, c4 = tid & 3;
#pragma unroll
    for (int q = 0; q < 4; ++q) {
      const int n = n0 + 16 * c4 + 4 * q;
      f32x4 v = {0.f, 0.f, 0.f, 0.f};
      if (n < nvalid) v = *(const f32x4*)(W + (size_t)(k0 + r) * ldw + n);
#pragma unroll
      for (int e = 0; e < 4; ++e) T[r * 66 + 16 * c4 + 4 * q + e] = (short)f2bf(v[e]);
    }
  }
  __syncthreads();
  {
    const int n = tid >> 2, kq = tid & 3;
    unsigned wv[8];
#pragma unroll
    for (int e = 0; e < 8; ++e) wv[e] = ((unsigned)(unsigned short)T[(16 * kq + 2 * e) * 66 + n]) | (((unsigned)(unsigned short)T[(16 * kq + 2 * e + 1) * 66 + n]) << 16);
    bfr* dst = WT + (size_t)(n0 + n) * ldt + k0 + 16 * kq;
    *(uint4*)dst = uint4{wv[0], wv[1], wv[2], wv[3]};
    *(uint4*)(dst + 8) = uint4{wv[4], wv[5], wv[6], wv[7]};
  }
}
template <int LDC, int NVALID> struct EpiBf16T {
  static constexpr bool PERM = true, AFTER_DRAIN = false;
  bfr* O;
  DI void operator()(const pg8::f32x4 (&acc)[2][2][4][2], const pg8::Unit& u, int wr, int wc, int fr, int fq) const {
    const int row0 = u.pm * 256 + wr * 64 + fr, col0 = u.pn * 256 + wc * 32 + 8 * fq;
#pragma unroll
    for (int ai = 0; ai < 2; ++ai)
#pragma unroll
      for (int m = 0; m < 4; ++m) {
        bfr* rowp = O + (size_t)(row0 + ai * 128 + m * 16) * LDC + col0;
#pragma unroll
        for (int bj = 0; bj < 2; ++bj) {
          if (col0 + bj * 128 < NVALID) {
            const pg8::f32x4 v0 = acc[ai][bj][m][0], v1 = acc[ai][bj][m][1];
            *(uint4*)(rowp + bj * 128) = uint4{pack2(v0[0], v0[1]), pack2(v0[2], v0[3]), pack2(v1[0], v1[1]), pack2(v1[2], v1[3])};
          }
        }
      }
  }
};
DI void phase_pgemm8(CParams& P, char* smem_all) {
  pg8::Gemm g{(const pg8::bf16_t*)(P.ws + WS_H), (const pg8::bf16_t*)(P.ws + WS_WINT), T_ALL, NPAD_IN, DM};
  pg8::StaticOrder S; S.init(T_ALL, NPAD_IN, (int)gridDim.x, (int)blockIdx.x);
  typedef EpiBf16T<DIN, DIN> EpiP;
  EpiP E{(bfr*)(P.ws + WS_P)};
  pg8::gemm_phase<EpiP, pg8::StaticOrder>((PG8_LAS unsigned char*)smem_all, g, S, E, nullptr);
}
DI void phase_outproj8(CParams& P, char* smem_all) {
  pg8::Gemm g{(const pg8::bf16_t*)(P.ws + WS_MIX), (const pg8::bf16_t*)(P.ws + WS_WOUTT), T_LAT, DM, DM};
  pg8::StaticOrder S; S.init(T_LAT, DM, (int)gridDim.x, (int)blockIdx.x);
  typedef EpiBf16T<DM, DM> EpiY;
  EpiY E{(bfr*)(P.ws + WS_Y)};
  pg8::gemm_phase<EpiY, pg8::StaticOrder>((PG8_LAS unsigned char*)smem_all, g, S, E, nullptr);
}


constexpr size_t WS_BTGU = 350 * MB;
constexpr size_t WS_BTD = 284 * MB;
constexpr size_t WS_HID8 = 138 * MB;
constexpr size_t WS_MOUT8 = 42 * MB;
constexpr int TAB_LDS_OFF = 131072 + 1024;

DI void transpose_quad(const float* W, int ldw, int k0, int n0, bfr* WT, int ldt, int dr0, int dr1, int dr2, int dr3, char* smem, int nvalid = 1 << 30) {
  short* T = (short*)smem;
  const int tid = VT;
  const int r = tid >> 2, c4 = tid & 3;
  f32x4 v[4][4];
#pragma unroll
  for (int j = 0; j < 4; ++j)
#pragma unroll
    for (int q = 0; q < 4; ++q) { const int n_ = n0 + j * 64 + 16 * c4 + 4 * q; v[j][q] = n_ < nvalid ? *(const f32x4*)(W + (size_t)(k0 + r) * ldw + n_) : f32x4{0.f, 0.f, 0.f, 0.f}; }
  __syncthreads();
#pragma unroll
  for (int j = 0; j < 4; ++j)
#pragma unroll
    for (int q = 0; q < 4; ++q)
#pragma unroll
      for (int e = 0; e < 4; ++e) T[j * 64 * 66 + r * 66 + 16 * c4 + 4 * q + e] = (short)f2bf(v[j][q][e]);
  __syncthreads();
  const int n = tid >> 2, kq = tid & 3;
#pragma unroll
  for (int j = 0; j < 4; ++j) {
    unsigned wv[8];
#pragma unroll
    for (int e = 0; e < 8; ++e) wv[e] = ((unsigned)(unsigned short)T[j * 64 * 66 + (16 * kq + 2 * e) * 66 + n]) | (((unsigned)(unsigned short)T[j * 64 * 66 + (16 * kq + 2 * e + 1) * 66 + n]) << 16);
    const int dr = j == 0 ? dr0 : j == 1 ? dr1 : j == 2 ? dr2 : dr3;
    bfr* dst = WT + (size_t)(dr + n) * ldt + k0 + 16 * kq;
    *(uint4*)dst = uint4{wv[0], wv[1], wv[2], wv[3]};
    *(uint4*)(dst + 8) = uint4{wv[4], wv[5], wv[6], wv[7]};
  }
}
DI void phase_moe_convert_gu(CParams& P, int bid, int nb, char* smem) {
  for (int it = bid; it < 64 * 64; it += nb) {
    const int e = it >> 6, s = it & 63;
    const int isup = s >> 5, kt = (s & 31) >> 1, nq = s & 1;
    const float* W = (isup ? P.in[30] : P.in[29]) + (size_t)e * DM * DEXP;
    bfr* WT = (bfr*)(P.ws + WS_BTGU) + (size_t)e * 1024 * 1024;
    const int b = nq * 4;
    transpose_quad(W, DEXP, kt * 64, nq * 256, WT, 1024,
                   ((b + 0) >> 1) * 256 + isup * 128 + ((b + 0) & 1) * 64, ((b + 1) >> 1) * 256 + isup * 128 + ((b + 1) & 1) * 64,
                   ((b + 2) >> 1) * 256 + isup * 128 + ((b + 2) & 1) * 64, ((b + 3) >> 1) * 256 + isup * 128 + ((b + 3) & 1) * 64, smem);
  }
}
DI void phase_moe_convert_d(CParams& P, int bid, int nb, char* smem) {
  for (int it = bid; it < 64 * 32; it += nb) {
    const int e = it >> 5, s2 = it & 31, kt = s2 >> 2, nq = s2 & 3;
    const float* W = P.in[31] + (size_t)e * DEXP * DM;
    bfr* WT = (bfr*)(P.ws + WS_BTD) + (size_t)e * 1024 * 512;
    transpose_quad(W, DM, kt * 64, nq * 256, WT, 512, nq * 256, nq * 256 + 64, nq * 256 + 128, nq * 256 + 192, smem);
  }
}
DI void moe_block_table256(CParams& P, int* tab  ) {
  const int* cnt = (const int*)(P.ws + WS_CNT);
  __syncthreads();
  const int t = tx_();
  if (t < 64) {
    int incl = (cnt[t] + 255) >> 8;
#pragma unroll
    for (int o = 1; o < 64; o <<= 1) { int u = __shfl_up(incl, o); if (t >= o) incl += u; }
    tab[t + 1] = incl;
    if (t == 0) tab[0] = 0;
  }
  __syncthreads();
}
struct MoeOrder {
  const int* tab; int nunits, G, c;
  DI bool next(int i, pg8::Unit& u) const {
    const int L = i * G + c; if (L >= nunits) return false;
    const int rb = L >> 2; int e = 0; while (tab[e + 1] <= rb) ++e;
    u.pm = rb; u.pn = e * 4 + (L & 3); return true;
  }
  DI void a_ready(const pg8::Unit&) const {}
  DI void done(const pg8::Unit&) const {}
};
struct EpiHid {
  static constexpr bool PERM = true, AFTER_DRAIN = false;
  bfr* H;
  DI void operator()(const pg8::f32x4 (&acc)[2][2][4][2], const pg8::Unit& u, int wr, int wc, int fr, int fq) const {
    const int row0 = u.pm * 256 + wr * 64 + fr, col0 = (u.pn & 3) * 128 + wc * 32 + 8 * fq;
#pragma unroll
    for (int ai = 0; ai < 2; ++ai)
#pragma unroll
      for (int m = 0; m < 4; ++m) {
        float hv[8];
#pragma unroll
        for (int n = 0; n < 2; ++n)
#pragma unroll
          for (int j = 0; j < 4; ++j) hv[4 * n + j] = siluf_(acc[ai][0][m][n][j]) * acc[ai][1][m][n][j];
        *(uint4*)(H + (size_t)(row0 + ai * 128 + m * 16) * DEXP + col0) = uint4{pack2(hv[0], hv[1]), pack2(hv[2], hv[3]), pack2(hv[4], hv[5]), pack2(hv[6], hv[7])};
      }
  }
};
struct EpiMout {
  static constexpr bool PERM = true, AFTER_DRAIN = false;
  bfr* O; const int* tab; const int* cnt; const int* list;
  DI void operator()(const pg8::f32x4 (&acc)[2][2][4][2], const pg8::Unit& u, int wr, int wc, int fr, int fq) const {
    const int e = u.pn >> 2, pnl = u.pn & 3;
    const int lrow0 = (u.pm - tab[e]) * 256 + wr * 64 + fr, ce = cnt[e];
    const int col0 = pnl * 256 + wc * 32 + 8 * fq;
#pragma unroll
    for (int ai = 0; ai < 2; ++ai)
#pragma unroll
      for (int m = 0; m < 4; ++m) {
        const int idx = lrow0 + ai * 128 + m * 16;
        if (idx < ce) {
          const int asg = list[e * T_LAT + idx];
          bfr* rowp = O + (size_t)asg * DM + col0;
#pragma unroll
          for (int bj = 0; bj < 2; ++bj) {
            const pg8::f32x4 v0 = acc[ai][bj][m][0], v1 = acc[ai][bj][m][1];
            *(uint4*)(rowp + bj * 128) = uint4{pack2(v0[0], v0[1]), pack2(v0[2], v0[3]), pack2(v1[0], v1[1]), pack2(v1[2], v1[3])};
          }
        }
      }
  }
};
struct MoeGather {
  const int* tab; const int* cnt; const int* list;
  DI unsigned rowoff(const pg8::Unit& u, int r) const {
    const int e = u.pn >> 2, idx = (u.pm - tab[e]) * 256 + r;
    const int tok = idx < cnt[e] ? (list[e * T_LAT + idx] >> 1) : 0;
    return (unsigned)tok * (unsigned)(DM * 2);
  }
};
DI void phase_moe1_8(CParams& P, char* smem_all) {
  int* tab = (int*)(smem_all + TAB_LDS_OFF);
  moe_block_table256(P, tab);
  const int nrb = tab[64];
  pg8::Gemm g{(const pg8::bf16_t*)(P.ws + WS_H2), (const pg8::bf16_t*)(P.ws + WS_BTGU), nrb * 256, 64 * 1024, DM};
  MoeOrder S{tab, nrb * 4, (int)gridDim.x, (int)blockIdx.x};
  EpiHid E{(bfr*)(P.ws + WS_HID8)};
  MoeGather G{tab, (const int*)(P.ws + WS_CNT), (const int*)(P.ws + WS_LIST)};
  pg8::gemm_phase_gather<EpiHid, MoeOrder, MoeGather>((PG8_LAS unsigned char*)smem_all, g, S, E, G, nullptr);
}
DI void phase_moe2_8(CParams& P, char* smem_all) {
  int* tab = (int*)(smem_all + TAB_LDS_OFF);
  moe_block_table256(P, tab);
  const int nrb = tab[64];
  pg8::Gemm g{(const pg8::bf16_t*)(P.ws + WS_HID8), (const pg8::bf16_t*)(P.ws + WS_BTD), nrb * 256, 64 * 1024, DEXP};
  MoeOrder S{tab, nrb * 4, (int)gridDim.x, (int)blockIdx.x};
  EpiMout E{(bfr*)(P.ws + WS_MOUT8), tab, (const int*)(P.ws + WS_CNT), (const int*)(P.ws + WS_LIST)};
  pg8::gemm_phase<EpiMout, MoeOrder>((PG8_LAS unsigned char*)smem_all, g, S, E, nullptr);
}

#define XB_TMO      128
#define XB_XCNT(j)  (256  + 64 * (j))
#define XB_XSUB(j)  (1280 + 64 * (j))
#define XB_XGEN(j)  (2304 + 64 * (j))
#define XB_TOP      3328
#define XB_TOPGEN   3392
#define XCD_BAR_WORDS 3456
#define XB_SPIN_CAP (1u << 22)
#define LAS __attribute__((address_space(3)))
DI unsigned xb_ld(unsigned* p)              { return __hip_atomic_load(p, __ATOMIC_RELAXED, __HIP_MEMORY_SCOPE_AGENT); }
DI unsigned xb_add(unsigned* p, unsigned v) { return __hip_atomic_fetch_add(p, v, __ATOMIC_RELAXED, __HIP_MEMORY_SCOPE_AGENT); }
DI unsigned xb_xcc_id() { return (unsigned)__builtin_amdgcn_s_getreg((3 << 11) | 20) & 0xFu; }
#define XB_SPIN(cond, bar) do { unsigned _sp = 0; while (cond) { __builtin_amdgcn_s_sleep(1); \
    if ((++_sp & 255u) == 0u) { if (xb_ld(&(bar)[XB_TMO])) break; if (_sp > XB_SPIN_CAP) { atomicAdd(&(bar)[XB_TMO], 1u); break; } } } } while (0)
struct XcdBarrier { unsigned* bar; unsigned x; volatile LAS unsigned* st; };
DI XcdBarrier xcd_barrier_post(unsigned* bar, volatile LAS unsigned* st) {
  XcdBarrier b; b.bar = bar; b.x = xb_xcc_id(); b.st = st;
  if (threadIdx.x == 0) (void)xb_add(&bar[XB_XCNT(b.x)], 1u);
  return b;
}
DI void xcd_barrier_complete(unsigned* bar, unsigned x, unsigned& nloc, unsigned& nx) {
  const unsigned G = gridDim.x * gridDim.y * gridDim.z;
  unsigned sum, cnt, mine, sp = 0u;
  for (;;) {
    sum = 0u; cnt = 0u; mine = 0u;
#pragma unroll
    for (unsigned j = 0; j < 16; ++j) { const unsigned c = xb_ld(&bar[XB_XCNT(j)]); sum += c; cnt += (c > 0u) ? 1u : 0u; mine = (j == x) ? c : mine; }
    if (sum == G) break;
    __builtin_amdgcn_s_sleep(1);
    if ((++sp & 255u) == 0u) { if (xb_ld(&bar[XB_TMO])) break; if (sp > XB_SPIN_CAP) { atomicAdd(&bar[XB_TMO], 1u); break; } }
  }
  nloc = mine > 0u ? mine : 1u; nx = cnt > 0u ? cnt : 1u;
}
DI void xcd_barrier(const XcdBarrier& b) {
  asm volatile("s_waitcnt vmcnt(0)" ::: "memory");
  __syncthreads();
  if (threadIdx.x == 0) {
    unsigned* bar = b.bar;
    __builtin_amdgcn_s_waitcnt(0);
    unsigned nloc = b.st[0], nx = b.st[1];
    if (nloc == 0u) { xcd_barrier_complete(bar, b.x, nloc, nx); b.st[0] = nloc; b.st[1] = nx; }
    const unsigned old = xb_add(&bar[XB_XSUB(b.x)], 1u);
    const unsigned gen = old / nloc;
    if (old + 1u == (gen + 1u) * nloc) {
      __builtin_amdgcn_fence(__ATOMIC_RELEASE, "agent");
      asm volatile("s_waitcnt vmcnt(0)" ::: "memory");
      const unsigned og = xb_add(&bar[XB_TOP], 1u);
      const unsigned tg = og / nx;
      if (og + 1u == (tg + 1u) * nx) xb_add(&bar[XB_TOPGEN], 1u);
      else XB_SPIN(xb_ld(&bar[XB_TOPGEN]) == tg, bar);
      __builtin_amdgcn_fence(__ATOMIC_ACQUIRE, "agent");
      xb_add(&bar[XB_XGEN(b.x)], 1u);
      asm volatile("s_waitcnt vmcnt(0)" ::: "memory");
    } else {
      XB_SPIN(xb_ld(&bar[XB_XGEN(b.x)]) == gen, bar);
      __builtin_amdgcn_fence(__ATOMIC_ACQUIRE, "agent");
      asm volatile("s_waitcnt vmcnt(0)" ::: "memory");
    }
  }
  __syncthreads();
}

namespace cg = cooperative_groups;
constexpr int HALF_LDS = 78080;
constexpr int SMEM_BYTES = 2 * HALF_LDS + 16;
__global__ void __launch_bounds__(NTHR_BLOCK) k_fused(Params Pval) {
  __shared__ __attribute__((aligned(16))) char smem_all[SMEM_BYTES];
  cg::grid_group grid = cg::this_grid();
  CParams* kp0 = (CParams*)__builtin_amdgcn_kernarg_segment_ptr();
#define PH(call) do { CParams* kp_ = kp0; asm volatile("" : "+s"(kp_)); CParams& P = *kp_; \
    int half = __builtin_amdgcn_readfirstlane((int)(threadIdx.x >> 8)); asm volatile("" : "+s"(half)); \
    char* smem = smem_all + half * HALF_LDS; const int bid = blockIdx.x * 2 + half, nb = gridDim.x * 2; (void)smem; (void)bid; (void)nb; call; } while (0)
  volatile LAS unsigned* bst = (volatile LAS unsigned*)(smem_all + SMEM_BYTES - 16);
  if (threadIdx.x < 4) bst[threadIdx.x] = 0u;
  __syncthreads();
  XcdBarrier xb = xcd_barrier_post(Pval.bar, bst);
#define GSYNC() do { if (Pval.use_cg) grid.sync(); else xcd_barrier(xb); } while (0)
  PH(phase_mod(P, bid, nb, smem));
  GSYNC();
  PH(phase_ln1(P, bid, nb));
  GSYNC();
  PH(phase_pgemm8(P, smem_all));
  GSYNC();
  PH(phase_rwprep(P, bid, nb, smem));
  GSYNC();
  PH(for (int it = bid; it < 16 * RW_NSC; it += nb) rw_levelA_item(P, it / RW_NSC, it % RW_NSC, smem));
  PH(for (int it = bid; it < 8 * HG_NSC; it += nb) hg_levelA_item(P, it / HG_NSC, it % HG_NSC, smem));
  GSYNC();
  PH(if (bid < 16) rw_levelB_chain(P, bid, smem); else { hg_levelB(P, bid - 16, nb - 16); phase_moe_convert_d(P, bid - 16, nb - 16, smem); });
  GSYNC();
  PH(phase_readout_fused(P, bid, nb));
  GSYNC();
  PH(phase_outproj8(P, smem_all));
  PH(phase_moe_convert_gu(P, bid, nb, smem));
  GSYNC();
  PH(phase_ln2route(P, smem_all));
  GSYNC();
  PH(phase_moe1_8(P, smem_all));
  GSYNC();
  PH(phase_moe2_8(P, smem_all));
  GSYNC();
  PH(phase_final(P, bid, nb));
}

extern "C" void kernel_launch(void* const* d_in, const int* in_sizes, int n_in, void* d_out, int out_size, void* d_ws, size_t ws_size, hipStream_t stream) {
  static int grid_blocks = 0;
  if (!grid_blocks) {
    int dev = 0, cus = 0, per_cu = 0;
    hipGetDevice(&dev);
    hipDeviceGetAttribute(&cus, hipDeviceAttributeMultiprocessorCount, dev);
    hipOccupancyMaxActiveBlocksPerMultiprocessor(&per_cu, k_fused, NTHR_BLOCK, 0);
    if (per_cu > 1) per_cu = 1;
    if (per_cu < 1) per_cu = 1;
    grid_blocks = cus * per_cu;
  }
  Params P{};
  P.bar = (unsigned*)((char*)d_ws + WS_BAR); P.use_cg = 0; P.pad = 0;
  hipMemsetAsync((char*)d_ws + WS_BAR, 0, XCD_BAR_WORDS * 4, stream);
  for (int i = 0; i < 32; ++i) P.in[i] = (const float*)d_in[i];
  P.out = (float*)d_out; P.ws = (char*)d_ws;
  void* args[] = {&P};
  hipError_t e = hipLaunchCooperativeKernel((void*)k_fused, dim3(grid_blocks), dim3(NTHR_BLOCK), args, 0, stream);
  if (e != hipSuccess) fprintf(stderr, "cooperative launch failed: %s (grid %d)\n", hipGetErrorString(e), grid_blocks);
}
```

```cpp
#include <hip/hip_runtime.h>
#include <hip/hip_cooperative_groups.h>
#include <cstdio>

typedef __attribute__((ext_vector_type(8))) short bf16x8;
typedef __attribute__((ext_vector_type(4))) short s16x4;
typedef __attribute__((ext_vector_type(4))) float f32x4;
typedef __attribute__((ext_vector_type(2))) float f32x2;
typedef __attribute__((ext_vector_type(2))) __bf16 bf16x2_t;
typedef unsigned short bfr;

#define DI __device__ __forceinline__

constexpr int T_LAT = 16384, T_CTX = 256, T_ALL = T_LAT + T_CTX;
constexpr int DM = 1024, DIN = 4288, HGC = 2560, RWC = 1728, DRW = 512, DHG = 512;
constexpr int NEXP = 64, DEXP = 512;
constexpr int NTHR = 256;
constexpr int NTHR_BLOCK = 512;
#define VT ((int)(threadIdx.x & 255))
__device__ __forceinline__ int tx_() { int t = (int)threadIdx.x; asm volatile("" : "+v"(t)); return t; }
constexpr float DN_ALPHA = 1.189207115002721f;
constexpr float RW_DECAY_SCALE = 0.6065306597126334f;

constexpr size_t MB = 1ull << 20;
constexpr size_t WS_MOD = 0;
constexpr size_t WS_MODC = 32768;
constexpr size_t WS_LB = 65536;
constexpr size_t WS_CNT = 65536 + 8192;
constexpr size_t WS_BAR = 81920;
constexpr size_t WS_ASGW = 131072;
constexpr size_t WS_LIST = 1 * MB;
constexpr size_t WS_H = 6 * MB;
constexpr size_t WS_P = 42 * MB;
constexpr size_t WS_Y = 42 * MB;
constexpr size_t WS_H2 = 106 * MB;
constexpr size_t WS_RW = 186 * MB;
constexpr size_t RW_ARR = (size_t)T_ALL * 512 * 2;
constexpr size_t WS_X1B = 6 * MB;
constexpr size_t WS_MIX = WS_RW + 3 * RW_ARR;
constexpr size_t WS_LW = 284 * MB;
constexpr size_t LW_ARR = (size_t)T_ALL * 512 * 4;

struct Params {
  const float* in[32];
  float* out;
  char* ws;
  unsigned* bar;
  int use_cg;
  int pad;
};
typedef const __attribute__((address_space(4))) Params CParams;

DI unsigned pack2(float a, float b) {
  f32x2 v = {a, b};
  bf16x2_t r = __builtin_convertvector(v, bf16x2_t);
  return __builtin_bit_cast(unsigned, r);
}
DI bfr f2bf(float a) { return (bfr)(pack2(a, 0.f) & 0xffffu); }
DI float bf2f(bfr v) { return __uint_as_float(((unsigned)v) << 16); }
DI float frcp_(float x) { return __builtin_amdgcn_rcpf(x); }
DI float sigmoidf_(float x) { return frcp_(1.f + __expf(-x)); }
DI float siluf_(float x) { return x * frcp_(1.f + __expf(-x)); }
DI f32x4 ld4bf(const bfr* p);
DI float wave_sum(float v) {
#pragma unroll
  for (int o = 32; o > 0; o >>= 1) v += __shfl_xor(v, o);
  return v;
}

DI void phase_lora_convert(CParams& P, int part, int nparts);
DI void phase_wrt_convert(CParams& P, int part, int nparts);
DI void transpose_tile(const float* W, int ldw, int k0, int n0, int nvalid, bfr* WT, int ldt, char* smem);
DI void transpose_quad(const float* W, int ldw, int k0, int n0, bfr* WT, int ldt, int dr0, int dr1, int dr2, int dr3, char* smem, int nvalid);
DI void phase_mod(CParams& P, int bid, int nb, char* smem) {
  const float* c = P.in[1]; const float* cc = P.in[3];
  const float* w_mod = P.in[4]; const float* b_mod = P.in[5];
  float* mod = (float*)(P.ws + WS_MOD); float* modc = (float*)(P.ws + WS_MODC);
  float* red = (float*)smem;
  const int tid = VT;
  for (int it = bid; it < 542; it += nb) {
    if (it < 192) {
      const int kq = tid >> 3, c4 = tid & 7;
      const int col = it * 32 + c4 * 4;
      f32x4 a1 = {0, 0, 0, 0}, a2 = {0, 0, 0, 0};
      for (int k = kq; k < DM; k += 32) {
        f32x4 w = *(const f32x4*)(w_mod + (long)k * 6144 + col);
        float s1 = siluf_(c[k]), s2 = siluf_(cc[k]);
        a1 += w * s1; a2 += w * s2;
      }
      __syncthreads();
#pragma unroll
      for (int e = 0; e < 4; ++e) { red[(kq * 32) + c4 * 4 + e] = a1[e]; red[1024 + kq * 32 + c4 * 4 + e] = a2[e]; }
      __syncthreads();
      if (tid < 64) {
        const int which = tid >> 5, cl = tid & 31;
        float s = 0.f;
        for (int q = 0; q < 32; ++q) s += red[which * 1024 + q * 32 + cl];
        const int cg = it * 32 + cl;
        s += b_mod[cg];
        if (which == 0) mod[cg] = s; else modc[cg] = s;
      }
    } else if (it == 192) {
      const float* L = P.in[8];
      float* lb = (float*)(P.ws + WS_LB);
      for (int i = tid; i < 1024; i += NTHR) {
        const int d = i >> 9, j = i & 511;
        float l0 = L[d * 1024 + j], l1 = L[d * 1024 + 512 + j];
        lb[i] = 1.f / (1.f + __expf(l1 - l0));
      }
    } else if (it == 193) {
      int* cnt = (int*)(P.ws + WS_CNT);
      if (tid < 64) cnt[tid] = 0;
    } else if (it < 198) {
      phase_lora_convert(P, it - 194, 4);
    } else if (it < 470) {
      const int t = it - 198, kt = t / 17, nq = t % 17;
      transpose_quad(P.in[6], DIN, kt * 64, nq * 256, (bfr*)(P.ws + (284ull << 20)), DM, nq * 256, nq * 256 + 64, nq * 256 + 128, nq * 256 + 192, smem, DIN);
    } else if (it < 534) {
      const int t = it - 470, kt = t >> 2, nq = t & 3;
      transpose_quad(P.in[7], DM, kt * 64, nq * 256, (bfr*)(P.ws + (1ull << 20)), DM, nq * 256, nq * 256 + 64, nq * 256 + 128, nq * 256 + 192, smem, DM);
    } else {
      phase_wrt_convert(P, it - 534, 8);
    }
  }
}

DI void phase_ln1(CParams& P, int bid, int nb) {
  const float* x = P.in[0]; const float* ctx = P.in[2];
  const float* mod = (const float*)(P.ws + WS_MOD); const float* modc = (const float*)(P.ws + WS_MODC);
  bfr* h = (bfr*)(P.ws + WS_H);
  const int wid = VT >> 6, lane = VT & 63;
  for (int row0 = (bid * 4 + wid) * 2; row0 < T_ALL; row0 += nb * 8) {
    const float* src = row0 < T_LAT ? x + (long)row0 * DM : ctx + (long)(row0 - T_LAT) * DM;
    const float* mm = row0 < T_LAT ? mod : modc;
    f32x4 v[2][4];
    float s[2] = {0.f, 0.f};
#pragma unroll
    for (int r = 0; r < 2; ++r)
#pragma unroll
      for (int i = 0; i < 4; ++i) { v[r][i] = *(const f32x4*)(src + r * DM + lane * 4 + 256 * i); s[r] += v[r][i][0] + v[r][i][1] + v[r][i][2] + v[r][i][3]; }
#pragma unroll
    for (int r = 0; r < 2; ++r) {
      const float mu = wave_sum(s[r]) * (1.f / DM);
      float q = 0.f;
#pragma unroll
      for (int i = 0; i < 4; ++i) { v[r][i] -= mu; q += v[r][i][0] * v[r][i][0] + v[r][i][1] * v[r][i][1] + v[r][i][2] * v[r][i][2] + v[r][i][3] * v[r][i][3]; }
      const float rs = rsqrtf(wave_sum(q) * (1.f / DM) + 1e-5f);
#pragma unroll
      for (int i = 0; i < 4; ++i) {
        const int cidx = lane * 4 + 256 * i;
        f32x4 sh = *(const f32x4*)(mm + cidx), sc = *(const f32x4*)(mm + 1024 + cidx);
        f32x4 o = v[r][i] * rs * (sc + 1.f) + sh;
        uint2 w = {pack2(o[0], o[1]), pack2(o[2], o[3])};
        *(uint2*)(h + (long)(row0 + r) * DM + cidx) = w;
      }
    }
  }
}

#define LDSP(T) __attribute__((address_space(3))) T*
DI int row_of_step(int dir, int s) {
  if (s < T_CTX) return T_LAT + (dir ? (T_CTX - 1 - s) : s);
  return dir ? (T_LAT - 1 - (s - T_CTX)) : (s - T_CTX);
}
DI bf16x8 ld_tr8(const short* base, int stride, int k0, int n0) {
  const int lane = VT & 63, g = lane >> 4, q = (lane & 15) >> 2, p = lane & 3;
  const short* a0 = base + (k0 + 8 * g + q) * stride + n0 + 4 * p;
  s16x4 lo = __builtin_amdgcn_ds_read_tr16_b64_v4i16((LDSP(s16x4))a0);
  s16x4 hi = __builtin_amdgcn_ds_read_tr16_b64_v4i16((LDSP(s16x4))(a0 + 4 * stride));
  return __builtin_shufflevector(lo, hi, 0, 1, 2, 3, 4, 5, 6, 7);
}
template <bool AT, bool BT>
DI f32x4 mm_tile(const short* A, int lda, int m0, const short* B, int ldb, int n0, int K, f32x4 acc) {
  const int lane = VT & 63, fr = lane & 15, fq = lane >> 4;
#ifdef SLOWMM
#pragma unroll
  for (int reg = 0; reg < 4; ++reg) {
    const int row = m0 + 4 * fq + reg, col = n0 + fr;
    float s = 0.f;
    for (int k = 0; k < K; ++k) {
      const float a = bf2f((bfr)(AT ? A[k * lda + row] : A[row * lda + k]));
      const float b = bf2f((bfr)(BT ? B[col * ldb + k] : B[k * ldb + col]));
      s += a * b;
    }
    acc[reg] += s;
  }
#else
  for (int k0 = 0; k0 < K; k0 += 32) {
    bf16x8 a, b;
    if (AT) a = ld_tr8(A, lda, k0, m0); else a = *(const bf16x8*)(A + (m0 + fr) * lda + k0 + fq * 8);
    if (BT) b = *(const bf16x8*)(B + (n0 + fr) * ldb + k0 + fq * 8); else b = ld_tr8(B, ldb, k0, n0);
    acc = __builtin_amdgcn_mfma_f32_16x16x32_bf16(a, b, acc, 0, 0, 0);
  }
#endif
  return acc;
}
DI void st_tile(short* C, int ldc, int m0, int n0, f32x4 acc) {
  const int lane = VT & 63, fr = lane & 15, fq = lane >> 4;
#pragma unroll
  for (int reg = 0; reg < 4; ++reg) C[(m0 + 4 * fq + reg) * ldc + n0 + fr] = (short)f2bf(acc[reg]);
}

constexpr int RW_NSC = 32;
DI int rw_sc_begin(int sc) { return sc * 16 + (sc < 8 ? sc : 8); }
DI int rw_sc_of_chunk(int ci) { return ci < 136 ? ci / 17 : 8 + (ci - 136) / 16; }
constexpr int XS = 72, SS = 40, GS = 72;
constexpr int RWL_XK = 0, RWL_XKB = 4608, RWL_XBB = 9216, RWL_XR = 13824, RWL_XV = 18432, RWL_S = 23040;
constexpr int RWL_GP = 38400, RWL_GQ = 47616, RWL_GAM = 56832, RWL_TOT = 57088, RWL_END = 58112;
constexpr size_t WS_PTOT = 6 * MB;
constexpr size_t WS_QTOT = 10 * MB;
constexpr size_t WS_SINRW = 18 * MB;
constexpr size_t WS_R2P = 350 * MB;
constexpr size_t WS_Y0P = 382 * MB;

constexpr int RTS = 40, RGS = 72;
constexpr int RWT_XK = 0, RWT_XKB = 5120, RWT_XBB = 10240, RWT_XR = 15360, RWT_XV = 20480, RWT_S = 25600;
constexpr int RWT_GP = 40960, RWT_GQ = 50176, RWT_GAM = 59392, RWT_TOT = 59648;
DI void st_tile_T(short* C, int ldc, int m0, int n0, f32x4 acc) {
  const int lane = (int)(threadIdx.x & 63), fr = lane & 15, fq = lane >> 4;
  *(uint2*)(C + (n0 + fr) * ldc + m0 + 4 * fq) = uint2{pack2(acc[0], acc[1]), pack2(acc[2], acc[3])};
}
DI void rw_levelA_item(CParams& P, int chain, int sc, char* smem) {
  const int dir = chain >> 3, hd = chain & 7;
  const bfr* Rg = (const bfr*)(P.ws + WS_RW); const bfr* Kg = (const bfr*)(P.ws + WS_RW + RW_ARR); const bfr* Vg = (const bfr*)(P.ws + WS_RW + 2 * RW_ARR);
  const bfr* KKg = (const bfr*)(P.ws + WS_RW + 3 * RW_ARR); const bfr* Ag = (const bfr*)(P.ws + WS_RW + 4 * RW_ARR);
  const float* LWg = (const float*)(P.ws + WS_LW + (dir ? LW_ARR : 0));
  bfr* R2P = (bfr*)(P.ws + WS_R2P) + (size_t)dir * T_LAT * 512;
  bfr* Y0P = (bfr*)(P.ws + WS_Y0P) + (size_t)dir * T_LAT * 512;
  short* XKt = (short*)(smem + RWT_XK); short* XKBt = (short*)(smem + RWT_XKB); short* XBBt = (short*)(smem + RWT_XBB);
  short* XRt = (short*)(smem + RWT_XR); short* XVt = (short*)(smem + RWT_XV);
  short* ZT = XRt; short* R2T = XRt; short* PcT = XKt;
  short* SLt = (short*)(smem + RWT_S); short* SAkkT = SLt + 32 * RTS; short* SAkrT = SAkkT + 32 * RTS; short* SMt = SAkrT + 32 * RTS;
  short* STt = SMt + 32 * RTS; short* SnAbrT = STt + 32 * RTS;
  short* W1T = SLt; short* W2T = SAkrT;
  short* GPT = (short*)(smem + RWT_GP); short* GQT = (short*)(smem + RWT_GQ);
  float* gam = (float*)(smem + RWT_GAM); float* tot = (float*)(smem + RWT_TOT);
  const int tid = VT, lane = tid & 63, w = tid >> 6, fr = lane & 15, fq = lane >> 4;
  const int tm = w >> 1, tn = w & 1;
  const int sgn = dir ? -1 : 1;
  const f32x4 z4 = {0.f, 0.f, 0.f, 0.f};
  __syncthreads();
  for (int i = tid; i < 64 * 64; i += NTHR) { const int r = i >> 6, c = i & 63; GPT[r * RGS + c] = (r == c) ? (short)0x3F80 : (short)0; GQT[r * RGS + c] = 0; }
  f32x4 pcum[4], qcum[4];
#pragma unroll
  for (int n = 0; n < 4; ++n) { pcum[n] = z4; qcum[n] = z4; }
  const int c_begin = rw_sc_begin(sc), c_end = rw_sc_begin(sc + 1);
  float pf_lw[8]; unsigned pf_rk[8], pf_vkk[8], pf_a[8];
#define RW_PREFETCH(cc) do { const unsigned o0_ = (unsigned)(row_of_step(dir, (cc) * 32 + (tid >> 6) * 8) * 512 + hd * 64 + (tid & 63)); \
      _Pragma("unroll") for (int e_ = 0; e_ < 8; ++e_) { const unsigned o_ = o0_ + (unsigned)(sgn * e_ * 512); \
      pf_lw[e_] = LWg[o_]; pf_rk[e_] = (unsigned)Rg[o_] | ((unsigned)Kg[o_] << 16); pf_vkk[e_] = (unsigned)Vg[o_] | ((unsigned)KKg[o_] << 16); pf_a[e_] = Ag[o_]; } } while (0)
  RW_PREFETCH(c_begin);
  for (int ci = c_begin; ci < c_end; ++ci) {
    __syncthreads();
    {
      const int j = tid & 63, qt = tid >> 6;
      float lam[8];
      float run = 0.f;
#pragma unroll
      for (int e = 0; e < 8; ++e) { run += pf_lw[e]; lam[e] = run; }
      tot[qt * 64 + j] = run;
      __syncthreads();
      float base = 0.f, total = 0.f;
#pragma unroll
      for (int q2 = 0; q2 < 4; ++q2) { const float tv = tot[q2 * 64 + j]; total += tv; if (q2 < qt) base += tv; }
      unsigned wk[4], wkb[4], wbb[4], wr_[4], wv[4];
#pragma unroll
      for (int e2 = 0; e2 < 4; ++e2) {
        float vk[2], vkb[2], vbb[2], vr[2];
#pragma unroll
        for (int u = 0; u < 2; ++u) {
          const int e = 2 * e2 + u;
          const float L = base + lam[e];
          const float eL = __expf(L), enL = frcp_(eL), eLp = eL * __expf(-pf_lw[e]);
          const float kkv = __uint_as_float(pf_vkk[e] & 0xffff0000u);
          vk[u] = kkv * eLp;
          vkb[u] = __uint_as_float(pf_rk[e] & 0xffff0000u) * enL;
          vbb[u] = kkv * __uint_as_float(pf_a[e] << 16) * enL;
          vr[u] = __uint_as_float(pf_rk[e] << 16) * eL;
        }
        wk[e2] = pack2(vk[0], vk[1]); wkb[e2] = pack2(vkb[0], vkb[1]); wbb[e2] = pack2(vbb[0], vbb[1]); wr_[e2] = pack2(vr[0], vr[1]);
        wv[e2] = (pf_vkk[2 * e2] & 0xffffu) | (pf_vkk[2 * e2 + 1] << 16);
      }
      const int co = j * RTS + 8 * qt;
      *(uint4*)(XKt + co) = uint4{wk[0], wk[1], wk[2], wk[3]};
      *(uint4*)(XKBt + co) = uint4{wkb[0], wkb[1], wkb[2], wkb[3]};
      *(uint4*)(XBBt + co) = uint4{wbb[0], wbb[1], wbb[2], wbb[3]};
      *(uint4*)(XRt + co) = uint4{wr_[0], wr_[1], wr_[2], wr_[3]};
      *(uint4*)(XVt + co) = uint4{wv[0], wv[1], wv[2], wv[3]};
      if (qt == 0) gam[j] = __expf(total);
      if (ci + 1 < c_end) RW_PREFETCH(ci + 1);
    }
    __syncthreads();
    f32x4 tacc; f32x4 rt[2];
    {
      f32x4 aL = mm_tile<true, false>(XKt, RTS, 16 * tm, XBBt, RTS, 16 * tn, 64, z4);
      f32x4 aKK = mm_tile<true, false>(XKt, RTS, 16 * tm, XKBt, RTS, 16 * tn, 64, z4);
      f32x4 aBR = mm_tile<true, false>(XRt, RTS, 16 * tm, XBBt, RTS, 16 * tn, 64, z4);
      f32x4 aKR = mm_tile<true, false>(XRt, RTS, 16 * tm, XKBt, RTS, 16 * tn, 64, z4);
#pragma unroll
      for (int reg = 0; reg < 4; ++reg) {
        const int row = 16 * tm + 4 * fq + reg, col = 16 * tn + fr;
        const bool st = col < row, inc = col <= row;
        aL[reg] = st ? aL[reg] : 0.f; aKK[reg] = st ? aKK[reg] : 0.f;
        aBR[reg] = inc ? -aBR[reg] : 0.f; aKR[reg] = inc ? aKR[reg] : 0.f;
        tacc[reg] = (row == col ? 1.f : 0.f) - aL[reg];
      }
      st_tile_T(SLt, RTS, 16 * tm, 16 * tn, aL); st_tile_T(STt, RTS, 16 * tm, 16 * tn, tacc);
      st_tile_T(SAkkT, RTS, 16 * tm, 16 * tn, aKK); st_tile_T(SnAbrT, RTS, 16 * tm, 16 * tn, aBR); st_tile_T(SAkrT, RTS, 16 * tm, 16 * tn, aKR);
#pragma unroll
      for (int i = 0; i < 2; ++i) rt[i] = ld4bf((const bfr*)(XRt + (16 * (2 * tn + i) + fr) * RTS + 16 * tm + 4 * fq));
    }
    __syncthreads();
    f32x4 y0[2];
    {
#pragma unroll
      for (int i = 0; i < 2; ++i) {
        f32x4 z = mm_tile<true, true>(SAkkT, RTS, 16 * tm, XVt, RTS, 16 * (2 * tn + i), 32, z4);
        st_tile_T(ZT, RTS, 16 * tm, 16 * (2 * tn + i), z);
        y0[i] = mm_tile<true, true>(SAkrT, RTS, 16 * tm, XVt, RTS, 16 * (2 * tn + i), 32, z4);
      }
      f32x4 m = mm_tile<true, true>(SLt, RTS, 16 * tm, SLt, RTS, 16 * tn, 32, z4);
      st_tile_T(SMt, RTS, 16 * tm, 16 * tn, m);
    }
    __syncthreads();
#pragma unroll 1
    for (int rd = 0; rd < 4; ++rd) {
      f32x4 tnew = mm_tile<true, true>(STt, RTS, 16 * tm, SMt, RTS, 16 * tn, 32, tacc);
      f32x4 mnew = z4;
      if (rd < 3) mnew = mm_tile<true, true>(SMt, RTS, 16 * tm, SMt, RTS, 16 * tn, 32, z4);
      __syncthreads();
      tacc = tnew;
      st_tile_T(STt, RTS, 16 * tm, 16 * tn, tacc);
      if (rd < 3) st_tile_T(SMt, RTS, 16 * tm, 16 * tn, mnew);
      __syncthreads();
    }
    {
      f32x4 w1[2], w2[2];
#pragma unroll
      for (int i = 0; i < 2; ++i) {
        w1[i] = mm_tile<true, true>(STt, RTS, 16 * tm, XKt, RTS, 16 * (2 * tn + i), 32, z4);
        w2[i] = mm_tile<true, true>(STt, RTS, 16 * tm, ZT, RTS, 16 * (2 * tn + i), 32, z4);
      }
#pragma unroll
      for (int i = 0; i < 2; ++i) { st_tile_T(W1T, RTS, 16 * tm, 16 * (2 * tn + i), w1[i]); st_tile_T(W2T, RTS, 16 * tm, 16 * (2 * tn + i), w2[i]); }
    }
    __syncthreads();
    f32x4 pa[4], qc[4], r2[2];
    {
#pragma unroll
      for (int n = 0; n < 4; ++n) {
        pa[n] = mm_tile<false, true>(W1T, RTS, 16 * w, XBBt, RTS, 16 * n, 32, z4);
        f32x4 qa = mm_tile<false, true>(XVt, RTS, 16 * w, XKBt, RTS, 16 * n, 32, z4);
        f32x4 qb = mm_tile<false, true>(W2T, RTS, 16 * w, XBBt, RTS, 16 * n, 32, z4);
        qc[n] = qa - qb;
      }
#pragma unroll
      for (int i = 0; i < 2; ++i) {
        r2[i] = mm_tile<true, true>(SnAbrT, RTS, 16 * tm, W1T, RTS, 16 * (2 * tn + i), 32, rt[i]);
        y0[i] = mm_tile<true, true>(SnAbrT, RTS, 16 * tm, W2T, RTS, 16 * (2 * tn + i), 32, y0[i]);
      }
    }
    __syncthreads();
    {
#pragma unroll
      for (int n = 0; n < 4; ++n) {
        const float gcol = gam[16 * n + fr];
        f32x4 pc;
#pragma unroll
        for (int reg = 0; reg < 4; ++reg) {
          const int row = 16 * w + 4 * fq + reg, col = 16 * n + fr;
          pc[reg] = ((row == col ? 1.f : 0.f) - pa[n][reg]) * gcol;
          qc[n][reg] *= gcol;
        }
        st_tile_T(PcT, RGS, 16 * w, 16 * n, pc);
      }
#pragma unroll
      for (int i = 0; i < 2; ++i) st_tile_T(R2T, RTS, 16 * tm, 16 * (2 * tn + i), r2[i]);
    }
    __syncthreads();
    {
      if (ci >= 8) {
        const unsigned orow = (unsigned)(row_of_step(dir, ci * 32 + 16 * tm + 4 * fq) * 512 + hd * 64 + fr);
#pragma unroll
        for (int i = 0; i < 2; ++i) {
          f32x4 o1 = mm_tile<true, false>(R2T, RTS, 16 * tm, GPT, RGS, 16 * (2 * tn + i), 64, z4);
          f32x4 o2 = mm_tile<true, false>(R2T, RTS, 16 * tm, GQT, RGS, 16 * (2 * tn + i), 64, y0[i]);
#pragma unroll
          for (int reg = 0; reg < 4; ++reg) {
            const unsigned o = orow + (unsigned)(sgn * reg * 512 + 16 * (2 * tn + i));
            R2P[o] = f2bf(o1[reg]); Y0P[o] = f2bf(o2[reg]);
          }
        }
      }
#pragma unroll
      for (int n = 0; n < 4; ++n) {
        pcum[n] = mm_tile<true, true>(GPT, RGS, 16 * w, PcT, RGS, 16 * n, 64, z4);
        qcum[n] = mm_tile<true, true>(GQT, RGS, 16 * w, PcT, RGS, 16 * n, 64, qc[n]);
      }
    }
    __syncthreads();
#pragma unroll
    for (int n = 0; n < 4; ++n) { st_tile_T(GPT, RGS, 16 * w, 16 * n, pcum[n]); st_tile_T(GQT, RGS, 16 * w, 16 * n, qcum[n]); }
  }
  {
    bfr* Pt = (bfr*)(P.ws + WS_PTOT) + (size_t)(chain * RW_NSC + sc) * 4096;
    float* Qt = (float*)(P.ws + WS_QTOT) + (size_t)(chain * RW_NSC + sc) * 4096;
#pragma unroll
    for (int n = 0; n < 4; ++n)
#pragma unroll
      for (int reg = 0; reg < 4; ++reg) {
        const int row = 16 * w + 4 * fq + reg, col = 16 * n + fr;
        Pt[row * 64 + col] = f2bf(pcum[n][reg]);
      }
#pragma unroll
    for (int n = 0; n < 4; ++n) *(f32x4*)(Qt + (16 * n + fr) * 64 + 16 * w + 4 * fq) = qcum[n];
  }
}

DI void rw_levelB_chain(CParams& P, int chain, char* smem) {
  short* SB = (short*)smem; short* PT = SB + 64 * GS;
  const bfr* Ptot = (const bfr*)(P.ws + WS_PTOT) + (size_t)chain * RW_NSC * 4096;
  const float* Qtot = (const float*)(P.ws + WS_QTOT) + (size_t)chain * RW_NSC * 4096;
  bfr* SIN = (bfr*)(P.ws + WS_SINRW) + (size_t)chain * (RW_NSC + 1) * 4096;
  const int tid = VT, lane = tid & 63, w = tid >> 6, fr = lane & 15, fq = lane >> 4;
  f32x4 S[4];
#pragma unroll
  for (int n = 0; n < 4; ++n) S[n] = f32x4{0.f, 0.f, 0.f, 0.f};
  bf16x8 pr[4][2]; f32x4 qr[4][4];
#define LB_LOAD(slot, sc_) do { _Pragma("unroll") for (int i_ = 0; i_ < 2; ++i_) { const int e_ = tid + i_ * NTHR; pr[slot][i_] = *(const bf16x8*)(Ptot + (size_t)(sc_) * 4096 + (e_ >> 3) * 64 + (e_ & 7) * 8); } \
    _Pragma("unroll") for (int n_ = 0; n_ < 4; ++n_) qr[slot][n_] = *(const f32x4*)(Qtot + (size_t)(sc_) * 4096 + (16 * n_ + fr) * 64 + 16 * w + 4 * fq); } while (0)
  LB_LOAD(0, 0); LB_LOAD(1, 1); LB_LOAD(2, 2); LB_LOAD(3, 3);
#define LB_STEP(u) do { const int sc = sc0 + (u); \
      __syncthreads(); \
      _Pragma("unroll") for (int n = 0; n < 4; ++n) { st_tile(SB, GS, 16 * w, 16 * n, S[n]); \
        _Pragma("unroll") for (int reg = 0; reg < 4; ++reg) SIN[(size_t)sc * 4096 + (16 * w + 4 * fq + reg) * 64 + 16 * n + fr] = f2bf(S[n][reg]); } \
      _Pragma("unroll") for (int i = 0; i < 2; ++i) { const int e = tid + i * NTHR; *(bf16x8*)(PT + (e >> 3) * GS + (e & 7) * 8) = pr[u][i]; } \
      const f32x4 qc0 = qr[u][0], qc1 = qr[u][1], qc2 = qr[u][2], qc3 = qr[u][3]; \
      __syncthreads(); \
      if (sc + 4 < RW_NSC) LB_LOAD(u, sc + 4); \
      S[0] = mm_tile<false, false>(SB, GS, 16 * w, PT, GS, 0, 64, qc0); S[1] = mm_tile<false, false>(SB, GS, 16 * w, PT, GS, 16, 64, qc1); \
      S[2] = mm_tile<false, false>(SB, GS, 16 * w, PT, GS, 32, 64, qc2); S[3] = mm_tile<false, false>(SB, GS, 16 * w, PT, GS, 48, 64, qc3); } while (0)
  for (int sc0 = 0; sc0 < RW_NSC; sc0 += 4) { LB_STEP(0); LB_STEP(1); LB_STEP(2); LB_STEP(3); }
#undef LB_STEP
#undef LB_LOAD
}

constexpr int HG_NSC = 64;
DI int hg_sc_begin(int sc) { return sc * 8 + (sc < 8 ? sc : 8); }
DI int hg_sc_of_chunk(int ci) { return ci < 72 ? ci / 9 : 8 + (ci - 72) / 8; }
constexpr int QS = 136;
constexpr int HGL_Q0 = 0, HGL_Q1 = 8704, HGL_KP = 13056, HGL_KH = 21760, HGL_VV = 30464, HGL_PM = 39168, HGL_STT = 41728;
constexpr int HGL_BL = 76544, HGL_TOT = 77056, HGL_END = 78080;
constexpr size_t WS_SINHG = 23 * MB;
constexpr size_t WS_QH = 414 * MB;
constexpr size_t WS_O0 = 446 * MB;
constexpr size_t WS_SLOC = 478 * MB;
constexpr size_t WS_DTOT = 510 * MB;

constexpr int HTS = 40, HT1S = 24;
constexpr int HGT_Q0 = 0, HGT_Q1 = 10240, HGT_KP = 16384, HGT_KH = 26624, HGT_VV = 36864, HGT_PM = 47104, HGT_BL = 49664, HGT_TOT = 50176;
DI bf16x8 ld_tr8p(const short* base, int stride, int k0, int n0) {
  const int lane = (int)(threadIdx.x & 63), g = lane >> 4, q = (lane & 15) >> 2, p = lane & 3;
  const short* a0 = base + (k0 + 4 * g + q) * stride + n0 + 4 * p;
  s16x4 lo = __builtin_amdgcn_ds_read_tr16_b64_v4i16((LDSP(s16x4))a0);
  s16x4 hi = __builtin_amdgcn_ds_read_tr16_b64_v4i16((LDSP(s16x4))(a0 + 16 * stride));
  return __builtin_shufflevector(lo, hi, 0, 1, 2, 3, 4, 5, 6, 7);
}
DI void hg_levelA_item(CParams& P, int chain, int sc, char* smem) {
  const int dir = chain >> 2, hd = chain & 3;
  const bfr* p = (const bfr*)(P.ws + WS_P);
  const float* lbp = (const float*)(P.ws + WS_LB) + dir * 512 + hd * 128;
  bfr* QH = (bfr*)(P.ws + WS_QH) + (size_t)dir * T_LAT * 512;
  bfr* O0 = (bfr*)(P.ws + WS_O0) + (size_t)dir * T_LAT * 512;
  short* Q0T = (short*)(smem + HGT_Q0); short* Q1T = (short*)(smem + HGT_Q1); short* KPT = (short*)(smem + HGT_KP);
  short* KHT = (short*)(smem + HGT_KH); short* VVT = (short*)(smem + HGT_VV); short* PMT = (short*)(smem + HGT_PM);
  float* BL = (float*)(smem + HGT_BL); float* tot = (float*)(smem + HGT_TOT);
  const int tid = VT, lane = tid & 63, w = tid >> 6, fr = lane & 15, fq = lane >> 4;
  const f32x4 z4 = {0.f, 0.f, 0.f, 0.f};
  f32x4 S[8][2];
#pragma unroll
  for (int m = 0; m < 8; ++m) { S[m][0] = z4; S[m][1] = z4; }
  const int d = tid & 127, hf = tid >> 7;
  const float lb = lbp[d];
  float dcum = 0.f;
  const int sgn = dir ? -1 : 1;
  const int c_begin = hg_sc_begin(sc), c_end = hg_sc_begin(sc + 1);
  unsigned qv[16]; bfr zr[16];
#define HG_PREFETCH(cc) do { const unsigned po0_ = (unsigned)(row_of_step(dir, (cc) * 32 + hf * 16) * DIN + hd * 128 + d); \
      _Pragma("unroll") for (int e_ = 0; e_ < 16; ++e_) { const unsigned po_ = po0_ + (unsigned)(sgn * e_ * DIN); \
      qv[e_] = (unsigned)p[po_] | ((unsigned)p[po_ + 512] << 16); zr[e_] = p[po_ + 1024 + dir * 512]; } } while (0)
  HG_PREFETCH(c_begin);
  for (int ci = c_begin; ci < c_end; ++ci) {
    __syncthreads();
    {
      float lc[16], kv[16]; float run = 0.f;
#pragma unroll
      for (int e = 0; e < 16; ++e) {
        const float sg = sigmoidf_(bf2f(zr[e]));
        const float f = lb + (1.f - lb) * sg;
        kv[e] = (1.f - lb) * (1.f - sg);
        run += __logf(f); lc[e] = run;
      }
      tot[hf * 128 + d] = run;
      __syncthreads();
      const float tot0 = tot[d], tot1 = tot[128 + d];
      const float blast = tot0 + tot1;
      const float e0f = hf ? __expf(tot0) : 1.f;
      const float ehf = __expf(blast - (hf ? tot0 : 0.f));
      const float edc = __expf(dcum);
      const unsigned qh0 = (unsigned)(row_of_step(dir, ci * 32 + hf * 16) * 512 + hd * 128 + d);
#pragma unroll
      for (int hq = 0; hq < 2; ++hq) {
        unsigned q0w[4], q1w[4], kpw[4], khw[4], vvw[4];
#pragma unroll
        for (int e2 = 0; e2 < 4; ++e2) {
          float q0v[2], q1v[2], kpv[2], khv[2];
#pragma unroll
          for (int u = 0; u < 2; ++u) {
            const int e = 8 * hq + 2 * e2 + u;
            const float el = __expf(lc[e]), eil = frcp_(el);
            const float qs = siluf_(__uint_as_float(qv[e] << 16));
            q1v[u] = qs * el; q0v[u] = q1v[u] * e0f;
            kpv[u] = kv[e] * eil; khv[u] = kpv[u] * ehf;
            if (ci >= 8) QH[qh0 + (unsigned)(sgn * e * 512)] = f2bf(q0v[u] * edc);
          }
          q0w[e2] = pack2(q0v[0], q0v[1]); q1w[e2] = pack2(q1v[0], q1v[1]); kpw[e2] = pack2(kpv[0], kpv[1]); khw[e2] = pack2(khv[0], khv[1]);
          vvw[e2] = (qv[8 * hq + 2 * e2] >> 16) | (qv[8 * hq + 2 * e2 + 1] & 0xffff0000u);
        }
        const int co = 16 * hf + 8 * hq;
        *(uint4*)(Q0T + d * HTS + co) = uint4{q0w[0], q0w[1], q0w[2], q0w[3]};
        if (hf) *(uint4*)(Q1T + d * HT1S + 8 * hq) = uint4{q1w[0], q1w[1], q1w[2], q1w[3]};
        *(uint4*)(KPT + d * HTS + co) = uint4{kpw[0], kpw[1], kpw[2], kpw[3]};
        *(uint4*)(KHT + d * HTS + co) = uint4{khw[0], khw[1], khw[2], khw[3]};
        *(uint4*)(VVT + d * HTS + co) = uint4{vvw[0], vvw[1], vvw[2], vvw[3]};
      }
      if (hf == 0) BL[d] = blast;
      dcum += blast;
      if (ci + 1 < c_end) HG_PREFETCH(ci + 1);
    }
    __syncthreads();
    {
      f32x4 pt = z4;
      if (w == 0) pt = mm_tile<true, false>(Q0T, HTS, 0, KPT, HTS, 0, 128, z4);
      else if (w == 1) pt = mm_tile<true, false>(Q0T, HTS, 16, KPT, HTS, 0, 128, z4);
      else if (w == 2) pt = mm_tile<true, false>(Q1T, HT1S, 0, KPT, HTS, 16, 128, z4);
      if (w == 0 || w == 2) {
#pragma unroll
        for (int reg = 0; reg < 4; ++reg) pt[reg] = (fr <= 4 * fq + reg) ? pt[reg] : 0.f;
      }
      const int ptm = (w == 0 || w == 3) ? 0 : 1, ptn = (w >= 2) ? 1 : 0;
      *(uint2*)(PMT + (16 * ptn + fr) * HTS + 16 * ptm + 4 * fq) = uint2{pack2(pt[0], pt[1]), pack2(pt[2], pt[3])};
    }
    __syncthreads();
    {
      bf16x8 vfr[2];
#pragma unroll
      for (int n = 0; n < 2; ++n) vfr[n] = *(const bf16x8*)(VVT + (32 * w + 16 * n + fr) * HTS + fq * 8);
      f32x4 o[2][2];
#pragma unroll
      for (int m = 0; m < 2; ++m) { o[m][0] = z4; o[m][1] = z4; }
#pragma unroll
      for (int ks = 0; ks < 4; ++ks) {
        bf16x8 sfr[2];
#pragma unroll
        for (int n = 0; n < 2; ++n) {
          typedef __attribute__((ext_vector_type(4))) unsigned u32x4_;
          u32x4_ wv = {pack2(S[2 * ks][n][0], S[2 * ks][n][1]), pack2(S[2 * ks][n][2], S[2 * ks][n][3]), pack2(S[2 * ks + 1][n][0], S[2 * ks + 1][n][1]), pack2(S[2 * ks + 1][n][2], S[2 * ks + 1][n][3])};
          sfr[n] = __builtin_bit_cast(bf16x8, wv);
        }
#pragma unroll
        for (int m = 0; m < 2; ++m) {
          const bf16x8 a = ld_tr8p(Q0T, HTS, 32 * ks, 16 * m);
#pragma unroll
          for (int n = 0; n < 2; ++n) o[m][n] = __builtin_amdgcn_mfma_f32_16x16x32_bf16(a, sfr[n], o[m][n], 0, 0, 0);
        }
      }
#pragma unroll
      for (int m = 0; m < 2; ++m) {
        const bf16x8 a = ld_tr8(PMT, HTS, 0, 16 * m);
#pragma unroll
        for (int n = 0; n < 2; ++n) {
          o[m][n] = __builtin_amdgcn_mfma_f32_16x16x32_bf16(a, vfr[n], o[m][n], 0, 0, 0);
          if (ci >= 8) {
            const unsigned orow = (unsigned)(row_of_step(dir, ci * 32 + 16 * m + 4 * fq) * 512 + hd * 128 + 32 * w + 16 * n + fr);
#pragma unroll
            for (int reg = 0; reg < 4; ++reg) O0[orow + (unsigned)(sgn * reg * 512)] = f2bf(o[m][n][reg]);
          }
        }
      }
#pragma unroll
      for (int m = 0; m < 8; ++m) {
        const f32x4 bl = *(const f32x4*)(BL + 16 * m + 4 * fq);
        f32x4 sc4 = {__expf(bl[0]), __expf(bl[1]), __expf(bl[2]), __expf(bl[3])};
        const bf16x8 a = *(const bf16x8*)(KHT + (16 * m + fr) * HTS + fq * 8);
#pragma unroll
        for (int n = 0; n < 2; ++n) S[m][n] = __builtin_amdgcn_mfma_f32_16x16x32_bf16(a, vfr[n], S[m][n] * sc4, 0, 0, 0);
      }
    }
  }
  {
    float* SL_ = (float*)(P.ws + WS_SLOC) + (size_t)(chain * HG_NSC + sc) * 16384;
    float* DT = (float*)(P.ws + WS_DTOT) + (size_t)(chain * HG_NSC + sc) * 128;
#pragma unroll
    for (int m = 0; m < 8; ++m)
#pragma unroll
      for (int n = 0; n < 2; ++n) *(f32x4*)(SL_ + (32 * w + 16 * n + fr) * 128 + 16 * m + 4 * fq) = S[m][n];
    if (hf == 0) DT[d] = dcum;
  }
}

DI void hg_levelB(CParams& P, int bid, int nb) {
  const float* SLOC = (const float*)(P.ws + WS_SLOC); const float* DT = (const float*)(P.ws + WS_DTOT);
  bfr* SIN = (bfr*)(P.ws + WS_SINHG);
  for (int idx = bid * NTHR + VT; idx < 8 * 16384; idx += nb * NTHR) {
    const int chain = idx >> 14, ed = idx & 16383, dd = ed & 127;
    float s = 0.f;
    for (int sc = 0; sc < HG_NSC; ++sc) {
      const size_t item = (size_t)chain * HG_NSC + sc;
      SIN[item * 16384 + ed] = f2bf(s);
      s = __expf(DT[item * 128 + dd]) * s + SLOC[item * 16384 + ed];
    }
  }
}

constexpr size_t WS_LORA = 256 * 1024;
constexpr int LORA_WD2T = 0, LORA_WA2T = 2 * 512 * 32, LORA_WG2T = LORA_WA2T + 512 * 32;
DI void phase_lora_convert(CParams& P, int part, int nparts) {
  const float* wd2 = P.in[12]; const float* wa2 = P.in[14]; const float* wg2 = P.in[15];
  bfr* L = (bfr*)(P.ws + WS_LORA);
  for (int i = part * NTHR + VT; i < 2 * 512 * 32; i += nparts * NTHR) { const int d = i >> 14, c = (i >> 5) & 511, j = i & 31; L[LORA_WD2T + i] = f2bf(wd2[(d * 32 + j) * 512 + c]); }
  for (int i = part * NTHR + VT; i < 512 * 32; i += nparts * NTHR) { const int c = i >> 5, j = i & 31; L[LORA_WA2T + i] = f2bf(wa2[j * 512 + c]); }
  for (int i = part * NTHR + VT; i < 512 * 96; i += nparts * NTHR) { const int c = i / 96, j = i % 96; L[LORA_WG2T + i] = f2bf(wg2[j * 512 + c]); }
}
#define NB_DECL(row) \
  int nb_o0, nb_o1, nb_o2, nb_o3; float nb_f0, nb_f1, nb_f2, nb_f3, nb_scale; \
  { const int r_ = (row); const bool lat_ = r_ < T_LAT; const int gr_ = r_ >> 6, gc_ = r_ & 63, s_ = r_ - T_LAT; \
    const bool v0_ = lat_ && gr_ > 0, v1_ = lat_ && gr_ < 255, v2_ = lat_ ? gc_ > 0 : s_ > 0, v3_ = lat_ ? gc_ < 63 : s_ < T_CTX - 1; \
    nb_o0 = v0_ ? -64 * DIN : 0; nb_o1 = v1_ ? 64 * DIN : 0; nb_o2 = v2_ ? -DIN : 0; nb_o3 = v3_ ? DIN : 0; \
    nb_f0 = v0_ ? 1.f : 0.f; nb_f1 = v1_ ? 1.f : 0.f; nb_f2 = v2_ ? 1.f : 0.f; nb_f3 = v3_ ? 1.f : 0.f; nb_scale = lat_ ? 0.25f : 0.5f; }
#define MIX4(pc, mup) mix4_((pc), (mup), nb_o0, nb_o1, nb_o2, nb_o3, nb_f0, nb_f1, nb_f2, nb_f3, nb_scale)
DI f32x4 ld4bf(const bfr* p) {
  const uint2 u = *(const uint2*)p;
  return f32x4{__uint_as_float(u.x << 16), __uint_as_float(u.x & 0xffff0000u), __uint_as_float(u.y << 16), __uint_as_float(u.y & 0xffff0000u)};
}
DI f32x4 mix4_(const bfr* pc, const float* mu, int o0, int o1, int o2, int o3, float f0, float f1, float f2, float f3, float scale) {
  const f32x4 c = ld4bf(pc);
  f32x4 s = ld4bf(pc + o0) * f0 + ld4bf(pc + o1) * f1 + ld4bf(pc + o2) * f2 + ld4bf(pc + o3) * f3;
  const f32x4 m = *(const f32x4*)mu;
  return c + (s * scale - c) * m;
}
DI void ld8bf(const bfr* p, f32x4& lo, f32x4& hi) {
  const uint4 u = *(const uint4*)p;
  lo = f32x4{__uint_as_float(u.x << 16), __uint_as_float(u.x & 0xffff0000u), __uint_as_float(u.y << 16), __uint_as_float(u.y & 0xffff0000u)};
  hi = f32x4{__uint_as_float(u.z << 16), __uint_as_float(u.z & 0xffff0000u), __uint_as_float(u.w << 16), __uint_as_float(u.w & 0xffff0000u)};
}
DI void mix8_(const bfr* pc, const float* mu, int o0, int o1, int o2, int o3, float f0, float f1, float f2, float f3, float scale, f32x4& lo, f32x4& hi) {
  f32x4 cl, chh, al, ah, bl, bh, dl, dh, el, eh;
  ld8bf(pc, cl, chh); ld8bf(pc + o0, al, ah); ld8bf(pc + o1, bl, bh); ld8bf(pc + o2, dl, dh); ld8bf(pc + o3, el, eh);
  const f32x4 sl = al * f0 + bl * f1 + dl * f2 + el * f3, sh = ah * f0 + bh * f1 + dh * f2 + eh * f3;
  const f32x4 ml = *(const f32x4*)mu, mh = *(const f32x4*)(mu + 4);
  lo = cl + (sl * scale - cl) * ml; hi = chh + (sh * scale - chh) * mh;
}
#define MIX8(pc, mup, lo, hi) mix8_((pc), (mup), nb_o0, nb_o1, nb_o2, nb_o3, nb_f0, nb_f1, nb_f2, nb_f3, nb_scale, lo, hi)
DI float ftanh_(float x) { const float e = __expf(2.f * x); return 1.f - 2.f * frcp_(e + 1.f); }
DI uint2 pk4(f32x4 v) { return uint2{pack2(v[0], v[1]), pack2(v[2], v[3])}; }
constexpr int LIS = 200;
constexpr int MXS = 388;
DI void phase_rwprep(CParams& P, int bid, int nb, char* smem) {
  const bfr* p = (const bfr*)(P.ws + WS_P);
  const float* mu = P.in[10]; const float* w0 = P.in[11]; const float* a0 = P.in[13];
  const float* k_k = P.in[16]; const float* k_a = P.in[17];
  const bfr* LW_ = (const bfr*)(P.ws + WS_LORA);
  bfr* R = (bfr*)(P.ws + WS_RW); bfr* K = (bfr*)(P.ws + WS_RW + RW_ARR); bfr* V = (bfr*)(P.ws + WS_RW + 2 * RW_ARR);
  bfr* KK = (bfr*)(P.ws + WS_RW + 3 * RW_ARR); bfr* A = (bfr*)(P.ws + WS_RW + 4 * RW_ARR); bfr* G = (bfr*)(P.ws + WS_RW + 5 * RW_ARR);
  float* LWF = (float*)(P.ws + WS_LW); float* LWB = (float*)(P.ws + WS_LW + LW_ARR);
  short* LI = (short*)smem;
  float* MX = (float*)(smem + 32 * LIS * 2);
  const int tid = VT, lane = tid & 63, w = tid >> 6, fr = lane & 15, fq = lane >> 4;
  const f32x4 z4 = {0.f, 0.f, 0.f, 0.f};
  const int hp = bid & 3;
  bf16x8 afr[4][6];
  {
    const int h = hp * 2 + (w >> 1);
#pragma unroll
    for (int m = 0; m < 4; ++m) {
      const int c0 = 64 * h + 16 * m;
      afr[m][0] = *(const bf16x8*)(LW_ + LORA_WD2T + (c0 + fr) * 32 + fq * 8);
      afr[m][1] = *(const bf16x8*)(LW_ + LORA_WD2T + 512 * 32 + (c0 + fr) * 32 + fq * 8);
      afr[m][2] = *(const bf16x8*)(LW_ + LORA_WA2T + (c0 + fr) * 32 + fq * 8);
#pragma unroll
      for (int ks = 0; ks < 3; ++ks) afr[m][3 + ks] = *(const bf16x8*)(LW_ + LORA_WG2T + (c0 + fr) * 96 + ks * 32 + fq * 8);
    }
  }
  for (int it = bid; it < (T_ALL / 32) * 4; it += nb) {
  const int tile = it >> 2;
  const int row0 = tile * 32;
  __syncthreads();
  for (int v = tid; v < 32 * 72; v += NTHR) {
    const int t = v / 72, g = v % 72;
    const int row = row0 + t;
    NB_DECL(row);
    f32x4 lo, hi;
    if (g < 24) {
      const bfr* pc = p + (size_t)row * DIN + HGC + 1536 + g * 8;
      MIX8(pc, mu + 1536 + g * 8, lo, hi);
#pragma unroll
      for (int e = 0; e < 4; ++e) {
        if (g < 8) { lo[e] = ftanh_(lo[e]); hi[e] = ftanh_(hi[e]); }
        else if (g >= 12) { lo[e] = sigmoidf_(lo[e]); hi[e] = sigmoidf_(hi[e]); }
      }
      const uint2 a = pk4(lo), b = pk4(hi);
      *(uint4*)(LI + t * LIS + g * 8) = uint4{a.x, a.y, b.x, b.y};
    } else {
      const int cg = g - 24, a = cg >> 4, c8 = cg & 15;
      const int col = a * 512 + hp * 128 + c8 * 8;
      MIX8(p + (size_t)row * DIN + HGC + col, mu + col, lo, hi);
      *(f32x4*)(MX + t * MXS + a * 128 + c8 * 8) = lo; *(f32x4*)(MX + t * MXS + a * 128 + c8 * 8 + 4) = hi;
    }
  }
  __syncthreads();
  {
    const int hl = w >> 1, th = w & 1, h = hp * 2 + hl;
    const int row = row0 + 16 * th + fr;
    const float* mrow = MX + (16 * th + fr) * MXS + hl * 64 + 4 * fq;
    f32x4 kkr[4], kraw[4], av[4];
    float ss = 0.f;
#pragma unroll
    for (int m = 0; m < 4; ++m) {
      const int c0 = 64 * h + 16 * m;
      const int ch = c0 + 4 * fq;
      const f32x4 r = *(const f32x4*)(mrow + 16 * m);
      kraw[m] = *(const f32x4*)(mrow + 128 + 16 * m);
      const f32x4 v = *(const f32x4*)(mrow + 256 + 16 * m);
      const short* lrow = LI + (16 * th + fr) * LIS + fq * 8;
      f32x4 aF = __builtin_amdgcn_mfma_f32_16x16x32_bf16(afr[m][0], *(const bf16x8*)(lrow), z4, 0, 0, 0);
      f32x4 aB = __builtin_amdgcn_mfma_f32_16x16x32_bf16(afr[m][1], *(const bf16x8*)(lrow + 32), z4, 0, 0, 0);
      f32x4 aA = __builtin_amdgcn_mfma_f32_16x16x32_bf16(afr[m][2], *(const bf16x8*)(lrow + 64), z4, 0, 0, 0);
      f32x4 aG = z4;
#pragma unroll
      for (int ks = 0; ks < 3; ++ks) aG = __builtin_amdgcn_mfma_f32_16x16x32_bf16(afr[m][3 + ks], *(const bf16x8*)(lrow + 96 + ks * 32), aG, 0, 0, 0);
      const size_t o = (size_t)row * 512 + ch;
      const f32x4 w0f = *(const f32x4*)(w0 + ch), w0b = *(const f32x4*)(w0 + 512 + ch), a0v = *(const f32x4*)(a0 + ch);
      f32x4 lwf, lwb;
#pragma unroll
      for (int e = 0; e < 4; ++e) {
        lwf[e] = -RW_DECAY_SCALE * sigmoidf_(w0f[e] + aF[e]);
        lwb[e] = -RW_DECAY_SCALE * sigmoidf_(w0b[e] + aB[e]);
        av[m][e] = sigmoidf_(a0v[e] + aA[e]);
      }
      *(f32x4*)(LWF + o) = lwf; *(f32x4*)(LWB + o) = lwb;
      *(uint2*)(G + o) = pk4(aG);
      *(uint2*)(A + o) = pk4(av[m]);
      *(uint2*)(R + o) = pk4(r); *(uint2*)(V + o) = pk4(v);
      kkr[m] = kraw[m] * *(const f32x4*)(k_k + ch);
      ss += kkr[m][0] * kkr[m][0] + kkr[m][1] * kkr[m][1] + kkr[m][2] * kkr[m][2] + kkr[m][3] * kkr[m][3];
    }
    ss += __shfl_xor(ss, 16); ss += __shfl_xor(ss, 32);
    const float rn = rsqrtf(fmaxf(ss, 1e-12f));
#pragma unroll
    for (int m = 0; m < 4; ++m) {
      const int ch = 64 * h + 16 * m + 4 * fq;
      const size_t o = (size_t)row * 512 + ch;
      const f32x4 ka = *(const f32x4*)(k_a + ch);
      f32x4 kv;
#pragma unroll
      for (int e = 0; e < 4; ++e) kv[e] = kraw[m][e] * (1.f + (av[m][e] - 1.f) * ka[e]);
      *(uint2*)(K + o) = pk4(kv);
      *(uint2*)(KK + o) = pk4(kkr[m] * rn);
    }
  }
  }
}

constexpr size_t WS_WRT = 512 * 1024;
DI void phase_wrt_convert(CParams& P, int part, int nparts) {
  const float* wgrp = P.in[25]; const float* wrt = P.in[27];
  bfr* Whi = (bfr*)(P.ws + WS_WRT); bfr* Wlo = Whi + 80 * 1024;
  for (int i = part * NTHR + VT; i < 80 * 1024; i += nparts * NTHR) {
    const int o = i >> 10, k = i & 1023;
    float wv = 0.f;
    if (o < 8) wv = wgrp[k * 8 + o]; else if (o < 72) wv = wrt[k * 64 + (o - 8)];
    const bfr hi = f2bf(wv);
    Whi[i] = hi; Wlo[i] = f2bf(wv - bf2f(hi));
  }
}
constexpr int HLS = 1032;
DI void phase_ln2route(CParams& P, char* smem_all) {
  const float* x = P.in[0];
  const bfr* y = (const bfr*)(P.ws + WS_Y);
  const float* mod = (const float*)(P.ws + WS_MOD);
  const float* ln1_g = P.in[21]; const float* ln1_b = P.in[22];
  const float* bgrp = P.in[26]; const float* brt = P.in[28];
  const bfr* Whi = (const bfr*)(P.ws + WS_WRT); const bfr* Wlo = Whi + 80 * 1024;
  bfr* x1 = (bfr*)(P.ws + WS_X1B);
  bfr* h2 = (bfr*)(P.ws + WS_H2);
  int* cnt = (int*)(P.ws + WS_CNT); int* list = (int*)(P.ws + WS_LIST); float* asgw = (float*)(P.ws + WS_ASGW);
  short* HI = (short*)smem_all; short* LO = HI + 32 * HLS;
  float* LG = (float*)(smem_all + 2 * 32 * HLS * 2);
  float* PS = LG + 32 * 80;
  const int tid = tx_(), wid = tid >> 6, lane = tid & 63, fr = lane & 15, fq = lane >> 4;
  for (int grp = blockIdx.x; grp < T_LAT / 32; grp += gridDim.x) {
    const int t0 = grp * 32;
    __syncthreads();
    f32x4 xin[4][4]; uint2 yin[4][4];
#pragma unroll
    for (int tt = 0; tt < 4; ++tt)
#pragma unroll
      for (int i = 0; i < 4; ++i) {
        const long o = (long)(t0 + wid * 4 + tt) * DM + lane * 4 + 256 * i;
        xin[tt][i] = *(const f32x4*)(x + o); yin[tt][i] = *(const uint2*)(y + o);
      }
#pragma unroll
    for (int tt = 0; tt < 4; ++tt) {
      const int tl = wid * 4 + tt, t = t0 + tl;
      f32x4 v[4]; float s = 0.f;
#pragma unroll
      for (int i = 0; i < 4; ++i) {
        const int c = lane * 4 + 256 * i;
        const f32x4 g1 = *(const f32x4*)(mod + 2048 + c);
        const uint2 u = yin[tt][i];
        const f32x4 yv = {__uint_as_float(u.x << 16), __uint_as_float(u.x & 0xffff0000u), __uint_as_float(u.y << 16), __uint_as_float(u.y & 0xffff0000u)};
        v[i] = xin[tt][i] * DN_ALPHA + g1 * yv;
        s += v[i][0] + v[i][1] + v[i][2] + v[i][3];
      }
      float mu = wave_sum(s) * (1.f / DM); float q = 0.f;
#pragma unroll
      for (int i = 0; i < 4; ++i) { v[i] -= mu; q += v[i][0] * v[i][0] + v[i][1] * v[i][1] + v[i][2] * v[i][2] + v[i][3] * v[i][3]; }
      float rs = rsqrtf(wave_sum(q) * (1.f / DM) + 1e-5f);
      s = 0.f;
#pragma unroll
      for (int i = 0; i < 4; ++i) {
        const int c = lane * 4 + 256 * i;
        f32x4 g = *(const f32x4*)(ln1_g + c), b = *(const f32x4*)(ln1_b + c);
        v[i] = v[i] * rs * g + b;
        *(uint2*)(x1 + (long)t * DM + c) = pk4(v[i]);
        s += v[i][0] + v[i][1] + v[i][2] + v[i][3];
      }
      mu = wave_sum(s) * (1.f / DM); q = 0.f;
#pragma unroll
      for (int i = 0; i < 4; ++i) { v[i] -= mu; q += v[i][0] * v[i][0] + v[i][1] * v[i][1] + v[i][2] * v[i][2] + v[i][3] * v[i][3]; }
      rs = rsqrtf(wave_sum(q) * (1.f / DM) + 1e-5f);
#pragma unroll
      for (int i = 0; i < 4; ++i) {
        const int c = lane * 4 + 256 * i;
        f32x4 sh = *(const f32x4*)(mod + 3072 + c), sc = *(const f32x4*)(mod + 4096 + c);
        v[i] = v[i] * rs * (sc + 1.f) + sh;
        const uint2 whi = {pack2(v[i][0], v[i][1]), pack2(v[i][2], v[i][3])};
        f32x4 r;
        r[0] = v[i][0] - __uint_as_float(whi.x << 16); r[1] = v[i][1] - __uint_as_float(whi.x & 0xffff0000u);
        r[2] = v[i][2] - __uint_as_float(whi.y << 16); r[3] = v[i][3] - __uint_as_float(whi.y & 0xffff0000u);
        const uint2 wlo = {pack2(r[0], r[1]), pack2(r[2], r[3])};
        *(uint2*)(h2 + (long)t * DM + c) = whi;
        *(uint2*)(HI + tl * HLS + c) = whi;
        *(uint2*)(LO + tl * HLS + c) = wlo;
      }
    }
    __syncthreads();
    {
      const int own = wid < 4;
      const int mrow = own ? 16 * wid : 64;
      f32x4 acc0 = {0.f, 0.f, 0.f, 0.f}, acc1 = {0.f, 0.f, 0.f, 0.f};
      bf16x8 a[8], an[8];
      const int nbatch = own ? 12 : 3;
#define RT_LOAD(bi_, dst) do { const int ps_ = own ? ((bi_) >> 2) : (bi_), kb_ = own ? (((bi_) & 3) * 8) : ((wid - 4) * 8); const bfr* Wp_ = ps_ == 1 ? Wlo : Whi; \
        _Pragma("unroll") for (int u = 0; u < 8; ++u) dst[u] = *(const bf16x8*)(Wp_ + (size_t)(mrow + fr) * 1024 + (kb_ + u) * 32 + fq * 8); } while (0)
      RT_LOAD(0, a);
#pragma unroll 1
      for (int bi = 0; bi < nbatch; ++bi) {
        if (bi + 1 < nbatch) RT_LOAD(bi + 1, an);
        const int ps = own ? (bi >> 2) : bi, kb = own ? ((bi & 3) * 8) : ((wid - 4) * 8);
        const short* Hp = ps == 2 ? LO : HI;
#pragma unroll
        for (int u = 0; u < 8; ++u) {
          const bf16x8 b0 = *(const bf16x8*)(Hp + fr * HLS + (kb + u) * 32 + fq * 8);
          const bf16x8 b1 = *(const bf16x8*)(Hp + (16 + fr) * HLS + (kb + u) * 32 + fq * 8);
          acc0 = __builtin_amdgcn_mfma_f32_16x16x32_bf16(a[u], b0, acc0, 0, 0, 0);
          acc1 = __builtin_amdgcn_mfma_f32_16x16x32_bf16(a[u], b1, acc1, 0, 0, 0);
        }
#pragma unroll
        for (int u = 0; u < 8; ++u) a[u] = an[u];
      }
#undef RT_LOAD
      if (own) {
#pragma unroll
        for (int reg = 0; reg < 4; ++reg) { LG[fr * 80 + mrow + 4 * fq + reg] = acc0[reg]; LG[(16 + fr) * 80 + mrow + 4 * fq + reg] = acc1[reg]; }
      } else {
#pragma unroll
        for (int reg = 0; reg < 4; ++reg) { PS[((wid - 4) * 32 + fr) * 16 + 4 * fq + reg] = acc0[reg]; PS[((wid - 4) * 32 + 16 + fr) * 16 + 4 * fq + reg] = acc1[reg]; }
      }
    }
    __syncthreads();
    {
      const int tk = tid >> 4, o = tid & 15;
      LG[tk * 80 + 64 + o] = (PS[(0 * 32 + tk) * 16 + o] + PS[(1 * 32 + tk) * 16 + o]) + (PS[(2 * 32 + tk) * 16 + o] + PS[(3 * 32 + tk) * 16 + o]);
    }
    __syncthreads();
    if (tid < 32) {
      const int t = t0 + tid;
      const float* lg = LG + tid * 80;
      int gi = 0; float gmax = -3.4e38f; float gl[8];
#pragma unroll
      for (int g = 0; g < 8; ++g) { gl[g] = lg[g] + bgrp[g]; if (gl[g] > gmax) { gmax = gl[g]; gi = g; } }
      float den = 0.f;
#pragma unroll
      for (int g = 0; g < 8; ++g) den += __expf(gl[g] - gmax);
      const float gprob = 1.f / den;
      int i1 = 0; float v1 = -3.4e38f; float el[8];
#pragma unroll
      for (int g = 0; g < 8; ++g) { el[g] = lg[8 + gi * 8 + g] + brt[gi * 8 + g]; if (el[g] > v1) { v1 = el[g]; i1 = g; } }
      int i2 = 0; float v2 = -3.4e38f;
#pragma unroll
      for (int g = 0; g < 8; ++g) { if (g != i1 && el[g] > v2) { v2 = el[g]; i2 = g; } }
      const float e2 = __expf(v2 - v1);
      const float wt1 = gprob / (1.f + e2), wt2 = gprob * e2 / (1.f + e2);
      const int ex1 = gi * 8 + i1, ex2 = gi * 8 + i2;
      int s1 = atomicAdd(&cnt[ex1], 1); list[ex1 * T_LAT + s1] = t * 2;
      int s2 = atomicAdd(&cnt[ex2], 1); list[ex2 * T_LAT + s2] = t * 2 + 1;
      asgw[t * 2] = wt1; asgw[t * 2 + 1] = wt2;
    }
  }
}

DI void phase_final(CParams& P, int bid, int nb) {
  const float* mod = (const float*)(P.ws + WS_MOD);
  const float* ln2_g = P.in[23]; const float* ln2_b = P.in[24];
  const bfr* mout = (const bfr*)(P.ws + (42ull << 20));
  const bfr* x1b = (const bfr*)(P.ws + WS_X1B);
  const float* asgw = (const float*)(P.ws + WS_ASGW);
  float* out = P.out;
  const int wid = VT >> 6, lane = VT & 63;
  for (int t0 = (bid * 4 + wid) * 2; t0 < T_LAT; t0 += nb * 8) {
    f32x4 v[2][4]; float s[2] = {0.f, 0.f};
#pragma unroll
    for (int r = 0; r < 2; ++r) {
      const int t = t0 + r;
      const float w1 = asgw[t * 2], w2 = asgw[t * 2 + 1];
#pragma unroll
      for (int i = 0; i < 4; ++i) {
        const int c = lane * 4 + 256 * i;
        const f32x4 xv = ld4bf(x1b + (long)t * DM + c), g2 = *(const f32x4*)(mod + 5120 + c);
        const f32x4 a = ld4bf(mout + (long)(2 * t) * DM + c), b = ld4bf(mout + (long)(2 * t + 1) * DM + c);
        v[r][i] = xv * DN_ALPHA + g2 * (a * w1 + b * w2);
        s[r] += v[r][i][0] + v[r][i][1] + v[r][i][2] + v[r][i][3];
      }
    }
#pragma unroll
    for (int r = 0; r < 2; ++r) {
      const float mu = wave_sum(s[r]) * (1.f / DM); float q = 0.f;
#pragma unroll
      for (int i = 0; i < 4; ++i) { v[r][i] -= mu; q += v[r][i][0] * v[r][i][0] + v[r][i][1] * v[r][i][1] + v[r][i][2] * v[r][i][2] + v[r][i][3] * v[r][i][3]; }
      const float rs = rsqrtf(wave_sum(q) * (1.f / DM) + 1e-5f);
#pragma unroll
      for (int i = 0; i < 4; ++i) {
        const int c = lane * 4 + 256 * i;
        f32x4 g = *(const f32x4*)(ln2_g + c), b = *(const f32x4*)(ln2_b + c);
        *(f32x4*)(out + (long)(t0 + r) * DM + c) = v[r][i] * rs * g + b;
      }
    }
  }
}

DI void phase_readout_fused(CParams& P, int bid, int nb) {
  const bfr* p = (const bfr*)(P.ws + WS_P);
  const bfr* R = (const bfr*)(P.ws + WS_RW); const bfr* K = (const bfr*)(P.ws + WS_RW + RW_ARR); const bfr* V = (const bfr*)(P.ws + WS_RW + 2 * RW_ARR);
  const bfr* G = (const bfr*)(P.ws + WS_RW + 5 * RW_ARR);
  const float* hg_norm_w = P.in[9]; const float* r_k = P.in[18]; const float* gn_w = P.in[19]; const float* gn_b = P.in[20];
  bfr* mix = (bfr*)(P.ws + WS_MIX);
  const int tid = VT, lane = tid & 63, w = tid >> 6, fr = lane & 15, fq = lane >> 4;
  const f32x4 z4 = {0.f, 0.f, 0.f, 0.f};
  for (int tile = bid; tile < T_LAT / 32; tile += nb) {
    const int t0 = tile * 32;
#pragma unroll 1
    for (int hh = 0; hh < 2; ++hh) {
      const int hd = 2 * w + hh;
      f32x4 acc[4][2];
#pragma unroll
      for (int m = 0; m < 4; ++m) { acc[m][0] = z4; acc[m][1] = z4; }
#pragma unroll
      for (int dir = 0; dir < 2; ++dir) {
        const int ci = dir ? (519 - tile) : (8 + tile);
        const int sc = rw_sc_of_chunk(ci);
        const bfr* Bq = (const bfr*)(P.ws + WS_R2P) + (size_t)dir * T_LAT * 512 + (size_t)t0 * 512 + hd * 64;
        const bfr* Y0 = (const bfr*)(P.ws + WS_Y0P) + (size_t)dir * T_LAT * 512 + (size_t)t0 * 512 + hd * 64;
        const bfr* Sin = (const bfr*)(P.ws + WS_SINRW) + ((size_t)(dir * 8 + hd) * (RW_NSC + 1) + sc) * 4096;
#pragma unroll
        for (int k0 = 0; k0 < 64; k0 += 32) {
          bf16x8 bq[2];
#pragma unroll
          for (int n = 0; n < 2; ++n) bq[n] = *(const bf16x8*)(Bq + (size_t)(16 * n + fr) * 512 + k0 + fq * 8);
#pragma unroll
          for (int m = 0; m < 4; ++m) {
            const bf16x8 a = *(const bf16x8*)(Sin + (16 * m + fr) * 64 + k0 + fq * 8);
#pragma unroll
            for (int n = 0; n < 2; ++n) acc[m][n] = __builtin_amdgcn_mfma_f32_16x16x32_bf16(a, bq[n], acc[m][n], 0, 0, 0);
          }
        }
#pragma unroll
        for (int m = 0; m < 4; ++m)
#pragma unroll
          for (int n = 0; n < 2; ++n) acc[m][n] += ld4bf(Y0 + (size_t)(16 * n + fr) * 512 + 16 * m + 4 * fq);
      }
#pragma unroll
      for (int n = 0; n < 2; ++n) {
        const size_t trow = (size_t)(t0 + 16 * n + fr) * 512 + hd * 64;
        float s = 0.f, bs = 0.f;
        f32x4 vv[4];
#pragma unroll
        for (int m = 0; m < 4; ++m) {
          const int c = 16 * m + 4 * fq;
          s += acc[m][n][0] + acc[m][n][1] + acc[m][n][2] + acc[m][n][3];
          const f32x4 rr = ld4bf(R + trow + c), kk2 = ld4bf(K + trow + c), rk = *(const f32x4*)(r_k + hd * 64 + c);
          vv[m] = ld4bf(V + trow + c);
          bs += rr[0] * kk2[0] * rk[0] + rr[1] * kk2[1] * rk[1] + rr[2] * kk2[2] * rk[2] + rr[3] * kk2[3] * rk[3];
        }
        s += __shfl_xor(s, 16); s += __shfl_xor(s, 32);
        bs += __shfl_xor(bs, 16); bs += __shfl_xor(bs, 32);
        const float mu = s * (1.f / 64.f);
        float q = 0.f;
#pragma unroll
        for (int m = 0; m < 4; ++m) { acc[m][n] -= mu; q += acc[m][n][0] * acc[m][n][0] + acc[m][n][1] * acc[m][n][1] + acc[m][n][2] * acc[m][n][2] + acc[m][n][3] * acc[m][n][3]; }
        q += __shfl_xor(q, 16); q += __shfl_xor(q, 32);
        const float rs = rsqrtf(q * (1.f / 64.f) + 64e-5f);
#pragma unroll
        for (int m = 0; m < 4; ++m) {
          const int c = hd * 64 + 16 * m + 4 * fq;
          const f32x4 gw = *(const f32x4*)(gn_w + c), gb = *(const f32x4*)(gn_b + c), gg = ld4bf(G + trow + 16 * m + 4 * fq);
          const f32x4 o = (acc[m][n] * rs * gw + gb + vv[m] * bs) * gg;
          *(uint2*)(mix + (size_t)(t0 + 16 * n + fr) * DM + 512 + c) = pk4(o);
        }
      }
    }
    {
      const int hd = w;
      f32x4 acc[8][2];
#pragma unroll
      for (int m = 0; m < 8; ++m) { acc[m][0] = z4; acc[m][1] = z4; }
#pragma unroll
      for (int dir = 0; dir < 2; ++dir) {
        const int ci = dir ? (519 - tile) : (8 + tile);
        const int sc = hg_sc_of_chunk(ci);
        const bfr* Bq = (const bfr*)(P.ws + WS_QH) + (size_t)dir * T_LAT * 512 + (size_t)t0 * 512 + hd * 128;
        const bfr* O0 = (const bfr*)(P.ws + WS_O0) + (size_t)dir * T_LAT * 512 + (size_t)t0 * 512 + hd * 128;
        const bfr* Sin = (const bfr*)(P.ws + WS_SINHG) + ((size_t)(dir * 4 + hd) * HG_NSC + sc) * 16384;
#pragma unroll
        for (int k0 = 0; k0 < 128; k0 += 32) {
          bf16x8 bq[2];
#pragma unroll
          for (int n = 0; n < 2; ++n) bq[n] = *(const bf16x8*)(Bq + (size_t)(16 * n + fr) * 512 + k0 + fq * 8);
#pragma unroll
          for (int m = 0; m < 8; ++m) {
            const bf16x8 a = *(const bf16x8*)(Sin + (16 * m + fr) * 128 + k0 + fq * 8);
#pragma unroll
            for (int n = 0; n < 2; ++n) acc[m][n] = __builtin_amdgcn_mfma_f32_16x16x32_bf16(a, bq[n], acc[m][n], 0, 0, 0);
          }
        }
#pragma unroll
        for (int m = 0; m < 8; ++m)
#pragma unroll
          for (int n = 0; n < 2; ++n) acc[m][n] += ld4bf(O0 + (size_t)(16 * n + fr) * 512 + 16 * m + 4 * fq);
      }
#pragma unroll
      for (int n = 0; n < 2; ++n) {
        const int t = t0 + 16 * n + fr;
        float ss = 0.f;
#pragma unroll
        for (int m = 0; m < 8; ++m) ss += acc[m][n][0] * acc[m][n][0] + acc[m][n][1] * acc[m][n][1] + acc[m][n][2] * acc[m][n][2] + acc[m][n][3] * acc[m][n][3];
        ss += __shfl_xor(ss, 16); ss += __shfl_xor(ss, 32);
        const float rs = rsqrtf(ss * (1.f / 128.f) + 1e-6f);
#pragma unroll
        for (int m = 0; m < 8; ++m) {
          const int c = hd * 128 + 16 * m + 4 * fq;
          const f32x4 nw = *(const f32x4*)(hg_norm_w + c), gg = ld4bf(p + (size_t)t * DIN + 2048 + c);
          f32x4 o;
#pragma unroll
          for (int e = 0; e < 4; ++e) o[e] = acc[m][n][e] * rs * nw[e] * siluf_(gg[e]);
          *(uint2*)(mix + (size_t)t * DM + c) = pk4(o);
        }
      }
    }
  }
}

namespace pg8 {
#define PG8_LAS __attribute__((address_space(3)))
typedef unsigned short bf16_t;
typedef short bf16x8 __attribute__((ext_vector_type(8)));
typedef float f32x4 __attribute__((ext_vector_type(4)));
typedef unsigned u32x4 __attribute__((ext_vector_type(4)));
constexpr int BM = 256, BK = 64, HALF = 128, HTB = HALF * BK * 2  , STAGE_BYTES = 8 * HTB, NXCD = 8, WGM = 8;

__host__ __device__ __forceinline__ int lds_byte(int r, int c) { const int st = (r >> 4) * 2 + (c >> 5), rr = r & 15, cc = c & 31, ob = rr * 64 + cc * 2; return st * 1024 + (ob ^ (((ob >> 9) & 1) << 5)); }
__host__ __device__ __forceinline__ void stage_rc(int b, int& R, int& C) { const int st = b / 1024, sb = b % 1024, swz = sb ^ (((sb >> 9) & 1) << 5); R = (st >> 1) * 16 + swz / 64; C = (st & 1) * 32 + (swz % 64) / 2; }
__host__ __device__ __forceinline__ int perm32(int rho) { const int n = rho >> 4, i = rho & 15; return 8 * (i >> 2) + 4 * n + (i & 3); }

struct Unit { int pm, pn; };
struct Gemm { const bf16_t* A; const bf16_t* Bt; int M, N, K; };

struct StaticOrder {
    int nM, nN, nwg, G, c;
    __host__ __device__ void init(int M, int N, int G_, int c_) { nM = M / BM; nN = N / BM; nwg = nM * nN; G = G_; c = c_; }
    __host__ __device__ bool next(int i, Unit& u) const {
        const long L = (long)i * G + c; if (L >= nwg) return false;
        int wgid = (int)L; { const int q = nwg / NXCD, r = nwg % NXCD, xcd = wgid % NXCD, off = wgid / NXCD; wgid = (xcd < r ? xcd * (q + 1) : r * (q + 1) + (xcd - r) * q) + off; }
        const int nig = WGM * nN, gid = wgid / nig, fm = gid * WGM, gsz = (nM - fm) < WGM ? (nM - fm) : WGM;
        u.pm = fm + ((wgid % nig) % gsz); u.pn = (wgid % nig) / gsz; return true;
    }
    __device__ __forceinline__ void a_ready(const Unit&) const {}
    __device__ __forceinline__ void done(const Unit&) const {}
};
struct CountedOrder : StaticOrder {
    const unsigned* ready; unsigned need; unsigned* tmo;
    __device__ __forceinline__ void a_ready(const Unit& u) const {
        if (threadIdx.x < 64) {
            const unsigned long long t0 = __builtin_amdgcn_s_memrealtime(); unsigned polls = 0;
            while ((unsigned)__builtin_amdgcn_readfirstlane(__hip_atomic_load(ready + 64 * u.pm, __ATOMIC_RELAXED, __HIP_MEMORY_SCOPE_AGENT)) < need) {
                if ((++polls & 255u) == 0u && __builtin_amdgcn_readfirstlane(__hip_atomic_load(tmo, __ATOMIC_RELAXED, __HIP_MEMORY_SCOPE_AGENT)) != 0u) break;
                if (__builtin_amdgcn_s_memrealtime() - t0 > 2000000ull) {
                    if (threadIdx.x == 0) { unsigned expect = 0u; __hip_atomic_compare_exchange_strong(tmo + 1, &expect, 0x600u | (unsigned)(u.pm & 0xff), __ATOMIC_RELAXED, __ATOMIC_RELAXED, __HIP_MEMORY_SCOPE_AGENT); __hip_atomic_store(tmo, 1u, __ATOMIC_RELAXED, __HIP_MEMORY_SCOPE_AGENT); }
                    break; }
                __builtin_amdgcn_s_sleep(2); }
            __builtin_amdgcn_fence(__ATOMIC_ACQUIRE, "agent");
            asm volatile("s_waitcnt vmcnt(0)" ::: "memory");
        }
#if !defined(BROKEN_HOOK_NO_BARRIER)
        asm volatile("" ::: "memory"); __builtin_amdgcn_s_barrier(); asm volatile("" ::: "memory");
#endif
    }
};
struct EpiF32 {
    static constexpr bool PERM = false, AFTER_DRAIN = false;
    float* C; int ldc; const float* bias;
    __device__ __forceinline__ void operator()(const f32x4 (&acc)[2][2][4][2], const Unit& u, int wr, int wc, int fr, int fq) const {
        const int row0 = u.pm * BM + wr * 64 + fr, col0 = u.pn * BM + wc * 32 + 4 * fq;
        f32x4 bv[2][2];
#pragma unroll
        for (int bj = 0; bj < 2; ++bj)
#pragma unroll
            for (int n = 0; n < 2; ++n) bv[bj][n] = bias ? *(const f32x4*)(bias + col0 + bj * HALF + n * 16) : (f32x4){0.f, 0.f, 0.f, 0.f};
#pragma unroll
        for (int ai = 0; ai < 2; ++ai)
#pragma unroll
            for (int m = 0; m < 4; ++m) { float* rowp = C + (size_t)(row0 + ai * HALF + m * 16) * ldc + col0;
#pragma unroll
                for (int bj = 0; bj < 2; ++bj)
#pragma unroll
                    for (int n = 0; n < 2; ++n) *(f32x4*)(rowp + bj * HALF + n * 16) = acc[ai][bj][m][n] + bv[bj][n]; }
    }
};
template <class Epi, class Sched, bool STAMP = false>
__device__ __forceinline__ void gemm_phase(PG8_LAS unsigned char* lds, const Gemm g, const Sched& S, const Epi& E, unsigned long long* stamps) {
    int tid_ = threadIdx.x; asm volatile("" : "+v"(tid_));
    const int tid = tid_, wid = __builtin_amdgcn_readfirstlane(tid >> 6), lane = tid & 63, wr = wid >> 2, wc = wid & 3, fr = lane & 15, fq = lane >> 4;
    const int K = g.K, nt = K / BK;
    int ts_lo = 0, ts_hi = 0, nts = 0; const unsigned long long rt_entry = STAMP ? (unsigned long long)wall_clock64() : 0ull;
#define PG8_STAMP() do { if (STAMP && wid == 0 && nts < 64) { const unsigned long long _c = (unsigned long long)clock64(); \
        ts_lo = (lane == nts) ? (int)(unsigned)_c : ts_lo; ts_hi = (lane == nts) ? (int)(unsigned)(_c >> 32) : ts_hi; ++nts; } } while (0)
    PG8_STAMP();
    unsigned voffA[2], voffB[2];
#pragma unroll
    for (int i = 0; i < 2; ++i) { int R, C; stage_rc(tid * 16 + i * 8192, R, C); const int Rb = Epi::PERM ? ((R & ~31) + perm32(R & 31)) : R;
        voffA[i] = (unsigned)(R * K + C) * 2u; voffB[i] = (unsigned)(Rb * K + C) * 2u; }
    const size_t kstep = (size_t)(BK * 2);
    const size_t hstep = (size_t)HALF * K * 2;
    const size_t tstep = 2 * hstep;
    const unsigned ldsw = (unsigned)wid * 1024u;
    const int aoff = lds_byte(wr * 64 + fr, fq * 8), boff = lds_byte(wc * 32 + fr, fq * 8);
#define PG8_SA(b, h) (((b) * 2 + (h)) * HTB)
#define PG8_SB(b, h) ((4 + (b) * 2 + (h)) * HTB)
#define PG8_STAGE(bufoff, gbase, voff) do { _Pragma("unroll") for (int _i = 0; _i < 2; ++_i) \
        __builtin_amdgcn_global_load_lds((const unsigned*)((const char*)(gbase) + (voff)[_i]), (PG8_LAS unsigned*)(lds + (bufoff) + ldsw + _i * 8192), 16, 0, 0); } while (0)
#define PG8_LDA(dst, b, h) do { _Pragma("unroll") for (int m = 0; m < 4; ++m) _Pragma("unroll") for (int k = 0; k < 2; ++k) dst[m][k] = *(const PG8_LAS bf16x8*)(lds + PG8_SA(b, h) + aoff + m * 2048 + k * 1024); } while (0)
#define PG8_LDB(dst, b, h) do { _Pragma("unroll") for (int n = 0; n < 2; ++n) _Pragma("unroll") for (int k = 0; k < 2; ++k) dst[n][k] = *(const PG8_LAS bf16x8*)(lds + PG8_SB(b, h) + boff + n * 2048 + k * 1024); } while (0)
#define PG8_MMA(ai, bj, At, Bt) do { __builtin_amdgcn_s_setprio(1); _Pragma("unroll") for (int m = 0; m < 4; ++m) _Pragma("unroll") for (int n = 0; n < 2; ++n) _Pragma("unroll") for (int k = 0; k < 2; ++k) \
        acc[ai][bj][m][n] = __builtin_amdgcn_mfma_f32_16x16x32_bf16(Bt[n][k], At[m][k], acc[ai][bj][m][n], 0, 0, 0); __builtin_amdgcn_s_setprio(0); } while (0)
#define PG8_WAIT_V(n) asm volatile("s_waitcnt vmcnt(" #n ")" ::: "memory")
#define PG8_WAIT_L(n) asm volatile("s_waitcnt lgkmcnt(" #n ")" ::: "memory")
#define PG8_BAR __builtin_amdgcn_s_barrier()
#define PG8_SCHED __builtin_amdgcn_sched_barrier(0)
    Unit cur, nxt; int ui = 0;
    if (!S.next(0, cur)) return;
    f32x4 acc[2][2][4][2];
#pragma unroll
    for (int a = 0; a < 2; ++a)
#pragma unroll
        for (int b = 0; b < 2; ++b)
#pragma unroll
            for (int m = 0; m < 4; ++m)
#pragma unroll
                for (int n = 0; n < 2; ++n) acc[a][b][m][n] = (f32x4){0.f, 0.f, 0.f, 0.f};
    bf16x8 At[4][2], B0[2][2], B1[2][2];
    const char* cA = (const char*)g.A + (size_t)cur.pm * tstep; const char* cB = (const char*)g.Bt + (size_t)cur.pn * tstep;
    S.a_ready(cur);
    PG8_STAGE(PG8_SB(0, 0), cB, voffB); PG8_STAGE(PG8_SA(0, 0), cA, voffA); PG8_STAGE(PG8_SB(0, 1), cB + hstep, voffB); PG8_STAGE(PG8_SA(0, 1), cA + hstep, voffA);
    if (wr == 1) PG8_BAR;
    PG8_WAIT_V(4); PG8_BAR;
    PG8_STAGE(PG8_SB(1, 0), cB + kstep, voffB); PG8_STAGE(PG8_SA(1, 0), cA + kstep, voffA); PG8_STAGE(PG8_SB(1, 1), cB + hstep + kstep, voffB);
    PG8_WAIT_V(6); PG8_BAR;
    PG8_STAMP();
    for (;;) {
        const bool has_next = S.next(ui + 1, nxt);
        const char* nA = has_next ? (const char*)g.A + (size_t)nxt.pm * tstep : cA; const char* nB = has_next ? (const char*)g.Bt + (size_t)nxt.pn * tstep : cB;
        for (int t = 0; t < nt; t += 2) {
            const bool last = (t == nt - 2);
            const char* a1 = cA + (size_t)(t + 1) * kstep;
            const char* a2 = last ? nA : cA + (size_t)(t + 2) * kstep; const char* b2 = last ? nB : cB + (size_t)(t + 2) * kstep;
            const char* a3 = a2 + kstep; const char* b3 = b2 + kstep;
            if (last && has_next) S.a_ready(nxt);
            PG8_LDB(B0, 0, 0); PG8_SCHED; PG8_LDA(At, 0, 0); PG8_STAGE(PG8_SA(1, 1), a1 + hstep, voffA);
            PG8_WAIT_L(8); PG8_BAR; PG8_WAIT_L(0); PG8_MMA(0, 0, At, B0); PG8_BAR; PG8_SCHED;
            PG8_LDB(B1, 0, 1); PG8_STAGE(PG8_SB(0, 0), b2, voffB);
            PG8_BAR; PG8_WAIT_L(0); PG8_MMA(0, 1, At, B1); PG8_BAR;
            PG8_LDA(At, 0, 1); PG8_STAGE(PG8_SA(0, 0), a2, voffA);
            PG8_BAR; PG8_WAIT_L(0); PG8_MMA(1, 0, At, B0); PG8_BAR; PG8_SCHED;
            PG8_STAGE(PG8_SB(0, 1), b2 + hstep, voffB);
            PG8_WAIT_V(6); PG8_BAR; PG8_MMA(1, 1, At, B1); PG8_BAR;
            PG8_LDB(B0, 1, 0); PG8_SCHED; PG8_LDA(At, 1, 0); PG8_STAGE(PG8_SA(0, 1), a2 + hstep, voffA);
            PG8_WAIT_L(8); PG8_BAR; PG8_WAIT_L(0); PG8_MMA(0, 0, At, B0); PG8_BAR; PG8_SCHED;
            PG8_LDB(B1, 1, 1); PG8_STAGE(PG8_SB(1, 0), b3, voffB);
            PG8_BAR; PG8_WAIT_L(0); PG8_MMA(0, 1, At, B1); PG8_BAR;
            PG8_LDA(At, 1, 1); PG8_STAGE(PG8_SA(1, 0), a3, voffA);
            PG8_BAR; PG8_WAIT_L(0); PG8_MMA(1, 0, At, B0); PG8_BAR; PG8_SCHED;
            PG8_STAGE(PG8_SB(1, 1), b3 + hstep, voffB);
            PG8_WAIT_V(6); PG8_BAR; PG8_MMA(1, 1, At, B1); PG8_BAR;
        }
        PG8_STAMP();
        if constexpr (!Epi::AFTER_DRAIN) { E(acc, cur, wr, wc, fr, fq); S.done(cur); }
        PG8_STAMP();
        if (!has_next) break;
#pragma unroll
        for (int a = 0; a < 2; ++a)
#pragma unroll
            for (int b = 0; b < 2; ++b)
#pragma unroll
                for (int m = 0; m < 4; ++m)
#pragma unroll
                    for (int n = 0; n < 2; ++n) acc[a][b][m][n] = (f32x4){0.f, 0.f, 0.f, 0.f};
        cur = nxt; cA = nA; cB = nB; ++ui;
    }
    PG8_WAIT_V(0);
    if (wr == 0) PG8_BAR;
    PG8_BAR;
    if constexpr (Epi::AFTER_DRAIN) { E.fused(acc, cur, wr, wc, fr, fq, lds, wid, lane); S.done(cur); }
    PG8_STAMP();
    if (STAMP && wid == 0) { stamps[lane] = lane < nts ? (((unsigned long long)(unsigned)ts_hi << 32) | (unsigned)ts_lo) : 0ull;
        if (lane == 62) stamps[62] = rt_entry; if (lane == 63) stamps[63] = (unsigned long long)wall_clock64(); }
#undef PG8_STAMP
#undef PG8_SA
#undef PG8_SB
#undef PG8_STAGE
#undef PG8_LDA
#undef PG8_LDB
#undef PG8_MMA
#undef PG8_WAIT_V
#undef PG8_WAIT_L
#undef PG8_BAR
#undef PG8_SCHED
}
template <class Epi, class Sched, class Gat, bool STAMP = false>
__device__ __forceinline__ void gemm_phase_gather(PG8_LAS unsigned char* lds, const Gemm g, const Sched& S, const Epi& E, const Gat& G, unsigned long long* stamps) {
    int tid_ = threadIdx.x; asm volatile("" : "+v"(tid_));
    const int tid = tid_, wid = __builtin_amdgcn_readfirstlane(tid >> 6), lane = tid & 63, wr = wid >> 2, wc = wid & 3, fr = lane & 15, fq = lane >> 4;
    const int K = g.K, nt = K / BK;
    int ts_lo = 0, ts_hi = 0, nts = 0; const unsigned long long rt_entry = STAMP ? (unsigned long long)wall_clock64() : 0ull;
#define PG8_STAMP() do { if (STAMP && wid == 0 && nts < 64) { const unsigned long long _c = (unsigned long long)clock64(); \
        ts_lo = (lane == nts) ? (int)(unsigned)_c : ts_lo; ts_hi = (lane == nts) ? (int)(unsigned)(_c >> 32) : ts_hi; ++nts; } } while (0)
    PG8_STAMP();
    unsigned voffA[2], voffB[2]; int RA[2]; unsigned CA2[2];
#pragma unroll
    for (int i = 0; i < 2; ++i) { int R, C; stage_rc(tid * 16 + i * 8192, R, C); const int Rb = Epi::PERM ? ((R & ~31) + perm32(R & 31)) : R;
        voffA[i] = (unsigned)(R * K + C) * 2u; voffB[i] = (unsigned)(Rb * K + C) * 2u; RA[i] = R; CA2[i] = (unsigned)C * 2u; }
    const size_t kstep = (size_t)(BK * 2);
    const size_t hstep = (size_t)HALF * K * 2;
    const size_t tstep = 2 * hstep;
    const unsigned ldsw = (unsigned)wid * 1024u;
    const int aoff = lds_byte(wr * 64 + fr, fq * 8), boff = lds_byte(wc * 32 + fr, fq * 8);
#define PG8_SA(b, h) (((b) * 2 + (h)) * HTB)
#define PG8_SB(b, h) ((4 + (b) * 2 + (h)) * HTB)
#define PG8_STAGE(bufoff, gbase, voff) do { _Pragma("unroll") for (int _i = 0; _i < 2; ++_i) \
        __builtin_amdgcn_global_load_lds((const unsigned*)((const char*)(gbase) + (voff)[_i]), (PG8_LAS unsigned*)(lds + (bufoff) + ldsw + _i * 8192), 16, 0, 0); } while (0)
#define PG8_LDA(dst, b, h) do { _Pragma("unroll") for (int m = 0; m < 4; ++m) _Pragma("unroll") for (int k = 0; k < 2; ++k) dst[m][k] = *(const PG8_LAS bf16x8*)(lds + PG8_SA(b, h) + aoff + m * 2048 + k * 1024); } while (0)
#define PG8_LDB(dst, b, h) do { _Pragma("unroll") for (int n = 0; n < 2; ++n) _Pragma("unroll") for (int k = 0; k < 2; ++k) dst[n][k] = *(const PG8_LAS bf16x8*)(lds + PG8_SB(b, h) + boff + n * 2048 + k * 1024); } while (0)
#define PG8_MMA(ai, bj, At, Bt) do { __builtin_amdgcn_s_setprio(1); _Pragma("unroll") for (int m = 0; m < 4; ++m) _Pragma("unroll") for (int n = 0; n < 2; ++n) _Pragma("unroll") for (int k = 0; k < 2; ++k) \
        acc[ai][bj][m][n] = __builtin_amdgcn_mfma_f32_16x16x32_bf16(Bt[n][k], At[m][k], acc[ai][bj][m][n], 0, 0, 0); __builtin_amdgcn_s_setprio(0); } while (0)
#define PG8_WAIT_V(n) asm volatile("s_waitcnt vmcnt(" #n ")" ::: "memory")
#define PG8_WAIT_L(n) asm volatile("s_waitcnt lgkmcnt(" #n ")" ::: "memory")
#define PG8_BAR __builtin_amdgcn_s_barrier()
#define PG8_SCHED __builtin_amdgcn_sched_barrier(0)
    Unit cur, nxt; int ui = 0;
    if (!S.next(0, cur)) return;
    f32x4 acc[2][2][4][2];
#pragma unroll
    for (int a = 0; a < 2; ++a)
#pragma unroll
        for (int b = 0; b < 2; ++b)
#pragma unroll
            for (int m = 0; m < 4; ++m)
#pragma unroll
                for (int n = 0; n < 2; ++n) acc[a][b][m][n] = (f32x4){0.f, 0.f, 0.f, 0.f};
    bf16x8 At[4][2], B0[2][2], B1[2][2];
    const char* Ab = (const char*)g.A; const char* cB = (const char*)g.Bt + (size_t)cur.pn * tstep;
    unsigned gc0[2], gc1[2], gn0[2], gn1[2];
#pragma unroll
    for (int i = 0; i < 2; ++i) { gc0[i] = G.rowoff(cur, RA[i]) + CA2[i]; gc1[i] = G.rowoff(cur, RA[i] + 128) + CA2[i]; }
    (void)voffA;
    S.a_ready(cur);
    PG8_STAGE(PG8_SB(0, 0), cB, voffB); PG8_STAGE(PG8_SA(0, 0), Ab, gc0); PG8_STAGE(PG8_SB(0, 1), cB + hstep, voffB); PG8_STAGE(PG8_SA(0, 1), Ab, gc1);
    if (wr == 1) PG8_BAR;
    PG8_WAIT_V(4); PG8_BAR;
    PG8_STAGE(PG8_SB(1, 0), cB + kstep, voffB); PG8_STAGE(PG8_SA(1, 0), Ab + kstep, gc0); PG8_STAGE(PG8_SB(1, 1), cB + hstep + kstep, voffB);
    PG8_WAIT_V(6); PG8_BAR;
    PG8_STAMP();
    for (;;) {
        const bool has_next = S.next(ui + 1, nxt);
        const char* nB = has_next ? (const char*)g.Bt + (size_t)nxt.pn * tstep : cB;
#pragma unroll
        for (int i = 0; i < 2; ++i) { gn0[i] = has_next ? G.rowoff(nxt, RA[i]) + CA2[i] : gc0[i]; gn1[i] = has_next ? G.rowoff(nxt, RA[i] + 128) + CA2[i] : gc1[i]; }
        for (int t = 0; t < nt; t += 2) {
            const bool last = (t == nt - 2);
            const char* a1 = Ab + (size_t)(t + 1) * kstep;
            const char* a2 = last ? Ab : Ab + (size_t)(t + 2) * kstep; const char* b2 = last ? nB : cB + (size_t)(t + 2) * kstep;
            unsigned g2a[2], g2b[2];
#pragma unroll
            for (int i = 0; i < 2; ++i) { g2a[i] = last ? gn0[i] : gc0[i]; g2b[i] = last ? gn1[i] : gc1[i]; }
            const char* a3 = a2 + kstep; const char* b3 = b2 + kstep;
            if (last && has_next) S.a_ready(nxt);
            PG8_LDB(B0, 0, 0); PG8_SCHED; PG8_LDA(At, 0, 0); PG8_STAGE(PG8_SA(1, 1), a1, gc1);
            PG8_WAIT_L(8); PG8_BAR; PG8_WAIT_L(0); PG8_MMA(0, 0, At, B0); PG8_BAR; PG8_SCHED;
            PG8_LDB(B1, 0, 1); PG8_STAGE(PG8_SB(0, 0), b2, voffB);
            PG8_BAR; PG8_WAIT_L(0); PG8_MMA(0, 1, At, B1); PG8_BAR;
            PG8_LDA(At, 0, 1); PG8_STAGE(PG8_SA(0, 0), a2, g2a);
            PG8_BAR; PG8_WAIT_L(0); PG8_MMA(1, 0, At, B0); PG8_BAR; PG8_SCHED;
            PG8_STAGE(PG8_SB(0, 1), b2 + hstep, voffB);
            PG8_WAIT_V(6); PG8_BAR; PG8_MMA(1, 1, At, B1); PG8_BAR;
            PG8_LDB(B0, 1, 0); PG8_SCHED; PG8_LDA(At, 1, 0); PG8_STAGE(PG8_SA(0, 1), a2, g2b);
            PG8_WAIT_L(8); PG8_BAR; PG8_WAIT_L(0); PG8_MMA(0, 0, At, B0); PG8_BAR; PG8_SCHED;
            PG8_LDB(B1, 1, 1); PG8_STAGE(PG8_SB(1, 0), b3, voffB);
            PG8_BAR; PG8_WAIT_L(0); PG8_MMA(0, 1, At, B1); PG8_BAR;
            PG8_LDA(At, 1, 1); PG8_STAGE(PG8_SA(1, 0), a3, g2a);
            PG8_BAR; PG8_WAIT_L(0); PG8_MMA(1, 0, At, B0); PG8_BAR; PG8_SCHED;
            PG8_STAGE(PG8_SB(1, 1), b3 + hstep, voffB);
            PG8_WAIT_V(6); PG8_BAR; PG8_MMA(1, 1, At, B1); PG8_BAR;
        }
        PG8_STAMP();
        if constexpr (!Epi::AFTER_DRAIN) { E(acc, cur, wr, wc, fr, fq); S.done(cur); }
        PG8_STAMP();
        if (!has_next) break;
#pragma unroll
        for (int a = 0; a < 2; ++a)
#pragma unroll
            for (int b = 0; b < 2; ++b)
#pragma unroll
                for (int m = 0; m < 4; ++m)
#pragma unroll
                    for (int n = 0; n < 2; ++n) acc[a][b][m][n] = (f32x4){0.f, 0.f, 0.f, 0.f};
        cur = nxt; cB = nB; ++ui;
#pragma unroll
        for (int i = 0; i < 2; ++i) { gc0[i] = gn0[i]; gc1[i] = gn1[i]; }
    }
    PG8_WAIT_V(0);
    if (wr == 0) PG8_BAR;
    PG8_BAR;
    if constexpr (Epi::AFTER_DRAIN) { E.fused(acc, cur, wr, wc, fr, fq, lds, wid, lane); S.done(cur); }
    PG8_STAMP();
    if (STAMP && wid == 0) { stamps[lane] = lane < nts ? (((unsigned long long)(unsigned)ts_hi << 32) | (unsigned)ts_lo) : 0ull;
        if (lane == 62) stamps[62] = rt_entry; if (lane == 63) stamps[63] = (unsigned long long)wall_clock64(); }
#undef PG8_STAMP
#undef PG8_SA
#undef PG8_SB
#undef PG8_STAGE
#undef PG8_LDA
#undef PG8_LDB
#undef PG8_MMA
#undef PG8_WAIT_V
#undef PG8_WAIT_L
#undef PG8_BAR
#undef PG8_SCHED
}
}

constexpr size_t WS_WINT = 284 * MB;
constexpr size_t WS_WOUTT = 1 * MB;
constexpr int NPAD_IN = 4352;
DI void transpose_tile(const float* W, int ldw, int k0, int n0, int nvalid, bfr* WT, int ldt, char* smem) {
  short* T = (short*)smem;
  const int tid = VT;
  __syncthreads();
  {
    const int r = tid >> 2, c4 = tid & 3;
#pragma unroll
    for (int q = 0; q < 4; ++q) {
      const int n = n0 + 16 * c4 + 4 * q;
      f32x4 v = {0.f, 0.f, 0.f, 0.f};
      if (n < nvalid) v = *(const f32x4*)(W + (size_t)(k0 + r) * ldw + n);
#pragma unroll
      for (int e = 0; e < 4; ++e) T[r * 66 + 16 * c4 + 4 * q + e] = (short)f2bf(v[e]);
    }
  }
  __syncthreads();
  {
    const int n = tid >> 2, kq = tid & 3;
    unsigned wv[8];
#pragma unroll
    for (int e = 0; e < 8; ++e) wv[e] = ((unsigned)(unsigned short)T[(16 * kq + 2 * e) * 66 + n]) | (((unsigned)(unsigned short)T[(16 * kq + 2 * e + 1) * 66 + n]) << 16);
    bfr* dst = WT + (size_t)(n0 + n) * ldt + k0 + 16 * kq;
    *(uint4*)dst = uint4{wv[0], wv[1], wv[2], wv[3]};
    *(uint4*)(dst + 8) = uint4{wv[4], wv[5], wv[6], wv[7]};
  }
}
template <int LDC, int NVALID> struct EpiBf16T {
  static constexpr bool PERM = true, AFTER_DRAIN = false;
  bfr* O;
  DI void operator()(const pg8::f32x4 (&acc)[2][2][4][2], const pg8::Unit& u, int wr, int wc, int fr, int fq) const {
    const int row0 = u.pm * 256 + wr * 64 + fr, col0 = u.pn * 256 + wc * 32 + 8 * fq;
#pragma unroll
    for (int ai = 0; ai < 2; ++ai)
#pragma unroll
      for (int m = 0; m < 4; ++m) {
        bfr* rowp = O + (size_t)(row0 + ai * 128 + m * 16) * LDC + col0;
#pragma unroll
        for (int bj = 0; bj < 2; ++bj) {
          if (col0 + bj * 128 < NVALID) {
            const pg8::f32x4 v0 = acc[ai][bj][m][0], v1 = acc[ai][bj][m][1];
            *(uint4*)(rowp + bj * 128) = uint4{pack2(v0[0], v0[1]), pack2(v0[2], v0[3]), pack2(v1[0], v1[1]), pack2(v1[2], v1[3])};
          }
        }
      }
  }
};
DI void phase_pgemm8(CParams& P, char* smem_all) {
  pg8::Gemm g{(const pg8::bf16_t*)(P.ws + WS_H), (const pg8::bf16_t*)(P.ws + WS_WINT), T_ALL, NPAD_IN, DM};
  pg8::StaticOrder S; S.init(T_ALL, NPAD_IN, (int)gridDim.x, (int)blockIdx.x);
  typedef EpiBf16T<DIN, DIN> EpiP;
  EpiP E{(bfr*)(P.ws + WS_P)};
  pg8::gemm_phase<EpiP, pg8::StaticOrder>((PG8_LAS unsigned char*)smem_all, g, S, E, nullptr);
}
DI void phase_outproj8(CParams& P, char* smem_all) {
  pg8::Gemm g{(const pg8::bf16_t*)(P.ws + WS_MIX), (const pg8::bf16_t*)(P.ws + WS_WOUTT), T_LAT, DM, DM};
  pg8::StaticOrder S; S.init(T_LAT, DM, (int)gridDim.x, (int)blockIdx.x);
  typedef EpiBf16T<DM, DM> EpiY;
  EpiY E{(bfr*)(P.ws + WS_Y)};
  pg8::gemm_phase<EpiY, pg8::StaticOrder>((PG8_LAS unsigned char*)smem_all, g, S, E, nullptr);
}


constexpr size_t WS_BTGU = 350 * MB;
constexpr size_t WS_BTD = 284 * MB;
constexpr size_t WS_HID8 = 138 * MB;
constexpr size_t WS_MOUT8 = 42 * MB;
constexpr int TAB_LDS_OFF = 131072 + 1024;

DI void transpose_quad(const float* W, int ldw, int k0, int n0, bfr* WT, int ldt, int dr0, int dr1, int dr2, int dr3, char* smem, int nvalid = 1 << 30) {
  short* T = (short*)smem;
  const int tid = VT;
  const int r = tid >> 2, c4 = tid & 3;
  f32x4 v[4][4];
#pragma unroll
  for (int j = 0; j < 4; ++j)
#pragma unroll
    for (int q = 0; q < 4; ++q) { const int n_ = n0 + j * 64 + 16 * c4 + 4 * q; v[j][q] = n_ < nvalid ? *(const f32x4*)(W + (size_t)(k0 + r) * ldw + n_) : f32x4{0.f, 0.f, 0.f, 0.f}; }
  __syncthreads();
#pragma unroll
  for (int j = 0; j < 4; ++j)
#pragma unroll
    for (int q = 0; q < 4; ++q)
#pragma unroll
      for (int e = 0; e < 4; ++e) T[j * 64 * 66 + r * 66 + 16 * c4 + 4 * q + e] = (short)f2bf(v[j][q][e]);
  __syncthreads();
  const int n = tid >> 2, kq = tid & 3;
#pragma unroll
  for (int j = 0; j < 4; ++j) {
    unsigned wv[8];
#pragma unroll
    for (int e = 0; e < 8; ++e) wv[e] = ((unsigned)(unsigned short)T[j * 64 * 66 + (16 * kq + 2 * e) * 66 + n]) | (((unsigned)(unsigned short)T[j * 64 * 66 + (16 * kq + 2 * e + 1) * 66 + n]) << 16);
    const int dr = j == 0 ? dr0 : j == 1 ? dr1 : j == 2 ? dr2 : dr3;
    bfr* dst = WT + (size_t)(dr + n) * ldt + k0 + 16 * kq;
    *(uint4*)dst = uint4{wv[0], wv[1], wv[2], wv[3]};
    *(uint4*)(dst + 8) = uint4{wv[4], wv[5], wv[6], wv[7]};
  }
}
DI void phase_moe_convert_gu(CParams& P, int bid, int nb, char* smem) {
  for (int it = bid; it < 64 * 64; it += nb) {
    const int e = it >> 6, s = it & 63;
    const int isup = s >> 5, kt = (s & 31) >> 1, nq = s & 1;
    const float* W = (isup ? P.in[30] : P.in[29]) + (size_t)e * DM * DEXP;
    bfr* WT = (bfr*)(P.ws + WS_BTGU) + (size_t)e * 1024 * 1024;
    const int b = nq * 4;
    transpose_quad(W, DEXP, kt * 64, nq * 256, WT, 1024,
                   ((b + 0) >> 1) * 256 + isup * 128 + ((b + 0) & 1) * 64, ((b + 1) >> 1) * 256 + isup * 128 + ((b + 1) & 1) * 64,
                   ((b + 2) >> 1) * 256 + isup * 128 + ((b + 2) & 1) * 64, ((b + 3) >> 1) * 256 + isup * 128 + ((b + 3) & 1) * 64, smem);
  }
}
constexpr int CONVD_ITEMS = 64 * 32, CONVD_SPLIT = 1152;
DI void phase_moe_convert_d(CParams& P, int bid, int nb, char* smem, int it_lo, int it_hi) {
  for (int it = it_lo + bid; it < it_hi; it += nb) {
    const int e = it >> 5, s2 = it & 31, kt = s2 >> 2, nq = s2 & 3;
    const float* W = P.in[31] + (size_t)e * DEXP * DM;
    bfr* WT = (bfr*)(P.ws + WS_BTD) + (size_t)e * 1024 * 512;
    transpose_quad(W, DM, kt * 64, nq * 256, WT, 512, nq * 256, nq * 256 + 64, nq * 256 + 128, nq * 256 + 192, smem);
  }
}
DI void moe_block_table256(CParams& P, int* tab  ) {
  const int* cnt = (const int*)(P.ws + WS_CNT);
  __syncthreads();
  const int t = tx_();
  if (t < 64) {
    int incl = (cnt[t] + 255) >> 8;
#pragma unroll
    for (int o = 1; o < 64; o <<= 1) { int u = __shfl_up(incl, o); if (t >= o) incl += u; }
    tab[t + 1] = incl;
    if (t == 0) tab[0] = 0;
  }
  __syncthreads();
}
struct MoeOrder {
  const int* tab; int nunits, G, c;
  DI bool next(int i, pg8::Unit& u) const {
    const int L = i * G + c; if (L >= nunits) return false;
    const int rb = L >> 2; int e = 0; while (tab[e + 1] <= rb) ++e;
    u.pm = rb; u.pn = e * 4 + (L & 3); return true;
  }
  DI void a_ready(const pg8::Unit&) const {}
  DI void done(const pg8::Unit&) const {}
};
struct EpiHid {
  static constexpr bool PERM = true, AFTER_DRAIN = false;
  bfr* H;
  DI void operator()(const pg8::f32x4 (&acc)[2][2][4][2], const pg8::Unit& u, int wr, int wc, int fr, int fq) const {
    const int row0 = u.pm * 256 + wr * 64 + fr, col0 = (u.pn & 3) * 128 + wc * 32 + 8 * fq;
#pragma unroll
    for (int ai = 0; ai < 2; ++ai)
#pragma unroll
      for (int m = 0; m < 4; ++m) {
        float hv[8];
#pragma unroll
        for (int n = 0; n < 2; ++n)
#pragma unroll
          for (int j = 0; j < 4; ++j) hv[4 * n + j] = siluf_(acc[ai][0][m][n][j]) * acc[ai][1][m][n][j];
        *(uint4*)(H + (size_t)(row0 + ai * 128 + m * 16) * DEXP + col0) = uint4{pack2(hv[0], hv[1]), pack2(hv[2], hv[3]), pack2(hv[4], hv[5]), pack2(hv[6], hv[7])};
      }
  }
};
struct EpiMout {
  static constexpr bool PERM = true, AFTER_DRAIN = false;
  bfr* O; const int* tab; const int* cnt; const int* list;
  DI void operator()(const pg8::f32x4 (&acc)[2][2][4][2], const pg8::Unit& u, int wr, int wc, int fr, int fq) const {
    const int e = u.pn >> 2, pnl = u.pn & 3;
    const int lrow0 = (u.pm - tab[e]) * 256 + wr * 64 + fr, ce = cnt[e];
    const int col0 = pnl * 256 + wc * 32 + 8 * fq;
#pragma unroll
    for (int ai = 0; ai < 2; ++ai)
#pragma unroll
      for (int m = 0; m < 4; ++m) {
        const int idx = lrow0 + ai * 128 + m * 16;
        if (idx < ce) {
          const int asg = list[e * T_LAT + idx];
          bfr* rowp = O + (size_t)asg * DM + col0;
#pragma unroll
          for (int bj = 0; bj < 2; ++bj) {
            const pg8::f32x4 v0 = acc[ai][bj][m][0], v1 = acc[ai][bj][m][1];
            *(uint4*)(rowp + bj * 128) = uint4{pack2(v0[0], v0[1]), pack2(v0[2], v0[3]), pack2(v1[0], v1[1]), pack2(v1[2], v1[3])};
          }
        }
      }
  }
};
struct MoeGather {
  const int* tab; const int* cnt; const int* list;
  DI unsigned rowoff(const pg8::Unit& u, int r) const {
    const int e = u.pn >> 2, idx = (u.pm - tab[e]) * 256 + r;
    const int tok = idx < cnt[e] ? (list[e * T_LAT + idx] >> 1) : 0;
    return (unsigned)tok * (unsigned)(DM * 2);
  }
};
DI void phase_moe1_8(CParams& P, char* smem_all) {
  int* tab = (int*)(smem_all + TAB_LDS_OFF);
  moe_block_table256(P, tab);
  const int nrb = tab[64];
  pg8::Gemm g{(const pg8::bf16_t*)(P.ws + WS_H2), (const pg8::bf16_t*)(P.ws + WS_BTGU), nrb * 256, 64 * 1024, DM};
  MoeOrder S{tab, nrb * 4, (int)gridDim.x, (int)blockIdx.x};
  EpiHid E{(bfr*)(P.ws + WS_HID8)};
  MoeGather G{tab, (const int*)(P.ws + WS_CNT), (const int*)(P.ws + WS_LIST)};
  pg8::gemm_phase_gather<EpiHid, MoeOrder, MoeGather>((PG8_LAS unsigned char*)smem_all, g, S, E, G, nullptr);
  const int G_ = (int)gridDim.x, nunits = nrb * 4;
  const int rounds = (nunits + G_ - 1) / G_, first_idle = nunits - (rounds - 1) * G_;
  if (first_idle < G_ && (int)blockIdx.x >= first_idle) {
    const int half = __builtin_amdgcn_readfirstlane((int)(threadIdx.x >> 8));
    phase_moe_convert_d(P, ((int)blockIdx.x - first_idle) * 2 + half, (G_ - first_idle) * 2, smem_all + half * 78080, CONVD_SPLIT, CONVD_ITEMS);
  } else if (first_idle >= G_) {
    const int half = __builtin_amdgcn_readfirstlane((int)(threadIdx.x >> 8));
    phase_moe_convert_d(P, (int)blockIdx.x * 2 + half, G_ * 2, smem_all + half * 78080, CONVD_SPLIT, CONVD_ITEMS);
  }
}
DI void phase_moe2_8(CParams& P, char* smem_all) {
  int* tab = (int*)(smem_all + TAB_LDS_OFF);
  moe_block_table256(P, tab);
  const int nrb = tab[64];
  pg8::Gemm g{(const pg8::bf16_t*)(P.ws + WS_HID8), (const pg8::bf16_t*)(P.ws + WS_BTD), nrb * 256, 64 * 1024, DEXP};
  MoeOrder S{tab, nrb * 4, (int)gridDim.x, (int)blockIdx.x};
  EpiMout E{(bfr*)(P.ws + WS_MOUT8), tab, (const int*)(P.ws + WS_CNT), (const int*)(P.ws + WS_LIST)};
  pg8::gemm_phase<EpiMout, MoeOrder>((PG8_LAS unsigned char*)smem_all, g, S, E, nullptr);
}

#define XB_TMO      128
#define XB_XCNT(j)  (256  + 64 * (j))
#define XB_XSUB(j)  (1280 + 64 * (j))
#define XB_XGEN(j)  (2304 + 64 * (j))
#define XB_TOP      3328
#define XB_TOPGEN   3392
#define XCD_BAR_WORDS 3456
#define XB_SPIN_CAP (1u << 22)
#define LAS __attribute__((address_space(3)))
DI unsigned xb_ld(unsigned* p)              { return __hip_atomic_load(p, __ATOMIC_RELAXED, __HIP_MEMORY_SCOPE_AGENT); }
DI unsigned xb_add(unsigned* p, unsigned v) { return __hip_atomic_fetch_add(p, v, __ATOMIC_RELAXED, __HIP_MEMORY_SCOPE_AGENT); }
DI unsigned xb_xcc_id() { return (unsigned)__builtin_amdgcn_s_getreg((3 << 11) | 20) & 0xFu; }
#define XB_SPIN(cond, bar) do { unsigned _sp = 0; while (cond) { __builtin_amdgcn_s_sleep(1); \
    if ((++_sp & 255u) == 0u) { if (xb_ld(&(bar)[XB_TMO])) break; if (_sp > XB_SPIN_CAP) { atomicAdd(&(bar)[XB_TMO], 1u); break; } } } } while (0)
struct XcdBarrier { unsigned* bar; unsigned x; volatile LAS unsigned* st; };
DI XcdBarrier xcd_barrier_post(unsigned* bar, volatile LAS unsigned* st) {
  XcdBarrier b; b.bar = bar; b.x = xb_xcc_id(); b.st = st;
  if (threadIdx.x == 0) (void)xb_add(&bar[XB_XCNT(b.x)], 1u);
  return b;
}
DI void xcd_barrier_complete(unsigned* bar, unsigned x, unsigned& nloc, unsigned& nx) {
  const unsigned G = gridDim.x * gridDim.y * gridDim.z;
  unsigned sum, cnt, mine, sp = 0u;
  for (;;) {
    sum = 0u; cnt = 0u; mine = 0u;
#pragma unroll
    for (unsigned j = 0; j < 16; ++j) { const unsigned c = xb_ld(&bar[XB_XCNT(j)]); sum += c; cnt += (c > 0u) ? 1u : 0u; mine = (j == x) ? c : mine; }
    if (sum == G) break;
    __builtin_amdgcn_s_sleep(1);
    if ((++sp & 255u) == 0u) { if (xb_ld(&bar[XB_TMO])) break; if (sp > XB_SPIN_CAP) { atomicAdd(&bar[XB_TMO], 1u); break; } }
  }
  nloc = mine > 0u ? mine : 1u; nx = cnt > 0u ? cnt : 1u;
}
DI void xcd_barrier(const XcdBarrier& b) {
  asm volatile("s_waitcnt vmcnt(0)" ::: "memory");
  __syncthreads();
  if (threadIdx.x == 0) {
    unsigned* bar = b.bar;
    __builtin_amdgcn_s_waitcnt(0);
    unsigned nloc = b.st[0], nx = b.st[1];
    if (nloc == 0u) { xcd_barrier_complete(bar, b.x, nloc, nx); b.st[0] = nloc; b.st[1] = nx; }
    const unsigned old = xb_add(&bar[XB_XSUB(b.x)], 1u);
    const unsigned gen = old / nloc;
    if (old + 1u == (gen + 1u) * nloc) {
      __builtin_amdgcn_fence(__ATOMIC_RELEASE, "agent");
      asm volatile("s_waitcnt vmcnt(0)" ::: "memory");
      const unsigned og = xb_add(&bar[XB_TOP], 1u);
      const unsigned tg = og / nx;
      if (og + 1u == (tg + 1u) * nx) xb_add(&bar[XB_TOPGEN], 1u);
      else XB_SPIN(xb_ld(&bar[XB_TOPGEN]) == tg, bar);
      __builtin_amdgcn_fence(__ATOMIC_ACQUIRE, "agent");
      xb_add(&bar[XB_XGEN(b.x)], 1u);
      asm volatile("s_waitcnt vmcnt(0)" ::: "memory");
    } else {
      XB_SPIN(xb_ld(&bar[XB_XGEN(b.x)]) == gen, bar);
      __builtin_amdgcn_fence(__ATOMIC_ACQUIRE, "agent");
      asm volatile("s_waitcnt vmcnt(0)" ::: "memory");
    }
  }
  __syncthreads();
}

namespace cg = cooperative_groups;
constexpr int HALF_LDS = 78080;
constexpr int SMEM_BYTES = 2 * HALF_LDS + 16;
__global__ void __launch_bounds__(NTHR_BLOCK) k_fused(Params Pval) {
  __shared__ __attribute__((aligned(16))) char smem_all[SMEM_BYTES];
  cg::grid_group grid = cg::this_grid();
  CParams* kp0 = (CParams*)__builtin_amdgcn_kernarg_segment_ptr();
#define PH(call) do { CParams* kp_ = kp0; asm volatile("" : "+s"(kp_)); CParams& P = *kp_; \
    int half = __builtin_amdgcn_readfirstlane((int)(threadIdx.x >> 8)); asm volatile("" : "+s"(half)); \
    char* smem = smem_all + half * HALF_LDS; const int bid = blockIdx.x * 2 + half, nb = gridDim.x * 2; (void)smem; (void)bid; (void)nb; call; } while (0)
  volatile LAS unsigned* bst = (volatile LAS unsigned*)(smem_all + SMEM_BYTES - 16);
  if (threadIdx.x < 4) bst[threadIdx.x] = 0u;
  __syncthreads();
  XcdBarrier xb = xcd_barrier_post(Pval.bar, bst);
#define GSYNC() do { if (Pval.use_cg) grid.sync(); else xcd_barrier(xb); } while (0)
  PH(phase_mod(P, bid, nb, smem));
  GSYNC();
  PH(phase_ln1(P, bid, nb));
  GSYNC();
  PH(phase_pgemm8(P, smem_all));
  GSYNC();
  PH(phase_rwprep(P, bid, nb, smem));
  GSYNC();
  PH(for (int it = bid; it < 16 * RW_NSC; it += nb) rw_levelA_item(P, it / RW_NSC, it % RW_NSC, smem));
  PH(for (int it = bid; it < 8 * HG_NSC; it += nb) hg_levelA_item(P, it / HG_NSC, it % HG_NSC, smem));
  GSYNC();
  PH(if (bid < 16) rw_levelB_chain(P, bid, smem); else { hg_levelB(P, bid - 16, nb - 16); phase_moe_convert_d(P, bid - 16, nb - 16, smem, 0, CONVD_SPLIT); });
  GSYNC();
  PH(phase_readout_fused(P, bid, nb));
  GSYNC();
  PH(phase_outproj8(P, smem_all));
  PH(phase_moe_convert_gu(P, bid, nb, smem));
  GSYNC();
  PH(phase_ln2route(P, smem_all));
  GSYNC();
  PH(phase_moe1_8(P, smem_all));
  GSYNC();
  PH(phase_moe2_8(P, smem_all));
  GSYNC();
  PH(phase_final(P, bid, nb));
}

extern "C" void kernel_launch(void* const* d_in, const int* in_sizes, int n_in, void* d_out, int out_size, void* d_ws, size_t ws_size, hipStream_t stream) {
  static int grid_blocks = 0;
  if (!grid_blocks) {
    int dev = 0, cus = 0, per_cu = 0;
    hipGetDevice(&dev);
    hipDeviceGetAttribute(&cus, hipDeviceAttributeMultiprocessorCount, dev);
    hipOccupancyMaxActiveBlocksPerMultiprocessor(&per_cu, k_fused, NTHR_BLOCK, 0);
    if (per_cu > 1) per_cu = 1;
    if (per_cu < 1) per_cu = 1;
    grid_blocks = cus * per_cu;
  }
  Params P{};
  P.bar = (unsigned*)((char*)d_ws + WS_BAR); P.use_cg = 0; P.pad = 0;
  hipMemsetAsync((char*)d_ws + WS_BAR, 0, XCD_BAR_WORDS * 4, stream);
  for (int i = 0; i < 32; ++i) P.in[i] = (const float*)d_in[i];
  P.out = (float*)d_out; P.ws = (char*)d_ws;
  void* args[] = {&P};
  hipError_t e = hipLaunchCooperativeKernel((void*)k_fused, dim3(grid_blocks), dim3(NTHR_BLOCK), args, 0, stream);
  if (e != hipSuccess) fprintf(stderr, "cooperative launch failed: %s (grid %d)\n", hipGetErrorString(e), grid_blocks);
}
```

```cpp
#include <hip/hip_runtime.h>
#include <hip/hip_cooperative_groups.h>
#include <cstdio>

typedef __attribute__((ext_vector_type(8))) short bf16x8;
typedef __attribute__((ext_vector_type(4))) short s16x4;
typedef __attribute__((ext_vector_type(4))) float f32x4;
typedef __attribute__((ext_vector_type(2))) float f32x2;
typedef __attribute__((ext_vector_type(2))) __bf16 bf16x2_t;
typedef unsigned short bfr;

#define DI __device__ __forceinline__

constexpr int T_LAT = 16384, T_CTX = 256, T_ALL = T_LAT + T_CTX;
constexpr int DM = 1024, DIN = 4288, HGC = 2560, RWC = 1728, DRW = 512, DHG = 512;
constexpr int NEXP = 64, DEXP = 512;
constexpr int NTHR = 256;
constexpr int NTHR_BLOCK = 512;
#define VT ((int)(threadIdx.x & 255))
__device__ __forceinline__ int tx_() { int t = (int)threadIdx.x; asm volatile("" : "+v"(t)); return t; }
constexpr float DN_ALPHA = 1.189207115002721f;
constexpr float RW_DECAY_SCALE = 0.6065306597126334f;

constexpr size_t MB = 1ull << 20;
constexpr size_t WS_MOD = 0;
constexpr size_t WS_MODC = 32768;
constexpr size_t WS_LB = 65536;
constexpr size_t WS_CNT = 65536 + 8192;
constexpr size_t WS_BAR = 81920;
constexpr size_t WS_ASGW = 131072;
constexpr size_t WS_LIST = 1 * MB;
constexpr size_t WS_H = 6 * MB;
constexpr size_t WS_P = 42 * MB;
constexpr size_t WS_Y = 42 * MB;
constexpr size_t WS_H2 = 106 * MB;
constexpr size_t WS_RW = 186 * MB;
constexpr size_t RW_ARR = (size_t)T_ALL * 512 * 2;
constexpr size_t WS_X1B = 6 * MB;
constexpr size_t WS_MIX = WS_RW + 3 * RW_ARR;
constexpr size_t WS_LW = 284 * MB;
constexpr size_t LW_ARR = (size_t)T_ALL * 512 * 4;

struct Params {
  const float* in[32];
  float* out;
  char* ws;
  unsigned* bar;
  int use_cg;
  int pad;
};
typedef const __attribute__((address_space(4))) Params CParams;

DI unsigned pack2(float a, float b) {
  f32x2 v = {a, b};
  bf16x2_t r = __builtin_convertvector(v, bf16x2_t);
  return __builtin_bit_cast(unsigned, r);
}
DI bfr f2bf(float a) { return (bfr)(pack2(a, 0.f) & 0xffffu); }
DI float bf2f(bfr v) { return __uint_as_float(((unsigned)v) << 16); }
DI float frcp_(float x) { return __builtin_amdgcn_rcpf(x); }
DI float sigmoidf_(float x) { return frcp_(1.f + __expf(-x)); }
DI float siluf_(float x) { return x * frcp_(1.f + __expf(-x)); }
DI f32x4 ld4bf(const bfr* p);
DI float wave_sum(float v) {
#pragma unroll
  for (int o = 32; o > 0; o >>= 1) v += __shfl_xor(v, o);
  return v;
}

DI void phase_lora_convert(CParams& P, int part, int nparts);
DI void phase_wrt_convert(CParams& P, int part, int nparts);
DI void transpose_tile(const float* W, int ldw, int k0, int n0, int nvalid, bfr* WT, int ldt, char* smem);
DI void transpose_quad(const float* W, int ldw, int k0, int n0, bfr* WT, int ldt, int dr0, int dr1, int dr2, int dr3, char* smem, int nvalid);
DI void phase_mod(CParams& P, int bid, int nb, char* smem) {
  const float* c = P.in[1]; const float* cc = P.in[3];
  const float* w_mod = P.in[4]; const float* b_mod = P.in[5];
  float* mod = (float*)(P.ws + WS_MOD); float* modc = (float*)(P.ws + WS_MODC);
  float* red = (float*)smem;
  const int tid = VT;
  for (int it = bid; it < 542; it += nb) {
    if (it < 192) {
      const int kq = tid >> 3, c4 = tid & 7;
      const int col = it * 32 + c4 * 4;
      f32x4 a1 = {0, 0, 0, 0}, a2 = {0, 0, 0, 0};
      for (int k = kq; k < DM; k += 32) {
        f32x4 w = *(const f32x4*)(w_mod + (long)k * 6144 + col);
        float s1 = siluf_(c[k]), s2 = siluf_(cc[k]);
        a1 += w * s1; a2 += w * s2;
      }
      __syncthreads();
#pragma unroll
      for (int e = 0; e < 4; ++e) { red[(kq * 32) + c4 * 4 + e] = a1[e]; red[1024 + kq * 32 + c4 * 4 + e] = a2[e]; }
      __syncthreads();
      if (tid < 64) {
        const int which = tid >> 5, cl = tid & 31;
        float s = 0.f;
        for (int q = 0; q < 32; ++q) s += red[which * 1024 + q * 32 + cl];
        const int cg = it * 32 + cl;
        s += b_mod[cg];
        if (which == 0) mod[cg] = s; else modc[cg] = s;
      }
    } else if (it == 192) {
      const float* L = P.in[8];
      float* lb = (float*)(P.ws + WS_LB);
      for (int i = tid; i < 1024; i += NTHR) {
        const int d = i >> 9, j = i & 511;
        float l0 = L[d * 1024 + j], l1 = L[d * 1024 + 512 + j];
        lb[i] = 1.f / (1.f + __expf(l1 - l0));
      }
    } else if (it == 193) {
      int* cnt = (int*)(P.ws + WS_CNT);
      if (tid < 64) cnt[tid] = 0;
    } else if (it < 198) {
      phase_lora_convert(P, it - 194, 4);
    } else if (it < 470) {
      const int t = it - 198, kt = t / 17, nq = t % 17;
      transpose_quad(P.in[6], DIN, kt * 64, nq * 256, (bfr*)(P.ws + (284ull << 20)), DM, nq * 256, nq * 256 + 64, nq * 256 + 128, nq * 256 + 192, smem, DIN);
    } else if (it < 534) {
      const int t = it - 470, kt = t >> 2, nq = t & 3;
      transpose_quad(P.in[7], DM, kt * 64, nq * 256, (bfr*)(P.ws + (1ull << 20)), DM, nq * 256, nq * 256 + 64, nq * 256 + 128, nq * 256 + 192, smem, DM);
    } else {
      phase_wrt_convert(P, it - 534, 8);
    }
  }
}

DI void phase_ln1(CParams& P, int bid, int nb) {
  const float* x = P.in[0]; const float* ctx = P.in[2];
  const float* mod = (const float*)(P.ws + WS_MOD); const float* modc = (const float*)(P.ws + WS_MODC);
  bfr* h = (bfr*)(P.ws + WS_H);
  const int wid = VT >> 6, lane = VT & 63;
  for (int row0 = (bid * 4 + wid) * 2; row0 < T_ALL; row0 += nb * 8) {
    const float* src = row0 < T_LAT ? x + (long)row0 * DM : ctx + (long)(row0 - T_LAT) * DM;
    const float* mm = row0 < T_LAT ? mod : modc;
    f32x4 v[2][4];
    float s[2] = {0.f, 0.f};
#pragma unroll
    for (int r = 0; r < 2; ++r)
#pragma unroll
      for (int i = 0; i < 4; ++i) { v[r][i] = *(const f32x4*)(src + r * DM + lane * 4 + 256 * i); s[r] += v[r][i][0] + v[r][i][1] + v[r][i][2] + v[r][i][3]; }
#pragma unroll
    for (int r = 0; r < 2; ++r) {
      const float mu = wave_sum(s[r]) * (1.f / DM);
      float q = 0.f;
#pragma unroll
      for (int i = 0; i < 4; ++i) { v[r][i] -= mu; q += v[r][i][0] * v[r][i][0] + v[r][i][1] * v[r][i][1] + v[r][i][2] * v[r][i][2] + v[r][i][3] * v[r][i][3]; }
      const float rs = rsqrtf(wave_sum(q) * (1.f / DM) + 1e-5f);
#pragma unroll
      for (int i = 0; i < 4; ++i) {
        const int cidx = lane * 4 + 256 * i;
        f32x4 sh = *(const f32x4*)(mm + cidx), sc = *(const f32x4*)(mm + 1024 + cidx);
        f32x4 o = v[r][i] * rs * (sc + 1.f) + sh;
        uint2 w = {pack2(o[0], o[1]), pack2(o[2], o[3])};
        *(uint2*)(h + (long)(row0 + r) * DM + cidx) = w;
      }
    }
  }
}

#define LDSP(T) __attribute__((address_space(3))) T*
DI int row_of_step(int dir, int s) {
  if (s < T_CTX) return T_LAT + (dir ? (T_CTX - 1 - s) : s);
  return dir ? (T_LAT - 1 - (s - T_CTX)) : (s - T_CTX);
}
DI bf16x8 ld_tr8(const short* base, int stride, int k0, int n0) {
  const int lane = VT & 63, g = lane >> 4, q = (lane & 15) >> 2, p = lane & 3;
  const short* a0 = base + (k0 + 8 * g + q) * stride + n0 + 4 * p;
  s16x4 lo = __builtin_amdgcn_ds_read_tr16_b64_v4i16((LDSP(s16x4))a0);
  s16x4 hi = __builtin_amdgcn_ds_read_tr16_b64_v4i16((LDSP(s16x4))(a0 + 4 * stride));
  return __builtin_shufflevector(lo, hi, 0, 1, 2, 3, 4, 5, 6, 7);
}
template <bool AT, bool BT>
DI f32x4 mm_tile(const short* A, int lda, int m0, const short* B, int ldb, int n0, int K, f32x4 acc) {
  const int lane = VT & 63, fr = lane & 15, fq = lane >> 4;
#ifdef SLOWMM
#pragma unroll
  for (int reg = 0; reg < 4; ++reg) {
    const int row = m0 + 4 * fq + reg, col = n0 + fr;
    float s = 0.f;
    for (int k = 0; k < K; ++k) {
      const float a = bf2f((bfr)(AT ? A[k * lda + row] : A[row * lda + k]));
      const float b = bf2f((bfr)(BT ? B[col * ldb + k] : B[k * ldb + col]));
      s += a * b;
    }
    acc[reg] += s;
  }
#else
  for (int k0 = 0; k0 < K; k0 += 32) {
    bf16x8 a, b;
    if (AT) a = ld_tr8(A, lda, k0, m0); else a = *(const bf16x8*)(A + (m0 + fr) * lda + k0 + fq * 8);
    if (BT) b = *(const bf16x8*)(B + (n0 + fr) * ldb + k0 + fq * 8); else b = ld_tr8(B, ldb, k0, n0);
    acc = __builtin_amdgcn_mfma_f32_16x16x32_bf16(a, b, acc, 0, 0, 0);
  }
#endif
  return acc;
}
DI void st_tile(short* C, int ldc, int m0, int n0, f32x4 acc) {
  const int lane = VT & 63, fr = lane & 15, fq = lane >> 4;
#pragma unroll
  for (int reg = 0; reg < 4; ++reg) C[(m0 + 4 * fq + reg) * ldc + n0 + fr] = (short)f2bf(acc[reg]);
}

constexpr int RW_NSC = 32;
DI int rw_sc_begin(int sc) { return sc * 16 + (sc < 8 ? sc : 8); }
DI int rw_sc_of_chunk(int ci) { return ci < 136 ? ci / 17 : 8 + (ci - 136) / 16; }
constexpr int XS = 72, SS = 40, GS = 72;
constexpr int RWL_XK = 0, RWL_XKB = 4608, RWL_XBB = 9216, RWL_XR = 13824, RWL_XV = 18432, RWL_S = 23040;
constexpr int RWL_GP = 38400, RWL_GQ = 47616, RWL_GAM = 56832, RWL_TOT = 57088, RWL_END = 58112;
constexpr size_t WS_PTOT = 6 * MB;
constexpr size_t WS_QTOT = 10 * MB;
constexpr size_t WS_SINRW = 18 * MB;
constexpr size_t WS_R2P = 350 * MB;
constexpr size_t WS_Y0P = 382 * MB;

constexpr int RTS = 40, RGS = 72;
constexpr int RWT_XK = 0, RWT_XKB = 5120, RWT_XBB = 10240, RWT_XR = 15360, RWT_XV = 20480, RWT_S = 25600;
constexpr int RWT_GP = 40960, RWT_GQ = 50176, RWT_GAM = 59392, RWT_TOT = 59648;
DI void st_tile_T(short* C, int ldc, int m0, int n0, f32x4 acc) {
  const int lane = (int)(threadIdx.x & 63), fr = lane & 15, fq = lane >> 4;
  *(uint2*)(C + (n0 + fr) * ldc + m0 + 4 * fq) = uint2{pack2(acc[0], acc[1]), pack2(acc[2], acc[3])};
}
DI void rw_levelA_item(CParams& P, int chain, int sc, char* smem) {
  const int dir = chain >> 3, hd = chain & 7;
  const bfr* Rg = (const bfr*)(P.ws + WS_RW); const bfr* Kg = (const bfr*)(P.ws + WS_RW + RW_ARR); const bfr* Vg = (const bfr*)(P.ws + WS_RW + 2 * RW_ARR);
  const bfr* KKg = (const bfr*)(P.ws + WS_RW + 3 * RW_ARR); const bfr* Ag = (const bfr*)(P.ws + WS_RW + 4 * RW_ARR);
  const float* LWg = (const float*)(P.ws + WS_LW + (dir ? LW_ARR : 0));
  bfr* R2P = (bfr*)(P.ws + WS_R2P) + (size_t)dir * T_LAT * 512;
  bfr* Y0P = (bfr*)(P.ws + WS_Y0P) + (size_t)dir * T_LAT * 512;
  short* XKt = (short*)(smem + RWT_XK); short* XKBt = (short*)(smem + RWT_XKB); short* XBBt = (short*)(smem + RWT_XBB);
  short* XRt = (short*)(smem + RWT_XR); short* XVt = (short*)(smem + RWT_XV);
  short* ZT = XRt; short* R2T = XRt; short* PcT = XKt;
  short* SLt = (short*)(smem + RWT_S); short* SAkkT = SLt + 32 * RTS; short* SAkrT = SAkkT + 32 * RTS; short* SMt = SAkrT + 32 * RTS;
  short* STt = SMt + 32 * RTS; short* SnAbrT = STt + 32 * RTS;
  short* W1T = SLt; short* W2T = SAkrT;
  short* GPT = (short*)(smem + RWT_GP); short* GQT = (short*)(smem + RWT_GQ);
  float* gam = (float*)(smem + RWT_GAM); float* tot = (float*)(smem + RWT_TOT);
  const int tid = VT, lane = tid & 63, w = tid >> 6, fr = lane & 15, fq = lane >> 4;
  const int tm = w >> 1, tn = w & 1;
  const int sgn = dir ? -1 : 1;
  const f32x4 z4 = {0.f, 0.f, 0.f, 0.f};
  __syncthreads();
  for (int i = tid; i < 64 * 64; i += NTHR) { const int r = i >> 6, c = i & 63; GPT[r * RGS + c] = (r == c) ? (short)0x3F80 : (short)0; GQT[r * RGS + c] = 0; }
  f32x4 pcum[4], qcum[4];
#pragma unroll
  for (int n = 0; n < 4; ++n) { pcum[n] = z4; qcum[n] = z4; }
  const int c_begin = rw_sc_begin(sc), c_end = rw_sc_begin(sc + 1);
  float pf_lw[8]; unsigned pf_rk[8], pf_vkk[8], pf_a[8];
#define RW_PREFETCH(cc) do { const unsigned o0_ = (unsigned)(row_of_step(dir, (cc) * 32 + (tid >> 6) * 8) * 512 + hd * 64 + (tid & 63)); \
      _Pragma("unroll") for (int e_ = 0; e_ < 8; ++e_) { const unsigned o_ = o0_ + (unsigned)(sgn * e_ * 512); \
      pf_lw[e_] = LWg[o_]; pf_rk[e_] = (unsigned)Rg[o_] | ((unsigned)Kg[o_] << 16); pf_vkk[e_] = (unsigned)Vg[o_] | ((unsigned)KKg[o_] << 16); pf_a[e_] = Ag[o_]; } } while (0)
  RW_PREFETCH(c_begin);
  for (int ci = c_begin; ci < c_end; ++ci) {
    __syncthreads();
    {
      const int j = tid & 63, qt = tid >> 6;
      float lam[8];
      float run = 0.f;
#pragma unroll
      for (int e = 0; e < 8; ++e) { run += pf_lw[e]; lam[e] = run; }
      tot[qt * 64 + j] = run;
      __syncthreads();
      float base = 0.f, total = 0.f;
#pragma unroll
      for (int q2 = 0; q2 < 4; ++q2) { const float tv = tot[q2 * 64 + j]; total += tv; if (q2 < qt) base += tv; }
      unsigned wk[4], wkb[4], wbb[4], wr_[4], wv[4];
#pragma unroll
      for (int e2 = 0; e2 < 4; ++e2) {
        float vk[2], vkb[2], vbb[2], vr[2];
#pragma unroll
        for (int u = 0; u < 2; ++u) {
          const int e = 2 * e2 + u;
          const float L = base + lam[e];
          const float eL = __expf(L), enL = frcp_(eL), eLp = eL * __expf(-pf_lw[e]);
          const float kkv = __uint_as_float(pf_vkk[e] & 0xffff0000u);
          vk[u] = kkv * eLp;
          vkb[u] = __uint_as_float(pf_rk[e] & 0xffff0000u) * enL;
          vbb[u] = kkv * __uint_as_float(pf_a[e] << 16) * enL;
          vr[u] = __uint_as_float(pf_rk[e] << 16) * eL;
        }
        wk[e2] = pack2(vk[0], vk[1]); wkb[e2] = pack2(vkb[0], vkb[1]); wbb[e2] = pack2(vbb[0], vbb[1]); wr_[e2] = pack2(vr[0], vr[1]);
        wv[e2] = (pf_vkk[2 * e2] & 0xffffu) | (pf_vkk[2 * e2 + 1] << 16);
      }
      const int co = j * RTS + 8 * qt;
      *(uint4*)(XKt + co) = uint4{wk[0], wk[1], wk[2], wk[3]};
      *(uint4*)(XKBt + co) = uint4{wkb[0], wkb[1], wkb[2], wkb[3]};
      *(uint4*)(XBBt + co) = uint4{wbb[0], wbb[1], wbb[2], wbb[3]};
      *(uint4*)(XRt + co) = uint4{wr_[0], wr_[1], wr_[2], wr_[3]};
      *(uint4*)(XVt + co) = uint4{wv[0], wv[1], wv[2], wv[3]};
      if (qt == 0) gam[j] = __expf(total);
      if (ci + 1 < c_end) RW_PREFETCH(ci + 1);
    }
    __syncthreads();
    f32x4 tacc; f32x4 rt[2];
    {
      f32x4 aL = mm_tile<true, false>(XKt, RTS, 16 * tm, XBBt, RTS, 16 * tn, 64, z4);
      f32x4 aKK = mm_tile<true, false>(XKt, RTS, 16 * tm, XKBt, RTS, 16 * tn, 64, z4);
      f32x4 aBR = mm_tile<true, false>(XRt, RTS, 16 * tm, XBBt, RTS, 16 * tn, 64, z4);
      f32x4 aKR = mm_tile<true, false>(XRt, RTS, 16 * tm, XKBt, RTS, 16 * tn, 64, z4);
#pragma unroll
      for (int reg = 0; reg < 4; ++reg) {
        const int row = 16 * tm + 4 * fq + reg, col = 16 * tn + fr;
        const bool st = col < row, inc = col <= row;
        aL[reg] = st ? aL[reg] : 0.f; aKK[reg] = st ? aKK[reg] : 0.f;
        aBR[reg] = inc ? -aBR[reg] : 0.f; aKR[reg] = inc ? aKR[reg] : 0.f;
        tacc[reg] = (row == col ? 1.f : 0.f) - aL[reg];
      }
      st_tile_T(SLt, RTS, 16 * tm, 16 * tn, aL); st_tile_T(STt, RTS, 16 * tm, 16 * tn, tacc);
      st_tile_T(SAkkT, RTS, 16 * tm, 16 * tn, aKK); st_tile_T(SnAbrT, RTS, 16 * tm, 16 * tn, aBR); st_tile_T(SAkrT, RTS, 16 * tm, 16 * tn, aKR);
#pragma unroll
      for (int i = 0; i < 2; ++i) rt[i] = ld4bf((const bfr*)(XRt + (16 * (2 * tn + i) + fr) * RTS + 16 * tm + 4 * fq));
    }
    __syncthreads();
    f32x4 y0[2];
    {
#pragma unroll
      for (int i = 0; i < 2; ++i) {
        f32x4 z = mm_tile<true, true>(SAkkT, RTS, 16 * tm, XVt, RTS, 16 * (2 * tn + i), 32, z4);
        st_tile_T(ZT, RTS, 16 * tm, 16 * (2 * tn + i), z);
        y0[i] = mm_tile<true, true>(SAkrT, RTS, 16 * tm, XVt, RTS, 16 * (2 * tn + i), 32, z4);
      }
      f32x4 m = mm_tile<true, true>(SLt, RTS, 16 * tm, SLt, RTS, 16 * tn, 32, z4);
      st_tile_T(SMt, RTS, 16 * tm, 16 * tn, m);
    }
    __syncthreads();
#pragma unroll 1
    for (int rd = 0; rd < 4; ++rd) {
      f32x4 tnew = mm_tile<true, true>(STt, RTS, 16 * tm, SMt, RTS, 16 * tn, 32, tacc);
      f32x4 mnew = z4;
      if (rd < 3) mnew = mm_tile<true, true>(SMt, RTS, 16 * tm, SMt, RTS, 16 * tn, 32, z4);
      __syncthreads();
      tacc = tnew;
      st_tile_T(STt, RTS, 16 * tm, 16 * tn, tacc);
      if (rd < 3) st_tile_T(SMt, RTS, 16 * tm, 16 * tn, mnew);
      __syncthreads();
    }
    {
      f32x4 w1[2], w2[2];
#pragma unroll
      for (int i = 0; i < 2; ++i) {
        w1[i] = mm_tile<true, true>(STt, RTS, 16 * tm, XKt, RTS, 16 * (2 * tn + i), 32, z4);
        w2[i] = mm_tile<true, true>(STt, RTS, 16 * tm, ZT, RTS, 16 * (2 * tn + i), 32, z4);
      }
#pragma unroll
      for (int i = 0; i < 2; ++i) { st_tile_T(W1T, RTS, 16 * tm, 16 * (2 * tn + i), w1[i]); st_tile_T(W2T, RTS, 16 * tm, 16 * (2 * tn + i), w2[i]); }
    }
    __syncthreads();
    f32x4 pa[4], qc[4], r2[2];
    {
#pragma unroll
      for (int n = 0; n < 4; ++n) {
        pa[n] = mm_tile<false, true>(W1T, RTS, 16 * w, XBBt, RTS, 16 * n, 32, z4);
        f32x4 qa = mm_tile<false, true>(XVt, RTS, 16 * w, XKBt, RTS, 16 * n, 32, z4);
        f32x4 qb = mm_tile<false, true>(W2T, RTS, 16 * w, XBBt, RTS, 16 * n, 32, z4);
        qc[n] = qa - qb;
      }
#pragma unroll
      for (int i = 0; i < 2; ++i) {
        r2[i] = mm_tile<true, true>(SnAbrT, RTS, 16 * tm, W1T, RTS, 16 * (2 * tn + i), 32, rt[i]);
        y0[i] = mm_tile<true, true>(SnAbrT, RTS, 16 * tm, W2T, RTS, 16 * (2 * tn + i), 32, y0[i]);
      }
    }
    __syncthreads();
    {
#pragma unroll
      for (int n = 0; n < 4; ++n) {
        const float gcol = gam[16 * n + fr];
        f32x4 pc;
#pragma unroll
        for (int reg = 0; reg < 4; ++reg) {
          const int row = 16 * w + 4 * fq + reg, col = 16 * n + fr;
          pc[reg] = ((row == col ? 1.f : 0.f) - pa[n][reg]) * gcol;
          qc[n][reg] *= gcol;
        }
        st_tile_T(PcT, RGS, 16 * w, 16 * n, pc);
      }
#pragma unroll
      for (int i = 0; i < 2; ++i) st_tile_T(R2T, RTS, 16 * tm, 16 * (2 * tn + i), r2[i]);
    }
    __syncthreads();
    {
      if (ci >= 8) {
        const unsigned orow = (unsigned)(row_of_step(dir, ci * 32 + 16 * tm + 4 * fq) * 512 + hd * 64 + fr);
#pragma unroll
        for (int i = 0; i < 2; ++i) {
          f32x4 o1 = mm_tile<true, false>(R2T, RTS, 16 * tm, GPT, RGS, 16 * (2 * tn + i), 64, z4);
          f32x4 o2 = mm_tile<true, false>(R2T, RTS, 16 * tm, GQT, RGS, 16 * (2 * tn + i), 64, y0[i]);
#pragma unroll
          for (int reg = 0; reg < 4; ++reg) {
            const unsigned o = orow + (unsigned)(sgn * reg * 512 + 16 * (2 * tn + i));
            R2P[o] = f2bf(o1[reg]); Y0P[o] = f2bf(o2[reg]);
          }
        }
      }
#pragma unroll
      for (int n = 0; n < 4; ++n) {
        pcum[n] = mm_tile<true, true>(GPT, RGS, 16 * w, PcT, RGS, 16 * n, 64, z4);
        qcum[n] = mm_tile<true, true>(GQT, RGS, 16 * w, PcT, RGS, 16 * n, 64, qc[n]);
      }
    }
    __syncthreads();
#pragma unroll
    for (int n = 0; n < 4; ++n) { st_tile_T(GPT, RGS, 16 * w, 16 * n, pcum[n]); st_tile_T(GQT, RGS, 16 * w, 16 * n, qcum[n]); }
  }
  {
    bfr* Pt = (bfr*)(P.ws + WS_PTOT) + (size_t)(chain * RW_NSC + sc) * 4096;
    float* Qt = (float*)(P.ws + WS_QTOT) + (size_t)(chain * RW_NSC + sc) * 4096;
#pragma unroll
    for (int n = 0; n < 4; ++n)
#pragma unroll
      for (int reg = 0; reg < 4; ++reg) {
        const int row = 16 * w + 4 * fq + reg, col = 16 * n + fr;
        Pt[row * 64 + col] = f2bf(pcum[n][reg]);
      }
#pragma unroll
    for (int n = 0; n < 4; ++n) *(f32x4*)(Qt + (16 * n + fr) * 64 + 16 * w + 4 * fq) = qcum[n];
  }
}

DI void rw_levelB_chain(CParams& P, int chain, char* smem) {
  short* SB = (short*)smem; short* PT = SB + 64 * GS;
  const bfr* Ptot = (const bfr*)(P.ws + WS_PTOT) + (size_t)chain * RW_NSC * 4096;
  const float* Qtot = (const float*)(P.ws + WS_QTOT) + (size_t)chain * RW_NSC * 4096;
  bfr* SIN = (bfr*)(P.ws + WS_SINRW) + (size_t)chain * (RW_NSC + 1) * 4096;
  const int tid = VT, lane = tid & 63, w = tid >> 6, fr = lane & 15, fq = lane >> 4;
  f32x4 S[4];
#pragma unroll
  for (int n = 0; n < 4; ++n) S[n] = f32x4{0.f, 0.f, 0.f, 0.f};
  bf16x8 pr[4][2]; f32x4 qr[4][4];
#define LB_LOAD(slot, sc_) do { _Pragma("unroll") for (int i_ = 0; i_ < 2; ++i_) { const int e_ = tid + i_ * NTHR; pr[slot][i_] = *(const bf16x8*)(Ptot + (size_t)(sc_) * 4096 + (e_ >> 3) * 64 + (e_ & 7) * 8); } \
    _Pragma("unroll") for (int n_ = 0; n_ < 4; ++n_) qr[slot][n_] = *(const f32x4*)(Qtot + (size_t)(sc_) * 4096 + (16 * n_ + fr) * 64 + 16 * w + 4 * fq); } while (0)
  LB_LOAD(0, 0); LB_LOAD(1, 1); LB_LOAD(2, 2); LB_LOAD(3, 3);
#define LB_STEP(u) do { const int sc = sc0 + (u); \
      __syncthreads(); \
      _Pragma("unroll") for (int n = 0; n < 4; ++n) { st_tile(SB, GS, 16 * w, 16 * n, S[n]); \
        _Pragma("unroll") for (int reg = 0; reg < 4; ++reg) SIN[(size_t)sc * 4096 + (16 * w + 4 * fq + reg) * 64 + 16 * n + fr] = f2bf(S[n][reg]); } \
      _Pragma("unroll") for (int i = 0; i < 2; ++i) { const int e = tid + i * NTHR; *(bf16x8*)(PT + (e >> 3) * GS + (e & 7) * 8) = pr[u][i]; } \
      const f32x4 qc0 = qr[u][0], qc1 = qr[u][1], qc2 = qr[u][2], qc3 = qr[u][3]; \
      __syncthreads(); \
      if (sc + 4 < RW_NSC) LB_LOAD(u, sc + 4); \
      S[0] = mm_tile<false, false>(SB, GS, 16 * w, PT, GS, 0, 64, qc0); S[1] = mm_tile<false, false>(SB, GS, 16 * w, PT, GS, 16, 64, qc1); \
      S[2] = mm_tile<false, false>(SB, GS, 16 * w, PT, GS, 32, 64, qc2); S[3] = mm_tile<false, false>(SB, GS, 16 * w, PT, GS, 48, 64, qc3); } while (0)
  for (int sc0 = 0; sc0 < RW_NSC; sc0 += 4) { LB_STEP(0); LB_STEP(1); LB_STEP(2); LB_STEP(3); }
#undef LB_STEP
#undef LB_LOAD
}

constexpr int HG_NSC = 64;
DI int hg_sc_begin(int sc) { return sc * 8 + (sc < 8 ? sc : 8); }
DI int hg_sc_of_chunk(int ci) { return ci < 72 ? ci / 9 : 8 + (ci - 72) / 8; }
constexpr int QS = 136;
constexpr int HGL_Q0 = 0, HGL_Q1 = 8704, HGL_KP = 13056, HGL_KH = 21760, HGL_VV = 30464, HGL_PM = 39168, HGL_STT = 41728;
constexpr int HGL_BL = 76544, HGL_TOT = 77056, HGL_END = 78080;
constexpr size_t WS_SINHG = 23 * MB;
constexpr size_t WS_QH = 414 * MB;
constexpr size_t WS_O0 = 446 * MB;
constexpr size_t WS_SLOC = 478 * MB;
constexpr size_t WS_DTOT = 510 * MB;

constexpr int HTS = 40, HT1S = 24;
constexpr int HGT_Q0 = 0, HGT_Q1 = 10240, HGT_KP = 16384, HGT_KH = 26624, HGT_VV = 36864, HGT_PM = 47104, HGT_BL = 49664, HGT_TOT = 50176;
DI bf16x8 ld_tr8p(const short* base, int stride, int k0, int n0) {
  const int lane = (int)(threadIdx.x & 63), g = lane >> 4, q = (lane & 15) >> 2, p = lane & 3;
  const short* a0 = base + (k0 + 4 * g + q) * stride + n0 + 4 * p;
  s16x4 lo = __builtin_amdgcn_ds_read_tr16_b64_v4i16((LDSP(s16x4))a0);
  s16x4 hi = __builtin_amdgcn_ds_read_tr16_b64_v4i16((LDSP(s16x4))(a0 + 16 * stride));
  return __builtin_shufflevector(lo, hi, 0, 1, 2, 3, 4, 5, 6, 7);
}
DI void hg_levelA_item(CParams& P, int chain, int sc, char* smem) {
  const int dir = chain >> 2, hd = chain & 3;
  const bfr* p = (const bfr*)(P.ws + WS_P);
  const float* lbp = (const float*)(P.ws + WS_LB) + dir * 512 + hd * 128;
  bfr* QH = (bfr*)(P.ws + WS_QH) + (size_t)dir * T_LAT * 512;
  bfr* O0 = (bfr*)(P.ws + WS_O0) + (size_t)dir * T_LAT * 512;
  short* Q0T = (short*)(smem + HGT_Q0); short* Q1T = (short*)(smem + HGT_Q1); short* KPT = (short*)(smem + HGT_KP);
  short* KHT = (short*)(smem + HGT_KH); short* VVT = (short*)(smem + HGT_VV); short* PMT = (short*)(smem + HGT_PM);
  float* BL = (float*)(smem + HGT_BL); float* tot = (float*)(smem + HGT_TOT);
  const int tid = VT, lane = tid & 63, w = tid >> 6, fr = lane & 15, fq = lane >> 4;
  const f32x4 z4 = {0.f, 0.f, 0.f, 0.f};
  f32x4 S[8][2];
#pragma unroll
  for (int m = 0; m < 8; ++m) { S[m][0] = z4; S[m][1] = z4; }
  const int d = tid & 127, hf = tid >> 7;
  const float lb = lbp[d];
  float dcum = 0.f;
  const int sgn = dir ? -1 : 1;
  const int c_begin = hg_sc_begin(sc), c_end = hg_sc_begin(sc + 1);
  unsigned qv[16]; bfr zr[16];
#define HG_PREFETCH(cc) do { const unsigned po0_ = (unsigned)(row_of_step(dir, (cc) * 32 + hf * 16) * DIN + hd * 128 + d); \
      _Pragma("unroll") for (int e_ = 0; e_ < 16; ++e_) { const unsigned po_ = po0_ + (unsigned)(sgn * e_ * DIN); \
      qv[e_] = (unsigned)p[po_] | ((unsigned)p[po_ + 512] << 16); zr[e_] = p[po_ + 1024 + dir * 512]; } } while (0)
  HG_PREFETCH(c_begin);
  for (int ci = c_begin; ci < c_end; ++ci) {
    __syncthreads();
    {
      float lc[16], kv[16]; float run = 0.f;
#pragma unroll
      for (int e = 0; e < 16; ++e) {
        const float sg = sigmoidf_(bf2f(zr[e]));
        const float f = lb + (1.f - lb) * sg;
        kv[e] = (1.f - lb) * (1.f - sg);
        run += __logf(f); lc[e] = run;
      }
      tot[hf * 128 + d] = run;
      __syncthreads();
      const float tot0 = tot[d], tot1 = tot[128 + d];
      const float blast = tot0 + tot1;
      const float e0f = hf ? __expf(tot0) : 1.f;
      const float ehf = __expf(blast - (hf ? tot0 : 0.f));
      const float edc = __expf(dcum);
      const unsigned qh0 = (unsigned)(row_of_step(dir, ci * 32 + hf * 16) * 512 + hd * 128 + d);
#pragma unroll
      for (int hq = 0; hq < 2; ++hq) {
        unsigned q0w[4], q1w[4], kpw[4], khw[4], vvw[4];
#pragma unroll
        for (int e2 = 0; e2 < 4; ++e2) {
          float q0v[2], q1v[2], kpv[2], khv[2];
#pragma unroll
          for (int u = 0; u < 2; ++u) {
            const int e = 8 * hq + 2 * e2 + u;
            const float el = __expf(lc[e]), eil = frcp_(el);
            const float qs = siluf_(__uint_as_float(qv[e] << 16));
            q1v[u] = qs * el; q0v[u] = q1v[u] * e0f;
            kpv[u] = kv[e] * eil; khv[u] = kpv[u] * ehf;
            if (ci >= 8) QH[qh0 + (unsigned)(sgn * e * 512)] = f2bf(q0v[u] * edc);
          }
          q0w[e2] = pack2(q0v[0], q0v[1]); q1w[e2] = pack2(q1v[0], q1v[1]); kpw[e2] = pack2(kpv[0], kpv[1]); khw[e2] = pack2(khv[0], khv[1]);
          vvw[e2] = (qv[8 * hq + 2 * e2] >> 16) | (qv[8 * hq + 2 * e2 + 1] & 0xffff0000u);
        }
        const int co = 16 * hf + 8 * hq;
        *(uint4*)(Q0T + d * HTS + co) = uint4{q0w[0], q0w[1], q0w[2], q0w[3]};
        if (hf) *(uint4*)(Q1T + d * HT1S + 8 * hq) = uint4{q1w[0], q1w[1], q1w[2], q1w[3]};
        *(uint4*)(KPT + d * HTS + co) = uint4{kpw[0], kpw[1], kpw[2], kpw[3]};
        *(uint4*)(KHT + d * HTS + co) = uint4{khw[0], khw[1], khw[2], khw[3]};
        *(uint4*)(VVT + d * HTS + co) = uint4{vvw[0], vvw[1], vvw[2], vvw[3]};
      }
      if (hf == 0) BL[d] = blast;
      dcum += blast;
      if (ci + 1 < c_end) HG_PREFETCH(ci + 1);
    }
    __syncthreads();
    {
      f32x4 pt = z4;
      if (w == 0) pt = mm_tile<true, false>(Q0T, HTS, 0, KPT, HTS, 0, 128, z4);
      else if (w == 1) pt = mm_tile<true, false>(Q0T, HTS, 16, KPT, HTS, 0, 128, z4);
      else if (w == 2) pt = mm_tile<true, false>(Q1T, HT1S, 0, KPT, HTS, 16, 128, z4);
      if (w == 0 || w == 2) {
#pragma unroll
        for (int reg = 0; reg < 4; ++reg) pt[reg] = (fr <= 4 * fq + reg) ? pt[reg] : 0.f;
      }
      const int ptm = (w == 0 || w == 3) ? 0 : 1, ptn = (w >= 2) ? 1 : 0;
      *(uint2*)(PMT + (16 * ptn + fr) * HTS + 16 * ptm + 4 * fq) = uint2{pack2(pt[0], pt[1]), pack2(pt[2], pt[3])};
    }
    __syncthreads();
    {
      bf16x8 vfr[2];
#pragma unroll
      for (int n = 0; n < 2; ++n) vfr[n] = *(const bf16x8*)(VVT + (32 * w + 16 * n + fr) * HTS + fq * 8);
      f32x4 o[2][2];
#pragma unroll
      for (int m = 0; m < 2; ++m) { o[m][0] = z4; o[m][1] = z4; }
#pragma unroll
      for (int ks = 0; ks < 4; ++ks) {
        bf16x8 sfr[2];
#pragma unroll
        for (int n = 0; n < 2; ++n) {
          typedef __attribute__((ext_vector_type(4))) unsigned u32x4_;
          u32x4_ wv = {pack2(S[2 * ks][n][0], S[2 * ks][n][1]), pack2(S[2 * ks][n][2], S[2 * ks][n][3]), pack2(S[2 * ks + 1][n][0], S[2 * ks + 1][n][1]), pack2(S[2 * ks + 1][n][2], S[2 * ks + 1][n][3])};
          sfr[n] = __builtin_bit_cast(bf16x8, wv);
        }
#pragma unroll
        for (int m = 0; m < 2; ++m) {
          const bf16x8 a = ld_tr8p(Q0T, HTS, 32 * ks, 16 * m);
#pragma unroll
          for (int n = 0; n < 2; ++n) o[m][n] = __builtin_amdgcn_mfma_f32_16x16x32_bf16(a, sfr[n], o[m][n], 0, 0, 0);
        }
      }
#pragma unroll
      for (int m = 0; m < 2; ++m) {
        const bf16x8 a = ld_tr8(PMT, HTS, 0, 16 * m);
#pragma unroll
        for (int n = 0; n < 2; ++n) {
          o[m][n] = __builtin_amdgcn_mfma_f32_16x16x32_bf16(a, vfr[n], o[m][n], 0, 0, 0);
          if (ci >= 8) {
            const unsigned orow = (unsigned)(row_of_step(dir, ci * 32 + 16 * m + 4 * fq) * 512 + hd * 128 + 32 * w + 16 * n + fr);
#pragma unroll
            for (int reg = 0; reg < 4; ++reg) O0[orow + (unsigned)(sgn * reg * 512)] = f2bf(o[m][n][reg]);
          }
        }
      }
#pragma unroll
      for (int m = 0; m < 8; ++m) {
        const f32x4 bl = *(const f32x4*)(BL + 16 * m + 4 * fq);
        f32x4 sc4 = {__expf(bl[0]), __expf(bl[1]), __expf(bl[2]), __expf(bl[3])};
        const bf16x8 a = *(const bf16x8*)(KHT + (16 * m + fr) * HTS + fq * 8);
#pragma unroll
        for (int n = 0; n < 2; ++n) S[m][n] = __builtin_amdgcn_mfma_f32_16x16x32_bf16(a, vfr[n], S[m][n] * sc4, 0, 0, 0);
      }
    }
  }
  {
    float* SL_ = (float*)(P.ws + WS_SLOC) + (size_t)(chain * HG_NSC + sc) * 16384;
    float* DT = (float*)(P.ws + WS_DTOT) + (size_t)(chain * HG_NSC + sc) * 128;
#pragma unroll
    for (int m = 0; m < 8; ++m)
#pragma unroll
      for (int n = 0; n < 2; ++n) *(f32x4*)(SL_ + (32 * w + 16 * n + fr) * 128 + 16 * m + 4 * fq) = S[m][n];
    if (hf == 0) DT[d] = dcum;
  }
}

DI void hg_levelB(CParams& P, int bid, int nb) {
  const float* SLOC = (const float*)(P.ws + WS_SLOC); const float* DT = (const float*)(P.ws + WS_DTOT);
  bfr* SIN = (bfr*)(P.ws + WS_SINHG);
  for (int idx = bid * NTHR + VT; idx < 8 * 16384; idx += nb * NTHR) {
    const int chain = idx >> 14, ed = idx & 16383, dd = ed & 127;
    float s = 0.f;
    for (int sc = 0; sc < HG_NSC; ++sc) {
      const size_t item = (size_t)chain * HG_NSC + sc;
      SIN[item * 16384 + ed] = f2bf(s);
      s = __expf(DT[item * 128 + dd]) * s + SLOC[item * 16384 + ed];
    }
  }
}

constexpr size_t WS_LORA = 256 * 1024;
constexpr int LORA_WD2T = 0, LORA_WA2T = 2 * 512 * 32, LORA_WG2T = LORA_WA2T + 512 * 32;
DI void phase_lora_convert(CParams& P, int part, int nparts) {
  const float* wd2 = P.in[12]; const float* wa2 = P.in[14]; const float* wg2 = P.in[15];
  bfr* L = (bfr*)(P.ws + WS_LORA);
  for (int i = part * NTHR + VT; i < 2 * 512 * 32; i += nparts * NTHR) { const int d = i >> 14, c = (i >> 5) & 511, j = i & 31; L[LORA_WD2T + i] = f2bf(wd2[(d * 32 + j) * 512 + c]); }
  for (int i = part * NTHR + VT; i < 512 * 32; i += nparts * NTHR) { const int c = i >> 5, j = i & 31; L[LORA_WA2T + i] = f2bf(wa2[j * 512 + c]); }
  for (int i = part * NTHR + VT; i < 512 * 96; i += nparts * NTHR) { const int c = i / 96, j = i % 96; L[LORA_WG2T + i] = f2bf(wg2[j * 512 + c]); }
}
#define NB_DECL(row) \
  int nb_o0, nb_o1, nb_o2, nb_o3; float nb_f0, nb_f1, nb_f2, nb_f3, nb_scale; \
  { const int r_ = (row); const bool lat_ = r_ < T_LAT; const int gr_ = r_ >> 6, gc_ = r_ & 63, s_ = r_ - T_LAT; \
    const bool v0_ = lat_ && gr_ > 0, v1_ = lat_ && gr_ < 255, v2_ = lat_ ? gc_ > 0 : s_ > 0, v3_ = lat_ ? gc_ < 63 : s_ < T_CTX - 1; \
    nb_o0 = v0_ ? -64 * DIN : 0; nb_o1 = v1_ ? 64 * DIN : 0; nb_o2 = v2_ ? -DIN : 0; nb_o3 = v3_ ? DIN : 0; \
    nb_f0 = v0_ ? 1.f : 0.f; nb_f1 = v1_ ? 1.f : 0.f; nb_f2 = v2_ ? 1.f : 0.f; nb_f3 = v3_ ? 1.f : 0.f; nb_scale = lat_ ? 0.25f : 0.5f; }
#define MIX4(pc, mup) mix4_((pc), (mup), nb_o0, nb_o1, nb_o2, nb_o3, nb_f0, nb_f1, nb_f2, nb_f3, nb_scale)
DI f32x4 ld4bf(const bfr* p) {
  const uint2 u = *(const uint2*)p;
  return f32x4{__uint_as_float(u.x << 16), __uint_as_float(u.x & 0xffff0000u), __uint_as_float(u.y << 16), __uint_as_float(u.y & 0xffff0000u)};
}
DI f32x4 mix4_(const bfr* pc, const float* mu, int o0, int o1, int o2, int o3, float f0, float f1, float f2, float f3, float scale) {
  const f32x4 c = ld4bf(pc);
  f32x4 s = ld4bf(pc + o0) * f0 + ld4bf(pc + o1) * f1 + ld4bf(pc + o2) * f2 + ld4bf(pc + o3) * f3;
  const f32x4 m = *(const f32x4*)mu;
  return c + (s * scale - c) * m;
}
DI void ld8bf(const bfr* p, f32x4& lo, f32x4& hi) {
  const uint4 u = *(const uint4*)p;
  lo = f32x4{__uint_as_float(u.x << 16), __uint_as_float(u.x & 0xffff0000u), __uint_as_float(u.y << 16), __uint_as_float(u.y & 0xffff0000u)};
  hi = f32x4{__uint_as_float(u.z << 16), __uint_as_float(u.z & 0xffff0000u), __uint_as_float(u.w << 16), __uint_as_float(u.w & 0xffff0000u)};
}
DI void mix8_(const bfr* pc, const float* mu, int o0, int o1, int o2, int o3, float f0, float f1, float f2, float f3, float scale, f32x4& lo, f32x4& hi) {
  f32x4 cl, chh, al, ah, bl, bh, dl, dh, el, eh;
  ld8bf(pc, cl, chh); ld8bf(pc + o0, al, ah); ld8bf(pc + o1, bl, bh); ld8bf(pc + o2, dl, dh); ld8bf(pc + o3, el, eh);
  const f32x4 sl = al * f0 + bl * f1 + dl * f2 + el * f3, sh = ah * f0 + bh * f1 + dh * f2 + eh * f3;
  const f32x4 ml = *(const f32x4*)mu, mh = *(const f32x4*)(mu + 4);
  lo = cl + (sl * scale - cl) * ml; hi = chh + (sh * scale - chh) * mh;
}
#define MIX8(pc, mup, lo, hi) mix8_((pc), (mup), nb_o0, nb_o1, nb_o2, nb_o3, nb_f0, nb_f1, nb_f2, nb_f3, nb_scale, lo, hi)
DI float ftanh_(float x) { const float e = __expf(2.f * x); return 1.f - 2.f * frcp_(e + 1.f); }
DI uint2 pk4(f32x4 v) { return uint2{pack2(v[0], v[1]), pack2(v[2], v[3])}; }
constexpr int LIS = 200;
constexpr int MXS = 388;
DI void phase_rwprep(CParams& P, int bid, int nb, char* smem) {
  const bfr* p = (const bfr*)(P.ws + WS_P);
  const float* mu = P.in[10]; const float* w0 = P.in[11]; const float* a0 = P.in[13];
  const float* k_k = P.in[16]; const float* k_a = P.in[17];
  const bfr* LW_ = (const bfr*)(P.ws + WS_LORA);
  bfr* R = (bfr*)(P.ws + WS_RW); bfr* K = (bfr*)(P.ws + WS_RW + RW_ARR); bfr* V = (bfr*)(P.ws + WS_RW + 2 * RW_ARR);
  bfr* KK = (bfr*)(P.ws + WS_RW + 3 * RW_ARR); bfr* A = (bfr*)(P.ws + WS_RW + 4 * RW_ARR); bfr* G = (bfr*)(P.ws + WS_RW + 5 * RW_ARR);
  float* LWF = (float*)(P.ws + WS_LW); float* LWB = (float*)(P.ws + WS_LW + LW_ARR);
  short* LI = (short*)smem;
  float* MX = (float*)(smem + 32 * LIS * 2);
  const int tid = VT, lane = tid & 63, w = tid >> 6, fr = lane & 15, fq = lane >> 4;
  const f32x4 z4 = {0.f, 0.f, 0.f, 0.f};
  const int hp = bid & 3;
  bf16x8 afr[4][6];
  {
    const int h = hp * 2 + (w >> 1);
#pragma unroll
    for (int m = 0; m < 4; ++m) {
      const int c0 = 64 * h + 16 * m;
      afr[m][0] = *(const bf16x8*)(LW_ + LORA_WD2T + (c0 + fr) * 32 + fq * 8);
      afr[m][1] = *(const bf16x8*)(LW_ + LORA_WD2T + 512 * 32 + (c0 + fr) * 32 + fq * 8);
      afr[m][2] = *(const bf16x8*)(LW_ + LORA_WA2T + (c0 + fr) * 32 + fq * 8);
#pragma unroll
      for (int ks = 0; ks < 3; ++ks) afr[m][3 + ks] = *(const bf16x8*)(LW_ + LORA_WG2T + (c0 + fr) * 96 + ks * 32 + fq * 8);
    }
  }
  for (int it = bid; it < (T_ALL / 32) * 4; it += nb) {
  const int tile = it >> 2;
  const int row0 = tile * 32;
  __syncthreads();
  for (int v = tid; v < 32 * 72; v += NTHR) {
    const int t = v / 72, g = v % 72;
    const int row = row0 + t;
    NB_DECL(row);
    f32x4 lo, hi;
    if (g < 24) {
      const bfr* pc = p + (size_t)row * DIN + HGC + 1536 + g * 8;
      MIX8(pc, mu + 1536 + g * 8, lo, hi);
#pragma unroll
      for (int e = 0; e < 4; ++e) {
        if (g < 8) { lo[e] = ftanh_(lo[e]); hi[e] = ftanh_(hi[e]); }
        else if (g >= 12) { lo[e] = sigmoidf_(lo[e]); hi[e] = sigmoidf_(hi[e]); }
      }
      const uint2 a = pk4(lo), b = pk4(hi);
      *(uint4*)(LI + t * LIS + g * 8) = uint4{a.x, a.y, b.x, b.y};
    } else {
      const int cg = g - 24, a = cg >> 4, c8 = cg & 15;
      const int col = a * 512 + hp * 128 + c8 * 8;
      MIX8(p + (size_t)row * DIN + HGC + col, mu + col, lo, hi);
      *(f32x4*)(MX + t * MXS + a * 128 + c8 * 8) = lo; *(f32x4*)(MX + t * MXS + a * 128 + c8 * 8 + 4) = hi;
    }
  }
  __syncthreads();
  {
    const int hl = w >> 1, th = w & 1, h = hp * 2 + hl;
    const int row = row0 + 16 * th + fr;
    const float* mrow = MX + (16 * th + fr) * MXS + hl * 64 + 4 * fq;
    f32x4 kkr[4], kraw[4], av[4];
    float ss = 0.f;
#pragma unroll
    for (int m = 0; m < 4; ++m) {
      const int c0 = 64 * h + 16 * m;
      const int ch = c0 + 4 * fq;
      const f32x4 r = *(const f32x4*)(mrow + 16 * m);
      kraw[m] = *(const f32x4*)(mrow + 128 + 16 * m);
      const f32x4 v = *(const f32x4*)(mrow + 256 + 16 * m);
      const short* lrow = LI + (16 * th + fr) * LIS + fq * 8;
      f32x4 aF = __builtin_amdgcn_mfma_f32_16x16x32_bf16(afr[m][0], *(const bf16x8*)(lrow), z4, 0, 0, 0);
      f32x4 aB = __builtin_amdgcn_mfma_f32_16x16x32_bf16(afr[m][1], *(const bf16x8*)(lrow + 32), z4, 0, 0, 0);
      f32x4 aA = __builtin_amdgcn_mfma_f32_16x16x32_bf16(afr[m][2], *(const bf16x8*)(lrow + 64), z4, 0, 0, 0);
      f32x4 aG = z4;
#pragma unroll
      for (int ks = 0; ks < 3; ++ks) aG = __builtin_amdgcn_mfma_f32_16x16x32_bf16(afr[m][3 + ks], *(const bf16x8*)(lrow + 96 + ks * 32), aG, 0, 0, 0);
      const size_t o = (size_t)row * 512 + ch;
      const f32x4 w0f = *(const f32x4*)(w0 + ch), w0b = *(const f32x4*)(w0 + 512 + ch), a0v = *(const f32x4*)(a0 + ch);
      f32x4 lwf, lwb;
#pragma unroll
      for (int e = 0; e < 4; ++e) {
        lwf[e] = -RW_DECAY_SCALE * sigmoidf_(w0f[e] + aF[e]);
        lwb[e] = -RW_DECAY_SCALE * sigmoidf_(w0b[e] + aB[e]);
        av[m][e] = sigmoidf_(a0v[e] + aA[e]);
      }
      *(f32x4*)(LWF + o) = lwf; *(f32x4*)(LWB + o) = lwb;
      *(uint2*)(G + o) = pk4(aG);
      *(uint2*)(A + o) = pk4(av[m]);
      *(uint2*)(R + o) = pk4(r); *(uint2*)(V + o) = pk4(v);
      kkr[m] = kraw[m] * *(const f32x4*)(k_k + ch);
      ss += kkr[m][0] * kkr[m][0] + kkr[m][1] * kkr[m][1] + kkr[m][2] * kkr[m][2] + kkr[m][3] * kkr[m][3];
    }
    ss += __shfl_xor(ss, 16); ss += __shfl_xor(ss, 32);
    const float rn = rsqrtf(fmaxf(ss, 1e-12f));
#pragma unroll
    for (int m = 0; m < 4; ++m) {
      const int ch = 64 * h + 16 * m + 4 * fq;
      const size_t o = (size_t)row * 512 + ch;
      const f32x4 ka = *(const f32x4*)(k_a + ch);
      f32x4 kv;
#pragma unroll
      for (int e = 0; e < 4; ++e) kv[e] = kraw[m][e] * (1.f + (av[m][e] - 1.f) * ka[e]);
      *(uint2*)(K + o) = pk4(kv);
      *(uint2*)(KK + o) = pk4(kkr[m] * rn);
    }
  }
  }
}

constexpr size_t WS_WRT = 512 * 1024;
DI void phase_wrt_convert(CParams& P, int part, int nparts) {
  const float* wgrp = P.in[25]; const float* wrt = P.in[27];
  bfr* Whi = (bfr*)(P.ws + WS_WRT); bfr* Wlo = Whi + 80 * 1024;
  for (int i = part * NTHR + VT; i < 80 * 1024; i += nparts * NTHR) {
    const int o = i >> 10, k = i & 1023;
    float wv = 0.f;
    if (o < 8) wv = wgrp[k * 8 + o]; else if (o < 72) wv = wrt[k * 64 + (o - 8)];
    const bfr hi = f2bf(wv);
    Whi[i] = hi; Wlo[i] = f2bf(wv - bf2f(hi));
  }
}
constexpr int HLS = 1032;
DI void phase_ln2route(CParams& P, char* smem_all) {
  const float* x = P.in[0];
  const bfr* y = (const bfr*)(P.ws + WS_Y);
  const float* mod = (const float*)(P.ws + WS_MOD);
  const float* ln1_g = P.in[21]; const float* ln1_b = P.in[22];
  const float* bgrp = P.in[26]; const float* brt = P.in[28];
  const bfr* Whi = (const bfr*)(P.ws + WS_WRT); const bfr* Wlo = Whi + 80 * 1024;
  bfr* x1 = (bfr*)(P.ws + WS_X1B);
  bfr* h2 = (bfr*)(P.ws + WS_H2);
  int* cnt = (int*)(P.ws + WS_CNT); int* list = (int*)(P.ws + WS_LIST); float* asgw = (float*)(P.ws + WS_ASGW);
  short* HI = (short*)smem_all; short* LO = HI + 32 * HLS;
  float* LG = (float*)(smem_all + 2 * 32 * HLS * 2);
  float* PS = LG + 32 * 80;
  const int tid = tx_(), wid = tid >> 6, lane = tid & 63, fr = lane & 15, fq = lane >> 4;
  for (int grp = blockIdx.x; grp < T_LAT / 32; grp += gridDim.x) {
    const int t0 = grp * 32;
    __syncthreads();
    f32x4 xin[4][4]; uint2 yin[4][4];
#pragma unroll
    for (int tt = 0; tt < 4; ++tt)
#pragma unroll
      for (int i = 0; i < 4; ++i) {
        const long o = (long)(t0 + wid * 4 + tt) * DM + lane * 4 + 256 * i;
        xin[tt][i] = *(const f32x4*)(x + o); yin[tt][i] = *(const uint2*)(y + o);
      }
#pragma unroll
    for (int tt = 0; tt < 4; ++tt) {
      const int tl = wid * 4 + tt, t = t0 + tl;
      f32x4 v[4]; float s = 0.f;
#pragma unroll
      for (int i = 0; i < 4; ++i) {
        const int c = lane * 4 + 256 * i;
        const f32x4 g1 = *(const f32x4*)(mod + 2048 + c);
        const uint2 u = yin[tt][i];
        const f32x4 yv = {__uint_as_float(u.x << 16), __uint_as_float(u.x & 0xffff0000u), __uint_as_float(u.y << 16), __uint_as_float(u.y & 0xffff0000u)};
        v[i] = xin[tt][i] * DN_ALPHA + g1 * yv;
        s += v[i][0] + v[i][1] + v[i][2] + v[i][3];
      }
      float mu = wave_sum(s) * (1.f / DM); float q = 0.f;
#pragma unroll
      for (int i = 0; i < 4; ++i) { v[i] -= mu; q += v[i][0] * v[i][0] + v[i][1] * v[i][1] + v[i][2] * v[i][2] + v[i][3] * v[i][3]; }
      float rs = rsqrtf(wave_sum(q) * (1.f / DM) + 1e-5f);
      s = 0.f;
#pragma unroll
      for (int i = 0; i < 4; ++i) {
        const int c = lane * 4 + 256 * i;
        f32x4 g = *(const f32x4*)(ln1_g + c), b = *(const f32x4*)(ln1_b + c);
        v[i] = v[i] * rs * g + b;
        *(uint2*)(x1 + (long)t * DM + c) = pk4(v[i]);
        s += v[i][0] + v[i][1] + v[i][2] + v[i][3];
      }
      mu = wave_sum(s) * (1.f / DM); q = 0.f;
#pragma unroll
      for (int i = 0; i < 4; ++i) { v[i] -= mu; q += v[i][0] * v[i][0] + v[i][1] * v[i][1] + v[i][2] * v[i][2] + v[i][3] * v[i][3]; }
      rs = rsqrtf(wave_sum(q) * (1.f / DM) + 1e-5f);
#pragma unroll
      for (int i = 0; i < 4; ++i) {
        const int c = lane * 4 + 256 * i;
        f32x4 sh = *(const f32x4*)(mod + 3072 + c), sc = *(const f32x4*)(mod + 4096 + c);
        v[i] = v[i] * rs * (sc + 1.f) + sh;
        const uint2 whi = {pack2(v[i][0], v[i][1]), pack2(v[i][2], v[i][3])};
        f32x4 r;
        r[0] = v[i][0] - __uint_as_float(whi.x << 16); r[1] = v[i][1] - __uint_as_float(whi.x & 0xffff0000u);
        r[2] = v[i][2] - __uint_as_float(whi.y << 16); r[3] = v[i][3] - __uint_as_float(whi.y & 0xffff0000u);
        const uint2 wlo = {pack2(r[0], r[1]), pack2(r[2], r[3])};
        *(uint2*)(h2 + (long)t * DM + c) = whi;
        *(uint2*)(HI + tl * HLS + c) = whi;
        *(uint2*)(LO + tl * HLS + c) = wlo;
      }
    }
    __syncthreads();
    {
      const int own = wid < 4;
      const int mrow = own ? 16 * wid : 64;
      f32x4 acc0 = {0.f, 0.f, 0.f, 0.f}, acc1 = {0.f, 0.f, 0.f, 0.f};
      bf16x8 a[8], an[8];
      const int nbatch = own ? 12 : 3;
#define RT_LOAD(bi_, dst) do { const int ps_ = own ? ((bi_) >> 2) : (bi_), kb_ = own ? (((bi_) & 3) * 8) : ((wid - 4) * 8); const bfr* Wp_ = ps_ == 1 ? Wlo : Whi; \
        _Pragma("unroll") for (int u = 0; u < 8; ++u) dst[u] = *(const bf16x8*)(Wp_ + (size_t)(mrow + fr) * 1024 + (kb_ + u) * 32 + fq * 8); } while (0)
      RT_LOAD(0, a);
#pragma unroll 1
      for (int bi = 0; bi < nbatch; ++bi) {
        if (bi + 1 < nbatch) RT_LOAD(bi + 1, an);
        const int ps = own ? (bi >> 2) : bi, kb = own ? ((bi & 3) * 8) : ((wid - 4) * 8);
        const short* Hp = ps == 2 ? LO : HI;
#pragma unroll
        for (int u = 0; u < 8; ++u) {
          const bf16x8 b0 = *(const bf16x8*)(Hp + fr * HLS + (kb + u) * 32 + fq * 8);
          const bf16x8 b1 = *(const bf16x8*)(Hp + (16 + fr) * HLS + (kb + u) * 32 + fq * 8);
          acc0 = __builtin_amdgcn_mfma_f32_16x16x32_bf16(a[u], b0, acc0, 0, 0, 0);
          acc1 = __builtin_amdgcn_mfma_f32_16x16x32_bf16(a[u], b1, acc1, 0, 0, 0);
        }
#pragma unroll
        for (int u = 0; u < 8; ++u) a[u] = an[u];
      }
#undef RT_LOAD
      if (own) {
#pragma unroll
        for (int reg = 0; reg < 4; ++reg) { LG[fr * 80 + mrow + 4 * fq + reg] = acc0[reg]; LG[(16 + fr) * 80 + mrow + 4 * fq + reg] = acc1[reg]; }
      } else {
#pragma unroll
        for (int reg = 0; reg < 4; ++reg) { PS[((wid - 4) * 32 + fr) * 16 + 4 * fq + reg] = acc0[reg]; PS[((wid - 4) * 32 + 16 + fr) * 16 + 4 * fq + reg] = acc1[reg]; }
      }
    }
    __syncthreads();
    {
      const int tk = tid >> 4, o = tid & 15;
      LG[tk * 80 + 64 + o] = (PS[(0 * 32 + tk) * 16 + o] + PS[(1 * 32 + tk) * 16 + o]) + (PS[(2 * 32 + tk) * 16 + o] + PS[(3 * 32 + tk) * 16 + o]);
    }
    __syncthreads();
    if (tid < 32) {
      const int t = t0 + tid;
      const float* lg = LG + tid * 80;
      int gi = 0; float gmax = -3.4e38f; float gl[8];
#pragma unroll
      for (int g = 0; g < 8; ++g) { gl[g] = lg[g] + bgrp[g]; if (gl[g] > gmax) { gmax = gl[g]; gi = g; } }
      float den = 0.f;
#pragma unroll
      for (int g = 0; g < 8; ++g) den += __expf(gl[g] - gmax);
      const float gprob = 1.f / den;
      int i1 = 0; float v1 = -3.4e38f; float el[8];
#pragma unroll
      for (int g = 0; g < 8; ++g) { el[g] = lg[8 + gi * 8 + g] + brt[gi * 8 + g]; if (el[g] > v1) { v1 = el[g]; i1 = g; } }
      int i2 = 0; float v2 = -3.4e38f;
#pragma unroll
      for (int g = 0; g < 8; ++g) { if (g != i1 && el[g] > v2) { v2 = el[g]; i2 = g; } }
      const float e2 = __expf(v2 - v1);
      const float wt1 = gprob / (1.f + e2), wt2 = gprob * e2 / (1.f + e2);
      const int ex1 = gi * 8 + i1, ex2 = gi * 8 + i2;
      int s1 = atomicAdd(&cnt[ex1], 1); list[ex1 * T_LAT + s1] = t * 2;
      int s2 = atomicAdd(&cnt[ex2], 1); list[ex2 * T_LAT + s2] = t * 2 + 1;
      asgw[t * 2] = wt1; asgw[t * 2 + 1] = wt2;
    }
  }
}

DI void phase_final(CParams& P, int bid, int nb) {
  const float* mod = (const float*)(P.ws + WS_MOD);
  const float* ln2_g = P.in[23]; const float* ln2_b = P.in[24];
  const bfr* mout = (const bfr*)(P.ws + (42ull << 20));
  const bfr* x1b = (const bfr*)(P.ws + WS_X1B);
  const float* asgw = (const float*)(P.ws + WS_ASGW);
  float* out = P.out;
  const int wid = VT >> 6, lane = VT & 63;
  for (int t0 = (bid * 4 + wid) * 2; t0 < T_LAT; t0 += nb * 8) {
    f32x4 v[2][4]; float s[2] = {0.f, 0.f};
#pragma unroll
    for (int r = 0; r < 2; ++r) {
      const int t = t0 + r;
      const float w1 = asgw[t * 2], w2 = asgw[t * 2 + 1];
#pragma unroll
      for (int i = 0; i < 4; ++i) {
        const int c = lane * 4 + 256 * i;
        const f32x4 xv = ld4bf(x1b + (long)t * DM + c), g2 = *(const f32x4*)(mod + 5120 + c);
        const f32x4 a = ld4bf(mout + (long)(2 * t) * DM + c), b = ld4bf(mout + (long)(2 * t + 1) * DM + c);
        v[r][i] = xv * DN_ALPHA + g2 * (a * w1 + b * w2);
        s[r] += v[r][i][0] + v[r][i][1] + v[r][i][2] + v[r][i][3];
      }
    }
#pragma unroll
    for (int r = 0; r < 2; ++r) {
      const float mu = wave_sum(s[r]) * (1.f / DM); float q = 0.f;
#pragma unroll
      for (int i = 0; i < 4; ++i) { v[r][i] -= mu; q += v[r][i][0] * v[r][i][0] + v[r][i][1] * v[r][i][1] + v[r][i][2] * v[r][i][2] + v[r][i][3] * v[r][i][3]; }
      const float rs = rsqrtf(wave_sum(q) * (1.f / DM) + 1e-5f);
#pragma unroll
      for (int i = 0; i < 4; ++i) {
        const int c = lane * 4 + 256 * i;
        f32x4 g = *(const f32x4*)(ln2_g + c), b = *(const f32x4*)(ln2_b + c);
        *(f32x4*)(out + (long)(t0 + r) * DM + c) = v[r][i] * rs * g + b;
      }
    }
  }
}

DI void phase_readout_fused(CParams& P, int bid, int nb) {
  const bfr* p = (const bfr*)(P.ws + WS_P);
  const bfr* R = (const bfr*)(P.ws + WS_RW); const bfr* K = (const bfr*)(P.ws + WS_RW + RW_ARR); const bfr* V = (const bfr*)(P.ws + WS_RW + 2 * RW_ARR);
  const bfr* G = (const bfr*)(P.ws + WS_RW + 5 * RW_ARR);
  const float* hg_norm_w = P.in[9]; const float* r_k = P.in[18]; const float* gn_w = P.in[19]; const float* gn_b = P.in[20];
  bfr* mix = (bfr*)(P.ws + WS_MIX);
  const int tid = VT, lane = tid & 63, w = tid >> 6, fr = lane & 15, fq = lane >> 4;
  const f32x4 z4 = {0.f, 0.f, 0.f, 0.f};
  for (int tile = bid; tile < T_LAT / 32; tile += nb) {
    const int t0 = tile * 32;
#pragma unroll 1
    for (int hh = 0; hh < 2; ++hh) {
      const int hd = 2 * w + hh;
      f32x4 acc[4][2];
#pragma unroll
      for (int m = 0; m < 4; ++m) { acc[m][0] = z4; acc[m][1] = z4; }
#pragma unroll
      for (int dir = 0; dir < 2; ++dir) {
        const int ci = dir ? (519 - tile) : (8 + tile);
        const int sc = rw_sc_of_chunk(ci);
        const bfr* Bq = (const bfr*)(P.ws + WS_R2P) + (size_t)dir * T_LAT * 512 + (size_t)t0 * 512 + hd * 64;
        const bfr* Y0 = (const bfr*)(P.ws + WS_Y0P) + (size_t)dir * T_LAT * 512 + (size_t)t0 * 512 + hd * 64;
        const bfr* Sin = (const bfr*)(P.ws + WS_SINRW) + ((size_t)(dir * 8 + hd) * (RW_NSC + 1) + sc) * 4096;
#pragma unroll
        for (int k0 = 0; k0 < 64; k0 += 32) {
          bf16x8 bq[2];
#pragma unroll
          for (int n = 0; n < 2; ++n) bq[n] = *(const bf16x8*)(Bq + (size_t)(16 * n + fr) * 512 + k0 + fq * 8);
#pragma unroll
          for (int m = 0; m < 4; ++m) {
            const bf16x8 a = *(const bf16x8*)(Sin + (16 * m + fr) * 64 + k0 + fq * 8);
#pragma unroll
            for (int n = 0; n < 2; ++n) acc[m][n] = __builtin_amdgcn_mfma_f32_16x16x32_bf16(a, bq[n], acc[m][n], 0, 0, 0);
          }
        }
#pragma unroll
        for (int m = 0; m < 4; ++m)
#pragma unroll
          for (int n = 0; n < 2; ++n) acc[m][n] += ld4bf(Y0 + (size_t)(16 * n + fr) * 512 + 16 * m + 4 * fq);
      }
#pragma unroll
      for (int n = 0; n < 2; ++n) {
        const size_t trow = (size_t)(t0 + 16 * n + fr) * 512 + hd * 64;
        float s = 0.f, bs = 0.f;
        f32x4 vv[4];
#pragma unroll
        for (int m = 0; m < 4; ++m) {
          const int c = 16 * m + 4 * fq;
          s += acc[m][n][0] + acc[m][n][1] + acc[m][n][2] + acc[m][n][3];
          const f32x4 rr = ld4bf(R + trow + c), kk2 = ld4bf(K + trow + c), rk = *(const f32x4*)(r_k + hd * 64 + c);
          vv[m] = ld4bf(V + trow + c);
          bs += rr[0] * kk2[0] * rk[0] + rr[1] * kk2[1] * rk[1] + rr[2] * kk2[2] * rk[2] + rr[3] * kk2[3] * rk[3];
        }
        s += __shfl_xor(s, 16); s += __shfl_xor(s, 32);
        bs += __shfl_xor(bs, 16); bs += __shfl_xor(bs, 32);
        const float mu = s * (1.f / 64.f);
        float q = 0.f;
#pragma unroll
        for (int m = 0; m < 4; ++m) { acc[m][n] -= mu; q += acc[m][n][0] * acc[m][n][0] + acc[m][n][1] * acc[m][n][1] + acc[m][n][2] * acc[m][n][2] + acc[m][n][3] * acc[m][n][3]; }
        q += __shfl_xor(q, 16); q += __shfl_xor(q, 32);
        const float rs = rsqrtf(q * (1.f / 64.f) + 64e-5f);
#pragma unroll
        for (int m = 0; m < 4; ++m) {
          const int c = hd * 64 + 16 * m + 4 * fq;
          const f32x4 gw = *(const f32x4*)(gn_w + c), gb = *(const f32x4*)(gn_b + c), gg = ld4bf(G + trow + 16 * m + 4 * fq);
          const f32x4 o = (acc[m][n] * rs * gw + gb + vv[m] * bs) * gg;
          *(uint2*)(mix + (size_t)(t0 + 16 * n + fr) * DM + 512 + c) = pk4(o);
        }
      }
    }
    {
      const int hd = w;
      f32x4 acc[8][2];
#pragma unroll
      for (int m = 0; m < 8; ++m) { acc[m][0] = z4; acc[m][1] = z4; }
#pragma unroll
      for (int dir = 0; dir < 2; ++dir) {
        const int ci = dir ? (519 - tile) : (8 + tile);
        const int sc = hg_sc_of_chunk(ci);
        const bfr* Bq = (const bfr*)(P.ws + WS_QH) + (size_t)dir * T_LAT * 512 + (size_t)t0 * 512 + hd * 128;
        const bfr* O0 = (const bfr*)(P.ws + WS_O0) + (size_t)dir * T_LAT * 512 + (size_t)t0 * 512 + hd * 128;
        const bfr* Sin = (const bfr*)(P.ws + WS_SINHG) + ((size_t)(dir * 4 + hd) * HG_NSC + sc) * 16384;
#pragma unroll
        for (int k0 = 0; k0 < 128; k0 += 32) {
          bf16x8 bq[2];
#pragma unroll
          for (int n = 0; n < 2; ++n) bq[n] = *(const bf16x8*)(Bq + (size_t)(16 * n + fr) * 512 + k0 + fq * 8);
#pragma unroll
          for (int m = 0; m < 8; ++m) {
            const bf16x8 a = *(const bf16x8*)(Sin + (16 * m + fr) * 128 + k0 + fq * 8);
#pragma unroll
            for (int n = 0; n < 2; ++n) acc[m][n] = __builtin_amdgcn_mfma_f32_16x16x32_bf16(a, bq[n], acc[m][n], 0, 0, 0);
          }
        }
#pragma unroll
        for (int m = 0; m < 8; ++m)
#pragma unroll
          for (int n = 0; n < 2; ++n) acc[m][n] += ld4bf(O0 + (size_t)(16 * n + fr) * 512 + 16 * m + 4 * fq);
      }
#pragma unroll
      for (int n = 0; n < 2; ++n) {
        const int t = t0 + 16 * n + fr;
        float ss = 0.f;
#pragma unroll
        for (int m = 0; m < 8; ++m) ss += acc[m][n][0] * acc[m][n][0] + acc[m][n][1] * acc[m][n][1] + acc[m][n][2] * acc[m][n][2] + acc[m][n][3] * acc[m][n][3];
        ss += __shfl_xor(ss, 16); ss += __shfl_xor(ss, 32);
        const float rs = rsqrtf(ss * (1.f / 128.f) + 1e-6f);
#pragma unroll
        for (int m = 0; m < 8; ++m) {
          const int c = hd * 128 + 16 * m + 4 * fq;
          const f32x4 nw = *(const f32x4*)(hg_norm_w + c), gg = ld4bf(p + (size_t)t * DIN + 2048 + c);
          f32x4 o;
#pragma unroll
          for (int e = 0; e < 4; ++e) o[e] = acc[m][n][e] * rs * nw[e] * siluf_(gg[e]);
          *(uint2*)(mix + (size_t)t * DM + c) = pk4(o);
        }
      }
    }
  }
}

namespace pg8 {
#define PG8_LAS __attribute__((address_space(3)))
typedef unsigned short bf16_t;
typedef short bf16x8 __attribute__((ext_vector_type(8)));
typedef float f32x4 __attribute__((ext_vector_type(4)));
typedef unsigned u32x4 __attribute__((ext_vector_type(4)));
constexpr int BM = 256, BK = 64, HALF = 128, HTB = HALF * BK * 2  , STAGE_BYTES = 8 * HTB, NXCD = 8, WGM = 8;

__host__ __device__ __forceinline__ int lds_byte(int r, int c) { const int st = (r >> 4) * 2 + (c >> 5), rr = r & 15, cc = c & 31, ob = rr * 64 + cc * 2; return st * 1024 + (ob ^ (((ob >> 9) & 1) << 5)); }
__host__ __device__ __forceinline__ void stage_rc(int b, int& R, int& C) { const int st = b / 1024, sb = b % 1024, swz = sb ^ (((sb >> 9) & 1) << 5); R = (st >> 1) * 16 + swz / 64; C = (st & 1) * 32 + (swz % 64) / 2; }
__host__ __device__ __forceinline__ int perm32(int rho) { const int n = rho >> 4, i = rho & 15; return 8 * (i >> 2) + 4 * n + (i & 3); }

struct Unit { int pm, pn; };
struct Gemm { const bf16_t* A; const bf16_t* Bt; int M, N, K; };

struct StaticOrder {
    int nM, nN, nwg, G, c;
    __host__ __device__ void init(int M, int N, int G_, int c_) { nM = M / BM; nN = N / BM; nwg = nM * nN; G = G_; c = c_; }
    __host__ __device__ bool next(int i, Unit& u) const {
        const long L = (long)i * G + c; if (L >= nwg) return false;
        int wgid = (int)L; { const int q = nwg / NXCD, r = nwg % NXCD, xcd = wgid % NXCD, off = wgid / NXCD; wgid = (xcd < r ? xcd * (q + 1) : r * (q + 1) + (xcd - r) * q) + off; }
        const int nig = WGM * nN, gid = wgid / nig, fm = gid * WGM, gsz = (nM - fm) < WGM ? (nM - fm) : WGM;
        u.pm = fm + ((wgid % nig) % gsz); u.pn = (wgid % nig) / gsz; return true;
    }
    __device__ __forceinline__ void a_ready(const Unit&) const {}
    __device__ __forceinline__ void done(const Unit&) const {}
};
struct CountedOrder : StaticOrder {
    const unsigned* ready; unsigned need; unsigned* tmo;
    __device__ __forceinline__ void a_ready(const Unit& u) const {
        if (threadIdx.x < 64) {
            const unsigned long long t0 = __builtin_amdgcn_s_memrealtime(); unsigned polls = 0;
            while ((unsigned)__builtin_amdgcn_readfirstlane(__hip_atomic_load(ready + 64 * u.pm, __ATOMIC_RELAXED, __HIP_MEMORY_SCOPE_AGENT)) < need) {
                if ((++polls & 255u) == 0u && __builtin_amdgcn_readfirstlane(__hip_atomic_load(tmo, __ATOMIC_RELAXED, __HIP_MEMORY_SCOPE_AGENT)) != 0u) break;
                if (__builtin_amdgcn_s_memrealtime() - t0 > 2000000ull) {
                    if (threadIdx.x == 0) { unsigned expect = 0u; __hip_atomic_compare_exchange_strong(tmo + 1, &expect, 0x600u | (unsigned)(u.pm & 0xff), __ATOMIC_RELAXED, __ATOMIC_RELAXED, __HIP_MEMORY_SCOPE_AGENT); __hip_atomic_store(tmo, 1u, __ATOMIC_RELAXED, __HIP_MEMORY_SCOPE_AGENT); }
                    break; }
                __builtin_amdgcn_s_sleep(2); }
            __builtin_amdgcn_fence(__ATOMIC_ACQUIRE, "agent");
            asm volatile("s_waitcnt vmcnt(0)" ::: "memory");
        }
#if !defined(BROKEN_HOOK_NO_BARRIER)
        asm volatile("" ::: "memory"); __builtin_amdgcn_s_barrier(); asm volatile("" ::: "memory");
#endif
    }
};
struct EpiF32 {
    static constexpr bool PERM = false, AFTER_DRAIN = false;
    float* C; int ldc; const float* bias;
    __device__ __forceinline__ void operator()(const f32x4 (&acc)[2][2][4][2], const Unit& u, int wr, int wc, int fr, int fq) const {
        const int row0 = u.pm * BM + wr * 64 + fr, col0 = u.pn * BM + wc * 32 + 4 * fq;
        f32x4 bv[2][2];
#pragma unroll
        for (int bj = 0; bj < 2; ++bj)
#pragma unroll
            for (int n = 0; n < 2; ++n) bv[bj][n] = bias ? *(const f32x4*)(bias + col0 + bj * HALF + n * 16) : (f32x4){0.f, 0.f, 0.f, 0.f};
#pragma unroll
        for (int ai = 0; ai < 2; ++ai)
#pragma unroll
            for (int m = 0; m < 4; ++m) { float* rowp = C + (size_t)(row0 + ai * HALF + m * 16) * ldc + col0;
#pragma unroll
                for (int bj = 0; bj < 2; ++bj)
#pragma unroll
                    for (int n = 0; n < 2; ++n) *(f32x4*)(rowp + bj * HALF + n * 16) = acc[ai][bj][m][n] + bv[bj][n]; }
    }
};
template <class Epi, class Sched, bool STAMP = false>
__device__ __forceinline__ void gemm_phase(PG8_LAS unsigned char* lds, const Gemm g, const Sched& S, const Epi& E, unsigned long long* stamps) {
    int tid_ = threadIdx.x; asm volatile("" : "+v"(tid_));
    const int tid = tid_, wid = __builtin_amdgcn_readfirstlane(tid >> 6), lane = tid & 63, wr = wid >> 2, wc = wid & 3, fr = lane & 15, fq = lane >> 4;
    const int K = g.K, nt = K / BK;
    int ts_lo = 0, ts_hi = 0, nts = 0; const unsigned long long rt_entry = STAMP ? (unsigned long long)wall_clock64() : 0ull;
#define PG8_STAMP() do { if (STAMP && wid == 0 && nts < 64) { const unsigned long long _c = (unsigned long long)clock64(); \
        ts_lo = (lane == nts) ? (int)(unsigned)_c : ts_lo; ts_hi = (lane == nts) ? (int)(unsigned)(_c >> 32) : ts_hi; ++nts; } } while (0)
    PG8_STAMP();
    unsigned voffA[2], voffB[2];
#pragma unroll
    for (int i = 0; i < 2; ++i) { int R, C; stage_rc(tid * 16 + i * 8192, R, C); const int Rb = Epi::PERM ? ((R & ~31) + perm32(R & 31)) : R;
        voffA[i] = (unsigned)(R * K + C) * 2u; voffB[i] = (unsigned)(Rb * K + C) * 2u; }
    const size_t kstep = (size_t)(BK * 2);
    const size_t hstep = (size_t)HALF * K * 2;
    const size_t tstep = 2 * hstep;
    const unsigned ldsw = (unsigned)wid * 1024u;
    const int aoff = lds_byte(wr * 64 + fr, fq * 8), boff = lds_byte(wc * 32 + fr, fq * 8);
#define PG8_SA(b, h) (((b) * 2 + (h)) * HTB)
#define PG8_SB(b, h) ((4 + (b) * 2 + (h)) * HTB)
#define PG8_STAGE(bufoff, gbase, voff) do { _Pragma("unroll") for (int _i = 0; _i < 2; ++_i) \
        __builtin_amdgcn_global_load_lds((const unsigned*)((const char*)(gbase) + (voff)[_i]), (PG8_LAS unsigned*)(lds + (bufoff) + ldsw + _i * 8192), 16, 0, 0); } while (0)
#define PG8_LDA(dst, b, h) do { _Pragma("unroll") for (int m = 0; m < 4; ++m) _Pragma("unroll") for (int k = 0; k < 2; ++k) dst[m][k] = *(const PG8_LAS bf16x8*)(lds + PG8_SA(b, h) + aoff + m * 2048 + k * 1024); } while (0)
#define PG8_LDB(dst, b, h) do { _Pragma("unroll") for (int n = 0; n < 2; ++n) _Pragma("unroll") for (int k = 0; k < 2; ++k) dst[n][k] = *(const PG8_LAS bf16x8*)(lds + PG8_SB(b, h) + boff + n * 2048 + k * 1024); } while (0)
#define PG8_MMA(ai, bj, At, Bt) do { __builtin_amdgcn_s_setprio(1); _Pragma("unroll") for (int m = 0; m < 4; ++m) _Pragma("unroll") for (int n = 0; n < 2; ++n) _Pragma("unroll") for (int k = 0; k < 2; ++k) \
        acc[ai][bj][m][n] = __builtin_amdgcn_mfma_f32_16x16x32_bf16(Bt[n][k], At[m][k], acc[ai][bj][m][n], 0, 0, 0); __builtin_amdgcn_s_setprio(0); } while (0)
#define PG8_WAIT_V(n) asm volatile("s_waitcnt vmcnt(" #n ")" ::: "memory")
#define PG8_WAIT_L(n) asm volatile("s_waitcnt lgkmcnt(" #n ")" ::: "memory")
#define PG8_BAR __builtin_amdgcn_s_barrier()
#define PG8_SCHED __builtin_amdgcn_sched_barrier(0)
    Unit cur, nxt; int ui = 0;
    if (!S.next(0, cur)) return;
    f32x4 acc[2][2][4][2];
#pragma unroll
    for (int a = 0; a < 2; ++a)
#pragma unroll
        for (int b = 0; b < 2; ++b)
#pragma unroll
            for (int m = 0; m < 4; ++m)
#pragma unroll
                for (int n = 0; n < 2; ++n) acc[a][b][m][n] = (f32x4){0.f, 0.f, 0.f, 0.f};
    bf16x8 At[4][2], B0[2][2], B1[2][2];
    const char* cA = (const char*)g.A + (size_t)cur.pm * tstep; const char* cB = (const char*)g.Bt + (size_t)cur.pn * tstep;
    S.a_ready(cur);
    PG8_STAGE(PG8_SB(0, 0), cB, voffB); PG8_STAGE(PG8_SA(0, 0), cA, voffA); PG8_STAGE(PG8_SB(0, 1), cB + hstep, voffB); PG8_STAGE(PG8_SA(0, 1), cA + hstep, voffA);
    if (wr == 1) PG8_BAR;
    PG8_WAIT_V(4); PG8_BAR;
    PG8_STAGE(PG8_SB(1, 0), cB + kstep, voffB); PG8_STAGE(PG8_SA(1, 0), cA + kstep, voffA); PG8_STAGE(PG8_SB(1, 1), cB + hstep + kstep, voffB);
    PG8_WAIT_V(6); PG8_BAR;
    PG8_STAMP();
    for (;;) {
        const bool has_next = S.next(ui + 1, nxt);
        const char* nA = has_next ? (const char*)g.A + (size_t)nxt.pm * tstep : cA; const char* nB = has_next ? (const char*)g.Bt + (size_t)nxt.pn * tstep : cB;
        for (int t = 0; t < nt; t += 2) {
            const bool last = (t == nt - 2);
            const char* a1 = cA + (size_t)(t + 1) * kstep;
            const char* a2 = last ? nA : cA + (size_t)(t + 2) * kstep; const char* b2 = last ? nB : cB + (size_t)(t + 2) * kstep;
            const char* a3 = a2 + kstep; const char* b3 = b2 + kstep;
            if (last && has_next) S.a_ready(nxt);
            PG8_LDB(B0, 0, 0); PG8_SCHED; PG8_LDA(At, 0, 0); PG8_STAGE(PG8_SA(1, 1), a1 + hstep, voffA);
            PG8_WAIT_L(8); PG8_BAR; PG8_WAIT_L(0); PG8_MMA(0, 0, At, B0); PG8_BAR; PG8_SCHED;
            PG8_LDB(B1, 0, 1); PG8_STAGE(PG8_SB(0, 0), b2, voffB);
            PG8_BAR; PG8_WAIT_L(0); PG8_MMA(0, 1, At, B1); PG8_BAR;
            PG8_LDA(At, 0, 1); PG8_STAGE(PG8_SA(0, 0), a2, voffA);
            PG8_BAR; PG8_WAIT_L(0); PG8_MMA(1, 0, At, B0); PG8_BAR; PG8_SCHED;
            PG8_STAGE(PG8_SB(0, 1), b2 + hstep, voffB);
            PG8_WAIT_V(6); PG8_BAR; PG8_MMA(1, 1, At, B1); PG8_BAR;
            PG8_LDB(B0, 1, 0); PG8_SCHED; PG8_LDA(At, 1, 0); PG8_STAGE(PG8_SA(0, 1), a2 + hstep, voffA);
            PG8_WAIT_L(8); PG8_BAR; PG8_WAIT_L(0); PG8_MMA(0, 0, At, B0); PG8_BAR; PG8_SCHED;
            PG8_LDB(B1, 1, 1); PG8_STAGE(PG8_SB(1, 0), b3, voffB);
            PG8_BAR; PG8_WAIT_L(0); PG8_MMA(0, 1, At, B1); PG8_BAR;
            PG8_LDA(At, 1, 1); PG8_STAGE(PG8_SA(1, 0), a3, voffA);
            PG8_BAR; PG8_WAIT_L(0); PG8_MMA(1, 0, At, B0); PG8_BAR; PG8_SCHED;
            PG8_STAGE(PG8_SB(1, 1), b3 + hstep, voffB);
            PG8_WAIT_V(6); PG8_BAR; PG8_MMA(1, 1, At, B1); PG8_BAR;
        }
        PG8_STAMP();
        if constexpr (!Epi::AFTER_DRAIN) { E(acc, cur, wr, wc, fr, fq); S.done(cur); }
        PG8_STAMP();
        if (!has_next) break;
#pragma unroll
        for (int a = 0; a < 2; ++a)
#pragma unroll
            for (int b = 0; b < 2; ++b)
#pragma unroll
                for (int m = 0; m < 4; ++m)
#pragma unroll
                    for (int n = 0; n < 2; ++n) acc[a][b][m][n] = (f32x4){0.f, 0.f, 0.f, 0.f};
        cur = nxt; cA = nA; cB = nB; ++ui;
    }
    PG8_WAIT_V(0);
    if (wr == 0) PG8_BAR;
    PG8_BAR;
    if constexpr (Epi::AFTER_DRAIN) { E.fused(acc, cur, wr, wc, fr, fq, lds, wid, lane); S.done(cur); }
    PG8_STAMP();
    if (STAMP && wid == 0) { stamps[lane] = lane < nts ? (((unsigned long long)(unsigned)ts_hi << 32) | (unsigned)ts_lo) : 0ull;
        if (lane == 62) stamps[62] = rt_entry; if (lane == 63) stamps[63] = (unsigned long long)wall_clock64(); }
#undef PG8_STAMP
#undef PG8_SA
#undef PG8_SB
#undef PG8_STAGE
#undef PG8_LDA
#undef PG8_LDB
#undef PG8_MMA
#undef PG8_WAIT_V
#undef PG8_WAIT_L
#undef PG8_BAR
#undef PG8_SCHED
}
template <class Epi, class Sched, class Gat, bool STAMP = false>
__device__ __forceinline__ void gemm_phase_gather(PG8_LAS unsigned char* lds, const Gemm g, const Sched& S, const Epi& E, const Gat& G, unsigned long long* stamps) {
    int tid_ = threadIdx.x; asm volatile("" : "+v"(tid_));
    const int tid = tid_, wid = __builtin_amdgcn_readfirstlane(tid >> 6), lane = tid & 63, wr = wid >> 2, wc = wid & 3, fr = lane & 15, fq = lane >> 4;
    const int K = g.K, nt = K / BK;
    int ts_lo = 0, ts_hi = 0, nts = 0; const unsigned long long rt_entry = STAMP ? (unsigned long long)wall_clock64() : 0ull;
#define PG8_STAMP() do { if (STAMP && wid == 0 && nts < 64) { const unsigned long long _c = (unsigned long long)clock64(); \
        ts_lo = (lane == nts) ? (int)(unsigned)_c : ts_lo; ts_hi = (lane == nts) ? (int)(unsigned)(_c >> 32) : ts_hi; ++nts; } } while (0)
    PG8_STAMP();
    unsigned voffA[2], voffB[2]; int RA[2]; unsigned CA2[2];
#pragma unroll
    for (int i = 0; i < 2; ++i) { int R, C; stage_rc(tid * 16 + i * 8192, R, C); const int Rb = Epi::PERM ? ((R & ~31) + perm32(R & 31)) : R;
        voffA[i] = (unsigned)(R * K + C) * 2u; voffB[i] = (unsigned)(Rb * K + C) * 2u; RA[i] = R; CA2[i] = (unsigned)C * 2u; }
    const size_t kstep = (size_t)(BK * 2);
    const size_t hstep = (size_t)HALF * K * 2;
    const size_t tstep = 2 * hstep;
    const unsigned ldsw = (unsigned)wid * 1024u;
    const int aoff = lds_byte(wr * 64 + fr, fq * 8), boff = lds_byte(wc * 32 + fr, fq * 8);
#define PG8_SA(b, h) (((b) * 2 + (h)) * HTB)
#define PG8_SB(b, h) ((4 + (b) * 2 + (h)) * HTB)
#define PG8_STAGE(bufoff, gbase, voff) do { _Pragma("unroll") for (int _i = 0; _i < 2; ++_i) \
        __builtin_amdgcn_global_load_lds((const unsigned*)((const char*)(gbase) + (voff)[_i]), (PG8_LAS unsigned*)(lds + (bufoff) + ldsw + _i * 8192), 16, 0, 0); } while (0)
#define PG8_LDA(dst, b, h) do { _Pragma("unroll") for (int m = 0; m < 4; ++m) _Pragma("unroll") for (int k = 0; k < 2; ++k) dst[m][k] = *(const PG8_LAS bf16x8*)(lds + PG8_SA(b, h) + aoff + m * 2048 + k * 1024); } while (0)
#define PG8_LDB(dst, b, h) do { _Pragma("unroll") for (int n = 0; n < 2; ++n) _Pragma("unroll") for (int k = 0; k < 2; ++k) dst[n][k] = *(const PG8_LAS bf16x8*)(lds + PG8_SB(b, h) + boff + n * 2048 + k * 1024); } while (0)
#define PG8_MMA(ai, bj, At, Bt) do { __builtin_amdgcn_s_setprio(1); _Pragma("unroll") for (int m = 0; m < 4; ++m) _Pragma("unroll") for (int n = 0; n < 2; ++n) _Pragma("unroll") for (int k = 0; k < 2; ++k) \
        acc[ai][bj][m][n] = __builtin_amdgcn_mfma_f32_16x16x32_bf16(Bt[n][k], At[m][k], acc[ai][bj][m][n], 0, 0, 0); __builtin_amdgcn_s_setprio(0); } while (0)
#define PG8_WAIT_V(n) asm volatile("s_waitcnt vmcnt(" #n ")" ::: "memory")
#define PG8_WAIT_L(n) asm volatile("s_waitcnt lgkmcnt(" #n ")" ::: "memory")
#define PG8_BAR __builtin_amdgcn_s_barrier()
#define PG8_SCHED __builtin_amdgcn_sched_barrier(0)
    Unit cur, nxt; int ui = 0;
    if (!S.next(0, cur)) return;
    f32x4 acc[2][2][4][2];
#pragma unroll
    for (int a = 0; a < 2; ++a)
#pragma unroll
        for (int b = 0; b < 2; ++b)
#pragma unroll
            for (int m = 0; m < 4; ++m)
#pragma unroll
                for (int n = 0; n < 2; ++n) acc[a][b][m][n] = (f32x4){0.f, 0.f, 0.f, 0.f};
    bf16x8 At[4][2], B0[2][2], B1[2][2];
    const char* Ab = (const char*)g.A; const char* cB = (const char*)g.Bt + (size_t)cur.pn * tstep;
    unsigned gc0[2], gc1[2], gn0[2], gn1[2];
#pragma unroll
    for (int i = 0; i < 2; ++i) { gc0[i] = G.rowoff(cur, RA[i]) + CA2[i]; gc1[i] = G.rowoff(cur, RA[i] + 128) + CA2[i]; }
    (void)voffA;
    S.a_ready(cur);
    PG8_STAGE(PG8_SB(0, 0), cB, voffB); PG8_STAGE(PG8_SA(0, 0), Ab, gc0); PG8_STAGE(PG8_SB(0, 1), cB + hstep, voffB); PG8_STAGE(PG8_SA(0, 1), Ab, gc1);
    if (wr == 1) PG8_BAR;
    PG8_WAIT_V(4); PG8_BAR;
    PG8_STAGE(PG8_SB(1, 0), cB + kstep, voffB); PG8_STAGE(PG8_SA(1, 0), Ab + kstep, gc0); PG8_STAGE(PG8_SB(1, 1), cB + hstep + kstep, voffB);
    PG8_WAIT_V(6); PG8_BAR;
    PG8_STAMP();
    for (;;) {
        const bool has_next = S.next(ui + 1, nxt);
        const char* nB = has_next ? (const char*)g.Bt + (size_t)nxt.pn * tstep : cB;
#pragma unroll
        for (int i = 0; i < 2; ++i) { gn0[i] = has_next ? G.rowoff(nxt, RA[i]) + CA2[i] : gc0[i]; gn1[i] = has_next ? G.rowoff(nxt, RA[i] + 128) + CA2[i] : gc1[i]; }
        for (int t = 0; t < nt; t += 2) {
            const bool last = (t == nt - 2);
            const char* a1 = Ab + (size_t)(t + 1) * kstep;
            const char* a2 = last ? Ab : Ab + (size_t)(t + 2) * kstep; const char* b2 = last ? nB : cB + (size_t)(t + 2) * kstep;
            unsigned g2a[2], g2b[2];
#pragma unroll
            for (int i = 0; i < 2; ++i) { g2a[i] = last ? gn0[i] : gc0[i]; g2b[i] = last ? gn1[i] : gc1[i]; }
            const char* a3 = a2 + kstep; const char* b3 = b2 + kstep;
            if (last && has_next) S.a_ready(nxt);
            PG8_LDB(B0, 0, 0); PG8_SCHED; PG8_LDA(At, 0, 0); PG8_STAGE(PG8_SA(1, 1), a1, gc1);
            PG8_WAIT_L(8); PG8_BAR; PG8_WAIT_L(0); PG8_MMA(0, 0, At, B0); PG8_BAR; PG8_SCHED;
            PG8_LDB(B1, 0, 1); PG8_STAGE(PG8_SB(0, 0), b2, voffB);
            PG8_BAR; PG8_WAIT_L(0); PG8_MMA(0, 1, At, B1); PG8_BAR;
            PG8_LDA(At, 0, 1); PG8_STAGE(PG8_SA(0, 0), a2, g2a);
            PG8_BAR; PG8_WAIT_L(0); PG8_MMA(1, 0, At, B0); PG8_BAR; PG8_SCHED;
            PG8_STAGE(PG8_SB(0, 1), b2 + hstep, voffB);
            PG8_WAIT_V(6); PG8_BAR; PG8_MMA(1, 1, At, B1); PG8_BAR;
            PG8_LDB(B0, 1, 0); PG8_SCHED; PG8_LDA(At, 1, 0); PG8_STAGE(PG8_SA(0, 1), a2, g2b);
            PG8_WAIT_L(8); PG8_BAR; PG8_WAIT_L(0); PG8_MMA(0, 0, At, B0); PG8_BAR; PG8_SCHED;
            PG8_LDB(B1, 1, 1); PG8_STAGE(PG8_SB(1, 0), b3, voffB);
            PG8_BAR; PG8_WAIT_L(0); PG8_MMA(0, 1, At, B1); PG8_BAR;
            PG8_LDA(At, 1, 1); PG8_STAGE(PG8_SA(1, 0), a3, g2a);
            PG8_BAR; PG8_WAIT_L(0); PG8_MMA(1, 0, At, B0); PG8_BAR; PG8_SCHED;
            PG8_STAGE(PG8_SB(1, 1), b3 + hstep, voffB);
            PG8_WAIT_V(6); PG8_BAR; PG8_MMA(1, 1, At, B1); PG8_BAR;
        }
        PG8_STAMP();
        if constexpr (!Epi::AFTER_DRAIN) { E(acc, cur, wr, wc, fr, fq); S.done(cur); }
        PG8_STAMP();
        if (!has_next) break;
#pragma unroll
        for (int a = 0; a < 2; ++a)
#pragma unroll
            for (int b = 0; b < 2; ++b)
#pragma unroll
                for (int m = 0; m < 4; ++m)
#pragma unroll
                    for (int n = 0; n < 2; ++n) acc[a][b][m][n] = (f32x4){0.f, 0.f, 0.f, 0.f};
        cur = nxt; cB = nB; ++ui;
#pragma unroll
        for (int i = 0; i < 2; ++i) { gc0[i] = gn0[i]; gc1[i] = gn1[i]; }
    }
    PG8_WAIT_V(0);
    if (wr == 0) PG8_BAR;
    PG8_BAR;
    if constexpr (Epi::AFTER_DRAIN) { E.fused(acc, cur, wr, wc, fr, fq, lds, wid, lane); S.done(cur); }
    PG8_STAMP();
    if (STAMP && wid == 0) { stamps[lane] = lane < nts ? (((unsigned long long)(unsigned)ts_hi << 32) | (unsigned)ts_lo) : 0ull;
        if (lane == 62) stamps[62] = rt_entry; if (lane == 63) stamps[63] = (unsigned long long)wall_clock64(); }
#undef PG8_STAMP
#undef PG8_SA
#undef PG8_SB
#undef PG8_STAGE
#undef PG8_LDA
#undef PG8_LDB
#undef PG8_MMA
#undef PG8_WAIT_V
#undef PG8_WAIT_L
#undef PG8_BAR
#undef PG8_SCHED
}
}

constexpr size_t WS_WINT = 284 * MB;
constexpr size_t WS_WOUTT = 1 * MB;
constexpr int NPAD_IN = 4352;
DI void transpose_tile(const float* W, int ldw, int k0, int n0, int nvalid, bfr* WT, int ldt, char* smem) {
  short* T = (short*)smem;
  const int tid = VT;
  __syncthreads();
  {
    const int r = tid >> 2, c4 = tid & 3;
#pragma unroll
    for (int q = 0; q < 4; ++q) {
      const int n = n0 + 16 * c4 + 4 * q;
      f32x4 v = {0.f, 0.f, 0.f, 0.f};
      if (n < nvalid) v = *(const f32x4*)(W + (size_t)(k0 + r) * ldw + n);
#pragma unroll
      for (int e = 0; e < 4; ++e) T[r * 66 + 16 * c4 + 4 * q + e] = (short)f2bf(v[e]);
    }
  }
  __syncthreads();
  {
    const int n = tid >> 2, kq = tid & 3;
    unsigned wv[8];
#pragma unroll
    for (int e = 0; e < 8; ++e) wv[e] = ((unsigned)(unsigned short)T[(16 * kq + 2 * e) * 66 + n]) | (((unsigned)(unsigned short)T[(16 * kq + 2 * e + 1) * 66 + n]) << 16);
    bfr* dst = WT + (size_t)(n0 + n) * ldt + k0 + 16 * kq;
    *(uint4*)dst = uint4{wv[0], wv[1], wv[2], wv[3]};
    *(uint4*)(dst + 8) = uint4{wv[4], wv[5], wv[6], wv[7]};
  }
}
template <int LDC, int NVALID> struct EpiBf16T {
  static constexpr bool PERM = true, AFTER_DRAIN = false;
  bfr* O;
  DI void operator()(const pg8::f32x4 (&acc)[2][2][4][2], const pg8::Unit& u, int wr, int wc, int fr, int fq) const {
    const int row0 = u.pm * 256 + wr * 64 + fr, col0 = u.pn * 256 + wc * 32 + 8 * fq;
#pragma unroll
    for (int ai = 0; ai < 2; ++ai)
#pragma unroll
      for (int m = 0; m < 4; ++m) {
        bfr* rowp = O + (size_t)(row0 + ai * 128 + m * 16) * LDC + col0;
#pragma unroll
        for (int bj = 0; bj < 2; ++bj) {
          if (col0 + bj * 128 < NVALID) {
            const pg8::f32x4 v0 = acc[ai][bj][m][0], v1 = acc[ai][bj][m][1];
            *(uint4*)(rowp + bj * 128) = uint4{pack2(v0[0], v0[1]), pack2(v0[2], v0[3]), pack2(v1[0], v1[1]), pack2(v1[2], v1[3])};
          }
        }
      }
  }
};
DI void phase_pgemm8(CParams& P, char* smem_all) {
  pg8::Gemm g{(const pg8::bf16_t*)(P.ws + WS_H), (const pg8::bf16_t*)(P.ws + WS_WINT), T_ALL, NPAD_IN, DM};
  pg8::StaticOrder S; S.init(T_ALL, NPAD_IN, (int)gridDim.x, (int)blockIdx.x);
  typedef EpiBf16T<DIN, DIN> EpiP;
  EpiP E{(bfr*)(P.ws + WS_P)};
  pg8::gemm_phase<EpiP, pg8::StaticOrder>((PG8_LAS unsigned char*)smem_all, g, S, E, nullptr);
}
DI void phase_outproj8(CParams& P, char* smem_all) {
  pg8::Gemm g{(const pg8::bf16_t*)(P.ws + WS_MIX), (const pg8::bf16_t*)(P.ws + WS_WOUTT), T_LAT, DM, DM};
  pg8::StaticOrder S; S.init(T_LAT, DM, (int)gridDim.x, (int)blockIdx.x);
  typedef EpiBf16T<DM, DM> EpiY;
  EpiY E{(bfr*)(P.ws + WS_Y)};
  pg8::gemm_phase<EpiY, pg8::StaticOrder>((PG8_LAS unsigned char*)smem_all, g, S, E, nullptr);
}


constexpr size_t WS_BTGU = 350 * MB;
constexpr size_t WS_BTD = 284 * MB;
constexpr size_t WS_HID8 = 138 * MB;
constexpr size_t WS_MOUT8 = 42 * MB;
constexpr int TAB_LDS_OFF = 131072 + 1024;

DI void transpose_quad(const float* W, int ldw, int k0, int n0, bfr* WT, int ldt, int dr0, int dr1, int dr2, int dr3, char* smem, int nvalid = 1 << 30) {
  short* T = (short*)smem;
  const int tid = VT;
  const int r = tid >> 2, c4 = tid & 3;
  f32x4 v[4][4];
#pragma unroll
  for (int j = 0; j < 4; ++j)
#pragma unroll
    for (int q = 0; q < 4; ++q) { const int n_ = n0 + j * 64 + 16 * c4 + 4 * q; v[j][q] = n_ < nvalid ? *(const f32x4*)(W + (size_t)(k0 + r) * ldw + n_) : f32x4{0.f, 0.f, 0.f, 0.f}; }
  __syncthreads();
#pragma unroll
  for (int j = 0; j < 4; ++j)
#pragma unroll
    for (int q = 0; q < 4; ++q)
#pragma unroll
      for (int e = 0; e < 4; ++e) T[j * 64 * 66 + r * 66 + 16 * c4 + 4 * q + e] = (short)f2bf(v[j][q][e]);
  __syncthreads();
  const int n = tid >> 2, kq = tid & 3;
#pragma unroll
  for (int j = 0; j < 4; ++j) {
    unsigned wv[8];
#pragma unroll
    for (int e = 0; e < 8; ++e) wv[e] = ((unsigned)(unsigned short)T[j * 64 * 66 + (16 * kq + 2 * e) * 66 + n]) | (((unsigned)(unsigned short)T[j * 64 * 66 + (16 * kq + 2 * e + 1) * 66 + n]) << 16);
    const int dr = j == 0 ? dr0 : j == 1 ? dr1 : j == 2 ? dr2 : dr3;
    bfr* dst = WT + (size_t)(dr + n) * ldt + k0 + 16 * kq;
    *(uint4*)dst = uint4{wv[0], wv[1], wv[2], wv[3]};
    *(uint4*)(dst + 8) = uint4{wv[4], wv[5], wv[6], wv[7]};
  }
}
DI void phase_moe_convert_gu(CParams& P, int bid, int nb, char* smem) {
  for (int it = bid; it < 64 * 64; it += nb) {
    const int e = it >> 6, s = it & 63;
    const int isup = s >> 5, kt = (s & 31) >> 1, nq = s & 1;
    const float* W = (isup ? P.in[30] : P.in[29]) + (size_t)e * DM * DEXP;
    bfr* WT = (bfr*)(P.ws + WS_BTGU) + (size_t)e * 1024 * 1024;
    const int b = nq * 4;
    transpose_quad(W, DEXP, kt * 64, nq * 256, WT, 1024,
                   ((b + 0) >> 1) * 256 + isup * 128 + ((b + 0) & 1) * 64, ((b + 1) >> 1) * 256 + isup * 128 + ((b + 1) & 1) * 64,
                   ((b + 2) >> 1) * 256 + isup * 128 + ((b + 2) & 1) * 64, ((b + 3) >> 1) * 256 + isup * 128 + ((b + 3) & 1) * 64, smem);
  }
}
constexpr int CONVD_ITEMS = 64 * 32, CONVD_SPLIT = 1152;
DI void phase_moe_convert_d(CParams& P, int bid, int nb, char* smem, int it_lo, int it_hi) {
  for (int it = it_lo + bid; it < it_hi; it += nb) {
    const int e = it >> 5, s2 = it & 31, kt = s2 >> 2, nq = s2 & 3;
    const float* W = P.in[31] + (size_t)e * DEXP * DM;
    bfr* WT = (bfr*)(P.ws + WS_BTD) + (size_t)e * 1024 * 512;
    transpose_quad(W, DM, kt * 64, nq * 256, WT, 512, nq * 256, nq * 256 + 64, nq * 256 + 128, nq * 256 + 192, smem);
  }
}
constexpr int XT_EXP = 80, XT_LP = 144;
DI void moe_block_table256(CParams& P, int* tab  ) {
  const int* cnt = (const int*)(P.ws + WS_CNT);
  __syncthreads();
  const int t = tx_();
  if (t < 64) {
    const int nr = (cnt[t] + 255) >> 8;
    int incl = nr;
#pragma unroll
    for (int o = 1; o < 64; o <<= 1) { int u = __shfl_up(incl, o); if (t >= o) incl += u; }
    tab[t + 1] = incl;
    if (t == 0) tab[0] = 0;
    int rank = 0;
#pragma unroll
    for (int o = 0; o < 64; ++o) { const int v = __builtin_amdgcn_readlane(nr, o); rank += (v > nr || (v == nr && o < t)) ? 1 : 0; }
    { const int k = rank >> 3, pos = rank & 7, x = (k & 1) ? 7 - pos : pos; tab[XT_EXP + x * 8 + k] = t; }
    __builtin_amdgcn_fence(__ATOMIC_RELEASE, "wavefront"); asm volatile("s_waitcnt lgkmcnt(0)" ::: "memory");
    const int e = tab[XT_EXP + t];
    int p = __shfl(nr, e);
#pragma unroll
    for (int o = 1; o < 8; o <<= 1) { int u = __shfl_up(p, o); if ((t & 7) >= o) p += u; }
    tab[XT_LP + (t >> 3) * 9 + (t & 7) + 1] = p;
    if ((t & 7) == 0) tab[XT_LP + (t >> 3) * 9] = 0;
  }
  __syncthreads();
}
struct MoeOrder {
  const int* tab; int nunits, G, c;
  DI bool next(int i, pg8::Unit& u) const {
    if ((G & 7) == 0) {
      const int x = c & 7, JW = G >> 3, v = i * JW + (c >> 3), lr = v >> 2;
      const int* lp = tab + XT_LP + x * 9;
      if (lr >= lp[8]) return false;
      int k = 0; while (lp[k + 1] <= lr) ++k;
      const int e = tab[XT_EXP + x * 8 + k];
      u.pm = tab[e] + lr - lp[k]; u.pn = e * 4 + (v & 3); return true;
    }
    const int L = i * G + c; if (L >= nunits) return false;
    const int rb = L >> 2; int e = 0; while (tab[e + 1] <= rb) ++e;
    u.pm = rb; u.pn = e * 4 + (L & 3); return true;
  }
  DI void a_ready(const pg8::Unit&) const {}
  DI void done(const pg8::Unit&) const {}
};
struct EpiHid {
  static constexpr bool PERM = true, AFTER_DRAIN = false;
  bfr* H;
  DI void operator()(const pg8::f32x4 (&acc)[2][2][4][2], const pg8::Unit& u, int wr, int wc, int fr, int fq) const {
    const int row0 = u.pm * 256 + wr * 64 + fr, col0 = (u.pn & 3) * 128 + wc * 32 + 8 * fq;
#pragma unroll
    for (int ai = 0; ai < 2; ++ai)
#pragma unroll
      for (int m = 0; m < 4; ++m) {
        float hv[8];
#pragma unroll
        for (int n = 0; n < 2; ++n)
#pragma unroll
          for (int j = 0; j < 4; ++j) hv[4 * n + j] = siluf_(acc[ai][0][m][n][j]) * acc[ai][1][m][n][j];
        *(uint4*)(H + (size_t)(row0 + ai * 128 + m * 16) * DEXP + col0) = uint4{pack2(hv[0], hv[1]), pack2(hv[2], hv[3]), pack2(hv[4], hv[5]), pack2(hv[6], hv[7])};
      }
  }
};
struct EpiMout {
  static constexpr bool PERM = true, AFTER_DRAIN = false;
  bfr* O; const int* tab; const int* cnt; const int* list;
  DI void operator()(const pg8::f32x4 (&acc)[2][2][4][2], const pg8::Unit& u, int wr, int wc, int fr, int fq) const {
    const int e = u.pn >> 2, pnl = u.pn & 3;
    const int lrow0 = (u.pm - tab[e]) * 256 + wr * 64 + fr, ce = cnt[e];
    const int col0 = pnl * 256 + wc * 32 + 8 * fq;
#pragma unroll
    for (int ai = 0; ai < 2; ++ai)
#pragma unroll
      for (int m = 0; m < 4; ++m) {
        const int idx = lrow0 + ai * 128 + m * 16;
        if (idx < ce) {
          const int asg = list[e * T_LAT + idx];
          bfr* rowp = O + (size_t)asg * DM + col0;
#pragma unroll
          for (int bj = 0; bj < 2; ++bj) {
            const pg8::f32x4 v0 = acc[ai][bj][m][0], v1 = acc[ai][bj][m][1];
            *(uint4*)(rowp + bj * 128) = uint4{pack2(v0[0], v0[1]), pack2(v0[2], v0[3]), pack2(v1[0], v1[1]), pack2(v1[2], v1[3])};
          }
        }
      }
  }
};
struct MoeGather {
  const int* tab; const int* cnt; const int* list;
  DI unsigned rowoff(const pg8::Unit& u, int r) const {
    const int e = u.pn >> 2, idx = (u.pm - tab[e]) * 256 + r;
    const int tok = idx < cnt[e] ? (list[e * T_LAT + idx] >> 1) : 0;
    return (unsigned)tok * (unsigned)(DM * 2);
  }
};
DI void phase_moe1_8(CParams& P, char* smem_all) {
  int* tab = (int*)(smem_all + TAB_LDS_OFF);
  moe_block_table256(P, tab);
  const int nrb = tab[64];
  pg8::Gemm g{(const pg8::bf16_t*)(P.ws + WS_H2), (const pg8::bf16_t*)(P.ws + WS_BTGU), nrb * 256, 64 * 1024, DM};
  MoeOrder S{tab, nrb * 4, (int)gridDim.x, (int)blockIdx.x};
  EpiHid E{(bfr*)(P.ws + WS_HID8)};
  MoeGather G{tab, (const int*)(P.ws + WS_CNT), (const int*)(P.ws + WS_LIST)};
  pg8::gemm_phase_gather<EpiHid, MoeOrder, MoeGather>((PG8_LAS unsigned char*)smem_all, g, S, E, G, nullptr);
  const int G_ = (int)gridDim.x, nunits = nrb * 4;
  int rank = -1, n_idle = 0;
  if ((G_ & 7) == 0) {
    const int JW = G_ >> 3, x = (int)blockIdx.x & 7, j = (int)blockIdx.x >> 3;
    int rmax = 0;
#pragma unroll
    for (int xx = 0; xx < 8; ++xx) { const int r_ = (4 * tab[XT_LP + xx * 9 + 8] + JW - 1) / JW; rmax = r_ > rmax ? r_ : rmax; }
#pragma unroll
    for (int xx = 0; xx < 8; ++xx) { int fi = 4 * tab[XT_LP + xx * 9 + 8] - (rmax - 1) * JW; fi = fi < 0 ? 0 : (fi > JW ? JW : fi);
      if (xx == x && j >= fi) rank = n_idle + (j - fi);
      n_idle += JW - fi; }
  } else {
    const int rounds = (nunits + G_ - 1) / G_, first_idle = nunits - (rounds - 1) * G_;
    if (first_idle < G_) { n_idle = G_ - first_idle; if ((int)blockIdx.x >= first_idle) rank = (int)blockIdx.x - first_idle; }
  }
  if (n_idle == 0) { n_idle = G_; rank = (int)blockIdx.x; }
  rank = __builtin_amdgcn_readfirstlane(rank); n_idle = __builtin_amdgcn_readfirstlane(n_idle);
  if (rank >= 0) {
    const int half = __builtin_amdgcn_readfirstlane((int)(threadIdx.x >> 8));
    phase_moe_convert_d(P, rank * 2 + half, n_idle * 2, smem_all + half * 78080, CONVD_SPLIT, CONVD_ITEMS);
  }
}
DI void phase_moe2_8(CParams& P, char* smem_all) {
  int* tab = (int*)(smem_all + TAB_LDS_OFF);
  moe_block_table256(P, tab);
  const int nrb = tab[64];
  pg8::Gemm g{(const pg8::bf16_t*)(P.ws + WS_HID8), (const pg8::bf16_t*)(P.ws + WS_BTD), nrb * 256, 64 * 1024, DEXP};
  MoeOrder S{tab, nrb * 4, (int)gridDim.x, (int)blockIdx.x};
  EpiMout E{(bfr*)(P.ws + WS_MOUT8), tab, (const int*)(P.ws + WS_CNT), (const int*)(P.ws + WS_LIST)};
  pg8::gemm_phase<EpiMout, MoeOrder>((PG8_LAS unsigned char*)smem_all, g, S, E, nullptr);
}

#define XB_TMO      128
#define XB_XCNT(j)  (256  + 64 * (j))
#define XB_XSUB(j)  (1280 + 64 * (j))
#define XB_XGEN(j)  (2304 + 64 * (j))
#define XB_TOP      3328
#define XB_TOPGEN   3392
#define XCD_BAR_WORDS 3456
#define XB_SPIN_CAP (1u << 22)
#define LAS __attribute__((address_space(3)))
DI unsigned xb_ld(unsigned* p)              { return __hip_atomic_load(p, __ATOMIC_RELAXED, __HIP_MEMORY_SCOPE_AGENT); }
DI unsigned xb_add(unsigned* p, unsigned v) { return __hip_atomic_fetch_add(p, v, __ATOMIC_RELAXED, __HIP_MEMORY_SCOPE_AGENT); }
DI unsigned xb_xcc_id() { return (unsigned)__builtin_amdgcn_s_getreg((3 << 11) | 20) & 0xFu; }
#define XB_SPIN(cond, bar) do { unsigned _sp = 0; while (cond) { __builtin_amdgcn_s_sleep(1); \
    if ((++_sp & 255u) == 0u) { if (xb_ld(&(bar)[XB_TMO])) break; if (_sp > XB_SPIN_CAP) { atomicAdd(&(bar)[XB_TMO], 1u); break; } } } } while (0)
struct XcdBarrier { unsigned* bar; unsigned x; volatile LAS unsigned* st; };
DI XcdBarrier xcd_barrier_post(unsigned* bar, volatile LAS unsigned* st) {
  XcdBarrier b; b.bar = bar; b.x = xb_xcc_id(); b.st = st;
  if (threadIdx.x == 0) (void)xb_add(&bar[XB_XCNT(b.x)], 1u);
  return b;
}
DI void xcd_barrier_complete(unsigned* bar, unsigned x, unsigned& nloc, unsigned& nx) {
  const unsigned G = gridDim.x * gridDim.y * gridDim.z;
  unsigned sum, cnt, mine, sp = 0u;
  for (;;) {
    sum = 0u; cnt = 0u; mine = 0u;
#pragma unroll
    for (unsigned j = 0; j < 16; ++j) { const unsigned c = xb_ld(&bar[XB_XCNT(j)]); sum += c; cnt += (c > 0u) ? 1u : 0u; mine = (j == x) ? c : mine; }
    if (sum == G) break;
    __builtin_amdgcn_s_sleep(1);
    if ((++sp & 255u) == 0u) { if (xb_ld(&bar[XB_TMO])) break; if (sp > XB_SPIN_CAP) { atomicAdd(&bar[XB_TMO], 1u); break; } }
  }
  nloc = mine > 0u ? mine : 1u; nx = cnt > 0u ? cnt : 1u;
}
DI void xcd_barrier(const XcdBarrier& b) {
  asm volatile("s_waitcnt vmcnt(0)" ::: "memory");
  __syncthreads();
  if (threadIdx.x == 0) {
    unsigned* bar = b.bar;
    __builtin_amdgcn_s_waitcnt(0);
    unsigned nloc = b.st[0], nx = b.st[1];
    if (nloc == 0u) { xcd_barrier_complete(bar, b.x, nloc, nx); b.st[0] = nloc; b.st[1] = nx; }
    const unsigned old = xb_add(&bar[XB_XSUB(b.x)], 1u);
    const unsigned gen = old / nloc;
    if (old + 1u == (gen + 1u) * nloc) {
      __builtin_amdgcn_fence(__ATOMIC_RELEASE, "agent");
      asm volatile("s_waitcnt vmcnt(0)" ::: "memory");
      const unsigned og = xb_add(&bar[XB_TOP], 1u);
      const unsigned tg = og / nx;
      if (og + 1u == (tg + 1u) * nx) xb_add(&bar[XB_TOPGEN], 1u);
      else XB_SPIN(xb_ld(&bar[XB_TOPGEN]) == tg, bar);
      __builtin_amdgcn_fence(__ATOMIC_ACQUIRE, "agent");
      xb_add(&bar[XB_XGEN(b.x)], 1u);
      asm volatile("s_waitcnt vmcnt(0)" ::: "memory");
    } else {
      XB_SPIN(xb_ld(&bar[XB_XGEN(b.x)]) == gen, bar);
      __builtin_amdgcn_fence(__ATOMIC_ACQUIRE, "agent");
      asm volatile("s_waitcnt vmcnt(0)" ::: "memory");
    }
  }
  __syncthreads();
}

namespace cg = cooperative_groups;
constexpr int HALF_LDS = 78080;
constexpr int SMEM_BYTES = 2 * HALF_LDS + 16;
__global__ void __launch_bounds__(NTHR_BLOCK) k_fused(Params Pval) {
  __shared__ __attribute__((aligned(16))) char smem_all[SMEM_BYTES];
  cg::grid_group grid = cg::this_grid();
  CParams* kp0 = (CParams*)__builtin_amdgcn_kernarg_segment_ptr();
#define PH(call) do { CParams* kp_ = kp0; asm volatile("" : "+s"(kp_)); CParams& P = *kp_; \
    int half = __builtin_amdgcn_readfirstlane((int)(threadIdx.x >> 8)); asm volatile("" : "+s"(half)); \
    char* smem = smem_all + half * HALF_LDS; const int bid = blockIdx.x * 2 + half, nb = gridDim.x * 2; (void)smem; (void)bid; (void)nb; call; } while (0)
  volatile LAS unsigned* bst = (volatile LAS unsigned*)(smem_all + SMEM_BYTES - 16);
  if (threadIdx.x < 4) bst[threadIdx.x] = 0u;
  __syncthreads();
  XcdBarrier xb = xcd_barrier_post(Pval.bar, bst);
#define GSYNC() do { if (Pval.use_cg) grid.sync(); else xcd_barrier(xb); } while (0)
  PH(phase_mod(P, bid, nb, smem));
  GSYNC();
  PH(phase_ln1(P, bid, nb));
  GSYNC();
  PH(phase_pgemm8(P, smem_all));
  GSYNC();
  PH(phase_rwprep(P, bid, nb, smem));
  GSYNC();
  PH(for (int it = bid; it < 16 * RW_NSC; it += nb) rw_levelA_item(P, it / RW_NSC, it % RW_NSC, smem));
  PH(for (int it = bid; it < 8 * HG_NSC; it += nb) hg_levelA_item(P, it / HG_NSC, it % HG_NSC, smem));
  GSYNC();
  PH(if (bid < 16) rw_levelB_chain(P, bid, smem); else { hg_levelB(P, bid - 16, nb - 16); phase_moe_convert_d(P, bid - 16, nb - 16, smem, 0, CONVD_SPLIT); });
  GSYNC();
  PH(phase_readout_fused(P, bid, nb));
  GSYNC();
  PH(phase_outproj8(P, smem_all));
  PH(phase_moe_convert_gu(P, bid, nb, smem));
  GSYNC();
  PH(phase_ln2route(P, smem_all));
  GSYNC();
  PH(phase_moe1_8(P, smem_all));
  GSYNC();
  PH(phase_moe2_8(P, smem_all));
  GSYNC();
  PH(phase_final(P, bid, nb));
}

extern "C" void kernel_launch(void* const* d_in, const int* in_sizes, int n_in, void* d_out, int out_size, void* d_ws, size_t ws_size, hipStream_t stream) {
  static int grid_blocks = 0;
  if (!grid_blocks) {
    int dev = 0, cus = 0, per_cu = 0;
    hipGetDevice(&dev);
    hipDeviceGetAttribute(&cus, hipDeviceAttributeMultiprocessorCount, dev);
    hipOccupancyMaxActiveBlocksPerMultiprocessor(&per_cu, k_fused, NTHR_BLOCK, 0);
    if (per_cu > 1) per_cu = 1;
    if (per_cu < 1) per_cu = 1;
    grid_blocks = cus * per_cu;
  }
  Params P{};
  P.bar = (unsigned*)((char*)d_ws + WS_BAR); P.use_cg = 0; P.pad = 0;
  hipMemsetAsync((char*)d_ws + WS_BAR, 0, XCD_BAR_WORDS * 4, stream);
  for (int i = 0; i < 32; ++i) P.in[i] = (const float*)d_in[i];
  P.out = (float*)d_out; P.ws = (char*)d_ws;
  void* args[] = {&P};
  hipError_t e = hipLaunchCooperativeKernel((void*)k_fused, dim3(grid_blocks), dim3(NTHR_BLOCK), args, 0, stream);
  if (e != hipSuccess) fprintf(stderr, "cooperative launch failed: %s (grid %d)\n", hipGetErrorString(e), grid_blocks);
}
```

```cpp
#include <hip/hip_runtime.h>
#include <hip/hip_cooperative_groups.h>
#include <cstdio>

typedef __attribute__((ext_vector_type(8))) short bf16x8;
typedef __attribute__((ext_vector_type(4))) short s16x4;
typedef __attribute__((ext_vector_type(4))) float f32x4;
typedef __attribute__((ext_vector_type(2))) float f32x2;
typedef __attribute__((ext_vector_type(2))) __bf16 bf16x2_t;
typedef unsigned short bfr;

#define DI __device__ __forceinline__

constexpr int T_LAT = 16384, T_CTX = 256, T_ALL = T_LAT + T_CTX;
constexpr int DM = 1024, DIN = 4288, HGC = 2560, RWC = 1728, DRW = 512, DHG = 512;
constexpr int NEXP = 64, DEXP = 512;
constexpr int NTHR = 256;
constexpr int NTHR_BLOCK = 512;
#define VT ((int)(threadIdx.x & 255))
__device__ __forceinline__ int tx_() { int t = (int)threadIdx.x; asm volatile("" : "+v"(t)); return t; }
constexpr float DN_ALPHA = 1.189207115002721f;
constexpr float RW_DECAY_SCALE = 0.6065306597126334f;

constexpr size_t MB = 1ull << 20;
constexpr size_t WS_MOD = 0;
constexpr size_t WS_MODC = 32768;
constexpr size_t WS_LB = 65536;
constexpr size_t WS_CNT = 65536 + 8192;
constexpr size_t WS_BAR = 81920;
constexpr size_t WS_ASGW = 131072;
constexpr size_t WS_LIST = 1 * MB;
constexpr size_t WS_H = 6 * MB;
constexpr size_t WS_P = 42 * MB;
constexpr size_t WS_Y = 42 * MB;
constexpr size_t WS_H2 = 106 * MB;
constexpr size_t WS_RW = 186 * MB;
constexpr size_t RW_ARR = (size_t)T_ALL * 512 * 2;
constexpr size_t WS_X1B = 6 * MB;
constexpr size_t WS_MIX = WS_RW + 3 * RW_ARR;
constexpr size_t WS_LW = 284 * MB;
constexpr size_t LW_ARR = (size_t)T_ALL * 512 * 4;

struct Params {
  const float* in[32];
  float* out;
  char* ws;
  unsigned* bar;
  int use_cg;
  int pad;
};
typedef const __attribute__((address_space(4))) Params CParams;

DI unsigned pack2(float a, float b) {
  f32x2 v = {a, b};
  bf16x2_t r = __builtin_convertvector(v, bf16x2_t);
  return __builtin_bit_cast(unsigned, r);
}
DI bfr f2bf(float a) { return (bfr)(pack2(a, 0.f) & 0xffffu); }
DI float bf2f(bfr v) { return __uint_as_float(((unsigned)v) << 16); }
DI float frcp_(float x) { return __builtin_amdgcn_rcpf(x); }
DI float sigmoidf_(float x) { return frcp_(1.f + __expf(-x)); }
DI float siluf_(float x) { return x * frcp_(1.f + __expf(-x)); }
DI f32x4 ld4bf(const bfr* p);
DI float wave_sum(float v) {
#pragma unroll
  for (int o = 32; o > 0; o >>= 1) v += __shfl_xor(v, o);
  return v;
}

DI void phase_lora_convert(CParams& P, int part, int nparts);
DI void phase_wrt_convert(CParams& P, int part, int nparts);
DI void transpose_tile(const float* W, int ldw, int k0, int n0, int nvalid, bfr* WT, int ldt, char* smem);
DI void transpose_quad(const float* W, int ldw, int k0, int n0, bfr* WT, int ldt, int dr0, int dr1, int dr2, int dr3, char* smem, int nvalid);
DI void phase_mod(CParams& P, int bid, int nb, char* smem) {
  const float* c = P.in[1]; const float* cc = P.in[3];
  const float* w_mod = P.in[4]; const float* b_mod = P.in[5];
  float* mod = (float*)(P.ws + WS_MOD); float* modc = (float*)(P.ws + WS_MODC);
  float* red = (float*)smem;
  const int tid = VT;
  for (int it = bid; it < 542; it += nb) {
    if (it < 192) {
      const int kq = tid >> 3, c4 = tid & 7;
      const int col = it * 32 + c4 * 4;
      f32x4 a1 = {0, 0, 0, 0}, a2 = {0, 0, 0, 0};
      for (int k = kq; k < DM; k += 32) {
        f32x4 w = *(const f32x4*)(w_mod + (long)k * 6144 + col);
        float s1 = siluf_(c[k]), s2 = siluf_(cc[k]);
        a1 += w * s1; a2 += w * s2;
      }
      __syncthreads();
#pragma unroll
      for (int e = 0; e < 4; ++e) { red[(kq * 32) + c4 * 4 + e] = a1[e]; red[1024 + kq * 32 + c4 * 4 + e] = a2[e]; }
      __syncthreads();
      if (tid < 64) {
        const int which = tid >> 5, cl = tid & 31;
        float s = 0.f;
        for (int q = 0; q < 32; ++q) s += red[which * 1024 + q * 32 + cl];
        const int cg = it * 32 + cl;
        s += b_mod[cg];
        if (which == 0) mod[cg] = s; else modc[cg] = s;
      }
    } else if (it == 192) {
      const float* L = P.in[8];
      float* lb = (float*)(P.ws + WS_LB);
      for (int i = tid; i < 1024; i += NTHR) {
        const int d = i >> 9, j = i & 511;
        float l0 = L[d * 1024 + j], l1 = L[d * 1024 + 512 + j];
        lb[i] = 1.f / (1.f + __expf(l1 - l0));
      }
    } else if (it == 193) {
      int* cnt = (int*)(P.ws + WS_CNT);
      if (tid < 64) cnt[tid] = 0;
    } else if (it < 198) {
      phase_lora_convert(P, it - 194, 4);
    } else if (it < 470) {
      const int t = it - 198, kt = t / 17, nq = t % 17;
      transpose_quad(P.in[6], DIN, kt * 64, nq * 256, (bfr*)(P.ws + (284ull << 20)), DM, nq * 256, nq * 256 + 64, nq * 256 + 128, nq * 256 + 192, smem, DIN);
    } else if (it < 534) {
      const int t = it - 470, kt = t >> 2, nq = t & 3;
      transpose_quad(P.in[7], DM, kt * 64, nq * 256, (bfr*)(P.ws + (1ull << 20)), DM, nq * 256, nq * 256 + 64, nq * 256 + 128, nq * 256 + 192, smem, DM);
    } else {
      phase_wrt_convert(P, it - 534, 8);
    }
  }
}

DI void phase_ln1(CParams& P, int bid, int nb) {
  const float* x = P.in[0]; const float* ctx = P.in[2];
  const float* mod = (const float*)(P.ws + WS_MOD); const float* modc = (const float*)(P.ws + WS_MODC);
  bfr* h = (bfr*)(P.ws + WS_H);
  const int wid = VT >> 6, lane = VT & 63;
  for (int row0 = (bid * 4 + wid) * 2; row0 < T_ALL; row0 += nb * 8) {
    const float* src = row0 < T_LAT ? x + (long)row0 * DM : ctx + (long)(row0 - T_LAT) * DM;
    const float* mm = row0 < T_LAT ? mod : modc;
    f32x4 v[2][4];
    float s[2] = {0.f, 0.f};
#pragma unroll
    for (int r = 0; r < 2; ++r)
#pragma unroll
      for (int i = 0; i < 4; ++i) { v[r][i] = *(const f32x4*)(src + r * DM + lane * 4 + 256 * i); s[r] += v[r][i][0] + v[r][i][1] + v[r][i][2] + v[r][i][3]; }
#pragma unroll
    for (int r = 0; r < 2; ++r) {
      const float mu = wave_sum(s[r]) * (1.f / DM);
      float q = 0.f;
#pragma unroll
      for (int i = 0; i < 4; ++i) { v[r][i] -= mu; q += v[r][i][0] * v[r][i][0] + v[r][i][1] * v[r][i][1] + v[r][i][2] * v[r][i][2] + v[r][i][3] * v[r][i][3]; }
      const float rs = rsqrtf(wave_sum(q) * (1.f / DM) + 1e-5f);
#pragma unroll
      for (int i = 0; i < 4; ++i) {
        const int cidx = lane * 4 + 256 * i;
        f32x4 sh = *(const f32x4*)(mm + cidx), sc = *(const f32x4*)(mm + 1024 + cidx);
        f32x4 o = v[r][i] * rs * (sc + 1.f) + sh;
        uint2 w = {pack2(o[0], o[1]), pack2(o[2], o[3])};
        *(uint2*)(h + (long)(row0 + r) * DM + cidx) = w;
      }
    }
  }
}

#define LDSP(T) __attribute__((address_space(3))) T*
DI int row_of_step(int dir, int s) {
  if (s < T_CTX) return T_LAT + (dir ? (T_CTX - 1 - s) : s);
  return dir ? (T_LAT - 1 - (s - T_CTX)) : (s - T_CTX);
}
DI bf16x8 ld_tr8(const short* base, int stride, int k0, int n0) {
  const int lane = VT & 63, g = lane >> 4, q = (lane & 15) >> 2, p = lane & 3;
  const short* a0 = base + (k0 + 8 * g + q) * stride + n0 + 4 * p;
  s16x4 lo = __builtin_amdgcn_ds_read_tr16_b64_v4i16((LDSP(s16x4))a0);
  s16x4 hi = __builtin_amdgcn_ds_read_tr16_b64_v4i16((LDSP(s16x4))(a0 + 4 * stride));
  return __builtin_shufflevector(lo, hi, 0, 1, 2, 3, 4, 5, 6, 7);
}
template <bool AT, bool BT>
DI f32x4 mm_tile(const short* A, int lda, int m0, const short* B, int ldb, int n0, int K, f32x4 acc) {
  const int lane = VT & 63, fr = lane & 15, fq = lane >> 4;
#ifdef SLOWMM
#pragma unroll
  for (int reg = 0; reg < 4; ++reg) {
    const int row = m0 + 4 * fq + reg, col = n0 + fr;
    float s = 0.f;
    for (int k = 0; k < K; ++k) {
      const float a = bf2f((bfr)(AT ? A[k * lda + row] : A[row * lda + k]));
      const float b = bf2f((bfr)(BT ? B[col * ldb + k] : B[k * ldb + col]));
      s += a * b;
    }
    acc[reg] += s;
  }
#else
  for (int k0 = 0; k0 < K; k0 += 32) {
    bf16x8 a, b;
    if (AT) a = ld_tr8(A, lda, k0, m0); else a = *(const bf16x8*)(A + (m0 + fr) * lda + k0 + fq * 8);
    if (BT) b = *(const bf16x8*)(B + (n0 + fr) * ldb + k0 + fq * 8); else b = ld_tr8(B, ldb, k0, n0);
    acc = __builtin_amdgcn_mfma_f32_16x16x32_bf16(a, b, acc, 0, 0, 0);
  }
#endif
  return acc;
}
DI void st_tile(short* C, int ldc, int m0, int n0, f32x4 acc) {
  const int lane = VT & 63, fr = lane & 15, fq = lane >> 4;
#pragma unroll
  for (int reg = 0; reg < 4; ++reg) C[(m0 + 4 * fq + reg) * ldc + n0 + fr] = (short)f2bf(acc[reg]);
}

constexpr int RW_NSC = 32;
DI int rw_sc_begin(int sc) { return sc * 16 + (sc < 8 ? sc : 8); }
DI int rw_sc_of_chunk(int ci) { return ci < 136 ? ci / 17 : 8 + (ci - 136) / 16; }
constexpr int XS = 72, SS = 40, GS = 72;
constexpr int RWL_XK = 0, RWL_XKB = 4608, RWL_XBB = 9216, RWL_XR = 13824, RWL_XV = 18432, RWL_S = 23040;
constexpr int RWL_GP = 38400, RWL_GQ = 47616, RWL_GAM = 56832, RWL_TOT = 57088, RWL_END = 58112;
constexpr size_t WS_PTOT = 6 * MB;
constexpr size_t WS_QTOT = 10 * MB;
constexpr size_t WS_SINRW = 18 * MB;
constexpr size_t WS_R2P = 350 * MB;
constexpr size_t WS_Y0P = 382 * MB;

constexpr int RTS = 40, RGS = 72;
constexpr int RWT_XK = 0, RWT_XKB = 5120, RWT_XBB = 10240, RWT_XR = 15360, RWT_XV = 20480, RWT_S = 25600;
constexpr int RWT_GP = 40960, RWT_GQ = 50176, RWT_GAM = 59392, RWT_TOT = 59648;
DI void st_tile_T(short* C, int ldc, int m0, int n0, f32x4 acc) {
  const int lane = (int)(threadIdx.x & 63), fr = lane & 15, fq = lane >> 4;
  *(uint2*)(C + (n0 + fr) * ldc + m0 + 4 * fq) = uint2{pack2(acc[0], acc[1]), pack2(acc[2], acc[3])};
}
DI void rw_levelA_item(CParams& P, int chain, int sc, char* smem) {
  const int dir = chain >> 3, hd = chain & 7;
  const bfr* Rg = (const bfr*)(P.ws + WS_RW); const bfr* Kg = (const bfr*)(P.ws + WS_RW + RW_ARR); const bfr* Vg = (const bfr*)(P.ws + WS_RW + 2 * RW_ARR);
  const bfr* KKg = (const bfr*)(P.ws + WS_RW + 3 * RW_ARR); const bfr* Ag = (const bfr*)(P.ws + WS_RW + 4 * RW_ARR);
  const float* LWg = (const float*)(P.ws + WS_LW + (dir ? LW_ARR : 0));
  bfr* R2P = (bfr*)(P.ws + WS_R2P) + (size_t)dir * T_LAT * 512;
  bfr* Y0P = (bfr*)(P.ws + WS_Y0P) + (size_t)dir * T_LAT * 512;
  short* XKt = (short*)(smem + RWT_XK); short* XKBt = (short*)(smem + RWT_XKB); short* XBBt = (short*)(smem + RWT_XBB);
  short* XRt = (short*)(smem + RWT_XR); short* XVt = (short*)(smem + RWT_XV);
  short* ZT = XRt; short* R2T = XRt; short* PcT = XKt;
  short* SLt = (short*)(smem + RWT_S); short* SAkkT = SLt + 32 * RTS; short* SAkrT = SAkkT + 32 * RTS; short* SMt = SAkrT + 32 * RTS;
  short* STt = SMt + 32 * RTS; short* SnAbrT = STt + 32 * RTS;
  short* W1T = SLt; short* W2T = SAkrT;
  short* GPT = (short*)(smem + RWT_GP); short* GQT = (short*)(smem + RWT_GQ);
  float* gam = (float*)(smem + RWT_GAM); float* tot = (float*)(smem + RWT_TOT);
  const int tid = VT, lane = tid & 63, w = tid >> 6, fr = lane & 15, fq = lane >> 4;
  const int tm = w >> 1, tn = w & 1;
  const int sgn = dir ? -1 : 1;
  const f32x4 z4 = {0.f, 0.f, 0.f, 0.f};
  __syncthreads();
  for (int i = tid; i < 64 * 64; i += NTHR) { const int r = i >> 6, c = i & 63; GPT[r * RGS + c] = (r == c) ? (short)0x3F80 : (short)0; GQT[r * RGS + c] = 0; }
  f32x4 pcum[4], qcum[4];
#pragma unroll
  for (int n = 0; n < 4; ++n) { pcum[n] = z4; qcum[n] = z4; }
  const int c_begin = rw_sc_begin(sc), c_end = rw_sc_begin(sc + 1);
  float pf_lw[8]; unsigned pf_rk[8], pf_vkk[8], pf_a[8];
#define RW_PREFETCH(cc) do { const unsigned o0_ = (unsigned)(row_of_step(dir, (cc) * 32 + (tid >> 6) * 8) * 512 + hd * 64 + (tid & 63)); \
      _Pragma("unroll") for (int e_ = 0; e_ < 8; ++e_) { const unsigned o_ = o0_ + (unsigned)(sgn * e_ * 512); \
      pf_lw[e_] = LWg[o_]; pf_rk[e_] = (unsigned)Rg[o_] | ((unsigned)Kg[o_] << 16); pf_vkk[e_] = (unsigned)Vg[o_] | ((unsigned)KKg[o_] << 16); pf_a[e_] = Ag[o_]; } } while (0)
  RW_PREFETCH(c_begin);
  for (int ci = c_begin; ci < c_end; ++ci) {
    __syncthreads();
    {
      const int j = tid & 63, qt = tid >> 6;
      float lam[8];
      float run = 0.f;
#pragma unroll
      for (int e = 0; e < 8; ++e) { run += pf_lw[e]; lam[e] = run; }
      tot[qt * 64 + j] = run;
      __syncthreads();
      float base = 0.f, total = 0.f;
#pragma unroll
      for (int q2 = 0; q2 < 4; ++q2) { const float tv = tot[q2 * 64 + j]; total += tv; if (q2 < qt) base += tv; }
      unsigned wk[4], wkb[4], wbb[4], wr_[4], wv[4];
#pragma unroll
      for (int e2 = 0; e2 < 4; ++e2) {
        float vk[2], vkb[2], vbb[2], vr[2];
#pragma unroll
        for (int u = 0; u < 2; ++u) {
          const int e = 2 * e2 + u;
          const float L = base + lam[e];
          const float eL = __expf(L), enL = frcp_(eL), eLp = eL * __expf(-pf_lw[e]);
          const float kkv = __uint_as_float(pf_vkk[e] & 0xffff0000u);
          vk[u] = kkv * eLp;
          vkb[u] = __uint_as_float(pf_rk[e] & 0xffff0000u) * enL;
          vbb[u] = kkv * __uint_as_float(pf_a[e] << 16) * enL;
          vr[u] = __uint_as_float(pf_rk[e] << 16) * eL;
        }
        wk[e2] = pack2(vk[0], vk[1]); wkb[e2] = pack2(vkb[0], vkb[1]); wbb[e2] = pack2(vbb[0], vbb[1]); wr_[e2] = pack2(vr[0], vr[1]);
        wv[e2] = (pf_vkk[2 * e2] & 0xffffu) | (pf_vkk[2 * e2 + 1] << 16);
      }
      const int co = j * RTS + 8 * qt;
      *(uint4*)(XKt + co) = uint4{wk[0], wk[1], wk[2], wk[3]};
      *(uint4*)(XKBt + co) = uint4{wkb[0], wkb[1], wkb[2], wkb[3]};
      *(uint4*)(XBBt + co) = uint4{wbb[0], wbb[1], wbb[2], wbb[3]};
      *(uint4*)(XRt + co) = uint4{wr_[0], wr_[1], wr_[2], wr_[3]};
      *(uint4*)(XVt + co) = uint4{wv[0], wv[1], wv[2], wv[3]};
      if (qt == 0) gam[j] = __expf(total);
      if (ci + 1 < c_end) RW_PREFETCH(ci + 1);
    }
    __syncthreads();
    f32x4 tacc; f32x4 rt[2];
    {
      f32x4 aL = mm_tile<true, false>(XKt, RTS, 16 * tm, XBBt, RTS, 16 * tn, 64, z4);
      f32x4 aKK = mm_tile<true, false>(XKt, RTS, 16 * tm, XKBt, RTS, 16 * tn, 64, z4);
      f32x4 aBR = mm_tile<true, false>(XRt, RTS, 16 * tm, XBBt, RTS, 16 * tn, 64, z4);
      f32x4 aKR = mm_tile<true, false>(XRt, RTS, 16 * tm, XKBt, RTS, 16 * tn, 64, z4);
#pragma unroll
      for (int reg = 0; reg < 4; ++reg) {
        const int row = 16 * tm + 4 * fq + reg, col = 16 * tn + fr;
        const bool st = col < row, inc = col <= row;
        aL[reg] = st ? aL[reg] : 0.f; aKK[reg] = st ? aKK[reg] : 0.f;
        aBR[reg] = inc ? -aBR[reg] : 0.f; aKR[reg] = inc ? aKR[reg] : 0.f;
        tacc[reg] = (row == col ? 1.f : 0.f) - aL[reg];
      }
      st_tile_T(SLt, RTS, 16 * tm, 16 * tn, aL); st_tile_T(STt, RTS, 16 * tm, 16 * tn, tacc);
      st_tile_T(SAkkT, RTS, 16 * tm, 16 * tn, aKK); st_tile_T(SnAbrT, RTS, 16 * tm, 16 * tn, aBR); st_tile_T(SAkrT, RTS, 16 * tm, 16 * tn, aKR);
#pragma unroll
      for (int i = 0; i < 2; ++i) rt[i] = ld4bf((const bfr*)(XRt + (16 * (2 * tn + i) + fr) * RTS + 16 * tm + 4 * fq));
    }
    __syncthreads();
    f32x4 y0[2];
    {
#pragma unroll
      for (int i = 0; i < 2; ++i) {
        f32x4 z = mm_tile<true, true>(SAkkT, RTS, 16 * tm, XVt, RTS, 16 * (2 * tn + i), 32, z4);
        st_tile_T(ZT, RTS, 16 * tm, 16 * (2 * tn + i), z);
        y0[i] = mm_tile<true, true>(SAkrT, RTS, 16 * tm, XVt, RTS, 16 * (2 * tn + i), 32, z4);
      }
      f32x4 m = mm_tile<true, true>(SLt, RTS, 16 * tm, SLt, RTS, 16 * tn, 32, z4);
      st_tile_T(SMt, RTS, 16 * tm, 16 * tn, m);
    }
    __syncthreads();
#pragma unroll 1
    for (int rd = 0; rd < 4; ++rd) {
      f32x4 tnew = mm_tile<true, true>(STt, RTS, 16 * tm, SMt, RTS, 16 * tn, 32, tacc);
      f32x4 mnew = z4;
      if (rd < 3) mnew = mm_tile<true, true>(SMt, RTS, 16 * tm, SMt, RTS, 16 * tn, 32, z4);
      __syncthreads();
      tacc = tnew;
      st_tile_T(STt, RTS, 16 * tm, 16 * tn, tacc);
      if (rd < 3) st_tile_T(SMt, RTS, 16 * tm, 16 * tn, mnew);
      __syncthreads();
    }
    {
      f32x4 w1[2], w2[2];
#pragma unroll
      for (int i = 0; i < 2; ++i) {
        w1[i] = mm_tile<true, true>(STt, RTS, 16 * tm, XKt, RTS, 16 * (2 * tn + i), 32, z4);
        w2[i] = mm_tile<true, true>(STt, RTS, 16 * tm, ZT, RTS, 16 * (2 * tn + i), 32, z4);
      }
#pragma unroll
      for (int i = 0; i < 2; ++i) { st_tile_T(W1T, RTS, 16 * tm, 16 * (2 * tn + i), w1[i]); st_tile_T(W2T, RTS, 16 * tm, 16 * (2 * tn + i), w2[i]); }
    }
    __syncthreads();
    f32x4 pa[4], qc[4], r2[2];
    {
#pragma unroll
      for (int n = 0; n < 4; ++n) {
        pa[n] = mm_tile<false, true>(W1T, RTS, 16 * w, XBBt, RTS, 16 * n, 32, z4);
        f32x4 qa = mm_tile<false, true>(XVt, RTS, 16 * w, XKBt, RTS, 16 * n, 32, z4);
        f32x4 qb = mm_tile<false, true>(W2T, RTS, 16 * w, XBBt, RTS, 16 * n, 32, z4);
        qc[n] = qa - qb;
      }
#pragma unroll
      for (int i = 0; i < 2; ++i) {
        r2[i] = mm_tile<true, true>(SnAbrT, RTS, 16 * tm, W1T, RTS, 16 * (2 * tn + i), 32, rt[i]);
        y0[i] = mm_tile<true, true>(SnAbrT, RTS, 16 * tm, W2T, RTS, 16 * (2 * tn + i), 32, y0[i]);
      }
    }
    __syncthreads();
    {
#pragma unroll
      for (int n = 0; n < 4; ++n) {
        const float gcol = gam[16 * n + fr];
        f32x4 pc;
#pragma unroll
        for (int reg = 0; reg < 4; ++reg) {
          const int row = 16 * w + 4 * fq + reg, col = 16 * n + fr;
          pc[reg] = ((row == col ? 1.f : 0.f) - pa[n][reg]) * gcol;
          qc[n][reg] *= gcol;
        }
        st_tile_T(PcT, RGS, 16 * w, 16 * n, pc);
      }
#pragma unroll
      for (int i = 0; i < 2; ++i) st_tile_T(R2T, RTS, 16 * tm, 16 * (2 * tn + i), r2[i]);
    }
    __syncthreads();
    {
      if (ci >= 8) {
        const unsigned orow = (unsigned)(row_of_step(dir, ci * 32 + 16 * tm + 4 * fq) * 512 + hd * 64 + fr);
#pragma unroll
        for (int i = 0; i < 2; ++i) {
          f32x4 o1 = mm_tile<true, false>(R2T, RTS, 16 * tm, GPT, RGS, 16 * (2 * tn + i), 64, z4);
          f32x4 o2 = mm_tile<true, false>(R2T, RTS, 16 * tm, GQT, RGS, 16 * (2 * tn + i), 64, y0[i]);
#pragma unroll
          for (int reg = 0; reg < 4; ++reg) {
            const unsigned o = orow + (unsigned)(sgn * reg * 512 + 16 * (2 * tn + i));
            R2P[o] = f2bf(o1[reg]); Y0P[o] = f2bf(o2[reg]);
          }
        }
      }
#pragma unroll
      for (int n = 0; n < 4; ++n) {
        pcum[n] = mm_tile<true, true>(GPT, RGS, 16 * w, PcT, RGS, 16 * n, 64, z4);
        qcum[n] = mm_tile<true, true>(GQT, RGS, 16 * w, PcT, RGS, 16 * n, 64, qc[n]);
      }
    }
    __syncthreads();
#pragma unroll
    for (int n = 0; n < 4; ++n) { st_tile_T(GPT, RGS, 16 * w, 16 * n, pcum[n]); st_tile_T(GQT, RGS, 16 * w, 16 * n, qcum[n]); }
  }
  {
    bfr* Pt = (bfr*)(P.ws + WS_PTOT) + (size_t)(chain * RW_NSC + sc) * 4096;
    float* Qt = (float*)(P.ws + WS_QTOT) + (size_t)(chain * RW_NSC + sc) * 4096;
#pragma unroll
    for (int n = 0; n < 4; ++n)
#pragma unroll
      for (int reg = 0; reg < 4; ++reg) {
        const int row = 16 * w + 4 * fq + reg, col = 16 * n + fr;
        Pt[row * 64 + col] = f2bf(pcum[n][reg]);
      }
#pragma unroll
    for (int n = 0; n < 4; ++n) *(f32x4*)(Qt + (16 * n + fr) * 64 + 16 * w + 4 * fq) = qcum[n];
  }
}

DI void rw_levelB_chain(CParams& P, int chain, char* smem) {
  short* SB = (short*)smem; short* PT = SB + 64 * GS;
  const bfr* Ptot = (const bfr*)(P.ws + WS_PTOT) + (size_t)chain * RW_NSC * 4096;
  const float* Qtot = (const float*)(P.ws + WS_QTOT) + (size_t)chain * RW_NSC * 4096;
  bfr* SIN = (bfr*)(P.ws + WS_SINRW) + (size_t)chain * (RW_NSC + 1) * 4096;
  const int tid = VT, lane = tid & 63, w = tid >> 6, fr = lane & 15, fq = lane >> 4;
  f32x4 S[4];
#pragma unroll
  for (int n = 0; n < 4; ++n) S[n] = f32x4{0.f, 0.f, 0.f, 0.f};
  bf16x8 pr[4][2]; f32x4 qr[4][4];
#define LB_LOAD(slot, sc_) do { _Pragma("unroll") for (int i_ = 0; i_ < 2; ++i_) { const int e_ = tid + i_ * NTHR; pr[slot][i_] = *(const bf16x8*)(Ptot + (size_t)(sc_) * 4096 + (e_ >> 3) * 64 + (e_ & 7) * 8); } \
    _Pragma("unroll") for (int n_ = 0; n_ < 4; ++n_) qr[slot][n_] = *(const f32x4*)(Qtot + (size_t)(sc_) * 4096 + (16 * n_ + fr) * 64 + 16 * w + 4 * fq); } while (0)
  LB_LOAD(0, 0); LB_LOAD(1, 1); LB_LOAD(2, 2); LB_LOAD(3, 3);
#define LB_STEP(u) do { const int sc = sc0 + (u); \
      __syncthreads(); \
      _Pragma("unroll") for (int n = 0; n < 4; ++n) { st_tile(SB, GS, 16 * w, 16 * n, S[n]); \
        _Pragma("unroll") for (int reg = 0; reg < 4; ++reg) SIN[(size_t)sc * 4096 + (16 * w + 4 * fq + reg) * 64 + 16 * n + fr] = f2bf(S[n][reg]); } \
      _Pragma("unroll") for (int i = 0; i < 2; ++i) { const int e = tid + i * NTHR; *(bf16x8*)(PT + (e >> 3) * GS + (e & 7) * 8) = pr[u][i]; } \
      const f32x4 qc0 = qr[u][0], qc1 = qr[u][1], qc2 = qr[u][2], qc3 = qr[u][3]; \
      __syncthreads(); \
      if (sc + 4 < RW_NSC) LB_LOAD(u, sc + 4); \
      S[0] = mm_tile<false, false>(SB, GS, 16 * w, PT, GS, 0, 64, qc0); S[1] = mm_tile<false, false>(SB, GS, 16 * w, PT, GS, 16, 64, qc1); \
      S[2] = mm_tile<false, false>(SB, GS, 16 * w, PT, GS, 32, 64, qc2); S[3] = mm_tile<false, false>(SB, GS, 16 * w, PT, GS, 48, 64, qc3); } while (0)
  for (int sc0 = 0; sc0 < RW_NSC; sc0 += 4) { LB_STEP(0); LB_STEP(1); LB_STEP(2); LB_STEP(3); }
#undef LB_STEP
#undef LB_LOAD
}

constexpr int HG_NSC = 64;
DI int hg_sc_begin(int sc) { return sc * 8 + (sc < 8 ? sc : 8); }
DI int hg_sc_of_chunk(int ci) { return ci < 72 ? ci / 9 : 8 + (ci - 72) / 8; }
constexpr int QS = 136;
constexpr int HGL_Q0 = 0, HGL_Q1 = 8704, HGL_KP = 13056, HGL_KH = 21760, HGL_VV = 30464, HGL_PM = 39168, HGL_STT = 41728;
constexpr int HGL_BL = 76544, HGL_TOT = 77056, HGL_END = 78080;
constexpr size_t WS_SINHG = 23 * MB;
constexpr size_t WS_QH = 414 * MB;
constexpr size_t WS_O0 = 446 * MB;
constexpr size_t WS_SLOC = 478 * MB;
constexpr size_t WS_DTOT = 510 * MB;

constexpr int HTS = 40, HT1S = 24;
constexpr int HGT_Q0 = 0, HGT_Q1 = 10240, HGT_KP = 16384, HGT_KH = 26624, HGT_VV = 36864, HGT_PM = 47104, HGT_BL = 49664, HGT_TOT = 50176;
DI bf16x8 ld_tr8p(const short* base, int stride, int k0, int n0) {
  const int lane = (int)(threadIdx.x & 63), g = lane >> 4, q = (lane & 15) >> 2, p = lane & 3;
  const short* a0 = base + (k0 + 4 * g + q) * stride + n0 + 4 * p;
  s16x4 lo = __builtin_amdgcn_ds_read_tr16_b64_v4i16((LDSP(s16x4))a0);
  s16x4 hi = __builtin_amdgcn_ds_read_tr16_b64_v4i16((LDSP(s16x4))(a0 + 16 * stride));
  return __builtin_shufflevector(lo, hi, 0, 1, 2, 3, 4, 5, 6, 7);
}
DI void hg_levelA_item(CParams& P, int chain, int sc, char* smem) {
  const int dir = chain >> 2, hd = chain & 3;
  const bfr* p = (const bfr*)(P.ws + WS_P);
  const float* lbp = (const float*)(P.ws + WS_LB) + dir * 512 + hd * 128;
  bfr* QH = (bfr*)(P.ws + WS_QH) + (size_t)dir * T_LAT * 512;
  bfr* O0 = (bfr*)(P.ws + WS_O0) + (size_t)dir * T_LAT * 512;
  short* Q0T = (short*)(smem + HGT_Q0); short* Q1T = (short*)(smem + HGT_Q1); short* KPT = (short*)(smem + HGT_KP);
  short* KHT = (short*)(smem + HGT_KH); short* VVT = (short*)(smem + HGT_VV); short* PMT = (short*)(smem + HGT_PM);
  float* BL = (float*)(smem + HGT_BL); float* tot = (float*)(smem + HGT_TOT);
  const int tid = VT, lane = tid & 63, w = tid >> 6, fr = lane & 15, fq = lane >> 4;
  const f32x4 z4 = {0.f, 0.f, 0.f, 0.f};
  f32x4 S[8][2];
#pragma unroll
  for (int m = 0; m < 8; ++m) { S[m][0] = z4; S[m][1] = z4; }
  const int d = tid & 127, hf = tid >> 7;
  const float lb = lbp[d];
  float dcum = 0.f;
  const int sgn = dir ? -1 : 1;
  const int c_begin = hg_sc_begin(sc), c_end = hg_sc_begin(sc + 1);
  unsigned qv[16]; bfr zr[16];
#define HG_PREFETCH(cc) do { const unsigned po0_ = (unsigned)(row_of_step(dir, (cc) * 32 + hf * 16) * DIN + hd * 128 + d); \
      _Pragma("unroll") for (int e_ = 0; e_ < 16; ++e_) { const unsigned po_ = po0_ + (unsigned)(sgn * e_ * DIN); \
      qv[e_] = (unsigned)p[po_] | ((unsigned)p[po_ + 512] << 16); zr[e_] = p[po_ + 1024 + dir * 512]; } } while (0)
  HG_PREFETCH(c_begin);
  for (int ci = c_begin; ci < c_end; ++ci) {
    __syncthreads();
    {
      float lc[16], kv[16]; float run = 0.f;
#pragma unroll
      for (int e = 0; e < 16; ++e) {
        const float sg = sigmoidf_(bf2f(zr[e]));
        const float f = lb + (1.f - lb) * sg;
        kv[e] = (1.f - lb) * (1.f - sg);
        run += __logf(f); lc[e] = run;
      }
      tot[hf * 128 + d] = run;
      __syncthreads();
      const float tot0 = tot[d], tot1 = tot[128 + d];
      const float blast = tot0 + tot1;
      const float e0f = hf ? __expf(tot0) : 1.f;
      const float ehf = __expf(blast - (hf ? tot0 : 0.f));
      const float edc = __expf(dcum);
      const unsigned qh0 = (unsigned)(row_of_step(dir, ci * 32 + hf * 16) * 512 + hd * 128 + d);
#pragma unroll
      for (int hq = 0; hq < 2; ++hq) {
        unsigned q0w[4], q1w[4], kpw[4], khw[4], vvw[4];
#pragma unroll
        for (int e2 = 0; e2 < 4; ++e2) {
          float q0v[2], q1v[2], kpv[2], khv[2];
#pragma unroll
          for (int u = 0; u < 2; ++u) {
            const int e = 8 * hq + 2 * e2 + u;
            const float el = __expf(lc[e]), eil = frcp_(el);
            const float qs = siluf_(__uint_as_float(qv[e] << 16));
            q1v[u] = qs * el; q0v[u] = q1v[u] * e0f;
            kpv[u] = kv[e] * eil; khv[u] = kpv[u] * ehf;
            if (ci >= 8) QH[qh0 + (unsigned)(sgn * e * 512)] = f2bf(q0v[u] * edc);
          }
          q0w[e2] = pack2(q0v[0], q0v[1]); q1w[e2] = pack2(q1v[0], q1v[1]); kpw[e2] = pack2(kpv[0], kpv[1]); khw[e2] = pack2(khv[0], khv[1]);
          vvw[e2] = (qv[8 * hq + 2 * e2] >> 16) | (qv[8 * hq + 2 * e2 + 1] & 0xffff0000u);
        }
        const int co = 16 * hf + 8 * hq;
        *(uint4*)(Q0T + d * HTS + co) = uint4{q0w[0], q0w[1], q0w[2], q0w[3]};
        if (hf) *(uint4*)(Q1T + d * HT1S + 8 * hq) = uint4{q1w[0], q1w[1], q1w[2], q1w[3]};
        *(uint4*)(KPT + d * HTS + co) = uint4{kpw[0], kpw[1], kpw[2], kpw[3]};
        *(uint4*)(KHT + d * HTS + co) = uint4{khw[0], khw[1], khw[2], khw[3]};
        *(uint4*)(VVT + d * HTS + co) = uint4{vvw[0], vvw[1], vvw[2], vvw[3]};
      }
      if (hf == 0) BL[d] = blast;
      dcum += blast;
      if (ci + 1 < c_end) HG_PREFETCH(ci + 1);
    }
    __syncthreads();
    {
      f32x4 pt = z4;
      if (w == 0) pt = mm_tile<true, false>(Q0T, HTS, 0, KPT, HTS, 0, 128, z4);
      else if (w == 1) pt = mm_tile<true, false>(Q0T, HTS, 16, KPT, HTS, 0, 128, z4);
      else if (w == 2) pt = mm_tile<true, false>(Q1T, HT1S, 0, KPT, HTS, 16, 128, z4);
      if (w == 0 || w == 2) {
#pragma unroll
        for (int reg = 0; reg < 4; ++reg) pt[reg] = (fr <= 4 * fq + reg) ? pt[reg] : 0.f;
      }
      const int ptm = (w == 0 || w == 3) ? 0 : 1, ptn = (w >= 2) ? 1 : 0;
      *(uint2*)(PMT + (16 * ptn + fr) * HTS + 16 * ptm + 4 * fq) = uint2{pack2(pt[0], pt[1]), pack2(pt[2], pt[3])};
    }
    __syncthreads();
    {
      bf16x8 vfr[2];
#pragma unroll
      for (int n = 0; n < 2; ++n) vfr[n] = *(const bf16x8*)(VVT + (32 * w + 16 * n + fr) * HTS + fq * 8);
      f32x4 o[2][2];
#pragma unroll
      for (int m = 0; m < 2; ++m) { o[m][0] = z4; o[m][1] = z4; }
#pragma unroll
      for (int ks = 0; ks < 4; ++ks) {
        bf16x8 sfr[2];
#pragma unroll
        for (int n = 0; n < 2; ++n) {
          typedef __attribute__((ext_vector_type(4))) unsigned u32x4_;
          u32x4_ wv = {pack2(S[2 * ks][n][0], S[2 * ks][n][1]), pack2(S[2 * ks][n][2], S[2 * ks][n][3]), pack2(S[2 * ks + 1][n][0], S[2 * ks + 1][n][1]), pack2(S[2 * ks + 1][n][2], S[2 * ks + 1][n][3])};
          sfr[n] = __builtin_bit_cast(bf16x8, wv);
        }
#pragma unroll
        for (int m = 0; m < 2; ++m) {
          const bf16x8 a = ld_tr8p(Q0T, HTS, 32 * ks, 16 * m);
#pragma unroll
          for (int n = 0; n < 2; ++n) o[m][n] = __builtin_amdgcn_mfma_f32_16x16x32_bf16(a, sfr[n], o[m][n], 0, 0, 0);
        }
      }
#pragma unroll
      for (int m = 0; m < 2; ++m) {
        const bf16x8 a = ld_tr8(PMT, HTS, 0, 16 * m);
#pragma unroll
        for (int n = 0; n < 2; ++n) {
          o[m][n] = __builtin_amdgcn_mfma_f32_16x16x32_bf16(a, vfr[n], o[m][n], 0, 0, 0);
          if (ci >= 8) {
            const unsigned orow = (unsigned)(row_of_step(dir, ci * 32 + 16 * m + 4 * fq) * 512 + hd * 128 + 32 * w + 16 * n + fr);
#pragma unroll
            for (int reg = 0; reg < 4; ++reg) O0[orow + (unsigned)(sgn * reg * 512)] = f2bf(o[m][n][reg]);
          }
        }
      }
#pragma unroll
      for (int m = 0; m < 8; ++m) {
        const f32x4 bl = *(const f32x4*)(BL + 16 * m + 4 * fq);
        f32x4 sc4 = {__expf(bl[0]), __expf(bl[1]), __expf(bl[2]), __expf(bl[3])};
        const bf16x8 a = *(const bf16x8*)(KHT + (16 * m + fr) * HTS + fq * 8);
#pragma unroll
        for (int n = 0; n < 2; ++n) S[m][n] = __builtin_amdgcn_mfma_f32_16x16x32_bf16(a, vfr[n], S[m][n] * sc4, 0, 0, 0);
      }
    }
  }
  {
    float* SL_ = (float*)(P.ws + WS_SLOC) + (size_t)(chain * HG_NSC + sc) * 16384;
    float* DT = (float*)(P.ws + WS_DTOT) + (size_t)(chain * HG_NSC + sc) * 128;
#pragma unroll
    for (int m = 0; m < 8; ++m)
#pragma unroll
      for (int n = 0; n < 2; ++n) *(f32x4*)(SL_ + (32 * w + 16 * n + fr) * 128 + 16 * m + 4 * fq) = S[m][n];
    if (hf == 0) DT[d] = dcum;
  }
}

DI void hg_levelB(CParams& P, int bid, int nb) {
  const float* SLOC = (const float*)(P.ws + WS_SLOC); const float* DT = (const float*)(P.ws + WS_DTOT);
  bfr* SIN = (bfr*)(P.ws + WS_SINHG);
  for (int idx = bid * NTHR + VT; idx < 8 * 16384; idx += nb * NTHR) {
    const int chain = idx >> 14, ed = idx & 16383, dd = ed & 127;
    float s = 0.f;
    for (int sc = 0; sc < HG_NSC; ++sc) {
      const size_t item = (size_t)chain * HG_NSC + sc;
      SIN[item * 16384 + ed] = f2bf(s);
      s = __expf(DT[item * 128 + dd]) * s + SLOC[item * 16384 + ed];
    }
  }
}

constexpr size_t WS_LORA = 256 * 1024;
constexpr int LORA_WD2T = 0, LORA_WA2T = 2 * 512 * 32, LORA_WG2T = LORA_WA2T + 512 * 32;
DI void phase_lora_convert(CParams& P, int part, int nparts) {
  const float* wd2 = P.in[12]; const float* wa2 = P.in[14]; const float* wg2 = P.in[15];
  bfr* L = (bfr*)(P.ws + WS_LORA);
  for (int i = part * NTHR + VT; i < 2 * 512 * 32; i += nparts * NTHR) { const int d = i >> 14, c = (i >> 5) & 511, j = i & 31; L[LORA_WD2T + i] = f2bf(wd2[(d * 32 + j) * 512 + c]); }
  for (int i = part * NTHR + VT; i < 512 * 32; i += nparts * NTHR) { const int c = i >> 5, j = i & 31; L[LORA_WA2T + i] = f2bf(wa2[j * 512 + c]); }
  for (int i = part * NTHR + VT; i < 512 * 96; i += nparts * NTHR) { const int c = i / 96, j = i % 96; L[LORA_WG2T + i] = f2bf(wg2[j * 512 + c]); }
}
#define NB_DECL(row) \
  int nb_o0, nb_o1, nb_o2, nb_o3; float nb_f0, nb_f1, nb_f2, nb_f3, nb_scale; \
  { const int r_ = (row); const bool lat_ = r_ < T_LAT; const int gr_ = r_ >> 6, gc_ = r_ & 63, s_ = r_ - T_LAT; \
    const bool v0_ = lat_ && gr_ > 0, v1_ = lat_ && gr_ < 255, v2_ = lat_ ? gc_ > 0 : s_ > 0, v3_ = lat_ ? gc_ < 63 : s_ < T_CTX - 1; \
    nb_o0 = v0_ ? -64 * DIN : 0; nb_o1 = v1_ ? 64 * DIN : 0; nb_o2 = v2_ ? -DIN : 0; nb_o3 = v3_ ? DIN : 0; \
    nb_f0 = v0_ ? 1.f : 0.f; nb_f1 = v1_ ? 1.f : 0.f; nb_f2 = v2_ ? 1.f : 0.f; nb_f3 = v3_ ? 1.f : 0.f; nb_scale = lat_ ? 0.25f : 0.5f; }
#define MIX4(pc, mup) mix4_((pc), (mup), nb_o0, nb_o1, nb_o2, nb_o3, nb_f0, nb_f1, nb_f2, nb_f3, nb_scale)
DI f32x4 ld4bf(const bfr* p) {
  const uint2 u = *(const uint2*)p;
  return f32x4{__uint_as_float(u.x << 16), __uint_as_float(u.x & 0xffff0000u), __uint_as_float(u.y << 16), __uint_as_float(u.y & 0xffff0000u)};
}
DI f32x4 mix4_(const bfr* pc, const float* mu, int o0, int o1, int o2, int o3, float f0, float f1, float f2, float f3, float scale) {
  const f32x4 c = ld4bf(pc);
  f32x4 s = ld4bf(pc + o0) * f0 + ld4bf(pc + o1) * f1 + ld4bf(pc + o2) * f2 + ld4bf(pc + o3) * f3;
  const f32x4 m = *(const f32x4*)mu;
  return c + (s * scale - c) * m;
}
DI void ld8bf(const bfr* p, f32x4& lo, f32x4& hi) {
  const uint4 u = *(const uint4*)p;
  lo = f32x4{__uint_as_float(u.x << 16), __uint_as_float(u.x & 0xffff0000u), __uint_as_float(u.y << 16), __uint_as_float(u.y & 0xffff0000u)};
  hi = f32x4{__uint_as_float(u.z << 16), __uint_as_float(u.z & 0xffff0000u), __uint_as_float(u.w << 16), __uint_as_float(u.w & 0xffff0000u)};
}
DI void mix8_(const bfr* pc, const float* mu, int o0, int o1, int o2, int o3, float f0, float f1, float f2, float f3, float scale, f32x4& lo, f32x4& hi) {
  f32x4 cl, chh, al, ah, bl, bh, dl, dh, el, eh;
  ld8bf(pc, cl, chh); ld8bf(pc + o0, al, ah); ld8bf(pc + o1, bl, bh); ld8bf(pc + o2, dl, dh); ld8bf(pc + o3, el, eh);
  const f32x4 sl = al * f0 + bl * f1 + dl * f2 + el * f3, sh = ah * f0 + bh * f1 + dh * f2 + eh * f3;
  const f32x4 ml = *(const f32x4*)mu, mh = *(const f32x4*)(mu + 4);
  lo = cl + (sl * scale - cl) * ml; hi = chh + (sh * scale - chh) * mh;
}
#define MIX8(pc, mup, lo, hi) mix8_((pc), (mup), nb_o0, nb_o1, nb_o2, nb_o3, nb_f0, nb_f1, nb_f2, nb_f3, nb_scale, lo, hi)
DI float ftanh_(float x) { const float e = __expf(2.f * x); return 1.f - 2.f * frcp_(e + 1.f); }
DI uint2 pk4(f32x4 v) { return uint2{pack2(v[0], v[1]), pack2(v[2], v[3])}; }
constexpr int LIS = 200;
constexpr int MXS = 388;
DI void phase_rwprep(CParams& P, int bid, int nb, char* smem) {
  const bfr* p = (const bfr*)(P.ws + WS_P);
  const float* mu = P.in[10]; const float* w0 = P.in[11]; const float* a0 = P.in[13];
  const float* k_k = P.in[16]; const float* k_a = P.in[17];
  const bfr* LW_ = (const bfr*)(P.ws + WS_LORA);
  bfr* R = (bfr*)(P.ws + WS_RW); bfr* K = (bfr*)(P.ws + WS_RW + RW_ARR); bfr* V = (bfr*)(P.ws + WS_RW + 2 * RW_ARR);
  bfr* KK = (bfr*)(P.ws + WS_RW + 3 * RW_ARR); bfr* A = (bfr*)(P.ws + WS_RW + 4 * RW_ARR); bfr* G = (bfr*)(P.ws + WS_RW + 5 * RW_ARR);
  float* LWF = (float*)(P.ws + WS_LW); float* LWB = (float*)(P.ws + WS_LW + LW_ARR);
  short* LI = (short*)smem;
  float* MX = (float*)(smem + 32 * LIS * 2);
  const int tid = VT, lane = tid & 63, w = tid >> 6, fr = lane & 15, fq = lane >> 4;
  const f32x4 z4 = {0.f, 0.f, 0.f, 0.f};
  const int hp = bid & 3;
  bf16x8 afr[4][6];
  {
    const int h = hp * 2 + (w >> 1);
#pragma unroll
    for (int m = 0; m < 4; ++m) {
      const int c0 = 64 * h + 16 * m;
      afr[m][0] = *(const bf16x8*)(LW_ + LORA_WD2T + (c0 + fr) * 32 + fq * 8);
      afr[m][1] = *(const bf16x8*)(LW_ + LORA_WD2T + 512 * 32 + (c0 + fr) * 32 + fq * 8);
      afr[m][2] = *(const bf16x8*)(LW_ + LORA_WA2T + (c0 + fr) * 32 + fq * 8);
#pragma unroll
      for (int ks = 0; ks < 3; ++ks) afr[m][3 + ks] = *(const bf16x8*)(LW_ + LORA_WG2T + (c0 + fr) * 96 + ks * 32 + fq * 8);
    }
  }
  for (int it = bid; it < (T_ALL / 32) * 4; it += nb) {
  const int tile = it >> 2;
  const int row0 = tile * 32;
  __syncthreads();
  for (int v = tid; v < 32 * 72; v += NTHR) {
    const int t = v / 72, g = v % 72;
    const int row = row0 + t;
    NB_DECL(row);
    f32x4 lo, hi;
    if (g < 24) {
      const bfr* pc = p + (size_t)row * DIN + HGC + 1536 + g * 8;
      MIX8(pc, mu + 1536 + g * 8, lo, hi);
#pragma unroll
      for (int e = 0; e < 4; ++e) {
        if (g < 8) { lo[e] = ftanh_(lo[e]); hi[e] = ftanh_(hi[e]); }
        else if (g >= 12) { lo[e] = sigmoidf_(lo[e]); hi[e] = sigmoidf_(hi[e]); }
      }
      const uint2 a = pk4(lo), b = pk4(hi);
      *(uint4*)(LI + t * LIS + g * 8) = uint4{a.x, a.y, b.x, b.y};
    } else {
      const int cg = g - 24, a = cg >> 4, c8 = cg & 15;
      const int col = a * 512 + hp * 128 + c8 * 8;
      MIX8(p + (size_t)row * DIN + HGC + col, mu + col, lo, hi);
      *(f32x4*)(MX + t * MXS + a * 128 + c8 * 8) = lo; *(f32x4*)(MX + t * MXS + a * 128 + c8 * 8 + 4) = hi;
    }
  }
  __syncthreads();
  {
    const int hl = w >> 1, th = w & 1, h = hp * 2 + hl;
    const int row = row0 + 16 * th + fr;
    const float* mrow = MX + (16 * th + fr) * MXS + hl * 64 + 4 * fq;
    f32x4 kkr[4], kraw[4], av[4];
    float ss = 0.f;
#pragma unroll
    for (int m = 0; m < 4; ++m) {
      const int c0 = 64 * h + 16 * m;
      const int ch = c0 + 4 * fq;
      const f32x4 r = *(const f32x4*)(mrow + 16 * m);
      kraw[m] = *(const f32x4*)(mrow + 128 + 16 * m);
      const f32x4 v = *(const f32x4*)(mrow + 256 + 16 * m);
      const short* lrow = LI + (16 * th + fr) * LIS + fq * 8;
      f32x4 aF = __builtin_amdgcn_mfma_f32_16x16x32_bf16(afr[m][0], *(const bf16x8*)(lrow), z4, 0, 0, 0);
      f32x4 aB = __builtin_amdgcn_mfma_f32_16x16x32_bf16(afr[m][1], *(const bf16x8*)(lrow + 32), z4, 0, 0, 0);
      f32x4 aA = __builtin_amdgcn_mfma_f32_16x16x32_bf16(afr[m][2], *(const bf16x8*)(lrow + 64), z4, 0, 0, 0);
      f32x4 aG = z4;
#pragma unroll
      for (int ks = 0; ks < 3; ++ks) aG = __builtin_amdgcn_mfma_f32_16x16x32_bf16(afr[m][3 + ks], *(const bf16x8*)(lrow + 96 + ks * 32), aG, 0, 0, 0);
      const size_t o = (size_t)row * 512 + ch;
      const f32x4 w0f = *(const f32x4*)(w0 + ch), w0b = *(const f32x4*)(w0 + 512 + ch), a0v = *(const f32x4*)(a0 + ch);
      f32x4 lwf, lwb;
#pragma unroll
      for (int e = 0; e < 4; ++e) {
        lwf[e] = -RW_DECAY_SCALE * sigmoidf_(w0f[e] + aF[e]);
        lwb[e] = -RW_DECAY_SCALE * sigmoidf_(w0b[e] + aB[e]);
        av[m][e] = sigmoidf_(a0v[e] + aA[e]);
      }
      *(f32x4*)(LWF + o) = lwf; *(f32x4*)(LWB + o) = lwb;
      *(uint2*)(G + o) = pk4(aG);
      *(uint2*)(A + o) = pk4(av[m]);
      *(uint2*)(R + o) = pk4(r); *(uint2*)(V + o) = pk4(v);
      kkr[m] = kraw[m] * *(const f32x4*)(k_k + ch);
      ss += kkr[m][0] * kkr[m][0] + kkr[m][1] * kkr[m][1] + kkr[m][2] * kkr[m][2] + kkr[m][3] * kkr[m][3];
    }
    ss += __shfl_xor(ss, 16); ss += __shfl_xor(ss, 32);
    const float rn = rsqrtf(fmaxf(ss, 1e-12f));
#pragma unroll
    for (int m = 0; m < 4; ++m) {
      const int ch = 64 * h + 16 * m + 4 * fq;
      const size_t o = (size_t)row * 512 + ch;
      const f32x4 ka = *(const f32x4*)(k_a + ch);
      f32x4 kv;
#pragma unroll
      for (int e = 0; e < 4; ++e) kv[e] = kraw[m][e] * (1.f + (av[m][e] - 1.f) * ka[e]);
      *(uint2*)(K + o) = pk4(kv);
      *(uint2*)(KK + o) = pk4(kkr[m] * rn);
    }
  }
  }
}

constexpr size_t WS_WRT = 512 * 1024;
DI void phase_wrt_convert(CParams& P, int part, int nparts) {
  const float* wgrp = P.in[25]; const float* wrt = P.in[27];
  bfr* Whi = (bfr*)(P.ws + WS_WRT); bfr* Wlo = Whi + 80 * 1024;
  for (int i = part * NTHR + VT; i < 80 * 1024; i += nparts * NTHR) {
    const int o = i >> 10, k = i & 1023;
    float wv = 0.f;
    if (o < 8) wv = wgrp[k * 8 + o]; else if (o < 72) wv = wrt[k * 64 + (o - 8)];
    const bfr hi = f2bf(wv);
    Whi[i] = hi; Wlo[i] = f2bf(wv - bf2f(hi));
  }
}
constexpr int HLS = 1032;
DI void phase_ln2route(CParams& P, char* smem_all) {
  const float* x = P.in[0];
  const bfr* y = (const bfr*)(P.ws + WS_Y);
  const float* mod = (const float*)(P.ws + WS_MOD);
  const float* ln1_g = P.in[21]; const float* ln1_b = P.in[22];
  const float* bgrp = P.in[26]; const float* brt = P.in[28];
  const bfr* Whi = (const bfr*)(P.ws + WS_WRT); const bfr* Wlo = Whi + 80 * 1024;
  bfr* x1 = (bfr*)(P.ws + WS_X1B);
  bfr* h2 = (bfr*)(P.ws + WS_H2);
  int* cnt = (int*)(P.ws + WS_CNT); int* list = (int*)(P.ws + WS_LIST); float* asgw = (float*)(P.ws + WS_ASGW);
  short* HI = (short*)smem_all; short* LO = HI + 32 * HLS;
  float* LG = (float*)(smem_all + 2 * 32 * HLS * 2);
  float* PS = LG + 32 * 80;
  const int tid = tx_(), wid = tid >> 6, lane = tid & 63, fr = lane & 15, fq = lane >> 4;
  for (int grp = blockIdx.x; grp < T_LAT / 32; grp += gridDim.x) {
    const int t0 = grp * 32;
    __syncthreads();
    f32x4 xin[4][4]; uint2 yin[4][4];
#pragma unroll
    for (int tt = 0; tt < 4; ++tt)
#pragma unroll
      for (int i = 0; i < 4; ++i) {
        const long o = (long)(t0 + wid * 4 + tt) * DM + lane * 4 + 256 * i;
        xin[tt][i] = *(const f32x4*)(x + o); yin[tt][i] = *(const uint2*)(y + o);
      }
#pragma unroll
    for (int tt = 0; tt < 4; ++tt) {
      const int tl = wid * 4 + tt, t = t0 + tl;
      f32x4 v[4]; float s = 0.f;
#pragma unroll
      for (int i = 0; i < 4; ++i) {
        const int c = lane * 4 + 256 * i;
        const f32x4 g1 = *(const f32x4*)(mod + 2048 + c);
        const uint2 u = yin[tt][i];
        const f32x4 yv = {__uint_as_float(u.x << 16), __uint_as_float(u.x & 0xffff0000u), __uint_as_float(u.y << 16), __uint_as_float(u.y & 0xffff0000u)};
        v[i] = xin[tt][i] * DN_ALPHA + g1 * yv;
        s += v[i][0] + v[i][1] + v[i][2] + v[i][3];
      }
      float mu = wave_sum(s) * (1.f / DM); float q = 0.f;
#pragma unroll
      for (int i = 0; i < 4; ++i) { v[i] -= mu; q += v[i][0] * v[i][0] + v[i][1] * v[i][1] + v[i][2] * v[i][2] + v[i][3] * v[i][3]; }
      float rs = rsqrtf(wave_sum(q) * (1.f / DM) + 1e-5f);
      s = 0.f;
#pragma unroll
      for (int i = 0; i < 4; ++i) {
        const int c = lane * 4 + 256 * i;
        f32x4 g = *(const f32x4*)(ln1_g + c), b = *(const f32x4*)(ln1_b + c);
        v[i] = v[i] * rs * g + b;
        *(uint2*)(x1 + (long)t * DM + c) = pk4(v[i]);
        s += v[i][0] + v[i][1] + v[i][2] + v[i][3];
      }
      mu = wave_sum(s) * (1.f / DM); q = 0.f;
#pragma unroll
      for (int i = 0; i < 4; ++i) { v[i] -= mu; q += v[i][0] * v[i][0] + v[i][1] * v[i][1] + v[i][2] * v[i][2] + v[i][3] * v[i][3]; }
      rs = rsqrtf(wave_sum(q) * (1.f / DM) + 1e-5f);
#pragma unroll
      for (int i = 0; i < 4; ++i) {
        const int c = lane * 4 + 256 * i;
        f32x4 sh = *(const f32x4*)(mod + 3072 + c), sc = *(const f32x4*)(mod + 4096 + c);
        v[i] = v[i] * rs * (sc + 1.f) + sh;
        const uint2 whi = {pack2(v[i][0], v[i][1]), pack2(v[i][2], v[i][3])};
        f32x4 r;
        r[0] = v[i][0] - __uint_as_float(whi.x << 16); r[1] = v[i][1] - __uint_as_float(whi.x & 0xffff0000u);
        r[2] = v[i][2] - __uint_as_float(whi.y << 16); r[3] = v[i][3] - __uint_as_float(whi.y & 0xffff0000u);
        const uint2 wlo = {pack2(r[0], r[1]), pack2(r[2], r[3])};
        *(uint2*)(h2 + (long)t * DM + c) = whi;
        *(uint2*)(HI + tl * HLS + c) = whi;
        *(uint2*)(LO + tl * HLS + c) = wlo;
      }
    }
    __syncthreads();
    {
      const int own = wid < 4;
      const int mrow = own ? 16 * wid : 64;
      f32x4 acc0 = {0.f, 0.f, 0.f, 0.f}, acc1 = {0.f, 0.f, 0.f, 0.f};
      bf16x8 a[8], an[8];
      const int nbatch = own ? 12 : 3;
#define RT_LOAD(bi_, dst) do { const int ps_ = own ? ((bi_) >> 2) : (bi_), kb_ = own ? (((bi_) & 3) * 8) : ((wid - 4) * 8); const bfr* Wp_ = ps_ == 1 ? Wlo : Whi; \
        _Pragma("unroll") for (int u = 0; u < 8; ++u) dst[u] = *(const bf16x8*)(Wp_ + (size_t)(mrow + fr) * 1024 + (kb_ + u) * 32 + fq * 8); } while (0)
      RT_LOAD(0, a);
#pragma unroll 1
      for (int bi = 0; bi < nbatch; ++bi) {
        if (bi + 1 < nbatch) RT_LOAD(bi + 1, an);
        const int ps = own ? (bi >> 2) : bi, kb = own ? ((bi & 3) * 8) : ((wid - 4) * 8);
        const short* Hp = ps == 2 ? LO : HI;
#pragma unroll
        for (int u = 0; u < 8; ++u) {
          const bf16x8 b0 = *(const bf16x8*)(Hp + fr * HLS + (kb + u) * 32 + fq * 8);
          const bf16x8 b1 = *(const bf16x8*)(Hp + (16 + fr) * HLS + (kb + u) * 32 + fq * 8);
          acc0 = __builtin_amdgcn_mfma_f32_16x16x32_bf16(a[u], b0, acc0, 0, 0, 0);
          acc1 = __builtin_amdgcn_mfma_f32_16x16x32_bf16(a[u], b1, acc1, 0, 0, 0);
        }
#pragma unroll
        for (int u = 0; u < 8; ++u) a[u] = an[u];
      }
#undef RT_LOAD
      if (own) {
#pragma unroll
        for (int reg = 0; reg < 4; ++reg) { LG[fr * 80 + mrow + 4 * fq + reg] = acc0[reg]; LG[(16 + fr) * 80 + mrow + 4 * fq + reg] = acc1[reg]; }
      } else {
#pragma unroll
        for (int reg = 0; reg < 4; ++reg) { PS[((wid - 4) * 32 + fr) * 16 + 4 * fq + reg] = acc0[reg]; PS[((wid - 4) * 32 + 16 + fr) * 16 + 4 * fq + reg] = acc1[reg]; }
      }
    }
    __syncthreads();
    {
      const int tk = tid >> 4, o = tid & 15;
      LG[tk * 80 + 64 + o] = (PS[(0 * 32 + tk) * 16 + o] + PS[(1 * 32 + tk) * 16 + o]) + (PS[(2 * 32 + tk) * 16 + o] + PS[(3 * 32 + tk) * 16 + o]);
    }
    __syncthreads();
    if (tid < 32) {
      const int t = t0 + tid;
      const float* lg = LG + tid * 80;
      int gi = 0; float gmax = -3.4e38f; float gl[8];
#pragma unroll
      for (int g = 0; g < 8; ++g) { gl[g] = lg[g] + bgrp[g]; if (gl[g] > gmax) { gmax = gl[g]; gi = g; } }
      float den = 0.f;
#pragma unroll
      for (int g = 0; g < 8; ++g) den += __expf(gl[g] - gmax);
      const float gprob = 1.f / den;
      int i1 = 0; float v1 = -3.4e38f; float el[8];
#pragma unroll
      for (int g = 0; g < 8; ++g) { el[g] = lg[8 + gi * 8 + g] + brt[gi * 8 + g]; if (el[g] > v1) { v1 = el[g]; i1 = g; } }
      int i2 = 0; float v2 = -3.4e38f;
#pragma unroll
      for (int g = 0; g < 8; ++g) { if (g != i1 && el[g] > v2) { v2 = el[g]; i2 = g; } }
      const float e2 = __expf(v2 - v1);
      const float wt1 = gprob / (1.f + e2), wt2 = gprob * e2 / (1.f + e2);
      const int ex1 = gi * 8 + i1, ex2 = gi * 8 + i2;
      int s1 = atomicAdd(&cnt[ex1], 1); list[ex1 * T_LAT + s1] = t * 2;
      int s2 = atomicAdd(&cnt[ex2], 1); list[ex2 * T_LAT + s2] = t * 2 + 1;
      asgw[t * 2] = wt1; asgw[t * 2 + 1] = wt2;
    }
  }
}

DI void phase_final(CParams& P, int bid, int nb) {
  const float* mod = (const float*)(P.ws + WS_MOD);
  const float* ln2_g = P.in[23]; const float* ln2_b = P.in[24];
  const bfr* mout = (const bfr*)(P.ws + (42ull << 20));
  const bfr* x1b = (const bfr*)(P.ws + WS_X1B);
  const float* asgw = (const float*)(P.ws + WS_ASGW);
  float* out = P.out;
  const int wid = VT >> 6, lane = VT & 63;
  for (int t0 = (bid * 4 + wid) * 2; t0 < T_LAT; t0 += nb * 8) {
    f32x4 v[2][4]; float s[2] = {0.f, 0.f};
#pragma unroll
    for (int r = 0; r < 2; ++r) {
      const int t = t0 + r;
      const float w1 = asgw[t * 2], w2 = asgw[t * 2 + 1];
#pragma unroll
      for (int i = 0; i < 4; ++i) {
        const int c = lane * 4 + 256 * i;
        const f32x4 xv = ld4bf(x1b + (long)t * DM + c), g2 = *(const f32x4*)(mod + 5120 + c);
        const f32x4 a = ld4bf(mout + (long)(2 * t) * DM + c), b = ld4bf(mout + (long)(2 * t + 1) * DM + c);
        v[r][i] = xv * DN_ALPHA + g2 * (a * w1 + b * w2);
        s[r] += v[r][i][0] + v[r][i][1] + v[r][i][2] + v[r][i][3];
      }
    }
#pragma unroll
    for (int r = 0; r < 2; ++r) {
      const float mu = wave_sum(s[r]) * (1.f / DM); float q = 0.f;
#pragma unroll
      for (int i = 0; i < 4; ++i) { v[r][i] -= mu; q += v[r][i][0] * v[r][i][0] + v[r][i][1] * v[r][i][1] + v[r][i][2] * v[r][i][2] + v[r][i][3] * v[r][i][3]; }
      const float rs = rsqrtf(wave_sum(q) * (1.f / DM) + 1e-5f);
#pragma unroll
      for (int i = 0; i < 4; ++i) {
        const int c = lane * 4 + 256 * i;
        f32x4 g = *(const f32x4*)(ln2_g + c), b = *(const f32x4*)(ln2_b + c);
        *(f32x4*)(out + (long)(t0 + r) * DM + c) = v[r][i] * rs * g + b;
      }
    }
  }
}

DI void phase_readout_fused(CParams& P, int bid, int nb) {
  const bfr* p = (const bfr*)(P.ws + WS_P);
  const bfr* R = (const bfr*)(P.ws + WS_RW); const bfr* K = (const bfr*)(P.ws + WS_RW + RW_ARR); const bfr* V = (const bfr*)(P.ws + WS_RW + 2 * RW_ARR);
  const bfr* G = (const bfr*)(P.ws + WS_RW + 5 * RW_ARR);
  const float* hg_norm_w = P.in[9]; const float* r_k = P.in[18]; const float* gn_w = P.in[19]; const float* gn_b = P.in[20];
  bfr* mix = (bfr*)(P.ws + WS_MIX);
  const int tid = VT, lane = tid & 63, w = tid >> 6, fr = lane & 15, fq = lane >> 4;
  const f32x4 z4 = {0.f, 0.f, 0.f, 0.f};
  for (int tile = bid; tile < T_LAT / 32; tile += nb) {
    const int t0 = tile * 32;
#pragma unroll 1
    for (int hh = 0; hh < 2; ++hh) {
      const int hd = 2 * w + hh;
      f32x4 acc[4][2];
#pragma unroll
      for (int m = 0; m < 4; ++m) { acc[m][0] = z4; acc[m][1] = z4; }
#pragma unroll
      for (int dir = 0; dir < 2; ++dir) {
        const int ci = dir ? (519 - tile) : (8 + tile);
        const int sc = rw_sc_of_chunk(ci);
        const bfr* Bq = (const bfr*)(P.ws + WS_R2P) + (size_t)dir * T_LAT * 512 + (size_t)t0 * 512 + hd * 64;
        const bfr* Y0 = (const bfr*)(P.ws + WS_Y0P) + (size_t)dir * T_LAT * 512 + (size_t)t0 * 512 + hd * 64;
        const bfr* Sin = (const bfr*)(P.ws + WS_SINRW) + ((size_t)(dir * 8 + hd) * (RW_NSC + 1) + sc) * 4096;
#pragma unroll
        for (int k0 = 0; k0 < 64; k0 += 32) {
          bf16x8 bq[2];
#pragma unroll
          for (int n = 0; n < 2; ++n) bq[n] = *(const bf16x8*)(Bq + (size_t)(16 * n + fr) * 512 + k0 + fq * 8);
#pragma unroll
          for (int m = 0; m < 4; ++m) {
            const bf16x8 a = *(const bf16x8*)(Sin + (16 * m + fr) * 64 + k0 + fq * 8);
#pragma unroll
            for (int n = 0; n < 2; ++n) acc[m][n] = __builtin_amdgcn_mfma_f32_16x16x32_bf16(a, bq[n], acc[m][n], 0, 0, 0);
          }
        }
#pragma unroll
        for (int m = 0; m < 4; ++m)
#pragma unroll
          for (int n = 0; n < 2; ++n) acc[m][n] += ld4bf(Y0 + (size_t)(16 * n + fr) * 512 + 16 * m + 4 * fq);
      }
#pragma unroll
      for (int n = 0; n < 2; ++n) {
        const size_t trow = (size_t)(t0 + 16 * n + fr) * 512 + hd * 64;
        float s = 0.f, bs = 0.f;
        f32x4 vv[4];
#pragma unroll
        for (int m = 0; m < 4; ++m) {
          const int c = 16 * m + 4 * fq;
          s += acc[m][n][0] + acc[m][n][1] + acc[m][n][2] + acc[m][n][3];
          const f32x4 rr = ld4bf(R + trow + c), kk2 = ld4bf(K + trow + c), rk = *(const f32x4*)(r_k + hd * 64 + c);
          vv[m] = ld4bf(V + trow + c);
          bs += rr[0] * kk2[0] * rk[0] + rr[1] * kk2[1] * rk[1] + rr[2] * kk2[2] * rk[2] + rr[3] * kk2[3] * rk[3];
        }
        s += __shfl_xor(s, 16); s += __shfl_xor(s, 32);
        bs += __shfl_xor(bs, 16); bs += __shfl_xor(bs, 32);
        const float mu = s * (1.f / 64.f);
        float q = 0.f;
#pragma unroll
        for (int m = 0; m < 4; ++m) { acc[m][n] -= mu; q += acc[m][n][0] * acc[m][n][0] + acc[m][n][1] * acc[m][n][1] + acc[m][n][2] * acc[m][n][2] + acc[m][n][3] * acc[m][n][3]; }
        q += __shfl_xor(q, 16); q += __shfl_xor(q, 32);
        const float rs = rsqrtf(q * (1.f / 64.f) + 64e-5f);
#pragma unroll
        for (int m = 0; m < 4; ++m) {
          const int c = hd * 64 + 16 * m + 4 * fq;
          const f32x4 gw = *(const f32x4*)(gn_w + c), gb = *(const f32x4*)(gn_b + c), gg = ld4bf(G + trow + 16 * m + 4 * fq);
          const f32x4 o = (acc[m][n] * rs * gw + gb + vv[m] * bs) * gg;
          *(uint2*)(mix + (size_t)(t0 + 16 * n + fr) * DM + 512 + c) = pk4(o);
        }
      }
    }
    {
      const int hd = w;
      f32x4 acc[8][2];
#pragma unroll
      for (int m = 0; m < 8; ++m) { acc[m][0] = z4; acc[m][1] = z4; }
#pragma unroll
      for (int dir = 0; dir < 2; ++dir) {
        const int ci = dir ? (519 - tile) : (8 + tile);
        const int sc = hg_sc_of_chunk(ci);
        const bfr* Bq = (const bfr*)(P.ws + WS_QH) + (size_t)dir * T_LAT * 512 + (size_t)t0 * 512 + hd * 128;
        const bfr* O0 = (const bfr*)(P.ws + WS_O0) + (size_t)dir * T_LAT * 512 + (size_t)t0 * 512 + hd * 128;
        const bfr* Sin = (const bfr*)(P.ws + WS_SINHG) + ((size_t)(dir * 4 + hd) * HG_NSC + sc) * 16384;
#pragma unroll
        for (int k0 = 0; k0 < 128; k0 += 32) {
          bf16x8 bq[2];
#pragma unroll
          for (int n = 0; n < 2; ++n) bq[n] = *(const bf16x8*)(Bq + (size_t)(16 * n + fr) * 512 + k0 + fq * 8);
#pragma unroll
          for (int m = 0; m < 8; ++m) {
            const bf16x8 a = *(const bf16x8*)(Sin + (16 * m + fr) * 128 + k0 + fq * 8);
#pragma unroll
            for (int n = 0; n < 2; ++n) acc[m][n] = __builtin_amdgcn_mfma_f32_16x16x32_bf16(a, bq[n], acc[m][n], 0, 0, 0);
          }
        }
#pragma unroll
        for (int m = 0; m < 8; ++m)
#pragma unroll
          for (int n = 0; n < 2; ++n) acc[m][n] += ld4bf(O0 + (size_t)(16 * n + fr) * 512 + 16 * m + 4 * fq);
      }
#pragma unroll
      for (int n = 0; n < 2; ++n) {
        const int t = t0 + 16 * n + fr;
        float ss = 0.f;
#pragma unroll
        for (int m = 0; m < 8; ++m) ss += acc[m][n][0] * acc[m][n][0] + acc[m][n][1] * acc[m][n][1] + acc[m][n][2] * acc[m][n][2] + acc[m][n][3] * acc[m][n][3];
        ss += __shfl_xor(ss, 16); ss += __shfl_xor(ss, 32);
        const float rs = rsqrtf(ss * (1.f / 128.f) + 1e-6f);
#pragma unroll
        for (int m = 0; m < 8; ++m) {
          const int c = hd * 128 + 16 * m + 4 * fq;
          const f32x4 nw = *(const f32x4*)(hg_norm_w + c), gg = ld4bf(p + (size_t)t * DIN + 2048 + c);
          f32x4 o;
#pragma unroll
          for (int e = 0; e < 4; ++e) o[e] = acc[m][n][e] * rs * nw[e] * siluf_(gg[e]);
          *(uint2*)(mix + (size_t)t * DM + c) = pk4(o);
        }
      }
    }
  }
}

namespace pg8 {
#define PG8_LAS __attribute__((address_space(3)))
typedef unsigned short bf16_t;
typedef short bf16x8 __attribute__((ext_vector_type(8)));
typedef float f32x4 __attribute__((ext_vector_type(4)));
typedef unsigned u32x4 __attribute__((ext_vector_type(4)));
constexpr int BM = 256, BK = 64, HALF = 128, HTB = HALF * BK * 2  , STAGE_BYTES = 8 * HTB, NXCD = 8, WGM = 8;

__host__ __device__ __forceinline__ int lds_byte(int r, int c) { const int st = (r >> 4) * 2 + (c >> 5), rr = r & 15, cc = c & 31, ob = rr * 64 + cc * 2; return st * 1024 + (ob ^ (((ob >> 9) & 1) << 5)); }
__host__ __device__ __forceinline__ void stage_rc(int b, int& R, int& C) { const int st = b / 1024, sb = b % 1024, swz = sb ^ (((sb >> 9) & 1) << 5); R = (st >> 1) * 16 + swz / 64; C = (st & 1) * 32 + (swz % 64) / 2; }
__host__ __device__ __forceinline__ int perm32(int rho) { const int n = rho >> 4, i = rho & 15; return 8 * (i >> 2) + 4 * n + (i & 3); }

struct Unit { int pm, pn; };
struct Gemm { const bf16_t* A; const bf16_t* Bt; int M, N, K; const bf16_t* Bt2; int pn_split; };

struct StaticOrder {
    int nM, nN, nwg, G, c;
    __host__ __device__ void init(int M, int N, int G_, int c_) { nM = M / BM; nN = N / BM; nwg = nM * nN; G = G_; c = c_; }
    __host__ __device__ bool next(int i, Unit& u) const {
        const long L = (long)i * G + c; if (L >= nwg) return false;
        int wgid = (int)L; { const int q = nwg / NXCD, r = nwg % NXCD, xcd = wgid % NXCD, off = wgid / NXCD; wgid = (xcd < r ? xcd * (q + 1) : r * (q + 1) + (xcd - r) * q) + off; }
        const int nig = WGM * nN, gid = wgid / nig, fm = gid * WGM, gsz = (nM - fm) < WGM ? (nM - fm) : WGM;
        u.pm = fm + ((wgid % nig) % gsz); u.pn = (wgid % nig) / gsz; return true;
    }
    __device__ __forceinline__ void a_ready(const Unit&) const {}
    __device__ __forceinline__ void done(const Unit&) const {}
};
struct CountedOrder : StaticOrder {
    const unsigned* ready; unsigned need; unsigned* tmo;
    __device__ __forceinline__ void a_ready(const Unit& u) const {
        if (threadIdx.x < 64) {
            const unsigned long long t0 = __builtin_amdgcn_s_memrealtime(); unsigned polls = 0;
            while ((unsigned)__builtin_amdgcn_readfirstlane(__hip_atomic_load(ready + 64 * u.pm, __ATOMIC_RELAXED, __HIP_MEMORY_SCOPE_AGENT)) < need) {
                if ((++polls & 255u) == 0u && __builtin_amdgcn_readfirstlane(__hip_atomic_load(tmo, __ATOMIC_RELAXED, __HIP_MEMORY_SCOPE_AGENT)) != 0u) break;
                if (__builtin_amdgcn_s_memrealtime() - t0 > 2000000ull) {
                    if (threadIdx.x == 0) { unsigned expect = 0u; __hip_atomic_compare_exchange_strong(tmo + 1, &expect, 0x600u | (unsigned)(u.pm & 0xff), __ATOMIC_RELAXED, __ATOMIC_RELAXED, __HIP_MEMORY_SCOPE_AGENT); __hip_atomic_store(tmo, 1u, __ATOMIC_RELAXED, __HIP_MEMORY_SCOPE_AGENT); }
                    break; }
                __builtin_amdgcn_s_sleep(2); }
            __builtin_amdgcn_fence(__ATOMIC_ACQUIRE, "agent");
            asm volatile("s_waitcnt vmcnt(0)" ::: "memory");
        }
#if !defined(BROKEN_HOOK_NO_BARRIER)
        asm volatile("" ::: "memory"); __builtin_amdgcn_s_barrier(); asm volatile("" ::: "memory");
#endif
    }
};
struct EpiF32 {
    static constexpr bool PERM = false, AFTER_DRAIN = false;
    float* C; int ldc; const float* bias;
    __device__ __forceinline__ void operator()(const f32x4 (&acc)[2][2][4][2], const Unit& u, int wr, int wc, int fr, int fq) const {
        const int row0 = u.pm * BM + wr * 64 + fr, col0 = u.pn * BM + wc * 32 + 4 * fq;
        f32x4 bv[2][2];
#pragma unroll
        for (int bj = 0; bj < 2; ++bj)
#pragma unroll
            for (int n = 0; n < 2; ++n) bv[bj][n] = bias ? *(const f32x4*)(bias + col0 + bj * HALF + n * 16) : (f32x4){0.f, 0.f, 0.f, 0.f};
#pragma unroll
        for (int ai = 0; ai < 2; ++ai)
#pragma unroll
            for (int m = 0; m < 4; ++m) { float* rowp = C + (size_t)(row0 + ai * HALF + m * 16) * ldc + col0;
#pragma unroll
                for (int bj = 0; bj < 2; ++bj)
#pragma unroll
                    for (int n = 0; n < 2; ++n) *(f32x4*)(rowp + bj * HALF + n * 16) = acc[ai][bj][m][n] + bv[bj][n]; }
    }
};
template <class Epi, class Sched, bool STAMP = false>
__device__ __forceinline__ void gemm_phase(PG8_LAS unsigned char* lds, const Gemm g, const Sched& S, const Epi& E, unsigned long long* stamps) {
    int tid_ = threadIdx.x; asm volatile("" : "+v"(tid_));
    const int tid = tid_, wid = __builtin_amdgcn_readfirstlane(tid >> 6), lane = tid & 63, wr = wid >> 2, wc = wid & 3, fr = lane & 15, fq = lane >> 4;
    const int K = g.K, nt = K / BK;
    int ts_lo = 0, ts_hi = 0, nts = 0; const unsigned long long rt_entry = STAMP ? (unsigned long long)wall_clock64() : 0ull;
#define PG8_STAMP() do { if (STAMP && wid == 0 && nts < 64) { const unsigned long long _c = (unsigned long long)clock64(); \
        ts_lo = (lane == nts) ? (int)(unsigned)_c : ts_lo; ts_hi = (lane == nts) ? (int)(unsigned)(_c >> 32) : ts_hi; ++nts; } } while (0)
    PG8_STAMP();
    unsigned voffA[2], voffB[2];
#pragma unroll
    for (int i = 0; i < 2; ++i) { int R, C; stage_rc(tid * 16 + i * 8192, R, C); const int Rb = Epi::PERM ? ((R & ~31) + perm32(R & 31)) : R;
        voffA[i] = (unsigned)(R * K + C) * 2u; voffB[i] = (unsigned)(Rb * K + C) * 2u; }
    const size_t kstep = (size_t)(BK * 2);
    const size_t hstep = (size_t)HALF * K * 2;
    const size_t tstep = 2 * hstep;
    const unsigned ldsw = (unsigned)wid * 1024u;
    const int aoff = lds_byte(wr * 64 + fr, fq * 8), boff = lds_byte(wc * 32 + fr, fq * 8);
#define PG8_SA(b, h) (((b) * 2 + (h)) * HTB)
#define PG8_SB(b, h) ((4 + (b) * 2 + (h)) * HTB)
#define PG8_STAGE(bufoff, gbase, voff) do { _Pragma("unroll") for (int _i = 0; _i < 2; ++_i) \
        __builtin_amdgcn_global_load_lds((const unsigned*)((const char*)(gbase) + (voff)[_i]), (PG8_LAS unsigned*)(lds + (bufoff) + ldsw + _i * 8192), 16, 0, 0); } while (0)
#define PG8_LDA(dst, b, h) do { _Pragma("unroll") for (int m = 0; m < 4; ++m) _Pragma("unroll") for (int k = 0; k < 2; ++k) dst[m][k] = *(const PG8_LAS bf16x8*)(lds + PG8_SA(b, h) + aoff + m * 2048 + k * 1024); } while (0)
#define PG8_LDB(dst, b, h) do { _Pragma("unroll") for (int n = 0; n < 2; ++n) _Pragma("unroll") for (int k = 0; k < 2; ++k) dst[n][k] = *(const PG8_LAS bf16x8*)(lds + PG8_SB(b, h) + boff + n * 2048 + k * 1024); } while (0)
#define PG8_MMA(ai, bj, At, Bt) do { __builtin_amdgcn_s_setprio(1); _Pragma("unroll") for (int m = 0; m < 4; ++m) _Pragma("unroll") for (int n = 0; n < 2; ++n) _Pragma("unroll") for (int k = 0; k < 2; ++k) \
        acc[ai][bj][m][n] = __builtin_amdgcn_mfma_f32_16x16x32_bf16(Bt[n][k], At[m][k], acc[ai][bj][m][n], 0, 0, 0); __builtin_amdgcn_s_setprio(0); } while (0)
#define PG8_WAIT_V(n) asm volatile("s_waitcnt vmcnt(" #n ")" ::: "memory")
#define PG8_WAIT_L(n) asm volatile("s_waitcnt lgkmcnt(" #n ")" ::: "memory")
#define PG8_BAR __builtin_amdgcn_s_barrier()
#define PG8_SCHED __builtin_amdgcn_sched_barrier(0)
    Unit cur, nxt; int ui = 0;
    if (!S.next(0, cur)) return;
    f32x4 acc[2][2][4][2];
#pragma unroll
    for (int a = 0; a < 2; ++a)
#pragma unroll
        for (int b = 0; b < 2; ++b)
#pragma unroll
            for (int m = 0; m < 4; ++m)
#pragma unroll
                for (int n = 0; n < 2; ++n) acc[a][b][m][n] = (f32x4){0.f, 0.f, 0.f, 0.f};
    bf16x8 At[4][2], B0[2][2], B1[2][2];
    const char* cA = (const char*)g.A + (size_t)cur.pm * tstep; const char* cB = (const char*)g.Bt + (size_t)cur.pn * tstep;
    S.a_ready(cur);
    PG8_STAGE(PG8_SB(0, 0), cB, voffB); PG8_STAGE(PG8_SA(0, 0), cA, voffA); PG8_STAGE(PG8_SB(0, 1), cB + hstep, voffB); PG8_STAGE(PG8_SA(0, 1), cA + hstep, voffA);
    if (wr == 1) PG8_BAR;
    PG8_WAIT_V(4); PG8_BAR;
    PG8_STAGE(PG8_SB(1, 0), cB + kstep, voffB); PG8_STAGE(PG8_SA(1, 0), cA + kstep, voffA); PG8_STAGE(PG8_SB(1, 1), cB + hstep + kstep, voffB);
    PG8_WAIT_V(6); PG8_BAR;
    PG8_STAMP();
    for (;;) {
        const bool has_next = S.next(ui + 1, nxt);
        const char* nA = has_next ? (const char*)g.A + (size_t)nxt.pm * tstep : cA; const char* nB = has_next ? (const char*)g.Bt + (size_t)nxt.pn * tstep : cB;
        for (int t = 0; t < nt; t += 2) {
            const bool last = (t == nt - 2);
            const char* a1 = cA + (size_t)(t + 1) * kstep;
            const char* a2 = last ? nA : cA + (size_t)(t + 2) * kstep; const char* b2 = last ? nB : cB + (size_t)(t + 2) * kstep;
            const char* a3 = a2 + kstep; const char* b3 = b2 + kstep;
            if (last && has_next) S.a_ready(nxt);
            PG8_LDB(B0, 0, 0); PG8_SCHED; PG8_LDA(At, 0, 0); PG8_STAGE(PG8_SA(1, 1), a1 + hstep, voffA);
            PG8_WAIT_L(8); PG8_BAR; PG8_WAIT_L(0); PG8_MMA(0, 0, At, B0); PG8_BAR; PG8_SCHED;
            PG8_LDB(B1, 0, 1); PG8_STAGE(PG8_SB(0, 0), b2, voffB);
            PG8_BAR; PG8_WAIT_L(0); PG8_MMA(0, 1, At, B1); PG8_BAR;
            PG8_LDA(At, 0, 1); PG8_STAGE(PG8_SA(0, 0), a2, voffA);
            PG8_BAR; PG8_WAIT_L(0); PG8_MMA(1, 0, At, B0); PG8_BAR; PG8_SCHED;
            PG8_STAGE(PG8_SB(0, 1), b2 + hstep, voffB);
            PG8_WAIT_V(6); PG8_BAR; PG8_MMA(1, 1, At, B1); PG8_BAR;
            PG8_LDB(B0, 1, 0); PG8_SCHED; PG8_LDA(At, 1, 0); PG8_STAGE(PG8_SA(0, 1), a2 + hstep, voffA);
            PG8_WAIT_L(8); PG8_BAR; PG8_WAIT_L(0); PG8_MMA(0, 0, At, B0); PG8_BAR; PG8_SCHED;
            PG8_LDB(B1, 1, 1); PG8_STAGE(PG8_SB(1, 0), b3, voffB);
            PG8_BAR; PG8_WAIT_L(0); PG8_MMA(0, 1, At, B1); PG8_BAR;
            PG8_LDA(At, 1, 1); PG8_STAGE(PG8_SA(1, 0), a3, voffA);
            PG8_BAR; PG8_WAIT_L(0); PG8_MMA(1, 0, At, B0); PG8_BAR; PG8_SCHED;
            PG8_STAGE(PG8_SB(1, 1), b3 + hstep, voffB);
            PG8_WAIT_V(6); PG8_BAR; PG8_MMA(1, 1, At, B1); PG8_BAR;
        }
        PG8_STAMP();
        if constexpr (!Epi::AFTER_DRAIN) { E(acc, cur, wr, wc, fr, fq); S.done(cur); }
        PG8_STAMP();
        if (!has_next) break;
#pragma unroll
        for (int a = 0; a < 2; ++a)
#pragma unroll
            for (int b = 0; b < 2; ++b)
#pragma unroll
                for (int m = 0; m < 4; ++m)
#pragma unroll
                    for (int n = 0; n < 2; ++n) acc[a][b][m][n] = (f32x4){0.f, 0.f, 0.f, 0.f};
        cur = nxt; cA = nA; cB = nB; ++ui;
    }
    PG8_WAIT_V(0);
    if (wr == 0) PG8_BAR;
    PG8_BAR;
    if constexpr (Epi::AFTER_DRAIN) { E.fused(acc, cur, wr, wc, fr, fq, lds, wid, lane); S.done(cur); }
    PG8_STAMP();
    if (STAMP && wid == 0) { stamps[lane] = lane < nts ? (((unsigned long long)(unsigned)ts_hi << 32) | (unsigned)ts_lo) : 0ull;
        if (lane == 62) stamps[62] = rt_entry; if (lane == 63) stamps[63] = (unsigned long long)wall_clock64(); }
#undef PG8_STAMP
#undef PG8_SA
#undef PG8_SB
#undef PG8_STAGE
#undef PG8_LDA
#undef PG8_LDB
#undef PG8_MMA
#undef PG8_WAIT_V
#undef PG8_WAIT_L
#undef PG8_BAR
#undef PG8_SCHED
}
template <class Epi, class Sched, class Gat, bool STAMP = false>
__device__ __forceinline__ void gemm_phase_gather(PG8_LAS unsigned char* lds, const Gemm g, const Sched& S, const Epi& E, const Gat& G, unsigned long long* stamps) {
    int tid_ = threadIdx.x; asm volatile("" : "+v"(tid_));
    const int tid = tid_, wid = __builtin_amdgcn_readfirstlane(tid >> 6), lane = tid & 63, wr = wid >> 2, wc = wid & 3, fr = lane & 15, fq = lane >> 4;
    const int K = g.K, nt = K / BK;
    int ts_lo = 0, ts_hi = 0, nts = 0; const unsigned long long rt_entry = STAMP ? (unsigned long long)wall_clock64() : 0ull;
#define PG8_STAMP() do { if (STAMP && wid == 0 && nts < 64) { const unsigned long long _c = (unsigned long long)clock64(); \
        ts_lo = (lane == nts) ? (int)(unsigned)_c : ts_lo; ts_hi = (lane == nts) ? (int)(unsigned)(_c >> 32) : ts_hi; ++nts; } } while (0)
    PG8_STAMP();
    unsigned voffA[2], voffB[2]; int RA[2]; unsigned CA2[2];
#pragma unroll
    for (int i = 0; i < 2; ++i) { int R, C; stage_rc(tid * 16 + i * 8192, R, C); const int Rb = Epi::PERM ? ((R & ~31) + perm32(R & 31)) : R;
        voffA[i] = (unsigned)(R * K + C) * 2u; voffB[i] = (unsigned)(Rb * K + C) * 2u; RA[i] = R; CA2[i] = (unsigned)C * 2u; }
    const size_t kstep = (size_t)(BK * 2);
    const size_t hstep = (size_t)HALF * K * 2;
    const size_t tstep = 2 * hstep;
    const unsigned ldsw = (unsigned)wid * 1024u;
    const int aoff = lds_byte(wr * 64 + fr, fq * 8), boff = lds_byte(wc * 32 + fr, fq * 8);
#define PG8_SA(b, h) (((b) * 2 + (h)) * HTB)
#define PG8_SB(b, h) ((4 + (b) * 2 + (h)) * HTB)
#define PG8_STAGE(bufoff, gbase, voff) do { _Pragma("unroll") for (int _i = 0; _i < 2; ++_i) \
        __builtin_amdgcn_global_load_lds((const unsigned*)((const char*)(gbase) + (voff)[_i]), (PG8_LAS unsigned*)(lds + (bufoff) + ldsw + _i * 8192), 16, 0, 0); } while (0)
#define PG8_LDA(dst, b, h) do { _Pragma("unroll") for (int m = 0; m < 4; ++m) _Pragma("unroll") for (int k = 0; k < 2; ++k) dst[m][k] = *(const PG8_LAS bf16x8*)(lds + PG8_SA(b, h) + aoff + m * 2048 + k * 1024); } while (0)
#define PG8_LDB(dst, b, h) do { _Pragma("unroll") for (int n = 0; n < 2; ++n) _Pragma("unroll") for (int k = 0; k < 2; ++k) dst[n][k] = *(const PG8_LAS bf16x8*)(lds + PG8_SB(b, h) + boff + n * 2048 + k * 1024); } while (0)
#define PG8_MMA(ai, bj, At, Bt) do { __builtin_amdgcn_s_setprio(1); _Pragma("unroll") for (int m = 0; m < 4; ++m) _Pragma("unroll") for (int n = 0; n < 2; ++n) _Pragma("unroll") for (int k = 0; k < 2; ++k) \
        acc[ai][bj][m][n] = __builtin_amdgcn_mfma_f32_16x16x32_bf16(Bt[n][k], At[m][k], acc[ai][bj][m][n], 0, 0, 0); __builtin_amdgcn_s_setprio(0); } while (0)
#define PG8_WAIT_V(n) asm volatile("s_waitcnt vmcnt(" #n ")" ::: "memory")
#define PG8_WAIT_L(n) asm volatile("s_waitcnt lgkmcnt(" #n ")" ::: "memory")
#define PG8_BAR __builtin_amdgcn_s_barrier()
#define PG8_SCHED __builtin_amdgcn_sched_barrier(0)
    Unit cur, nxt; int ui = 0;
    if (!S.next(0, cur)) return;
    f32x4 acc[2][2][4][2];
#pragma unroll
    for (int a = 0; a < 2; ++a)
#pragma unroll
        for (int b = 0; b < 2; ++b)
#pragma unroll
            for (int m = 0; m < 4; ++m)
#pragma unroll
                for (int n = 0; n < 2; ++n) acc[a][b][m][n] = (f32x4){0.f, 0.f, 0.f, 0.f};
    bf16x8 At[4][2], B0[2][2], B1[2][2];
    const char* Ab = (const char*)g.A; const char* cB = (const char*)(cur.pn < g.pn_split ? g.Bt2 : g.Bt) + (size_t)cur.pn * tstep;
    unsigned gc0[2], gc1[2], gn0[2], gn1[2];
#pragma unroll
    for (int i = 0; i < 2; ++i) { gc0[i] = G.rowoff(cur, RA[i]) + CA2[i]; gc1[i] = G.rowoff(cur, RA[i] + 128) + CA2[i]; }
    (void)voffA;
    S.a_ready(cur);
    PG8_STAGE(PG8_SB(0, 0), cB, voffB); PG8_STAGE(PG8_SA(0, 0), Ab, gc0); PG8_STAGE(PG8_SB(0, 1), cB + hstep, voffB); PG8_STAGE(PG8_SA(0, 1), Ab, gc1);
    if (wr == 1) PG8_BAR;
    PG8_WAIT_V(4); PG8_BAR;
    PG8_STAGE(PG8_SB(1, 0), cB + kstep, voffB); PG8_STAGE(PG8_SA(1, 0), Ab + kstep, gc0); PG8_STAGE(PG8_SB(1, 1), cB + hstep + kstep, voffB);
    PG8_WAIT_V(6); PG8_BAR;
    PG8_STAMP();
    for (;;) {
        const bool has_next = S.next(ui + 1, nxt);
        const char* nB = has_next ? (const char*)(nxt.pn < g.pn_split ? g.Bt2 : g.Bt) + (size_t)nxt.pn * tstep : cB;
#pragma unroll
        for (int i = 0; i < 2; ++i) { gn0[i] = has_next ? G.rowoff(nxt, RA[i]) + CA2[i] : gc0[i]; gn1[i] = has_next ? G.rowoff(nxt, RA[i] + 128) + CA2[i] : gc1[i]; }
        for (int t = 0; t < nt; t += 2) {
            const bool last = (t == nt - 2);
            const char* a1 = Ab + (size_t)(t + 1) * kstep;
            const char* a2 = last ? Ab : Ab + (size_t)(t + 2) * kstep; const char* b2 = last ? nB : cB + (size_t)(t + 2) * kstep;
            unsigned g2a[2], g2b[2];
#pragma unroll
            for (int i = 0; i < 2; ++i) { g2a[i] = last ? gn0[i] : gc0[i]; g2b[i] = last ? gn1[i] : gc1[i]; }
            const char* a3 = a2 + kstep; const char* b3 = b2 + kstep;
            if (last && has_next) S.a_ready(nxt);
            PG8_LDB(B0, 0, 0); PG8_SCHED; PG8_LDA(At, 0, 0); PG8_STAGE(PG8_SA(1, 1), a1, gc1);
            PG8_WAIT_L(8); PG8_BAR; PG8_WAIT_L(0); PG8_MMA(0, 0, At, B0); PG8_BAR; PG8_SCHED;
            PG8_LDB(B1, 0, 1); PG8_STAGE(PG8_SB(0, 0), b2, voffB);
            PG8_BAR; PG8_WAIT_L(0); PG8_MMA(0, 1, At, B1); PG8_BAR;
            PG8_LDA(At, 0, 1); PG8_STAGE(PG8_SA(0, 0), a2, g2a);
            PG8_BAR; PG8_WAIT_L(0); PG8_MMA(1, 0, At, B0); PG8_BAR; PG8_SCHED;
            PG8_STAGE(PG8_SB(0, 1), b2 + hstep, voffB);
            PG8_WAIT_V(6); PG8_BAR; PG8_MMA(1, 1, At, B1); PG8_BAR;
            PG8_LDB(B0, 1, 0); PG8_SCHED; PG8_LDA(At, 1, 0); PG8_STAGE(PG8_SA(0, 1), a2, g2b);
            PG8_WAIT_L(8); PG8_BAR; PG8_WAIT_L(0); PG8_MMA(0, 0, At, B0); PG8_BAR; PG8_SCHED;
            PG8_LDB(B1, 1, 1); PG8_STAGE(PG8_SB(1, 0), b3, voffB);
            PG8_BAR; PG8_WAIT_L(0); PG8_MMA(0, 1, At, B1); PG8_BAR;
            PG8_LDA(At, 1, 1); PG8_STAGE(PG8_SA(1, 0), a3, g2a);
            PG8_BAR; PG8_WAIT_L(0); PG8_MMA(1, 0, At, B0); PG8_BAR; PG8_SCHED;
            PG8_STAGE(PG8_SB(1, 1), b3 + hstep, voffB);
            PG8_WAIT_V(6); PG8_BAR; PG8_MMA(1, 1, At, B1); PG8_BAR;
        }
        PG8_STAMP();
        if constexpr (!Epi::AFTER_DRAIN) { E(acc, cur, wr, wc, fr, fq); S.done(cur); }
        PG8_STAMP();
        if (!has_next) break;
#pragma unroll
        for (int a = 0; a < 2; ++a)
#pragma unroll
            for (int b = 0; b < 2; ++b)
#pragma unroll
                for (int m = 0; m < 4; ++m)
#pragma unroll
                    for (int n = 0; n < 2; ++n) acc[a][b][m][n] = (f32x4){0.f, 0.f, 0.f, 0.f};
        cur = nxt; cB = nB; ++ui;
#pragma unroll
        for (int i = 0; i < 2; ++i) { gc0[i] = gn0[i]; gc1[i] = gn1[i]; }
    }
    PG8_WAIT_V(0);
    if (wr == 0) PG8_BAR;
    PG8_BAR;
    if constexpr (Epi::AFTER_DRAIN) { E.fused(acc, cur, wr, wc, fr, fq, lds, wid, lane); S.done(cur); }
    PG8_STAMP();
    if (STAMP && wid == 0) { stamps[lane] = lane < nts ? (((unsigned long long)(unsigned)ts_hi << 32) | (unsigned)ts_lo) : 0ull;
        if (lane == 62) stamps[62] = rt_entry; if (lane == 63) stamps[63] = (unsigned long long)wall_clock64(); }
#undef PG8_STAMP
#undef PG8_SA
#undef PG8_SB
#undef PG8_STAGE
#undef PG8_LDA
#undef PG8_LDB
#undef PG8_MMA
#undef PG8_WAIT_V
#undef PG8_WAIT_L
#undef PG8_BAR
#undef PG8_SCHED
}
}

constexpr size_t WS_WINT = 284 * MB;
constexpr size_t WS_WOUTT = 1 * MB;
constexpr int NPAD_IN = 4352;
DI void transpose_tile(const float* W, int ldw, int k0, int n0, int nvalid, bfr* WT, int ldt, char* smem) {
  short* T = (short*)smem;
  const int tid = VT;
  __syncthreads();
  {
    const int r = tid >> 2, c4 = tid & 3;
#pragma unroll
    for (int q = 0; q < 4; ++q) {
      const int n = n0 + 16 * c4 + 4 * q;
      f32x4 v = {0.f, 0.f, 0.f, 0.f};
      if (n < nvalid) v = *(const f32x4*)(W + (size_t)(k0 + r) * ldw + n);
#pragma unroll
      for (int e = 0; e < 4; ++e) T[r * 66 + 16 * c4 + 4 * q + e] = (short)f2bf(v[e]);
    }
  }
  __syncthreads();
  {
    const int n = tid >> 2, kq = tid & 3;
    unsigned wv[8];
#pragma unroll
    for (int e = 0; e < 8; ++e) wv[e] = ((unsigned)(unsigned short)T[(16 * kq + 2 * e) * 66 + n]) | (((unsigned)(unsigned short)T[(16 * kq + 2 * e + 1) * 66 + n]) << 16);
    bfr* dst = WT + (size_t)(n0 + n) * ldt + k0 + 16 * kq;
    *(uint4*)dst = uint4{wv[0], wv[1], wv[2], wv[3]};
    *(uint4*)(dst + 8) = uint4{wv[4], wv[5], wv[6], wv[7]};
  }
}
template <int LDC, int NVALID> struct EpiBf16T {
  static constexpr bool PERM = true, AFTER_DRAIN = false;
  bfr* O;
  DI void operator()(const pg8::f32x4 (&acc)[2][2][4][2], const pg8::Unit& u, int wr, int wc, int fr, int fq) const {
    const int row0 = u.pm * 256 + wr * 64 + fr, col0 = u.pn * 256 + wc * 32 + 8 * fq;
#pragma unroll
    for (int ai = 0; ai < 2; ++ai)
#pragma unroll
      for (int m = 0; m < 4; ++m) {
        bfr* rowp = O + (size_t)(row0 + ai * 128 + m * 16) * LDC + col0;
#pragma unroll
        for (int bj = 0; bj < 2; ++bj) {
          if (col0 + bj * 128 < NVALID) {
            const pg8::f32x4 v0 = acc[ai][bj][m][0], v1 = acc[ai][bj][m][1];
            *(uint4*)(rowp + bj * 128) = uint4{pack2(v0[0], v0[1]), pack2(v0[2], v0[3]), pack2(v1[0], v1[1]), pack2(v1[2], v1[3])};
          }
        }
      }
  }
};
constexpr int GU_EARLY_E = 16, GU_EARLY_ITEMS = GU_EARLY_E * 64;
DI void phase_moe_convert_gu(CParams& P, int bid, int nb, char* smem, int it_lo, int it_hi);
DI void phase_pgemm8(CParams& P, char* smem_all) {
  pg8::Gemm g{(const pg8::bf16_t*)(P.ws + WS_H), (const pg8::bf16_t*)(P.ws + WS_WINT), T_ALL, NPAD_IN, DM};
  pg8::StaticOrder S; S.init(T_ALL, NPAD_IN, (int)gridDim.x, (int)blockIdx.x);
  typedef EpiBf16T<DIN, DIN> EpiP;
  EpiP E{(bfr*)(P.ws + WS_P)};
  pg8::gemm_phase<EpiP, pg8::StaticOrder>((PG8_LAS unsigned char*)smem_all, g, S, E, nullptr);
  const int G_ = (int)gridDim.x, nunits = (T_ALL / 256) * (NPAD_IN / 256);
  const int rounds = (nunits + G_ - 1) / G_, first_idle = nunits - (rounds - 1) * G_;
  const int half = __builtin_amdgcn_readfirstlane((int)(threadIdx.x >> 8));
  if (first_idle < G_) { if ((int)blockIdx.x >= first_idle) phase_moe_convert_gu(P, ((int)blockIdx.x - first_idle) * 2 + half, (G_ - first_idle) * 2, smem_all + half * 78080, 0, GU_EARLY_ITEMS); }
  else phase_moe_convert_gu(P, (int)blockIdx.x * 2 + half, G_ * 2, smem_all + half * 78080, 0, GU_EARLY_ITEMS);
}
DI void phase_outproj8(CParams& P, char* smem_all) {
  pg8::Gemm g{(const pg8::bf16_t*)(P.ws + WS_MIX), (const pg8::bf16_t*)(P.ws + WS_WOUTT), T_LAT, DM, DM};
  pg8::StaticOrder S; S.init(T_LAT, DM, (int)gridDim.x, (int)blockIdx.x);
  typedef EpiBf16T<DM, DM> EpiY;
  EpiY E{(bfr*)(P.ws + WS_Y)};
  pg8::gemm_phase<EpiY, pg8::StaticOrder>((PG8_LAS unsigned char*)smem_all, g, S, E, nullptr);
}


constexpr size_t WS_BTGU = 350 * MB;
constexpr size_t WS_BTD = 284 * MB;
constexpr size_t WS_HID8 = 138 * MB;
constexpr size_t WS_MOUT8 = 42 * MB;
constexpr int TAB_LDS_OFF = 131072 + 1024;

DI void transpose_quad(const float* W, int ldw, int k0, int n0, bfr* WT, int ldt, int dr0, int dr1, int dr2, int dr3, char* smem, int nvalid = 1 << 30) {
  short* T = (short*)smem;
  const int tid = VT;
  const int r = tid >> 2, c4 = tid & 3;
  f32x4 v[4][4];
#pragma unroll
  for (int j = 0; j < 4; ++j)
#pragma unroll
    for (int q = 0; q < 4; ++q) { const int n_ = n0 + j * 64 + 16 * c4 + 4 * q; v[j][q] = n_ < nvalid ? *(const f32x4*)(W + (size_t)(k0 + r) * ldw + n_) : f32x4{0.f, 0.f, 0.f, 0.f}; }
  __syncthreads();
#pragma unroll
  for (int j = 0; j < 4; ++j)
#pragma unroll
    for (int q = 0; q < 4; ++q)
#pragma unroll
      for (int e = 0; e < 4; ++e) T[j * 64 * 66 + r * 66 + 16 * c4 + 4 * q + e] = (short)f2bf(v[j][q][e]);
  __syncthreads();
  const int n = tid >> 2, kq = tid & 3;
#pragma unroll
  for (int j = 0; j < 4; ++j) {
    unsigned wv[8];
#pragma unroll
    for (int e = 0; e < 8; ++e) wv[e] = ((unsigned)(unsigned short)T[j * 64 * 66 + (16 * kq + 2 * e) * 66 + n]) | (((unsigned)(unsigned short)T[j * 64 * 66 + (16 * kq + 2 * e + 1) * 66 + n]) << 16);
    const int dr = j == 0 ? dr0 : j == 1 ? dr1 : j == 2 ? dr2 : dr3;
    bfr* dst = WT + (size_t)(dr + n) * ldt + k0 + 16 * kq;
    *(uint4*)dst = uint4{wv[0], wv[1], wv[2], wv[3]};
    *(uint4*)(dst + 8) = uint4{wv[4], wv[5], wv[6], wv[7]};
  }
}
DI void phase_moe_convert_gu(CParams& P, int bid, int nb, char* smem, int it_lo, int it_hi) {
  for (int it = it_lo + bid; it < it_hi; it += nb) {
    const int e = it >> 6, s = it & 63;
    const int isup = s >> 5, kt = (s & 31) >> 1, nq = s & 1;
    const float* W = (isup ? P.in[30] : P.in[29]) + (size_t)e * DM * DEXP;
    bfr* WT = (e < GU_EARLY_E ? (bfr*)P.out : (bfr*)(P.ws + WS_BTGU)) + (size_t)e * 1024 * 1024;
    const int b = nq * 4;
    transpose_quad(W, DEXP, kt * 64, nq * 256, WT, 1024,
                   ((b + 0) >> 1) * 256 + isup * 128 + ((b + 0) & 1) * 64, ((b + 1) >> 1) * 256 + isup * 128 + ((b + 1) & 1) * 64,
                   ((b + 2) >> 1) * 256 + isup * 128 + ((b + 2) & 1) * 64, ((b + 3) >> 1) * 256 + isup * 128 + ((b + 3) & 1) * 64, smem);
  }
}
constexpr int CONVD_ITEMS = 64 * 32, CONVD_SPLIT = 1152;
DI void phase_moe_convert_d(CParams& P, int bid, int nb, char* smem, int it_lo, int it_hi) {
  for (int it = it_lo + bid; it < it_hi; it += nb) {
    const int e = it >> 5, s2 = it & 31, kt = s2 >> 2, nq = s2 & 3;
    const float* W = P.in[31] + (size_t)e * DEXP * DM;
    bfr* WT = (bfr*)(P.ws + WS_BTD) + (size_t)e * 1024 * 512;
    transpose_quad(W, DM, kt * 64, nq * 256, WT, 512, nq * 256, nq * 256 + 64, nq * 256 + 128, nq * 256 + 192, smem);
  }
}
constexpr int XT_EXP = 80, XT_LP = 144;
DI void moe_block_table256(CParams& P, int* tab  ) {
  const int* cnt = (const int*)(P.ws + WS_CNT);
  __syncthreads();
  const int t = tx_();
  if (t < 64) {
    const int nr = (cnt[t] + 255) >> 8;
    int incl = nr;
#pragma unroll
    for (int o = 1; o < 64; o <<= 1) { int u = __shfl_up(incl, o); if (t >= o) incl += u; }
    tab[t + 1] = incl;
    if (t == 0) tab[0] = 0;
    int rank = 0;
#pragma unroll
    for (int o = 0; o < 64; ++o) { const int v = __builtin_amdgcn_readlane(nr, o); rank += (v > nr || (v == nr && o < t)) ? 1 : 0; }
    { const int k = rank >> 3, pos = rank & 7, x = (k & 1) ? 7 - pos : pos; tab[XT_EXP + x * 8 + k] = t; }
    __builtin_amdgcn_fence(__ATOMIC_RELEASE, "wavefront"); asm volatile("s_waitcnt lgkmcnt(0)" ::: "memory");
    const int e = tab[XT_EXP + t];
    int p = __shfl(nr, e);
#pragma unroll
    for (int o = 1; o < 8; o <<= 1) { int u = __shfl_up(p, o); if ((t & 7) >= o) p += u; }
    tab[XT_LP + (t >> 3) * 9 + (t & 7) + 1] = p;
    if ((t & 7) == 0) tab[XT_LP + (t >> 3) * 9] = 0;
  }
  __syncthreads();
}
struct MoeOrder {
  const int* tab; int nunits, G, c;
  DI bool next(int i, pg8::Unit& u) const {
    if ((G & 7) == 0) {
      const int x = c & 7, JW = G >> 3, v = i * JW + (c >> 3), lr = v >> 2;
      const int* lp = tab + XT_LP + x * 9;
      if (lr >= lp[8]) return false;
      int k = 0; while (lp[k + 1] <= lr) ++k;
      const int e = tab[XT_EXP + x * 8 + k];
      u.pm = tab[e] + lr - lp[k]; u.pn = e * 4 + (v & 3); return true;
    }
    const int L = i * G + c; if (L >= nunits) return false;
    const int rb = L >> 2; int e = 0; while (tab[e + 1] <= rb) ++e;
    u.pm = rb; u.pn = e * 4 + (L & 3); return true;
  }
  DI void a_ready(const pg8::Unit&) const {}
  DI void done(const pg8::Unit&) const {}
};
struct EpiHid {
  static constexpr bool PERM = true, AFTER_DRAIN = false;
  bfr* H;
  DI void operator()(const pg8::f32x4 (&acc)[2][2][4][2], const pg8::Unit& u, int wr, int wc, int fr, int fq) const {
    const int row0 = u.pm * 256 + wr * 64 + fr, col0 = (u.pn & 3) * 128 + wc * 32 + 8 * fq;
#pragma unroll
    for (int ai = 0; ai < 2; ++ai)
#pragma unroll
      for (int m = 0; m < 4; ++m) {
        float hv[8];
#pragma unroll
        for (int n = 0; n < 2; ++n)
#pragma unroll
          for (int j = 0; j < 4; ++j) hv[4 * n + j] = siluf_(acc[ai][0][m][n][j]) * acc[ai][1][m][n][j];
        *(uint4*)(H + (size_t)(row0 + ai * 128 + m * 16) * DEXP + col0) = uint4{pack2(hv[0], hv[1]), pack2(hv[2], hv[3]), pack2(hv[4], hv[5]), pack2(hv[6], hv[7])};
      }
  }
};
struct EpiMout {
  static constexpr bool PERM = true, AFTER_DRAIN = false;
  bfr* O; const int* tab; const int* cnt; const int* list;
  DI void operator()(const pg8::f32x4 (&acc)[2][2][4][2], const pg8::Unit& u, int wr, int wc, int fr, int fq) const {
    const int e = u.pn >> 2, pnl = u.pn & 3;
    const int lrow0 = (u.pm - tab[e]) * 256 + wr * 64 + fr, ce = cnt[e];
    const int col0 = pnl * 256 + wc * 32 + 8 * fq;
#pragma unroll
    for (int ai = 0; ai < 2; ++ai)
#pragma unroll
      for (int m = 0; m < 4; ++m) {
        const int idx = lrow0 + ai * 128 + m * 16;
        if (idx < ce) {
          const int asg = list[e * T_LAT + idx];
          bfr* rowp = O + (size_t)asg * DM + col0;
#pragma unroll
          for (int bj = 0; bj < 2; ++bj) {
            const pg8::f32x4 v0 = acc[ai][bj][m][0], v1 = acc[ai][bj][m][1];
            *(uint4*)(rowp + bj * 128) = uint4{pack2(v0[0], v0[1]), pack2(v0[2], v0[3]), pack2(v1[0], v1[1]), pack2(v1[2], v1[3])};
          }
        }
      }
  }
};
struct MoeGather {
  const int* tab; const int* cnt; const int* list;
  DI unsigned rowoff(const pg8::Unit& u, int r) const {
    const int e = u.pn >> 2, idx = (u.pm - tab[e]) * 256 + r;
    const int tok = idx < cnt[e] ? (list[e * T_LAT + idx] >> 1) : 0;
    return (unsigned)tok * (unsigned)(DM * 2);
  }
};
DI void phase_moe1_8(CParams& P, char* smem_all) {
  int* tab = (int*)(smem_all + TAB_LDS_OFF);
  moe_block_table256(P, tab);
  const int nrb = tab[64];
  pg8::Gemm g{(const pg8::bf16_t*)(P.ws + WS_H2), (const pg8::bf16_t*)(P.ws + WS_BTGU), nrb * 256, 64 * 1024, DM, (const pg8::bf16_t*)P.out, GU_EARLY_E * 4};
  MoeOrder S{tab, nrb * 4, (int)gridDim.x, (int)blockIdx.x};
  EpiHid E{(bfr*)(P.ws + WS_HID8)};
  MoeGather G{tab, (const int*)(P.ws + WS_CNT), (const int*)(P.ws + WS_LIST)};
  pg8::gemm_phase_gather<EpiHid, MoeOrder, MoeGather>((PG8_LAS unsigned char*)smem_all, g, S, E, G, nullptr);
  const int G_ = (int)gridDim.x, nunits = nrb * 4;
  int rank = -1, n_idle = 0;
  if ((G_ & 7) == 0) {
    const int JW = G_ >> 3, x = (int)blockIdx.x & 7, j = (int)blockIdx.x >> 3;
    int rmax = 0;
#pragma unroll
    for (int xx = 0; xx < 8; ++xx) { const int r_ = (4 * tab[XT_LP + xx * 9 + 8] + JW - 1) / JW; rmax = r_ > rmax ? r_ : rmax; }
#pragma unroll
    for (int xx = 0; xx < 8; ++xx) { int fi = 4 * tab[XT_LP + xx * 9 + 8] - (rmax - 1) * JW; fi = fi < 0 ? 0 : (fi > JW ? JW : fi);
      if (xx == x && j >= fi) rank = n_idle + (j - fi);
      n_idle += JW - fi; }
  } else {
    const int rounds = (nunits + G_ - 1) / G_, first_idle = nunits - (rounds - 1) * G_;
    if (first_idle < G_) { n_idle = G_ - first_idle; if ((int)blockIdx.x >= first_idle) rank = (int)blockIdx.x - first_idle; }
  }
  if (n_idle == 0) { n_idle = G_; rank = (int)blockIdx.x; }
  rank = __builtin_amdgcn_readfirstlane(rank); n_idle = __builtin_amdgcn_readfirstlane(n_idle);
  if (rank >= 0) {
    const int half = __builtin_amdgcn_readfirstlane((int)(threadIdx.x >> 8));
    phase_moe_convert_d(P, rank * 2 + half, n_idle * 2, smem_all + half * 78080, CONVD_SPLIT, CONVD_ITEMS);
  }
}
DI void phase_moe2_8(CParams& P, char* smem_all) {
  int* tab = (int*)(smem_all + TAB_LDS_OFF);
  moe_block_table256(P, tab);
  const int nrb = tab[64];
  pg8::Gemm g{(const pg8::bf16_t*)(P.ws + WS_HID8), (const pg8::bf16_t*)(P.ws + WS_BTD), nrb * 256, 64 * 1024, DEXP};
  MoeOrder S{tab, nrb * 4, (int)gridDim.x, (int)blockIdx.x};
  EpiMout E{(bfr*)(P.ws + WS_MOUT8), tab, (const int*)(P.ws + WS_CNT), (const int*)(P.ws + WS_LIST)};
  pg8::gemm_phase<EpiMout, MoeOrder>((PG8_LAS unsigned char*)smem_all, g, S, E, nullptr);
}

#define XB_TMO      128
#define XB_XCNT(j)  (256  + 64 * (j))
#define XB_XSUB(j)  (1280 + 64 * (j))
#define XB_XGEN(j)  (2304 + 64 * (j))
#define XB_TOP      3328
#define XB_TOPGEN   3392
#define XCD_BAR_WORDS 3456
#define XB_SPIN_CAP (1u << 22)
#define LAS __attribute__((address_space(3)))
DI unsigned xb_ld(unsigned* p)              { return __hip_atomic_load(p, __ATOMIC_RELAXED, __HIP_MEMORY_SCOPE_AGENT); }
DI unsigned xb_add(unsigned* p, unsigned v) { return __hip_atomic_fetch_add(p, v, __ATOMIC_RELAXED, __HIP_MEMORY_SCOPE_AGENT); }
DI unsigned xb_xcc_id() { return (unsigned)__builtin_amdgcn_s_getreg((3 << 11) | 20) & 0xFu; }
#define XB_SPIN(cond, bar) do { unsigned _sp = 0; while (cond) { __builtin_amdgcn_s_sleep(1); \
    if ((++_sp & 255u) == 0u) { if (xb_ld(&(bar)[XB_TMO])) break; if (_sp > XB_SPIN_CAP) { atomicAdd(&(bar)[XB_TMO], 1u); break; } } } } while (0)
struct XcdBarrier { unsigned* bar; unsigned x; volatile LAS unsigned* st; };
DI XcdBarrier xcd_barrier_post(unsigned* bar, volatile LAS unsigned* st) {
  XcdBarrier b; b.bar = bar; b.x = xb_xcc_id(); b.st = st;
  if (threadIdx.x == 0) (void)xb_add(&bar[XB_XCNT(b.x)], 1u);
  return b;
}
DI void xcd_barrier_complete(unsigned* bar, unsigned x, unsigned& nloc, unsigned& nx) {
  const unsigned G = gridDim.x * gridDim.y * gridDim.z;
  unsigned sum, cnt, mine, sp = 0u;
  for (;;) {
    sum = 0u; cnt = 0u; mine = 0u;
#pragma unroll
    for (unsigned j = 0; j < 16; ++j) { const unsigned c = xb_ld(&bar[XB_XCNT(j)]); sum += c; cnt += (c > 0u) ? 1u : 0u; mine = (j == x) ? c : mine; }
    if (sum == G) break;
    __builtin_amdgcn_s_sleep(1);
    if ((++sp & 255u) == 0u) { if (xb_ld(&bar[XB_TMO])) break; if (sp > XB_SPIN_CAP) { atomicAdd(&bar[XB_TMO], 1u); break; } }
  }
  nloc = mine > 0u ? mine : 1u; nx = cnt > 0u ? cnt : 1u;
}
DI void xcd_barrier(const XcdBarrier& b) {
  asm volatile("s_waitcnt vmcnt(0)" ::: "memory");
  __syncthreads();
  if (threadIdx.x == 0) {
    unsigned* bar = b.bar;
    __builtin_amdgcn_s_waitcnt(0);
    unsigned nloc = b.st[0], nx = b.st[1];
    if (nloc == 0u) { xcd_barrier_complete(bar, b.x, nloc, nx); b.st[0] = nloc; b.st[1] = nx; }
    const unsigned old = xb_add(&bar[XB_XSUB(b.x)], 1u);
    const unsigned gen = old / nloc;
    if (old + 1u == (gen + 1u) * nloc) {
      __builtin_amdgcn_fence(__ATOMIC_RELEASE, "agent");
      asm volatile("s_waitcnt vmcnt(0)" ::: "memory");
      const unsigned og = xb_add(&bar[XB_TOP], 1u);
      const unsigned tg = og / nx;
      if (og + 1u == (tg + 1u) * nx) xb_add(&bar[XB_TOPGEN], 1u);
      else XB_SPIN(xb_ld(&bar[XB_TOPGEN]) == tg, bar);
      __builtin_amdgcn_fence(__ATOMIC_ACQUIRE, "agent");
      xb_add(&bar[XB_XGEN(b.x)], 1u);
      asm volatile("s_waitcnt vmcnt(0)" ::: "memory");
    } else {
      XB_SPIN(xb_ld(&bar[XB_XGEN(b.x)]) == gen, bar);
      __builtin_amdgcn_fence(__ATOMIC_ACQUIRE, "agent");
      asm volatile("s_waitcnt vmcnt(0)" ::: "memory");
    }
  }
  __syncthreads();
}

namespace cg = cooperative_groups;
constexpr int HALF_LDS = 78080;
constexpr int SMEM_BYTES = 2 * HALF_LDS + 16;
__global__ void __launch_bounds__(NTHR_BLOCK) k_fused(Params Pval) {
  __shared__ __attribute__((aligned(16))) char smem_all[SMEM_BYTES];
  cg::grid_group grid = cg::this_grid();
  CParams* kp0 = (CParams*)__builtin_amdgcn_kernarg_segment_ptr();
#define PH(call) do { CParams* kp_ = kp0; asm volatile("" : "+s"(kp_)); CParams& P = *kp_; \
    int half = __builtin_amdgcn_readfirstlane((int)(threadIdx.x >> 8)); asm volatile("" : "+s"(half)); \
    char* smem = smem_all + half * HALF_LDS; const int bid = blockIdx.x * 2 + half, nb = gridDim.x * 2; (void)smem; (void)bid; (void)nb; call; } while (0)
  volatile LAS unsigned* bst = (volatile LAS unsigned*)(smem_all + SMEM_BYTES - 16);
  if (threadIdx.x < 4) bst[threadIdx.x] = 0u;
  __syncthreads();
  XcdBarrier xb = xcd_barrier_post(Pval.bar, bst);
#define GSYNC() do { if (Pval.use_cg) grid.sync(); else xcd_barrier(xb); } while (0)
  PH(phase_mod(P, bid, nb, smem));
  GSYNC();
  PH(phase_ln1(P, bid, nb));
  GSYNC();
  PH(phase_pgemm8(P, smem_all));
  GSYNC();
  PH(phase_rwprep(P, bid, nb, smem));
  GSYNC();
  PH(for (int it = bid; it < 16 * RW_NSC; it += nb) rw_levelA_item(P, it / RW_NSC, it % RW_NSC, smem));
  PH(for (int it = bid; it < 8 * HG_NSC; it += nb) hg_levelA_item(P, it / HG_NSC, it % HG_NSC, smem));
  GSYNC();
  PH(if (bid < 16) rw_levelB_chain(P, bid, smem); else { hg_levelB(P, bid - 16, nb - 16); phase_moe_convert_d(P, bid - 16, nb - 16, smem, 0, CONVD_SPLIT); });
  GSYNC();
  PH(phase_readout_fused(P, bid, nb));
  GSYNC();
  PH(phase_outproj8(P, smem_all));
  PH(phase_moe_convert_gu(P, bid, nb, smem, GU_EARLY_ITEMS, 64 * 64));
  GSYNC();
  PH(phase_ln2route(P, smem_all));
  GSYNC();
  PH(phase_moe1_8(P, smem_all));
  GSYNC();
  PH(phase_moe2_8(P, smem_all));
  GSYNC();
  PH(phase_final(P, bid, nb));
}

extern "C" void kernel_launch(void* const* d_in, const int* in_sizes, int n_in, void* d_out, int out_size, void* d_ws, size_t ws_size, hipStream_t stream) {
  static int grid_blocks = 0;
  if (!grid_blocks) {
    int dev = 0, cus = 0, per_cu = 0;
    hipGetDevice(&dev);
    hipDeviceGetAttribute(&cus, hipDeviceAttributeMultiprocessorCount, dev);
    hipOccupancyMaxActiveBlocksPerMultiprocessor(&per_cu, k_fused, NTHR_BLOCK, 0);
    if (per_cu > 1) per_cu = 1;
    if (per_cu < 1) per_cu = 1;
    grid_blocks = cus * per_cu;
  }
  Params P{};
  P.bar = (unsigned*)((char*)d_ws + WS_BAR); P.use_cg = 0; P.pad = 0;
  hipMemsetAsync((char*)d_ws + WS_BAR, 0, XCD_BAR_WORDS * 4, stream);
  for (int i = 0; i < 32; ++i) P.in[i] = (const float*)d_in[i];
  P.out = (float*)d_out; P.ws = (char*)d_ws;
  void* args[] = {&P};
  hipError_t e = hipLaunchCooperativeKernel((void*)k_fused, dim3(grid_blocks), dim3(NTHR_BLOCK), args, 0, stream);
  if (e != hipSuccess) fprintf(stderr, "cooperative launch failed: %s (grid %d)\n", hipGetErrorString(e), grid_blocks);
}
```

```cpp
#include <hip/hip_runtime.h>
#include <hip/hip_cooperative_groups.h>
#include <cstdio>

typedef __attribute__((ext_vector_type(8))) short bf16x8;
typedef __attribute__((ext_vector_type(4))) short s16x4;
typedef __attribute__((ext_vector_type(4))) float f32x4;
typedef __attribute__((ext_vector_type(2))) float f32x2;
typedef __attribute__((ext_vector_type(2))) __bf16 bf16x2_t;
typedef unsigned short bfr;

#define DI __device__ __forceinline__

constexpr int T_LAT = 16384, T_CTX = 256, T_ALL = T_LAT + T_CTX;
constexpr int DM = 1024, DIN = 4288, HGC = 2560, RWC = 1728, DRW = 512, DHG = 512;
constexpr int NEXP = 64, DEXP = 512;
constexpr int NTHR = 256;
constexpr int NTHR_BLOCK = 512;
#define VT ((int)(threadIdx.x & 255))
__device__ __forceinline__ int tx_() { int t = (int)threadIdx.x; asm volatile("" : "+v"(t)); return t; }
constexpr float DN_ALPHA = 1.189207115002721f;
constexpr float RW_DECAY_SCALE = 0.6065306597126334f;

constexpr size_t MB = 1ull << 20;
constexpr size_t WS_MOD = 0;
constexpr size_t WS_MODC = 32768;
constexpr size_t WS_LB = 65536;
constexpr size_t WS_CNT = 65536 + 8192;
constexpr size_t WS_BAR = 81920;
constexpr size_t WS_ASGW = 131072;
constexpr size_t WS_LIST = 1 * MB;
constexpr size_t WS_H = 6 * MB;
constexpr size_t WS_P = 42 * MB;
constexpr size_t WS_Y = 42 * MB;
constexpr size_t WS_H2 = 106 * MB;
constexpr size_t WS_RW = 186 * MB;
constexpr size_t RW_ARR = (size_t)T_ALL * 512 * 2;
constexpr size_t WS_X1B = 6 * MB;
constexpr size_t WS_MIX = 316 * MB;
constexpr size_t WS_LW = 284 * MB;
constexpr size_t LW_ARR = (size_t)T_ALL * 512 * 4;

struct Params {
  const float* in[32];
  float* out;
  char* ws;
  unsigned* bar;
  int use_cg;
  int pad;
};
typedef const __attribute__((address_space(4))) Params CParams;

DI unsigned pack2(float a, float b) {
  f32x2 v = {a, b};
  bf16x2_t r = __builtin_convertvector(v, bf16x2_t);
  return __builtin_bit_cast(unsigned, r);
}
DI bfr f2bf(float a) { return (bfr)(pack2(a, 0.f) & 0xffffu); }
DI uint2 pk4(f32x4 v);
#define LBAR() do { asm volatile("s_waitcnt lgkmcnt(0)" ::: "memory"); __builtin_amdgcn_s_barrier(); asm volatile("" ::: "memory"); } while (0)
DI unsigned pk4_f8(float a, float b, float c, float d) { int r = __builtin_amdgcn_cvt_pk_fp8_f32(a, b, 0, false); r = __builtin_amdgcn_cvt_pk_fp8_f32(c, d, r, true); return (unsigned)r; }
DI float bf2f(bfr v) { return __uint_as_float(((unsigned)v) << 16); }
DI float frcp_(float x) { return __builtin_amdgcn_rcpf(x); }
DI float sigmoidf_(float x) { return frcp_(1.f + __expf(-x)); }
DI float siluf_(float x) { return x * frcp_(1.f + __expf(-x)); }
DI f32x4 ld4bf(const bfr* p);
DI float wave_sum(float v) {
#pragma unroll
  for (int o = 32; o > 0; o >>= 1) v += __shfl_xor(v, o);
  return v;
}

DI void phase_lora_convert(CParams& P, int part, int nparts);
DI void phase_wrt_convert(CParams& P, int part, int nparts);
DI void transpose_tile(const float* W, int ldw, int k0, int n0, int nvalid, bfr* WT, int ldt, char* smem);
DI void transpose_quad(const float* W, int ldw, int k0, int n0, bfr* WT, int ldt, int dr0, int dr1, int dr2, int dr3, char* smem, int nvalid, int dstride);
DI void phase_mod(CParams& P, int bid, int nb, char* smem) {
  const float* c = P.in[1]; const float* cc = P.in[3];
  const float* w_mod = P.in[4]; const float* b_mod = P.in[5];
  float* mod = (float*)(P.ws + WS_MOD); float* modc = (float*)(P.ws + WS_MODC);
  float* red = (float*)smem;
  const int tid = VT;
  for (int it = bid; it < 542; it += nb) {
    if (it < 192) {
      const int kq = tid >> 3, c4 = tid & 7;
      const int col = it * 32 + c4 * 4;
      f32x4 a1 = {0, 0, 0, 0}, a2 = {0, 0, 0, 0};
      for (int k = kq; k < DM; k += 32) {
        f32x4 w = __builtin_nontemporal_load((const f32x4*)(w_mod + (long)k * 6144 + col));
        float s1 = siluf_(c[k]), s2 = siluf_(cc[k]);
        a1 += w * s1; a2 += w * s2;
      }
      LBAR();
#pragma unroll
      for (int e = 0; e < 4; ++e) { red[(kq * 32) + c4 * 4 + e] = a1[e]; red[1024 + kq * 32 + c4 * 4 + e] = a2[e]; }
      LBAR();
      if (tid < 64) {
        const int which = tid >> 5, cl = tid & 31;
        float s = 0.f;
        for (int q = 0; q < 32; ++q) s += red[which * 1024 + q * 32 + cl];
        const int cg = it * 32 + cl;
        s += b_mod[cg];
        if (which == 0) mod[cg] = s; else modc[cg] = s;
      }
    } else if (it == 192) {
      const float* L = P.in[8];
      float* lb = (float*)(P.ws + WS_LB);
      for (int i = tid; i < 1024; i += NTHR) {
        const int d = i >> 9, j = i & 511;
        float l0 = L[d * 1024 + j], l1 = L[d * 1024 + 512 + j];
        lb[i] = 1.f / (1.f + __expf(l1 - l0));
      }
    } else if (it == 193) {
      int* cnt = (int*)(P.ws + WS_CNT);
      if (tid < 64) cnt[tid] = 0;
    } else if (it < 198) {
      phase_lora_convert(P, it - 194, 4);
    } else if (it < 470) {
      const int t = it - 198, kt = t / 17, nq = t % 17;
      if (nq < 8) {
        const int ty = nq >> 1, c0 = (nq & 1) * 256;
        transpose_quad(P.in[6], DIN, kt * 64, nq * 256, (bfr*)(P.ws + (284ull << 20)), DM, 4 * c0 + ty, 4 * (c0 + 64) + ty, 4 * (c0 + 128) + ty, 4 * (c0 + 192) + ty, smem, DIN, 4);
      } else
      transpose_quad(P.in[6], DIN, kt * 64, nq * 256, (bfr*)(P.ws + (284ull << 20)), DM, nq * 256, nq * 256 + 64, nq * 256 + 128, nq * 256 + 192, smem, DIN, 1);
    } else if (it < 534) {
      const int t = it - 470, kt = t >> 2, nq = t & 3;
      transpose_quad(P.in[7], DM, kt * 64, nq * 256, (bfr*)(P.ws + (1ull << 20)), DM, nq * 256, nq * 256 + 64, nq * 256 + 128, nq * 256 + 192, smem, DM, 1);
    } else {
      phase_wrt_convert(P, it - 534, 8);
    }
  }
}

DI void phase_ln1(CParams& P, int bid, int nb) {
  const float* x = P.in[0]; const float* ctx = P.in[2];
  const float* mod = (const float*)(P.ws + WS_MOD); const float* modc = (const float*)(P.ws + WS_MODC);
  bfr* h = (bfr*)(P.ws + WS_H);
  const int wid = VT >> 6, lane = VT & 63;
  for (int row0 = (bid * 4 + wid) * 2; row0 < T_ALL; row0 += nb * 8) {
    const float* src = row0 < T_LAT ? x + (long)row0 * DM : ctx + (long)(row0 - T_LAT) * DM;
    const float* mm = row0 < T_LAT ? mod : modc;
    f32x4 v[2][4];
    float s[2] = {0.f, 0.f};
    f32x4 psh[4], psc[4];
#pragma unroll
    for (int i = 0; i < 4; ++i) { const int cidx = lane * 4 + 256 * i; psh[i] = *(const f32x4*)(mm + cidx); psc[i] = *(const f32x4*)(mm + 1024 + cidx); }
#pragma unroll
    for (int r = 0; r < 2; ++r)
#pragma unroll
      for (int i = 0; i < 4; ++i) { v[r][i] = __builtin_nontemporal_load((const f32x4*)(src + r * DM + lane * 4 + 256 * i)); s[r] += v[r][i][0] + v[r][i][1] + v[r][i][2] + v[r][i][3]; }
#pragma unroll
    for (int r = 0; r < 2; ++r) {
      const float mu = wave_sum(s[r]) * (1.f / DM);
      float q = 0.f;
#pragma unroll
      for (int i = 0; i < 4; ++i) { v[r][i] -= mu; q += v[r][i][0] * v[r][i][0] + v[r][i][1] * v[r][i][1] + v[r][i][2] * v[r][i][2] + v[r][i][3] * v[r][i][3]; }
      const float rs = rsqrtf(wave_sum(q) * (1.f / DM) + 1e-5f);
#pragma unroll
      for (int i = 0; i < 4; ++i) {
        const int cidx = lane * 4 + 256 * i;
        f32x4 o = v[r][i] * rs * (psc[i] + 1.f) + psh[i];
        uint2 w = {pack2(o[0], o[1]), pack2(o[2], o[3])};
        *(uint2*)(h + (long)(row0 + r) * DM + cidx) = w;
      }
    }
  }
}

#define LDSP(T) __attribute__((address_space(3))) T*
DI int row_of_step(int dir, int s) {
  if (s < T_CTX) return T_LAT + (dir ? (T_CTX - 1 - s) : s);
  return dir ? (T_LAT - 1 - (s - T_CTX)) : (s - T_CTX);
}
DI bf16x8 ld_tr8(const short* base, int stride, int k0, int n0) {
  const int lane = VT & 63, g = lane >> 4, q = (lane & 15) >> 2, p = lane & 3;
  const short* a0 = base + (k0 + 8 * g + q) * stride + n0 + 4 * p;
  s16x4 lo = __builtin_amdgcn_ds_read_tr16_b64_v4i16((LDSP(s16x4))a0);
  s16x4 hi = __builtin_amdgcn_ds_read_tr16_b64_v4i16((LDSP(s16x4))(a0 + 4 * stride));
  return __builtin_shufflevector(lo, hi, 0, 1, 2, 3, 4, 5, 6, 7);
}
template <bool AT, bool BT>
DI f32x4 mm_tile(const short* A, int lda, int m0, const short* B, int ldb, int n0, int K, f32x4 acc) {
  const int lane = VT & 63, fr = lane & 15, fq = lane >> 4;
#ifdef SLOWMM
#pragma unroll
  for (int reg = 0; reg < 4; ++reg) {
    const int row = m0 + 4 * fq + reg, col = n0 + fr;
    float s = 0.f;
    for (int k = 0; k < K; ++k) {
      const float a = bf2f((bfr)(AT ? A[k * lda + row] : A[row * lda + k]));
      const float b = bf2f((bfr)(BT ? B[col * ldb + k] : B[k * ldb + col]));
      s += a * b;
    }
    acc[reg] += s;
  }
#else
  for (int k0 = 0; k0 < K; k0 += 32) {
    bf16x8 a, b;
    if (AT) a = ld_tr8(A, lda, k0, m0); else a = *(const bf16x8*)(A + (m0 + fr) * lda + k0 + fq * 8);
    if (BT) b = *(const bf16x8*)(B + (n0 + fr) * ldb + k0 + fq * 8); else b = ld_tr8(B, ldb, k0, n0);
    acc = __builtin_amdgcn_mfma_f32_16x16x32_bf16(a, b, acc, 0, 0, 0);
  }
#endif
  return acc;
}
DI void st_tile(short* C, int ldc, int m0, int n0, f32x4 acc) {
  const int lane = VT & 63, fr = lane & 15, fq = lane >> 4;
#pragma unroll
  for (int reg = 0; reg < 4; ++reg) C[(m0 + 4 * fq + reg) * ldc + n0 + fr] = (short)f2bf(acc[reg]);
}

constexpr int RW_NSC = 32;
DI int rw_sc_begin(int sc) { return sc * 16 + (sc < 8 ? sc : 8); }
DI int rw_sc_of_chunk(int ci) { return ci < 136 ? ci / 17 : 8 + (ci - 136) / 16; }
constexpr int XS = 72, SS = 40, GS = 72;
constexpr int RWL_XK = 0, RWL_XKB = 4608, RWL_XBB = 9216, RWL_XR = 13824, RWL_XV = 18432, RWL_S = 23040;
constexpr int RWL_GP = 38400, RWL_GQ = 47616, RWL_GAM = 56832, RWL_TOT = 57088, RWL_END = 58112;
constexpr size_t WS_PTOT = 6 * MB;
constexpr size_t WS_QTOT = 10 * MB;
constexpr size_t WS_SINRW = 18 * MB;
constexpr size_t WS_R2P = 350 * MB;
constexpr size_t WS_Y0P = 382 * MB;

constexpr int RTS = 40, RGS = 72;
constexpr int RWT_XK = 0, RWT_XKB = 5120, RWT_XBB = 10240, RWT_XR = 15360, RWT_XV = 20480, RWT_S = 25600;
constexpr int RWT_GP = 40960, RWT_GQ = 50176, RWT_GAM = 59392, RWT_TOT = 59648;
DI void st_tile_T(short* C, int ldc, int m0, int n0, f32x4 acc) {
  const int lane = (int)(threadIdx.x & 63), fr = lane & 15, fq = lane >> 4;
  *(uint2*)(C + (n0 + fr) * ldc + m0 + 4 * fq) = uint2{pack2(acc[0], acc[1]), pack2(acc[2], acc[3])};
}
DI void rw_levelA_item(CParams& P, int chain, int sc, char* smem) {
  const int dir = chain >> 3, hd = chain & 7;
  const uint2* RKVg = (const uint2*)(P.ws + WS_RW);
  const unsigned* LWAg = (const unsigned*)(P.ws + WS_LW + (dir ? LW_ARR : 0));
  bfr* R2P = (bfr*)(P.ws + WS_R2P) + (size_t)dir * T_LAT * 512;
  bfr* Y0P = (bfr*)(P.ws + WS_Y0P) + (size_t)dir * T_LAT * 512;
  short* XKt = (short*)(smem + RWT_XK); short* XKBt = (short*)(smem + RWT_XKB); short* XBBt = (short*)(smem + RWT_XBB);
  short* XRt = (short*)(smem + RWT_XR); short* XVt = (short*)(smem + RWT_XV);
  short* ZT = XRt; short* R2T = XRt; short* PcT = XKt;
  short* SLt = (short*)(smem + RWT_S); short* SAkkT = SLt + 32 * RTS; short* SAkrT = SAkkT + 32 * RTS; short* SMt = SAkrT + 32 * RTS;
  short* STt = SMt + 32 * RTS; short* SnAbrT = STt + 32 * RTS;
  short* W1T = SLt; short* W2T = SAkrT;
  short* GPT = (short*)(smem + RWT_GP); short* GQT = (short*)(smem + RWT_GQ);
  float* gam = (float*)(smem + RWT_GAM); float* tot = (float*)(smem + RWT_TOT);
  short* STt2 = (short*)(smem + RWT_TOT + 1024); short* SMt2 = STt2 + 32 * RTS;
  const int tid = VT, lane = tid & 63, w = tid >> 6, fr = lane & 15, fq = lane >> 4;
  const int tm = w >> 1, tn = w & 1;
  const int sgn = dir ? -1 : 1;
  const f32x4 z4 = {0.f, 0.f, 0.f, 0.f};
  LBAR();
  for (int i = tid; i < 64 * 64; i += NTHR) { const int r = i >> 6, c = i & 63; GPT[r * RGS + c] = (r == c) ? (short)0x3F80 : (short)0; GQT[r * RGS + c] = 0; }
  f32x4 pcum[4], qcum[4];
#pragma unroll
  for (int n = 0; n < 4; ++n) { pcum[n] = z4; qcum[n] = z4; }
  const int c_begin = rw_sc_begin(sc), c_end = rw_sc_begin(sc + 1);
  unsigned pf_lwa[8], pf_rk[8], pf_vkk[8];
#define RW_PREFETCH(cc) do { const unsigned o0_ = (unsigned)(row_of_step(dir, (cc) * 32 + (tid >> 6) * 8) * 512 + hd * 64 + (tid & 63)); \
      _Pragma("unroll") for (int e_ = 0; e_ < 8; ++e_) { const unsigned o_ = o0_ + (unsigned)(sgn * e_ * 512); \
      pf_lwa[e_] = LWAg[o_]; const uint2 u_ = RKVg[o_]; pf_rk[e_] = u_.x; pf_vkk[e_] = u_.y; } } while (0)
  RW_PREFETCH(c_begin);
  for (int ci = c_begin; ci < c_end; ++ci) {
    LBAR();
    {
      const int j = tid & 63, qt = tid >> 6;
      float lam[8];
      float run = 0.f;
#pragma unroll
      for (int e = 0; e < 8; ++e) { run += __uint_as_float(pf_lwa[e] << 16); lam[e] = run; }
      tot[qt * 64 + j] = run;
      LBAR();
      float base = 0.f, total = 0.f;
#pragma unroll
      for (int q2 = 0; q2 < 4; ++q2) { const float tv = tot[q2 * 64 + j]; total += tv; if (q2 < qt) base += tv; }
      unsigned wk[4], wkb[4], wbb[4], wr_[4], wv[4];
#pragma unroll
      for (int e2 = 0; e2 < 4; ++e2) {
        float vk[2], vkb[2], vbb[2], vr[2];
#pragma unroll
        for (int u = 0; u < 2; ++u) {
          const int e = 2 * e2 + u;
          const float L = base + lam[e];
          const float eL = __expf(L), enL = frcp_(eL), eLp = eL * __expf(-__uint_as_float(pf_lwa[e] << 16));
          const float kkv = __uint_as_float(pf_vkk[e] & 0xffff0000u);
          vk[u] = kkv * eLp;
          vkb[u] = __uint_as_float(pf_rk[e] & 0xffff0000u) * enL;
          vbb[u] = kkv * __uint_as_float(pf_lwa[e] & 0xffff0000u) * enL;
          vr[u] = __uint_as_float(pf_rk[e] << 16) * eL;
        }
        wk[e2] = pack2(vk[0], vk[1]); wkb[e2] = pack2(vkb[0], vkb[1]); wbb[e2] = pack2(vbb[0], vbb[1]); wr_[e2] = pack2(vr[0], vr[1]);
        wv[e2] = (pf_vkk[2 * e2] & 0xffffu) | (pf_vkk[2 * e2 + 1] << 16);
      }
      const int co = j * RTS + 8 * qt;
      *(uint4*)(XKt + co) = uint4{wk[0], wk[1], wk[2], wk[3]};
      *(uint4*)(XKBt + co) = uint4{wkb[0], wkb[1], wkb[2], wkb[3]};
      *(uint4*)(XBBt + co) = uint4{wbb[0], wbb[1], wbb[2], wbb[3]};
      *(uint4*)(XRt + co) = uint4{wr_[0], wr_[1], wr_[2], wr_[3]};
      *(uint4*)(XVt + co) = uint4{wv[0], wv[1], wv[2], wv[3]};
      if (qt == 0) gam[j] = __expf(total);
      if (ci + 1 < c_end) RW_PREFETCH(ci + 1);
    }
    LBAR();
    f32x4 tacc; f32x4 rt[2];
    {
      f32x4 aL = mm_tile<true, false>(XKt, RTS, 16 * tm, XBBt, RTS, 16 * tn, 64, z4);
      f32x4 aKK = mm_tile<true, false>(XKt, RTS, 16 * tm, XKBt, RTS, 16 * tn, 64, z4);
      f32x4 aBR = mm_tile<true, false>(XRt, RTS, 16 * tm, XBBt, RTS, 16 * tn, 64, z4);
      f32x4 aKR = mm_tile<true, false>(XRt, RTS, 16 * tm, XKBt, RTS, 16 * tn, 64, z4);
#pragma unroll
      for (int reg = 0; reg < 4; ++reg) {
        const int row = 16 * tm + 4 * fq + reg, col = 16 * tn + fr;
        const bool st = col < row, inc = col <= row;
        aL[reg] = st ? aL[reg] : 0.f; aKK[reg] = st ? aKK[reg] : 0.f;
        aBR[reg] = inc ? -aBR[reg] : 0.f; aKR[reg] = inc ? aKR[reg] : 0.f;
        tacc[reg] = (row == col ? 1.f : 0.f) - aL[reg];
      }
      st_tile_T(SLt, RTS, 16 * tm, 16 * tn, aL); st_tile_T(STt, RTS, 16 * tm, 16 * tn, tacc);
      st_tile_T(SAkkT, RTS, 16 * tm, 16 * tn, aKK); st_tile_T(SnAbrT, RTS, 16 * tm, 16 * tn, aBR); st_tile_T(SAkrT, RTS, 16 * tm, 16 * tn, aKR);
#pragma unroll
      for (int i = 0; i < 2; ++i) rt[i] = ld4bf((const bfr*)(XRt + (16 * (2 * tn + i) + fr) * RTS + 16 * tm + 4 * fq));
    }
    LBAR();
    f32x4 y0[2];
    {
#pragma unroll
      for (int i = 0; i < 2; ++i) {
        f32x4 z = mm_tile<true, true>(SAkkT, RTS, 16 * tm, XVt, RTS, 16 * (2 * tn + i), 32, z4);
        st_tile_T(ZT, RTS, 16 * tm, 16 * (2 * tn + i), z);
        y0[i] = mm_tile<false, false>(XVt, RTS, 16 * (2 * tn + i), SAkrT, RTS, 16 * tm, 32, z4);
      }
      f32x4 m = mm_tile<true, true>(SLt, RTS, 16 * tm, SLt, RTS, 16 * tn, 32, z4);
      st_tile_T(SMt, RTS, 16 * tm, 16 * tn, m);
    }
    LBAR();
#pragma unroll
    for (int rd = 0; rd < 4; ++rd) {
      short* Tr = (rd & 1) ? STt2 : STt; short* Mr = (rd & 1) ? SMt2 : SMt;
      short* Tw = (rd & 1) ? STt : STt2; short* Mw = (rd & 1) ? SMt : SMt2;
      tacc = mm_tile<true, true>(Tr, RTS, 16 * tm, Mr, RTS, 16 * tn, 32, tacc);
      f32x4 mnew = z4;
      if (rd < 3) mnew = mm_tile<true, true>(Mr, RTS, 16 * tm, Mr, RTS, 16 * tn, 32, z4);
      st_tile_T(Tw, RTS, 16 * tm, 16 * tn, tacc);
      if (rd < 3) st_tile_T(Mw, RTS, 16 * tm, 16 * tn, mnew);
      LBAR();
    }
    {
      f32x4 w1[2], w2[2];
#pragma unroll
      for (int i = 0; i < 2; ++i) {
        w1[i] = mm_tile<true, true>(STt, RTS, 16 * tm, XKt, RTS, 16 * (2 * tn + i), 32, z4);
        w2[i] = mm_tile<true, true>(STt, RTS, 16 * tm, ZT, RTS, 16 * (2 * tn + i), 32, z4);
      }
#pragma unroll
      for (int i = 0; i < 2; ++i) { st_tile_T(W1T, RTS, 16 * tm, 16 * (2 * tn + i), w1[i]); st_tile_T(W2T, RTS, 16 * tm, 16 * (2 * tn + i), w2[i]); }
    }
    LBAR();
    f32x4 pa[4], qc[4], r2[2];
    {
#pragma unroll
      for (int n = 0; n < 4; ++n) {
        pa[n] = mm_tile<false, true>(W1T, RTS, 16 * w, XBBt, RTS, 16 * n, 32, z4);
        f32x4 qa = mm_tile<false, true>(XVt, RTS, 16 * w, XKBt, RTS, 16 * n, 32, z4);
        f32x4 qb = mm_tile<false, true>(W2T, RTS, 16 * w, XBBt, RTS, 16 * n, 32, z4);
        qc[n] = qa - qb;
      }
#pragma unroll
      for (int i = 0; i < 2; ++i) {
        r2[i] = mm_tile<true, true>(SnAbrT, RTS, 16 * tm, W1T, RTS, 16 * (2 * tn + i), 32, rt[i]);
        y0[i] = mm_tile<false, false>(W2T, RTS, 16 * (2 * tn + i), SnAbrT, RTS, 16 * tm, 32, y0[i]);
      }
    }
    LBAR();
    {
#pragma unroll
      for (int n = 0; n < 4; ++n) {
        const float gcol = gam[16 * n + fr];
        f32x4 pc;
#pragma unroll
        for (int reg = 0; reg < 4; ++reg) {
          const int row = 16 * w + 4 * fq + reg, col = 16 * n + fr;
          pc[reg] = ((row == col ? 1.f : 0.f) - pa[n][reg]) * gcol;
          qc[n][reg] *= gcol;
        }
        st_tile_T(PcT, RGS, 16 * w, 16 * n, pc);
      }
#pragma unroll
      for (int i = 0; i < 2; ++i) st_tile_T(R2T, RTS, 16 * tm, 16 * (2 * tn + i), r2[i]);
    }
    LBAR();
    {
      if (ci >= 8) {
        const unsigned orow = (unsigned)(row_of_step(dir, ci * 32 + 16 * tm + fr) * 512 + hd * 64 + 4 * fq);
#pragma unroll
        for (int i = 0; i < 2; ++i) {
          f32x4 o1 = mm_tile<true, false>(GPT, RGS, 16 * (2 * tn + i), R2T, RTS, 16 * tm, 64, z4);
          f32x4 o2 = mm_tile<true, false>(GQT, RGS, 16 * (2 * tn + i), R2T, RTS, 16 * tm, 64, y0[i]);
          *(uint2*)(R2P + orow + 16 * (2 * tn + i)) = pk4(o1); *(uint2*)(Y0P + orow + 16 * (2 * tn + i)) = pk4(o2);
        }
      }
#pragma unroll
      for (int n = 0; n < 4; ++n) {
        pcum[n] = mm_tile<true, true>(GPT, RGS, 16 * w, PcT, RGS, 16 * n, 64, z4);
        qcum[n] = mm_tile<true, true>(GQT, RGS, 16 * w, PcT, RGS, 16 * n, 64, qc[n]);
      }
    }
    LBAR();
#pragma unroll
    for (int n = 0; n < 4; ++n) { st_tile_T(GPT, RGS, 16 * w, 16 * n, pcum[n]); st_tile_T(GQT, RGS, 16 * w, 16 * n, qcum[n]); }
  }
  {
    bfr* Pt = (bfr*)(P.ws + WS_PTOT) + (size_t)(chain * RW_NSC + sc) * 4096;
    bfr* Qt = (bfr*)(P.ws + WS_QTOT) + (size_t)(chain * RW_NSC + sc) * 4096;
#pragma unroll
    for (int n = 0; n < 4; ++n)
#pragma unroll
      for (int reg = 0; reg < 4; ++reg) {
        const int row = 16 * w + 4 * fq + reg, col = 16 * n + fr;
        Pt[row * 64 + col] = f2bf(pcum[n][reg]);
      }
#pragma unroll
    for (int n = 0; n < 4; ++n) *(uint2*)(Qt + ((w * 4 + n) * 64 + lane) * 4) = pk4(qcum[n]);
  }
}

DI void rw_levelB_chain(CParams& P, int chain, char* smem) {
  short* SB = (short*)smem; short* PT = SB + 64 * GS;
  const bfr* Ptot = (const bfr*)(P.ws + WS_PTOT) + (size_t)chain * RW_NSC * 4096;
  const bfr* Qtot = (const bfr*)(P.ws + WS_QTOT) + (size_t)chain * RW_NSC * 4096;
  bfr* SIN = (bfr*)(P.ws + WS_SINRW) + (size_t)chain * (RW_NSC + 1) * 4096;
  const int tid = VT, lane = tid & 63, w = tid >> 6, fr = lane & 15, fq = lane >> 4;
  f32x4 S[4];
#pragma unroll
  for (int n = 0; n < 4; ++n) S[n] = f32x4{0.f, 0.f, 0.f, 0.f};
  bf16x8 pr[4][2]; uint2 qr[4][4];
#define LB_LOAD(slot, sc_) do { _Pragma("unroll") for (int i_ = 0; i_ < 2; ++i_) { const int e_ = tid + i_ * NTHR; pr[slot][i_] = *(const bf16x8*)(Ptot + (size_t)(sc_) * 4096 + (e_ >> 3) * 64 + (e_ & 7) * 8); } \
    _Pragma("unroll") for (int n_ = 0; n_ < 4; ++n_) qr[slot][n_] = *(const uint2*)(Qtot + (size_t)(sc_) * 4096 + ((w * 4 + n_) * 64 + lane) * 4); } while (0)
#define LB_Q(u_, n_) f32x4{__uint_as_float(qr[u_][n_].x << 16), __uint_as_float(qr[u_][n_].x & 0xffff0000u), __uint_as_float(qr[u_][n_].y << 16), __uint_as_float(qr[u_][n_].y & 0xffff0000u)}
  LB_LOAD(0, 0); LB_LOAD(1, 1); LB_LOAD(2, 2); LB_LOAD(3, 3);
#define LB_STEP(u, PF) do { const int sc = sc0 + (u); \
      LBAR(); \
      _Pragma("unroll") for (int n = 0; n < 4; ++n) st_tile(SB, GS, 16 * w, 16 * n, S[n]); \
      _Pragma("unroll") for (int i = 0; i < 2; ++i) { const int e = tid + i * NTHR; *(bf16x8*)(PT + (e >> 3) * GS + (e & 7) * 8) = pr[u][i]; } \
      const f32x4 qc0 = LB_Q(u, 0), qc1 = LB_Q(u, 1), qc2 = LB_Q(u, 2), qc3 = LB_Q(u, 3); \
      LBAR(); \
      if (PF) LB_LOAD(u, sc + 4); \
      _Pragma("unroll") for (int i = 0; i < 2; ++i) { const int e = tid + i * NTHR; *(bf16x8*)(SIN + (size_t)sc * 4096 + (e >> 3) * 64 + (e & 7) * 8) = *(const bf16x8*)(SB + (e >> 3) * GS + (e & 7) * 8); } \
      S[0] = mm_tile<false, false>(SB, GS, 16 * w, PT, GS, 0, 64, qc0); S[1] = mm_tile<false, false>(SB, GS, 16 * w, PT, GS, 16, 64, qc1); \
      S[2] = mm_tile<false, false>(SB, GS, 16 * w, PT, GS, 32, 64, qc2); S[3] = mm_tile<false, false>(SB, GS, 16 * w, PT, GS, 48, 64, qc3); } while (0)
#pragma unroll 1
  for (int sc0 = 0; sc0 < RW_NSC - 4; sc0 += 4) { LB_STEP(0, 1); LB_STEP(1, 1); LB_STEP(2, 1); LB_STEP(3, 1); }
  { const int sc0 = RW_NSC - 4; LB_STEP(0, 0); LB_STEP(1, 0); LB_STEP(2, 0); LB_STEP(3, 0); }
#undef LB_STEP
#undef LB_LOAD
#undef LB_Q
}

constexpr int HG_NSC = 64;
DI int hg_sc_begin(int sc) { return sc * 8 + (sc < 8 ? sc : 8); }
DI int hg_sc_of_chunk(int ci) { return ci < 72 ? ci / 9 : 8 + (ci - 72) / 8; }
constexpr int QS = 136;
constexpr int HGL_Q0 = 0, HGL_Q1 = 8704, HGL_KP = 13056, HGL_KH = 21760, HGL_VV = 30464, HGL_PM = 39168, HGL_STT = 41728;
constexpr int HGL_BL = 76544, HGL_TOT = 77056, HGL_END = 78080;
constexpr size_t WS_SINHG = 23 * MB;
constexpr size_t WS_QH = 414 * MB;
constexpr size_t WS_O0 = 446 * MB;
constexpr size_t WS_SLOC = 478 * MB;
constexpr size_t WS_DTOT = 510 * MB;

constexpr int HTS = 40, HT1S = 24;
constexpr int HGT_Q0 = 0, HGT_Q1 = 10240, HGT_KP = 16384, HGT_KH = 26624, HGT_VV = 36864, HGT_PM = 47104, HGT_BL = 49664, HGT_TOT = 50176;
DI bf16x8 ld_tr8p(const short* base, int stride, int k0, int n0) {
  const int lane = (int)(threadIdx.x & 63), g = lane >> 4, q = (lane & 15) >> 2, p = lane & 3;
  const short* a0 = base + (k0 + 4 * g + q) * stride + n0 + 4 * p;
  s16x4 lo = __builtin_amdgcn_ds_read_tr16_b64_v4i16((LDSP(s16x4))a0);
  s16x4 hi = __builtin_amdgcn_ds_read_tr16_b64_v4i16((LDSP(s16x4))(a0 + 16 * stride));
  return __builtin_shufflevector(lo, hi, 0, 1, 2, 3, 4, 5, 6, 7);
}
DI void hg_levelA_item(CParams& P, int chain, int sc, char* smem) {
  const int dir = chain >> 2, hd = chain & 3;
  const bfr* p = (const bfr*)(P.ws + WS_P);
  const float* lbp = (const float*)(P.ws + WS_LB) + dir * 512 + hd * 128;
  bfr* QH = (bfr*)(P.ws + WS_QH) + (size_t)dir * T_LAT * 512;
  bfr* O0 = (bfr*)(P.ws + WS_O0) + (size_t)dir * T_LAT * 512;
  short* Q0T = (short*)(smem + HGT_Q0); short* Q1T = (short*)(smem + HGT_Q1); short* KPT = (short*)(smem + HGT_KP);
  short* KHT = (short*)(smem + HGT_KH); short* VVT = (short*)(smem + HGT_VV); short* PMT = (short*)(smem + HGT_PM);
  float* BL = (float*)(smem + HGT_BL); float* tot = (float*)(smem + HGT_TOT);
  const int tid = VT, lane = tid & 63, w = tid >> 6, fr = lane & 15, fq = lane >> 4;
  const f32x4 z4 = {0.f, 0.f, 0.f, 0.f};
  f32x4 S[8][2];
#pragma unroll
  for (int m = 0; m < 8; ++m) { S[m][0] = z4; S[m][1] = z4; }
  const int d = tid & 127, hf = tid >> 7;
  const float lb = lbp[d];
  float dcum = 1.f;
  const int sgn = dir ? -1 : 1;
  const int c_begin = hg_sc_begin(sc), c_end = hg_sc_begin(sc + 1);
  unsigned qv[16]; bfr zr[16];
#define HG_PREFETCH(cc) do { const unsigned po0_ = (unsigned)(row_of_step(dir, (cc) * 32 + hf * 16) * DIN + hd * 512 + 4 * d); \
      _Pragma("unroll") for (int e_ = 0; e_ < 16; ++e_) { const unsigned po_ = po0_ + (unsigned)(sgn * e_ * DIN); \
      const uint2 u_ = *(const uint2*)(p + po_); qv[e_] = u_.x; zr[e_] = (bfr)(dir ? (u_.y >> 16) : (u_.y & 0xffffu)); } } while (0)
  HG_PREFETCH(c_begin);
  for (int ci = c_begin; ci < c_end; ++ci) {
    LBAR();
    {
      float elv[16], eiv[16], kv[16]; float run = 1.f, runi = 1.f;
#pragma unroll
      for (int e = 0; e < 16; ++e) {
        const float a_ = 1.f + __expf(-fmaxf(bf2f(zr[e]), -30.f)), b_ = lb * a_ + (1.f - lb);
        const float t_ = frcp_(a_ * b_), sg = t_ * b_;
        kv[e] = (1.f - lb) * (1.f - sg);
        run *= b_ * sg; runi *= t_ * a_ * a_; elv[e] = run; eiv[e] = runi;
      }
      tot[hf * 128 + d] = run;
      LBAR();
      const float tot0 = tot[d], tot1 = tot[128 + d];
      const float blast = tot0 * tot1;
      const float e0f = hf ? tot0 : 1.f;
      const float ehf = hf ? tot1 : blast;
      const float edc = dcum;
      const unsigned qh0 = (unsigned)(row_of_step(dir, ci * 32 + hf * 16) * 512 + hd * 128 + d);
#pragma unroll
      for (int hq = 0; hq < 2; ++hq) {
        unsigned q0w[4], q1w[4], kpw[4], khw[4], vvw[4];
#pragma unroll
        for (int e2 = 0; e2 < 4; ++e2) {
          float q0v[2], q1v[2], kpv[2], khv[2];
#pragma unroll
          for (int u = 0; u < 2; ++u) {
            const int e = 8 * hq + 2 * e2 + u;
            const float el = elv[e], eil = eiv[e];
            const float qs = siluf_(__uint_as_float(qv[e] << 16));
            q1v[u] = qs * el; q0v[u] = q1v[u] * e0f;
            kpv[u] = kv[e] * eil; khv[u] = kpv[u] * ehf;
            if (ci >= 8) QH[qh0 + (unsigned)(sgn * e * 512)] = f2bf(q0v[u] * edc);
          }
          q0w[e2] = pack2(q0v[0], q0v[1]); q1w[e2] = pack2(q1v[0], q1v[1]); kpw[e2] = pack2(kpv[0], kpv[1]); khw[e2] = pack2(khv[0], khv[1]);
          vvw[e2] = (qv[8 * hq + 2 * e2] >> 16) | (qv[8 * hq + 2 * e2 + 1] & 0xffff0000u);
        }
        const int co = 16 * hf + 8 * hq;
        *(uint4*)(Q0T + d * HTS + co) = uint4{q0w[0], q0w[1], q0w[2], q0w[3]};
        if (hf) *(uint4*)(Q1T + d * HT1S + 8 * hq) = uint4{q1w[0], q1w[1], q1w[2], q1w[3]};
        *(uint4*)(KPT + d * HTS + co) = uint4{kpw[0], kpw[1], kpw[2], kpw[3]};
        *(uint4*)(KHT + d * HTS + co) = uint4{khw[0], khw[1], khw[2], khw[3]};
        *(uint4*)(VVT + d * HTS + co) = uint4{vvw[0], vvw[1], vvw[2], vvw[3]};
      }
      if (hf == 0) BL[d] = blast;
      dcum *= blast;
      if (ci + 1 < c_end) HG_PREFETCH(ci + 1);
    }
    LBAR();
    {
      f32x4 pt = z4;
      if (w == 0) pt = mm_tile<true, false>(Q0T, HTS, 0, KPT, HTS, 0, 128, z4);
      else if (w == 1) pt = mm_tile<true, false>(Q0T, HTS, 16, KPT, HTS, 0, 128, z4);
      else if (w == 2) pt = mm_tile<true, false>(Q1T, HT1S, 0, KPT, HTS, 16, 128, z4);
      if (w == 0 || w == 2) {
#pragma unroll
        for (int reg = 0; reg < 4; ++reg) pt[reg] = (fr <= 4 * fq + reg) ? pt[reg] : 0.f;
      }
      const int ptm = (w == 0 || w == 3) ? 0 : 1, ptn = (w >= 2) ? 1 : 0;
      *(uint2*)(PMT + (16 * ptn + fr) * HTS + 16 * ptm + 4 * fq) = uint2{pack2(pt[0], pt[1]), pack2(pt[2], pt[3])};
    }
    LBAR();
    {
      bf16x8 vfr[2];
#pragma unroll
      for (int n = 0; n < 2; ++n) vfr[n] = *(const bf16x8*)(VVT + (32 * w + 16 * n + fr) * HTS + fq * 8);
      f32x4 o[2][2];
#pragma unroll
      for (int m = 0; m < 2; ++m) { o[m][0] = z4; o[m][1] = z4; }
#pragma unroll
      for (int ks = 0; ks < 4; ++ks) {
        bf16x8 sfr[2];
#pragma unroll
        for (int n = 0; n < 2; ++n) {
          typedef __attribute__((ext_vector_type(4))) unsigned u32x4_;
          u32x4_ wv = {pack2(S[2 * ks][n][0], S[2 * ks][n][1]), pack2(S[2 * ks][n][2], S[2 * ks][n][3]), pack2(S[2 * ks + 1][n][0], S[2 * ks + 1][n][1]), pack2(S[2 * ks + 1][n][2], S[2 * ks + 1][n][3])};
          sfr[n] = __builtin_bit_cast(bf16x8, wv);
        }
#pragma unroll
        for (int m = 0; m < 2; ++m) {
          const bf16x8 a = ld_tr8p(Q0T, HTS, 32 * ks, 16 * m);
#pragma unroll
          for (int n = 0; n < 2; ++n) o[m][n] = __builtin_amdgcn_mfma_f32_16x16x32_bf16(sfr[n], a, o[m][n], 0, 0, 0);
        }
      }
#pragma unroll
      for (int m = 0; m < 2; ++m) {
        const bf16x8 a = ld_tr8(PMT, HTS, 0, 16 * m);
#pragma unroll
        for (int n = 0; n < 2; ++n) {
          o[m][n] = __builtin_amdgcn_mfma_f32_16x16x32_bf16(vfr[n], a, o[m][n], 0, 0, 0);
          if (ci >= 8) *(uint2*)(O0 + (unsigned)(row_of_step(dir, ci * 32 + 16 * m + fr) * 512 + hd * 128 + 32 * w + 16 * n + 4 * fq)) = pk4(o[m][n]);
        }
      }
#pragma unroll
      for (int m = 0; m < 8; ++m) {
        const f32x4 sc4 = *(const f32x4*)(BL + 16 * m + 4 * fq);
        const bf16x8 a = *(const bf16x8*)(KHT + (16 * m + fr) * HTS + fq * 8);
#pragma unroll
        for (int n = 0; n < 2; ++n) S[m][n] = __builtin_amdgcn_mfma_f32_16x16x32_bf16(a, vfr[n], S[m][n] * sc4, 0, 0, 0);
      }
    }
  }
  {
    float* SL_ = (float*)(P.ws + WS_SLOC) + (size_t)(chain * HG_NSC + sc) * 16384;
    float* DT = (float*)(P.ws + WS_DTOT) + (size_t)(chain * HG_NSC + sc) * 128;
#pragma unroll
    for (int m = 0; m < 8; ++m)
#pragma unroll
      for (int n = 0; n < 2; ++n) *(f32x4*)(SL_ + (32 * w + 16 * n + fr) * 128 + 16 * m + 4 * fq) = S[m][n];
    if (hf == 0) DT[d] = dcum;
  }
}

DI void hg_levelB(CParams& P, int bid, int nb) {
  const float* SLOC = (const float*)(P.ws + WS_SLOC); const float* DT = (const float*)(P.ws + WS_DTOT);
  bfr* SIN = (bfr*)(P.ws + WS_SINHG);
  for (int idx = bid * NTHR + VT; idx < 8 * 8192; idx += nb * NTHR) {
    const int chain = idx >> 13, ed = (idx & 8191) * 2, dd = ed & 127;
    const float* sl = SLOC + (size_t)chain * HG_NSC * 16384 + ed;
    const float* dt = DT + (size_t)chain * HG_NSC * 128 + dd;
    bfr* so = SIN + (size_t)chain * HG_NSC * 16384 + ed;
    f32x2 rs[8], rd[8];
#pragma unroll
    for (int u = 0; u < 8; ++u) { rs[u] = __builtin_nontemporal_load((const f32x2*)(sl + (size_t)u * 16384)); rd[u] = *(const f32x2*)(dt + u * 128); }
    float s0 = 0.f, s1 = 0.f;
#pragma unroll 1
    for (int sc0 = 0; sc0 < HG_NSC - 8; sc0 += 8) {
#pragma unroll
      for (int u = 0; u < 8; ++u) {
        const int sc = sc0 + u;
        *(unsigned*)(so + (size_t)sc * 16384) = pack2(s0, s1);
        s0 = rd[u][0] * s0 + rs[u][0]; s1 = rd[u][1] * s1 + rs[u][1];
        rs[u] = __builtin_nontemporal_load((const f32x2*)(sl + (size_t)(sc + 8) * 16384)); rd[u] = *(const f32x2*)(dt + (sc + 8) * 128);
      }
    }
#pragma unroll
    for (int u = 0; u < 8; ++u) {
      const int sc = HG_NSC - 8 + u;
      *(unsigned*)(so + (size_t)sc * 16384) = pack2(s0, s1);
      s0 = rd[u][0] * s0 + rs[u][0]; s1 = rd[u][1] * s1 + rs[u][1];
    }
  }
}

constexpr size_t WS_LORA = 256 * 1024;
constexpr int LORA_WD2T = 0, LORA_WA2T = 2 * 512 * 32, LORA_WG2T = LORA_WA2T + 512 * 32;
DI void phase_lora_convert(CParams& P, int part, int nparts) {
  const float* wd2 = P.in[12]; const float* wa2 = P.in[14]; const float* wg2 = P.in[15];
  bfr* L = (bfr*)(P.ws + WS_LORA);
  for (int i = part * NTHR + VT; i < 2 * 512 * 32; i += nparts * NTHR) { const int d = i >> 14, c = (i >> 5) & 511, j = i & 31; L[LORA_WD2T + i] = f2bf(wd2[(d * 32 + j) * 512 + c]); }
  for (int i = part * NTHR + VT; i < 512 * 32; i += nparts * NTHR) { const int c = i >> 5, j = i & 31; L[LORA_WA2T + i] = f2bf(wa2[j * 512 + c]); }
  for (int i = part * NTHR + VT; i < 512 * 96; i += nparts * NTHR) { const int c = i / 96, j = i % 96; L[LORA_WG2T + i] = f2bf(wg2[j * 512 + c]); }
}
#define NB_DECL(row) \
  int nb_o0, nb_o1, nb_o2, nb_o3; float nb_f0, nb_f1, nb_f2, nb_f3, nb_scale; \
  { const int r_ = (row); const bool lat_ = r_ < T_LAT; const int gr_ = r_ >> 6, gc_ = r_ & 63, s_ = r_ - T_LAT; \
    const bool v0_ = lat_ && gr_ > 0, v1_ = lat_ && gr_ < 255, v2_ = lat_ ? gc_ > 0 : s_ > 0, v3_ = lat_ ? gc_ < 63 : s_ < T_CTX - 1; \
    nb_o0 = v0_ ? -64 * DIN : 0; nb_o1 = v1_ ? 64 * DIN : 0; nb_o2 = v2_ ? -DIN : 0; nb_o3 = v3_ ? DIN : 0; \
    nb_f0 = v0_ ? 1.f : 0.f; nb_f1 = v1_ ? 1.f : 0.f; nb_f2 = v2_ ? 1.f : 0.f; nb_f3 = v3_ ? 1.f : 0.f; nb_scale = lat_ ? 0.25f : 0.5f; }
#define MIX4(pc, mup) mix4_((pc), (mup), nb_o0, nb_o1, nb_o2, nb_o3, nb_f0, nb_f1, nb_f2, nb_f3, nb_scale)
DI f32x4 ld4bf(const bfr* p) {
  const uint2 u = *(const uint2*)p;
  return f32x4{__uint_as_float(u.x << 16), __uint_as_float(u.x & 0xffff0000u), __uint_as_float(u.y << 16), __uint_as_float(u.y & 0xffff0000u)};
}
DI f32x4 mix4_(const bfr* pc, const float* mu, int o0, int o1, int o2, int o3, float f0, float f1, float f2, float f3, float scale) {
  const f32x4 c = ld4bf(pc);
  f32x4 s = ld4bf(pc + o0) * f0 + ld4bf(pc + o1) * f1 + ld4bf(pc + o2) * f2 + ld4bf(pc + o3) * f3;
  const f32x4 m = *(const f32x4*)mu;
  return c + (s * scale - c) * m;
}
DI void ld8bf(const bfr* p, f32x4& lo, f32x4& hi) {
  const uint4 u = *(const uint4*)p;
  lo = f32x4{__uint_as_float(u.x << 16), __uint_as_float(u.x & 0xffff0000u), __uint_as_float(u.y << 16), __uint_as_float(u.y & 0xffff0000u)};
  hi = f32x4{__uint_as_float(u.z << 16), __uint_as_float(u.z & 0xffff0000u), __uint_as_float(u.w << 16), __uint_as_float(u.w & 0xffff0000u)};
}
DI void mix8_(const bfr* pc, const float* mu, int o0, int o1, int o2, int o3, float f0, float f1, float f2, float f3, float scale, f32x4& lo, f32x4& hi) {
  f32x4 cl, chh, al, ah, bl, bh, dl, dh, el, eh;
  ld8bf(pc, cl, chh); ld8bf(pc + o0, al, ah); ld8bf(pc + o1, bl, bh); ld8bf(pc + o2, dl, dh); ld8bf(pc + o3, el, eh);
  const f32x4 sl = al * f0 + bl * f1 + dl * f2 + el * f3, sh = ah * f0 + bh * f1 + dh * f2 + eh * f3;
  const f32x4 ml = *(const f32x4*)mu, mh = *(const f32x4*)(mu + 4);
  lo = cl + (sl * scale - cl) * ml; hi = chh + (sh * scale - chh) * mh;
}
#define MIX8(pc, mup, lo, hi) mix8_((pc), (mup), nb_o0, nb_o1, nb_o2, nb_o3, nb_f0, nb_f1, nb_f2, nb_f3, nb_scale, lo, hi)
DI float ftanh_(float x) { const float e = __expf(2.f * x); return 1.f - 2.f * frcp_(e + 1.f); }
DI uint2 pk4(f32x4 v) { return uint2{pack2(v[0], v[1]), pack2(v[2], v[3])}; }
constexpr int LIS = 200;
constexpr int MXS = 388;
DI void phase_rwprep(CParams& P, int bid, int nb, char* smem) {
  const bfr* p = (const bfr*)(P.ws + WS_P);
  const float* mu = P.in[10]; const float* w0 = P.in[11]; const float* a0 = P.in[13];
  const float* k_k = P.in[16]; const float* k_a = P.in[17];
  const bfr* LW_ = (const bfr*)(P.ws + WS_LORA);
  unsigned* RKV = (unsigned*)(P.ws + WS_RW);
  bfr* G = (bfr*)(P.ws + WS_RW + 5 * RW_ARR);
  unsigned* LWAF = (unsigned*)(P.ws + WS_LW); unsigned* LWAB = (unsigned*)(P.ws + WS_LW + LW_ARR);
  short* LI = (short*)smem;
  float* MX = (float*)(smem + 32 * LIS * 2);
  const int tid = VT, lane = tid & 63, w = tid >> 6, fr = lane & 15, fq = lane >> 4;
  const f32x4 z4 = {0.f, 0.f, 0.f, 0.f};
  constexpr int NT_LAT = T_LAT / 32, NT_CTX = T_CTX / 32;
  const int n_lat = (NT_LAT - bid + nb - 1) / nb, n_ctx = (NT_CTX * 4 - bid + nb - 1) / nb;
  for (int wi = 0; wi < n_lat + n_ctx; ++wi) {
  const bool lat = wi < n_lat;
  const int ci_ = bid + (wi - n_lat) * nb;
  const int tile = lat ? bid + wi * nb : NT_LAT + (ci_ >> 2);
  const int hp_lo = lat ? 0 : (ci_ & 3), hp_hi = lat ? 4 : hp_lo + 1;
  const int row0 = tile * 32;
  LBAR();
#pragma unroll
  for (int i = 0; i < 3; ++i) {
    const int v = tid + i * NTHR;
    const int t = v / 24, g = v % 24;
    const int row = row0 + t;
    NB_DECL(row);
    f32x4 lo, hi;
    const bfr* pc = p + (size_t)row * DIN + HGC + 1536 + g * 8;
    MIX8(pc, mu + 1536 + g * 8, lo, hi);
#pragma unroll
    for (int e = 0; e < 4; ++e) {
      if (g < 8) { lo[e] = ftanh_(lo[e]); hi[e] = ftanh_(hi[e]); }
      else if (g >= 12) { lo[e] = sigmoidf_(lo[e]); hi[e] = sigmoidf_(hi[e]); }
    }
    const uint2 a = pk4(lo), b = pk4(hi);
    *(uint4*)(LI + t * LIS + g * 8) = uint4{a.x, a.y, b.x, b.y};
  }
#pragma unroll 1
  for (int hp = hp_lo; hp < hp_hi; ++hp) {
  if (hp != hp_lo) LBAR();
#pragma unroll 2
  for (int i = 0; i < 6; ++i) {
    const int v = tid + i * NTHR;
    const int t = v / 48, cg = v % 48;
    const int row = row0 + t;
    NB_DECL(row);
    f32x4 lo, hi;
    const int a = cg >> 4, c8 = cg & 15;
    const int col = a * 512 + hp * 128 + c8 * 8;
    MIX8(p + (size_t)row * DIN + HGC + col, mu + col, lo, hi);
    *(f32x4*)(MX + t * MXS + a * 128 + c8 * 8) = lo; *(f32x4*)(MX + t * MXS + a * 128 + c8 * 8 + 4) = hi;
  }
  asm volatile("" ::: "memory");
  bf16x8 afr[4][6];
  {
    const int h = hp * 2 + (w >> 1);
#pragma unroll
    for (int m = 0; m < 4; ++m) {
      const int c0 = 64 * h + 16 * m;
      afr[m][0] = *(const bf16x8*)(LW_ + LORA_WD2T + (c0 + fr) * 32 + fq * 8);
      afr[m][1] = *(const bf16x8*)(LW_ + LORA_WD2T + 512 * 32 + (c0 + fr) * 32 + fq * 8);
      afr[m][2] = *(const bf16x8*)(LW_ + LORA_WA2T + (c0 + fr) * 32 + fq * 8);
#pragma unroll
      for (int ks = 0; ks < 3; ++ks) afr[m][3 + ks] = *(const bf16x8*)(LW_ + LORA_WG2T + (c0 + fr) * 96 + ks * 32 + fq * 8);
    }
  }
  LBAR();
  {
    const int hl = w >> 1, th = w & 1, h = hp * 2 + hl;
    const int row = row0 + 16 * th + fr;
    const float* mrow = MX + (16 * th + fr) * MXS + hl * 64 + 4 * fq;
    f32x4 kkr[4], kraw[4], av[4];
    float ss = 0.f;
    f32x4 kap[4], nw0f, nw0b, na0, nkk;
#pragma unroll
    for (int m = 0; m < 4; ++m) kap[m] = *(const f32x4*)(k_a + 64 * h + 16 * m + 4 * fq);
    { const int ch0 = 64 * h + 4 * fq; nw0f = *(const f32x4*)(w0 + ch0); nw0b = *(const f32x4*)(w0 + 512 + ch0); na0 = *(const f32x4*)(a0 + ch0); nkk = *(const f32x4*)(k_k + ch0); }
#pragma unroll
    for (int m = 0; m < 4; ++m) {
      const int c0 = 64 * h + 16 * m;
      const int ch = c0 + 4 * fq;
      const f32x4 w0f = nw0f, w0b = nw0b, a0v = na0, kkp = nkk;
      if (m < 3) { const int ch1 = ch + 16; nw0f = *(const f32x4*)(w0 + ch1); nw0b = *(const f32x4*)(w0 + 512 + ch1); na0 = *(const f32x4*)(a0 + ch1); nkk = *(const f32x4*)(k_k + ch1); }
      kraw[m] = *(const f32x4*)(mrow + 128 + 16 * m);
      const short* lrow = LI + (16 * th + fr) * LIS + fq * 8;
      f32x4 aF = __builtin_amdgcn_mfma_f32_16x16x32_bf16(afr[m][0], *(const bf16x8*)(lrow), z4, 0, 0, 0);
      f32x4 aB = __builtin_amdgcn_mfma_f32_16x16x32_bf16(afr[m][1], *(const bf16x8*)(lrow + 32), z4, 0, 0, 0);
      f32x4 aA = __builtin_amdgcn_mfma_f32_16x16x32_bf16(afr[m][2], *(const bf16x8*)(lrow + 64), z4, 0, 0, 0);
      f32x4 aG = z4;
#pragma unroll
      for (int ks = 0; ks < 3; ++ks) aG = __builtin_amdgcn_mfma_f32_16x16x32_bf16(afr[m][3 + ks], *(const bf16x8*)(lrow + 96 + ks * 32), aG, 0, 0, 0);
      const size_t o = (size_t)row * 512 + ch;
      f32x4 lwf, lwb;
#pragma unroll
      for (int e = 0; e < 4; ++e) {
        lwf[e] = -RW_DECAY_SCALE * sigmoidf_(w0f[e] + aF[e]);
        lwb[e] = -RW_DECAY_SCALE * sigmoidf_(w0b[e] + aB[e]);
        av[m][e] = sigmoidf_(a0v[e] + aA[e]);
      }
      *(uint4*)(LWAF + o) = uint4{pack2(lwf[0], av[m][0]), pack2(lwf[1], av[m][1]), pack2(lwf[2], av[m][2]), pack2(lwf[3], av[m][3])};
      *(uint4*)(LWAB + o) = uint4{pack2(lwb[0], av[m][0]), pack2(lwb[1], av[m][1]), pack2(lwb[2], av[m][2]), pack2(lwb[3], av[m][3])};
      *(uint2*)(G + o) = pk4(aG);
      kkr[m] = kraw[m] * kkp;
      ss += kkr[m][0] * kkr[m][0] + kkr[m][1] * kkr[m][1] + kkr[m][2] * kkr[m][2] + kkr[m][3] * kkr[m][3];
    }
    ss += __shfl_xor(ss, 16); ss += __shfl_xor(ss, 32);
    const float rn = rsqrtf(fmaxf(ss, 1e-12f));
#pragma unroll
    for (int m = 0; m < 4; ++m) {
      const int ch = 64 * h + 16 * m + 4 * fq;
      const size_t o = (size_t)row * 512 + ch;
      const f32x4 ka = kap[m];
      f32x4 kv;
#pragma unroll
      for (int e = 0; e < 4; ++e) kv[e] = kraw[m][e] * (1.f + (av[m][e] - 1.f) * ka[e]);
      const f32x4 r = *(const f32x4*)(mrow + 16 * m), v = *(const f32x4*)(mrow + 256 + 16 * m), kkn = kkr[m] * rn;
      *(uint4*)(RKV + 2 * o) = uint4{pack2(r[0], kv[0]), pack2(v[0], kkn[0]), pack2(r[1], kv[1]), pack2(v[1], kkn[1])};
      *(uint4*)(RKV + 2 * o + 4) = uint4{pack2(r[2], kv[2]), pack2(v[2], kkn[2]), pack2(r[3], kv[3]), pack2(v[3], kkn[3])};
    }
  }
  }
  }
}

constexpr size_t WS_WRT = 512 * 1024;
DI void phase_wrt_convert(CParams& P, int part, int nparts) {
  const float* wgrp = P.in[25]; const float* wrt = P.in[27];
  bfr* Whi = (bfr*)(P.ws + WS_WRT); bfr* Wlo = Whi + 80 * 1024;
  for (int i = part * NTHR + VT; i < 80 * 1024; i += nparts * NTHR) {
    const int o = i >> 10, k = i & 1023;
    float wv = 0.f;
    if (o < 8) wv = wgrp[k * 8 + o]; else if (o < 72) wv = wrt[k * 64 + (o - 8)];
    const bfr hi = f2bf(wv);
    Whi[i] = hi; Wlo[i] = f2bf(wv - bf2f(hi));
  }
}
constexpr int HLS = 1032;
DI void phase_ln2route(CParams& P, char* smem_all) {
  const float* x = P.in[0];
  const bfr* y = (const bfr*)(P.ws + WS_Y);
  const float* mod = (const float*)(P.ws + WS_MOD);
  const float* ln1_g = P.in[21]; const float* ln1_b = P.in[22];
  const float* bgrp = P.in[26]; const float* brt = P.in[28];
  const bfr* Whi = (const bfr*)(P.ws + WS_WRT);
  bfr* x1 = (bfr*)(P.ws + WS_X1B);
  unsigned char* h2 = (unsigned char*)(P.ws + WS_H2);
  int* cnt = (int*)(P.ws + WS_CNT); int* list = (int*)(P.ws + WS_LIST); float* asgw = (float*)(P.ws + WS_ASGW);
  short* HI = (short*)smem_all;
  float* LG = (float*)(smem_all + 2 * 32 * HLS * 2);
  float* PS = LG + 32 * 80;
  const int tid = tx_(), wid = tid >> 6, lane = tid & 63, fr = lane & 15, fq = lane >> 4;
  f32x4 pl1g[4], pl1b[4], psh[4], psc[4];
#pragma unroll
  for (int i = 0; i < 4; ++i) {
    const int c = lane * 4 + 256 * i;
    pl1g[i] = *(const f32x4*)(ln1_g + c); pl1b[i] = *(const f32x4*)(ln1_b + c);
    psh[i] = *(const f32x4*)(mod + 3072 + c); psc[i] = *(const f32x4*)(mod + 4096 + c) + 1.f;
  }
  float* G1L = (float*)(smem_all + 32 * HLS * 2);
  for (int i = tid; i < DM; i += NTHR_BLOCK) G1L[i] = mod[2048 + i];
  for (int grp = blockIdx.x; grp < T_LAT / 32; grp += gridDim.x) {
    const int t0 = grp * 32;
    __syncthreads();
    f32x4 xin[4][4]; uint2 yin[4][4];
#pragma unroll
    for (int tt = 0; tt < 4; ++tt)
#pragma unroll
      for (int i = 0; i < 4; ++i) {
        const long o = (long)(t0 + wid * 4 + tt) * DM + lane * 4 + 256 * i;
        xin[tt][i] = *(const f32x4*)(x + o); yin[tt][i] = *(const uint2*)(y + o);
      }
#pragma unroll
    for (int tt = 0; tt < 4; ++tt) {
      const int tl = wid * 4 + tt, t = t0 + tl;
      f32x4 v[4]; float s = 0.f;
#pragma unroll
      for (int i = 0; i < 4; ++i) {
        const int c = lane * 4 + 256 * i;
        const f32x4 g1 = *(const f32x4*)(G1L + c);
        const uint2 u = yin[tt][i];
        const f32x4 yv = {__uint_as_float(u.x << 16), __uint_as_float(u.x & 0xffff0000u), __uint_as_float(u.y << 16), __uint_as_float(u.y & 0xffff0000u)};
        v[i] = xin[tt][i] * DN_ALPHA + g1 * yv;
        s += v[i][0] + v[i][1] + v[i][2] + v[i][3];
      }
      float mu = wave_sum(s) * (1.f / DM); float q = 0.f;
#pragma unroll
      for (int i = 0; i < 4; ++i) { v[i] -= mu; q += v[i][0] * v[i][0] + v[i][1] * v[i][1] + v[i][2] * v[i][2] + v[i][3] * v[i][3]; }
      float rs = rsqrtf(wave_sum(q) * (1.f / DM) + 1e-5f);
      s = 0.f;
#pragma unroll
      for (int i = 0; i < 4; ++i) {
        const int c = lane * 4 + 256 * i;
        const f32x4 g = pl1g[i], b = pl1b[i];
        v[i] = v[i] * rs * g + b;
        *(uint2*)(x1 + (long)t * DM + c) = pk4(v[i]);
        s += v[i][0] + v[i][1] + v[i][2] + v[i][3];
      }
      mu = wave_sum(s) * (1.f / DM); q = 0.f;
#pragma unroll
      for (int i = 0; i < 4; ++i) { v[i] -= mu; q += v[i][0] * v[i][0] + v[i][1] * v[i][1] + v[i][2] * v[i][2] + v[i][3] * v[i][3]; }
      rs = rsqrtf(wave_sum(q) * (1.f / DM) + 1e-5f);
#pragma unroll
      for (int i = 0; i < 4; ++i) {
        const int c = lane * 4 + 256 * i;
        v[i] = v[i] * rs * psc[i] + psh[i];
        const uint2 whi = {pack2(v[i][0], v[i][1]), pack2(v[i][2], v[i][3])};
        *(unsigned*)(h2 + (long)t * DM + c) = pk4_f8(v[i][0], v[i][1], v[i][2], v[i][3]);
        *(uint2*)(HI + tl * HLS + c) = whi;
      }
    }
    __syncthreads();
    {
      const int own = wid < 4;
      const int mrow = own ? 16 * wid : 64;
      f32x4 acc0 = {0.f, 0.f, 0.f, 0.f}, acc1 = {0.f, 0.f, 0.f, 0.f};
      bf16x8 a[8], an[8];
      const int nbatch = own ? 4 : 1;
#define RT_LOAD(bi_, dst) do { const int kb_ = own ? ((bi_) * 8) : ((wid - 4) * 8); \
        _Pragma("unroll") for (int u = 0; u < 8; ++u) dst[u] = *(const bf16x8*)(Whi + (size_t)(mrow + fr) * 1024 + (kb_ + u) * 32 + fq * 8); } while (0)
      RT_LOAD(0, a);
#pragma unroll 1
      for (int bi = 0; bi < nbatch; ++bi) {
        if (bi + 1 < nbatch) RT_LOAD(bi + 1, an);
        const int kb = own ? (bi * 8) : ((wid - 4) * 8);
        const short* Hp = HI;
#pragma unroll
        for (int u = 0; u < 8; ++u) {
          const bf16x8 b0 = *(const bf16x8*)(Hp + fr * HLS + (kb + u) * 32 + fq * 8);
          const bf16x8 b1 = *(const bf16x8*)(Hp + (16 + fr) * HLS + (kb + u) * 32 + fq * 8);
          acc0 = __builtin_amdgcn_mfma_f32_16x16x32_bf16(a[u], b0, acc0, 0, 0, 0);
          acc1 = __builtin_amdgcn_mfma_f32_16x16x32_bf16(a[u], b1, acc1, 0, 0, 0);
        }
#pragma unroll
        for (int u = 0; u < 8; ++u) a[u] = an[u];
      }
#undef RT_LOAD
      if (own) {
#pragma unroll
        for (int reg = 0; reg < 4; ++reg) { LG[fr * 80 + mrow + 4 * fq + reg] = acc0[reg]; LG[(16 + fr) * 80 + mrow + 4 * fq + reg] = acc1[reg]; }
      } else {
#pragma unroll
        for (int reg = 0; reg < 4; ++reg) { PS[((wid - 4) * 32 + fr) * 16 + 4 * fq + reg] = acc0[reg]; PS[((wid - 4) * 32 + 16 + fr) * 16 + 4 * fq + reg] = acc1[reg]; }
      }
    }
    __syncthreads();
    {
      const int tk = tid >> 4, o = tid & 15;
      LG[tk * 80 + 64 + o] = (PS[(0 * 32 + tk) * 16 + o] + PS[(1 * 32 + tk) * 16 + o]) + (PS[(2 * 32 + tk) * 16 + o] + PS[(3 * 32 + tk) * 16 + o]);
    }
    __syncthreads();
    if (tid < 32) {
      const int t = t0 + tid;
      const float* lg = LG + tid * 80;
      int gi = 0; float gmax = -3.4e38f; float gl[8];
#pragma unroll
      for (int g = 0; g < 8; ++g) { gl[g] = lg[g] + bgrp[g]; if (gl[g] > gmax) { gmax = gl[g]; gi = g; } }
      float den = 0.f;
#pragma unroll
      for (int g = 0; g < 8; ++g) den += __expf(gl[g] - gmax);
      const float gprob = 1.f / den;
      int i1 = 0; float v1 = -3.4e38f; float el[8];
#pragma unroll
      for (int g = 0; g < 8; ++g) { el[g] = lg[8 + gi * 8 + g] + brt[gi * 8 + g]; if (el[g] > v1) { v1 = el[g]; i1 = g; } }
      int i2 = 0; float v2 = -3.4e38f;
#pragma unroll
      for (int g = 0; g < 8; ++g) { if (g != i1 && el[g] > v2) { v2 = el[g]; i2 = g; } }
      const float e2 = __expf(v2 - v1);
      const float wt1 = gprob / (1.f + e2), wt2 = gprob * e2 / (1.f + e2);
      const int ex1 = gi * 8 + i1, ex2 = gi * 8 + i2;
      const int s1 = atomicAdd(&cnt[ex1], 1), s2 = atomicAdd(&cnt[ex2], 1);
      list[ex1 * T_LAT + s1] = t * 2; list[ex2 * T_LAT + s2] = t * 2 + 1;
      asgw[t * 2] = wt1; asgw[t * 2 + 1] = wt2;
    }
  }
}

DI void phase_final(CParams& P, int bid, int nb) {
  const float* mod = (const float*)(P.ws + WS_MOD);
  const float* ln2_g = P.in[23]; const float* ln2_b = P.in[24];
  const bfr* mout = (const bfr*)(P.ws + (42ull << 20));
  const bfr* x1b = (const bfr*)(P.ws + WS_X1B);
  const float* asgw = (const float*)(P.ws + WS_ASGW);
  float* out = P.out;
  const int wid = VT >> 6, lane = VT & 63;
  f32x4 plg[4], plb[4];
#pragma unroll
  for (int i = 0; i < 4; ++i) { const int c = lane * 4 + 256 * i; plg[i] = *(const f32x4*)(ln2_g + c); plb[i] = *(const f32x4*)(ln2_b + c); }
  for (int t0 = (bid * 4 + wid) * 2; t0 < T_LAT; t0 += nb * 8) {
    f32x4 v[2][4]; float s[2] = {0.f, 0.f};
#pragma unroll
    for (int r = 0; r < 2; ++r) {
      const int t = t0 + r;
      const float w1 = asgw[t * 2], w2 = asgw[t * 2 + 1];
#pragma unroll
      for (int i = 0; i < 4; ++i) {
        const int c = lane * 4 + 256 * i;
        const f32x4 xv = ld4bf(x1b + (long)t * DM + c), g2 = *(const f32x4*)(mod + 5120 + c);
        const f32x4 a = ld4bf(mout + (long)(2 * t) * DM + c), b = ld4bf(mout + (long)(2 * t + 1) * DM + c);
        v[r][i] = xv * DN_ALPHA + g2 * (a * w1 + b * w2);
        s[r] += v[r][i][0] + v[r][i][1] + v[r][i][2] + v[r][i][3];
      }
    }
#pragma unroll
    for (int r = 0; r < 2; ++r) {
      const float mu = wave_sum(s[r]) * (1.f / DM); float q = 0.f;
#pragma unroll
      for (int i = 0; i < 4; ++i) { v[r][i] -= mu; q += v[r][i][0] * v[r][i][0] + v[r][i][1] * v[r][i][1] + v[r][i][2] * v[r][i][2] + v[r][i][3] * v[r][i][3]; }
      const float rs = rsqrtf(wave_sum(q) * (1.f / DM) + 1e-5f);
#pragma unroll
      for (int i = 0; i < 4; ++i) {
        const int c = lane * 4 + 256 * i;
        *(f32x4*)(out + (long)(t0 + r) * DM + c) = v[r][i] * rs * plg[i] + plb[i];
      }
    }
  }
}

DI void phase_readout_fused(CParams& P, int bid, int nb) {
  const bfr* p = (const bfr*)(P.ws + WS_P);
  const unsigned* RKV = (const unsigned*)(P.ws + WS_RW);
  const bfr* G = (const bfr*)(P.ws + WS_RW + 5 * RW_ARR);
  const float* hg_norm_w = P.in[9]; const float* r_k = P.in[18]; const float* gn_w = P.in[19]; const float* gn_b = P.in[20];
  bfr* mix = (bfr*)(P.ws + WS_MIX);
  const int tid = VT, lane = tid & 63, w = tid >> 6, fr = lane & 15, fq = lane >> 4;
  const f32x4 z4 = {0.f, 0.f, 0.f, 0.f};
  for (int tile = bid; tile < T_LAT / 32; tile += nb) {
    const int t0 = tile * 32;
#pragma unroll 1
    for (int hh = 0; hh < 2; ++hh) {
      const int hd = 2 * w + hh;
      f32x4 acc[4][2];
#pragma unroll
      for (int m = 0; m < 4; ++m) { acc[m][0] = z4; acc[m][1] = z4; }
#pragma unroll
      for (int dir = 0; dir < 2; ++dir) {
        const int ci = dir ? (519 - tile) : (8 + tile);
        const int sc = rw_sc_of_chunk(ci);
        const bfr* Bq = (const bfr*)(P.ws + WS_R2P) + (size_t)dir * T_LAT * 512 + (size_t)t0 * 512 + hd * 64;
        const bfr* Y0 = (const bfr*)(P.ws + WS_Y0P) + (size_t)dir * T_LAT * 512 + (size_t)t0 * 512 + hd * 64;
        const bfr* Sin = (const bfr*)(P.ws + WS_SINRW) + ((size_t)(dir * 8 + hd) * (RW_NSC + 1) + sc) * 4096;
        bf16x8 bq[2][2], af[2][4]; uint2 y0r[4][2];
#pragma unroll
        for (int ks = 0; ks < 2; ++ks) {
#pragma unroll
          for (int n = 0; n < 2; ++n) bq[ks][n] = *(const bf16x8*)(Bq + (size_t)(16 * n + fr) * 512 + 32 * ks + fq * 8);
#pragma unroll
          for (int m = 0; m < 4; ++m) af[ks][m] = *(const bf16x8*)(Sin + (16 * m + fr) * 64 + 32 * ks + fq * 8);
        }
#pragma unroll
        for (int m = 0; m < 4; ++m)
#pragma unroll
          for (int n = 0; n < 2; ++n) y0r[m][n] = *(const uint2*)(Y0 + (size_t)(16 * n + fr) * 512 + 16 * m + 4 * fq);
        asm volatile("" ::: "memory");
#pragma unroll
        for (int ks = 0; ks < 2; ++ks)
#pragma unroll
          for (int m = 0; m < 4; ++m)
#pragma unroll
            for (int n = 0; n < 2; ++n) acc[m][n] = __builtin_amdgcn_mfma_f32_16x16x32_bf16(af[ks][m], bq[ks][n], acc[m][n], 0, 0, 0);
#pragma unroll
        for (int m = 0; m < 4; ++m)
#pragma unroll
          for (int n = 0; n < 2; ++n) { const uint2 u = y0r[m][n]; acc[m][n] += f32x4{__uint_as_float(u.x << 16), __uint_as_float(u.x & 0xffff0000u), __uint_as_float(u.y << 16), __uint_as_float(u.y & 0xffff0000u)}; }
      }
#pragma unroll
      for (int n = 0; n < 2; ++n) {
        const size_t trow = (size_t)(t0 + 16 * n + fr) * 512 + hd * 64;
        float s = 0.f, bs = 0.f;
        f32x4 vv[4];
        uint4 rkp_[4], vkp_[4]; uint2 gg_[4]; f32x4 rk_[4], gw_[4], gb_[4];
#pragma unroll
        for (int m = 0; m < 4; ++m) {
          const int c = 16 * m + 4 * fq;
          rkp_[m] = *(const uint4*)(RKV + 2 * (trow + c)); vkp_[m] = *(const uint4*)(RKV + 2 * (trow + c) + 4); gg_[m] = *(const uint2*)(G + trow + c);
          rk_[m] = *(const f32x4*)(r_k + hd * 64 + c); gw_[m] = *(const f32x4*)(gn_w + hd * 64 + c); gb_[m] = *(const f32x4*)(gn_b + hd * 64 + c);
        }
        asm volatile("" ::: "memory");
#define RO_BF4(u) f32x4{__uint_as_float((u).x << 16), __uint_as_float((u).x & 0xffff0000u), __uint_as_float((u).y << 16), __uint_as_float((u).y & 0xffff0000u)}
#pragma unroll
        for (int m = 0; m < 4; ++m) {
          s += acc[m][n][0] + acc[m][n][1] + acc[m][n][2] + acc[m][n][3];
          const uint4 a_ = rkp_[m], b_ = vkp_[m];
          const f32x4 rr = {__uint_as_float(a_.x << 16), __uint_as_float(a_.z << 16), __uint_as_float(b_.x << 16), __uint_as_float(b_.z << 16)};
          const f32x4 kk2 = {__uint_as_float(a_.x & 0xffff0000u), __uint_as_float(a_.z & 0xffff0000u), __uint_as_float(b_.x & 0xffff0000u), __uint_as_float(b_.z & 0xffff0000u)}, rk = rk_[m];
          vv[m] = f32x4{__uint_as_float(a_.y << 16), __uint_as_float(a_.w << 16), __uint_as_float(b_.y << 16), __uint_as_float(b_.w << 16)};
          bs += rr[0] * kk2[0] * rk[0] + rr[1] * kk2[1] * rk[1] + rr[2] * kk2[2] * rk[2] + rr[3] * kk2[3] * rk[3];
        }
        s += __shfl_xor(s, 16); s += __shfl_xor(s, 32);
        bs += __shfl_xor(bs, 16); bs += __shfl_xor(bs, 32);
        const float mu = s * (1.f / 64.f);
        float q = 0.f;
#pragma unroll
        for (int m = 0; m < 4; ++m) { acc[m][n] -= mu; q += acc[m][n][0] * acc[m][n][0] + acc[m][n][1] * acc[m][n][1] + acc[m][n][2] * acc[m][n][2] + acc[m][n][3] * acc[m][n][3]; }
        q += __shfl_xor(q, 16); q += __shfl_xor(q, 32);
        const float rs = rsqrtf(q * (1.f / 64.f) + 64e-5f);
#pragma unroll
        for (int m = 0; m < 4; ++m) {
          const int c = hd * 64 + 16 * m + 4 * fq;
          const f32x4 gw = gw_[m], gb = gb_[m], gg = RO_BF4(gg_[m]);
          const f32x4 o = (acc[m][n] * rs * gw + gb + vv[m] * bs) * gg;
          *(uint2*)(mix + (size_t)(t0 + 16 * n + fr) * DM + 512 + c) = pk4(o);
        }
      }
    }
    {
      const int hd = w;
      f32x4 acc[8][2];
#pragma unroll
      for (int m = 0; m < 8; ++m) { acc[m][0] = z4; acc[m][1] = z4; }
#pragma unroll
      for (int dir = 0; dir < 2; ++dir) {
        const int ci = dir ? (519 - tile) : (8 + tile);
        const int sc = hg_sc_of_chunk(ci);
        const bfr* Bq = (const bfr*)(P.ws + WS_QH) + (size_t)dir * T_LAT * 512 + (size_t)t0 * 512 + hd * 128;
        const bfr* O0 = (const bfr*)(P.ws + WS_O0) + (size_t)dir * T_LAT * 512 + (size_t)t0 * 512 + hd * 128;
        const bfr* Sin = (const bfr*)(P.ws + WS_SINHG) + ((size_t)(dir * 4 + hd) * HG_NSC + sc) * 16384;
#pragma unroll
        for (int k0 = 0; k0 < 128; k0 += 32) {
          bf16x8 bq[2];
#pragma unroll
          for (int n = 0; n < 2; ++n) bq[n] = *(const bf16x8*)(Bq + (size_t)(16 * n + fr) * 512 + k0 + fq * 8);
#pragma unroll
          for (int m = 0; m < 8; ++m) {
            const bf16x8 a = *(const bf16x8*)(Sin + (16 * m + fr) * 128 + k0 + fq * 8);
#pragma unroll
            for (int n = 0; n < 2; ++n) acc[m][n] = __builtin_amdgcn_mfma_f32_16x16x32_bf16(a, bq[n], acc[m][n], 0, 0, 0);
          }
        }
#pragma unroll
        for (int m = 0; m < 8; ++m)
#pragma unroll
          for (int n = 0; n < 2; ++n) acc[m][n] += ld4bf(O0 + (size_t)(16 * n + fr) * 512 + 16 * m + 4 * fq);
      }
#pragma unroll
      for (int n = 0; n < 2; ++n) {
        const int t = t0 + 16 * n + fr;
        uint2 ggp[8]; f32x4 nwv[8];
#pragma unroll
        for (int m = 0; m < 8; ++m) { const int c = hd * 128 + 16 * m + 4 * fq; ggp[m] = *(const uint2*)(p + (size_t)t * DIN + 2048 + c); nwv[m] = *(const f32x4*)(hg_norm_w + c); }
        asm volatile("" ::: "memory");
        float ss = 0.f;
#pragma unroll
        for (int m = 0; m < 8; ++m) ss += acc[m][n][0] * acc[m][n][0] + acc[m][n][1] * acc[m][n][1] + acc[m][n][2] * acc[m][n][2] + acc[m][n][3] * acc[m][n][3];
        ss += __shfl_xor(ss, 16); ss += __shfl_xor(ss, 32);
        const float rs = rsqrtf(ss * (1.f / 128.f) + 1e-6f);
#pragma unroll
        for (int m = 0; m < 8; ++m) {
          const int c = hd * 128 + 16 * m + 4 * fq;
          const f32x4 nw = nwv[m], gg = RO_BF4(ggp[m]);
          f32x4 o;
#pragma unroll
          for (int e = 0; e < 4; ++e) o[e] = acc[m][n][e] * rs * nw[e] * siluf_(gg[e]);
          *(uint2*)(mix + (size_t)t * DM + c) = pk4(o);
        }
      }
    }
  }
}

namespace pg8 {
#define PG8_LAS __attribute__((address_space(3)))
typedef unsigned short bf16_t;
typedef short bf16x8 __attribute__((ext_vector_type(8)));
typedef float f32x4 __attribute__((ext_vector_type(4)));
typedef unsigned u32x4 __attribute__((ext_vector_type(4)));
typedef int i32x4 __attribute__((ext_vector_type(4)));
typedef int i32x8 __attribute__((ext_vector_type(8)));
__device__ __forceinline__ i32x8 cat8(bf16x8 a, bf16x8 b) { return __builtin_shufflevector(__builtin_bit_cast(i32x4, a), __builtin_bit_cast(i32x4, b), 0, 1, 2, 3, 4, 5, 6, 7); }
constexpr int BM = 256, BK = 64, HALF = 128, HTB = HALF * BK * 2  , STAGE_BYTES = 8 * HTB, NXCD = 8, WGM = 8;

__host__ __device__ __forceinline__ int lds_byte(int r, int c) { const int st = (r >> 4) * 2 + (c >> 5), rr = r & 15, cc = c & 31, ob = rr * 64 + cc * 2; return st * 1024 + (ob ^ (((ob >> 9) & 1) << 5)); }
__host__ __device__ __forceinline__ void stage_rc(int b, int& R, int& C) { const int st = b / 1024, sb = b % 1024, swz = sb ^ (((sb >> 9) & 1) << 5); R = (st >> 1) * 16 + swz / 64; C = (st & 1) * 32 + (swz % 64) / 2; }
__host__ __device__ __forceinline__ int perm32(int rho) { const int n = rho >> 4, i = rho & 15; return 8 * (i >> 2) + 4 * n + (i & 3); }

struct Unit { int pm, pn; };
struct Gemm { const bf16_t* A; const bf16_t* Bt; int M, N, K; const bf16_t* Bt2; int pn_split; };

struct StaticOrder {
    int nM, nN, nwg, G, c;
    __host__ __device__ void init(int M, int N, int G_, int c_) { nM = M / BM; nN = N / BM; nwg = nM * nN; G = G_; c = c_; }
    __host__ __device__ bool next(int i, Unit& u) const {
        const long L = (long)i * G + c; if (L >= nwg) return false;
        int wgid = (int)L; { const int q = nwg / NXCD, r = nwg % NXCD, xcd = wgid % NXCD, off = wgid / NXCD; wgid = (xcd < r ? xcd * (q + 1) : r * (q + 1) + (xcd - r) * q) + off; }
        const int nig = WGM * nN, gid = wgid / nig, fm = gid * WGM, gsz = (nM - fm) < WGM ? (nM - fm) : WGM;
        u.pm = fm + ((wgid % nig) % gsz); u.pn = (wgid % nig) / gsz; return true;
    }
    __device__ __forceinline__ void a_ready(const Unit&) const {}
    __device__ __forceinline__ void done(const Unit&) const {}
};
struct CountedOrder : StaticOrder {
    const unsigned* ready; unsigned need; unsigned* tmo;
    __device__ __forceinline__ void a_ready(const Unit& u) const {
        if (threadIdx.x < 64) {
            const unsigned long long t0 = __builtin_amdgcn_s_memrealtime(); unsigned polls = 0;
            while ((unsigned)__builtin_amdgcn_readfirstlane(__hip_atomic_load(ready + 64 * u.pm, __ATOMIC_RELAXED, __HIP_MEMORY_SCOPE_AGENT)) < need) {
                if ((++polls & 255u) == 0u && __builtin_amdgcn_readfirstlane(__hip_atomic_load(tmo, __ATOMIC_RELAXED, __HIP_MEMORY_SCOPE_AGENT)) != 0u) break;
                if (__builtin_amdgcn_s_memrealtime() - t0 > 2000000ull) {
                    if (threadIdx.x == 0) { unsigned expect = 0u; __hip_atomic_compare_exchange_strong(tmo + 1, &expect, 0x600u | (unsigned)(u.pm & 0xff), __ATOMIC_RELAXED, __ATOMIC_RELAXED, __HIP_MEMORY_SCOPE_AGENT); __hip_atomic_store(tmo, 1u, __ATOMIC_RELAXED, __HIP_MEMORY_SCOPE_AGENT); }
                    break; }
                __builtin_amdgcn_s_sleep(2); }
            __builtin_amdgcn_fence(__ATOMIC_ACQUIRE, "agent");
            asm volatile("s_waitcnt vmcnt(0)" ::: "memory");
        }
#if !defined(BROKEN_HOOK_NO_BARRIER)
        asm volatile("" ::: "memory"); __builtin_amdgcn_s_barrier(); asm volatile("" ::: "memory");
#endif
    }
};
struct EpiF32 {
    static constexpr bool PERM = false, AFTER_DRAIN = false, F8 = false;
    float* C; int ldc; const float* bias;
    __device__ __forceinline__ void operator()(const f32x4 (&acc)[2][2][4][2], const Unit& u, int wr, int wc, int fr, int fq) const {
        const int row0 = u.pm * BM + wr * 64 + fr, col0 = u.pn * BM + wc * 32 + 4 * fq;
        f32x4 bv[2][2];
#pragma unroll
        for (int bj = 0; bj < 2; ++bj)
#pragma unroll
            for (int n = 0; n < 2; ++n) bv[bj][n] = bias ? *(const f32x4*)(bias + col0 + bj * HALF + n * 16) : (f32x4){0.f, 0.f, 0.f, 0.f};
#pragma unroll
        for (int ai = 0; ai < 2; ++ai)
#pragma unroll
            for (int m = 0; m < 4; ++m) { float* rowp = C + (size_t)(row0 + ai * HALF + m * 16) * ldc + col0;
#pragma unroll
                for (int bj = 0; bj < 2; ++bj)
#pragma unroll
                    for (int n = 0; n < 2; ++n) *(f32x4*)(rowp + bj * HALF + n * 16) = acc[ai][bj][m][n] + bv[bj][n]; }
    }
};
template <class Epi, class Sched, bool STAMP = false>
__device__ __forceinline__ void gemm_phase(PG8_LAS unsigned char* lds, const Gemm g, const Sched& S, const Epi& E, unsigned long long* stamps) {
    int tid_ = threadIdx.x; asm volatile("" : "+v"(tid_));
    const int tid = tid_, wid = __builtin_amdgcn_readfirstlane(tid >> 6), lane = tid & 63, wr = wid >> 2, wc = wid & 3, fr = lane & 15, fq = lane >> 4;
    const int K = g.K, nt = K / BK;
    int ts_lo = 0, ts_hi = 0, nts = 0; const unsigned long long rt_entry = STAMP ? (unsigned long long)wall_clock64() : 0ull;
#define PG8_STAMP() do { if (STAMP && wid == 0 && nts < 64) { const unsigned long long _c = (unsigned long long)clock64(); \
        ts_lo = (lane == nts) ? (int)(unsigned)_c : ts_lo; ts_hi = (lane == nts) ? (int)(unsigned)(_c >> 32) : ts_hi; ++nts; } } while (0)
    PG8_STAMP();
    unsigned voffA[2], voffB[2];
#pragma unroll
    for (int i = 0; i < 2; ++i) { int R, C; stage_rc(tid * 16 + i * 8192, R, C); const int Rb = Epi::PERM ? ((R & ~31) + perm32(R & 31)) : R;
        voffA[i] = (unsigned)(R * K + C) * 2u; voffB[i] = (unsigned)(Rb * K + C) * 2u; }
    const size_t kstep = (size_t)(BK * 2);
    const size_t hstep = (size_t)HALF * K * 2;
    const size_t tstep = 2 * hstep;
    const unsigned ldsw = (unsigned)wid * 1024u;
    const int aoff = lds_byte(wr * 64 + fr, fq * 8), boff = lds_byte(wc * 32 + fr, fq * 8);
#define PG8_SA(b, h) (((b) * 2 + (h)) * HTB)
#define PG8_SB(b, h) ((4 + (b) * 2 + (h)) * HTB)
#define PG8_STAGE(bufoff, gbase, voff) do { _Pragma("unroll") for (int _i = 0; _i < 2; ++_i) \
        __builtin_amdgcn_global_load_lds((const unsigned*)((const char*)(gbase) + (voff)[_i]), (PG8_LAS unsigned*)(lds + (bufoff) + ldsw + _i * 8192), 16, 0, 0); } while (0)
#define PG8_LDA(dst, b, h) do { if constexpr (Epi::F8) { _Pragma("unroll") for (int m = 0; m < 4; ++m) dst##8[m] = cat8(*(const PG8_LAS bf16x8*)(lds + PG8_SA(b, h) + aoff + m * 2048), *(const PG8_LAS bf16x8*)(lds + PG8_SA(b, h) + aoff + m * 2048 + 1024)); } \
        else { _Pragma("unroll") for (int m = 0; m < 4; ++m) _Pragma("unroll") for (int k = 0; k < 2; ++k) dst[m][k] = *(const PG8_LAS bf16x8*)(lds + PG8_SA(b, h) + aoff + m * 2048 + k * 1024); } } while (0)
#define PG8_LDB(dst, b, h) do { if constexpr (Epi::F8) { _Pragma("unroll") for (int n = 0; n < 2; ++n) dst##8[n] = cat8(*(const PG8_LAS bf16x8*)(lds + PG8_SB(b, h) + boff + n * 2048), *(const PG8_LAS bf16x8*)(lds + PG8_SB(b, h) + boff + n * 2048 + 1024)); } \
        else { _Pragma("unroll") for (int n = 0; n < 2; ++n) _Pragma("unroll") for (int k = 0; k < 2; ++k) dst[n][k] = *(const PG8_LAS bf16x8*)(lds + PG8_SB(b, h) + boff + n * 2048 + k * 1024); } } while (0)
#define PG8_MMA(ai, bj, At, Bt) do { __builtin_amdgcn_s_setprio(1); \
        if constexpr (Epi::F8) { _Pragma("unroll") for (int m = 0; m < 4; ++m) _Pragma("unroll") for (int n = 0; n < 2; ++n) \
            asm volatile("v_mfma_scale_f32_16x16x128_f8f6f4 %0, %1, %2, %0, %3, %4 op_sel_hi:[0,0,0]" : "+v"(acc[ai][bj][m][n]) : "v"(Bt##8[n]), "v"(At##8[m]), "v"(f8_sw), "v"(f8_sa)); } \
        else { _Pragma("unroll") for (int m = 0; m < 4; ++m) _Pragma("unroll") for (int n = 0; n < 2; ++n) _Pragma("unroll") for (int k = 0; k < 2; ++k) \
            acc[ai][bj][m][n] = __builtin_amdgcn_mfma_f32_16x16x32_bf16(Bt[n][k], At[m][k], acc[ai][bj][m][n], 0, 0, 0); } \
        __builtin_amdgcn_s_setprio(0); } while (0)
#define PG8_WAIT_V(n) asm volatile("s_waitcnt vmcnt(" #n ")" ::: "memory")
#define PG8_WAIT_L(n) asm volatile("s_waitcnt lgkmcnt(" #n ")" ::: "memory")
#define PG8_BAR __builtin_amdgcn_s_barrier()
#define PG8_SCHED __builtin_amdgcn_sched_barrier(0)
    Unit cur, nxt; int ui = 0;
    if (!S.next(0, cur)) return;
    f32x4 acc[2][2][4][2];
#pragma unroll
    for (int a = 0; a < 2; ++a)
#pragma unroll
        for (int b = 0; b < 2; ++b)
#pragma unroll
            for (int m = 0; m < 4; ++m)
#pragma unroll
                for (int n = 0; n < 2; ++n) acc[a][b][m][n] = (f32x4){0.f, 0.f, 0.f, 0.f};
    bf16x8 At[4][2], B0[2][2], B1[2][2]; i32x8 At8[4], B08[2], B18[2];
    const int f8_sw = 0x7a7a7a7a, f8_sa = 0x7f7f7f7f;
    const char* cA = (const char*)g.A + (size_t)cur.pm * tstep; const char* cB = (const char*)g.Bt + (size_t)cur.pn * tstep;
    S.a_ready(cur);
    PG8_STAGE(PG8_SB(0, 0), cB, voffB); PG8_STAGE(PG8_SA(0, 0), cA, voffA); PG8_STAGE(PG8_SB(0, 1), cB + hstep, voffB); PG8_STAGE(PG8_SA(0, 1), cA + hstep, voffA);
    if (wr == 1) PG8_BAR;
    PG8_WAIT_V(4); PG8_BAR;
    PG8_STAGE(PG8_SB(1, 0), cB + kstep, voffB); PG8_STAGE(PG8_SA(1, 0), cA + kstep, voffA); PG8_STAGE(PG8_SB(1, 1), cB + hstep + kstep, voffB);
    PG8_WAIT_V(6); PG8_BAR;
    PG8_STAMP();
    for (;;) {
        const bool has_next = S.next(ui + 1, nxt);
        const char* nA = has_next ? (const char*)g.A + (size_t)nxt.pm * tstep : cA; const char* nB = has_next ? (const char*)g.Bt + (size_t)nxt.pn * tstep : cB;
        for (int t = 0; t < nt; t += 2) {
            const bool last = (t == nt - 2);
            const char* a1 = cA + (size_t)(t + 1) * kstep;
            const char* a2 = last ? nA : cA + (size_t)(t + 2) * kstep; const char* b2 = last ? nB : cB + (size_t)(t + 2) * kstep;
            const char* a3 = a2 + kstep; const char* b3 = b2 + kstep;
            if (last && has_next) S.a_ready(nxt);
            PG8_LDB(B0, 0, 0); PG8_SCHED; PG8_LDA(At, 0, 0); PG8_STAGE(PG8_SA(1, 1), a1 + hstep, voffA);
            PG8_WAIT_L(8); PG8_BAR; PG8_WAIT_L(0); PG8_MMA(0, 0, At, B0); PG8_BAR; PG8_SCHED;
            PG8_LDB(B1, 0, 1); PG8_STAGE(PG8_SB(0, 0), b2, voffB);
            PG8_BAR; PG8_WAIT_L(0); PG8_MMA(0, 1, At, B1); PG8_BAR;
            PG8_LDA(At, 0, 1); PG8_STAGE(PG8_SA(0, 0), a2, voffA);
            PG8_BAR; PG8_WAIT_L(0); PG8_MMA(1, 0, At, B0); PG8_BAR; PG8_SCHED;
            PG8_STAGE(PG8_SB(0, 1), b2 + hstep, voffB);
            PG8_WAIT_V(6); PG8_BAR; PG8_MMA(1, 1, At, B1); PG8_BAR;
            PG8_LDB(B0, 1, 0); PG8_SCHED; PG8_LDA(At, 1, 0); PG8_STAGE(PG8_SA(0, 1), a2 + hstep, voffA);
            PG8_WAIT_L(8); PG8_BAR; PG8_WAIT_L(0); PG8_MMA(0, 0, At, B0); PG8_BAR; PG8_SCHED;
            PG8_LDB(B1, 1, 1); PG8_STAGE(PG8_SB(1, 0), b3, voffB);
            PG8_BAR; PG8_WAIT_L(0); PG8_MMA(0, 1, At, B1); PG8_BAR;
            PG8_LDA(At, 1, 1); PG8_STAGE(PG8_SA(1, 0), a3, voffA);
            PG8_BAR; PG8_WAIT_L(0); PG8_MMA(1, 0, At, B0); PG8_BAR; PG8_SCHED;
            PG8_STAGE(PG8_SB(1, 1), b3 + hstep, voffB);
            PG8_WAIT_V(6); PG8_BAR; PG8_MMA(1, 1, At, B1); PG8_BAR;
        }
        PG8_STAMP();
        if constexpr (Epi::F8) asm volatile("s_nop 15\n\ts_nop 15\n\ts_nop 15" ::: "memory");
        if constexpr (!Epi::AFTER_DRAIN) { E(acc, cur, wr, wc, fr, fq); S.done(cur); }
        PG8_STAMP();
        if (!has_next) break;
#pragma unroll
        for (int a = 0; a < 2; ++a)
#pragma unroll
            for (int b = 0; b < 2; ++b)
#pragma unroll
                for (int m = 0; m < 4; ++m)
#pragma unroll
                    for (int n = 0; n < 2; ++n) acc[a][b][m][n] = (f32x4){0.f, 0.f, 0.f, 0.f};
        cur = nxt; cA = nA; cB = nB; ++ui;
    }
    PG8_WAIT_V(0);
    if (wr == 0) PG8_BAR;
    PG8_BAR;
    if constexpr (Epi::AFTER_DRAIN) { E.fused(acc, cur, wr, wc, fr, fq, lds, wid, lane); S.done(cur); }
    PG8_STAMP();
    if (STAMP && wid == 0) { stamps[lane] = lane < nts ? (((unsigned long long)(unsigned)ts_hi << 32) | (unsigned)ts_lo) : 0ull;
        if (lane == 62) stamps[62] = rt_entry; if (lane == 63) stamps[63] = (unsigned long long)wall_clock64(); }
#undef PG8_STAMP
#undef PG8_SA
#undef PG8_SB
#undef PG8_STAGE
#undef PG8_LDA
#undef PG8_LDB
#undef PG8_MMA
#undef PG8_WAIT_V
#undef PG8_WAIT_L
#undef PG8_BAR
#undef PG8_SCHED
}
template <class Epi, class Sched, class Gat, bool STAMP = false>
__device__ __forceinline__ void gemm_phase_gather(PG8_LAS unsigned char* lds, const Gemm g, const Sched& S, const Epi& E, const Gat& G, unsigned long long* stamps) {
    int tid_ = threadIdx.x; asm volatile("" : "+v"(tid_));
    const int tid = tid_, wid = __builtin_amdgcn_readfirstlane(tid >> 6), lane = tid & 63, wr = wid >> 2, wc = wid & 3, fr = lane & 15, fq = lane >> 4;
    const int K = g.K, nt = K / BK;
    int ts_lo = 0, ts_hi = 0, nts = 0; const unsigned long long rt_entry = STAMP ? (unsigned long long)wall_clock64() : 0ull;
#define PG8_STAMP() do { if (STAMP && wid == 0 && nts < 64) { const unsigned long long _c = (unsigned long long)clock64(); \
        ts_lo = (lane == nts) ? (int)(unsigned)_c : ts_lo; ts_hi = (lane == nts) ? (int)(unsigned)(_c >> 32) : ts_hi; ++nts; } } while (0)
    PG8_STAMP();
    unsigned voffA[2], voffB[2]; int RA[2]; unsigned CA2[2];
#pragma unroll
    for (int i = 0; i < 2; ++i) { int R, C; stage_rc(tid * 16 + i * 8192, R, C); const int Rb = Epi::PERM ? ((R & ~31) + perm32(R & 31)) : R;
        voffA[i] = (unsigned)(R * K + C) * 2u; voffB[i] = (unsigned)(Rb * K + C) * 2u; RA[i] = R; CA2[i] = (unsigned)C * 2u; }
    const size_t kstep = (size_t)(BK * 2);
    const size_t hstep = (size_t)HALF * K * 2;
    const size_t tstep = 2 * hstep;
    const unsigned ldsw = (unsigned)wid * 1024u;
    const int aoff = lds_byte(wr * 64 + fr, fq * 8), boff = lds_byte(wc * 32 + fr, fq * 8);
#define PG8_SA(b, h) (((b) * 2 + (h)) * HTB)
#define PG8_SB(b, h) ((4 + (b) * 2 + (h)) * HTB)
#define PG8_STAGE(bufoff, gbase, voff) do { _Pragma("unroll") for (int _i = 0; _i < 2; ++_i) \
        __builtin_amdgcn_global_load_lds((const unsigned*)((const char*)(gbase) + (voff)[_i]), (PG8_LAS unsigned*)(lds + (bufoff) + ldsw + _i * 8192), 16, 0, 0); } while (0)
#define PG8_LDA(dst, b, h) do { if constexpr (Epi::F8) { _Pragma("unroll") for (int m = 0; m < 4; ++m) dst##8[m] = cat8(*(const PG8_LAS bf16x8*)(lds + PG8_SA(b, h) + aoff + m * 2048), *(const PG8_LAS bf16x8*)(lds + PG8_SA(b, h) + aoff + m * 2048 + 1024)); } \
        else { _Pragma("unroll") for (int m = 0; m < 4; ++m) _Pragma("unroll") for (int k = 0; k < 2; ++k) dst[m][k] = *(const PG8_LAS bf16x8*)(lds + PG8_SA(b, h) + aoff + m * 2048 + k * 1024); } } while (0)
#define PG8_LDB(dst, b, h) do { if constexpr (Epi::F8) { _Pragma("unroll") for (int n = 0; n < 2; ++n) dst##8[n] = cat8(*(const PG8_LAS bf16x8*)(lds + PG8_SB(b, h) + boff + n * 2048), *(const PG8_LAS bf16x8*)(lds + PG8_SB(b, h) + boff + n * 2048 + 1024)); } \
        else { _Pragma("unroll") for (int n = 0; n < 2; ++n) _Pragma("unroll") for (int k = 0; k < 2; ++k) dst[n][k] = *(const PG8_LAS bf16x8*)(lds + PG8_SB(b, h) + boff + n * 2048 + k * 1024); } } while (0)
#define PG8_MMA(ai, bj, At, Bt) do { __builtin_amdgcn_s_setprio(1); \
        if constexpr (Epi::F8) { _Pragma("unroll") for (int m = 0; m < 4; ++m) _Pragma("unroll") for (int n = 0; n < 2; ++n) \
            asm volatile("v_mfma_scale_f32_16x16x128_f8f6f4 %0, %1, %2, %0, %3, %4 op_sel_hi:[0,0,0]" : "+v"(acc[ai][bj][m][n]) : "v"(Bt##8[n]), "v"(At##8[m]), "v"(f8_sw), "v"(f8_sa)); } \
        else { _Pragma("unroll") for (int m = 0; m < 4; ++m) _Pragma("unroll") for (int n = 0; n < 2; ++n) _Pragma("unroll") for (int k = 0; k < 2; ++k) \
            acc[ai][bj][m][n] = __builtin_amdgcn_mfma_f32_16x16x32_bf16(Bt[n][k], At[m][k], acc[ai][bj][m][n], 0, 0, 0); } \
        __builtin_amdgcn_s_setprio(0); } while (0)
#define PG8_WAIT_V(n) asm volatile("s_waitcnt vmcnt(" #n ")" ::: "memory")
#define PG8_WAIT_L(n) asm volatile("s_waitcnt lgkmcnt(" #n ")" ::: "memory")
#define PG8_BAR __builtin_amdgcn_s_barrier()
#define PG8_SCHED __builtin_amdgcn_sched_barrier(0)
    Unit cur, nxt; int ui = 0;
    if (!S.next(0, cur)) return;
    f32x4 acc[2][2][4][2];
#pragma unroll
    for (int a = 0; a < 2; ++a)
#pragma unroll
        for (int b = 0; b < 2; ++b)
#pragma unroll
            for (int m = 0; m < 4; ++m)
#pragma unroll
                for (int n = 0; n < 2; ++n) acc[a][b][m][n] = (f32x4){0.f, 0.f, 0.f, 0.f};
    bf16x8 At[4][2], B0[2][2], B1[2][2]; i32x8 At8[4], B08[2], B18[2];
    const int f8_sw = 0x7a7a7a7a, f8_sa = 0x7f7f7f7f;
    const char* Ab = (const char*)g.A; const char* cB = (const char*)(cur.pn < g.pn_split ? g.Bt2 : g.Bt) + (size_t)cur.pn * tstep;
    unsigned gc0[2], gc1[2], gn0[2], gn1[2];
#pragma unroll
    for (int i = 0; i < 2; ++i) { gc0[i] = G.rowoff(cur, RA[i]) + CA2[i]; gc1[i] = G.rowoff(cur, RA[i] + 128) + CA2[i]; }
    (void)voffA;
    S.a_ready(cur);
    PG8_STAGE(PG8_SB(0, 0), cB, voffB); PG8_STAGE(PG8_SA(0, 0), Ab, gc0); PG8_STAGE(PG8_SB(0, 1), cB + hstep, voffB); PG8_STAGE(PG8_SA(0, 1), Ab, gc1);
    if (wr == 1) PG8_BAR;
    PG8_WAIT_V(4); PG8_BAR;
    PG8_STAGE(PG8_SB(1, 0), cB + kstep, voffB); PG8_STAGE(PG8_SA(1, 0), Ab + kstep, gc0); PG8_STAGE(PG8_SB(1, 1), cB + hstep + kstep, voffB);
    PG8_WAIT_V(6); PG8_BAR;
    PG8_STAMP();
    for (;;) {
        const bool has_next = S.next(ui + 1, nxt);
        const char* nB = has_next ? (const char*)(nxt.pn < g.pn_split ? g.Bt2 : g.Bt) + (size_t)nxt.pn * tstep : cB;
#pragma unroll
        for (int i = 0; i < 2; ++i) { gn0[i] = has_next ? G.rowoff(nxt, RA[i]) + CA2[i] : gc0[i]; gn1[i] = has_next ? G.rowoff(nxt, RA[i] + 128) + CA2[i] : gc1[i]; }
        for (int t = 0; t < nt; t += 2) {
            const bool last = (t == nt - 2);
            const char* a1 = Ab + (size_t)(t + 1) * kstep;
            const char* a2 = last ? Ab : Ab + (size_t)(t + 2) * kstep; const char* b2 = last ? nB : cB + (size_t)(t + 2) * kstep;
            unsigned g2a[2], g2b[2];
#pragma unroll
            for (int i = 0; i < 2; ++i) { g2a[i] = last ? gn0[i] : gc0[i]; g2b[i] = last ? gn1[i] : gc1[i]; }
            const char* a3 = a2 + kstep; const char* b3 = b2 + kstep;
            if (last && has_next) S.a_ready(nxt);
            PG8_LDB(B0, 0, 0); PG8_SCHED; PG8_LDA(At, 0, 0); PG8_STAGE(PG8_SA(1, 1), a1, gc1);
            PG8_WAIT_L(8); PG8_BAR; PG8_WAIT_L(0); PG8_MMA(0, 0, At, B0); PG8_BAR; PG8_SCHED;
            PG8_LDB(B1, 0, 1); PG8_STAGE(PG8_SB(0, 0), b2, voffB);
            PG8_BAR; PG8_WAIT_L(0); PG8_MMA(0, 1, At, B1); PG8_BAR;
            PG8_LDA(At, 0, 1); PG8_STAGE(PG8_SA(0, 0), a2, g2a);
            PG8_BAR; PG8_WAIT_L(0); PG8_MMA(1, 0, At, B0); PG8_BAR; PG8_SCHED;
            PG8_STAGE(PG8_SB(0, 1), b2 + hstep, voffB);
            PG8_WAIT_V(6); PG8_BAR; PG8_MMA(1, 1, At, B1); PG8_BAR;
            PG8_LDB(B0, 1, 0); PG8_SCHED; PG8_LDA(At, 1, 0); PG8_STAGE(PG8_SA(0, 1), a2, g2b);
            PG8_WAIT_L(8); PG8_BAR; PG8_WAIT_L(0); PG8_MMA(0, 0, At, B0); PG8_BAR; PG8_SCHED;
            PG8_LDB(B1, 1, 1); PG8_STAGE(PG8_SB(1, 0), b3, voffB);
            PG8_BAR; PG8_WAIT_L(0); PG8_MMA(0, 1, At, B1); PG8_BAR;
            PG8_LDA(At, 1, 1); PG8_STAGE(PG8_SA(1, 0), a3, g2a);
            PG8_BAR; PG8_WAIT_L(0); PG8_MMA(1, 0, At, B0); PG8_BAR; PG8_SCHED;
            PG8_STAGE(PG8_SB(1, 1), b3 + hstep, voffB);
            PG8_WAIT_V(6); PG8_BAR; PG8_MMA(1, 1, At, B1); PG8_BAR;
        }
        PG8_STAMP();
        if constexpr (Epi::F8) asm volatile("s_nop 15\n\ts_nop 15\n\ts_nop 15" ::: "memory");
        if constexpr (!Epi::AFTER_DRAIN) { E(acc, cur, wr, wc, fr, fq); S.done(cur); }
        PG8_STAMP();
        if (!has_next) break;
#pragma unroll
        for (int a = 0; a < 2; ++a)
#pragma unroll
            for (int b = 0; b < 2; ++b)
#pragma unroll
                for (int m = 0; m < 4; ++m)
#pragma unroll
                    for (int n = 0; n < 2; ++n) acc[a][b][m][n] = (f32x4){0.f, 0.f, 0.f, 0.f};
        cur = nxt; cB = nB; ++ui;
#pragma unroll
        for (int i = 0; i < 2; ++i) { gc0[i] = gn0[i]; gc1[i] = gn1[i]; }
    }
    PG8_WAIT_V(0);
    if (wr == 0) PG8_BAR;
    PG8_BAR;
    if constexpr (Epi::AFTER_DRAIN) { E.fused(acc, cur, wr, wc, fr, fq, lds, wid, lane); S.done(cur); }
    PG8_STAMP();
    if (STAMP && wid == 0) { stamps[lane] = lane < nts ? (((unsigned long long)(unsigned)ts_hi << 32) | (unsigned)ts_lo) : 0ull;
        if (lane == 62) stamps[62] = rt_entry; if (lane == 63) stamps[63] = (unsigned long long)wall_clock64(); }
#undef PG8_STAMP
#undef PG8_SA
#undef PG8_SB
#undef PG8_STAGE
#undef PG8_LDA
#undef PG8_LDB
#undef PG8_MMA
#undef PG8_WAIT_V
#undef PG8_WAIT_L
#undef PG8_BAR
#undef PG8_SCHED
}
}

constexpr size_t WS_WINT = 284 * MB;
constexpr size_t WS_WOUTT = 1 * MB;
constexpr int NPAD_IN = 4352;
DI void transpose_tile(const float* W, int ldw, int k0, int n0, int nvalid, bfr* WT, int ldt, char* smem) {
  short* T = (short*)smem;
  const int tid = VT;
  LBAR();
  {
    const int r = tid >> 2, c4 = tid & 3;
#pragma unroll
    for (int q = 0; q < 4; ++q) {
      const int n = n0 + 16 * c4 + 4 * q;
      f32x4 v = {0.f, 0.f, 0.f, 0.f};
      if (n < nvalid) v = *(const f32x4*)(W + (size_t)(k0 + r) * ldw + n);
#pragma unroll
      for (int e = 0; e < 4; ++e) T[r * 66 + 16 * c4 + 4 * q + e] = (short)f2bf(v[e]);
    }
  }
  LBAR();
  {
    const int n = tid >> 2, kq = tid & 3;
    unsigned wv[8];
#pragma unroll
    for (int e = 0; e < 8; ++e) wv[e] = ((unsigned)(unsigned short)T[(16 * kq + 2 * e) * 66 + n]) | (((unsigned)(unsigned short)T[(16 * kq + 2 * e + 1) * 66 + n]) << 16);
    bfr* dst = WT + (size_t)(n0 + n) * ldt + k0 + 16 * kq;
    *(uint4*)dst = uint4{wv[0], wv[1], wv[2], wv[3]};
    *(uint4*)(dst + 8) = uint4{wv[4], wv[5], wv[6], wv[7]};
  }
}
template <int LDC, int NVALID> struct EpiBf16T {
  static constexpr bool PERM = true, AFTER_DRAIN = false, F8 = false;
  bfr* O;
  DI void operator()(const pg8::f32x4 (&acc)[2][2][4][2], const pg8::Unit& u, int wr, int wc, int fr, int fq) const {
    const int row0 = u.pm * 256 + wr * 64 + fr, col0 = u.pn * 256 + wc * 32 + 8 * fq;
#pragma unroll
    for (int ai = 0; ai < 2; ++ai)
#pragma unroll
      for (int m = 0; m < 4; ++m) {
        bfr* rowp = O + (size_t)(row0 + ai * 128 + m * 16) * LDC + col0;
#pragma unroll
        for (int bj = 0; bj < 2; ++bj) {
          if (col0 + bj * 128 < NVALID) {
            const pg8::f32x4 v0 = acc[ai][bj][m][0], v1 = acc[ai][bj][m][1];
            *(uint4*)(rowp + bj * 128) = uint4{pack2(v0[0], v0[1]), pack2(v0[2], v0[3]), pack2(v1[0], v1[1]), pack2(v1[2], v1[3])};
          }
        }
      }
  }
};
constexpr int GU_EARLY_E = 16, GU_EARLY_ITEMS = GU_EARLY_E * 64;
DI void phase_moe_convert_gu(CParams& P, int bid, int nb, char* smem, int it_lo, int it_hi);
DI void phase_pgemm8(CParams& P, char* smem_all) {
  pg8::Gemm g{(const pg8::bf16_t*)(P.ws + WS_H), (const pg8::bf16_t*)(P.ws + WS_WINT), T_ALL, NPAD_IN, DM};
  pg8::StaticOrder S; S.init(T_ALL, NPAD_IN, (int)gridDim.x, (int)blockIdx.x);
  typedef EpiBf16T<DIN, DIN> EpiP;
  EpiP E{(bfr*)(P.ws + WS_P)};
  pg8::gemm_phase<EpiP, pg8::StaticOrder>((PG8_LAS unsigned char*)smem_all, g, S, E, nullptr);
  const int G_ = (int)gridDim.x, nunits = (T_ALL / 256) * (NPAD_IN / 256);
  const int rounds = (nunits + G_ - 1) / G_, first_idle = nunits - (rounds - 1) * G_;
  const int half = __builtin_amdgcn_readfirstlane((int)(threadIdx.x >> 8));
  if (first_idle < G_) { if ((int)blockIdx.x >= first_idle) phase_moe_convert_gu(P, ((int)blockIdx.x - first_idle) * 2 + half, (G_ - first_idle) * 2, smem_all + half * 78080, 0, GU_EARLY_ITEMS); }
  else phase_moe_convert_gu(P, (int)blockIdx.x * 2 + half, G_ * 2, smem_all + half * 78080, 0, GU_EARLY_ITEMS);
}
DI bool outproj_split(int G) { return (G & 15) == 0; }
DI void phase_outproj8(CParams& P, char* smem_all) {
  pg8::Gemm g{(const pg8::bf16_t*)(P.ws + WS_MIX), (const pg8::bf16_t*)(P.ws + WS_WOUTT), T_LAT, DM, DM};
  const int G_ = (int)gridDim.x, b_ = (int)blockIdx.x;
  pg8::StaticOrder S;
  if (outproj_split(G_)) { if ((b_ >> 3) & 1) return; S.init(T_LAT, DM, G_ >> 1, (b_ >> 4) * 8 + (b_ & 7)); }
  else S.init(T_LAT, DM, G_, b_);
  typedef EpiBf16T<DM, DM> EpiY;
  EpiY E{(bfr*)(P.ws + WS_Y)};
  pg8::gemm_phase<EpiY, pg8::StaticOrder>((PG8_LAS unsigned char*)smem_all, g, S, E, nullptr);
}
DI void phase_gu_beside_outproj(CParams& P, int bid, int nb, char* smem) {
  const int G_ = (int)gridDim.x, b_ = (int)blockIdx.x;
  if (!outproj_split(G_)) { phase_moe_convert_gu(P, bid, nb, smem, GU_EARLY_ITEMS, 64 * 64); return; }
  const int lo = GU_EARLY_ITEMS, mid = lo + 2 * (64 * 64 - lo) / 3;
  if ((b_ >> 3) & 1) phase_moe_convert_gu(P, ((b_ >> 4) * 8 + (b_ & 7)) * 2 + (bid & 1), nb >> 1, smem, lo, mid);
  phase_moe_convert_gu(P, bid, nb, smem, mid, 64 * 64);
}


constexpr size_t WS_BTGU = 350 * MB;
constexpr size_t WS_BTD = 284 * MB;
constexpr size_t WS_HID8 = 138 * MB;
constexpr size_t WS_MOUT8 = 42 * MB;
constexpr int TAB_LDS_OFF = 131072 + 1024;

DI void transpose_quad(const float* W, int ldw, int k0, int n0, bfr* WT, int ldt, int dr0, int dr1, int dr2, int dr3, char* smem, int nvalid = 1 << 30, int dstride = 1) {
  short* T = (short*)smem;
  const int tid = VT;
  const int w_ = tid >> 6, l = tid & 63;
  f32x4 v[16];
#pragma unroll
  for (int i = 0; i < 16; ++i) v[i] = (n0 + 4 * l) < nvalid ? __builtin_nontemporal_load((const f32x4*)(W + (size_t)(k0 + 4 * i + w_) * ldw + n0 + 4 * l)) : f32x4{0.f, 0.f, 0.f, 0.f};
  LBAR();
  {
    short* tw = T + (l >> 4) * (64 * 68) + w_ * 68 + 4 * (l & 15);
#pragma unroll
    for (int i = 0; i < 16; ++i) *(uint2*)(tw + 4 * i * 68) = uint2{pack2(v[i][0], v[i][1]), pack2(v[i][2], v[i][3])};
  }
  LBAR();
  const int n = tid >> 2, kq = tid & 3;
#pragma unroll
  for (int j = 0; j < 4; ++j) {
    unsigned wv[8];
#pragma unroll
    for (int e = 0; e < 8; ++e) wv[e] = ((unsigned)(unsigned short)T[j * 64 * 68 + (16 * kq + 2 * e) * 68 + n]) | (((unsigned)(unsigned short)T[j * 64 * 68 + (16 * kq + 2 * e + 1) * 68 + n]) << 16);
    const int dr = j == 0 ? dr0 : j == 1 ? dr1 : j == 2 ? dr2 : dr3;
    bfr* dst = WT + (size_t)(dr + n * dstride) * ldt + k0 + 16 * kq;
    *(uint4*)dst = uint4{wv[0], wv[1], wv[2], wv[3]};
    *(uint4*)(dst + 8) = uint4{wv[4], wv[5], wv[6], wv[7]};
  }
}
DI void transpose_quad_f8(const float* W, int ldw, int k0, int n0, unsigned char* WT, int ldt, int dr0, int dr1, int dr2, int dr3, char* smem) {
  unsigned char* T = (unsigned char*)smem;
  const int tid = VT;
  const int w_ = tid >> 6, l = tid & 63;
  f32x4 v[16];
#pragma unroll
  for (int i = 0; i < 16; ++i) v[i] = __builtin_nontemporal_load((const f32x4*)(W + (size_t)(k0 + 4 * i + w_) * ldw + n0 + 4 * l));
  LBAR();
  {
    unsigned char* tw = T + (l >> 4) * (64 * 68) + w_ * 68 + 4 * (l & 15);
#pragma unroll
    for (int i = 0; i < 16; ++i) *(unsigned*)(tw + 4 * i * 68) = pk4_f8(v[i][0] * 32.f, v[i][1] * 32.f, v[i][2] * 32.f, v[i][3] * 32.f);
  }
  LBAR();
  const int n = tid >> 2, kq = tid & 3;
#pragma unroll
  for (int j = 0; j < 4; ++j) {
    unsigned wv[4];
#pragma unroll
    for (int e = 0; e < 4; ++e) {
      const unsigned char* tp = T + j * (64 * 68) + (16 * kq + 4 * e) * 68 + n;
      wv[e] = (unsigned)tp[0] | ((unsigned)tp[68] << 8) | ((unsigned)tp[136] << 16) | ((unsigned)tp[204] << 24);
    }
    const int dr = j == 0 ? dr0 : j == 1 ? dr1 : j == 2 ? dr2 : dr3;
    *(uint4*)(WT + (size_t)(dr + n) * ldt + k0 + 16 * kq) = uint4{wv[0], wv[1], wv[2], wv[3]};
  }
}
DI void phase_moe_convert_gu(CParams& P, int bid, int nb, char* smem, int it_lo, int it_hi) {
  for (int it = it_lo + bid; it < it_hi; it += nb) {
    const int e = it >> 6, s = it & 63;
    const int isup = s >> 5, kt = (s & 31) >> 1, nq = s & 1;
    const float* W = (isup ? P.in[30] : P.in[29]) + (size_t)e * DM * DEXP;
    unsigned char* WT = (e < GU_EARLY_E ? (unsigned char*)P.out : (unsigned char*)(P.ws + WS_BTGU)) + (size_t)e * 1024 * 1024;
    const int b = nq * 4;
    transpose_quad_f8(W, DEXP, kt * 64, nq * 256, WT, 1024,
                   ((b + 0) >> 1) * 256 + isup * 128 + ((b + 0) & 1) * 64, ((b + 1) >> 1) * 256 + isup * 128 + ((b + 1) & 1) * 64,
                   ((b + 2) >> 1) * 256 + isup * 128 + ((b + 2) & 1) * 64, ((b + 3) >> 1) * 256 + isup * 128 + ((b + 3) & 1) * 64, smem);
  }
}
constexpr int CONVD_ITEMS = 64 * 32, CONVD_SPLIT = 1152;
DI void phase_moe_convert_d(CParams& P, int bid, int nb, char* smem, int it_lo, int it_hi) {
  for (int it = it_lo + bid; it < it_hi; it += nb) {
    const int e = it >> 5, s2 = it & 31, kt = s2 >> 2, nq = s2 & 3;
    const float* W = P.in[31] + (size_t)e * DEXP * DM;
    unsigned char* WT = (unsigned char*)(P.ws + WS_BTD) + (size_t)e * 1024 * 512;
    transpose_quad_f8(W, DM, kt * 64, nq * 256, WT, 512, nq * 256, nq * 256 + 64, nq * 256 + 128, nq * 256 + 192, smem);
  }
}
constexpr int XT_EXP = 80, XT_LP = 144, XT_CNT = 224;
DI void moe_block_table256(CParams& P, int* tab  ) {
  const int* cnt = (const int*)(P.ws + WS_CNT);
  __syncthreads();
  const int t = tx_();
  if (t < 64) {
    const int ct_ = cnt[t];
    tab[XT_CNT + t] = ct_;
    const int nr = (ct_ + 255) >> 8;
    int incl = nr;
#pragma unroll
    for (int o = 1; o < 64; o <<= 1) { int u = __shfl_up(incl, o); if (t >= o) incl += u; }
    tab[t + 1] = incl;
    if (t == 0) tab[0] = 0;
    int rank = 0;
#pragma unroll
    for (int o = 0; o < 64; ++o) { const int v = __builtin_amdgcn_readlane(nr, o); rank += (v > nr || (v == nr && o < t)) ? 1 : 0; }
    { const int k = rank >> 3, pos = rank & 7, x = (k & 1) ? 7 - pos : pos; tab[XT_EXP + x * 8 + k] = t; }
    __builtin_amdgcn_fence(__ATOMIC_RELEASE, "wavefront"); asm volatile("s_waitcnt lgkmcnt(0)" ::: "memory");
    const int e = tab[XT_EXP + t];
    int p = __shfl(nr, e);
#pragma unroll
    for (int o = 1; o < 8; o <<= 1) { int u = __shfl_up(p, o); if ((t & 7) >= o) p += u; }
    tab[XT_LP + (t >> 3) * 9 + (t & 7) + 1] = p;
    if ((t & 7) == 0) tab[XT_LP + (t >> 3) * 9] = 0;
  }
  __syncthreads();
}
struct MoeOrder {
  const int* tab; int nunits, G, c;
  DI bool next(int i, pg8::Unit& u) const {
    if ((G & 7) == 0) {
      const int x = c & 7, JW = G >> 3, v = i * JW + (c >> 3), lr = v >> 2;
      const int* lp = tab + XT_LP + x * 9;
      if (lr >= lp[8]) return false;
      int k = 0; while (lp[k + 1] <= lr) ++k;
      const int e = tab[XT_EXP + x * 8 + k];
      u.pm = tab[e] + lr - lp[k]; u.pn = e * 4 + (v & 3); return true;
    }
    const int L = i * G + c; if (L >= nunits) return false;
    const int rb = L >> 2; int e = 0; while (tab[e + 1] <= rb) ++e;
    u.pm = rb; u.pn = e * 4 + (L & 3); return true;
  }
  DI void a_ready(const pg8::Unit&) const {}
  DI void done(const pg8::Unit&) const {}
};
struct EpiHid {
  static constexpr bool PERM = true, AFTER_DRAIN = false, F8 = true;
  unsigned char* H;
  DI void operator()(const pg8::f32x4 (&acc)[2][2][4][2], const pg8::Unit& u, int wr, int wc, int fr, int fq) const {
    const int row0 = u.pm * 256 + wr * 64 + fr, col0 = (u.pn & 3) * 128 + wc * 32 + 8 * fq;
#pragma unroll
    for (int ai = 0; ai < 2; ++ai)
#pragma unroll
      for (int m = 0; m < 4; ++m) {
        float hv[8];
#pragma unroll
        for (int n = 0; n < 2; ++n)
#pragma unroll
          for (int j = 0; j < 4; ++j) hv[4 * n + j] = siluf_(acc[ai][0][m][n][j]) * acc[ai][1][m][n][j];
        *(uint2*)(H + (size_t)(row0 + ai * 128 + m * 16) * DEXP + col0) = uint2{pk4_f8(hv[0], hv[1], hv[2], hv[3]), pk4_f8(hv[4], hv[5], hv[6], hv[7])};
      }
  }
};
struct EpiMout {
  static constexpr bool PERM = true, AFTER_DRAIN = false, F8 = true;
  bfr* O; const int* tab; const int* cnt; const int* list; bfr* dump;
  DI void operator()(const pg8::f32x4 (&acc)[2][2][4][2], const pg8::Unit& u, int wr, int wc, int fr, int fq) const {
    const int e = u.pn >> 2, pnl = u.pn & 3;
    const int lrow0 = (u.pm - tab[e]) * 256 + wr * 64 + fr, ce = tab[XT_CNT + e];
    const int col0 = pnl * 256 + wc * 32 + 8 * fq;
    int asgs[2][4];
#pragma unroll
    for (int ai = 0; ai < 2; ++ai)
#pragma unroll
      for (int m = 0; m < 4; ++m) { const int idx = lrow0 + ai * 128 + m * 16; asgs[ai][m] = list[e * T_LAT + (idx < ce ? idx : 0)]; }
#pragma unroll
    for (int ai = 0; ai < 2; ++ai)
#pragma unroll
      for (int m = 0; m < 4; ++m) {
        const int idx = lrow0 + ai * 128 + m * 16;
        {
          const int asg = asgs[ai][m];
          bfr* rowp = (idx < ce ? O + (size_t)asg * DM : dump) + col0;
#pragma unroll
          for (int bj = 0; bj < 2; ++bj) {
            const pg8::f32x4 v0 = acc[ai][bj][m][0], v1 = acc[ai][bj][m][1];
            *(uint4*)(rowp + bj * 128) = uint4{pack2(v0[0], v0[1]), pack2(v0[2], v0[3]), pack2(v1[0], v1[1]), pack2(v1[2], v1[3])};
          }
        }
      }
  }
};
struct MoeGather {
  const int* tab; const int* cnt; const int* list;
  DI unsigned rowoff(const pg8::Unit& u, int r) const {
    const int e = u.pn >> 2, idx = (u.pm - tab[e]) * 256 + r;
    const int tok = list[e * T_LAT + (idx < tab[XT_CNT + e] ? idx : 0)] >> 1;
    return (unsigned)tok * (unsigned)DM;
  }
};
DI void phase_moe1_8(CParams& P, char* smem_all) {
  int* tab = (int*)(smem_all + TAB_LDS_OFF);
  moe_block_table256(P, tab);
  const int nrb = tab[64];
  pg8::Gemm g{(const pg8::bf16_t*)(P.ws + WS_H2), (const pg8::bf16_t*)(P.ws + WS_BTGU), nrb * 256, 64 * 1024, DM / 2, (const pg8::bf16_t*)P.out, GU_EARLY_E * 4};
  MoeOrder S{tab, nrb * 4, (int)gridDim.x, (int)blockIdx.x};
  EpiHid E{(unsigned char*)(P.ws + WS_HID8)};
  MoeGather G{tab, (const int*)(P.ws + WS_CNT), (const int*)(P.ws + WS_LIST)};
  pg8::gemm_phase_gather<EpiHid, MoeOrder, MoeGather>((PG8_LAS unsigned char*)smem_all, g, S, E, G, nullptr);
  const int G_ = (int)gridDim.x, nunits = nrb * 4;
  int rank = -1, n_idle = 0;
  if ((G_ & 7) == 0) {
    const int JW = G_ >> 3, x = (int)blockIdx.x & 7, j = (int)blockIdx.x >> 3;
    int rmax = 0;
#pragma unroll
    for (int xx = 0; xx < 8; ++xx) { const int r_ = (4 * tab[XT_LP + xx * 9 + 8] + JW - 1) / JW; rmax = r_ > rmax ? r_ : rmax; }
#pragma unroll
    for (int xx = 0; xx < 8; ++xx) { int fi = 4 * tab[XT_LP + xx * 9 + 8] - (rmax - 1) * JW; fi = fi < 0 ? 0 : (fi > JW ? JW : fi);
      if (xx == x && j >= fi) rank = n_idle + (j - fi);
      n_idle += JW - fi; }
  } else {
    const int rounds = (nunits + G_ - 1) / G_, first_idle = nunits - (rounds - 1) * G_;
    if (first_idle < G_) { n_idle = G_ - first_idle; if ((int)blockIdx.x >= first_idle) rank = (int)blockIdx.x - first_idle; }
  }
  if (n_idle == 0) { n_idle = G_; rank = (int)blockIdx.x; }
  rank = __builtin_amdgcn_readfirstlane(rank); n_idle = __builtin_amdgcn_readfirstlane(n_idle);
  if (rank >= 0) {
    const int half = __builtin_amdgcn_readfirstlane((int)(threadIdx.x >> 8));
    phase_moe_convert_d(P, rank * 2 + half, n_idle * 2, smem_all + half * 78080, CONVD_SPLIT, CONVD_ITEMS);
  }
}
DI void phase_moe2_8(CParams& P, char* smem_all) {
  int* tab = (int*)(smem_all + TAB_LDS_OFF);
  moe_block_table256(P, tab);
  const int nrb = tab[64];
  pg8::Gemm g{(const pg8::bf16_t*)(P.ws + WS_HID8), (const pg8::bf16_t*)(P.ws + WS_BTD), nrb * 256, 64 * 1024, DEXP / 2};
  MoeOrder S{tab, nrb * 4, (int)gridDim.x, (int)blockIdx.x};
  EpiMout E{(bfr*)(P.ws + WS_MOUT8), tab, (const int*)(P.ws + WS_CNT), (const int*)(P.ws + WS_LIST), (bfr*)((char*)P.out + (48ull << 20))};
  pg8::gemm_phase<EpiMout, MoeOrder>((PG8_LAS unsigned char*)smem_all, g, S, E, nullptr);
}

#define XB_TMO      128
#define XB_XCNT(j)  (256  + 64 * (j))
#define XB_XSUB(j)  (1280 + 64 * (j))
#define XB_XGEN(j)  (2304 + 64 * (j))
#define XB_TOP      3328
#define XB_TOPGEN   3392
#define XCD_BAR_WORDS 3456
#define XB_SPIN_CAP (1u << 22)
#define LAS __attribute__((address_space(3)))
DI unsigned xb_ld(unsigned* p)              { return __hip_atomic_load(p, __ATOMIC_RELAXED, __HIP_MEMORY_SCOPE_AGENT); }
DI unsigned xb_add(unsigned* p, unsigned v) { return __hip_atomic_fetch_add(p, v, __ATOMIC_RELAXED, __HIP_MEMORY_SCOPE_AGENT); }
DI unsigned xb_xcc_id() { return (unsigned)__builtin_amdgcn_s_getreg((3 << 11) | 20) & 0xFu; }
#define XB_SPIN(cond, bar) do { unsigned _sp = 0; while (cond) { __builtin_amdgcn_s_sleep(1); \
    if ((++_sp & 255u) == 0u) { if (xb_ld(&(bar)[XB_TMO])) break; if (_sp > XB_SPIN_CAP) { atomicAdd(&(bar)[XB_TMO], 1u); break; } } } } while (0)
struct XcdBarrier { unsigned* bar; unsigned x; volatile LAS unsigned* st; };
DI XcdBarrier xcd_barrier_post(unsigned* bar, volatile LAS unsigned* st) {
  XcdBarrier b; b.bar = bar; b.x = xb_xcc_id(); b.st = st;
  if (threadIdx.x == 0) (void)xb_add(&bar[XB_XCNT(b.x)], 1u);
  return b;
}
DI void xcd_barrier_complete(unsigned* bar, unsigned x, unsigned& nloc, unsigned& nx) {
  const unsigned G = gridDim.x * gridDim.y * gridDim.z;
  unsigned sum, cnt, mine, sp = 0u;
  for (;;) {
    sum = 0u; cnt = 0u; mine = 0u;
#pragma unroll
    for (unsigned j = 0; j < 16; ++j) { const unsigned c = xb_ld(&bar[XB_XCNT(j)]); sum += c; cnt += (c > 0u) ? 1u : 0u; mine = (j == x) ? c : mine; }
    if (sum == G) break;
    __builtin_amdgcn_s_sleep(1);
    if ((++sp & 255u) == 0u) { if (xb_ld(&bar[XB_TMO])) break; if (sp > XB_SPIN_CAP) { atomicAdd(&bar[XB_TMO], 1u); break; } }
  }
  nloc = mine > 0u ? mine : 1u; nx = cnt > 0u ? cnt : 1u;
}
DI void xcd_barrier(const XcdBarrier& b) {
  asm volatile("s_waitcnt vmcnt(0)" ::: "memory");
  __syncthreads();
  if (threadIdx.x == 0) {
    unsigned* bar = b.bar;
    __builtin_amdgcn_s_waitcnt(0);
    unsigned nloc = b.st[0], nx = b.st[1];
    if (nloc == 0u) { xcd_barrier_complete(bar, b.x, nloc, nx); b.st[0] = nloc; b.st[1] = nx; }
    const unsigned old = xb_add(&bar[XB_XSUB(b.x)], 1u);
    const unsigned gen = old / nloc;
    asm volatile("buffer_inv sc1" ::: "memory");
    if (old + 1u == (gen + 1u) * nloc) {
      asm volatile("buffer_wbl2 sc1\n\ts_waitcnt vmcnt(0)" ::: "memory");
      const unsigned og = xb_add(&bar[XB_TOP], 1u);
      const unsigned tg = og / nx;
      if (og + 1u == (tg + 1u) * nx) xb_add(&bar[XB_TOPGEN], 1u);
      else XB_SPIN(xb_ld(&bar[XB_TOPGEN]) == tg, bar);
      xb_add(&bar[XB_XGEN(b.x)], 1u);
      asm volatile("s_waitcnt vmcnt(0)" ::: "memory");
    } else {
      XB_SPIN(xb_ld(&bar[XB_XGEN(b.x)]) == gen, bar);
      asm volatile("s_waitcnt vmcnt(0)" ::: "memory");
    }
  }
  __syncthreads();
}

namespace cg = cooperative_groups;
constexpr int HALF_LDS = 78080;
constexpr int SMEM_BYTES = 2 * HALF_LDS + 16;
__global__ void __launch_bounds__(NTHR_BLOCK) k_fused(Params Pval) {
  __shared__ __attribute__((aligned(16))) char smem_all[SMEM_BYTES];
  cg::grid_group grid = cg::this_grid();
  CParams* kp0 = (CParams*)__builtin_amdgcn_kernarg_segment_ptr();
#define PH(call) do { CParams* kp_ = kp0; asm volatile("" : "+s"(kp_)); CParams& P = *kp_; \
    int half = __builtin_amdgcn_readfirstlane((int)(threadIdx.x >> 8)); asm volatile("" : "+s"(half)); \
    char* smem = smem_all + half * HALF_LDS; const int bid = blockIdx.x * 2 + half, nb = gridDim.x * 2; (void)smem; (void)bid; (void)nb; call; } while (0)
  volatile LAS unsigned* bst = (volatile LAS unsigned*)(smem_all + SMEM_BYTES - 16);
  if (threadIdx.x < 4) bst[threadIdx.x] = 0u;
  __syncthreads();
  XcdBarrier xb = xcd_barrier_post(Pval.bar, bst);
#define GSYNC() do { if (Pval.use_cg) grid.sync(); else xcd_barrier(xb); } while (0)
  PH(phase_mod(P, bid, nb, smem));
  GSYNC();
  PH(phase_ln1(P, bid, nb));
  GSYNC();
  PH(phase_pgemm8(P, smem_all));
  GSYNC();
  PH(phase_rwprep(P, bid, nb, smem));
  PH(for (int it0 = bid; it0 < 8 * HG_NSC; it0 += nb) { const int it = (it0 + 8) % (8 * HG_NSC); hg_levelA_item(P, it / HG_NSC, it % HG_NSC, smem); });
  GSYNC();
  PH(for (int it = bid; it < 16 * RW_NSC; it += nb) rw_levelA_item(P, it / RW_NSC, it % RW_NSC, smem));
  GSYNC();
  PH(if (bid < 16) rw_levelB_chain(P, bid, smem); else { hg_levelB(P, bid - 16, nb - 16); phase_moe_convert_d(P, bid - 16, nb - 16, smem, 0, CONVD_SPLIT); });
  GSYNC();
  PH(phase_readout_fused(P, bid, nb));
  GSYNC();
  PH(phase_outproj8(P, smem_all));
  PH(phase_gu_beside_outproj(P, bid, nb, smem));
  GSYNC();
  PH(phase_ln2route(P, smem_all));
  GSYNC();
  PH(phase_moe1_8(P, smem_all));
  GSYNC();
  PH(phase_moe2_8(P, smem_all));
  GSYNC();
  PH(phase_final(P, bid, nb));
}

extern "C" void kernel_launch(void* const* d_in, const int* in_sizes, int n_in, void* d_out, int out_size, void* d_ws, size_t ws_size, hipStream_t stream) {
  static int grid_blocks = 0;
  if (!grid_blocks) {
    int dev = 0, cus = 0, per_cu = 0;
    hipGetDevice(&dev);
    hipDeviceGetAttribute(&cus, hipDeviceAttributeMultiprocessorCount, dev);
    hipOccupancyMaxActiveBlocksPerMultiprocessor(&per_cu, k_fused, NTHR_BLOCK, 0);
    if (per_cu > 1) per_cu = 1;
    if (per_cu < 1) per_cu = 1;
    grid_blocks = cus * per_cu;
  }
  Params P{};
  P.bar = (unsigned*)((char*)d_ws + WS_BAR); P.use_cg = 0; P.pad = 0;
  hipMemsetAsync((char*)d_ws + WS_BAR, 0, XCD_BAR_WORDS * 4, stream);
  for (int i = 0; i < 32; ++i) P.in[i] = (const float*)d_in[i];
  P.out = (float*)d_out; P.ws = (char*)d_ws;
  void* args[] = {&P};
  hipError_t e = hipLaunchCooperativeKernel((void*)k_fused, dim3(grid_blocks), dim3(NTHR_BLOCK), args, 0, stream);
  if (e != hipSuccess) fprintf(stderr, "cooperative launch failed: %s (grid %d)\n", hipGetErrorString(e), grid_blocks);
}
```
